# Optimizing an MI355X kernel written in HIP

```python
import math
import jax, jax.numpy as jnp
from jax import lax
import numpy as np

D_MODEL = 1024
BATCH = 8
SEQ = 4096
DEPTH = 1

CONV_CH = D_MODEL // 2
CONV_WIDTH = 31
DA_HEADS = 4
DA_HEAD_DIM = 64
DA_V_DIM = 2 * DA_HEAD_DIM
ATTN_W = DA_HEADS * DA_V_DIM
N_BRANCH = 2
COL_CONV = 2 * CONV_CH
COL_Q = DA_HEADS * 2 * DA_HEAD_DIM
COL_K = DA_HEADS * 2 * DA_HEAD_DIM
COL_V = ATTN_W
COL_GATE = N_BRANCH * D_MODEL
IN_COLS = COL_CONV + COL_Q + COL_K + COL_V + COL_GATE
N_GROUPS = 4
EXPERTS_PER_GROUP = 8
N_EXPERTS = N_GROUPS * EXPERTS_PER_GROUP
TOP_K_IN_GROUP = 2
D_EXPERT = D_MODEL // 2

Q_BLOCK = 128
ROW_BLOCK = 128
EPS = 1e-6

kernel_name = "hybrid_conv_diffattn_hmoe_block"


def rms_norm(x, g):
    xf = x.astype(jnp.float32)
    y = xf * lax.rsqrt(jnp.mean(xf * xf, axis=-1, keepdims=True) + EPS)
    return (y * g.astype(jnp.float32)).astype(x.dtype)


def layer_norm(x, g, b):
    xf = x.astype(jnp.float32)
    mu = jnp.mean(xf, axis=-1, keepdims=True)
    var = jnp.mean(jnp.square(xf - mu), axis=-1, keepdims=True)
    y = (xf - mu) * lax.rsqrt(var + EPS)
    return (y * g.astype(jnp.float32) + b.astype(jnp.float32)).astype(x.dtype)


def conformer_conv(u, dw_w, dw_b, ln_g, ln_b):
    a, gate = jnp.split(u, 2, axis=-1)
    y = a * jax.nn.sigmoid(gate)
    y = lax.conv_general_dilated(
        y, dw_w[:, None, :].astype(y.dtype), window_strides=(1,),
        padding=[(CONV_WIDTH - 1, 0)],
        dimension_numbers=("NWC", "WIO", "NWC"),
        feature_group_count=CONV_CH) + dw_b
    y = layer_norm(y, ln_g, ln_b)
    return jax.nn.silu(y)


def diff_attention(q, k, v, lam, subln_g, lam_init):
    B, S = q.shape[0], q.shape[1]
    nb = S // Q_BLOCK
    scale = DA_HEAD_DIM ** -0.5
    qb = q.reshape(B, nb, Q_BLOCK, DA_HEADS, 2, DA_HEAD_DIM).transpose(1, 0, 2, 3, 4, 5)
    key_pos = jnp.arange(S)

    def block(args):
        qi, bi = args
        s = jnp.einsum("bqhcd,bkhcd->bhcqk", qi, k,
                       preferred_element_type=jnp.float32) * scale
        q_pos = bi * Q_BLOCK + jnp.arange(Q_BLOCK)
        mask = key_pos[None, :] <= q_pos[:, None]
        s = jnp.where(mask, s, -jnp.inf)
        p = jax.nn.softmax(s, axis=-1)
        a = (p[:, :, 0] - lam * p[:, :, 1]).astype(v.dtype)
        return jnp.einsum("bhqk,bkhe->bqhe", a, v)

    o = lax.map(block, (qb, jnp.arange(nb)))
    o = o.transpose(1, 0, 2, 3, 4).reshape(B, S, DA_HEADS, DA_V_DIM)
    o = rms_norm(o, subln_g) * (1.0 - lam_init)
    return o.reshape(B, S, ATTN_W)


def hierarchical_moe(h, w_rg, b_rg, w_re, b_re, w_g, w_u, w_d):
    B, S, D = h.shape
    T = B * S
    hf = h.reshape(T, D)
    g_logits = jnp.matmul(hf, w_rg, preferred_element_type=jnp.float32) + b_rg.astype(jnp.float32)
    g_prob = jax.nn.softmax(g_logits, axis=-1)
    g_sel = jnp.argmax(g_logits, axis=-1)
    g_w = jnp.take_along_axis(g_prob, g_sel[:, None], axis=1)
    e_logits = (jnp.matmul(hf, w_re, preferred_element_type=jnp.float32)
                + b_re.astype(jnp.float32)).reshape(T, N_GROUPS, EXPERTS_PER_GROUP)
    e_logits = jnp.take_along_axis(e_logits, g_sel[:, None, None], axis=1)[:, 0]
    e_prob = jax.nn.softmax(e_logits, axis=-1)
    top_p, top_i = lax.top_k(e_prob, TOP_K_IN_GROUP)
    wts = top_p / jnp.sum(top_p, axis=-1, keepdims=True) * g_w
    eidx = g_sel[:, None] * EXPERTS_PER_GROUP + top_i

    A = T * TOP_K_IN_GROUP
    e_flat = eidx.reshape(A).astype(jnp.int32)
    tok_flat = jnp.repeat(jnp.arange(T, dtype=jnp.int32), TOP_K_IN_GROUP)
    w_flat = wts.reshape(A).astype(h.dtype)
    order = jnp.argsort(e_flat, stable=True)
    e_s, tok_s, w_s = e_flat[order], tok_flat[order], w_flat[order]
    counts = jnp.zeros((N_EXPERTS,), jnp.int32).at[e_flat].add(1)
    padded = (counts + ROW_BLOCK - 1) // ROW_BLOCK * ROW_BLOCK
    start = jnp.cumsum(counts) - counts
    pad_end = jnp.cumsum(padded)
    pstart = pad_end - padded
    dest = pstart[e_s] + jnp.arange(A, dtype=jnp.int32) - start[e_s]
    n_rows = A + N_EXPERTS * ROW_BLOCK
    n_blk = n_rows // ROW_BLOCK
    row_tok = jnp.zeros((n_rows,), jnp.int32).at[dest].set(tok_s)
    row_w = jnp.zeros((n_rows,), h.dtype).at[dest].set(w_s)
    blk_exp = jnp.clip(jnp.searchsorted(pad_end, jnp.arange(n_blk, dtype=jnp.int32) * ROW_BLOCK,
                                        side="right"), 0, N_EXPERTS - 1)

    def expert_block(args):
        toks, wb, e = args
        xb = hf[toks]
        hid = jax.nn.silu(jnp.matmul(xb, w_g[e])) * jnp.matmul(xb, w_u[e])
        return jnp.matmul(hid, w_d[e]) * wb[:, None]

    yb = lax.map(expert_block, (row_tok.reshape(n_blk, ROW_BLOCK),
                                row_w.reshape(n_blk, ROW_BLOCK), blk_exp))
    y = jnp.zeros_like(hf).at[row_tok].add(yb.reshape(n_rows, D))
    return y.reshape(B, S, D)


def setup_inputs(seed: int = 0) -> dict:
    key = jax.random.key(seed)
    ks = jax.random.split(key, 26)
    f32 = jnp.float32

    def nrm(k, shape, scale):
        return jax.random.normal(k, shape, f32) * scale

    L, D, C = DEPTH, D_MODEL, CONV_CH
    return {
        "x": nrm(ks[0], (BATCH, SEQ, D), 1.0),
        "attn_norm_g": 1.0 + nrm(ks[1], (L, D), 0.05),
        "w_in": nrm(ks[2], (L, D, IN_COLS), D ** -0.5),
        "conv_dw_w": nrm(ks[3], (L, CONV_WIDTH, C), CONV_WIDTH ** -0.5),
        "conv_dw_b": nrm(ks[4], (L, C), 0.02),
        "conv_ln_g": 1.0 + nrm(ks[5], (L, C), 0.05),
        "conv_ln_b": nrm(ks[6], (L, C), 0.02),
        "w_conv_out": nrm(ks[7], (L, C, D), C ** -0.5),
        "q_norm_g": 1.0 + nrm(ks[8], (L, DA_HEAD_DIM), 0.05),
        "k_norm_g": 1.0 + nrm(ks[9], (L, DA_HEAD_DIM), 0.05),
        "lambda_q1": nrm(ks[10], (L, DA_HEAD_DIM), 0.1),
        "lambda_k1": nrm(ks[11], (L, DA_HEAD_DIM), 0.1),
        "lambda_q2": nrm(ks[12], (L, DA_HEAD_DIM), 0.1),
        "lambda_k2": nrm(ks[13], (L, DA_HEAD_DIM), 0.1),
        "subln_g": 1.0 + nrm(ks[14], (L, DA_V_DIM), 0.05),
        "w_attn_out": nrm(ks[15], (L, ATTN_W, D), ATTN_W ** -0.5),
        "w_out": nrm(ks[16], (L, D, D), D ** -0.5),
        "ffn_norm_g": 1.0 + nrm(ks[17], (L, D), 0.05),
        "w_router_group": nrm(ks[18], (L, D, N_GROUPS), D ** -0.5),
        "b_router_group": nrm(ks[19], (L, N_GROUPS), 0.01),
        "w_router_expert": nrm(ks[20], (L, D, N_EXPERTS), D ** -0.5),
        "b_router_expert": nrm(ks[21], (L, N_EXPERTS), 0.01),
        "w_gate_e": nrm(ks[22], (L, N_EXPERTS, D, D_EXPERT), D ** -0.5),
        "w_up_e": nrm(ks[23], (L, N_EXPERTS, D, D_EXPERT), D ** -0.5),
        "w_down_e": nrm(ks[24], (L, N_EXPERTS, D_EXPERT, D), D_EXPERT ** -0.5),
    }


def reference(x, attn_norm_g, w_in, conv_dw_w, conv_dw_b, conv_ln_g, conv_ln_b, w_conv_out,
              q_norm_g, k_norm_g, lambda_q1, lambda_k1, lambda_q2, lambda_k2, subln_g,
              w_attn_out, w_out, ffn_norm_g, w_router_group, b_router_group,
              w_router_expert, b_router_expert, w_gate_e, w_up_e, w_down_e):
    B, S, D = x.shape
    for l in range(DEPTH):
        lam_init = 0.8 - 0.6 * math.exp(-0.3 * l)
        h = rms_norm(x, attn_norm_g[l])
        proj = jnp.matmul(h, w_in[l])
        o0 = COL_CONV
        o1 = o0 + COL_Q
        o2 = o1 + COL_K
        o3 = o2 + COL_V
        u_conv = proj[..., :o0]
        q = proj[..., o0:o1].reshape(B, S, DA_HEADS, 2, DA_HEAD_DIM)
        k = proj[..., o1:o2].reshape(B, S, DA_HEADS, 2, DA_HEAD_DIM)
        v = proj[..., o2:o3].reshape(B, S, DA_HEADS, DA_V_DIM)
        gates = jax.nn.sigmoid(proj[..., o3:]).reshape(B, S, N_BRANCH, D)

        conv_out = conformer_conv(u_conv, conv_dw_w[l], conv_dw_b[l], conv_ln_g[l], conv_ln_b[l])

        q = rms_norm(q, q_norm_g[l])
        k = rms_norm(k, k_norm_g[l])
        lam = (jnp.exp(jnp.sum(lambda_q1[l].astype(jnp.float32) * lambda_k1[l].astype(jnp.float32)))
               - jnp.exp(jnp.sum(lambda_q2[l].astype(jnp.float32) * lambda_k2[l].astype(jnp.float32)))
               + lam_init)
        attn_out = diff_attention(q, k, v, lam, subln_g[l], lam_init)

        merged = (gates[:, :, 0] * jnp.matmul(conv_out, w_conv_out[l])
                  + gates[:, :, 1] * jnp.matmul(attn_out, w_attn_out[l]))
        x = x + jnp.matmul(merged, w_out[l])
        h2 = rms_norm(x, ffn_norm_g[l])
        x = x + hierarchical_moe(h2, w_router_group[l], b_router_group[l], w_router_expert[l],
                                 b_router_expert[l], w_gate_e[l], w_up_e[l], w_down_e[l])
    return x
```

```cpp
#include <hip/hip_runtime.h>
#include <hip/hip_bf16.h>
#include <hip/hip_cooperative_groups.h>
#include <cstdio>
#include <cstdint>
#include <cmath>
namespace cg = cooperative_groups;

constexpr int BATCH = 8, SEQ = 4096, DMODEL = 1024, NTOK = BATCH * SEQ;
constexpr int CONV_CH = 512, CONV_W = 31, NHEADS = 4, IN_COLS = 4608;
constexpr int NEXP = 32, DEXP = 512, LCAP = NTOK;
constexpr int NCLS = 4 * 28;
constexpr int CROWS = NTOK + NCLS * 256;
constexpr int MOE_ROWS = 2 * NTOK + NEXP * 256;
constexpr float EPS = 1e-6f;

namespace pg8 {
#define PG8_LAS __attribute__((address_space(3)))
typedef unsigned short bf16_t;
typedef short bf16x8 __attribute__((ext_vector_type(8)));
typedef float f32x4 __attribute__((ext_vector_type(4)));
typedef unsigned u32x4 __attribute__((ext_vector_type(4)));
constexpr int BM = 256, BK = 64, HALF = 128, HTB = HALF * BK * 2  , STAGE_BYTES = 8 * HTB, NXCD = 8, WGM = 8;

__host__ __device__ __forceinline__ int lds_byte(int r, int c) { const int st = (r >> 4) * 2 + (c >> 5), rr = r & 15, cc = c & 31, ob = rr * 64 + cc * 2; return st * 1024 + (ob ^ (((ob >> 9) & 1) << 5)); }
__host__ __device__ __forceinline__ void stage_rc(int b, int& R, int& C) { const int st = b / 1024, sb = b % 1024, swz = sb ^ (((sb >> 9) & 1) << 5); R = (st >> 1) * 16 + swz / 64; C = (st & 1) * 32 + (swz % 64) / 2; }
__host__ __device__ __forceinline__ int perm32(int rho) { const int n = rho >> 4, i = rho & 15; return 8 * (i >> 2) + 4 * n + (i & 3); }

struct Unit { int pm, pn, arow, e, e2, lrow, nvalid, orow; };
struct Gemm { const bf16_t* A; const bf16_t* Bt; int K; size_t bstride; const int* list; int lstride; int KBrow; };

struct StaticOrder {
    int nM, nN, nwg, G, c;
    __device__ void init(int M, int N, int G_, int c_) { nM = M / BM; nN = N / BM; nwg = nM * nN; G = G_; c = c_; }
    __device__ bool next(int i, Unit& u) const {
        const long L = (long)i * G + c; if (L >= nwg) return false;
        int wgid = (int)L; { const int q = nwg / NXCD, r = nwg % NXCD, xcd = wgid % NXCD, off = wgid / NXCD; wgid = (xcd < r ? xcd * (q + 1) : r * (q + 1) + (xcd - r) * q) + off; }
        const int nig = WGM * nN, gid = wgid / nig, fm = gid * WGM, gsz = (nM - fm) < WGM ? (nM - fm) : WGM;
        u.pm = fm + ((wgid % nig) % gsz); u.pn = (wgid % nig) / gsz; u.arow = u.pm * BM; u.orow = u.arow; u.e = 0; u.e2 = 0; u.lrow = 0; u.nvalid = BM; return true;
    }
};

typedef float f32x2_t __attribute__((ext_vector_type(2))); typedef __bf16 bf16x2_t __attribute__((ext_vector_type(2)));
__device__ __forceinline__ unsigned cvt_pk_bf16(float lo, float hi) { const f32x2_t v = {lo, hi}; const bf16x2_t b = __builtin_convertvector(v, bf16x2_t); return __builtin_bit_cast(unsigned, b); }
typedef int v8i_t __attribute__((ext_vector_type(8))); typedef int v4i_t __attribute__((ext_vector_type(4)));
__device__ __forceinline__ v8i_t cat8(const bf16x8 a, const bf16x8 b) { const v4i_t x = __builtin_bit_cast(v4i_t, a), y = __builtin_bit_cast(v4i_t, b); return (v8i_t){x[0], x[1], x[2], x[3], y[0], y[1], y[2], y[3]}; }
__device__ __forceinline__ unsigned pack4_fp8(float a, float b, float c, float d) { int w = 0; w = __builtin_amdgcn_cvt_pk_fp8_f32(a, b, w, false); w = __builtin_amdgcn_cvt_pk_fp8_f32(c, d, w, true); return (unsigned)w; }
__device__ __forceinline__ float bf_lo(unsigned w) { return __uint_as_float(w << 16); }
__device__ __forceinline__ float bf_hi(unsigned w) { return __uint_as_float(w & 0xffff0000u); }
__device__ __forceinline__ float sigmoidf_fast(float x) { return __builtin_amdgcn_rcpf(1.0f + __builtin_amdgcn_exp2f(-1.4426950408889634f * x)); }
__device__ __forceinline__ u32x4 pack8(const f32x4 a, const f32x4 b) { u32x4 w; w.x = cvt_pk_bf16(a[0], a[1]); w.y = cvt_pk_bf16(a[2], a[3]); w.z = cvt_pk_bf16(b[0], b[1]); w.w = cvt_pk_bf16(b[2], b[3]); return w; }
__device__ __forceinline__ void unpack8(const u32x4 w, f32x4& a, f32x4& b) { a = (f32x4){bf_lo(w.x), bf_hi(w.x), bf_lo(w.y), bf_hi(w.y)}; b = (f32x4){bf_lo(w.z), bf_hi(w.z), bf_lo(w.w), bf_hi(w.w)}; }

template <class Epi, class Sched, bool GATHER, bool ALIGN_EPI, bool FP8 = false, bool BSPLIT = false>
__device__ __forceinline__ void gemm_phase(PG8_LAS unsigned char* lds, const Gemm g, const Sched& S, const Epi& E) {
    const int tid = threadIdx.x, wid = __builtin_amdgcn_readfirstlane(tid >> 6), lane = tid & 63, wr = wid >> 2, wc = wid & 3, fr = lane & 15, fq = lane >> 4;
    const int K = g.K, nt = K / BK, KBp = g.KBrow ? g.KBrow : K;
    unsigned voffB[2]; int Ra[2], Ca[2];
#pragma unroll
    for (int i = 0; i < 2; ++i) { int R, C; stage_rc(tid * 16 + i * 8192, R, C); const int Rb = (R & ~31) + perm32(R & 31); Ra[i] = R; Ca[i] = C; voffB[i] = (unsigned)(Rb * KBp + C) * 2u; }
    const unsigned kstep = (unsigned)(BK * 2);
    const unsigned hstep = (unsigned)HALF * KBp * 2;
    const unsigned tstep = 2 * hstep;
    const char* const gA = (const char*)g.A; const char* const gB = (const char*)g.Bt;
    const unsigned ldsw = (unsigned)wid * 1024u;
    const int aoff = lds_byte(wr * 64 + fr, fq * 8), boff = lds_byte(wc * 32 + fr, fq * 8);
#define PG8_SA(b, h) (((b) * 2 + (h)) * HTB)
#define PG8_SB(b, h) ((4 + (b) * 2 + (h)) * HTB)
#define PG8_STAGE(bufoff, gbase, uoff, voff) do { _Pragma("unroll") for (int _i = 0; _i < 2; ++_i) \
        __builtin_amdgcn_global_load_lds((const unsigned*)((const char*)(gbase) + (unsigned)((uoff) + (voff)[_i])), (PG8_LAS unsigned*)(lds + (bufoff) + ldsw + _i * 8192), 16, 0, 0); } while (0)
#define PG8_LDA(dst, b, h) do { _Pragma("unroll") for (int m = 0; m < 4; ++m) _Pragma("unroll") for (int k = 0; k < 2; ++k) dst[m][k] = *(const PG8_LAS bf16x8*)(lds + PG8_SA(b, h) + aoff + m * 2048 + k * 1024); } while (0)
#define PG8_LDB(dst, b, h) do { _Pragma("unroll") for (int n = 0; n < 2; ++n) _Pragma("unroll") for (int k = 0; k < 2; ++k) dst[n][k] = *(const PG8_LAS bf16x8*)(lds + PG8_SB(b, h) + boff + n * 2048 + k * 1024); } while (0)
#define PG8_MMA(ai, bj, At, Bt) do { __builtin_amdgcn_s_setprio(1); \
        if constexpr (FP8) { _Pragma("unroll") for (int m = 0; m < 4; ++m) _Pragma("unroll") for (int n = 0; n < 2; ++n) \
            asm volatile("v_mfma_scale_f32_16x16x128_f8f6f4 %0, %1, %2, %0, %3, %3 op_sel_hi:[0,0,0]" : "+v"(acc[ai][bj][m][n]) : "v"(cat8(Bt[n][0], Bt[n][1])), "v"(cat8(At[m][0], At[m][1])), "v"(one_e8m0)); } \
        else { _Pragma("unroll") for (int m = 0; m < 4; ++m) _Pragma("unroll") for (int n = 0; n < 2; ++n) _Pragma("unroll") for (int k = 0; k < 2; ++k) \
            acc[ai][bj][m][n] = __builtin_amdgcn_mfma_f32_16x16x32_bf16(Bt[n][k], At[m][k], acc[ai][bj][m][n], 0, 0, 0); } \
        __builtin_amdgcn_s_setprio(0); } while (0)
#define PG8_WAIT_V(n) asm volatile("s_waitcnt vmcnt(" #n ")" ::: "memory")
#define PG8_WAIT_L(n) asm volatile("s_waitcnt lgkmcnt(" #n ")" ::: "memory")
#define PG8_BAR __builtin_amdgcn_s_barrier()
#define PG8_SCHED __builtin_amdgcn_sched_barrier(0)
#define PG8_LOAD_VA(dst, u) do { _Pragma("unroll") for (int _h = 0; _h < 2; ++_h) _Pragma("unroll") for (int _i = 0; _i < 2; ++_i) { const int _row = _h * HALF + Ra[_i]; \
        if constexpr (GATHER) { const int _tok = (_row < (u).nvalid) ? g.list[((u).lrow + _row) * g.lstride] : 0; dst[_h][_i] = (unsigned)(_tok * K + Ca[_i]) * 2u; } \
        else dst[_h][_i] = (unsigned)(_row * K + Ca[_i]) * 2u; } } while (0)
    Unit cur, nxt; int ui = 0;
    if (!S.next(0, cur)) return;
    unsigned vAc[2][2], vAn[2][2];
    PG8_LOAD_VA(vAc, cur);
    f32x4 acc[2][2][4][2];
#pragma unroll
    for (int a = 0; a < 2; ++a)
#pragma unroll
        for (int b = 0; b < 2; ++b)
#pragma unroll
            for (int m = 0; m < 4; ++m)
#pragma unroll
                for (int n = 0; n < 2; ++n) acc[a][b][m][n] = (f32x4){0.f, 0.f, 0.f, 0.f};
    bf16x8 At[4][2], B0[2][2], B1[2][2];
    const int one_e8m0 = 0x7f7f7f7f; (void)one_e8m0;
    unsigned cA = (unsigned)cur.arow * K * 2, cB = (unsigned)cur.e * (unsigned)g.bstride + (unsigned)cur.pn * tstep;
    unsigned cB2 = (unsigned)cur.e2 * (unsigned)g.bstride + (unsigned)cur.pn * tstep; const unsigned hk = (unsigned)(nt / 2) * kstep; (void)cB2; (void)hk;
    PG8_STAGE(PG8_SB(0, 0), gB, cB, voffB); PG8_STAGE(PG8_SB(0, 1), gB, cB + hstep, voffB); PG8_STAGE(PG8_SA(0, 0), gA, cA, vAc[0]); PG8_STAGE(PG8_SA(0, 1), gA, cA, vAc[1]);
    if (wr == 1) PG8_BAR;
    PG8_WAIT_V(2); PG8_BAR;
    PG8_STAGE(PG8_SB(1, 0), gB, cB + kstep, voffB); PG8_STAGE(PG8_SA(1, 0), gA, cA + kstep, vAc[0]); PG8_STAGE(PG8_SB(1, 1), gB, cB + hstep + kstep, voffB);
    PG8_WAIT_V(6); PG8_BAR;
    for (;;) {
        const bool has_next = S.next(ui + 1, nxt);
        const unsigned nA = has_next ? (unsigned)nxt.arow * K * 2 : cA;
        const unsigned nB = has_next ? (unsigned)nxt.e * (unsigned)g.bstride + (unsigned)nxt.pn * tstep : cB;
        const unsigned nB2 = has_next ? (unsigned)nxt.e2 * (unsigned)g.bstride + (unsigned)nxt.pn * tstep : cB2; (void)nB2;
        if (has_next) { PG8_LOAD_VA(vAn, nxt); }
        else {
#pragma unroll
            for (int h = 0; h < 2; ++h)
#pragma unroll
                for (int i = 0; i < 2; ++i) vAn[h][i] = vAc[h][i]; }
#pragma unroll 1
        for (int t = 0; t < nt; t += 2) {
            const bool last = (t == nt - 2);
            if constexpr (Epi::MID) { if (t == nt / 2) E.mid(acc, cur, wr, wc, fr, fq); }
            const unsigned a1 = cA + (unsigned)(t + 1) * kstep;
            const unsigned a2 = last ? nA : cA + (unsigned)(t + 2) * kstep;
            unsigned b2 = last ? nB : cB + (unsigned)(t + 2) * kstep;
            if constexpr (BSPLIT) { if (!last && t + 2 >= nt / 2) b2 = cB2 + (unsigned)(t + 2) * kstep - hk; }
            const unsigned a3 = a2 + kstep, b3 = b2 + kstep;
            unsigned v2[2][2];
#pragma unroll
            for (int h = 0; h < 2; ++h)
#pragma unroll
                for (int i = 0; i < 2; ++i) v2[h][i] = vAc[h][i];
            if (last) { asm volatile("" ::: "memory");
#pragma unroll
                for (int h = 0; h < 2; ++h)
#pragma unroll
                    for (int i = 0; i < 2; ++i) v2[h][i] = vAn[h][i]; }
            PG8_LDB(B0, 0, 0); PG8_LDB(B1, 0, 1); PG8_SCHED; PG8_LDA(At, 0, 0); PG8_STAGE(PG8_SA(1, 1), gA, a1, vAc[1]);
            PG8_WAIT_V(8); PG8_WAIT_L(0); PG8_BAR; PG8_MMA(0, 0, At, B0); PG8_MMA(0, 1, At, B1); PG8_BAR; PG8_SCHED;
            PG8_LDA(At, 0, 1); PG8_STAGE(PG8_SB(0, 0), gB, b2, voffB); PG8_STAGE(PG8_SB(0, 1), gB, b2 + hstep, voffB); PG8_STAGE(PG8_SA(0, 0), gA, a2, v2[0]);
            PG8_WAIT_V(8); PG8_WAIT_L(0); PG8_BAR; PG8_MMA(1, 0, At, B0); PG8_MMA(1, 1, At, B1); PG8_BAR; PG8_SCHED;
            PG8_LDB(B0, 1, 0); PG8_LDB(B1, 1, 1); PG8_SCHED; PG8_LDA(At, 1, 0); PG8_STAGE(PG8_SA(0, 1), gA, a2, v2[1]);
            PG8_WAIT_V(8); PG8_WAIT_L(0); PG8_BAR; PG8_MMA(0, 0, At, B0); PG8_MMA(0, 1, At, B1); PG8_BAR; PG8_SCHED;
            PG8_LDA(At, 1, 1); PG8_STAGE(PG8_SB(1, 0), gB, b3, voffB); PG8_STAGE(PG8_SB(1, 1), gB, b3 + hstep, voffB); PG8_STAGE(PG8_SA(1, 0), gA, a3, v2[0]);
            PG8_WAIT_V(8); PG8_WAIT_L(0); PG8_BAR; PG8_MMA(1, 0, At, B0); PG8_MMA(1, 1, At, B1); PG8_BAR; PG8_SCHED;
        }
        if constexpr (ALIGN_EPI) { if (wr == 0) PG8_BAR; }
        if constexpr (FP8) asm volatile("s_nop 15\n\ts_nop 15\n\ts_nop 15\n\ts_nop 15" ::: "memory");
        E(acc, cur, wr, wc, fr, fq);
        if (!has_next) break;
#pragma unroll
        for (int a = 0; a < 2; ++a)
#pragma unroll
            for (int b = 0; b < 2; ++b)
#pragma unroll
                for (int m = 0; m < 4; ++m)
#pragma unroll
                    for (int n = 0; n < 2; ++n) acc[a][b][m][n] = (f32x4){0.f, 0.f, 0.f, 0.f};
        cur = nxt; cA = nA; cB = nB; cB2 = nB2; ++ui;
#pragma unroll
        for (int h = 0; h < 2; ++h)
#pragma unroll
            for (int i = 0; i < 2; ++i) vAc[h][i] = vAn[h][i];
        if constexpr (ALIGN_EPI) { if (wr == 1) PG8_BAR; }
    }
    PG8_WAIT_V(0);
    if constexpr (!ALIGN_EPI) { if (wr == 0) PG8_BAR; }
    PG8_BAR;
#undef PG8_SA
#undef PG8_SB
#undef PG8_STAGE
#undef PG8_LDA
#undef PG8_LDB
#undef PG8_MMA
#undef PG8_WAIT_V
#undef PG8_WAIT_L
#undef PG8_BAR
#undef PG8_SCHED
#undef PG8_LOAD_VA
}
}

namespace attn_body {
using bf16=__hip_bfloat16;
using bf16x8=__attribute__((ext_vector_type(8)))short;
using s16x4=__attribute__((ext_vector_type(4)))short;
using f32x16=__attribute__((ext_vector_type(16)))float;
using u32x4=__attribute__((ext_vector_type(4)))unsigned;
constexpr int D=64, QP=512, KP=512, VP=512, OP=1024;
constexpr int NW=8,QBLK=32,QB=QBLK*NW,KVBLK=64;
constexpr int ATTN_UNIT_ROWS=QB;
__device__ __forceinline__ int crow(int r,int hi){return (r&3)+8*(r>>2)+4*hi;}
#define SBAR() __builtin_amdgcn_sched_barrier(0)
__device__ __forceinline__ void cmask(f32x16&p0,f32x16&p1,int jb,int qrel,int hi){
  const float NEG=-INFINITY; int kb=64*jb+4*hi;
  #pragma unroll
  for(int r=0;r<16;++r){int kv=kb+(r&3)+8*(r>>2); if(kv>qrel)p0[r]=NEG; if(kv+32>qrel)p1[r]=NEG;}
}

constexpr int NSLOT=3, SLOTB=8192, VSLOTB=16384;
constexpr int LDS_K=0, LDS_V=NSLOT*SLOTB, LDS_WS=LDS_V+NSLOT*VSLOTB, LDS_OST=LDS_WS+NW*64*4, LDS_BYTES=LDS_OST+NW*4096;
constexpr float C2=0.125f*1.4426950408889634f;
__device__ __forceinline__ void glds16(const void*gsrc,unsigned lds_dst){unsigned keep;
  asm volatile("s_mov_b32 %0, m0\n\ts_mov_b32 m0, %2\n\ts_nop 0\n\tglobal_load_lds_dwordx4 %1, off\n\ts_mov_b32 m0, %0":"=&s"(keep):"v"(gsrc),"s"(lds_dst):"memory");}
__device__ __forceinline__ float max3f(float a,float b,float c){float r;asm("v_max3_f32 %0, %1, %2, %3":"=v"(r):"v"(a),"v"(b),"v"(c));return r;}
__device__ __forceinline__ float max2f(float a,float b){float r;asm("v_max_f32_e32 %0, %1, %2":"=v"(r):"v"(a),"v"(b));return r;}
__device__ __forceinline__ float fadd_s(float a,float b){float r;asm("v_add_f32_e32 %0, %1, %2":"=v"(r):"v"(a),"v"(b));return r;}
__device__ __forceinline__ float fsub_s(float a,float b){float r;asm("v_sub_f32_e32 %0, %1, %2":"=v"(r):"v"(a),"v"(b));return r;}
typedef float f32x2_t __attribute__((ext_vector_type(2))); typedef __bf16 bf16x2_t __attribute__((ext_vector_type(2)));
__device__ __forceinline__ unsigned cvtpk_s(float lo,float hi){f32x2_t v={lo,hi};bf16x2_t b=__builtin_convertvector(v,bf16x2_t);return __builtin_bit_cast(unsigned,b);}
#define WAIT_BAR(N) asm volatile("s_waitcnt vmcnt(" #N ") lgkmcnt(0)\n\ts_barrier":::"memory")

__device__ __forceinline__ void qkt(f32x16&p0,f32x16&p1,const char*Kslot,const bf16x8*qr,const f32x16&negm,int r32,int hi){
  const char*kb=Kslot+hi*1024+r32*16;
  #pragma unroll
  for(int d0=0;d0<4;++d0){
    const bf16x8 b0=*reinterpret_cast<const bf16x8*>(kb+d0*2048);
    const bf16x8 b1=*reinterpret_cast<const bf16x8*>(kb+d0*2048+512);
    if(d0==0){p0=__builtin_amdgcn_mfma_f32_32x32x16_bf16(b0,qr[0],negm,0,0,0);p1=__builtin_amdgcn_mfma_f32_32x32x16_bf16(b1,qr[0],negm,0,0,0);}
    else{p0=__builtin_amdgcn_mfma_f32_32x32x16_bf16(b0,qr[d0],p0,0,0,0);p1=__builtin_amdgcn_mfma_f32_32x32x16_bf16(b1,qr[d0],p1,0,0,0);}}
}
typedef __attribute__((address_space(3))) const char* lds_cptr;
typedef short v4i16_t __attribute__((ext_vector_type(4)));
__device__ __forceinline__ void kload8(bf16x8*kf,lds_cptr kp){
  kf[0]=*(const __attribute__((address_space(3))) bf16x8*)(kp);      kf[1]=*(const __attribute__((address_space(3))) bf16x8*)(kp+512);
  kf[2]=*(const __attribute__((address_space(3))) bf16x8*)(kp+2048); kf[3]=*(const __attribute__((address_space(3))) bf16x8*)(kp+2560);
  kf[4]=*(const __attribute__((address_space(3))) bf16x8*)(kp+4096); kf[5]=*(const __attribute__((address_space(3))) bf16x8*)(kp+4608);
  kf[6]=*(const __attribute__((address_space(3))) bf16x8*)(kp+6144); kf[7]=*(const __attribute__((address_space(3))) bf16x8*)(kp+6656);
}
__device__ __forceinline__ void kload2(bf16x8*kf,lds_cptr kp,int j){ kf[2*j]=*(const __attribute__((address_space(3))) bf16x8*)(kp+j*2048); kf[2*j+1]=*(const __attribute__((address_space(3))) bf16x8*)(kp+j*2048+512); }
__device__ __forceinline__ s16x4 vtr(lds_cptr p){ return __builtin_bit_cast(s16x4,__builtin_amdgcn_ds_read_tr16_b64_v4i16((__attribute__((address_space(3))) v4i16_t*)p)); }
__device__ __forceinline__ float rowmax(const f32x16&p0,const f32x16&p1){
  float a=max3f(p0[0],p0[1],p1[0]),b=max3f(p0[2],p0[3],p1[1]);a=max3f(a,p1[2],p1[3]);
  #pragma unroll
  for(int r=4;r<16;r+=4){a=max3f(a,p0[r],p0[r+1]);b=max3f(b,p0[r+2],p0[r+3]);a=max3f(a,p1[r],p1[r+1]);b=max3f(b,p1[r+2],p1[r+3]);}
  const float m=max2f(a,b);
  auto rr=__builtin_amdgcn_permlane32_swap(__float_as_uint(m),__float_as_uint(m),false,false);
  return max2f(__uint_as_float(rr[0]),__uint_as_float(rr[1]));
}
__device__ __forceinline__ void pv(f32x16*o,int vb,bf16x8 pa0,bf16x8 pa1,bf16x8 pa2,bf16x8 pa3){
  #pragma unroll
  for(int d0=0;d0<4;++d0){s16x4 lo[4],hi[4];
    #pragma unroll
    for(int ks=0;ks<4;++ks){
      asm volatile("ds_read_b64_tr_b16 %0,%1 offset:%c2":"=&v"(lo[ks]):"v"(vb),"i"(d0*4096+ks*1024):"memory");
      asm volatile("ds_read_b64_tr_b16 %0,%1 offset:%c2":"=&v"(hi[ks]):"v"(vb),"i"(d0*4096+ks*1024+512):"memory");}
    asm volatile("s_waitcnt lgkmcnt(0)":::"memory");SBAR();
    #define PK(k) (bf16x8){lo[k][0],lo[k][1],lo[k][2],lo[k][3],hi[k][0],hi[k][1],hi[k][2],hi[k][3]}
    o[d0]=__builtin_amdgcn_mfma_f32_32x32x16_bf16(pa0,PK(0),o[d0],0,0,0);
    o[d0]=__builtin_amdgcn_mfma_f32_32x32x16_bf16(pa1,PK(1),o[d0],0,0,0);
    o[d0]=__builtin_amdgcn_mfma_f32_32x32x16_bf16(pa2,PK(2),o[d0],0,0,0);
    o[d0]=__builtin_amdgcn_mfma_f32_32x32x16_bf16(pa3,PK(3),o[d0],0,0,0);
    #undef PK
  }
}

#ifndef ATTN_STORE16
#define ATTN_STORE16(p,v) (*(u32x4*)(p)=(v))
#endif
template<int THRL,bool STAT> __device__ __forceinline__ void attn_unit(float mstat,int q0,const bf16*Q,const bf16*__restrict__ K,const bf16*__restrict__ V,bf16*O,char*shm){
  int tid_=threadIdx.x; asm volatile("":"+v"(tid_));
  const int tid=tid_,lane=tid&63,r32=lane&31,hi=lane>>5; const int wid=__builtin_amdgcn_readfirstlane(tid>>6);
  const bf16*Qw=Q+(long)(q0+wid*QBLK)*QP;
  const bf16*Kh=K,*Vh=V;
  const unsigned lds0=(unsigned)(uintptr_t)shm;
  float*wsf=(float*)(shm+LDS_WS)+wid*64;
  const bf16*ksrc=Kh+(long)lane*KP+wid*8;
  const bf16*vsrc=Vh+(long)(16*(wid&3)+(lane>>2))*VP+(wid>>2)*32+(lane&3)*8;
  const unsigned kdst=lds0+LDS_K+wid*1024, vdst=lds0+LDS_V+wid*1024;
  #define DMA_K(t,slot) glds16(ksrc+(long)(t)*KVBLK*KP,(unsigned)__builtin_amdgcn_readfirstlane(kdst+(slot)))
  #define DMA_V(t,slot) do{ glds16(vsrc+(long)(t)*KVBLK*VP,(unsigned)__builtin_amdgcn_readfirstlane(vdst+2*(slot))); glds16(vsrc+(long)(t)*KVBLK*VP+64,(unsigned)__builtin_amdgcn_readfirstlane(vdst+2*(slot)+8192)); }while(0)
  const int vb0=(int)(lds0+LDS_V)+((lane>>4)&1)*32+(lane&3)*8+(4*hi+((lane&15)>>2))*64;
  const char*Kbase=shm+LDS_K; bf16x8 kf[8];
  const lds_cptr shm3=(lds_cptr)shm; const lds_cptr kp0=shm3+LDS_K+hi*1024+r32*16; const lds_cptr vp0=shm3+LDS_V+((lane>>4)&1)*32+(lane&3)*8+(4*hi+((lane&15)>>2))*64;
  const int NT=(q0+QB)/KVBLK;
  DMA_K(0,0);DMA_V(0,0);DMA_K(1,SLOTB);
  bf16x8 qr[4];
  #pragma unroll
  for(int d0=0;d0<4;++d0)qr[d0]=*reinterpret_cast<const bf16x8*>(&Qw[(long)r32*QP+d0*16+hi*8]);
  float mhat=0.f,l_reg=0.f;f32x16 o[4];{float zz=0.f;asm volatile("":"+v"(zz));
  #pragma unroll
  for(int r=0;r<16;++r){o[0][r]=zz;o[1][r]=zz;o[2][r]=zz;o[3][r]=zz;}}
  f32x16 negm;{float zn=0.f;asm volatile("":"+v"(zn));
  #pragma unroll
  for(int r=0;r<16;++r)negm[r]=zn;}
  asm volatile("":"+v"(negm));
  const int qrel=wid*QBLK+r32;
  #define CMASK(P0,P1,t) do{int jb_=(t)-(NT-4); if(jb_>=0)cmask(P0,P1,jb_,qrel,hi);}while(0)
  bool resc=false;
  #define START(P0,P1) do{ float rm; if constexpr (STAT) rm=mstat; else rm=rowmax(P0,P1); resc=false; \
    { const float dl=rm; mhat=fadd_s(mhat,dl); \
      _Pragma("unroll") for(int r=0;r<16;++r){P0[r]=fsub_s(P0[r],dl);P1[r]=fsub_s(P1[r],dl);} \
      _Pragma("unroll") for(int r=0;r<16;++r)negm[r]=-mhat; asm volatile("":"+v"(negm)); } \
    _Pragma("unroll") for(int r=0;r<16;++r)P0[r]=__builtin_amdgcn_exp2f(P0[r]); }while(0)
  #define RESC() do{ if(resc){ asm volatile("s_waitcnt lgkmcnt(0)":::"memory"); \
      _Pragma("unroll") for(int d_=0;d_<4;++d_) _Pragma("unroll") for(int r=0;r<16;++r)o[d_][r]*=wsf[crow(r,hi)]; } }while(0)
  f32x16 pA0,pA1,pB0,pB1;
  int sl_prev=0,sl_cur=0,sl_next=SLOTB;
  #define ROT() do{sl_prev=sl_cur;sl_cur=sl_next;sl_next=(sl_next==(NSLOT-1)*SLOTB)?0:sl_next+SLOTB;}while(0)
  DMA_K(2,2*SLOTB);
  WAIT_BAR(4);
  qkt(pA0,pA1,Kbase,qr,negm,r32,hi);asm volatile("s_nop 15\n\ts_nop 7":"+v"(pA0),"+v"(pA1));CMASK(pA0,pA1,0);
  START(pA0,pA1);
  _Pragma("unroll") for(int r=0;r<16;++r)pA1[r]=__builtin_amdgcn_exp2f(pA1[r]);
  WAIT_BAR(0);
  DMA_K(3,0);DMA_V(1,SLOTB);
  ROT();
  kload8(kf,kp0+sl_cur);
  WAIT_BAR(3);
  s16x4 vlo[8],vhi[8]; u32x4 pw0,pw1,pw2,pw3;
  #define PKW(P,B) cvtpk_s(P[B],P[B+1])
  #define PAF(k) __builtin_bit_cast(bf16x8,pw##k)
  #define VFR(i) (bf16x8){vlo[i][0],vlo[i][1],vlo[i][2],vlo[i][3],vhi[i][0],vhi[i][1],vhi[i][2],vhi[i][3]}
  #define PIN(x) asm volatile("":"+v"(x))
  #define MX3(a,b,c) __builtin_fmaxf(__builtin_fmaxf((a),(b)),(c))
  #define GAPA(MF,A0,A1,A2,A3,W0,W1,PW) do{ MF; sacc+=A0; sacc+=A1; sacc+=A2; sacc+=A3; PIN(sacc); W0; W1; PIN(PW); SBAR(); }while(0)
  #define EX(v) __builtin_amdgcn_exp2f(v)
  #define GAPB2(MF,X,B) do{ MF; X[B]=EX(X[B]); X[B+1]=EX(X[B+1]); PIN(X); SBAR(); }while(0)
  #define VRD2(i) do{ vlo[i]=vtr(vp_+((((i)>>2)+2)*4096+((i)&3)*1024)); vhi[i]=vtr(vp_+((((i)>>2)+2)*4096+((i)&3)*1024+512)); }while(0)
  #define VRD(i) do{ vlo[i]=vtr(vp_+(((i)>>2)*4096+((i)&3)*1024)); vhi[i]=vtr(vp_+(((i)>>2)*4096+((i)&3)*1024+512)); }while(0)
  #define KRD(G,j) do{ if(G){ kload2(kf,kp0+sl_next,j); SBAR(); } }while(0)
  #define STEP(C0,C1,P0,P1,t,GK,GV,GL) do{ SBAR(); \
    const lds_cptr vp_=vp0+2*sl_prev; \
    VRD(0); SBAR(); float sacc=(P0[0]+P0[1]); \
    GAPA(C0=__builtin_amdgcn_mfma_f32_32x32x16_bf16(kf[0],qr[0],negm,0,0,0), P0[2],P0[3],P0[4],P0[5],     pw0[0]=PKW(P0,0), pw0[1]=PKW(P0,2), pw0); \
    VRD(4); SBAR(); GAPA(C1=__builtin_amdgcn_mfma_f32_32x32x16_bf16(kf[1],qr[0],negm,0,0,0), P0[6],P0[7],P0[8],P0[9],     pw0[2]=PKW(P0,4), pw0[3]=PKW(P0,6), pw0); \
    VRD(1); SBAR(); GAPA(C0=__builtin_amdgcn_mfma_f32_32x32x16_bf16(kf[2],qr[1],C0,0,0,0),   P0[10],P0[11],P0[12],P0[13], pw1[0]=PKW(P0,8), pw1[1]=PKW(P0,10), pw1); \
    VRD(5); SBAR(); GAPA(C1=__builtin_amdgcn_mfma_f32_32x32x16_bf16(kf[3],qr[1],C1,0,0,0),   P0[14],P0[15],P1[0],P1[1],   pw1[2]=PKW(P0,12),pw1[3]=PKW(P0,14), pw1); \
    VRD(2); SBAR(); GAPA(C0=__builtin_amdgcn_mfma_f32_32x32x16_bf16(kf[4],qr[2],C0,0,0,0),   P1[2],P1[3],P1[4],P1[5],     pw2[0]=PKW(P1,0), pw2[1]=PKW(P1,2), pw2); \
    VRD(6); SBAR(); GAPA(C1=__builtin_amdgcn_mfma_f32_32x32x16_bf16(kf[5],qr[2],C1,0,0,0),   P1[6],P1[7],P1[8],P1[9],     pw2[2]=PKW(P1,4), pw2[3]=PKW(P1,6), pw2); \
    VRD(3); SBAR(); GAPA(C0=__builtin_amdgcn_mfma_f32_32x32x16_bf16(kf[6],qr[3],C0,0,0,0),   P1[10],P1[11],P1[12],P1[13], pw3[0]=PKW(P1,8), pw3[1]=PKW(P1,10), pw3); \
    VRD(7); SBAR(); GAPA(C1=__builtin_amdgcn_mfma_f32_32x32x16_bf16(kf[7],qr[3],C1,0,0,0),   P1[14],P1[15],0.f,0.f,       pw3[2]=PKW(P1,12),pw3[3]=PKW(P1,14), pw3); \
    l_reg+=sacc; \
    if(GK){DMA_K((t)+3,sl_cur);} if(GV){DMA_V((t)+1,sl_next);} \
    CMASK(C0,C1,t); \
    if constexpr (!STAT) { float a=MX3(C0[0],C0[1],C1[0]),b=MX3(C0[2],C0[3],C1[1]); a=MX3(a,C1[2],C1[3]); \
      _Pragma("unroll") for(int r=4;r<16;r+=4){a=MX3(a,C0[r],C0[r+1]);b=MX3(b,C0[r+2],C0[r+3]);a=MX3(a,C1[r],C1[r+1]);b=MX3(b,C1[r+2],C1[r+3]);} \
      float rm=__builtin_fmaxf(a,b); { auto rr=__builtin_amdgcn_permlane32_swap(__float_as_uint(rm),__float_as_uint(rm),false,false); rm=__builtin_fmaxf(__uint_as_float(rr[0]),__uint_as_float(rr[1])); } \
      resc=false; \
      if(__builtin_expect(__any(rm>(float)THRL),0)){ const float dl=__builtin_fmaxf(rm,0.f); mhat+=dl; \
        _Pragma("unroll") for(int r=0;r<16;++r){C0[r]-=dl;C1[r]-=dl;} \
        _Pragma("unroll") for(int r=0;r<16;++r)negm[r]=-mhat; asm volatile("":"+v"(negm)); \
        const float f=__builtin_amdgcn_exp2f(-dl); l_reg*=f; if(hi==0)wsf[r32]=f; resc=true; } } \
    SBAR(); \
    GAPB2(o[0]=__builtin_amdgcn_mfma_f32_32x32x16_bf16(PAF(0),VFR(0),o[0],0,0,0), C0,0);  VRD2(0); SBAR(); \
    GAPB2(o[1]=__builtin_amdgcn_mfma_f32_32x32x16_bf16(PAF(0),VFR(4),o[1],0,0,0), C0,2);  VRD2(4); SBAR(); \
    GAPB2(o[0]=__builtin_amdgcn_mfma_f32_32x32x16_bf16(PAF(1),VFR(1),o[0],0,0,0), C0,4);  VRD2(1); SBAR(); \
    GAPB2(o[1]=__builtin_amdgcn_mfma_f32_32x32x16_bf16(PAF(1),VFR(5),o[1],0,0,0), C0,6);  VRD2(5); SBAR(); \
    GAPB2(o[0]=__builtin_amdgcn_mfma_f32_32x32x16_bf16(PAF(2),VFR(2),o[0],0,0,0), C0,8);  VRD2(2); SBAR(); \
    GAPB2(o[1]=__builtin_amdgcn_mfma_f32_32x32x16_bf16(PAF(2),VFR(6),o[1],0,0,0), C0,10); VRD2(6); SBAR(); \
    GAPB2(o[0]=__builtin_amdgcn_mfma_f32_32x32x16_bf16(PAF(3),VFR(3),o[0],0,0,0), C0,12); VRD2(3); SBAR(); \
    GAPB2(o[1]=__builtin_amdgcn_mfma_f32_32x32x16_bf16(PAF(3),VFR(7),o[1],0,0,0), C0,14); VRD2(7); SBAR(); \
    GAPB2(o[2]=__builtin_amdgcn_mfma_f32_32x32x16_bf16(PAF(0),VFR(0),o[2],0,0,0), C1,0); \
    GAPB2(o[3]=__builtin_amdgcn_mfma_f32_32x32x16_bf16(PAF(0),VFR(4),o[3],0,0,0), C1,2); \
    KRD(GL,0); GAPB2(o[2]=__builtin_amdgcn_mfma_f32_32x32x16_bf16(PAF(1),VFR(1),o[2],0,0,0), C1,4); \
    KRD(GL,1); GAPB2(o[3]=__builtin_amdgcn_mfma_f32_32x32x16_bf16(PAF(1),VFR(5),o[3],0,0,0), C1,6); \
    KRD(GL,2); GAPB2(o[2]=__builtin_amdgcn_mfma_f32_32x32x16_bf16(PAF(2),VFR(2),o[2],0,0,0), C1,8); \
    KRD(GL,3); GAPB2(o[3]=__builtin_amdgcn_mfma_f32_32x32x16_bf16(PAF(2),VFR(6),o[3],0,0,0), C1,10); \
    GAPB2(o[2]=__builtin_amdgcn_mfma_f32_32x32x16_bf16(PAF(3),VFR(3),o[2],0,0,0), C1,12); \
    GAPB2(o[3]=__builtin_amdgcn_mfma_f32_32x32x16_bf16(PAF(3),VFR(7),o[3],0,0,0), C1,14); \
    }while(0)
  int t=1;
  #undef CMASK
  #define CMASK(P0,P1,t) do{}while(0)
  for(;t+5<NT;t+=2){
    STEP(pB0,pB1,pA0,pA1,t,true,true,true);     WAIT_BAR(3); RESC(); ROT();
    STEP(pA0,pA1,pB0,pB1,t+1,true,true,true);   WAIT_BAR(3); RESC(); ROT();
  }
  #undef CMASK
  #define CMASK(P0,P1,t) do{int jb_=(t)-(NT-4); if(jb_>=0)cmask(P0,P1,jb_,qrel,hi);}while(0)
  #define ENDW(tt) do{ if((tt)+3<NT){WAIT_BAR(3);} else if((tt)+2<NT){WAIT_BAR(2);} else {WAIT_BAR(0);} }while(0)
  for(;t+1<NT;t+=2){
    STEP(pB0,pB1,pA0,pA1,t,(t+3<NT),(t+1<NT),(t+1<NT));       ENDW(t);   RESC(); ROT();
    STEP(pA0,pA1,pB0,pB1,t+1,(t+4<NT),(t+2<NT),(t+2<NT));     ENDW(t+1); RESC(); ROT();
  }
  STEP(pB0,pB1,pA0,pA1,NT-1,false,false,false); RESC();
  { float sacc=pB0[0]+pB0[1]; _Pragma("unroll") for(int r=2;r<16;++r)sacc+=pB0[r]; _Pragma("unroll") for(int r=0;r<16;++r)sacc+=pB1[r]; l_reg+=sacc;
    pw0=(u32x4){PKW(pB0,0),PKW(pB0,2),PKW(pB0,4),PKW(pB0,6)};pw1=(u32x4){PKW(pB0,8),PKW(pB0,10),PKW(pB0,12),PKW(pB0,14)};pw2=(u32x4){PKW(pB1,0),PKW(pB1,2),PKW(pB1,4),PKW(pB1,6)};pw3=(u32x4){PKW(pB1,8),PKW(pB1,10),PKW(pB1,12),PKW(pB1,14)};
    SBAR(); pv(o,vb0+2*sl_cur,PAF(0),PAF(1),PAF(2),PAF(3)); }
  #undef PKW
  #undef PAF
  #undef VFR
  #undef PIN
  #undef MX3
  #undef GAPA
  #undef GAPB2
  #undef VRD2
  #undef EX
  #undef VRD
  #undef KRD
  #undef STEP
  #undef ENDW
  {auto rr=__builtin_amdgcn_permlane32_swap(__float_as_uint(l_reg),__float_as_uint(l_reg),false,false);l_reg=__uint_as_float(rr[0])+__uint_as_float(rr[1]);}
  if(hi==0)wsf[32+r32]=l_reg;asm volatile("s_waitcnt lgkmcnt(0)":::"memory");
  float rli[16];
  #pragma unroll
  for(int r=0;r<16;++r)rli[r]=__builtin_amdgcn_rcpf(wsf[32+crow(r,hi)]);
  bf16*Ow=O+(long)(q0+wid*QBLK)*OP;
  { bf16*stg=(bf16*)(shm+LDS_OST)+wid*2048;
    #pragma unroll
    for(int hf=0;hf<2;++hf){
      #pragma unroll
      for(int r=0;r<16;++r){const int orow=crow(r,hi);
        #pragma unroll
        for(int d0=0;d0<2;++d0)stg[orow*64+d0*32+r32]=__float2bfloat16(o[2*hf+d0][r]*rli[r]);}
      asm volatile("s_waitcnt lgkmcnt(0)":::"memory");
      #pragma unroll
      for(int i=0;i<4;++i){const int row=i*8+(lane>>3),ch=lane&7; const u32x4 v=*(const u32x4*)(stg+row*64+ch*8); ATTN_STORE16(Ow+(long)row*OP+hf*64+ch*8,v);}
      asm volatile("s_waitcnt lgkmcnt(0)":::"memory"); } }
  asm volatile("s_waitcnt lgkmcnt(0)\n\ts_barrier":::"memory");
  #undef DMA_K
  #undef DMA_V
  #undef CMASK
  #undef START
  #undef RESC
  #undef ROT
}
constexpr int ATTN_LDS_BYTES=LDS_BYTES;
#undef SBAR
#undef WAIT_BAR
}

constexpr int NWAVES = 8, NTHREADS = NWAVES * 64;
#ifndef MK_PER_PHASE
#define MK_PER_PHASE 0
#endif
#ifndef RUN_PHASES
#define RUN_PHASES 8
#endif
constexpr int N_PHASES = RUN_PHASES;

constexpr size_t MiB = 1u << 20;
constexpr size_t WS_CTL = 0, CTL_ZERO_BYTES = 65536;
constexpr size_t WS_RS = 1 * MiB;
constexpr size_t WS_TINFO = 2 * MiB;
constexpr size_t WS_WR = 3 * MiB;
constexpr size_t WS_LTOK = 4 * MiB, WS_LW = 8 * MiB;
constexpr size_t WS_WIN = 16 * MiB, WS_WCA = 25 * MiB, WS_WOUT = 27 * MiB;
constexpr size_t WS_A = 32 * MiB;
constexpr size_t WS_QB = 112 * MiB, WS_KB = 144 * MiB, WS_VB = 176 * MiB, WS_YG = 208 * MiB;
constexpr size_t WS_MG = 112 * MiB, WS_XM = 176 * MiB;
constexpr size_t WS_GT = 240 * MiB;
constexpr size_t WS_WGU = 240 * MiB, WS_WD = 304 * MiB;
constexpr size_t WS_CA = 368 * MiB;
constexpr size_t WS_YB = 112 * MiB;
constexpr size_t WS_LIST = 432 * MiB;
constexpr size_t WS_CTOK = 448 * MiB;
constexpr size_t WS_END = 464 * MiB;
static_assert(WS_A + (size_t)CROWS * 1024 <= WS_QB && WS_WD + (size_t)NEXP * 1024 * 512 <= WS_CA, "d_ws map");
static_assert(WS_WIN + (size_t)IN_COLS * 1024 * 2 <= WS_WCA, "d_ws map");

constexpr int RING_BYTES = 131072;
constexpr int META_OFF = RING_BYTES;
constexpr int HIST_OFF = RING_BYTES + 1024;
constexpr int BARST_OFF = RING_BYTES + 3072;
constexpr int META2_OFF = RING_BYTES + 4096;
constexpr int LDS_BYTES = 147456;

#define GAS __attribute__((address_space(1)))
#define LAS __attribute__((address_space(3)))
typedef unsigned short bf16;
typedef unsigned v4u __attribute__((ext_vector_type(4)));
typedef unsigned v2u __attribute__((ext_vector_type(2)));
typedef float f32x4 __attribute__((ext_vector_type(4)));
typedef float f32x16 __attribute__((ext_vector_type(16)));
typedef short bf16x8 __attribute__((ext_vector_type(8)));
using pg8::cvt_pk_bf16; using pg8::bf_lo; using pg8::bf_hi; using pg8::sigmoidf_fast; using pg8::pack8; using pg8::unpack8;

__device__ __forceinline__ float wave_sum(float v) {
#pragma unroll
    for (int o = 1; o < 64; o <<= 1) v += __shfl_xor(v, o);
    return v;
}
__device__ __forceinline__ float bf16_round(float x) { return bf_lo(cvt_pk_bf16(x, 0.f) & 0xffffu); }

#define XB_TMO      128
#define XB_XCNT(j)  (256  + 64 * (j))
#define XB_XSUB(j)  (1280 + 64 * (j))
#define XB_XGEN(j)  (2304 + 64 * (j))
#define XB_TOP      3328
#define XB_TOPGEN   3392
#define XCD_BAR_WORDS 3456
#define XB_SPIN_CAP (1u << 18)

__device__ __forceinline__ unsigned xb_ld(unsigned* p)              { return __hip_atomic_load(p, __ATOMIC_RELAXED, __HIP_MEMORY_SCOPE_AGENT); }
__device__ __forceinline__ unsigned xb_add(unsigned* p, unsigned v) { return __hip_atomic_fetch_add(p, v, __ATOMIC_RELAXED, __HIP_MEMORY_SCOPE_AGENT); }
__device__ __forceinline__ unsigned xb_xcc_id() { return (unsigned)__builtin_amdgcn_s_getreg((3 << 11) | 20) & 0xFu; }
#define XB_SPIN(cond, bar) do { unsigned _sp = 0; while (cond) { __builtin_amdgcn_s_sleep(1); \
    if ((++_sp & 255u) == 0u) { if (xb_ld(&(bar)[XB_TMO])) break; if (_sp > XB_SPIN_CAP) { atomicAdd(&(bar)[XB_TMO], 1u); break; } } } } while (0)

struct XcdBarrier {
    unsigned* bar; unsigned x;
    volatile LAS unsigned* st;
};

__device__ __forceinline__ XcdBarrier xcd_barrier_post(unsigned* bar, volatile LAS unsigned* st) {
    XcdBarrier b; b.bar = bar; b.x = xb_xcc_id(); b.st = st;
    if (threadIdx.x == 0) (void)xb_add(&bar[XB_XCNT(b.x)], 1u);
    return b;
}
__device__ __forceinline__ void xcd_barrier_complete(unsigned* bar, unsigned x, unsigned& nloc, unsigned& nx) {
    const unsigned G = gridDim.x * gridDim.y * gridDim.z;
    unsigned sum, cnt, mine, sp = 0u;
    for (;;) {
        sum = 0u; cnt = 0u; mine = 0u;
#pragma unroll
        for (unsigned j = 0; j < 16; ++j) { const unsigned c = xb_ld(&bar[XB_XCNT(j)]); sum += c; cnt += (c > 0u) ? 1u : 0u; mine = (j == x) ? c : mine; }
        if (sum == G) break;
        __builtin_amdgcn_s_sleep(1);
        if ((++sp & 255u) == 0u) { if (xb_ld(&bar[XB_TMO])) break; if (sp > XB_SPIN_CAP) { atomicAdd(&bar[XB_TMO], 1u); break; } }
    }
    nloc = mine > 0u ? mine : 1u; nx = cnt > 0u ? cnt : 1u;
}

__device__ __forceinline__ void xcd_barrier(const XcdBarrier& b) {
    asm volatile("s_waitcnt vmcnt(0)" ::: "memory");
    __syncthreads();
    if (threadIdx.x == 0) {
        unsigned* bar = b.bar;
        __builtin_amdgcn_s_waitcnt(0);
        unsigned nloc = b.st[0], nx = b.st[1];
        if (nloc == 0u) { xcd_barrier_complete(bar, b.x, nloc, nx); b.st[0] = nloc; b.st[1] = nx; }
        const unsigned old = xb_add(&bar[XB_XSUB(b.x)], 1u);
        const unsigned gen = old / nloc;
        if (old + 1u == (gen + 1u) * nloc) {
            __builtin_amdgcn_fence(__ATOMIC_RELEASE, "agent");
            asm volatile("s_waitcnt vmcnt(0)" ::: "memory");
            const unsigned og = xb_add(&bar[XB_TOP], 1u);
            const unsigned tg = og / nx;
            if (og + 1u == (tg + 1u) * nx) xb_add(&bar[XB_TOPGEN], 1u);
            else XB_SPIN(xb_ld(&bar[XB_TOPGEN]) == tg, bar);
            __builtin_amdgcn_fence(__ATOMIC_ACQUIRE, "agent");
            xb_add(&bar[XB_XGEN(b.x)], 1u);
            asm volatile("s_waitcnt vmcnt(0)" ::: "memory");
        } else {
            XB_SPIN(xb_ld(&bar[XB_XGEN(b.x)]) == gen, bar);
            __builtin_amdgcn_fence(__ATOMIC_ACQUIRE, "agent");
            asm volatile("s_waitcnt vmcnt(0)" ::: "memory");
        }
    }
    __syncthreads();
}


typedef f32x4 AccT[2][2][4][2];
struct EpiInProj {
    static constexpr bool MID = false;
    bf16 *YG, *QB, *KB, *VB, *GT; const LAS float* gl;
    __device__ __forceinline__ void mid(AccT&, const pg8::Unit&, int, int, int, int) const {}
    __device__ __forceinline__ void operator()(AccT& acc, const pg8::Unit& u, int wr, int wc, int fr, int fq) const {
        asm volatile("" : "+v"(fr), "+v"(fq));
        const int pn = u.pn; const size_t row0 = (size_t)u.orow + wr * 64 + fr;
        if (pn < 4) {
#pragma unroll
            for (int ai = 0; ai < 2; ++ai)
#pragma unroll
                for (int m = 0; m < 4; ++m) { const size_t row = row0 + ai * 128 + m * 16; f32x4 y[2];
#pragma unroll
                    for (int n = 0; n < 2; ++n) { const f32x4 a = acc[ai][0][m][n], g = acc[ai][1][m][n];
                        y[n] = (f32x4){a[0] * sigmoidf_fast(g[0]), a[1] * sigmoidf_fast(g[1]), a[2] * sigmoidf_fast(g[2]), a[3] * sigmoidf_fast(g[3])}; }
                    __builtin_nontemporal_store(pack8(y[0], y[1]), (v4u*)(YG + row * 512 + pn * 128 + wc * 32 + 8 * fq)); }
        } else if (pn < 8) {
            const bool isq = pn < 6; bf16* base = isq ? QB : KB; const LAS float* gp = gl + (isq ? 0 : 64); const float sc = isq ? 0.125f * 1.4426950408889634f : 1.0f;
            f32x4 gv[2][2];
#pragma unroll
            for (int bj = 0; bj < 2; ++bj)
#pragma unroll
                for (int n = 0; n < 2; ++n) gv[bj][n] = *(const LAS f32x4*)(gp + 32 * bj + 8 * fq + 4 * n) * sc;
#pragma unroll
            for (int ai = 0; ai < 2; ++ai)
#pragma unroll
                for (int m = 0; m < 4; ++m) { const size_t row = row0 + ai * 128 + m * 16; float ss = 0.f;
#pragma unroll
                    for (int bj = 0; bj < 2; ++bj)
#pragma unroll
                        for (int n = 0; n < 2; ++n) { const f32x4 a = acc[ai][bj][m][n]; ss += (a[0] * a[0] + a[1] * a[1]) + (a[2] * a[2] + a[3] * a[3]); }
                    ss += __shfl_xor(ss, 16); ss += __shfl_xor(ss, 32);
                    const float rinv = 1.0f / sqrtf(ss * (1.0f / 64.0f) + EPS);
#pragma unroll
                    for (int bj = 0; bj < 2; ++bj)
                        __builtin_nontemporal_store(pack8(acc[ai][bj][m][0] * rinv * gv[bj][0], acc[ai][bj][m][1] * rinv * gv[bj][1]), (v4u*)(base + row * 512 + (pn & 1) * 256 + wc * 64 + bj * 32 + 8 * fq)); }
        } else if (pn < 10) {
#pragma unroll
            for (int ai = 0; ai < 2; ++ai)
#pragma unroll
                for (int m = 0; m < 4; ++m) { const size_t row = row0 + ai * 128 + m * 16;
#pragma unroll
                    for (int bj = 0; bj < 2; ++bj) __builtin_nontemporal_store(pack8(acc[ai][bj][m][0], acc[ai][bj][m][1]), (v4u*)(VB + row * 512 + (pn - 8) * 256 + bj * 128 + wc * 32 + 8 * fq)); }
        } else {
#pragma unroll
            for (int ai = 0; ai < 2; ++ai)
#pragma unroll
                for (int m = 0; m < 4; ++m) { const size_t row = row0 + ai * 128 + m * 16; f32x4 rr[2], gg[2];
#pragma unroll
                    for (int n = 0; n < 2; ++n)
#pragma unroll
                        for (int j = 0; j < 4; ++j) { const float e0 = __builtin_amdgcn_exp2f(-1.4426950408889634f * acc[ai][0][m][n][j]), e1 = fminf(__builtin_amdgcn_exp2f(-1.4426950408889634f * acc[ai][1][m][n][j]), 1e30f);
                            gg[n][j] = __builtin_amdgcn_rcpf(1.0f + e1); rr[n][j] = (1.0f + e1) * __builtin_amdgcn_rcpf(1.0f + e0); }
                    const size_t o = row * 1024 + (pn - 10) * 128 + wc * 32 + 8 * fq;
                    __builtin_nontemporal_store(pack8(rr[0], rr[1]), (v4u*)(GT + o)); __builtin_nontemporal_store(pack8(gg[0], gg[1]), (v4u*)(GT + (size_t)NTOK * 1024 + o)); }
        }
    }
};
struct EpiMerged {
    static constexpr bool MID = true;
    const bf16* GR; const bf16* G1; bf16* MG;
    __device__ __forceinline__ void mid(AccT& acc, const pg8::Unit& u, int wr, int wc, int fr, int fq) const {
        asm volatile("" : "+v"(fr), "+v"(fq));
        const size_t row0 = (size_t)u.orow + wr * 64 + fr; const int col0 = u.pn * 256 + wc * 32 + 8 * fq;
        v4u w0[2][4][2];
#pragma unroll
        for (int ai = 0; ai < 2; ++ai)
#pragma unroll
            for (int m = 0; m < 4; ++m)
#pragma unroll
                for (int bj = 0; bj < 2; ++bj) w0[ai][m][bj] = *(const v4u*)(GR + (row0 + ai * 128 + m * 16) * 1024 + col0 + bj * 128);
        __builtin_amdgcn_sched_barrier(0);
#pragma unroll
        for (int ai = 0; ai < 2; ++ai)
#pragma unroll
            for (int m = 0; m < 4; ++m)
#pragma unroll
                for (int bj = 0; bj < 2; ++bj) { f32x4 a0, a1; unpack8(w0[ai][m][bj], a0, a1); acc[ai][bj][m][0] = acc[ai][bj][m][0] * a0; acc[ai][bj][m][1] = acc[ai][bj][m][1] * a1; }
        __builtin_amdgcn_sched_barrier(0);
    }
    __device__ __forceinline__ void operator()(AccT& acc, const pg8::Unit& u, int wr, int wc, int fr, int fq) const {
        asm volatile("" : "+v"(fr), "+v"(fq));
        const size_t row0 = (size_t)u.orow + wr * 64 + fr; const int col0 = u.pn * 256 + wc * 32 + 8 * fq;
        v4u w1[2][4][2];
#pragma unroll
        for (int ai = 0; ai < 2; ++ai)
#pragma unroll
            for (int m = 0; m < 4; ++m)
#pragma unroll
                for (int bj = 0; bj < 2; ++bj) w1[ai][m][bj] = *(const v4u*)(G1 + (row0 + ai * 128 + m * 16) * 1024 + col0 + bj * 128);
        __builtin_amdgcn_sched_barrier(0);
#pragma unroll
        for (int ai = 0; ai < 2; ++ai)
#pragma unroll
            for (int m = 0; m < 4; ++m) { const size_t row = row0 + ai * 128 + m * 16;
#pragma unroll
                for (int bj = 0; bj < 2; ++bj) { f32x4 b0, b1; unpack8(w1[ai][m][bj], b0, b1);
                    *(v4u*)(MG + row * 1024 + col0 + bj * 128) = pack8(acc[ai][bj][m][0] * b0, acc[ai][bj][m][1] * b1); } }
    }
};
struct EpiOut {
    static constexpr bool MID = false;
    const float* x; bf16* XMB; unsigned char* XM8;
    __device__ __forceinline__ void mid(AccT&, const pg8::Unit&, int, int, int, int) const {}
    __device__ __forceinline__ void operator()(AccT& acc, const pg8::Unit& u, int wr, int wc, int fr, int fq) const {
        asm volatile("" : "+v"(fr), "+v"(fq));
        const size_t row0 = (size_t)u.orow + wr * 64 + fr; const int col0 = u.pn * 256 + wc * 32 + 8 * fq;
#pragma unroll
        for (int ai = 0; ai < 2; ++ai) {
            f32x4 xv[4][2][2];
#pragma unroll
            for (int m = 0; m < 4; ++m) { const size_t off = (row0 + ai * 128 + m * 16) * 1024 + col0;
#pragma unroll
                for (int bj = 0; bj < 2; ++bj) { xv[m][bj][0] = __builtin_nontemporal_load((const f32x4*)(x + off + bj * 128)); xv[m][bj][1] = __builtin_nontemporal_load((const f32x4*)(x + off + bj * 128 + 4)); } }
            __builtin_amdgcn_sched_barrier(0);
#pragma unroll
            for (int m = 0; m < 4; ++m) { const size_t off = (row0 + ai * 128 + m * 16) * 1024 + col0;
#pragma unroll
                for (int bj = 0; bj < 2; ++bj) { const f32x4 o0 = xv[m][bj][0] + acc[ai][bj][m][0], o1 = xv[m][bj][1] + acc[ai][bj][m][1];
                    *(v4u*)(XMB + off + bj * 128) = pack8(o0, o1);
                    v2u w8; w8.x = pg8::pack4_fp8(o0[0], o0[1], o0[2], o0[3]); w8.y = pg8::pack4_fp8(o1[0], o1[1], o1[2], o1[3]); *(v2u*)(XM8 + off + bj * 128) = w8; } }
            __builtin_amdgcn_sched_barrier(0);
        }
    }
};
struct EpiGateUp {
    static constexpr bool MID = false;
    const int* LIST; unsigned char* HP8; const LAS int* m2;
    __device__ __forceinline__ void mid(AccT&, const pg8::Unit&, int, int, int, int) const {}
    __device__ __forceinline__ void operator()(AccT& acc, const pg8::Unit& u, int wr, int wc, int fr, int fq) const {
        asm volatile("" : "+v"(fr), "+v"(fq));
        typedef int i32x4 __attribute__((ext_vector_type(4)));
        i32x4 ent[2][4];
#pragma unroll
        for (int ai = 0; ai < 2; ++ai)
#pragma unroll
            for (int m = 0; m < 4; ++m) { const int r = ai * 128 + wr * 64 + m * 16 + fr; ent[ai][m] = (r < u.nvalid) ? *(const i32x4*)(LIST + (size_t)(u.lrow + r) * 4) : (i32x4){-1, 0, 0, 0}; }
#pragma unroll
        for (int ai = 0; ai < 2; ++ai)
#pragma unroll
            for (int m = 0; m < 4; ++m) { const i32x4 en = ent[ai][m]; if (en[0] < 0) continue;
                const float rs = __int_as_float(en[3]) * (1.0f / 64.0f), w8 = __int_as_float(en[2]) * 8.0f;
                const int dst = en[1]; const size_t drow = (size_t)m2[dst >> 17] * 256 + ((dst >> 1) & 0xffff);
                float h[8];
#pragma unroll
                for (int n = 0; n < 2; ++n)
#pragma unroll
                    for (int j = 0; j < 4; ++j) { const float g = acc[ai][0][m][n][j] * rs, up = acc[ai][1][m][n][j] * rs; h[4 * n + j] = __builtin_amdgcn_fmed3f(g * sigmoidf_fast(g) * up * w8, -448.f, 448.f); }
                v2u o8; o8.x = pg8::pack4_fp8(h[0], h[1], h[2], h[3]); o8.y = pg8::pack4_fp8(h[4], h[5], h[6], h[7]);
                *(v2u*)(HP8 + drow * 1024 + (dst & 1) * 512 + u.pn * 128 + wc * 32 + 8 * fq) = o8; }
    }
};
struct EpiDownAdd {
    static constexpr bool MID = false;
    const int* CTOK; const bf16* XMB; float* out;
    __device__ __forceinline__ void mid(AccT&, const pg8::Unit&, int, int, int, int) const {}
    __device__ __forceinline__ void operator()(AccT& acc, const pg8::Unit& u, int wr, int wc, int fr, int fq) const {
        asm volatile("" : "+v"(fr), "+v"(fq));
        const int col0 = u.pn * 256 + wc * 32 + 8 * fq;
        int tokall[2][4];
#pragma unroll
        for (int ai = 0; ai < 2; ++ai)
#pragma unroll
            for (int m = 0; m < 4; ++m) { const int r = ai * 128 + wr * 64 + m * 16 + fr; tokall[ai][m] = (r < u.nvalid) ? CTOK[u.lrow + r] : -1; }
#pragma unroll
        for (int ai = 0; ai < 2; ++ai) {
            int tok[4];
#pragma unroll
            for (int m = 0; m < 4; ++m) tok[m] = tokall[ai][m];
            v4u xw[4][2];
#pragma unroll
            for (int m = 0; m < 4; ++m) { const size_t off = (size_t)(tok[m] < 0 ? 0 : tok[m]) * 1024 + col0;
#pragma unroll
                for (int bj = 0; bj < 2; ++bj) xw[m][bj] = *(const v4u*)(XMB + off + bj * 128); }
            __builtin_amdgcn_sched_barrier(0);
#pragma unroll
            for (int m = 0; m < 4; ++m) { if (tok[m] < 0) continue; const size_t off = (size_t)tok[m] * 1024 + col0;
#pragma unroll
                for (int bj = 0; bj < 2; ++bj) { f32x4 x0, x1; unpack8(xw[m][bj], x0, x1);
                    __builtin_nontemporal_store(x0 + acc[ai][bj][m][0] * (1.0f / 256.0f), (f32x4*)(out + off + bj * 128)); __builtin_nontemporal_store(x1 + acc[ai][bj][m][1] * (1.0f / 256.0f), (f32x4*)(out + off + bj * 128 + 4)); } }
            __builtin_amdgcn_sched_barrier(0);
        }
    }
};
struct MoeOrder {
    int G, c, total; const LAS int* meta;
    __device__ __forceinline__ bool next(int i, pg8::Unit& u) const {
        const int L = i * G + c; if (L >= total * 4) return false;
        const int blk = L >> 2, lane = threadIdx.x & 63;
        const int e = __builtin_amdgcn_readfirstlane(__builtin_popcountll(__ballot(lane < NEXP - 1 && meta[1 + lane] <= blk)));
        const int pre = __builtin_amdgcn_readfirstlane(meta[e]), cnt = __builtin_amdgcn_readfirstlane(meta[64 + e]); const int rb = blk - pre;
        u.pn = L & 3; u.pm = rb; u.e = e; u.e2 = e; u.lrow = e * LCAP + rb * 256; u.nvalid = min(256, cnt - rb * 256); u.orow = blk * 256; u.arow = 0; return true;
    }
};
struct ClassOrder {
    int G, c, total; const LAS int* m2;
    __device__ __forceinline__ bool next(int i, pg8::Unit& u) const {
        const int L = i * G + c; if (L >= total * 4) return false;
        const int blk = L >> 2, lane = threadIdx.x & 63;
        const int n0 = __builtin_popcountll(__ballot(m2[1 + lane] <= blk)), n1 = __builtin_popcountll(__ballot(lane + 65 <= NCLS - 1 && m2[65 + lane] <= blk));
        const int cls = __builtin_amdgcn_readfirstlane(n0 + n1);
        const int pre = __builtin_amdgcn_readfirstlane(m2[cls]), cnt = __builtin_amdgcn_readfirstlane(m2[128 + cls]); const int rb = blk - pre;
        const int g = cls / 28; int p = cls % 28, a = 0;
        while (p >= 7 - a) { p -= 7 - a; ++a; }
        u.e = g * 8 + a; u.e2 = g * 8 + a + 1 + p; u.pn = L & 3; u.pm = rb; u.lrow = cls * NTOK + rb * 256; u.nvalid = min(256, cnt - rb * 256); u.orow = blk * 256; u.arow = u.orow; return true;
    }
};
__device__ __forceinline__ void moe_meta(LAS int* meta, LAS int* m2, const unsigned* ctl) {
    const int tid = threadIdx.x;
    if (tid < NEXP) meta[64 + tid] = (int)__hip_atomic_load(ctl + tid, __ATOMIC_RELAXED, __HIP_MEMORY_SCOPE_AGENT);
    if (tid >= 64 && tid < 64 + NCLS) m2[128 + tid - 64] = (int)__hip_atomic_load(ctl + tid, __ATOMIC_RELAXED, __HIP_MEMORY_SCOPE_AGENT);
    __syncthreads();
    if (tid == 0) { int p = 0;
        for (int e = 0; e < NEXP; ++e) { meta[e] = p; p += (meta[64 + e] + 255) >> 8; }
        meta[NEXP] = p; }
    if (tid == 64) { int p = 0;
        for (int c = 0; c < NCLS; ++c) { m2[c] = p; p += (m2[128 + c] + 255) >> 8; }
        m2[NCLS] = p; }
    __syncthreads();
}

__device__ __forceinline__ void transpose_item(const float* W, int N, int k0, int n0, bf16* WT, int dpitch, int drow0, int dcol0, const float* kscale, LAS float* scr, int lane) {
    const int kr = lane >> 3, nc = (lane & 7) * 4;
    f32x4 v[8];
#pragma unroll
    for (int i = 0; i < 8; ++i) v[i] = *(const f32x4*)(W + (size_t)(k0 + i * 8 + kr) * N + n0 + nc);
    if (kscale) {
#pragma unroll
        for (int i = 0; i < 8; ++i) v[i] = v[i] * kscale[k0 + i * 8 + kr]; }
#pragma unroll
    for (int i = 0; i < 8; ++i) { LAS float* d = scr + (i * 8 + kr) * 33 + nc; d[0] = v[i][0]; d[1] = v[i][1]; d[2] = v[i][2]; d[3] = v[i][3]; }
    asm volatile("s_waitcnt lgkmcnt(0)" ::: "memory");
    const int c = lane & 7;
#pragma unroll
    for (int j = 0; j < 4; ++j) { const int n = (lane >> 3) + 8 * j; const LAS float* s = scr + (8 * c) * 33 + n;
        v4u o; o.x = cvt_pk_bf16(s[0 * 33], s[1 * 33]); o.y = cvt_pk_bf16(s[2 * 33], s[3 * 33]); o.z = cvt_pk_bf16(s[4 * 33], s[5 * 33]); o.w = cvt_pk_bf16(s[6 * 33], s[7 * 33]);
        *(v4u*)(WT + (size_t)(drow0 + n) * dpitch + dcol0 + k0 + 8 * c) = o; }
    asm volatile("s_waitcnt lgkmcnt(0)" ::: "memory");
}
__device__ __forceinline__ void transpose_item_fp8(const float* W, int N, int k0, int n0, unsigned char* WT, int dpitch, int drow0, const float* kscale, float mul, LAS float* scr, int lane) {
    const int kr = lane >> 3, nc = (lane & 7) * 4;
    f32x4 v[8];
#pragma unroll
    for (int i = 0; i < 8; ++i) v[i] = *(const f32x4*)(W + (size_t)(k0 + i * 8 + kr) * N + n0 + nc);
#pragma unroll
    for (int i = 0; i < 8; ++i) v[i] = v[i] * (kscale ? kscale[k0 + i * 8 + kr] * mul : mul);
#pragma unroll
    for (int i = 0; i < 8; ++i) { LAS float* d = scr + (i * 8 + kr) * 33 + nc; d[0] = v[i][0]; d[1] = v[i][1]; d[2] = v[i][2]; d[3] = v[i][3]; }
    asm volatile("s_waitcnt lgkmcnt(0)" ::: "memory");
    const int c = lane & 7;
#pragma unroll
    for (int j = 0; j < 4; ++j) { const int n = (lane >> 3) + 8 * j; const LAS float* s = scr + (8 * c) * 33 + n;
        v2u o; o.x = pg8::pack4_fp8(s[0 * 33], s[1 * 33], s[2 * 33], s[3 * 33]); o.y = pg8::pack4_fp8(s[4 * 33], s[5 * 33], s[6 * 33], s[7 * 33]);
        *(v2u*)(WT + (size_t)(drow0 + n) * dpitch + k0 + 8 * c) = o; }
    asm volatile("s_waitcnt lgkmcnt(0)" ::: "memory");
}
__device__ __forceinline__ int inproj_phys(int c) {
    if (c < 512) return (c >> 7) * 256 + (c & 127);
    if (c < 1024) { c -= 512; return (c >> 7) * 256 + 128 + (c & 127); }
    if (c < 2048) { const int sec = (c - 1024) >> 8, cl = (c - 1024) & 255, s = cl >> 6, d = cl & 63; return 1024 + sec * 256 + ((d >> 5) << 7) + (s << 5) + (d & 31); }
    if (c < 2560) return c;
    { int j = c - 2560; const int hi = j >= 1024; j &= 1023; return 2560 + (j >> 7) * 256 + hi * 128 + (j & 127); }
}
struct Ptrs {
    const float *x, *attn_norm_g, *w_in, *conv_dw_w, *conv_dw_b, *conv_ln_g, *conv_ln_b, *w_conv_out, *q_norm_g, *k_norm_g, *lq1, *lk1, *lq2, *lk2, *subln_g,
        *w_attn_out, *w_out, *ffn_norm_g, *w_rg, *b_rg, *w_re, *b_re, *w_gate, *w_up, *w_down;
    float* out; unsigned char* ws;
};

__device__ __forceinline__ void p0_prologue(const Ptrs& P, LAS unsigned char* lds, int vcu, int G) {
    const int tid = threadIdx.x, lane = tid & 63, wave = __builtin_amdgcn_readfirstlane(tid >> 6);
    LAS float* scr = (LAS float*)(lds + wave * 16384);
    const int gw = vcu * NWAVES + wave, NGW = G * NWAVES;
    bf16* WIN = (bf16*)(P.ws + WS_WIN); bf16* WCA = (bf16*)(P.ws + WS_WCA); bf16* WOUT = (bf16*)(P.ws + WS_WOUT);
    constexpr int I_IN = (DMODEL / 64) * (IN_COLS / 32), I_C = (CONV_CH / 64) * (DMODEL / 32), I_O = (DMODEL / 64) * (DMODEL / 32);
    for (int it = gw; it < I_IN + 2 * I_C + I_O; it += NGW) {
        int r = it;
        if (r < I_IN) { const int kb = r / (IN_COLS / 32), nb = r % (IN_COLS / 32); transpose_item(P.w_in, IN_COLS, kb * 64, nb * 32, WIN, 1024, inproj_phys(nb * 32), 0, nullptr, scr, lane); continue; } r -= I_IN;
        if (r < I_C) { const int kb = r / 32, nb = r % 32; transpose_item(P.w_conv_out, DMODEL, kb * 64, nb * 32, WCA, 1024, nb * 32, 0, nullptr, scr, lane); continue; } r -= I_C;
        if (r < I_C) { const int kb = r / 32, nb = r % 32; transpose_item(P.w_attn_out, DMODEL, kb * 64, nb * 32, WCA, 1024, nb * 32, 512, nullptr, scr, lane); continue; } r -= I_C;
        { const int kb = r / 32, nb = r % 32; transpose_item(P.w_out, DMODEL, kb * 64, nb * 32, WOUT, 1024, nb * 32, 0, nullptr, scr, lane); }
    }
    bf16* WRhi = (bf16*)(P.ws + WS_WR); bf16* WRlo = WRhi + 64 * 1024;
    for (int idx = vcu * NTHREADS + tid; idx < 64 * 1024; idx += G * NTHREADS) {
        const int n = idx >> 10, k = idx & 1023; float v = 0.f;
        if (n < 4) v = P.w_rg[k * 4 + n]; else if (n < 36) v = P.w_re[k * 32 + (n - 4)];
        v *= P.ffn_norm_g[k];
        const unsigned hb = cvt_pk_bf16(v, 0.f) & 0xffffu; const float hf = __uint_as_float(hb << 16);
        WRhi[idx] = (bf16)hb; WRlo[idx] = (bf16)(cvt_pk_bf16(v - hf, 0.f) & 0xffffu);
    }
    bf16* HB = (bf16*)(P.ws + WS_A);
    f32x4 gq[4];
#pragma unroll
    for (int j = 0; j < 4; ++j) gq[j] = ((const f32x4*)P.attn_norm_g)[64 * j + lane];
    for (int m = gw; m < NTOK; m += NGW) {
        const f32x4* xr = (const f32x4*)(P.x + (size_t)m * DMODEL) + lane; f32x4 v[4]; float s = 0.f;
#pragma unroll
        for (int j = 0; j < 4; ++j) { v[j] = xr[64 * j]; s += (v[j][0] * v[j][0] + v[j][1] * v[j][1]) + (v[j][2] * v[j][2] + v[j][3] * v[j][3]); }
        const float r = 1.0f / sqrtf(wave_sum(s) * (1.0f / DMODEL) + EPS);
        v2u* o8 = (v2u*)(HB + (size_t)m * DMODEL) + lane;
#pragma unroll
        for (int j = 0; j < 4; ++j) { const f32x4 y = v[j] * r * gq[j]; v2u w; w.x = cvt_pk_bf16(y[0], y[1]); w.y = cvt_pk_bf16(y[2], y[3]); o8[64 * j] = w; }
    }
}

__device__ __forceinline__ void conv_phase(const Ptrs& P, LAS unsigned char* lds, int first, int stride) {
    const int tid = threadIdx.x, lane = tid & 63, wave = __builtin_amdgcn_readfirstlane(tid >> 6);
    const bf16* YG = (const bf16*)(P.ws + WS_YG); bf16* CA = (bf16*)(P.ws + WS_CA);
    LAS bf16* yt = (LAS bf16*)lds; LAS float* co = (LAS float*)(lds + 62 * 1024);
    constexpr int NT = NTOK / 32;
    if (first >= NT) return;
    float w[CONV_W];
#pragma unroll
    for (int j = 0; j < CONV_W; ++j) w[j] = P.conv_dw_w[j * CONV_CH + tid];
    const float bias = P.conv_dw_b[tid];
    const f32x4 g0 = ((const f32x4*)P.conv_ln_g)[lane], g1 = ((const f32x4*)P.conv_ln_g)[64 + lane], b0 = ((const f32x4*)P.conv_ln_b)[lane], b1 = ((const f32x4*)P.conv_ln_b)[64 + lane];
    v4u pre[8];
#define CONV_FETCH(tile) do { const int b_ = (tile) / (SEQ / 32), t0_ = ((tile) % (SEQ / 32)) * 32; _Pragma("unroll") for (int p = 0; p < 8; ++p) { const int q = tid + NTHREADS * p; const int row = q >> 6, ch = q & 63, t = t0_ - 30 + row; \
        pre[p] = (v4u){0u, 0u, 0u, 0u}; if (q < 62 * 64 && t >= 0) pre[p] = *(const v4u*)(YG + ((size_t)(b_ * SEQ + t)) * 512 + ch * 8); } } while (0)
    CONV_FETCH(first);
    for (int tile = first; tile < NT; tile += stride) {
        const int b = tile / (SEQ / 32), t0 = (tile % (SEQ / 32)) * 32;
#pragma unroll
        for (int p = 0; p < 8; ++p) { const int q = tid + NTHREADS * p; if (q < 62 * 64) *(LAS v4u*)(yt + (q >> 6) * 512 + (q & 63) * 8) = pre[p]; }
        __syncthreads();
        if (tile + stride < NT) CONV_FETCH(tile + stride);
        float yv[62];
#pragma unroll
        for (int i = 0; i < 62; ++i) yv[i] = __uint_as_float((unsigned)yt[i * 512 + tid] << 16);
#pragma unroll
        for (int t = 0; t < 32; ++t) { float a = bias;
#pragma unroll
            for (int j = 0; j < CONV_W; ++j) a += w[j] * yv[t + j];
            co[t * 512 + tid] = a; }
        __syncthreads();
#pragma unroll
        for (int rr = 0; rr < 4; ++rr) { const int row = wave * 4 + rr;
            const f32x4 v0 = *(const LAS f32x4*)(co + row * 512 + lane * 4), v1 = *(const LAS f32x4*)(co + row * 512 + 256 + lane * 4);
            const float mean = wave_sum((v0[0] + v0[1]) + (v0[2] + v0[3]) + (v1[0] + v1[1]) + (v1[2] + v1[3])) * (1.0f / CONV_CH);
            const f32x4 d0 = v0 - mean, d1 = v1 - mean;
            const float var = wave_sum((d0[0] * d0[0] + d0[1] * d0[1]) + (d0[2] * d0[2] + d0[3] * d0[3]) + (d1[0] * d1[0] + d1[1] * d1[1]) + (d1[2] * d1[2] + d1[3] * d1[3])) * (1.0f / CONV_CH);
            const float rstd = 1.0f / sqrtf(var + EPS);
            f32x4 y0 = d0 * rstd * g0 + b0, y1 = d1 * rstd * g1 + b1;
#pragma unroll
            for (int j = 0; j < 4; ++j) { y0[j] = y0[j] * sigmoidf_fast(y0[j]); y1[j] = y1[j] * sigmoidf_fast(y1[j]); }
            bf16* orow = CA + ((size_t)(b * SEQ + t0 + row)) * 1024;
            v2u o0, o1; o0.x = cvt_pk_bf16(y0[0], y0[1]); o0.y = cvt_pk_bf16(y0[2], y0[3]); o1.x = cvt_pk_bf16(y1[0], y1[1]); o1.y = cvt_pk_bf16(y1[2], y1[3]);
            *(v2u*)(orow + lane * 4) = o0; *(v2u*)(orow + 256 + lane * 4) = o1; }
        __syncthreads();
    }
#undef CONV_FETCH
}

__device__ __forceinline__ void attn_pair(const Ptrs& P, LAS unsigned char* lds, char* lds_generic, int p) {
    const int tid = threadIdx.x, lane = tid & 63, wave = __builtin_amdgcn_readfirstlane(tid >> 6);
    const int bh = p >> 3, s = p & 7, b = bh >> 2, h = bh & 3;
    const __hip_bfloat16* QB = (const __hip_bfloat16*)(P.ws + WS_QB); const __hip_bfloat16* KB = (const __hip_bfloat16*)(P.ws + WS_KB); const __hip_bfloat16* VB = (const __hip_bfloat16*)(P.ws + WS_VB);
    __hip_bfloat16* OT = (__hip_bfloat16*)(P.ws + WS_A); bf16* CA = (bf16*)(P.ws + WS_CA);
    float mstat;
    { int l0 = lane; asm volatile("" : "+v"(l0));
      float a = fabsf(P.q_norm_g[l0]), b = fabsf(P.k_norm_g[l0]);
#pragma unroll
      for (int o = 1; o < 64; o <<= 1) { a = fmaxf(a, __shfl_xor(a, o)); b = fmaxf(b, __shfl_xor(b, o)); }
      mstat = __int_as_float(__builtin_amdgcn_readfirstlane(__float_as_int(0.125f * 1.4426950408889634f * 64.0f * 1.02f * a * b))); }
    for (int i = 0; i < 2; ++i) {
        const int qb = (i == 0) ? s : 15 - s;
#pragma unroll 1
        for (int c = 0; c < 2; ++c) {
            const __hip_bfloat16* q_ = QB + (size_t)b * SEQ * 512 + (h * 2 + c) * 64; const __hip_bfloat16* k_ = KB + (size_t)b * SEQ * 512 + (h * 2 + c) * 64; const __hip_bfloat16* v_ = VB + (size_t)b * SEQ * 512 + h * 128;
            __hip_bfloat16* o_ = OT + (size_t)b * SEQ * 1024 + (h * 2 + c) * 128;
            if (mstat <= 40.0f) attn_body::attn_unit<8, true>(mstat, qb * 256, q_, k_, v_, o_, lds_generic);
            else attn_body::attn_unit<8, false>(0.f, qb * 256, q_, k_, v_, o_, lds_generic); }
        asm volatile("s_waitcnt vmcnt(0)" ::: "memory");
        int ln = lane; asm volatile("" : "+v"(ln));
        const size_t r0 = (size_t)b * SEQ + qb * 256 + wave * 32;
        const float2 sg = ((const float2*)P.subln_g)[ln];
        const float lam = __expf(wave_sum(P.lq1[ln] * P.lk1[ln])) - __expf(wave_sum(P.lq2[ln] * P.lk2[ln])) + 0.2f;
#pragma unroll 16
        for (int r = 0; r < 32; ++r) { unsigned* op = (unsigned*)(OT + (r0 + r) * 1024 + h * 256) + ln;
            const unsigned w1 = __hip_atomic_load(op, __ATOMIC_RELAXED, __HIP_MEMORY_SCOPE_AGENT), w2 = __hip_atomic_load(op + 64, __ATOMIC_RELAXED, __HIP_MEMORY_SCOPE_AGENT);
            const float o0 = bf_lo(w1) - lam * bf_lo(w2), o1 = bf_hi(w1) - lam * bf_hi(w2);
            const float rn = 1.0f / sqrtf(wave_sum(o0 * o0 + o1 * o1) * (1.0f / 128.0f) + EPS) * 0.8f;
            ((unsigned*)(CA + (r0 + r) * 1024 + 512 + h * 128))[ln] = cvt_pk_bf16(o0 * rn * sg.x, o1 * rn * sg.y); }
    }
}

__device__ __forceinline__ void router_tile(const Ptrs& P, LAS unsigned char* lds, int tile) {
    const int tid = threadIdx.x, lane = tid & 63, wave = __builtin_amdgcn_readfirstlane(tid >> 6), r32 = lane & 31, hi = lane >> 5;
    const bf16* WRhi = (const bf16*)(P.ws + WS_WR); const bf16* WRlo = WRhi + 64 * 1024;
    int* LIST = (int*)(P.ws + WS_LIST); int* CTOK = (int*)(P.ws + WS_CTOK); unsigned* cnt = (unsigned*)(P.ws + WS_CTL); unsigned* ccnt = cnt + 64;
    LAS float* lg = (LAS float*)(lds + wave * 8448);
    LAS int* hist = (LAS int*)(lds + HIST_OFF); LAS int* hbase = hist + 32; LAS int* hist2 = hist + 64; LAS int* hbase2 = hist2 + NCLS;
    if (tid < 32) hist[tid] = 0;
    if (tid >= 64 && tid < 64 + NCLS) hist2[tid - 64] = 0;
    __syncthreads();
    const int tbase = tile * 256 + wave * 32;
    const bf16* xr = (const bf16*)(P.ws + WS_CA) + (size_t)(tbase + r32) * DMODEL + 8 * hi;
    const bf16* bh0 = WRhi + (size_t)r32 * 1024 + 8 * hi; const bf16* bl0 = WRlo + (size_t)r32 * 1024 + 8 * hi;
    f32x16 acc0 = {}, acc1 = {}; float ssq = 0.f;
#pragma unroll 4
    for (int ks = 0; ks < 64; ++ks) {
        const v4u xa = *(const v4u*)(xr + ks * 16);
        f32x4 x0, x1; unpack8(xa, x0, x1);
        ssq += (x0[0] * x0[0] + x0[1] * x0[1]) + (x0[2] * x0[2] + x0[3] * x0[3]) + (x1[0] * x1[0] + x1[1] * x1[1]) + (x1[2] * x1[2] + x1[3] * x1[3]);
        const bf16x8 a_hi = __builtin_bit_cast(bf16x8, xa);
        const bf16x8 bh_0 = *(const bf16x8*)(bh0 + ks * 16), bh_1 = *(const bf16x8*)(bh0 + 32 * 1024 + ks * 16), bl_0 = *(const bf16x8*)(bl0 + ks * 16), bl_1 = *(const bf16x8*)(bl0 + 32 * 1024 + ks * 16);
        acc0 = __builtin_amdgcn_mfma_f32_32x32x16_bf16(a_hi, bh_0, acc0, 0, 0, 0); acc1 = __builtin_amdgcn_mfma_f32_32x32x16_bf16(a_hi, bh_1, acc1, 0, 0, 0);
        acc0 = __builtin_amdgcn_mfma_f32_32x32x16_bf16(a_hi, bl_0, acc0, 0, 0, 0); acc1 = __builtin_amdgcn_mfma_f32_32x32x16_bf16(a_hi, bl_1, acc1, 0, 0, 0);
    }
    ssq += __shfl_xor(ssq, 32);
    const float rs = 1.0f / sqrtf(ssq * (1.0f / DMODEL) + EPS);
#pragma unroll
    for (int r = 0; r < 16; ++r) { const int m = (r & 3) + 8 * (r >> 2) + 4 * hi; lg[m * 66 + r32] = acc0[r]; lg[m * 66 + 32 + r32] = acc1[r]; }
    asm volatile("s_waitcnt lgkmcnt(0)" ::: "memory");
    int ea = 0, eb = 0, cls = 0, lpa = 0, lpb = 0, lpc = 0; float wa = 0.f, wb = 0.f;
    if (lane < 32) {
        const LAS float* L = lg + lane * 66;
        float gl[4];
#pragma unroll
        for (int j = 0; j < 4; ++j) gl[j] = L[j] * rs + P.b_rg[j];
        int gs = 0; float gm = gl[0];
#pragma unroll
        for (int j = 1; j < 4; ++j) if (gl[j] > gm) { gm = gl[j]; gs = j; }
        float gsum = 0.f;
#pragma unroll
        for (int j = 0; j < 4; ++j) gsum += __expf(gl[j] - gm);
        const float gw = 1.0f / gsum;
        float l0 = -INFINITY, l1 = -INFINITY; int i0 = 0, i1 = 0;
#pragma unroll
        for (int j = 0; j < 8; ++j) { const float v = L[4 + gs * 8 + j] * rs + P.b_re[gs * 8 + j];
            if (v > l0) { l1 = l0; i1 = i0; l0 = v; i0 = j; } else if (v > l1) { l1 = v; i1 = j; } }
        const float q = __expf(l1 - l0), inv = 1.0f / (1.0f + q);
        const float w0 = inv * gw, w1 = q * inv * gw;
        const int a = min(i0, i1), b = max(i0, i1);
        wa = (i0 < i1) ? w0 : w1; wb = (i0 < i1) ? w1 : w0;
        ea = gs * 8 + a; eb = gs * 8 + b; cls = gs * 28 + (a * (15 - a)) / 2 + (b - a - 1);
        lpa = __hip_atomic_fetch_add(&hist[ea], 1, __ATOMIC_RELAXED, __HIP_MEMORY_SCOPE_WORKGROUP); lpb = __hip_atomic_fetch_add(&hist[eb], 1, __ATOMIC_RELAXED, __HIP_MEMORY_SCOPE_WORKGROUP);
        lpc = __hip_atomic_fetch_add(&hist2[cls], 1, __ATOMIC_RELAXED, __HIP_MEMORY_SCOPE_WORKGROUP);
    }
    __syncthreads();
    if (tid < 32) hbase[tid] = (int)atomicAdd(cnt + tid, (unsigned)hist[tid]);
    if (tid >= 64 && tid < 64 + NCLS) { const int c = tid - 64; const int n = hist2[c]; hbase2[c] = n ? (int)atomicAdd(ccnt + c, (unsigned)n) : 0; }
    __syncthreads();
    if (lane < 32) { const int t = tbase + lane; const int pa = hbase[ea] + lpa, pb = hbase[eb] + lpb, pc = hbase2[cls] + lpc;
        typedef int i32x4 __attribute__((ext_vector_type(4)));
        const int dst = (cls << 17) | (pc << 1);
        *(i32x4*)(LIST + (size_t)(ea * LCAP + pa) * 4) = (i32x4){t, dst, __float_as_int(wa), __float_as_int(rs)};
        *(i32x4*)(LIST + (size_t)(eb * LCAP + pb) * 4) = (i32x4){t, dst | 1, __float_as_int(wb), __float_as_int(rs)};
        CTOK[(size_t)cls * NTOK + pc] = t; }
    __syncthreads();
}

__device__ __forceinline__ void p5_convert(const Ptrs& P, LAS unsigned char* lds, int vcu, int G) {
    const int tid = threadIdx.x, lane = tid & 63, wave = __builtin_amdgcn_readfirstlane(tid >> 6);
    LAS float* scr = (LAS float*)(lds + wave * 16384);
    const int gw = vcu * NWAVES + wave, NGW = G * NWAVES;
    unsigned char* WGU = P.ws + WS_WGU; unsigned char* WD = P.ws + WS_WD;
    constexpr int I_G = (DMODEL / 64) * (DEXP / 32);
    constexpr int I_D = (DEXP / 64) * (DMODEL / 32);
    constexpr int PER_E = 2 * I_G + I_D;
    constexpr int NITEMS = NEXP * PER_E, NRW = (NTOK / 256) * NWAVES;
    const bool split = (G == 256) && (NITEMS == NRW * 10 + (256 * NWAVES - NRW) * 14);
    const bool rwg = (int)blockIdx.x < NTOK / 256; const int wv = ((int)blockIdx.x - (rwg ? 0 : NTOK / 256)) * NWAVES + wave;
    const int it0 = split ? (rwg ? wv : NRW * 10 + wv) : gw, itn = split ? (rwg ? NRW * 10 : NITEMS) : NITEMS, its = split ? NRW : NGW;
    for (int it = it0; it < itn; it += its) {
        const int e = it / PER_E; int r = it % PER_E;
        if (r < 2 * I_G) { const int up = r / I_G; r %= I_G; const int kb = r / (DEXP / 32), nb = r % (DEXP / 32), n0 = nb * 32;
            const float* W = (up ? P.w_up : P.w_gate) + (size_t)e * DMODEL * DEXP;
            transpose_item_fp8(W, DEXP, kb * 64, n0, WGU + (size_t)e * 1024 * 1024, 1024, (n0 >> 7) * 256 + up * 128 + (n0 & 127), P.ffn_norm_g, 64.f, scr, lane);
        } else { r -= 2 * I_G; const int kb = r / (DMODEL / 32), nb = r % (DMODEL / 32);
            transpose_item_fp8(P.w_down + (size_t)e * DEXP * DMODEL, DMODEL, kb * 64, nb * 32, WD + (size_t)e * 1024 * 512, 512, nb * 32, nullptr, 32.f, scr, lane); }
    }
}

struct Args { Ptrs p; int ph_lo, ph_hi, use_cg, pad; };
__global__ void __launch_bounds__(NTHREADS, 2) mega_fwd(Args args) {
    extern __shared__ __attribute__((aligned(16))) unsigned char lds_raw[];
    LAS unsigned char* lds = (LAS unsigned char*)lds_raw;
    const Ptrs& P = args.p;
    const int tid = threadIdx.x, lane = tid & 63;
    const int G = gridDim.x, bx = blockIdx.x; const int vcu = (G % 8 == 0) ? (bx % 8) * (G / 8) + bx / 8 : bx;
    const int lo = args.ph_lo, hi = args.ph_hi;
    LAS int* meta = (LAS int*)(lds + META_OFF);
    if (tid < 2) ((volatile LAS unsigned*)(lds + BARST_OFF))[tid] = 0u;
    __syncthreads();
    XcdBarrier bar = xcd_barrier_post((unsigned*)(P.ws + WS_CTL) + 1024, (volatile LAS unsigned*)(lds + BARST_OFF));
#ifndef PHASE_MASK
#define PHASE_MASK 0xff
#endif
#ifndef DUP_PHASE
#define DUP_PHASE -1
#endif
#define REPS(k) for (int rep_ = 0; rep_ < ((DUP_PHASE == (k)) ? 2 : 1); ++rep_)
#define REPBAR() do { if (rep_) xcd_barrier(bar); } while (0)
#define IN(k) (((PHASE_MASK >> (k)) & 1) && lo <= (k) && (k) < hi)
#define SEAM(k) do { if (IN(k) && IN((k) + 1)) xcd_barrier(bar); } while (0)
    bf16* WS16 = (bf16*)P.ws;
    if (IN(0)) REPS(0) { REPBAR(); p0_prologue(P, lds, vcu, G); }
    SEAM(0);
    if (IN(1)) REPS(1) { REPBAR();
        pg8::Gemm g{(const bf16*)(P.ws + WS_A), (const bf16*)(P.ws + WS_WIN), DMODEL, 0, nullptr};
        pg8::StaticOrder S; S.init(NTOK, IN_COLS, G, bx);
        LAS float* gl = (LAS float*)(lds + RING_BYTES + 8192);
        if (tid < 128) gl[tid] = (tid < 64) ? P.q_norm_g[tid] : P.k_norm_g[tid - 64];
        __syncthreads();
        EpiInProj E{(bf16*)(P.ws + WS_YG), (bf16*)(P.ws + WS_QB), (bf16*)(P.ws + WS_KB), (bf16*)(P.ws + WS_VB), (bf16*)(P.ws + WS_GT), gl};
#if defined(DUMP_SEL) && DUMP_SEL == 5
        EpiRaw ER{(bf16*)(P.ws + WS_QB)};
        pg8::gemm_phase<EpiRaw, pg8::StaticOrder, false, true>(lds, g, S, ER);
#else
        pg8::gemm_phase<EpiInProj, pg8::StaticOrder, false, true>(lds, g, S, E);
#endif
    }
    SEAM(1);
    if (IN(2)) {
        REPS(2) { REPBAR();
        for (int p = vcu; p < 256; p += G) attn_pair(P, lds, (char*)lds_raw, p);
        __syncthreads(); }
        REPS(20) { REPBAR();
        conv_phase(P, lds, bx, G); }
    }
    SEAM(2);
    if (IN(3)) REPS(3) { REPBAR();
        pg8::Gemm g{(const bf16*)(P.ws + WS_CA), (const bf16*)(P.ws + WS_WCA), DMODEL, 0, nullptr};
        pg8::StaticOrder S; S.init(NTOK, DMODEL, G, bx);
        EpiMerged E{(const bf16*)(P.ws + WS_GT), (const bf16*)(P.ws + WS_GT) + (size_t)NTOK * 1024, (bf16*)(P.ws + WS_MG)};
        pg8::gemm_phase<EpiMerged, pg8::StaticOrder, false, true>(lds, g, S, E);
    }
    SEAM(3);
    if (IN(4)) REPS(4) { REPBAR();
        pg8::Gemm g{(const bf16*)(P.ws + WS_MG), (const bf16*)(P.ws + WS_WOUT), DMODEL, 0, nullptr};
        pg8::StaticOrder S; S.init(NTOK, DMODEL, G, bx);
        EpiOut E{P.x, (bf16*)(P.ws + WS_CA), P.ws + WS_XM};
        pg8::gemm_phase<EpiOut, pg8::StaticOrder, false, true>(lds, g, S, E);
    }
    SEAM(4);
    if (IN(5)) {
        for (int t = bx; t < NTOK / 256; t += G) router_tile(P, lds, t);
        REPS(5) { REPBAR(); p5_convert(P, lds, vcu, G); }
    }
    SEAM(5);
    LAS int* meta2 = (LAS int*)(lds + META2_OFF);
    if (IN(6)) REPS(6) { REPBAR();
        moe_meta(meta, meta2, (const unsigned*)(P.ws + WS_CTL));
        pg8::Gemm g{(const bf16*)(P.ws + WS_XM), (const bf16*)(P.ws + WS_WGU), DMODEL / 2, (size_t)1024 * 1024, (const int*)(P.ws + WS_LIST), 4};
        MoeOrder S{G, bx, __builtin_amdgcn_readfirstlane(meta[NEXP]), meta};
        EpiGateUp E{(const int*)(P.ws + WS_LIST), P.ws + WS_A, meta2};
        pg8::gemm_phase<EpiGateUp, MoeOrder, true, true, true>(lds, g, S, E);
    }
    SEAM(6);
    if (IN(7)) REPS(7) { REPBAR();
        moe_meta(meta, meta2, (const unsigned*)(P.ws + WS_CTL));
        pg8::Gemm g{(const bf16*)(P.ws + WS_A), (const bf16*)(P.ws + WS_WD), DMODEL / 2, (size_t)1024 * 512, nullptr, 0, DEXP / 2};
        ClassOrder S{G, bx, __builtin_amdgcn_readfirstlane(meta2[NCLS]), meta2};
        EpiDownAdd E{(const int*)(P.ws + WS_CTOK), (const bf16*)(P.ws + WS_CA), P.out};
        pg8::gemm_phase<EpiDownAdd, ClassOrder, false, true, true, true>(lds, g, S, E);
    }
#if defined(DUMP_SEL)
    xcd_barrier(bar);
    { const bf16* YG = (const bf16*)(P.ws + WS_YG); const bf16* QB = (const bf16*)(P.ws + WS_QB); const bf16* KB = (const bf16*)(P.ws + WS_KB); const bf16* VB = (const bf16*)(P.ws + WS_VB);
      const bf16* GT = (const bf16*)(P.ws + WS_GT); const bf16* CA = (const bf16*)(P.ws + WS_CA); const bf16* MG = (const bf16*)(P.ws + WS_MG);
      for (size_t i = (size_t)bx * NTHREADS + tid; i < (size_t)NTOK * 1024; i += (size_t)G * NTHREADS) { const size_t t = i >> 10; const int c = (int)(i & 1023); float v = 0.f;
#if DUMP_SEL == 1
          v = bf_lo(YG[t * 512 + (c & 511)]) + bf_lo(QB[t * 512 + (c & 511)]) + 2.f * bf_lo(KB[t * 512 + (c & 511)]) + 3.f * bf_lo(VB[t * 512 + (c & 511)]) + bf_lo(GT[t * 2048 + c]) + bf_lo(GT[t * 2048 + 1024 + c]);
#elif DUMP_SEL == 2
          v = bf_lo(CA[t * 1024 + c]);
#elif DUMP_SEL == 4
          { const bf16* HB = (const bf16*)(P.ws + WS_A); const bf16* WIN = (const bf16*)(P.ws + WS_WIN); v = bf_lo(HB[i]) + 30.f * bf_lo(WIN[i % ((size_t)IN_COLS * 1024)]); }
#elif DUMP_SEL == 5
          { const bf16* R = (const bf16*)(P.ws + WS_QB); v = bf_lo(R[t * 4608 + c]) + bf_lo(R[t * 4608 + 1024 + c]) + bf_lo(R[t * 4608 + 2048 + c]) + bf_lo(R[t * 4608 + 3072 + c]) + bf_lo(R[t * 4608 + 4096 + (c & 511)]); }
#elif DUMP_SEL == 3
          v = bf_lo(MG[t * 1024 + c]);
#endif
          P.out[i] = v; } }
#endif
    (void)WS16;
#undef IN
#undef SEAM
}

extern "C" void kernel_launch(void* const* d_in, const int* in_sizes, int n_in, void* d_out, int out_size, void* d_ws, size_t ws_size, hipStream_t stream) {
    static int grid = 0;
    if (grid == 0) {
        if (n_in != 25 || in_sizes[0] != NTOK * DMODEL || out_size != NTOK * DMODEL || ws_size < WS_END) {
            fprintf(stderr, "kernel_launch: unexpected shapes (n_in %d, in0 %d, out %d, ws %zu); nothing launched\n", n_in, n_in > 0 ? in_sizes[0] : -1, out_size, ws_size); grid = -1; return; }
        int dev = 0, cus = 0, per_cu = 0;
        if (hipGetDevice(&dev) != hipSuccess || hipDeviceGetAttribute(&cus, hipDeviceAttributeMultiprocessorCount, dev) != hipSuccess) { grid = -1; return; }
        if (hipFuncSetAttribute((const void*)mega_fwd, hipFuncAttributeMaxDynamicSharedMemorySize, LDS_BYTES) != hipSuccess) { fprintf(stderr, "kernel_launch: hipFuncSetAttribute failed\n"); grid = -1; return; }
        if (hipOccupancyMaxActiveBlocksPerMultiprocessor(&per_cu, (const void*)mega_fwd, NTHREADS, LDS_BYTES) != hipSuccess || per_cu < 1) { fprintf(stderr, "kernel_launch: the occupancy query reports %d workgroups per CU for this kernel and LDS size; nothing launched\n", per_cu); grid = -1; return; }
        (void)hipGetLastError();
        grid = cus;
    }
    if (grid < 0) return;
    (void)hipMemsetAsync((char*)d_ws + WS_CTL, 0, CTL_ZERO_BYTES, stream);
    Args a{};
    const float** pp = (const float**)&a.p;
    for (int i = 0; i < 25; ++i) pp[i] = (const float*)d_in[i];
    a.p.out = (float*)d_out; a.p.ws = (unsigned char*)d_ws;
#if MK_PER_PHASE
    for (int ph = 0; ph < N_PHASES; ++ph) { a.ph_lo = ph; a.ph_hi = ph + 1; void* params[] = {&a};
        hipError_t e = hipLaunchCooperativeKernel((const void*)mega_fwd, dim3(grid), dim3(NTHREADS), params, LDS_BYTES, stream);
        if (e != hipSuccess) { fprintf(stderr, "launch %d failed: %s\n", ph, hipGetErrorString(e)); break; } }
#else
    a.ph_lo = 0; a.ph_hi = N_PHASES; void* params[] = {&a};
    hipError_t e = hipLaunchCooperativeKernel((const void*)mega_fwd, dim3(grid), dim3(NTHREADS), params, LDS_BYTES, stream);
    if (e != hipSuccess) fprintf(stderr, "cooperative launch failed: %s (grid %d)\n", hipGetErrorString(e), grid);
#endif
}
```

```cpp
#include <hip/hip_runtime.h>
#include <hip/hip_bf16.h>
#include <hip/hip_cooperative_groups.h>
#include <cstdio>
#include <cstdint>
#include <cmath>
namespace cg = cooperative_groups;

constexpr int BATCH = 8, SEQ = 4096, DMODEL = 1024, NTOK = BATCH * SEQ;
constexpr int CONV_CH = 512, CONV_W = 31, NHEADS = 4, IN_COLS = 4608;
constexpr int NEXP = 32, DEXP = 512, LCAP = NTOK;
constexpr int NCLS = 4 * 28;
constexpr int CROWS = NTOK + NCLS * 256;
constexpr int MOE_ROWS = 2 * NTOK + NEXP * 256;
constexpr float EPS = 1e-6f;

namespace pg8 {
#define PG8_LAS __attribute__((address_space(3)))
typedef unsigned short bf16_t;
typedef short bf16x8 __attribute__((ext_vector_type(8)));
typedef float f32x4 __attribute__((ext_vector_type(4)));
typedef unsigned u32x4 __attribute__((ext_vector_type(4)));
constexpr int BM = 256, BK = 64, HALF = 128, HTB = HALF * BK * 2  , STAGE_BYTES = 8 * HTB, NXCD = 8, WGM = 8;

__host__ __device__ __forceinline__ int lds_byte(int r, int c) { const int st = (r >> 4) * 2 + (c >> 5), rr = r & 15, cc = c & 31, ob = rr * 64 + cc * 2; return st * 1024 + (ob ^ (((ob >> 9) & 1) << 5)); }
__host__ __device__ __forceinline__ void stage_rc(int b, int& R, int& C) { const int st = b / 1024, sb = b % 1024, swz = sb ^ (((sb >> 9) & 1) << 5); R = (st >> 1) * 16 + swz / 64; C = (st & 1) * 32 + (swz % 64) / 2; }
__host__ __device__ __forceinline__ int perm32(int rho) { const int n = rho >> 4, i = rho & 15; return 8 * (i >> 2) + 4 * n + (i & 3); }

struct Unit { int pm, pn, arow, e, e2, lrow, nvalid, orow; };
struct Gemm { const bf16_t* A; const bf16_t* Bt; int K; size_t bstride; const int* list; int lstride; int KBrow; };

struct StaticOrder {
    int nM, nN, nwg, G, c;
    __device__ void init(int M, int N, int G_, int c_) { nM = M / BM; nN = N / BM; nwg = nM * nN; G = G_; c = c_; }
    __device__ bool next(int i, Unit& u) const {
        const long L = (long)i * G + c; if (L >= nwg) return false;
        int wgid = (int)L; { const int q = nwg / NXCD, r = nwg % NXCD, xcd = wgid % NXCD, off = wgid / NXCD; wgid = (xcd < r ? xcd * (q + 1) : r * (q + 1) + (xcd - r) * q) + off; }
        const int nig = WGM * nN, gid = wgid / nig, fm = gid * WGM, gsz = (nM - fm) < WGM ? (nM - fm) : WGM;
        u.pm = fm + ((wgid % nig) % gsz); u.pn = (wgid % nig) / gsz; u.arow = u.pm * BM; u.orow = u.arow; u.e = 0; u.e2 = 0; u.lrow = 0; u.nvalid = BM; return true;
    }
};

typedef float f32x2_t __attribute__((ext_vector_type(2))); typedef __bf16 bf16x2_t __attribute__((ext_vector_type(2)));
__device__ __forceinline__ unsigned cvt_pk_bf16(float lo, float hi) { const f32x2_t v = {lo, hi}; const bf16x2_t b = __builtin_convertvector(v, bf16x2_t); return __builtin_bit_cast(unsigned, b); }
typedef int v8i_t __attribute__((ext_vector_type(8))); typedef int v4i_t __attribute__((ext_vector_type(4)));
__device__ __forceinline__ v8i_t cat8(const bf16x8 a, const bf16x8 b) { const v4i_t x = __builtin_bit_cast(v4i_t, a), y = __builtin_bit_cast(v4i_t, b); return (v8i_t){x[0], x[1], x[2], x[3], y[0], y[1], y[2], y[3]}; }
__device__ __forceinline__ unsigned pack4_fp8(float a, float b, float c, float d) { int w = 0; w = __builtin_amdgcn_cvt_pk_fp8_f32(a, b, w, false); w = __builtin_amdgcn_cvt_pk_fp8_f32(c, d, w, true); return (unsigned)w; }
__device__ __forceinline__ float bf_lo(unsigned w) { return __uint_as_float(w << 16); }
__device__ __forceinline__ float bf_hi(unsigned w) { return __uint_as_float(w & 0xffff0000u); }
__device__ __forceinline__ float sigmoidf_fast(float x) { return __builtin_amdgcn_rcpf(1.0f + __builtin_amdgcn_exp2f(-1.4426950408889634f * x)); }
__device__ __forceinline__ u32x4 pack8(const f32x4 a, const f32x4 b) { u32x4 w; w.x = cvt_pk_bf16(a[0], a[1]); w.y = cvt_pk_bf16(a[2], a[3]); w.z = cvt_pk_bf16(b[0], b[1]); w.w = cvt_pk_bf16(b[2], b[3]); return w; }
__device__ __forceinline__ void unpack8(const u32x4 w, f32x4& a, f32x4& b) { a = (f32x4){bf_lo(w.x), bf_hi(w.x), bf_lo(w.y), bf_hi(w.y)}; b = (f32x4){bf_lo(w.z), bf_hi(w.z), bf_lo(w.w), bf_hi(w.w)}; }

template <class Epi, class Sched, bool GATHER, bool ALIGN_EPI, bool FP8 = false, bool BSPLIT = false>
__device__ __forceinline__ void gemm_phase(PG8_LAS unsigned char* lds, const Gemm g, const Sched& S, const Epi& E) {
    const int tid = threadIdx.x, wid = __builtin_amdgcn_readfirstlane(tid >> 6), lane = tid & 63, wr = wid >> 2, wc = wid & 3, fr = lane & 15, fq = lane >> 4;
    const int K = g.K, nt = K / BK, KBp = g.KBrow ? g.KBrow : K;
    unsigned voffB[2]; int Ra[2], Ca[2];
#pragma unroll
    for (int i = 0; i < 2; ++i) { int R, C; stage_rc(tid * 16 + i * 8192, R, C); const int Rb = (R & ~31) + perm32(R & 31); Ra[i] = R; Ca[i] = C; voffB[i] = (unsigned)(Rb * KBp + C) * 2u; }
    const unsigned kstep = (unsigned)(BK * 2);
    const unsigned hstep = (unsigned)HALF * KBp * 2;
    const unsigned tstep = 2 * hstep;
    const char* const gA = (const char*)g.A; const char* const gB = (const char*)g.Bt;
    const unsigned ldsw = (unsigned)wid * 1024u;
    const int aoff = lds_byte(wr * 64 + fr, fq * 8), boff = lds_byte(wc * 32 + fr, fq * 8);
#define PG8_SA(b, h) (((b) * 2 + (h)) * HTB)
#define PG8_SB(b, h) ((4 + (b) * 2 + (h)) * HTB)
#define PG8_STAGE(bufoff, gbase, uoff, voff) do { _Pragma("unroll") for (int _i = 0; _i < 2; ++_i) \
        __builtin_amdgcn_global_load_lds((const unsigned*)((const char*)(gbase) + (unsigned)((uoff) + (voff)[_i])), (PG8_LAS unsigned*)(lds + (bufoff) + ldsw + _i * 8192), 16, 0, 0); } while (0)
#define PG8_LDA(dst, b, h) do { _Pragma("unroll") for (int m = 0; m < 4; ++m) _Pragma("unroll") for (int k = 0; k < 2; ++k) dst[m][k] = *(const PG8_LAS bf16x8*)(lds + PG8_SA(b, h) + aoff + m * 2048 + k * 1024); } while (0)
#define PG8_LDB(dst, b, h) do { _Pragma("unroll") for (int n = 0; n < 2; ++n) _Pragma("unroll") for (int k = 0; k < 2; ++k) dst[n][k] = *(const PG8_LAS bf16x8*)(lds + PG8_SB(b, h) + boff + n * 2048 + k * 1024); } while (0)
#define PG8_MMA(ai, bj, At, Bt) do { __builtin_amdgcn_s_setprio(1); \
        if constexpr (FP8) { _Pragma("unroll") for (int m = 0; m < 4; ++m) _Pragma("unroll") for (int n = 0; n < 2; ++n) \
            asm volatile("v_mfma_scale_f32_16x16x128_f8f6f4 %0, %1, %2, %0, %3, %3 op_sel_hi:[0,0,0]" : "+v"(acc[ai][bj][m][n]) : "v"(cat8(Bt[n][0], Bt[n][1])), "v"(cat8(At[m][0], At[m][1])), "v"(one_e8m0)); } \
        else { _Pragma("unroll") for (int m = 0; m < 4; ++m) _Pragma("unroll") for (int n = 0; n < 2; ++n) _Pragma("unroll") for (int k = 0; k < 2; ++k) \
            acc[ai][bj][m][n] = __builtin_amdgcn_mfma_f32_16x16x32_bf16(Bt[n][k], At[m][k], acc[ai][bj][m][n], 0, 0, 0); } \
        __builtin_amdgcn_s_setprio(0); } while (0)
#define PG8_WAIT_V(n) asm volatile("s_waitcnt vmcnt(" #n ")" ::: "memory")
#define PG8_WAIT_L(n) asm volatile("s_waitcnt lgkmcnt(" #n ")" ::: "memory")
#define PG8_BAR __builtin_amdgcn_s_barrier()
#define PG8_SCHED __builtin_amdgcn_sched_barrier(0)
#define PG8_LOAD_VA(dst, u) do { _Pragma("unroll") for (int _h = 0; _h < 2; ++_h) _Pragma("unroll") for (int _i = 0; _i < 2; ++_i) { const int _row = _h * HALF + Ra[_i]; \
        if constexpr (GATHER) { const int _tok = (_row < (u).nvalid) ? g.list[((u).lrow + _row) * g.lstride] : 0; dst[_h][_i] = (unsigned)(_tok * K + Ca[_i]) * 2u; } \
        else dst[_h][_i] = (unsigned)(_row * K + Ca[_i]) * 2u; } } while (0)
    Unit cur, nxt; int ui = 0;
    if (!S.next(0, cur)) return;
    unsigned vAc[2][2], vAn[2][2];
    PG8_LOAD_VA(vAc, cur);
    f32x4 acc[2][2][4][2];
#pragma unroll
    for (int a = 0; a < 2; ++a)
#pragma unroll
        for (int b = 0; b < 2; ++b)
#pragma unroll
            for (int m = 0; m < 4; ++m)
#pragma unroll
                for (int n = 0; n < 2; ++n) acc[a][b][m][n] = (f32x4){0.f, 0.f, 0.f, 0.f};
    bf16x8 At[4][2], B0[2][2], B1[2][2];
    const int one_e8m0 = 0x7f7f7f7f; (void)one_e8m0;
    unsigned cA = (unsigned)cur.arow * K * 2, cB = (unsigned)cur.e * (unsigned)g.bstride + (unsigned)cur.pn * tstep;
    unsigned cB2 = (unsigned)cur.e2 * (unsigned)g.bstride + (unsigned)cur.pn * tstep; const unsigned hk = (unsigned)(nt / 2) * kstep; (void)cB2; (void)hk;
    PG8_STAGE(PG8_SB(0, 0), gB, cB, voffB); PG8_STAGE(PG8_SB(0, 1), gB, cB + hstep, voffB); PG8_STAGE(PG8_SA(0, 0), gA, cA, vAc[0]); PG8_STAGE(PG8_SA(0, 1), gA, cA, vAc[1]);
    if (wr == 1) PG8_BAR;
    PG8_WAIT_V(2); PG8_BAR;
    PG8_STAGE(PG8_SB(1, 0), gB, cB + kstep, voffB); PG8_STAGE(PG8_SA(1, 0), gA, cA + kstep, vAc[0]); PG8_STAGE(PG8_SB(1, 1), gB, cB + hstep + kstep, voffB);
    PG8_WAIT_V(6); PG8_BAR;
    for (;;) {
        const bool has_next = S.next(ui + 1, nxt);
        const unsigned nA = has_next ? (unsigned)nxt.arow * K * 2 : cA;
        const unsigned nB = has_next ? (unsigned)nxt.e * (unsigned)g.bstride + (unsigned)nxt.pn * tstep : cB;
        const unsigned nB2 = has_next ? (unsigned)nxt.e2 * (unsigned)g.bstride + (unsigned)nxt.pn * tstep : cB2; (void)nB2;
        if (has_next) { PG8_LOAD_VA(vAn, nxt); }
        else {
#pragma unroll
            for (int h = 0; h < 2; ++h)
#pragma unroll
                for (int i = 0; i < 2; ++i) vAn[h][i] = vAc[h][i]; }
#pragma unroll 1
        for (int t = 0; t < nt; t += 2) {
            const bool last = (t == nt - 2);
            if constexpr (Epi::MID) { if (t == nt / 2) E.mid(acc, cur, wr, wc, fr, fq); }
            const unsigned a1 = cA + (unsigned)(t + 1) * kstep;
            const unsigned a2 = last ? nA : cA + (unsigned)(t + 2) * kstep;
            unsigned b2 = last ? nB : cB + (unsigned)(t + 2) * kstep;
            if constexpr (BSPLIT) { if (!last && t + 2 >= nt / 2) b2 = cB2 + (unsigned)(t + 2) * kstep - hk; }
            const unsigned a3 = a2 + kstep, b3 = b2 + kstep;
            unsigned v2[2][2];
#pragma unroll
            for (int h = 0; h < 2; ++h)
#pragma unroll
                for (int i = 0; i < 2; ++i) v2[h][i] = vAc[h][i];
            if (last) { asm volatile("" ::: "memory");
#pragma unroll
                for (int h = 0; h < 2; ++h)
#pragma unroll
                    for (int i = 0; i < 2; ++i) v2[h][i] = vAn[h][i]; }
            PG8_LDB(B0, 0, 0); PG8_LDB(B1, 0, 1); PG8_SCHED; PG8_LDA(At, 0, 0); PG8_STAGE(PG8_SA(1, 1), gA, a1, vAc[1]);
            PG8_WAIT_V(8); PG8_WAIT_L(0); PG8_BAR; PG8_MMA(0, 0, At, B0); PG8_MMA(0, 1, At, B1); PG8_BAR; PG8_SCHED;
            PG8_LDA(At, 0, 1); PG8_STAGE(PG8_SB(0, 0), gB, b2, voffB); PG8_STAGE(PG8_SB(0, 1), gB, b2 + hstep, voffB); PG8_STAGE(PG8_SA(0, 0), gA, a2, v2[0]);
            PG8_WAIT_V(8); PG8_WAIT_L(0); PG8_BAR; PG8_MMA(1, 0, At, B0); PG8_MMA(1, 1, At, B1); PG8_BAR; PG8_SCHED;
            PG8_LDB(B0, 1, 0); PG8_LDB(B1, 1, 1); PG8_SCHED; PG8_LDA(At, 1, 0); PG8_STAGE(PG8_SA(0, 1), gA, a2, v2[1]);
            PG8_WAIT_V(8); PG8_WAIT_L(0); PG8_BAR; PG8_MMA(0, 0, At, B0); PG8_MMA(0, 1, At, B1); PG8_BAR; PG8_SCHED;
            PG8_LDA(At, 1, 1); PG8_STAGE(PG8_SB(1, 0), gB, b3, voffB); PG8_STAGE(PG8_SB(1, 1), gB, b3 + hstep, voffB); PG8_STAGE(PG8_SA(1, 0), gA, a3, v2[0]);
            PG8_WAIT_V(8); PG8_WAIT_L(0); PG8_BAR; PG8_MMA(1, 0, At, B0); PG8_MMA(1, 1, At, B1); PG8_BAR; PG8_SCHED;
        }
        if constexpr (ALIGN_EPI) { if (wr == 0) PG8_BAR; }
        if constexpr (FP8) asm volatile("s_nop 15\n\ts_nop 15\n\ts_nop 15\n\ts_nop 15" ::: "memory");
        E(acc, cur, wr, wc, fr, fq);
        if (!has_next) break;
#pragma unroll
        for (int a = 0; a < 2; ++a)
#pragma unroll
            for (int b = 0; b < 2; ++b)
#pragma unroll
                for (int m = 0; m < 4; ++m)
#pragma unroll
                    for (int n = 0; n < 2; ++n) acc[a][b][m][n] = (f32x4){0.f, 0.f, 0.f, 0.f};
        cur = nxt; cA = nA; cB = nB; cB2 = nB2; ++ui;
#pragma unroll
        for (int h = 0; h < 2; ++h)
#pragma unroll
            for (int i = 0; i < 2; ++i) vAc[h][i] = vAn[h][i];
        if constexpr (ALIGN_EPI) { if (wr == 1) PG8_BAR; }
    }
    PG8_WAIT_V(0);
    if constexpr (!ALIGN_EPI) { if (wr == 0) PG8_BAR; }
    PG8_BAR;
#undef PG8_SA
#undef PG8_SB
#undef PG8_STAGE
#undef PG8_LDA
#undef PG8_LDB
#undef PG8_MMA
#undef PG8_WAIT_V
#undef PG8_WAIT_L
#undef PG8_BAR
#undef PG8_SCHED
#undef PG8_LOAD_VA
}
}

namespace attn_body {
using bf16=__hip_bfloat16;
using bf16x8=__attribute__((ext_vector_type(8)))short;
using s16x4=__attribute__((ext_vector_type(4)))short;
using f32x16=__attribute__((ext_vector_type(16)))float;
using u32x4=__attribute__((ext_vector_type(4)))unsigned;
constexpr int D=64, QP=512, KP=512, VP=512, OP=1024;
constexpr int NW=8,QBLK=32,QB=QBLK*NW,KVBLK=64;
constexpr int ATTN_UNIT_ROWS=QB;
__device__ __forceinline__ int crow(int r,int hi){return (r&3)+8*(r>>2)+4*hi;}
#define SBAR() __builtin_amdgcn_sched_barrier(0)
__device__ __forceinline__ void cmask(f32x16&p0,f32x16&p1,int jb,int qrel,int hi){
  const float NEG=-INFINITY; int kb=64*jb+4*hi;
  #pragma unroll
  for(int r=0;r<16;++r){int kv=kb+(r&3)+8*(r>>2); if(kv>qrel)p0[r]=NEG; if(kv+32>qrel)p1[r]=NEG;}
}

constexpr int NSLOT=3, SLOTB=8192, VSLOTB=16384;
constexpr int LDS_K=0, LDS_V=NSLOT*SLOTB, LDS_WS=LDS_V+NSLOT*VSLOTB, LDS_OST=LDS_WS+NW*64*4, LDS_BYTES=LDS_OST+NW*4096;
constexpr float C2=0.125f*1.4426950408889634f;
__device__ __forceinline__ void glds16(const void*gsrc,unsigned lds_dst){unsigned keep;
  asm volatile("s_mov_b32 %0, m0\n\ts_mov_b32 m0, %2\n\ts_nop 0\n\tglobal_load_lds_dwordx4 %1, off\n\ts_mov_b32 m0, %0":"=&s"(keep):"v"(gsrc),"s"(lds_dst):"memory");}
__device__ __forceinline__ float max3f(float a,float b,float c){float r;asm("v_max3_f32 %0, %1, %2, %3":"=v"(r):"v"(a),"v"(b),"v"(c));return r;}
__device__ __forceinline__ float max2f(float a,float b){float r;asm("v_max_f32_e32 %0, %1, %2":"=v"(r):"v"(a),"v"(b));return r;}
__device__ __forceinline__ float fadd_s(float a,float b){float r;asm("v_add_f32_e32 %0, %1, %2":"=v"(r):"v"(a),"v"(b));return r;}
__device__ __forceinline__ float fsub_s(float a,float b){float r;asm("v_sub_f32_e32 %0, %1, %2":"=v"(r):"v"(a),"v"(b));return r;}
typedef float f32x2_t __attribute__((ext_vector_type(2))); typedef __bf16 bf16x2_t __attribute__((ext_vector_type(2)));
__device__ __forceinline__ unsigned cvtpk_s(float lo,float hi){f32x2_t v={lo,hi};bf16x2_t b=__builtin_convertvector(v,bf16x2_t);return __builtin_bit_cast(unsigned,b);}
#define WAIT_BAR(N) asm volatile("s_waitcnt vmcnt(" #N ") lgkmcnt(0)\n\ts_barrier":::"memory")

__device__ __forceinline__ void qkt(f32x16&p0,f32x16&p1,const char*Kslot,const bf16x8*qr,const f32x16&negm,int r32,int hi){
  const char*kb=Kslot+hi*1024+r32*16;
  #pragma unroll
  for(int d0=0;d0<4;++d0){
    const bf16x8 b0=*reinterpret_cast<const bf16x8*>(kb+d0*2048);
    const bf16x8 b1=*reinterpret_cast<const bf16x8*>(kb+d0*2048+512);
    if(d0==0){p0=__builtin_amdgcn_mfma_f32_32x32x16_bf16(b0,qr[0],negm,0,0,0);p1=__builtin_amdgcn_mfma_f32_32x32x16_bf16(b1,qr[0],negm,0,0,0);}
    else{p0=__builtin_amdgcn_mfma_f32_32x32x16_bf16(b0,qr[d0],p0,0,0,0);p1=__builtin_amdgcn_mfma_f32_32x32x16_bf16(b1,qr[d0],p1,0,0,0);}}
}
typedef __attribute__((address_space(3))) const char* lds_cptr;
typedef short v4i16_t __attribute__((ext_vector_type(4)));
__device__ __forceinline__ void kload8(bf16x8*kf,lds_cptr kp){
  kf[0]=*(const __attribute__((address_space(3))) bf16x8*)(kp);      kf[1]=*(const __attribute__((address_space(3))) bf16x8*)(kp+512);
  kf[2]=*(const __attribute__((address_space(3))) bf16x8*)(kp+2048); kf[3]=*(const __attribute__((address_space(3))) bf16x8*)(kp+2560);
  kf[4]=*(const __attribute__((address_space(3))) bf16x8*)(kp+4096); kf[5]=*(const __attribute__((address_space(3))) bf16x8*)(kp+4608);
  kf[6]=*(const __attribute__((address_space(3))) bf16x8*)(kp+6144); kf[7]=*(const __attribute__((address_space(3))) bf16x8*)(kp+6656);
}
__device__ __forceinline__ void kload2(bf16x8*kf,lds_cptr kp,int j){ kf[2*j]=*(const __attribute__((address_space(3))) bf16x8*)(kp+j*2048); kf[2*j+1]=*(const __attribute__((address_space(3))) bf16x8*)(kp+j*2048+512); }
__device__ __forceinline__ s16x4 vtr(lds_cptr p){ return __builtin_bit_cast(s16x4,__builtin_amdgcn_ds_read_tr16_b64_v4i16((__attribute__((address_space(3))) v4i16_t*)p)); }
__device__ __forceinline__ float rowmax(const f32x16&p0,const f32x16&p1){
  float a=max3f(p0[0],p0[1],p1[0]),b=max3f(p0[2],p0[3],p1[1]);a=max3f(a,p1[2],p1[3]);
  #pragma unroll
  for(int r=4;r<16;r+=4){a=max3f(a,p0[r],p0[r+1]);b=max3f(b,p0[r+2],p0[r+3]);a=max3f(a,p1[r],p1[r+1]);b=max3f(b,p1[r+2],p1[r+3]);}
  const float m=max2f(a,b);
  auto rr=__builtin_amdgcn_permlane32_swap(__float_as_uint(m),__float_as_uint(m),false,false);
  return max2f(__uint_as_float(rr[0]),__uint_as_float(rr[1]));
}
__device__ __forceinline__ void pv(f32x16*o,int vb,bf16x8 pa0,bf16x8 pa1,bf16x8 pa2,bf16x8 pa3){
  #pragma unroll
  for(int d0=0;d0<4;++d0){s16x4 lo[4],hi[4];
    #pragma unroll
    for(int ks=0;ks<4;++ks){
      asm volatile("ds_read_b64_tr_b16 %0,%1 offset:%c2":"=&v"(lo[ks]):"v"(vb),"i"(d0*4096+ks*1024):"memory");
      asm volatile("ds_read_b64_tr_b16 %0,%1 offset:%c2":"=&v"(hi[ks]):"v"(vb),"i"(d0*4096+ks*1024+512):"memory");}
    asm volatile("s_waitcnt lgkmcnt(0)":::"memory");SBAR();
    #define PK(k) (bf16x8){lo[k][0],lo[k][1],lo[k][2],lo[k][3],hi[k][0],hi[k][1],hi[k][2],hi[k][3]}
    o[d0]=__builtin_amdgcn_mfma_f32_32x32x16_bf16(pa0,PK(0),o[d0],0,0,0);
    o[d0]=__builtin_amdgcn_mfma_f32_32x32x16_bf16(pa1,PK(1),o[d0],0,0,0);
    o[d0]=__builtin_amdgcn_mfma_f32_32x32x16_bf16(pa2,PK(2),o[d0],0,0,0);
    o[d0]=__builtin_amdgcn_mfma_f32_32x32x16_bf16(pa3,PK(3),o[d0],0,0,0);
    #undef PK
  }
}

#ifndef ATTN_STORE16
#define ATTN_STORE16(p,v) (*(u32x4*)(p)=(v))
#endif
template<int THRL,bool STAT> __device__ __forceinline__ void attn_unit(float mstat,int q0,const bf16*Q,const bf16*__restrict__ K,const bf16*__restrict__ V,bf16*O,char*shm,const bf16*O1,float lam,const float*subg,unsigned short*CAo){
  int tid_=threadIdx.x; asm volatile("":"+v"(tid_));
  const int tid=tid_,lane=tid&63,r32=lane&31,hi=lane>>5; const int wid=__builtin_amdgcn_readfirstlane(tid>>6);
  const bf16*Qw=Q+(long)(q0+wid*QBLK)*QP;
  const bf16*Kh=K,*Vh=V;
  const unsigned lds0=(unsigned)(uintptr_t)shm;
  float*wsf=(float*)(shm+LDS_WS)+wid*64;
  const bf16*ksrc=Kh+(long)lane*KP+wid*8;
  const bf16*vsrc=Vh+(long)(16*(wid&3)+(lane>>2))*VP+(wid>>2)*32+(lane&3)*8;
  const unsigned kdst=lds0+LDS_K+wid*1024, vdst=lds0+LDS_V+wid*1024;
  #define DMA_K(t,slot) glds16(ksrc+(long)(t)*KVBLK*KP,(unsigned)__builtin_amdgcn_readfirstlane(kdst+(slot)))
  #define DMA_V(t,slot) do{ glds16(vsrc+(long)(t)*KVBLK*VP,(unsigned)__builtin_amdgcn_readfirstlane(vdst+2*(slot))); glds16(vsrc+(long)(t)*KVBLK*VP+64,(unsigned)__builtin_amdgcn_readfirstlane(vdst+2*(slot)+8192)); }while(0)
  const int vb0=(int)(lds0+LDS_V)+((lane>>4)&1)*32+(lane&3)*8+(4*hi+((lane&15)>>2))*64;
  const char*Kbase=shm+LDS_K; bf16x8 kf[8];
  const lds_cptr shm3=(lds_cptr)shm; const lds_cptr kp0=shm3+LDS_K+hi*1024+r32*16; const lds_cptr vp0=shm3+LDS_V+((lane>>4)&1)*32+(lane&3)*8+(4*hi+((lane&15)>>2))*64;
  const int NT=(q0+QB)/KVBLK;
  DMA_K(0,0);DMA_V(0,0);DMA_K(1,SLOTB);
  bf16x8 qr[4];
  #pragma unroll
  for(int d0=0;d0<4;++d0)qr[d0]=*reinterpret_cast<const bf16x8*>(&Qw[(long)r32*QP+d0*16+hi*8]);
  float mhat=0.f,l_reg=0.f;f32x16 o[4];{float zz=0.f;asm volatile("":"+v"(zz));
  #pragma unroll
  for(int r=0;r<16;++r){o[0][r]=zz;o[1][r]=zz;o[2][r]=zz;o[3][r]=zz;}}
  f32x16 negm;{float zn=0.f;asm volatile("":"+v"(zn));
  #pragma unroll
  for(int r=0;r<16;++r)negm[r]=zn;}
  asm volatile("":"+v"(negm));
  const int qrel=wid*QBLK+r32;
  #define CMASK(P0,P1,t) do{int jb_=(t)-(NT-4); if(jb_>=0)cmask(P0,P1,jb_,qrel,hi);}while(0)
  bool resc=false;
  #define START(P0,P1) do{ float rm; if constexpr (STAT) rm=mstat; else rm=rowmax(P0,P1); resc=false; \
    { const float dl=rm; mhat=fadd_s(mhat,dl); \
      _Pragma("unroll") for(int r=0;r<16;++r){P0[r]=fsub_s(P0[r],dl);P1[r]=fsub_s(P1[r],dl);} \
      _Pragma("unroll") for(int r=0;r<16;++r)negm[r]=-mhat; asm volatile("":"+v"(negm)); } \
    _Pragma("unroll") for(int r=0;r<16;++r)P0[r]=__builtin_amdgcn_exp2f(P0[r]); }while(0)
  #define RESC() do{ if(resc){ asm volatile("s_waitcnt lgkmcnt(0)":::"memory"); \
      _Pragma("unroll") for(int d_=0;d_<4;++d_) _Pragma("unroll") for(int r=0;r<16;++r)o[d_][r]*=wsf[crow(r,hi)]; } }while(0)
  f32x16 pA0,pA1,pB0,pB1;
  int sl_prev=0,sl_cur=0,sl_next=SLOTB;
  #define ROT() do{sl_prev=sl_cur;sl_cur=sl_next;sl_next=(sl_next==(NSLOT-1)*SLOTB)?0:sl_next+SLOTB;}while(0)
  DMA_K(2,2*SLOTB);
  WAIT_BAR(4);
  qkt(pA0,pA1,Kbase,qr,negm,r32,hi);asm volatile("s_nop 15\n\ts_nop 7":"+v"(pA0),"+v"(pA1));CMASK(pA0,pA1,0);
  START(pA0,pA1);
  _Pragma("unroll") for(int r=0;r<16;++r)pA1[r]=__builtin_amdgcn_exp2f(pA1[r]);
  WAIT_BAR(0);
  DMA_K(3,0);DMA_V(1,SLOTB);
  ROT();
  kload8(kf,kp0+sl_cur);
  WAIT_BAR(3);
  s16x4 vlo[8],vhi[8]; u32x4 pw0,pw1,pw2,pw3;
  #define PKW(P,B) cvtpk_s(P[B],P[B+1])
  #define PAF(k) __builtin_bit_cast(bf16x8,pw##k)
  #define VFR(i) (bf16x8){vlo[i][0],vlo[i][1],vlo[i][2],vlo[i][3],vhi[i][0],vhi[i][1],vhi[i][2],vhi[i][3]}
  #define PIN(x) asm volatile("":"+v"(x))
  #define MX3(a,b,c) __builtin_fmaxf(__builtin_fmaxf((a),(b)),(c))
  #define GAPA(MF,A0,A1,A2,A3,W0,W1,PW) do{ MF; sacc+=A0; sacc+=A1; sacc+=A2; sacc+=A3; PIN(sacc); W0; W1; PIN(PW); SBAR(); }while(0)
  #define EX(v) __builtin_amdgcn_exp2f(v)
  #define GAPB2(MF,X,B) do{ MF; X[B]=EX(X[B]); X[B+1]=EX(X[B+1]); PIN(X); SBAR(); }while(0)
  #define VRD2(i) do{ vlo[i]=vtr(vp_+((((i)>>2)+2)*4096+((i)&3)*1024)); vhi[i]=vtr(vp_+((((i)>>2)+2)*4096+((i)&3)*1024+512)); }while(0)
  #define VRD(i) do{ vlo[i]=vtr(vp_+(((i)>>2)*4096+((i)&3)*1024)); vhi[i]=vtr(vp_+(((i)>>2)*4096+((i)&3)*1024+512)); }while(0)
  #define KRD(G,j) do{ if(G){ kload2(kf,kp0+sl_next,j); SBAR(); } }while(0)
  #define STEP(C0,C1,P0,P1,t,GK,GV,GL) do{ SBAR(); \
    const lds_cptr vp_=vp0+2*sl_prev; \
    VRD(0); SBAR(); float sacc=(P0[0]+P0[1]); \
    GAPA(C0=__builtin_amdgcn_mfma_f32_32x32x16_bf16(kf[0],qr[0],negm,0,0,0), P0[2],P0[3],P0[4],P0[5],     pw0[0]=PKW(P0,0), pw0[1]=PKW(P0,2), pw0); \
    VRD(4); SBAR(); GAPA(C1=__builtin_amdgcn_mfma_f32_32x32x16_bf16(kf[1],qr[0],negm,0,0,0), P0[6],P0[7],P0[8],P0[9],     pw0[2]=PKW(P0,4), pw0[3]=PKW(P0,6), pw0); \
    VRD(1); SBAR(); GAPA(C0=__builtin_amdgcn_mfma_f32_32x32x16_bf16(kf[2],qr[1],C0,0,0,0),   P0[10],P0[11],P0[12],P0[13], pw1[0]=PKW(P0,8), pw1[1]=PKW(P0,10), pw1); \
    VRD(5); SBAR(); GAPA(C1=__builtin_amdgcn_mfma_f32_32x32x16_bf16(kf[3],qr[1],C1,0,0,0),   P0[14],P0[15],P1[0],P1[1],   pw1[2]=PKW(P0,12),pw1[3]=PKW(P0,14), pw1); \
    VRD(2); SBAR(); GAPA(C0=__builtin_amdgcn_mfma_f32_32x32x16_bf16(kf[4],qr[2],C0,0,0,0),   P1[2],P1[3],P1[4],P1[5],     pw2[0]=PKW(P1,0), pw2[1]=PKW(P1,2), pw2); \
    VRD(6); SBAR(); GAPA(C1=__builtin_amdgcn_mfma_f32_32x32x16_bf16(kf[5],qr[2],C1,0,0,0),   P1[6],P1[7],P1[8],P1[9],     pw2[2]=PKW(P1,4), pw2[3]=PKW(P1,6), pw2); \
    VRD(3); SBAR(); GAPA(C0=__builtin_amdgcn_mfma_f32_32x32x16_bf16(kf[6],qr[3],C0,0,0,0),   P1[10],P1[11],P1[12],P1[13], pw3[0]=PKW(P1,8), pw3[1]=PKW(P1,10), pw3); \
    VRD(7); SBAR(); GAPA(C1=__builtin_amdgcn_mfma_f32_32x32x16_bf16(kf[7],qr[3],C1,0,0,0),   P1[14],P1[15],0.f,0.f,       pw3[2]=PKW(P1,12),pw3[3]=PKW(P1,14), pw3); \
    l_reg+=sacc; \
    if(GK){DMA_K((t)+3,sl_cur);} if(GV){DMA_V((t)+1,sl_next);} \
    CMASK(C0,C1,t); \
    if constexpr (!STAT) { float a=MX3(C0[0],C0[1],C1[0]),b=MX3(C0[2],C0[3],C1[1]); a=MX3(a,C1[2],C1[3]); \
      _Pragma("unroll") for(int r=4;r<16;r+=4){a=MX3(a,C0[r],C0[r+1]);b=MX3(b,C0[r+2],C0[r+3]);a=MX3(a,C1[r],C1[r+1]);b=MX3(b,C1[r+2],C1[r+3]);} \
      float rm=__builtin_fmaxf(a,b); { auto rr=__builtin_amdgcn_permlane32_swap(__float_as_uint(rm),__float_as_uint(rm),false,false); rm=__builtin_fmaxf(__uint_as_float(rr[0]),__uint_as_float(rr[1])); } \
      resc=false; \
      if(__builtin_expect(__any(rm>(float)THRL),0)){ const float dl=__builtin_fmaxf(rm,0.f); mhat+=dl; \
        _Pragma("unroll") for(int r=0;r<16;++r){C0[r]-=dl;C1[r]-=dl;} \
        _Pragma("unroll") for(int r=0;r<16;++r)negm[r]=-mhat; asm volatile("":"+v"(negm)); \
        const float f=__builtin_amdgcn_exp2f(-dl); l_reg*=f; if(hi==0)wsf[r32]=f; resc=true; } } \
    SBAR(); \
    GAPB2(o[0]=__builtin_amdgcn_mfma_f32_32x32x16_bf16(PAF(0),VFR(0),o[0],0,0,0), C0,0);  VRD2(0); SBAR(); \
    GAPB2(o[1]=__builtin_amdgcn_mfma_f32_32x32x16_bf16(PAF(0),VFR(4),o[1],0,0,0), C0,2);  VRD2(4); SBAR(); \
    GAPB2(o[0]=__builtin_amdgcn_mfma_f32_32x32x16_bf16(PAF(1),VFR(1),o[0],0,0,0), C0,4);  VRD2(1); SBAR(); \
    GAPB2(o[1]=__builtin_amdgcn_mfma_f32_32x32x16_bf16(PAF(1),VFR(5),o[1],0,0,0), C0,6);  VRD2(5); SBAR(); \
    GAPB2(o[0]=__builtin_amdgcn_mfma_f32_32x32x16_bf16(PAF(2),VFR(2),o[0],0,0,0), C0,8);  VRD2(2); SBAR(); \
    GAPB2(o[1]=__builtin_amdgcn_mfma_f32_32x32x16_bf16(PAF(2),VFR(6),o[1],0,0,0), C0,10); VRD2(6); SBAR(); \
    GAPB2(o[0]=__builtin_amdgcn_mfma_f32_32x32x16_bf16(PAF(3),VFR(3),o[0],0,0,0), C0,12); VRD2(3); SBAR(); \
    GAPB2(o[1]=__builtin_amdgcn_mfma_f32_32x32x16_bf16(PAF(3),VFR(7),o[1],0,0,0), C0,14); VRD2(7); SBAR(); \
    GAPB2(o[2]=__builtin_amdgcn_mfma_f32_32x32x16_bf16(PAF(0),VFR(0),o[2],0,0,0), C1,0); \
    GAPB2(o[3]=__builtin_amdgcn_mfma_f32_32x32x16_bf16(PAF(0),VFR(4),o[3],0,0,0), C1,2); \
    KRD(GL,0); GAPB2(o[2]=__builtin_amdgcn_mfma_f32_32x32x16_bf16(PAF(1),VFR(1),o[2],0,0,0), C1,4); \
    KRD(GL,1); GAPB2(o[3]=__builtin_amdgcn_mfma_f32_32x32x16_bf16(PAF(1),VFR(5),o[3],0,0,0), C1,6); \
    KRD(GL,2); GAPB2(o[2]=__builtin_amdgcn_mfma_f32_32x32x16_bf16(PAF(2),VFR(2),o[2],0,0,0), C1,8); \
    KRD(GL,3); GAPB2(o[3]=__builtin_amdgcn_mfma_f32_32x32x16_bf16(PAF(2),VFR(6),o[3],0,0,0), C1,10); \
    GAPB2(o[2]=__builtin_amdgcn_mfma_f32_32x32x16_bf16(PAF(3),VFR(3),o[2],0,0,0), C1,12); \
    GAPB2(o[3]=__builtin_amdgcn_mfma_f32_32x32x16_bf16(PAF(3),VFR(7),o[3],0,0,0), C1,14); \
    }while(0)
  int t=1;
  #undef CMASK
  #define CMASK(P0,P1,t) do{}while(0)
  for(;t+5<NT;t+=2){
    STEP(pB0,pB1,pA0,pA1,t,true,true,true);     WAIT_BAR(3); RESC(); ROT();
    STEP(pA0,pA1,pB0,pB1,t+1,true,true,true);   WAIT_BAR(3); RESC(); ROT();
  }
  #undef CMASK
  #define CMASK(P0,P1,t) do{int jb_=(t)-(NT-4); if(jb_>=0)cmask(P0,P1,jb_,qrel,hi);}while(0)
  #define ENDW(tt) do{ if((tt)+3<NT){WAIT_BAR(3);} else if((tt)+2<NT){WAIT_BAR(2);} else {WAIT_BAR(0);} }while(0)
  for(;t+1<NT;t+=2){
    STEP(pB0,pB1,pA0,pA1,t,(t+3<NT),(t+1<NT),(t+1<NT));       ENDW(t);   RESC(); ROT();
    STEP(pA0,pA1,pB0,pB1,t+1,(t+4<NT),(t+2<NT),(t+2<NT));     ENDW(t+1); RESC(); ROT();
  }
  STEP(pB0,pB1,pA0,pA1,NT-1,false,false,false); RESC();
  { float sacc=pB0[0]+pB0[1]; _Pragma("unroll") for(int r=2;r<16;++r)sacc+=pB0[r]; _Pragma("unroll") for(int r=0;r<16;++r)sacc+=pB1[r]; l_reg+=sacc;
    pw0=(u32x4){PKW(pB0,0),PKW(pB0,2),PKW(pB0,4),PKW(pB0,6)};pw1=(u32x4){PKW(pB0,8),PKW(pB0,10),PKW(pB0,12),PKW(pB0,14)};pw2=(u32x4){PKW(pB1,0),PKW(pB1,2),PKW(pB1,4),PKW(pB1,6)};pw3=(u32x4){PKW(pB1,8),PKW(pB1,10),PKW(pB1,12),PKW(pB1,14)};
    SBAR(); pv(o,vb0+2*sl_cur,PAF(0),PAF(1),PAF(2),PAF(3)); }
  #undef PKW
  #undef PAF
  #undef VFR
  #undef PIN
  #undef MX3
  #undef GAPA
  #undef GAPB2
  #undef VRD2
  #undef EX
  #undef VRD
  #undef KRD
  #undef STEP
  #undef ENDW
  {auto rr=__builtin_amdgcn_permlane32_swap(__float_as_uint(l_reg),__float_as_uint(l_reg),false,false);l_reg=__uint_as_float(rr[0])+__uint_as_float(rr[1]);}
  if(hi==0)wsf[32+r32]=l_reg;asm volatile("s_waitcnt lgkmcnt(0)":::"memory");
  float rli[16];
  #pragma unroll
  for(int r=0;r<16;++r)rli[r]=__builtin_amdgcn_rcpf(wsf[32+crow(r,hi)]);
  bf16*Ow=O+(long)(q0+wid*QBLK)*OP;
  bf16*stg=(bf16*)(shm+LDS_OST)+wid*2048;
  if(O1==nullptr){
    #pragma unroll
    for(int hf=0;hf<2;++hf){
      #pragma unroll
      for(int r=0;r<16;++r){const int orow=crow(r,hi);
        #pragma unroll
        for(int d0=0;d0<2;++d0)stg[orow*64+d0*32+r32]=__float2bfloat16(o[2*hf+d0][r]*rli[r]);}
      asm volatile("s_waitcnt lgkmcnt(0)":::"memory");
      #pragma unroll
      for(int i=0;i<4;++i){const int row=i*8+(lane>>3),ch=lane&7; const u32x4 v=*(const u32x4*)(stg+row*64+ch*8); ATTN_STORE16(Ow+(long)row*OP+hf*64+ch*8,v);}
      asm volatile("s_waitcnt lgkmcnt(0)":::"memory"); }
  } else {
    const bf16*O1w=O1+(long)(q0+wid*QBLK)*OP; unsigned long long p1[2][4][2];
    #pragma unroll
    for(int hf=0;hf<2;++hf)
      #pragma unroll
      for(int i=0;i<4;++i){const int row=i*8+(lane>>3),ch=lane&7; unsigned long long*a=(unsigned long long*)(O1w+(long)row*OP+hf*64+ch*8);
        p1[hf][i][0]=__hip_atomic_load(a,__ATOMIC_RELAXED,__HIP_MEMORY_SCOPE_AGENT); p1[hf][i][1]=__hip_atomic_load(a+1,__ATOMIC_RELAXED,__HIP_MEMORY_SCOPE_AGENT);}
    float dd[2][4][8]; float ssp[4]={0.f,0.f,0.f,0.f};
    #pragma unroll
    for(int hf=0;hf<2;++hf){
      #pragma unroll
      for(int r=0;r<16;++r){const int orow=crow(r,hi);
        #pragma unroll
        for(int d0=0;d0<2;++d0)stg[orow*64+d0*32+r32]=__float2bfloat16(o[2*hf+d0][r]*rli[r]);}
      asm volatile("s_waitcnt lgkmcnt(0)":::"memory");
      #pragma unroll
      for(int i=0;i<4;++i){const int row=i*8+(lane>>3),ch=lane&7; const u32x4 v=*(const u32x4*)(stg+row*64+ch*8);
        const unsigned w1[4]={(unsigned)p1[hf][i][0],(unsigned)(p1[hf][i][0]>>32),(unsigned)p1[hf][i][1],(unsigned)(p1[hf][i][1]>>32)};
        #pragma unroll
        for(int j=0;j<4;++j){ const float a0=__uint_as_float(w1[j]<<16)-lam*__uint_as_float(v[j]<<16), a1=__uint_as_float(w1[j]&0xffff0000u)-lam*__uint_as_float(v[j]&0xffff0000u);
          dd[hf][i][2*j]=a0; dd[hf][i][2*j+1]=a1; ssp[i]+=a0*a0+a1*a1; } }
      asm volatile("s_waitcnt lgkmcnt(0)":::"memory"); }
    #pragma unroll
    for(int i=0;i<4;++i){ float ss=ssp[i]; ss+=__shfl_xor(ss,1); ss+=__shfl_xor(ss,2); ss+=__shfl_xor(ss,4);
      const float rn=1.0f/sqrtf(ss*(1.0f/128.0f)+1e-6f)*0.8f;
      const int row=i*8+(lane>>3),ch=lane&7;
      #pragma unroll
      for(int hf=0;hf<2;++hf){ const float*gp=subg+hf*64+ch*8; u32x4 w;
        w[0]=cvtpk_s(dd[hf][i][0]*rn*gp[0],dd[hf][i][1]*rn*gp[1]); w[1]=cvtpk_s(dd[hf][i][2]*rn*gp[2],dd[hf][i][3]*rn*gp[3]);
        w[2]=cvtpk_s(dd[hf][i][4]*rn*gp[4],dd[hf][i][5]*rn*gp[5]); w[3]=cvtpk_s(dd[hf][i][6]*rn*gp[6],dd[hf][i][7]*rn*gp[7]);
        *(u32x4*)(CAo+(long)(q0+wid*QBLK+row)*1024+hf*64+ch*8)=w; } }
  }
  asm volatile("s_waitcnt lgkmcnt(0)\n\ts_barrier":::"memory");
  #undef DMA_K
  #undef DMA_V
  #undef CMASK
  #undef START
  #undef RESC
  #undef ROT
}
constexpr int ATTN_LDS_BYTES=LDS_BYTES;
#undef SBAR
#undef WAIT_BAR
}

constexpr int NWAVES = 8, NTHREADS = NWAVES * 64;
#ifndef MK_PER_PHASE
#define MK_PER_PHASE 0
#endif
#ifndef RUN_PHASES
#define RUN_PHASES 8
#endif
constexpr int N_PHASES = RUN_PHASES;

constexpr size_t MiB = 1u << 20;
constexpr size_t WS_CTL = 0, CTL_ZERO_BYTES = 65536;
constexpr size_t WS_RS = 1 * MiB;
constexpr size_t WS_TINFO = 2 * MiB;
constexpr size_t WS_WR = 3 * MiB;
constexpr size_t WS_LTOK = 4 * MiB, WS_LW = 8 * MiB;
constexpr size_t WS_WIN = 16 * MiB, WS_WCA = 25 * MiB, WS_WOUT = 27 * MiB;
constexpr size_t WS_A = 32 * MiB;
constexpr size_t WS_QB = 112 * MiB, WS_KB = 144 * MiB, WS_VB = 176 * MiB, WS_YG = 208 * MiB;
constexpr size_t WS_MG = 112 * MiB, WS_XM = 176 * MiB;
constexpr size_t WS_GT = 240 * MiB;
constexpr size_t WS_WGU = 240 * MiB, WS_WD = 304 * MiB;
constexpr size_t WS_CA = 368 * MiB;
constexpr size_t WS_YB = 112 * MiB;
constexpr size_t WS_LIST = 432 * MiB;
constexpr size_t WS_CTOK = 448 * MiB;
constexpr size_t WS_END = 464 * MiB;
static_assert(WS_A + (size_t)CROWS * 1024 <= WS_QB && WS_WD + (size_t)NEXP * 1024 * 512 <= WS_CA, "d_ws map");
static_assert(WS_WIN + (size_t)IN_COLS * 1024 * 2 <= WS_WCA, "d_ws map");

constexpr int RING_BYTES = 131072;
constexpr int META_OFF = RING_BYTES;
constexpr int HIST_OFF = RING_BYTES + 1024;
constexpr int BARST_OFF = RING_BYTES + 3072;
constexpr int META2_OFF = RING_BYTES + 4096;
constexpr int LDS_BYTES = 147456;

#define GAS __attribute__((address_space(1)))
#define LAS __attribute__((address_space(3)))
typedef unsigned short bf16;
typedef unsigned v4u __attribute__((ext_vector_type(4)));
typedef unsigned v2u __attribute__((ext_vector_type(2)));
typedef float f32x4 __attribute__((ext_vector_type(4)));
typedef float f32x16 __attribute__((ext_vector_type(16)));
typedef short bf16x8 __attribute__((ext_vector_type(8)));
using pg8::cvt_pk_bf16; using pg8::bf_lo; using pg8::bf_hi; using pg8::sigmoidf_fast; using pg8::pack8; using pg8::unpack8;

__device__ __forceinline__ float wave_sum(float v) {
#pragma unroll
    for (int o = 1; o < 64; o <<= 1) v += __shfl_xor(v, o);
    return v;
}
__device__ __forceinline__ float bf16_round(float x) { return bf_lo(cvt_pk_bf16(x, 0.f) & 0xffffu); }

#define XB_TMO      128
#define XB_XCNT(j)  (256  + 64 * (j))
#define XB_XSUB(j)  (1280 + 64 * (j))
#define XB_XGEN(j)  (2304 + 64 * (j))
#define XB_TOP      3328
#define XB_TOPGEN   3392
#define XCD_BAR_WORDS 3456
#define XB_SPIN_CAP (1u << 18)

__device__ __forceinline__ unsigned xb_ld(unsigned* p)              { return __hip_atomic_load(p, __ATOMIC_RELAXED, __HIP_MEMORY_SCOPE_AGENT); }
__device__ __forceinline__ unsigned xb_add(unsigned* p, unsigned v) { return __hip_atomic_fetch_add(p, v, __ATOMIC_RELAXED, __HIP_MEMORY_SCOPE_AGENT); }
__device__ __forceinline__ unsigned xb_xcc_id() { return (unsigned)__builtin_amdgcn_s_getreg((3 << 11) | 20) & 0xFu; }
#define XB_SPIN(cond, bar) do { unsigned _sp = 0; while (cond) { __builtin_amdgcn_s_sleep(1); \
    if ((++_sp & 255u) == 0u) { if (xb_ld(&(bar)[XB_TMO])) break; if (_sp > XB_SPIN_CAP) { atomicAdd(&(bar)[XB_TMO], 1u); break; } } } } while (0)

struct XcdBarrier {
    unsigned* bar; unsigned x;
    volatile LAS unsigned* st;
};

__device__ __forceinline__ XcdBarrier xcd_barrier_post(unsigned* bar, volatile LAS unsigned* st) {
    XcdBarrier b; b.bar = bar; b.x = xb_xcc_id(); b.st = st;
    if (threadIdx.x == 0) (void)xb_add(&bar[XB_XCNT(b.x)], 1u);
    return b;
}
__device__ __forceinline__ void xcd_barrier_complete(unsigned* bar, unsigned x, unsigned& nloc, unsigned& nx) {
    const unsigned G = gridDim.x * gridDim.y * gridDim.z;
    unsigned sum, cnt, mine, sp = 0u;
    for (;;) {
        sum = 0u; cnt = 0u; mine = 0u;
#pragma unroll
        for (unsigned j = 0; j < 16; ++j) { const unsigned c = xb_ld(&bar[XB_XCNT(j)]); sum += c; cnt += (c > 0u) ? 1u : 0u; mine = (j == x) ? c : mine; }
        if (sum == G) break;
        __builtin_amdgcn_s_sleep(1);
        if ((++sp & 255u) == 0u) { if (xb_ld(&bar[XB_TMO])) break; if (sp > XB_SPIN_CAP) { atomicAdd(&bar[XB_TMO], 1u); break; } }
    }
    nloc = mine > 0u ? mine : 1u; nx = cnt > 0u ? cnt : 1u;
}

__device__ __forceinline__ void xcd_barrier(const XcdBarrier& b) {
    asm volatile("s_waitcnt vmcnt(0)" ::: "memory");
    __syncthreads();
    if (threadIdx.x == 0) {
        unsigned* bar = b.bar;
        __builtin_amdgcn_s_waitcnt(0);
        unsigned nloc = b.st[0], nx = b.st[1];
        if (nloc == 0u) { xcd_barrier_complete(bar, b.x, nloc, nx); b.st[0] = nloc; b.st[1] = nx; }
        const unsigned old = xb_add(&bar[XB_XSUB(b.x)], 1u);
        const unsigned gen = old / nloc;
        if (old + 1u == (gen + 1u) * nloc) {
            __builtin_amdgcn_fence(__ATOMIC_RELEASE, "agent");
            asm volatile("s_waitcnt vmcnt(0)" ::: "memory");
            const unsigned og = xb_add(&bar[XB_TOP], 1u);
            const unsigned tg = og / nx;
            if (og + 1u == (tg + 1u) * nx) xb_add(&bar[XB_TOPGEN], 1u);
            else XB_SPIN(xb_ld(&bar[XB_TOPGEN]) == tg, bar);
            __builtin_amdgcn_fence(__ATOMIC_ACQUIRE, "agent");
            xb_add(&bar[XB_XGEN(b.x)], 1u);
            asm volatile("s_waitcnt vmcnt(0)" ::: "memory");
        } else {
            XB_SPIN(xb_ld(&bar[XB_XGEN(b.x)]) == gen, bar);
            __builtin_amdgcn_fence(__ATOMIC_ACQUIRE, "agent");
            asm volatile("s_waitcnt vmcnt(0)" ::: "memory");
        }
    }
    __syncthreads();
}


typedef f32x4 AccT[2][2][4][2];
struct EpiInProj {
    static constexpr bool MID = false;
    bf16 *YG, *QB, *KB, *VB, *GT; const LAS float* gl;
    __device__ __forceinline__ void mid(AccT&, const pg8::Unit&, int, int, int, int) const {}
    __device__ __forceinline__ void operator()(AccT& acc, const pg8::Unit& u, int wr, int wc, int fr, int fq) const {
        asm volatile("" : "+v"(fr), "+v"(fq));
        const int pn = u.pn; const size_t row0 = (size_t)u.orow + wr * 64 + fr;
        if (pn < 4) {
#pragma unroll
            for (int ai = 0; ai < 2; ++ai)
#pragma unroll
                for (int m = 0; m < 4; ++m) { const size_t row = row0 + ai * 128 + m * 16; f32x4 y[2];
#pragma unroll
                    for (int n = 0; n < 2; ++n) { const f32x4 a = acc[ai][0][m][n], g = acc[ai][1][m][n];
                        y[n] = (f32x4){a[0] * sigmoidf_fast(g[0]), a[1] * sigmoidf_fast(g[1]), a[2] * sigmoidf_fast(g[2]), a[3] * sigmoidf_fast(g[3])}; }
                    __builtin_nontemporal_store(pack8(y[0], y[1]), (v4u*)(YG + row * 512 + pn * 128 + wc * 32 + 8 * fq)); }
        } else if (pn < 8) {
            const bool isq = pn < 6; bf16* base = isq ? QB : KB; const LAS float* gp = gl + (isq ? 0 : 64); const float sc = isq ? 0.125f * 1.4426950408889634f : 1.0f;
            f32x4 gv[2][2];
#pragma unroll
            for (int bj = 0; bj < 2; ++bj)
#pragma unroll
                for (int n = 0; n < 2; ++n) gv[bj][n] = *(const LAS f32x4*)(gp + 32 * bj + 8 * fq + 4 * n) * sc;
#pragma unroll
            for (int ai = 0; ai < 2; ++ai)
#pragma unroll
                for (int m = 0; m < 4; ++m) { const size_t row = row0 + ai * 128 + m * 16; float ss = 0.f;
#pragma unroll
                    for (int bj = 0; bj < 2; ++bj)
#pragma unroll
                        for (int n = 0; n < 2; ++n) { const f32x4 a = acc[ai][bj][m][n]; ss += (a[0] * a[0] + a[1] * a[1]) + (a[2] * a[2] + a[3] * a[3]); }
                    ss += __shfl_xor(ss, 16); ss += __shfl_xor(ss, 32);
                    const float rinv = 1.0f / sqrtf(ss * (1.0f / 64.0f) + EPS);
#pragma unroll
                    for (int bj = 0; bj < 2; ++bj)
                        __builtin_nontemporal_store(pack8(acc[ai][bj][m][0] * rinv * gv[bj][0], acc[ai][bj][m][1] * rinv * gv[bj][1]), (v4u*)(base + row * 512 + (pn & 1) * 256 + wc * 64 + bj * 32 + 8 * fq)); }
        } else if (pn < 10) {
#pragma unroll
            for (int ai = 0; ai < 2; ++ai)
#pragma unroll
                for (int m = 0; m < 4; ++m) { const size_t row = row0 + ai * 128 + m * 16;
#pragma unroll
                    for (int bj = 0; bj < 2; ++bj) __builtin_nontemporal_store(pack8(acc[ai][bj][m][0], acc[ai][bj][m][1]), (v4u*)(VB + row * 512 + (pn - 8) * 256 + bj * 128 + wc * 32 + 8 * fq)); }
        } else {
#pragma unroll
            for (int ai = 0; ai < 2; ++ai)
#pragma unroll
                for (int m = 0; m < 4; ++m) { const size_t row = row0 + ai * 128 + m * 16; f32x4 rr[2], gg[2];
#pragma unroll
                    for (int n = 0; n < 2; ++n)
#pragma unroll
                        for (int j = 0; j < 4; ++j) { const float e0 = __builtin_amdgcn_exp2f(-1.4426950408889634f * acc[ai][0][m][n][j]), e1 = fminf(__builtin_amdgcn_exp2f(-1.4426950408889634f * acc[ai][1][m][n][j]), 1e30f);
                            gg[n][j] = __builtin_amdgcn_rcpf(1.0f + e1); rr[n][j] = (1.0f + e1) * __builtin_amdgcn_rcpf(1.0f + e0); }
                    const size_t o = row * 1024 + (pn - 10) * 128 + wc * 32 + 8 * fq;
                    __builtin_nontemporal_store(pack8(rr[0], rr[1]), (v4u*)(GT + o)); __builtin_nontemporal_store(pack8(gg[0], gg[1]), (v4u*)(GT + (size_t)NTOK * 1024 + o)); }
        }
    }
};
struct EpiMerged {
    static constexpr bool MID = true;
    const bf16* GR; const bf16* G1; bf16* MG;
    __device__ __forceinline__ void mid(AccT& acc, const pg8::Unit& u, int wr, int wc, int fr, int fq) const {
        asm volatile("" : "+v"(fr), "+v"(fq));
        const size_t row0 = (size_t)u.orow + wr * 64 + fr; const int col0 = u.pn * 256 + wc * 32 + 8 * fq;
        v4u w0[2][4][2];
#pragma unroll
        for (int ai = 0; ai < 2; ++ai)
#pragma unroll
            for (int m = 0; m < 4; ++m)
#pragma unroll
                for (int bj = 0; bj < 2; ++bj) w0[ai][m][bj] = *(const v4u*)(GR + (row0 + ai * 128 + m * 16) * 1024 + col0 + bj * 128);
        __builtin_amdgcn_sched_barrier(0);
#pragma unroll
        for (int ai = 0; ai < 2; ++ai)
#pragma unroll
            for (int m = 0; m < 4; ++m)
#pragma unroll
                for (int bj = 0; bj < 2; ++bj) { f32x4 a0, a1; unpack8(w0[ai][m][bj], a0, a1); acc[ai][bj][m][0] = acc[ai][bj][m][0] * a0; acc[ai][bj][m][1] = acc[ai][bj][m][1] * a1; }
        __builtin_amdgcn_sched_barrier(0);
    }
    __device__ __forceinline__ void operator()(AccT& acc, const pg8::Unit& u, int wr, int wc, int fr, int fq) const {
        asm volatile("" : "+v"(fr), "+v"(fq));
        const size_t row0 = (size_t)u.orow + wr * 64 + fr; const int col0 = u.pn * 256 + wc * 32 + 8 * fq;
        v4u w1[2][4][2];
#pragma unroll
        for (int ai = 0; ai < 2; ++ai)
#pragma unroll
            for (int m = 0; m < 4; ++m)
#pragma unroll
                for (int bj = 0; bj < 2; ++bj) w1[ai][m][bj] = *(const v4u*)(G1 + (row0 + ai * 128 + m * 16) * 1024 + col0 + bj * 128);
        __builtin_amdgcn_sched_barrier(0);
#pragma unroll
        for (int ai = 0; ai < 2; ++ai)
#pragma unroll
            for (int m = 0; m < 4; ++m) { const size_t row = row0 + ai * 128 + m * 16;
#pragma unroll
                for (int bj = 0; bj < 2; ++bj) { f32x4 b0, b1; unpack8(w1[ai][m][bj], b0, b1);
                    *(v4u*)(MG + row * 1024 + col0 + bj * 128) = pack8(acc[ai][bj][m][0] * b0, acc[ai][bj][m][1] * b1); } }
    }
};
struct EpiOut {
    static constexpr bool MID = false;
    const float* x; bf16* XMB; unsigned char* XM8;
    __device__ __forceinline__ void mid(AccT&, const pg8::Unit&, int, int, int, int) const {}
    __device__ __forceinline__ void operator()(AccT& acc, const pg8::Unit& u, int wr, int wc, int fr, int fq) const {
        asm volatile("" : "+v"(fr), "+v"(fq));
        const size_t row0 = (size_t)u.orow + wr * 64 + fr; const int col0 = u.pn * 256 + wc * 32 + 8 * fq;
#pragma unroll
        for (int ai = 0; ai < 2; ++ai) {
            f32x4 xv[4][2][2];
#pragma unroll
            for (int m = 0; m < 4; ++m) { const size_t off = (row0 + ai * 128 + m * 16) * 1024 + col0;
#pragma unroll
                for (int bj = 0; bj < 2; ++bj) { xv[m][bj][0] = __builtin_nontemporal_load((const f32x4*)(x + off + bj * 128)); xv[m][bj][1] = __builtin_nontemporal_load((const f32x4*)(x + off + bj * 128 + 4)); } }
            __builtin_amdgcn_sched_barrier(0);
#pragma unroll
            for (int m = 0; m < 4; ++m) { const size_t off = (row0 + ai * 128 + m * 16) * 1024 + col0;
#pragma unroll
                for (int bj = 0; bj < 2; ++bj) { const f32x4 o0 = xv[m][bj][0] + acc[ai][bj][m][0], o1 = xv[m][bj][1] + acc[ai][bj][m][1];
                    *(v4u*)(XMB + off + bj * 128) = pack8(o0, o1);
                    v2u w8; w8.x = pg8::pack4_fp8(o0[0], o0[1], o0[2], o0[3]); w8.y = pg8::pack4_fp8(o1[0], o1[1], o1[2], o1[3]); *(v2u*)(XM8 + off + bj * 128) = w8; } }
            __builtin_amdgcn_sched_barrier(0);
        }
    }
};
struct EpiGateUp {
    static constexpr bool MID = false;
    const int* LIST; unsigned char* HP8; const LAS int* m2;
    __device__ __forceinline__ void mid(AccT&, const pg8::Unit&, int, int, int, int) const {}
    __device__ __forceinline__ void operator()(AccT& acc, const pg8::Unit& u, int wr, int wc, int fr, int fq) const {
        asm volatile("" : "+v"(fr), "+v"(fq));
        typedef int i32x4 __attribute__((ext_vector_type(4)));
        i32x4 ent[2][4];
#pragma unroll
        for (int ai = 0; ai < 2; ++ai)
#pragma unroll
            for (int m = 0; m < 4; ++m) { const int r = ai * 128 + wr * 64 + m * 16 + fr; ent[ai][m] = (r < u.nvalid) ? *(const i32x4*)(LIST + (size_t)(u.lrow + r) * 4) : (i32x4){-1, 0, 0, 0}; }
#pragma unroll
        for (int ai = 0; ai < 2; ++ai)
#pragma unroll
            for (int m = 0; m < 4; ++m) { const i32x4 en = ent[ai][m]; if (en[0] < 0) continue;
                const float rs = __int_as_float(en[3]) * (1.0f / 64.0f), w8 = __int_as_float(en[2]) * 8.0f;
                const int dst = en[1]; const size_t drow = (size_t)m2[dst >> 17] * 256 + ((dst >> 1) & 0xffff);
                float h[8];
#pragma unroll
                for (int n = 0; n < 2; ++n)
#pragma unroll
                    for (int j = 0; j < 4; ++j) { const float g = acc[ai][0][m][n][j] * rs, up = acc[ai][1][m][n][j] * rs; h[4 * n + j] = __builtin_amdgcn_fmed3f(g * sigmoidf_fast(g) * up * w8, -448.f, 448.f); }
                v2u o8; o8.x = pg8::pack4_fp8(h[0], h[1], h[2], h[3]); o8.y = pg8::pack4_fp8(h[4], h[5], h[6], h[7]);
                *(v2u*)(HP8 + drow * 1024 + (dst & 1) * 512 + u.pn * 128 + wc * 32 + 8 * fq) = o8; }
    }
};
struct EpiDownAdd {
    static constexpr bool MID = false;
    const int* CTOK; const bf16* XMB; float* out;
    __device__ __forceinline__ void mid(AccT&, const pg8::Unit&, int, int, int, int) const {}
    __device__ __forceinline__ void operator()(AccT& acc, const pg8::Unit& u, int wr, int wc, int fr, int fq) const {
        asm volatile("" : "+v"(fr), "+v"(fq));
        const int col0 = u.pn * 256 + wc * 32 + 8 * fq;
        int tokall[2][4];
#pragma unroll
        for (int ai = 0; ai < 2; ++ai)
#pragma unroll
            for (int m = 0; m < 4; ++m) { const int r = ai * 128 + wr * 64 + m * 16 + fr; tokall[ai][m] = (r < u.nvalid) ? CTOK[u.lrow + r] : -1; }
#pragma unroll
        for (int ai = 0; ai < 2; ++ai) {
            int tok[4];
#pragma unroll
            for (int m = 0; m < 4; ++m) tok[m] = tokall[ai][m];
            v4u xw[4][2];
#pragma unroll
            for (int m = 0; m < 4; ++m) { const size_t off = (size_t)(tok[m] < 0 ? 0 : tok[m]) * 1024 + col0;
#pragma unroll
                for (int bj = 0; bj < 2; ++bj) xw[m][bj] = *(const v4u*)(XMB + off + bj * 128); }
            __builtin_amdgcn_sched_barrier(0);
#pragma unroll
            for (int m = 0; m < 4; ++m) { if (tok[m] < 0) continue; const size_t off = (size_t)tok[m] * 1024 + col0;
#pragma unroll
                for (int bj = 0; bj < 2; ++bj) { f32x4 x0, x1; unpack8(xw[m][bj], x0, x1);
                    __builtin_nontemporal_store(x0 + acc[ai][bj][m][0] * (1.0f / 256.0f), (f32x4*)(out + off + bj * 128)); __builtin_nontemporal_store(x1 + acc[ai][bj][m][1] * (1.0f / 256.0f), (f32x4*)(out + off + bj * 128 + 4)); } }
            __builtin_amdgcn_sched_barrier(0);
        }
    }
};
struct MoeOrder {
    int G, c, total; const LAS int* meta;
    __device__ __forceinline__ bool next(int i, pg8::Unit& u) const {
        const int L = i * G + c; if (L >= total * 4) return false;
        const int blk = L >> 2, lane = threadIdx.x & 63;
        const int e = __builtin_amdgcn_readfirstlane(__builtin_popcountll(__ballot(lane < NEXP - 1 && meta[1 + lane] <= blk)));
        const int pre = __builtin_amdgcn_readfirstlane(meta[e]), cnt = __builtin_amdgcn_readfirstlane(meta[64 + e]); const int rb = blk - pre;
        u.pn = L & 3; u.pm = rb; u.e = e; u.e2 = e; u.lrow = e * LCAP + rb * 256; u.nvalid = min(256, cnt - rb * 256); u.orow = blk * 256; u.arow = 0; return true;
    }
};
struct ClassOrder {
    int G, c, total; const LAS int* m2;
    __device__ __forceinline__ bool next(int i, pg8::Unit& u) const {
        const int L = i * G + c; if (L >= total * 4) return false;
        const int blk = L >> 2, lane = threadIdx.x & 63;
        const int n0 = __builtin_popcountll(__ballot(m2[1 + lane] <= blk)), n1 = __builtin_popcountll(__ballot(lane + 65 <= NCLS - 1 && m2[65 + lane] <= blk));
        const int cls = __builtin_amdgcn_readfirstlane(n0 + n1);
        const int pre = __builtin_amdgcn_readfirstlane(m2[cls]), cnt = __builtin_amdgcn_readfirstlane(m2[128 + cls]); const int rb = blk - pre;
        const int g = cls / 28; int p = cls % 28, a = 0;
        while (p >= 7 - a) { p -= 7 - a; ++a; }
        u.e = g * 8 + a; u.e2 = g * 8 + a + 1 + p; u.pn = L & 3; u.pm = rb; u.lrow = cls * NTOK + rb * 256; u.nvalid = min(256, cnt - rb * 256); u.orow = blk * 256; u.arow = u.orow; return true;
    }
};
__device__ __forceinline__ void moe_meta(LAS int* meta, LAS int* m2, const unsigned* ctl) {
    const int tid = threadIdx.x;
    if (tid < NEXP) meta[64 + tid] = (int)__hip_atomic_load(ctl + tid, __ATOMIC_RELAXED, __HIP_MEMORY_SCOPE_AGENT);
    if (tid >= 64 && tid < 64 + NCLS) m2[128 + tid - 64] = (int)__hip_atomic_load(ctl + tid, __ATOMIC_RELAXED, __HIP_MEMORY_SCOPE_AGENT);
    __syncthreads();
    if (tid == 0) { int p = 0;
        for (int e = 0; e < NEXP; ++e) { meta[e] = p; p += (meta[64 + e] + 255) >> 8; }
        meta[NEXP] = p; }
    if (tid == 64) { int p = 0;
        for (int c = 0; c < NCLS; ++c) { m2[c] = p; p += (m2[128 + c] + 255) >> 8; }
        m2[NCLS] = p; }
    __syncthreads();
}

__device__ __forceinline__ void transpose_item(const float* W, int N, int k0, int n0, bf16* WT, int dpitch, int drow0, int dcol0, const float* kscale, LAS float* scr, int lane) {
    const int kr = lane >> 3, nc = (lane & 7) * 4;
    f32x4 v[8];
#pragma unroll
    for (int i = 0; i < 8; ++i) v[i] = *(const f32x4*)(W + (size_t)(k0 + i * 8 + kr) * N + n0 + nc);
    if (kscale) {
#pragma unroll
        for (int i = 0; i < 8; ++i) v[i] = v[i] * kscale[k0 + i * 8 + kr]; }
#pragma unroll
    for (int i = 0; i < 8; ++i) { LAS float* d = scr + (i * 8 + kr) * 33 + nc; d[0] = v[i][0]; d[1] = v[i][1]; d[2] = v[i][2]; d[3] = v[i][3]; }
    asm volatile("s_waitcnt lgkmcnt(0)" ::: "memory");
    const int c = lane & 7;
#pragma unroll
    for (int j = 0; j < 4; ++j) { const int n = (lane >> 3) + 8 * j; const LAS float* s = scr + (8 * c) * 33 + n;
        v4u o; o.x = cvt_pk_bf16(s[0 * 33], s[1 * 33]); o.y = cvt_pk_bf16(s[2 * 33], s[3 * 33]); o.z = cvt_pk_bf16(s[4 * 33], s[5 * 33]); o.w = cvt_pk_bf16(s[6 * 33], s[7 * 33]);
        *(v4u*)(WT + (size_t)(drow0 + n) * dpitch + dcol0 + k0 + 8 * c) = o; }
    asm volatile("s_waitcnt lgkmcnt(0)" ::: "memory");
}
__device__ __forceinline__ void transpose_item_fp8(const float* W, int N, int k0, int n0, unsigned char* WT, int dpitch, int drow0, const float* kscale, float mul, LAS float* scr, int lane) {
    const int kr = lane >> 3, nc = (lane & 7) * 4;
    f32x4 v[8];
#pragma unroll
    for (int i = 0; i < 8; ++i) v[i] = *(const f32x4*)(W + (size_t)(k0 + i * 8 + kr) * N + n0 + nc);
#pragma unroll
    for (int i = 0; i < 8; ++i) v[i] = v[i] * (kscale ? kscale[k0 + i * 8 + kr] * mul : mul);
#pragma unroll
    for (int i = 0; i < 8; ++i) { LAS float* d = scr + (i * 8 + kr) * 33 + nc; d[0] = v[i][0]; d[1] = v[i][1]; d[2] = v[i][2]; d[3] = v[i][3]; }
    asm volatile("s_waitcnt lgkmcnt(0)" ::: "memory");
    const int c = lane & 7;
#pragma unroll
    for (int j = 0; j < 4; ++j) { const int n = (lane >> 3) + 8 * j; const LAS float* s = scr + (8 * c) * 33 + n;
        v2u o; o.x = pg8::pack4_fp8(s[0 * 33], s[1 * 33], s[2 * 33], s[3 * 33]); o.y = pg8::pack4_fp8(s[4 * 33], s[5 * 33], s[6 * 33], s[7 * 33]);
        *(v2u*)(WT + (size_t)(drow0 + n) * dpitch + k0 + 8 * c) = o; }
    asm volatile("s_waitcnt lgkmcnt(0)" ::: "memory");
}
__device__ __forceinline__ int inproj_phys(int c) {
    if (c < 512) return (c >> 7) * 256 + (c & 127);
    if (c < 1024) { c -= 512; return (c >> 7) * 256 + 128 + (c & 127); }
    if (c < 2048) { const int sec = (c - 1024) >> 8, cl = (c - 1024) & 255, s = cl >> 6, d = cl & 63; return 1024 + sec * 256 + ((d >> 5) << 7) + (s << 5) + (d & 31); }
    if (c < 2560) return c;
    { int j = c - 2560; const int hi = j >= 1024; j &= 1023; return 2560 + (j >> 7) * 256 + hi * 128 + (j & 127); }
}
struct Ptrs {
    const float *x, *attn_norm_g, *w_in, *conv_dw_w, *conv_dw_b, *conv_ln_g, *conv_ln_b, *w_conv_out, *q_norm_g, *k_norm_g, *lq1, *lk1, *lq2, *lk2, *subln_g,
        *w_attn_out, *w_out, *ffn_norm_g, *w_rg, *b_rg, *w_re, *b_re, *w_gate, *w_up, *w_down;
    float* out; unsigned char* ws;
};

__device__ __forceinline__ void p0_prologue(const Ptrs& P, LAS unsigned char* lds, int vcu, int G) {
    const int tid = threadIdx.x, lane = tid & 63, wave = __builtin_amdgcn_readfirstlane(tid >> 6);
    LAS float* scr = (LAS float*)(lds + wave * 16384);
    const int gw = vcu * NWAVES + wave, NGW = G * NWAVES;
    bf16* WIN = (bf16*)(P.ws + WS_WIN); bf16* WCA = (bf16*)(P.ws + WS_WCA); bf16* WOUT = (bf16*)(P.ws + WS_WOUT);
    constexpr int I_IN = (DMODEL / 64) * (IN_COLS / 32), I_C = (CONV_CH / 64) * (DMODEL / 32), I_O = (DMODEL / 64) * (DMODEL / 32);
    for (int it = gw; it < I_IN + 2 * I_C + I_O; it += NGW) {
        int r = it;
        if (r < I_IN) { const int kb = r / (IN_COLS / 32), nb = r % (IN_COLS / 32); transpose_item(P.w_in, IN_COLS, kb * 64, nb * 32, WIN, 1024, inproj_phys(nb * 32), 0, nullptr, scr, lane); continue; } r -= I_IN;
        if (r < I_C) { const int kb = r / 32, nb = r % 32; transpose_item(P.w_conv_out, DMODEL, kb * 64, nb * 32, WCA, 1024, nb * 32, 0, nullptr, scr, lane); continue; } r -= I_C;
        if (r < I_C) { const int kb = r / 32, nb = r % 32; transpose_item(P.w_attn_out, DMODEL, kb * 64, nb * 32, WCA, 1024, nb * 32, 512, nullptr, scr, lane); continue; } r -= I_C;
        { const int kb = r / 32, nb = r % 32; transpose_item(P.w_out, DMODEL, kb * 64, nb * 32, WOUT, 1024, nb * 32, 0, nullptr, scr, lane); }
    }
    bf16* WRhi = (bf16*)(P.ws + WS_WR); bf16* WRlo = WRhi + 64 * 1024;
    for (int idx = vcu * NTHREADS + tid; idx < 64 * 1024; idx += G * NTHREADS) {
        const int n = idx >> 10, k = idx & 1023; float v = 0.f;
        if (n < 4) v = P.w_rg[k * 4 + n]; else if (n < 36) v = P.w_re[k * 32 + (n - 4)];
        v *= P.ffn_norm_g[k];
        const unsigned hb = cvt_pk_bf16(v, 0.f) & 0xffffu; const float hf = __uint_as_float(hb << 16);
        WRhi[idx] = (bf16)hb; WRlo[idx] = (bf16)(cvt_pk_bf16(v - hf, 0.f) & 0xffffu);
    }
    bf16* HB = (bf16*)(P.ws + WS_A);
    f32x4 gq[4];
#pragma unroll
    for (int j = 0; j < 4; ++j) gq[j] = ((const f32x4*)P.attn_norm_g)[64 * j + lane];
    for (int m = gw; m < NTOK; m += NGW) {
        const f32x4* xr = (const f32x4*)(P.x + (size_t)m * DMODEL) + lane; f32x4 v[4]; float s = 0.f;
#pragma unroll
        for (int j = 0; j < 4; ++j) { v[j] = xr[64 * j]; s += (v[j][0] * v[j][0] + v[j][1] * v[j][1]) + (v[j][2] * v[j][2] + v[j][3] * v[j][3]); }
        const float r = 1.0f / sqrtf(wave_sum(s) * (1.0f / DMODEL) + EPS);
        v2u* o8 = (v2u*)(HB + (size_t)m * DMODEL) + lane;
#pragma unroll
        for (int j = 0; j < 4; ++j) { const f32x4 y = v[j] * r * gq[j]; v2u w; w.x = cvt_pk_bf16(y[0], y[1]); w.y = cvt_pk_bf16(y[2], y[3]); o8[64 * j] = w; }
    }
}

__device__ __forceinline__ void conv_phase(const Ptrs& P, LAS unsigned char* lds, int first, int stride) {
    const int tid = threadIdx.x, lane = tid & 63, wave = __builtin_amdgcn_readfirstlane(tid >> 6);
    const bf16* YG = (const bf16*)(P.ws + WS_YG); bf16* CA = (bf16*)(P.ws + WS_CA);
    LAS bf16* yt = (LAS bf16*)lds; LAS float* co = (LAS float*)(lds + 62 * 1024);
    constexpr int NT = NTOK / 32;
    if (first >= NT) return;
    float w[CONV_W];
#pragma unroll
    for (int j = 0; j < CONV_W; ++j) w[j] = P.conv_dw_w[j * CONV_CH + tid];
    const float bias = P.conv_dw_b[tid];
    const f32x4 g0 = ((const f32x4*)P.conv_ln_g)[lane], g1 = ((const f32x4*)P.conv_ln_g)[64 + lane], b0 = ((const f32x4*)P.conv_ln_b)[lane], b1 = ((const f32x4*)P.conv_ln_b)[64 + lane];
    v4u pre[8];
#define CONV_FETCH(tile) do { const int b_ = (tile) / (SEQ / 32), t0_ = ((tile) % (SEQ / 32)) * 32; _Pragma("unroll") for (int p = 0; p < 8; ++p) { const int q = tid + NTHREADS * p; const int row = q >> 6, ch = q & 63, t = t0_ - 30 + row; \
        pre[p] = (v4u){0u, 0u, 0u, 0u}; if (q < 62 * 64 && t >= 0) pre[p] = *(const v4u*)(YG + ((size_t)(b_ * SEQ + t)) * 512 + ch * 8); } } while (0)
    CONV_FETCH(first);
    for (int tile = first; tile < NT; tile += stride) {
        const int b = tile / (SEQ / 32), t0 = (tile % (SEQ / 32)) * 32;
#pragma unroll
        for (int p = 0; p < 8; ++p) { const int q = tid + NTHREADS * p; if (q < 62 * 64) *(LAS v4u*)(yt + (q >> 6) * 512 + (q & 63) * 8) = pre[p]; }
        __syncthreads();
        if (tile + stride < NT) CONV_FETCH(tile + stride);
        float yv[62];
#pragma unroll
        for (int i = 0; i < 62; ++i) yv[i] = __uint_as_float((unsigned)yt[i * 512 + tid] << 16);
#pragma unroll
        for (int t = 0; t < 32; ++t) { float a = bias;
#pragma unroll
            for (int j = 0; j < CONV_W; ++j) a += w[j] * yv[t + j];
            co[t * 512 + tid] = a; }
        __syncthreads();
#pragma unroll
        for (int rr = 0; rr < 4; ++rr) { const int row = wave * 4 + rr;
            const f32x4 v0 = *(const LAS f32x4*)(co + row * 512 + lane * 4), v1 = *(const LAS f32x4*)(co + row * 512 + 256 + lane * 4);
            const float mean = wave_sum((v0[0] + v0[1]) + (v0[2] + v0[3]) + (v1[0] + v1[1]) + (v1[2] + v1[3])) * (1.0f / CONV_CH);
            const f32x4 d0 = v0 - mean, d1 = v1 - mean;
            const float var = wave_sum((d0[0] * d0[0] + d0[1] * d0[1]) + (d0[2] * d0[2] + d0[3] * d0[3]) + (d1[0] * d1[0] + d1[1] * d1[1]) + (d1[2] * d1[2] + d1[3] * d1[3])) * (1.0f / CONV_CH);
            const float rstd = 1.0f / sqrtf(var + EPS);
            f32x4 y0 = d0 * rstd * g0 + b0, y1 = d1 * rstd * g1 + b1;
#pragma unroll
            for (int j = 0; j < 4; ++j) { y0[j] = y0[j] * sigmoidf_fast(y0[j]); y1[j] = y1[j] * sigmoidf_fast(y1[j]); }
            bf16* orow = CA + ((size_t)(b * SEQ + t0 + row)) * 1024;
            v2u o0, o1; o0.x = cvt_pk_bf16(y0[0], y0[1]); o0.y = cvt_pk_bf16(y0[2], y0[3]); o1.x = cvt_pk_bf16(y1[0], y1[1]); o1.y = cvt_pk_bf16(y1[2], y1[3]);
            *(v2u*)(orow + lane * 4) = o0; *(v2u*)(orow + 256 + lane * 4) = o1; }
        __syncthreads();
    }
#undef CONV_FETCH
}

__device__ __forceinline__ void attn_pair(const Ptrs& P, LAS unsigned char* lds, char* lds_generic, int p) {
    const int tid = threadIdx.x, lane = tid & 63, wave = __builtin_amdgcn_readfirstlane(tid >> 6);
    const int bh = p >> 3, s = p & 7, b = bh >> 2, h = bh & 3;
    const __hip_bfloat16* QB = (const __hip_bfloat16*)(P.ws + WS_QB); const __hip_bfloat16* KB = (const __hip_bfloat16*)(P.ws + WS_KB); const __hip_bfloat16* VB = (const __hip_bfloat16*)(P.ws + WS_VB);
    __hip_bfloat16* OT = (__hip_bfloat16*)(P.ws + WS_A); bf16* CA = (bf16*)(P.ws + WS_CA);
    float mstat;
    { int l0 = lane; asm volatile("" : "+v"(l0));
      float a = fabsf(P.q_norm_g[l0]), b = fabsf(P.k_norm_g[l0]);
#pragma unroll
      for (int o = 1; o < 64; o <<= 1) { a = fmaxf(a, __shfl_xor(a, o)); b = fmaxf(b, __shfl_xor(b, o)); }
      mstat = __int_as_float(__builtin_amdgcn_readfirstlane(__float_as_int(0.125f * 1.4426950408889634f * 64.0f * 1.02f * a * b))); }
    float lam;
    { int l1 = lane; asm volatile("" : "+v"(l1));
      lam = __int_as_float(__builtin_amdgcn_readfirstlane(__float_as_int(__expf(wave_sum(P.lq1[l1] * P.lk1[l1])) - __expf(wave_sum(P.lq2[l1] * P.lk2[l1])) + 0.2f))); }
    for (int i = 0; i < 2; ++i) {
        const int qb = (i == 0) ? s : 15 - s;
#pragma unroll 1
        for (int c = 0; c < 2; ++c) {
            const __hip_bfloat16* q_ = QB + (size_t)b * SEQ * 512 + (h * 2 + c) * 64; const __hip_bfloat16* k_ = KB + (size_t)b * SEQ * 512 + (h * 2 + c) * 64; const __hip_bfloat16* v_ = VB + (size_t)b * SEQ * 512 + h * 128;
            __hip_bfloat16* o_ = OT + (size_t)b * SEQ * 1024 + (h * 2) * 128;
            const __hip_bfloat16* o1_ = c ? o_ : nullptr; unsigned short* ca_ = CA + (size_t)b * SEQ * 1024 + 512 + h * 128;
            if (mstat <= 40.0f) attn_body::attn_unit<8, true>(mstat, qb * 256, q_, k_, v_, o_, lds_generic, o1_, lam, P.subln_g, ca_);
            else attn_body::attn_unit<8, false>(0.f, qb * 256, q_, k_, v_, o_, lds_generic, o1_, lam, P.subln_g, ca_); }
    }
}

__device__ __forceinline__ void router_tile(const Ptrs& P, LAS unsigned char* lds, int tile) {
    const int tid = threadIdx.x, lane = tid & 63, wave = __builtin_amdgcn_readfirstlane(tid >> 6), r32 = lane & 31, hi = lane >> 5;
    const bf16* WRhi = (const bf16*)(P.ws + WS_WR); const bf16* WRlo = WRhi + 64 * 1024;
    int* LIST = (int*)(P.ws + WS_LIST); int* CTOK = (int*)(P.ws + WS_CTOK); unsigned* cnt = (unsigned*)(P.ws + WS_CTL); unsigned* ccnt = cnt + 64;
    LAS float* lg = (LAS float*)(lds + wave * 8448);
    LAS int* hist = (LAS int*)(lds + HIST_OFF); LAS int* hbase = hist + 32; LAS int* hist2 = hist + 64; LAS int* hbase2 = hist2 + NCLS;
    if (tid < 32) hist[tid] = 0;
    if (tid >= 64 && tid < 64 + NCLS) hist2[tid - 64] = 0;
    __syncthreads();
    const int tbase = tile * 256 + wave * 32;
    const bf16* xr = (const bf16*)(P.ws + WS_CA) + (size_t)(tbase + r32) * DMODEL + 8 * hi;
    const bf16* bh0 = WRhi + (size_t)r32 * 1024 + 8 * hi; const bf16* bl0 = WRlo + (size_t)r32 * 1024 + 8 * hi;
    f32x16 acc0 = {}, acc1 = {}; float ssq = 0.f;
#pragma unroll 4
    for (int ks = 0; ks < 64; ++ks) {
        const v4u xa = *(const v4u*)(xr + ks * 16);
        f32x4 x0, x1; unpack8(xa, x0, x1);
        ssq += (x0[0] * x0[0] + x0[1] * x0[1]) + (x0[2] * x0[2] + x0[3] * x0[3]) + (x1[0] * x1[0] + x1[1] * x1[1]) + (x1[2] * x1[2] + x1[3] * x1[3]);
        const bf16x8 a_hi = __builtin_bit_cast(bf16x8, xa);
        const bf16x8 bh_0 = *(const bf16x8*)(bh0 + ks * 16), bh_1 = *(const bf16x8*)(bh0 + 32 * 1024 + ks * 16), bl_0 = *(const bf16x8*)(bl0 + ks * 16), bl_1 = *(const bf16x8*)(bl0 + 32 * 1024 + ks * 16);
        acc0 = __builtin_amdgcn_mfma_f32_32x32x16_bf16(a_hi, bh_0, acc0, 0, 0, 0); acc1 = __builtin_amdgcn_mfma_f32_32x32x16_bf16(a_hi, bh_1, acc1, 0, 0, 0);
        acc0 = __builtin_amdgcn_mfma_f32_32x32x16_bf16(a_hi, bl_0, acc0, 0, 0, 0); acc1 = __builtin_amdgcn_mfma_f32_32x32x16_bf16(a_hi, bl_1, acc1, 0, 0, 0);
    }
    ssq += __shfl_xor(ssq, 32);
    const float rs = 1.0f / sqrtf(ssq * (1.0f / DMODEL) + EPS);
#pragma unroll
    for (int r = 0; r < 16; ++r) { const int m = (r & 3) + 8 * (r >> 2) + 4 * hi; lg[m * 66 + r32] = acc0[r]; lg[m * 66 + 32 + r32] = acc1[r]; }
    asm volatile("s_waitcnt lgkmcnt(0)" ::: "memory");
    int ea = 0, eb = 0, cls = 0, lpa = 0, lpb = 0, lpc = 0; float wa = 0.f, wb = 0.f;
    if (lane < 32) {
        const LAS float* L = lg + lane * 66;
        float gl[4];
#pragma unroll
        for (int j = 0; j < 4; ++j) gl[j] = L[j] * rs + P.b_rg[j];
        int gs = 0; float gm = gl[0];
#pragma unroll
        for (int j = 1; j < 4; ++j) if (gl[j] > gm) { gm = gl[j]; gs = j; }
        float gsum = 0.f;
#pragma unroll
        for (int j = 0; j < 4; ++j) gsum += __expf(gl[j] - gm);
        const float gw = 1.0f / gsum;
        float l0 = -INFINITY, l1 = -INFINITY; int i0 = 0, i1 = 0;
#pragma unroll
        for (int j = 0; j < 8; ++j) { const float v = L[4 + gs * 8 + j] * rs + P.b_re[gs * 8 + j];
            if (v > l0) { l1 = l0; i1 = i0; l0 = v; i0 = j; } else if (v > l1) { l1 = v; i1 = j; } }
        const float q = __expf(l1 - l0), inv = 1.0f / (1.0f + q);
        const float w0 = inv * gw, w1 = q * inv * gw;
        const int a = min(i0, i1), b = max(i0, i1);
        wa = (i0 < i1) ? w0 : w1; wb = (i0 < i1) ? w1 : w0;
        ea = gs * 8 + a; eb = gs * 8 + b; cls = gs * 28 + (a * (15 - a)) / 2 + (b - a - 1);
        lpa = __hip_atomic_fetch_add(&hist[ea], 1, __ATOMIC_RELAXED, __HIP_MEMORY_SCOPE_WORKGROUP); lpb = __hip_atomic_fetch_add(&hist[eb], 1, __ATOMIC_RELAXED, __HIP_MEMORY_SCOPE_WORKGROUP);
        lpc = __hip_atomic_fetch_add(&hist2[cls], 1, __ATOMIC_RELAXED, __HIP_MEMORY_SCOPE_WORKGROUP);
    }
    __syncthreads();
    if (tid < 32) hbase[tid] = (int)atomicAdd(cnt + tid, (unsigned)hist[tid]);
    if (tid >= 64 && tid < 64 + NCLS) { const int c = tid - 64; const int n = hist2[c]; hbase2[c] = n ? (int)atomicAdd(ccnt + c, (unsigned)n) : 0; }
    __syncthreads();
    if (lane < 32) { const int t = tbase + lane; const int pa = hbase[ea] + lpa, pb = hbase[eb] + lpb, pc = hbase2[cls] + lpc;
        typedef int i32x4 __attribute__((ext_vector_type(4)));
        const int dst = (cls << 17) | (pc << 1);
        *(i32x4*)(LIST + (size_t)(ea * LCAP + pa) * 4) = (i32x4){t, dst, __float_as_int(wa), __float_as_int(rs)};
        *(i32x4*)(LIST + (size_t)(eb * LCAP + pb) * 4) = (i32x4){t, dst | 1, __float_as_int(wb), __float_as_int(rs)};
        CTOK[(size_t)cls * NTOK + pc] = t; }
    __syncthreads();
}

__device__ __forceinline__ void p5_convert(const Ptrs& P, LAS unsigned char* lds, int vcu, int G) {
    const int tid = threadIdx.x, lane = tid & 63, wave = __builtin_amdgcn_readfirstlane(tid >> 6);
    LAS float* scr = (LAS float*)(lds + wave * 16384);
    const int gw = vcu * NWAVES + wave, NGW = G * NWAVES;
    unsigned char* WGU = P.ws + WS_WGU; unsigned char* WD = P.ws + WS_WD;
    constexpr int I_G = (DMODEL / 64) * (DEXP / 32);
    constexpr int I_D = (DEXP / 64) * (DMODEL / 32);
    constexpr int PER_E = 2 * I_G + I_D;
    constexpr int NITEMS = NEXP * PER_E, NRW = (NTOK / 256) * NWAVES;
    const bool split = (G == 256) && (NITEMS == NRW * 10 + (256 * NWAVES - NRW) * 14);
    const bool rwg = (int)blockIdx.x < NTOK / 256; const int wv = ((int)blockIdx.x - (rwg ? 0 : NTOK / 256)) * NWAVES + wave;
    const int it0 = split ? (rwg ? wv : NRW * 10 + wv) : gw, itn = split ? (rwg ? NRW * 10 : NITEMS) : NITEMS, its = split ? NRW : NGW;
    for (int it = it0; it < itn; it += its) {
        const int e = it / PER_E; int r = it % PER_E;
        if (r < 2 * I_G) { const int up = r / I_G; r %= I_G; const int kb = r / (DEXP / 32), nb = r % (DEXP / 32), n0 = nb * 32;
            const float* W = (up ? P.w_up : P.w_gate) + (size_t)e * DMODEL * DEXP;
            transpose_item_fp8(W, DEXP, kb * 64, n0, WGU + (size_t)e * 1024 * 1024, 1024, (n0 >> 7) * 256 + up * 128 + (n0 & 127), P.ffn_norm_g, 64.f, scr, lane);
        } else { r -= 2 * I_G; const int kb = r / (DMODEL / 32), nb = r % (DMODEL / 32);
            transpose_item_fp8(P.w_down + (size_t)e * DEXP * DMODEL, DMODEL, kb * 64, nb * 32, WD + (size_t)e * 1024 * 512, 512, nb * 32, nullptr, 32.f, scr, lane); }
    }
}

struct Args { Ptrs p; int ph_lo, ph_hi, use_cg, pad; };
__global__ void __launch_bounds__(NTHREADS, 2) mega_fwd(Args args) {
    extern __shared__ __attribute__((aligned(16))) unsigned char lds_raw[];
    LAS unsigned char* lds = (LAS unsigned char*)lds_raw;
    const Ptrs& P = args.p;
    const int tid = threadIdx.x, lane = tid & 63;
    const int G = gridDim.x, bx = blockIdx.x; const int vcu = (G % 8 == 0) ? (bx % 8) * (G / 8) + bx / 8 : bx;
    const int lo = args.ph_lo, hi = args.ph_hi;
    LAS int* meta = (LAS int*)(lds + META_OFF);
    if (tid < 2) ((volatile LAS unsigned*)(lds + BARST_OFF))[tid] = 0u;
    __syncthreads();
    XcdBarrier bar = xcd_barrier_post((unsigned*)(P.ws + WS_CTL) + 1024, (volatile LAS unsigned*)(lds + BARST_OFF));
#ifndef PHASE_MASK
#define PHASE_MASK 0xff
#endif
#ifndef DUP_PHASE
#define DUP_PHASE -1
#endif
#define REPS(k) for (int rep_ = 0; rep_ < ((DUP_PHASE == (k)) ? 2 : 1); ++rep_)
#define REPBAR() do { if (rep_) xcd_barrier(bar); } while (0)
#define IN(k) (((PHASE_MASK >> (k)) & 1) && lo <= (k) && (k) < hi)
#define SEAM(k) do { if (IN(k) && IN((k) + 1)) xcd_barrier(bar); } while (0)
    bf16* WS16 = (bf16*)P.ws;
    if (IN(0)) REPS(0) { REPBAR(); p0_prologue(P, lds, vcu, G); }
    SEAM(0);
    if (IN(1)) REPS(1) { REPBAR();
        pg8::Gemm g{(const bf16*)(P.ws + WS_A), (const bf16*)(P.ws + WS_WIN), DMODEL, 0, nullptr};
        pg8::StaticOrder S; S.init(NTOK, IN_COLS, G, bx);
        LAS float* gl = (LAS float*)(lds + RING_BYTES + 8192);
        if (tid < 128) gl[tid] = (tid < 64) ? P.q_norm_g[tid] : P.k_norm_g[tid - 64];
        __syncthreads();
        EpiInProj E{(bf16*)(P.ws + WS_YG), (bf16*)(P.ws + WS_QB), (bf16*)(P.ws + WS_KB), (bf16*)(P.ws + WS_VB), (bf16*)(P.ws + WS_GT), gl};
#if defined(DUMP_SEL) && DUMP_SEL == 5
        EpiRaw ER{(bf16*)(P.ws + WS_QB)};
        pg8::gemm_phase<EpiRaw, pg8::StaticOrder, false, true>(lds, g, S, ER);
#else
        pg8::gemm_phase<EpiInProj, pg8::StaticOrder, false, true>(lds, g, S, E);
#endif
    }
    SEAM(1);
    if (IN(2)) {
        REPS(2) { REPBAR();
        for (int p = vcu; p < 256; p += G) attn_pair(P, lds, (char*)lds_raw, p);
        __syncthreads(); }
        REPS(20) { REPBAR();
        conv_phase(P, lds, bx, G); }
    }
    SEAM(2);
    if (IN(3)) REPS(3) { REPBAR();
        pg8::Gemm g{(const bf16*)(P.ws + WS_CA), (const bf16*)(P.ws + WS_WCA), DMODEL, 0, nullptr};
        pg8::StaticOrder S; S.init(NTOK, DMODEL, G, bx);
        EpiMerged E{(const bf16*)(P.ws + WS_GT), (const bf16*)(P.ws + WS_GT) + (size_t)NTOK * 1024, (bf16*)(P.ws + WS_MG)};
        pg8::gemm_phase<EpiMerged, pg8::StaticOrder, false, true>(lds, g, S, E);
    }
    SEAM(3);
    if (IN(4)) REPS(4) { REPBAR();
        pg8::Gemm g{(const bf16*)(P.ws + WS_MG), (const bf16*)(P.ws + WS_WOUT), DMODEL, 0, nullptr};
        pg8::StaticOrder S; S.init(NTOK, DMODEL, G, bx);
        EpiOut E{P.x, (bf16*)(P.ws + WS_CA), P.ws + WS_XM};
        pg8::gemm_phase<EpiOut, pg8::StaticOrder, false, true>(lds, g, S, E);
    }
    SEAM(4);
    if (IN(5)) {
        for (int t = bx; t < NTOK / 256; t += G) router_tile(P, lds, t);
        REPS(5) { REPBAR(); p5_convert(P, lds, vcu, G); }
    }
    SEAM(5);
    LAS int* meta2 = (LAS int*)(lds + META2_OFF);
    if (IN(6)) REPS(6) { REPBAR();
        moe_meta(meta, meta2, (const unsigned*)(P.ws + WS_CTL));
        pg8::Gemm g{(const bf16*)(P.ws + WS_XM), (const bf16*)(P.ws + WS_WGU), DMODEL / 2, (size_t)1024 * 1024, (const int*)(P.ws + WS_LIST), 4};
        MoeOrder S{G, bx, __builtin_amdgcn_readfirstlane(meta[NEXP]), meta};
        EpiGateUp E{(const int*)(P.ws + WS_LIST), P.ws + WS_A, meta2};
        pg8::gemm_phase<EpiGateUp, MoeOrder, true, true, true>(lds, g, S, E);
    }
    SEAM(6);
    if (IN(7)) REPS(7) { REPBAR();
        moe_meta(meta, meta2, (const unsigned*)(P.ws + WS_CTL));
        pg8::Gemm g{(const bf16*)(P.ws + WS_A), (const bf16*)(P.ws + WS_WD), DMODEL / 2, (size_t)1024 * 512, nullptr, 0, DEXP / 2};
        ClassOrder S{G, bx, __builtin_amdgcn_readfirstlane(meta2[NCLS]), meta2};
        EpiDownAdd E{(const int*)(P.ws + WS_CTOK), (const bf16*)(P.ws + WS_CA), P.out};
        pg8::gemm_phase<EpiDownAdd, ClassOrder, false, true, true, true>(lds, g, S, E);
    }
#if defined(DUMP_SEL)
    xcd_barrier(bar);
    { const bf16* YG = (const bf16*)(P.ws + WS_YG); const bf16* QB = (const bf16*)(P.ws + WS_QB); const bf16* KB = (const bf16*)(P.ws + WS_KB); const bf16* VB = (const bf16*)(P.ws + WS_VB);
      const bf16* GT = (const bf16*)(P.ws + WS_GT); const bf16* CA = (const bf16*)(P.ws + WS_CA); const bf16* MG = (const bf16*)(P.ws + WS_MG);
      for (size_t i = (size_t)bx * NTHREADS + tid; i < (size_t)NTOK * 1024; i += (size_t)G * NTHREADS) { const size_t t = i >> 10; const int c = (int)(i & 1023); float v = 0.f;
#if DUMP_SEL == 1
          v = bf_lo(YG[t * 512 + (c & 511)]) + bf_lo(QB[t * 512 + (c & 511)]) + 2.f * bf_lo(KB[t * 512 + (c & 511)]) + 3.f * bf_lo(VB[t * 512 + (c & 511)]) + bf_lo(GT[t * 2048 + c]) + bf_lo(GT[t * 2048 + 1024 + c]);
#elif DUMP_SEL == 2
          v = bf_lo(CA[t * 1024 + c]);
#elif DUMP_SEL == 4
          { const bf16* HB = (const bf16*)(P.ws + WS_A); const bf16* WIN = (const bf16*)(P.ws + WS_WIN); v = bf_lo(HB[i]) + 30.f * bf_lo(WIN[i % ((size_t)IN_COLS * 1024)]); }
#elif DUMP_SEL == 5
          { const bf16* R = (const bf16*)(P.ws + WS_QB); v = bf_lo(R[t * 4608 + c]) + bf_lo(R[t * 4608 + 1024 + c]) + bf_lo(R[t * 4608 + 2048 + c]) + bf_lo(R[t * 4608 + 3072 + c]) + bf_lo(R[t * 4608 + 4096 + (c & 511)]); }
#elif DUMP_SEL == 3
          v = bf_lo(MG[t * 1024 + c]);
#endif
          P.out[i] = v; } }
#endif
    (void)WS16;
#undef IN
#undef SEAM
}

extern "C" void kernel_launch(void* const* d_in, const int* in_sizes, int n_in, void* d_out, int out_size, void* d_ws, size_t ws_size, hipStream_t stream) {
    static int grid = 0;
    if (grid == 0) {
        if (n_in != 25 || in_sizes[0] != NTOK * DMODEL || out_size != NTOK * DMODEL || ws_size < WS_END) {
            fprintf(stderr, "kernel_launch: unexpected shapes (n_in %d, in0 %d, out %d, ws %zu); nothing launched\n", n_in, n_in > 0 ? in_sizes[0] : -1, out_size, ws_size); grid = -1; return; }
        int dev = 0, cus = 0, per_cu = 0;
        if (hipGetDevice(&dev) != hipSuccess || hipDeviceGetAttribute(&cus, hipDeviceAttributeMultiprocessorCount, dev) != hipSuccess) { grid = -1; return; }
        if (hipFuncSetAttribute((const void*)mega_fwd, hipFuncAttributeMaxDynamicSharedMemorySize, LDS_BYTES) != hipSuccess) { fprintf(stderr, "kernel_launch: hipFuncSetAttribute failed\n"); grid = -1; return; }
        if (hipOccupancyMaxActiveBlocksPerMultiprocessor(&per_cu, (const void*)mega_fwd, NTHREADS, LDS_BYTES) != hipSuccess || per_cu < 1) { fprintf(stderr, "kernel_launch: the occupancy query reports %d workgroups per CU for this kernel and LDS size; nothing launched\n", per_cu); grid = -1; return; }
        (void)hipGetLastError();
        grid = cus;
    }
    if (grid < 0) return;
    (void)hipMemsetAsync((char*)d_ws + WS_CTL, 0, CTL_ZERO_BYTES, stream);
    Args a{};
    const float** pp = (const float**)&a.p;
    for (int i = 0; i < 25; ++i) pp[i] = (const float*)d_in[i];
    a.p.out = (float*)d_out; a.p.ws = (unsigned char*)d_ws;
#if MK_PER_PHASE
    for (int ph = 0; ph < N_PHASES; ++ph) { a.ph_lo = ph; a.ph_hi = ph + 1; void* params[] = {&a};
        hipError_t e = hipLaunchCooperativeKernel((const void*)mega_fwd, dim3(grid), dim3(NTHREADS), params, LDS_BYTES, stream);
        if (e != hipSuccess) { fprintf(stderr, "launch %d failed: %s\n", ph, hipGetErrorString(e)); break; } }
#else
    a.ph_lo = 0; a.ph_hi = N_PHASES; void* params[] = {&a};
    hipError_t e = hipLaunchCooperativeKernel((const void*)mega_fwd, dim3(grid), dim3(NTHREADS), params, LDS_BYTES, stream);
    if (e != hipSuccess) fprintf(stderr, "cooperative launch failed: %s (grid %d)\n", hipGetErrorString(e), grid);
#endif
}
```

```cpp
#include <hip/hip_runtime.h>
#include <hip/hip_bf16.h>
#include <hip/hip_cooperative_groups.h>
#include <cstdio>
#include <cstdint>
#include <cmath>
namespace cg = cooperative_groups;

constexpr int BATCH = 8, SEQ = 4096, DMODEL = 1024, NTOK = BATCH * SEQ;
constexpr int CONV_CH = 512, CONV_W = 31, NHEADS = 4, IN_COLS = 4608;
constexpr int NEXP = 32, DEXP = 512, LCAP = NTOK;
constexpr int NCLS = 4 * 28;
constexpr int CROWS = NTOK + NCLS * 256;
constexpr int MOE_ROWS = 2 * NTOK + NEXP * 256;
constexpr float EPS = 1e-6f;

namespace pg8 {
#define PG8_LAS __attribute__((address_space(3)))
typedef unsigned short bf16_t;
typedef short bf16x8 __attribute__((ext_vector_type(8)));
typedef float f32x4 __attribute__((ext_vector_type(4)));
typedef unsigned u32x4 __attribute__((ext_vector_type(4)));
constexpr int BM = 256, BK = 64, HALF = 128, HTB = HALF * BK * 2  , STAGE_BYTES = 8 * HTB, NXCD = 8, WGM = 8;

__host__ __device__ __forceinline__ int lds_byte(int r, int c) { const int st = (r >> 4) * 2 + (c >> 5), rr = r & 15, cc = c & 31, ob = rr * 64 + cc * 2; return st * 1024 + (ob ^ (((ob >> 9) & 1) << 5)); }
__host__ __device__ __forceinline__ void stage_rc(int b, int& R, int& C) { const int st = b / 1024, sb = b % 1024, swz = sb ^ (((sb >> 9) & 1) << 5); R = (st >> 1) * 16 + swz / 64; C = (st & 1) * 32 + (swz % 64) / 2; }
__host__ __device__ __forceinline__ int perm32(int rho) { const int n = rho >> 4, i = rho & 15; return 8 * (i >> 2) + 4 * n + (i & 3); }

struct Unit { int pm, pn, arow, e, e2, lrow, nvalid, orow; };
struct Gemm { const bf16_t* A; const bf16_t* Bt; int K; size_t bstride; const int* list; int lstride; int KBrow; };

struct StaticOrder {
    int nM, nN, nwg, G, c;
    __device__ void init(int M, int N, int G_, int c_) { nM = M / BM; nN = N / BM; nwg = nM * nN; G = G_; c = c_; }
    __device__ bool next(int i, Unit& u) const {
        const long L = (long)i * G + c; if (L >= nwg) return false;
        int wgid = (int)L; { const int q = nwg / NXCD, r = nwg % NXCD, xcd = wgid % NXCD, off = wgid / NXCD; wgid = (xcd < r ? xcd * (q + 1) : r * (q + 1) + (xcd - r) * q) + off; }
        const int nig = WGM * nN, gid = wgid / nig, fm = gid * WGM, gsz = (nM - fm) < WGM ? (nM - fm) : WGM;
        u.pm = fm + ((wgid % nig) % gsz); u.pn = (wgid % nig) / gsz; u.arow = u.pm * BM; u.orow = u.arow; u.e = 0; u.e2 = 0; u.lrow = 0; u.nvalid = BM; return true;
    }
};

typedef float f32x2_t __attribute__((ext_vector_type(2))); typedef __bf16 bf16x2_t __attribute__((ext_vector_type(2)));
__device__ __forceinline__ unsigned cvt_pk_bf16(float lo, float hi) { const f32x2_t v = {lo, hi}; const bf16x2_t b = __builtin_convertvector(v, bf16x2_t); return __builtin_bit_cast(unsigned, b); }
typedef int v8i_t __attribute__((ext_vector_type(8))); typedef int v4i_t __attribute__((ext_vector_type(4)));
__device__ __forceinline__ v8i_t cat8(const bf16x8 a, const bf16x8 b) { const v4i_t x = __builtin_bit_cast(v4i_t, a), y = __builtin_bit_cast(v4i_t, b); return (v8i_t){x[0], x[1], x[2], x[3], y[0], y[1], y[2], y[3]}; }
__device__ __forceinline__ unsigned pack4_fp8(float a, float b, float c, float d) { int w = 0; w = __builtin_amdgcn_cvt_pk_fp8_f32(a, b, w, false); w = __builtin_amdgcn_cvt_pk_fp8_f32(c, d, w, true); return (unsigned)w; }
__device__ __forceinline__ float bf_lo(unsigned w) { return __uint_as_float(w << 16); }
__device__ __forceinline__ float bf_hi(unsigned w) { return __uint_as_float(w & 0xffff0000u); }
__device__ __forceinline__ float sigmoidf_fast(float x) { return __builtin_amdgcn_rcpf(1.0f + __builtin_amdgcn_exp2f(-1.4426950408889634f * x)); }
__device__ __forceinline__ u32x4 pack8(const f32x4 a, const f32x4 b) { u32x4 w; w.x = cvt_pk_bf16(a[0], a[1]); w.y = cvt_pk_bf16(a[2], a[3]); w.z = cvt_pk_bf16(b[0], b[1]); w.w = cvt_pk_bf16(b[2], b[3]); return w; }
__device__ __forceinline__ void unpack8(const u32x4 w, f32x4& a, f32x4& b) { a = (f32x4){bf_lo(w.x), bf_hi(w.x), bf_lo(w.y), bf_hi(w.y)}; b = (f32x4){bf_lo(w.z), bf_hi(w.z), bf_lo(w.w), bf_hi(w.w)}; }

template <class Epi, class Sched, bool GATHER, bool ALIGN_EPI, bool FP8 = false, bool BSPLIT = false>
__device__ __forceinline__ void gemm_phase(PG8_LAS unsigned char* lds, const Gemm g, const Sched& S, const Epi& E) {
    const int tid = threadIdx.x, wid = __builtin_amdgcn_readfirstlane(tid >> 6), lane = tid & 63, wr = wid >> 2, wc = wid & 3, fr = lane & 15, fq = lane >> 4;
    const int K = g.K, nt = K / BK, KBp = g.KBrow ? g.KBrow : K;
    unsigned voffB[2]; int Ra[2], Ca[2];
#pragma unroll
    for (int i = 0; i < 2; ++i) { int R, C; stage_rc(tid * 16 + i * 8192, R, C); const int Rb = (R & ~31) + perm32(R & 31); Ra[i] = R; Ca[i] = C; voffB[i] = (unsigned)(Rb * KBp + C) * 2u; }
    const unsigned kstep = (unsigned)(BK * 2);
    const unsigned hstep = (unsigned)HALF * KBp * 2;
    const unsigned tstep = 2 * hstep;
    const char* const gA = (const char*)g.A; const char* const gB = (const char*)g.Bt;
    const unsigned ldsw = (unsigned)wid * 1024u;
    const int aoff = lds_byte(wr * 64 + fr, fq * 8), boff = lds_byte(wc * 32 + fr, fq * 8);
#define PG8_SA(b, h) (((b) * 2 + (h)) * HTB)
#define PG8_SB(b, h) ((4 + (b) * 2 + (h)) * HTB)
#define PG8_STAGE(bufoff, gbase, uoff, voff) do { _Pragma("unroll") for (int _i = 0; _i < 2; ++_i) \
        __builtin_amdgcn_global_load_lds((const unsigned*)((const char*)(gbase) + (unsigned)((uoff) + (voff)[_i])), (PG8_LAS unsigned*)(lds + (bufoff) + ldsw + _i * 8192), 16, 0, 0); } while (0)
#define PG8_LDA(dst, b, h) do { _Pragma("unroll") for (int m = 0; m < 4; ++m) _Pragma("unroll") for (int k = 0; k < 2; ++k) dst[m][k] = *(const PG8_LAS bf16x8*)(lds + PG8_SA(b, h) + aoff + m * 2048 + k * 1024); } while (0)
#define PG8_LDB(dst, b, h) do { _Pragma("unroll") for (int n = 0; n < 2; ++n) _Pragma("unroll") for (int k = 0; k < 2; ++k) dst[n][k] = *(const PG8_LAS bf16x8*)(lds + PG8_SB(b, h) + boff + n * 2048 + k * 1024); } while (0)
#define PG8_MMA(ai, bj, At, Bt) do { __builtin_amdgcn_s_setprio(1); \
        if constexpr (FP8) { _Pragma("unroll") for (int m = 0; m < 4; ++m) _Pragma("unroll") for (int n = 0; n < 2; ++n) \
            asm volatile("v_mfma_scale_f32_16x16x128_f8f6f4 %0, %1, %2, %0, %3, %3 op_sel_hi:[0,0,0]" : "+v"(acc[ai][bj][m][n]) : "v"(cat8(Bt[n][0], Bt[n][1])), "v"(cat8(At[m][0], At[m][1])), "v"(one_e8m0)); } \
        else { _Pragma("unroll") for (int m = 0; m < 4; ++m) _Pragma("unroll") for (int n = 0; n < 2; ++n) _Pragma("unroll") for (int k = 0; k < 2; ++k) \
            acc[ai][bj][m][n] = __builtin_amdgcn_mfma_f32_16x16x32_bf16(Bt[n][k], At[m][k], acc[ai][bj][m][n], 0, 0, 0); } \
        __builtin_amdgcn_s_setprio(0); } while (0)
#define PG8_WAIT_V(n) asm volatile("s_waitcnt vmcnt(" #n ")" ::: "memory")
#define PG8_WAIT_L(n) asm volatile("s_waitcnt lgkmcnt(" #n ")" ::: "memory")
#define PG8_BAR __builtin_amdgcn_s_barrier()
#define PG8_SCHED __builtin_amdgcn_sched_barrier(0)
#define PG8_LOAD_VA(dst, u) do { _Pragma("unroll") for (int _h = 0; _h < 2; ++_h) _Pragma("unroll") for (int _i = 0; _i < 2; ++_i) { const int _row = _h * HALF + Ra[_i]; \
        if constexpr (GATHER) { const int _tok = (_row < (u).nvalid) ? g.list[((u).lrow + _row) * g.lstride] : 0; dst[_h][_i] = (unsigned)(_tok * K + Ca[_i]) * 2u; } \
        else dst[_h][_i] = (unsigned)(_row * K + Ca[_i]) * 2u; } } while (0)
    Unit cur, nxt; int ui = 0;
    if (!S.next(0, cur)) return;
    unsigned vAc[2][2], vAn[2][2];
    PG8_LOAD_VA(vAc, cur);
    f32x4 acc[2][2][4][2];
#pragma unroll
    for (int a = 0; a < 2; ++a)
#pragma unroll
        for (int b = 0; b < 2; ++b)
#pragma unroll
            for (int m = 0; m < 4; ++m)
#pragma unroll
                for (int n = 0; n < 2; ++n) acc[a][b][m][n] = (f32x4){0.f, 0.f, 0.f, 0.f};
    bf16x8 At[4][2], B0[2][2], B1[2][2];
    const int one_e8m0 = 0x7f7f7f7f; (void)one_e8m0;
    unsigned cA = (unsigned)cur.arow * K * 2, cB = (unsigned)cur.e * (unsigned)g.bstride + (unsigned)cur.pn * tstep;
    unsigned cB2 = (unsigned)cur.e2 * (unsigned)g.bstride + (unsigned)cur.pn * tstep; const unsigned hk = (unsigned)(nt / 2) * kstep; (void)cB2; (void)hk;
    PG8_STAGE(PG8_SB(0, 0), gB, cB, voffB); PG8_STAGE(PG8_SB(0, 1), gB, cB + hstep, voffB); PG8_STAGE(PG8_SA(0, 0), gA, cA, vAc[0]); PG8_STAGE(PG8_SA(0, 1), gA, cA, vAc[1]);
    if (wr == 1) PG8_BAR;
    PG8_WAIT_V(2); PG8_BAR;
    PG8_STAGE(PG8_SB(1, 0), gB, cB + kstep, voffB); PG8_STAGE(PG8_SA(1, 0), gA, cA + kstep, vAc[0]); PG8_STAGE(PG8_SB(1, 1), gB, cB + hstep + kstep, voffB);
    PG8_WAIT_V(6); PG8_BAR;
    for (;;) {
        const bool has_next = S.next(ui + 1, nxt);
        const unsigned nA = has_next ? (unsigned)nxt.arow * K * 2 : cA;
        const unsigned nB = has_next ? (unsigned)nxt.e * (unsigned)g.bstride + (unsigned)nxt.pn * tstep : cB;
        const unsigned nB2 = has_next ? (unsigned)nxt.e2 * (unsigned)g.bstride + (unsigned)nxt.pn * tstep : cB2; (void)nB2;
        if (has_next) { PG8_LOAD_VA(vAn, nxt); }
        else {
#pragma unroll
            for (int h = 0; h < 2; ++h)
#pragma unroll
                for (int i = 0; i < 2; ++i) vAn[h][i] = vAc[h][i]; }
#pragma unroll 1
        for (int t = 0; t < nt; t += 2) {
            const bool last = (t == nt - 2);
            if constexpr (Epi::MID) { if (t == nt / 2) E.mid(acc, cur, wr, wc, fr, fq); }
            const unsigned a1 = cA + (unsigned)(t + 1) * kstep;
            const unsigned a2 = last ? nA : cA + (unsigned)(t + 2) * kstep;
            unsigned b2 = last ? nB : cB + (unsigned)(t + 2) * kstep;
            if constexpr (BSPLIT) { if (!last && t + 2 >= nt / 2) b2 = cB2 + (unsigned)(t + 2) * kstep - hk; }
            const unsigned a3 = a2 + kstep, b3 = b2 + kstep;
            unsigned v2[2][2];
#pragma unroll
            for (int h = 0; h < 2; ++h)
#pragma unroll
                for (int i = 0; i < 2; ++i) v2[h][i] = vAc[h][i];
            if (last) { asm volatile("" ::: "memory");
#pragma unroll
                for (int h = 0; h < 2; ++h)
#pragma unroll
                    for (int i = 0; i < 2; ++i) v2[h][i] = vAn[h][i]; }
            PG8_LDB(B0, 0, 0); PG8_LDB(B1, 0, 1); PG8_SCHED; PG8_LDA(At, 0, 0); PG8_STAGE(PG8_SA(1, 1), gA, a1, vAc[1]);
            PG8_WAIT_V(8); PG8_WAIT_L(0); PG8_BAR; PG8_MMA(0, 0, At, B0); PG8_MMA(0, 1, At, B1); PG8_BAR; PG8_SCHED;
            PG8_LDA(At, 0, 1); PG8_STAGE(PG8_SB(0, 0), gB, b2, voffB); PG8_STAGE(PG8_SB(0, 1), gB, b2 + hstep, voffB); PG8_STAGE(PG8_SA(0, 0), gA, a2, v2[0]);
            PG8_WAIT_V(8); PG8_WAIT_L(0); PG8_BAR; PG8_MMA(1, 0, At, B0); PG8_MMA(1, 1, At, B1); PG8_BAR; PG8_SCHED;
            PG8_LDB(B0, 1, 0); PG8_LDB(B1, 1, 1); PG8_SCHED; PG8_LDA(At, 1, 0); PG8_STAGE(PG8_SA(0, 1), gA, a2, v2[1]);
            PG8_WAIT_V(8); PG8_WAIT_L(0); PG8_BAR; PG8_MMA(0, 0, At, B0); PG8_MMA(0, 1, At, B1); PG8_BAR; PG8_SCHED;
            PG8_LDA(At, 1, 1); PG8_STAGE(PG8_SB(1, 0), gB, b3, voffB); PG8_STAGE(PG8_SB(1, 1), gB, b3 + hstep, voffB); PG8_STAGE(PG8_SA(1, 0), gA, a3, v2[0]);
            PG8_WAIT_V(8); PG8_WAIT_L(0); PG8_BAR; PG8_MMA(1, 0, At, B0); PG8_MMA(1, 1, At, B1); PG8_BAR; PG8_SCHED;
        }
        if constexpr (ALIGN_EPI) { if (wr == 0) PG8_BAR; }
        if constexpr (FP8) asm volatile("s_nop 15\n\ts_nop 15\n\ts_nop 15\n\ts_nop 15" ::: "memory");
        E(acc, cur, wr, wc, fr, fq);
        if (!has_next) break;
#pragma unroll
        for (int a = 0; a < 2; ++a)
#pragma unroll
            for (int b = 0; b < 2; ++b)
#pragma unroll
                for (int m = 0; m < 4; ++m)
#pragma unroll
                    for (int n = 0; n < 2; ++n) acc[a][b][m][n] = (f32x4){0.f, 0.f, 0.f, 0.f};
        cur = nxt; cA = nA; cB = nB; cB2 = nB2; ++ui;
#pragma unroll
        for (int h = 0; h < 2; ++h)
#pragma unroll
            for (int i = 0; i < 2; ++i) vAc[h][i] = vAn[h][i];
        if constexpr (ALIGN_EPI) { if (wr == 1) PG8_BAR; }
    }
    PG8_WAIT_V(0);
    if constexpr (!ALIGN_EPI) { if (wr == 0) PG8_BAR; }
    PG8_BAR;
#undef PG8_SA
#undef PG8_SB
#undef PG8_STAGE
#undef PG8_LDA
#undef PG8_LDB
#undef PG8_MMA
#undef PG8_WAIT_V
#undef PG8_WAIT_L
#undef PG8_BAR
#undef PG8_SCHED
#undef PG8_LOAD_VA
}
}

namespace attn_body {
using bf16=__hip_bfloat16;
using bf16x8=__attribute__((ext_vector_type(8)))short;
using s16x4=__attribute__((ext_vector_type(4)))short;
using f32x16=__attribute__((ext_vector_type(16)))float;
using u32x4=__attribute__((ext_vector_type(4)))unsigned;
constexpr int D=64, QP=512, KP=512, VP=512, OP=1024;
constexpr int NW=8,QBLK=32,QB=QBLK*NW,KVBLK=64;
constexpr int ATTN_UNIT_ROWS=QB;
__device__ __forceinline__ int crow(int r,int hi){return (r&3)+8*(r>>2)+4*hi;}
#define SBAR() __builtin_amdgcn_sched_barrier(0)
__device__ __forceinline__ void cmask(f32x16&p0,f32x16&p1,int jb,int qrel,int hi){
  const float NEG=-INFINITY; int kb=64*jb+4*hi;
  #pragma unroll
  for(int r=0;r<16;++r){int kv=kb+(r&3)+8*(r>>2); if(kv>qrel)p0[r]=NEG; if(kv+32>qrel)p1[r]=NEG;}
}

constexpr int NSLOT=3, SLOTB=8192, VSLOTB=16384;
constexpr int LDS_K=0, LDS_V=NSLOT*SLOTB, LDS_WS=LDS_V+NSLOT*VSLOTB, LDS_OST=LDS_WS+NW*64*4, LDS_BYTES=LDS_OST+NW*4096;
constexpr float C2=0.125f*1.4426950408889634f;
__device__ __forceinline__ void glds16(const void*gsrc,unsigned lds_dst){unsigned keep;
  asm volatile("s_mov_b32 %0, m0\n\ts_mov_b32 m0, %2\n\ts_nop 0\n\tglobal_load_lds_dwordx4 %1, off\n\ts_mov_b32 m0, %0":"=&s"(keep):"v"(gsrc),"s"(lds_dst):"memory");}
__device__ __forceinline__ float max3f(float a,float b,float c){float r;asm("v_max3_f32 %0, %1, %2, %3":"=v"(r):"v"(a),"v"(b),"v"(c));return r;}
__device__ __forceinline__ float max2f(float a,float b){float r;asm("v_max_f32_e32 %0, %1, %2":"=v"(r):"v"(a),"v"(b));return r;}
__device__ __forceinline__ float fadd_s(float a,float b){float r;asm("v_add_f32_e32 %0, %1, %2":"=v"(r):"v"(a),"v"(b));return r;}
__device__ __forceinline__ float fsub_s(float a,float b){float r;asm("v_sub_f32_e32 %0, %1, %2":"=v"(r):"v"(a),"v"(b));return r;}
typedef float f32x2_t __attribute__((ext_vector_type(2))); typedef __bf16 bf16x2_t __attribute__((ext_vector_type(2)));
__device__ __forceinline__ unsigned cvtpk_s(float lo,float hi){f32x2_t v={lo,hi};bf16x2_t b=__builtin_convertvector(v,bf16x2_t);return __builtin_bit_cast(unsigned,b);}
#define WAIT_BAR(N) asm volatile("s_waitcnt vmcnt(" #N ") lgkmcnt(0)\n\ts_barrier":::"memory")

__device__ __forceinline__ void qkt(f32x16&p0,f32x16&p1,const char*Kslot,const bf16x8*qr,const f32x16&negm,int r32,int hi){
  const char*kb=Kslot+hi*1024+r32*16;
  #pragma unroll
  for(int d0=0;d0<4;++d0){
    const bf16x8 b0=*reinterpret_cast<const bf16x8*>(kb+d0*2048);
    const bf16x8 b1=*reinterpret_cast<const bf16x8*>(kb+d0*2048+512);
    if(d0==0){p0=__builtin_amdgcn_mfma_f32_32x32x16_bf16(b0,qr[0],negm,0,0,0);p1=__builtin_amdgcn_mfma_f32_32x32x16_bf16(b1,qr[0],negm,0,0,0);}
    else{p0=__builtin_amdgcn_mfma_f32_32x32x16_bf16(b0,qr[d0],p0,0,0,0);p1=__builtin_amdgcn_mfma_f32_32x32x16_bf16(b1,qr[d0],p1,0,0,0);}}
}
typedef __attribute__((address_space(3))) const char* lds_cptr;
typedef short v4i16_t __attribute__((ext_vector_type(4)));
__device__ __forceinline__ void kload8(bf16x8*kf,lds_cptr kp){
  kf[0]=*(const __attribute__((address_space(3))) bf16x8*)(kp);      kf[1]=*(const __attribute__((address_space(3))) bf16x8*)(kp+512);
  kf[2]=*(const __attribute__((address_space(3))) bf16x8*)(kp+2048); kf[3]=*(const __attribute__((address_space(3))) bf16x8*)(kp+2560);
  kf[4]=*(const __attribute__((address_space(3))) bf16x8*)(kp+4096); kf[5]=*(const __attribute__((address_space(3))) bf16x8*)(kp+4608);
  kf[6]=*(const __attribute__((address_space(3))) bf16x8*)(kp+6144); kf[7]=*(const __attribute__((address_space(3))) bf16x8*)(kp+6656);
}
__device__ __forceinline__ void kload2(bf16x8*kf,lds_cptr kp,int j){ kf[2*j]=*(const __attribute__((address_space(3))) bf16x8*)(kp+j*2048); kf[2*j+1]=*(const __attribute__((address_space(3))) bf16x8*)(kp+j*2048+512); }
__device__ __forceinline__ s16x4 vtr(lds_cptr p){ return __builtin_bit_cast(s16x4,__builtin_amdgcn_ds_read_tr16_b64_v4i16((__attribute__((address_space(3))) v4i16_t*)p)); }
__device__ __forceinline__ float rowmax(const f32x16&p0,const f32x16&p1){
  float a=max3f(p0[0],p0[1],p1[0]),b=max3f(p0[2],p0[3],p1[1]);a=max3f(a,p1[2],p1[3]);
  #pragma unroll
  for(int r=4;r<16;r+=4){a=max3f(a,p0[r],p0[r+1]);b=max3f(b,p0[r+2],p0[r+3]);a=max3f(a,p1[r],p1[r+1]);b=max3f(b,p1[r+2],p1[r+3]);}
  const float m=max2f(a,b);
  auto rr=__builtin_amdgcn_permlane32_swap(__float_as_uint(m),__float_as_uint(m),false,false);
  return max2f(__uint_as_float(rr[0]),__uint_as_float(rr[1]));
}
__device__ __forceinline__ void pv(f32x16*o,int vb,bf16x8 pa0,bf16x8 pa1,bf16x8 pa2,bf16x8 pa3){
  #pragma unroll
  for(int d0=0;d0<4;++d0){s16x4 lo[4],hi[4];
    #pragma unroll
    for(int ks=0;ks<4;++ks){
      asm volatile("ds_read_b64_tr_b16 %0,%1 offset:%c2":"=&v"(lo[ks]):"v"(vb),"i"(d0*4096+ks*1024):"memory");
      asm volatile("ds_read_b64_tr_b16 %0,%1 offset:%c2":"=&v"(hi[ks]):"v"(vb),"i"(d0*4096+ks*1024+512):"memory");}
    asm volatile("s_waitcnt lgkmcnt(0)":::"memory");SBAR();
    #define PK(k) (bf16x8){lo[k][0],lo[k][1],lo[k][2],lo[k][3],hi[k][0],hi[k][1],hi[k][2],hi[k][3]}
    o[d0]=__builtin_amdgcn_mfma_f32_32x32x16_bf16(pa0,PK(0),o[d0],0,0,0);
    o[d0]=__builtin_amdgcn_mfma_f32_32x32x16_bf16(pa1,PK(1),o[d0],0,0,0);
    o[d0]=__builtin_amdgcn_mfma_f32_32x32x16_bf16(pa2,PK(2),o[d0],0,0,0);
    o[d0]=__builtin_amdgcn_mfma_f32_32x32x16_bf16(pa3,PK(3),o[d0],0,0,0);
    #undef PK
  }
}

#ifndef ATTN_STORE16
#define ATTN_STORE16(p,v) (*(u32x4*)(p)=(v))
#endif
template<int THRL,bool STAT> __device__ __forceinline__ int attn_unit(float mstat,int q0,const bf16*Q,const bf16*__restrict__ K,const bf16*__restrict__ V,bf16*O,char*shm,const bf16*O1,float lam,const float*subg,unsigned short*CAo,const bf16*Knext,const bf16*Vnext,int s0,bool pre){
  #define NXT_(x) (((x)==(NSLOT-1)*SLOTB)?0:(x)+SLOTB)
  const int s1=NXT_(s0),s2=NXT_(s1);
  int tid_=threadIdx.x; asm volatile("":"+v"(tid_));
  const int tid=tid_,lane=tid&63,r32=lane&31,hi=lane>>5; const int wid=__builtin_amdgcn_readfirstlane(tid>>6);
  const bf16*Qw=Q+(long)(q0+wid*QBLK)*QP;
  const bf16*Kh=K,*Vh=V;
  const unsigned lds0=(unsigned)(uintptr_t)shm;
  float*wsf=(float*)(shm+LDS_WS)+wid*64;
  const bf16*ksrc=Kh+(long)lane*KP+wid*8;
  const bf16*vsrc=Vh+(long)(16*(wid&3)+(lane>>2))*VP+(wid>>2)*32+(lane&3)*8;
  const unsigned kdst=lds0+LDS_K+wid*1024, vdst=lds0+LDS_V+wid*1024;
  #define DMA_K(t,slot) glds16(ksrc+(long)(t)*KVBLK*KP,(unsigned)__builtin_amdgcn_readfirstlane(kdst+(slot)))
  #define DMA_V(t,slot) do{ glds16(vsrc+(long)(t)*KVBLK*VP,(unsigned)__builtin_amdgcn_readfirstlane(vdst+2*(slot))); glds16(vsrc+(long)(t)*KVBLK*VP+64,(unsigned)__builtin_amdgcn_readfirstlane(vdst+2*(slot)+8192)); }while(0)
  const int vb0=(int)(lds0+LDS_V)+((lane>>4)&1)*32+(lane&3)*8+(4*hi+((lane&15)>>2))*64;
  const char*Kbase=shm+LDS_K; bf16x8 kf[8];
  const lds_cptr shm3=(lds_cptr)shm; const lds_cptr kp0=shm3+LDS_K+hi*1024+r32*16; const lds_cptr vp0=shm3+LDS_V+((lane>>4)&1)*32+(lane&3)*8+(4*hi+((lane&15)>>2))*64;
  const int NT=(q0+QB)/KVBLK;
  if(!pre){DMA_K(0,s0);DMA_V(0,s0);DMA_K(1,s1);}
  bf16x8 qr[4];
  #pragma unroll
  for(int d0=0;d0<4;++d0)qr[d0]=*reinterpret_cast<const bf16x8*>(&Qw[(long)r32*QP+d0*16+hi*8]);
  float mhat=0.f,l_reg=0.f;f32x16 o[4];{float zz=0.f;asm volatile("":"+v"(zz));
  #pragma unroll
  for(int r=0;r<16;++r){o[0][r]=zz;o[1][r]=zz;o[2][r]=zz;o[3][r]=zz;}}
  f32x16 negm;{float zn=0.f;asm volatile("":"+v"(zn));
  #pragma unroll
  for(int r=0;r<16;++r)negm[r]=zn;}
  asm volatile("":"+v"(negm));
  const int qrel=wid*QBLK+r32;
  #define CMASK(P0,P1,t) do{int jb_=(t)-(NT-4); if(jb_>=0)cmask(P0,P1,jb_,qrel,hi);}while(0)
  bool resc=false;
  #define START(P0,P1) do{ float rm; if constexpr (STAT) rm=mstat; else rm=rowmax(P0,P1); resc=false; \
    { const float dl=rm; mhat=fadd_s(mhat,dl); \
      _Pragma("unroll") for(int r=0;r<16;++r){P0[r]=fsub_s(P0[r],dl);P1[r]=fsub_s(P1[r],dl);} \
      _Pragma("unroll") for(int r=0;r<16;++r)negm[r]=-mhat; asm volatile("":"+v"(negm)); } \
    _Pragma("unroll") for(int r=0;r<16;++r)P0[r]=__builtin_amdgcn_exp2f(P0[r]); }while(0)
  #define RESC() do{ if(resc){ asm volatile("s_waitcnt lgkmcnt(0)":::"memory"); \
      _Pragma("unroll") for(int d_=0;d_<4;++d_) _Pragma("unroll") for(int r=0;r<16;++r)o[d_][r]*=wsf[crow(r,hi)]; } }while(0)
  f32x16 pA0,pA1,pB0,pB1;
  int sl_prev=s0,sl_cur=s0,sl_next=s1;
  #define ROT() do{sl_prev=sl_cur;sl_cur=sl_next;sl_next=(sl_next==(NSLOT-1)*SLOTB)?0:sl_next+SLOTB;}while(0)
  if(!pre){DMA_K(2,s2);}
  WAIT_BAR(4);
  qkt(pA0,pA1,Kbase+s0,qr,negm,r32,hi);asm volatile("s_nop 15\n\ts_nop 7":"+v"(pA0),"+v"(pA1));CMASK(pA0,pA1,0);
  START(pA0,pA1);
  _Pragma("unroll") for(int r=0;r<16;++r)pA1[r]=__builtin_amdgcn_exp2f(pA1[r]);
  WAIT_BAR(0);
  DMA_K(3,s0);DMA_V(1,s1);
  ROT();
  kload8(kf,kp0+sl_cur);
  WAIT_BAR(3);
  s16x4 vlo[8],vhi[8]; u32x4 pw0,pw1,pw2,pw3;
  #define PKW(P,B) cvtpk_s(P[B],P[B+1])
  #define PAF(k) __builtin_bit_cast(bf16x8,pw##k)
  #define VFR(i) (bf16x8){vlo[i][0],vlo[i][1],vlo[i][2],vlo[i][3],vhi[i][0],vhi[i][1],vhi[i][2],vhi[i][3]}
  #define PIN(x) asm volatile("":"+v"(x))
  #define MX3(a,b,c) __builtin_fmaxf(__builtin_fmaxf((a),(b)),(c))
  #define GAPA(MF,A0,A1,A2,A3,W0,W1,PW) do{ MF; sacc+=A0; sacc+=A1; sacc+=A2; sacc+=A3; PIN(sacc); W0; W1; PIN(PW); SBAR(); }while(0)
  #define EX(v) __builtin_amdgcn_exp2f(v)
  #define GAPB2(MF,X,B) do{ MF; X[B]=EX(X[B]); X[B+1]=EX(X[B+1]); PIN(X); SBAR(); }while(0)
  #define VRD2(i) do{ vlo[i]=vtr(vp_+((((i)>>2)+2)*4096+((i)&3)*1024)); vhi[i]=vtr(vp_+((((i)>>2)+2)*4096+((i)&3)*1024+512)); }while(0)
  #define VRD(i) do{ vlo[i]=vtr(vp_+(((i)>>2)*4096+((i)&3)*1024)); vhi[i]=vtr(vp_+(((i)>>2)*4096+((i)&3)*1024+512)); }while(0)
  #define KRD(G,j) do{ if(G){ kload2(kf,kp0+sl_next,j); SBAR(); } }while(0)
  #define STEP(C0,C1,P0,P1,t,GK,GV,GL) do{ SBAR(); \
    const lds_cptr vp_=vp0+2*sl_prev; \
    VRD(0); SBAR(); float sacc=(P0[0]+P0[1]); \
    GAPA(C0=__builtin_amdgcn_mfma_f32_32x32x16_bf16(kf[0],qr[0],negm,0,0,0), P0[2],P0[3],P0[4],P0[5],     pw0[0]=PKW(P0,0), pw0[1]=PKW(P0,2), pw0); \
    VRD(4); SBAR(); GAPA(C1=__builtin_amdgcn_mfma_f32_32x32x16_bf16(kf[1],qr[0],negm,0,0,0), P0[6],P0[7],P0[8],P0[9],     pw0[2]=PKW(P0,4), pw0[3]=PKW(P0,6), pw0); \
    VRD(1); SBAR(); GAPA(C0=__builtin_amdgcn_mfma_f32_32x32x16_bf16(kf[2],qr[1],C0,0,0,0),   P0[10],P0[11],P0[12],P0[13], pw1[0]=PKW(P0,8), pw1[1]=PKW(P0,10), pw1); \
    VRD(5); SBAR(); GAPA(C1=__builtin_amdgcn_mfma_f32_32x32x16_bf16(kf[3],qr[1],C1,0,0,0),   P0[14],P0[15],P1[0],P1[1],   pw1[2]=PKW(P0,12),pw1[3]=PKW(P0,14), pw1); \
    VRD(2); SBAR(); GAPA(C0=__builtin_amdgcn_mfma_f32_32x32x16_bf16(kf[4],qr[2],C0,0,0,0),   P1[2],P1[3],P1[4],P1[5],     pw2[0]=PKW(P1,0), pw2[1]=PKW(P1,2), pw2); \
    VRD(6); SBAR(); GAPA(C1=__builtin_amdgcn_mfma_f32_32x32x16_bf16(kf[5],qr[2],C1,0,0,0),   P1[6],P1[7],P1[8],P1[9],     pw2[2]=PKW(P1,4), pw2[3]=PKW(P1,6), pw2); \
    VRD(3); SBAR(); GAPA(C0=__builtin_amdgcn_mfma_f32_32x32x16_bf16(kf[6],qr[3],C0,0,0,0),   P1[10],P1[11],P1[12],P1[13], pw3[0]=PKW(P1,8), pw3[1]=PKW(P1,10), pw3); \
    VRD(7); SBAR(); GAPA(C1=__builtin_amdgcn_mfma_f32_32x32x16_bf16(kf[7],qr[3],C1,0,0,0),   P1[14],P1[15],0.f,0.f,       pw3[2]=PKW(P1,12),pw3[3]=PKW(P1,14), pw3); \
    l_reg+=sacc; \
    if(GK){DMA_K((t)+3,sl_cur);} if(GV){DMA_V((t)+1,sl_next);} \
    CMASK(C0,C1,t); \
    if constexpr (!STAT) { float a=MX3(C0[0],C0[1],C1[0]),b=MX3(C0[2],C0[3],C1[1]); a=MX3(a,C1[2],C1[3]); \
      _Pragma("unroll") for(int r=4;r<16;r+=4){a=MX3(a,C0[r],C0[r+1]);b=MX3(b,C0[r+2],C0[r+3]);a=MX3(a,C1[r],C1[r+1]);b=MX3(b,C1[r+2],C1[r+3]);} \
      float rm=__builtin_fmaxf(a,b); { auto rr=__builtin_amdgcn_permlane32_swap(__float_as_uint(rm),__float_as_uint(rm),false,false); rm=__builtin_fmaxf(__uint_as_float(rr[0]),__uint_as_float(rr[1])); } \
      resc=false; \
      if(__builtin_expect(__any(rm>(float)THRL),0)){ const float dl=__builtin_fmaxf(rm,0.f); mhat+=dl; \
        _Pragma("unroll") for(int r=0;r<16;++r){C0[r]-=dl;C1[r]-=dl;} \
        _Pragma("unroll") for(int r=0;r<16;++r)negm[r]=-mhat; asm volatile("":"+v"(negm)); \
        const float f=__builtin_amdgcn_exp2f(-dl); l_reg*=f; if(hi==0)wsf[r32]=f; resc=true; } } \
    SBAR(); \
    GAPB2(o[0]=__builtin_amdgcn_mfma_f32_32x32x16_bf16(PAF(0),VFR(0),o[0],0,0,0), C0,0);  VRD2(0); SBAR(); \
    GAPB2(o[1]=__builtin_amdgcn_mfma_f32_32x32x16_bf16(PAF(0),VFR(4),o[1],0,0,0), C0,2);  VRD2(4); SBAR(); \
    GAPB2(o[0]=__builtin_amdgcn_mfma_f32_32x32x16_bf16(PAF(1),VFR(1),o[0],0,0,0), C0,4);  VRD2(1); SBAR(); \
    GAPB2(o[1]=__builtin_amdgcn_mfma_f32_32x32x16_bf16(PAF(1),VFR(5),o[1],0,0,0), C0,6);  VRD2(5); SBAR(); \
    GAPB2(o[0]=__builtin_amdgcn_mfma_f32_32x32x16_bf16(PAF(2),VFR(2),o[0],0,0,0), C0,8);  VRD2(2); SBAR(); \
    GAPB2(o[1]=__builtin_amdgcn_mfma_f32_32x32x16_bf16(PAF(2),VFR(6),o[1],0,0,0), C0,10); VRD2(6); SBAR(); \
    GAPB2(o[0]=__builtin_amdgcn_mfma_f32_32x32x16_bf16(PAF(3),VFR(3),o[0],0,0,0), C0,12); VRD2(3); SBAR(); \
    GAPB2(o[1]=__builtin_amdgcn_mfma_f32_32x32x16_bf16(PAF(3),VFR(7),o[1],0,0,0), C0,14); VRD2(7); SBAR(); \
    GAPB2(o[2]=__builtin_amdgcn_mfma_f32_32x32x16_bf16(PAF(0),VFR(0),o[2],0,0,0), C1,0); \
    GAPB2(o[3]=__builtin_amdgcn_mfma_f32_32x32x16_bf16(PAF(0),VFR(4),o[3],0,0,0), C1,2); \
    KRD(GL,0); GAPB2(o[2]=__builtin_amdgcn_mfma_f32_32x32x16_bf16(PAF(1),VFR(1),o[2],0,0,0), C1,4); \
    KRD(GL,1); GAPB2(o[3]=__builtin_amdgcn_mfma_f32_32x32x16_bf16(PAF(1),VFR(5),o[3],0,0,0), C1,6); \
    KRD(GL,2); GAPB2(o[2]=__builtin_amdgcn_mfma_f32_32x32x16_bf16(PAF(2),VFR(2),o[2],0,0,0), C1,8); \
    KRD(GL,3); GAPB2(o[3]=__builtin_amdgcn_mfma_f32_32x32x16_bf16(PAF(2),VFR(6),o[3],0,0,0), C1,10); \
    GAPB2(o[2]=__builtin_amdgcn_mfma_f32_32x32x16_bf16(PAF(3),VFR(3),o[2],0,0,0), C1,12); \
    GAPB2(o[3]=__builtin_amdgcn_mfma_f32_32x32x16_bf16(PAF(3),VFR(7),o[3],0,0,0), C1,14); \
    }while(0)
  int t=1;
  #undef CMASK
  #define CMASK(P0,P1,t) do{}while(0)
  for(;t+5<NT;t+=2){
    STEP(pB0,pB1,pA0,pA1,t,true,true,true);     WAIT_BAR(3); RESC(); ROT();
    STEP(pA0,pA1,pB0,pB1,t+1,true,true,true);   WAIT_BAR(3); RESC(); ROT();
  }
  #undef CMASK
  #define CMASK(P0,P1,t) do{int jb_=(t)-(NT-4); if(jb_>=0)cmask(P0,P1,jb_,qrel,hi);}while(0)
  #define ENDW(tt) do{ if((tt)+3<NT){WAIT_BAR(3);} else if((tt)+2<NT){WAIT_BAR(2);} else {WAIT_BAR(0);} }while(0)
  for(;t+1<NT;t+=2){
    STEP(pB0,pB1,pA0,pA1,t,(t+3<NT),(t+1<NT),(t+1<NT));       ENDW(t);   RESC(); ROT();
    STEP(pA0,pA1,pB0,pB1,t+1,(t+4<NT),(t+2<NT),(t+2<NT));     ENDW(t+1); RESC(); ROT();
  }
  int snext=0;
  if(Knext!=nullptr){
    const int p0=sl_next,p1=NXT_(p0),p2=NXT_(p1); snext=p0;
    const bf16*kn=Knext+(long)lane*KP+wid*8; const bf16*vn=Vnext+(long)(16*(wid&3)+(lane>>2))*VP+(wid>>2)*32+(lane&3)*8;
    glds16(kn,(unsigned)__builtin_amdgcn_readfirstlane(kdst+p0));
    glds16(vn,(unsigned)__builtin_amdgcn_readfirstlane(vdst+2*p0)); glds16(vn+64,(unsigned)__builtin_amdgcn_readfirstlane(vdst+2*p0+8192));
    glds16(kn+(long)KVBLK*KP,(unsigned)__builtin_amdgcn_readfirstlane(kdst+p1)); glds16(kn+(long)2*KVBLK*KP,(unsigned)__builtin_amdgcn_readfirstlane(kdst+p2)); }
  STEP(pB0,pB1,pA0,pA1,NT-1,false,false,false); RESC();
  { float sacc=pB0[0]+pB0[1]; _Pragma("unroll") for(int r=2;r<16;++r)sacc+=pB0[r]; _Pragma("unroll") for(int r=0;r<16;++r)sacc+=pB1[r]; l_reg+=sacc;
    pw0=(u32x4){PKW(pB0,0),PKW(pB0,2),PKW(pB0,4),PKW(pB0,6)};pw1=(u32x4){PKW(pB0,8),PKW(pB0,10),PKW(pB0,12),PKW(pB0,14)};pw2=(u32x4){PKW(pB1,0),PKW(pB1,2),PKW(pB1,4),PKW(pB1,6)};pw3=(u32x4){PKW(pB1,8),PKW(pB1,10),PKW(pB1,12),PKW(pB1,14)};
    SBAR(); pv(o,vb0+2*sl_cur,PAF(0),PAF(1),PAF(2),PAF(3)); }
  #undef PKW
  #undef PAF
  #undef VFR
  #undef PIN
  #undef MX3
  #undef GAPA
  #undef GAPB2
  #undef VRD2
  #undef EX
  #undef VRD
  #undef KRD
  #undef STEP
  #undef ENDW
  {auto rr=__builtin_amdgcn_permlane32_swap(__float_as_uint(l_reg),__float_as_uint(l_reg),false,false);l_reg=__uint_as_float(rr[0])+__uint_as_float(rr[1]);}
  if(hi==0)wsf[32+r32]=l_reg;asm volatile("s_waitcnt lgkmcnt(0)":::"memory");
  float rli[16];
  #pragma unroll
  for(int r=0;r<16;++r)rli[r]=__builtin_amdgcn_rcpf(wsf[32+crow(r,hi)]);
  bf16*Ow=O+(long)(q0+wid*QBLK)*OP;
  bf16*stg=(bf16*)(shm+LDS_OST)+wid*2048;
  if(O1==nullptr){
    #pragma unroll
    for(int hf=0;hf<2;++hf){
      #pragma unroll
      for(int r=0;r<16;++r){const int orow=crow(r,hi);
        #pragma unroll
        for(int d0=0;d0<2;++d0)stg[orow*64+d0*32+r32]=__float2bfloat16(o[2*hf+d0][r]*rli[r]);}
      asm volatile("s_waitcnt lgkmcnt(0)":::"memory");
      #pragma unroll
      for(int i=0;i<4;++i){const int row=i*8+(lane>>3),ch=lane&7; const u32x4 v=*(const u32x4*)(stg+row*64+ch*8); ATTN_STORE16(Ow+(long)row*OP+hf*64+ch*8,v);}
      asm volatile("s_waitcnt lgkmcnt(0)":::"memory"); }
  } else {
    const bf16*O1w=O1+(long)(q0+wid*QBLK)*OP; unsigned long long p1[2][4][2];
    #pragma unroll
    for(int hf=0;hf<2;++hf)
      #pragma unroll
      for(int i=0;i<4;++i){const int row=i*8+(lane>>3),ch=lane&7; unsigned long long*a=(unsigned long long*)(O1w+(long)row*OP+hf*64+ch*8);
        p1[hf][i][0]=__hip_atomic_load(a,__ATOMIC_RELAXED,__HIP_MEMORY_SCOPE_AGENT); p1[hf][i][1]=__hip_atomic_load(a+1,__ATOMIC_RELAXED,__HIP_MEMORY_SCOPE_AGENT);}
    float dd[2][4][8]; float ssp[4]={0.f,0.f,0.f,0.f};
    #pragma unroll
    for(int hf=0;hf<2;++hf){
      #pragma unroll
      for(int r=0;r<16;++r){const int orow=crow(r,hi);
        #pragma unroll
        for(int d0=0;d0<2;++d0)stg[orow*64+d0*32+r32]=__float2bfloat16(o[2*hf+d0][r]*rli[r]);}
      asm volatile("s_waitcnt lgkmcnt(0)":::"memory");
      #pragma unroll
      for(int i=0;i<4;++i){const int row=i*8+(lane>>3),ch=lane&7; const u32x4 v=*(const u32x4*)(stg+row*64+ch*8);
        const unsigned w1[4]={(unsigned)p1[hf][i][0],(unsigned)(p1[hf][i][0]>>32),(unsigned)p1[hf][i][1],(unsigned)(p1[hf][i][1]>>32)};
        #pragma unroll
        for(int j=0;j<4;++j){ const float a0=__uint_as_float(w1[j]<<16)-lam*__uint_as_float(v[j]<<16), a1=__uint_as_float(w1[j]&0xffff0000u)-lam*__uint_as_float(v[j]&0xffff0000u);
          dd[hf][i][2*j]=a0; dd[hf][i][2*j+1]=a1; ssp[i]+=a0*a0+a1*a1; } }
      asm volatile("s_waitcnt lgkmcnt(0)":::"memory"); }
    #pragma unroll
    for(int i=0;i<4;++i){ float ss=ssp[i]; ss+=__shfl_xor(ss,1); ss+=__shfl_xor(ss,2); ss+=__shfl_xor(ss,4);
      const float rn=1.0f/sqrtf(ss*(1.0f/128.0f)+1e-6f)*0.8f;
      const int row=i*8+(lane>>3),ch=lane&7;
      #pragma unroll
      for(int hf=0;hf<2;++hf){ const float*gp=subg+hf*64+ch*8; u32x4 w;
        w[0]=cvtpk_s(dd[hf][i][0]*rn*gp[0],dd[hf][i][1]*rn*gp[1]); w[1]=cvtpk_s(dd[hf][i][2]*rn*gp[2],dd[hf][i][3]*rn*gp[3]);
        w[2]=cvtpk_s(dd[hf][i][4]*rn*gp[4],dd[hf][i][5]*rn*gp[5]); w[3]=cvtpk_s(dd[hf][i][6]*rn*gp[6],dd[hf][i][7]*rn*gp[7]);
        *(u32x4*)(CAo+(long)(q0+wid*QBLK+row)*1024+hf*64+ch*8)=w; } }
  }
  asm volatile("s_waitcnt lgkmcnt(0)\n\ts_barrier":::"memory");
  #undef DMA_K
  #undef DMA_V
  #undef CMASK
  #undef START
  #undef RESC
  #undef ROT
  #undef NXT_
  return snext;
}
constexpr int ATTN_LDS_BYTES=LDS_BYTES;
#undef SBAR
#undef WAIT_BAR
}

constexpr int NWAVES = 8, NTHREADS = NWAVES * 64;
#ifndef MK_PER_PHASE
#define MK_PER_PHASE 0
#endif
#ifndef RUN_PHASES
#define RUN_PHASES 8
#endif
constexpr int N_PHASES = RUN_PHASES;

constexpr size_t MiB = 1u << 20;
constexpr size_t WS_CTL = 0, CTL_ZERO_BYTES = 65536;
constexpr size_t WS_RS = 1 * MiB;
constexpr size_t WS_TINFO = 2 * MiB;
constexpr size_t WS_WR = 3 * MiB;
constexpr size_t WS_LTOK = 4 * MiB, WS_LW = 8 * MiB;
constexpr size_t WS_WIN = 16 * MiB, WS_WCA = 25 * MiB, WS_WOUT = 27 * MiB;
constexpr size_t WS_A = 32 * MiB;
constexpr size_t WS_QB = 112 * MiB, WS_KB = 144 * MiB, WS_VB = 176 * MiB, WS_YG = 208 * MiB;
constexpr size_t WS_MG = 112 * MiB, WS_XM = 176 * MiB;
constexpr size_t WS_GT = 240 * MiB;
constexpr size_t WS_WGU = 240 * MiB, WS_WD = 304 * MiB;
constexpr size_t WS_CA = 368 * MiB;
constexpr size_t WS_YB = 112 * MiB;
constexpr size_t WS_LIST = 432 * MiB;
constexpr size_t WS_CTOK = 448 * MiB;
constexpr size_t WS_END = 464 * MiB;
static_assert(WS_A + (size_t)CROWS * 1024 <= WS_QB && WS_WD + (size_t)NEXP * 1024 * 512 <= WS_CA, "d_ws map");
static_assert(WS_WIN + (size_t)IN_COLS * 1024 * 2 <= WS_WCA, "d_ws map");

constexpr int RING_BYTES = 131072;
constexpr int META_OFF = RING_BYTES;
constexpr int HIST_OFF = RING_BYTES + 1024;
constexpr int BARST_OFF = RING_BYTES + 3072;
constexpr int META2_OFF = RING_BYTES + 4096;
constexpr int LDS_BYTES = 147456;

#define GAS __attribute__((address_space(1)))
#define LAS __attribute__((address_space(3)))
typedef unsigned short bf16;
typedef unsigned v4u __attribute__((ext_vector_type(4)));
typedef unsigned v2u __attribute__((ext_vector_type(2)));
typedef float f32x4 __attribute__((ext_vector_type(4)));
typedef float f32x16 __attribute__((ext_vector_type(16)));
typedef short bf16x8 __attribute__((ext_vector_type(8)));
using pg8::cvt_pk_bf16; using pg8::bf_lo; using pg8::bf_hi; using pg8::sigmoidf_fast; using pg8::pack8; using pg8::unpack8;

__device__ __forceinline__ float wave_sum(float v) {
    v += __int_as_float(__builtin_amdgcn_update_dpp(0, __float_as_int(v), 0xB1, 0xf, 0xf, true));
    v += __int_as_float(__builtin_amdgcn_update_dpp(0, __float_as_int(v), 0x4E, 0xf, 0xf, true));
    v += __int_as_float(__builtin_amdgcn_update_dpp(0, __float_as_int(v), 0x141, 0xf, 0xf, true));
    v += __int_as_float(__builtin_amdgcn_update_dpp(0, __float_as_int(v), 0x140, 0xf, 0xf, true));
    const int iv = __float_as_int(v);
    return (__int_as_float(__builtin_amdgcn_readlane(iv, 0)) + __int_as_float(__builtin_amdgcn_readlane(iv, 16))) + (__int_as_float(__builtin_amdgcn_readlane(iv, 32)) + __int_as_float(__builtin_amdgcn_readlane(iv, 48)));
}
__device__ __forceinline__ float bf16_round(float x) { return bf_lo(cvt_pk_bf16(x, 0.f) & 0xffffu); }

#define XB_TMO      128
#define XB_XCNT(j)  (256  + 64 * (j))
#define XB_XSUB(j)  (1280 + 64 * (j))
#define XB_XGEN(j)  (2304 + 64 * (j))
#define XB_TOP      3328
#define XB_TOPGEN   3392
#define XCD_BAR_WORDS 3456
#define XB_SPIN_CAP (1u << 18)

__device__ __forceinline__ unsigned xb_ld(unsigned* p)              { return __hip_atomic_load(p, __ATOMIC_RELAXED, __HIP_MEMORY_SCOPE_AGENT); }
__device__ __forceinline__ unsigned xb_add(unsigned* p, unsigned v) { return __hip_atomic_fetch_add(p, v, __ATOMIC_RELAXED, __HIP_MEMORY_SCOPE_AGENT); }
__device__ __forceinline__ unsigned xb_xcc_id() { return (unsigned)__builtin_amdgcn_s_getreg((3 << 11) | 20) & 0xFu; }
#define XB_SPIN(cond, bar) do { unsigned _sp = 0; while (cond) { __builtin_amdgcn_s_sleep(1); \
    if ((++_sp & 255u) == 0u) { if (xb_ld(&(bar)[XB_TMO])) break; if (_sp > XB_SPIN_CAP) { atomicAdd(&(bar)[XB_TMO], 1u); break; } } } } while (0)

struct XcdBarrier {
    unsigned* bar; unsigned x;
    volatile LAS unsigned* st;
};

__device__ __forceinline__ XcdBarrier xcd_barrier_post(unsigned* bar, volatile LAS unsigned* st) {
    XcdBarrier b; b.bar = bar; b.x = xb_xcc_id(); b.st = st;
    if (threadIdx.x == 0) (void)xb_add(&bar[XB_XCNT(b.x)], 1u);
    return b;
}
__device__ __forceinline__ void xcd_barrier_complete(unsigned* bar, unsigned x, unsigned& nloc, unsigned& nx) {
    const unsigned G = gridDim.x * gridDim.y * gridDim.z;
    unsigned sum, cnt, mine, sp = 0u;
    for (;;) {
        sum = 0u; cnt = 0u; mine = 0u;
#pragma unroll
        for (unsigned j = 0; j < 16; ++j) { const unsigned c = xb_ld(&bar[XB_XCNT(j)]); sum += c; cnt += (c > 0u) ? 1u : 0u; mine = (j == x) ? c : mine; }
        if (sum == G) break;
        __builtin_amdgcn_s_sleep(1);
        if ((++sp & 255u) == 0u) { if (xb_ld(&bar[XB_TMO])) break; if (sp > XB_SPIN_CAP) { atomicAdd(&bar[XB_TMO], 1u); break; } }
    }
    nloc = mine > 0u ? mine : 1u; nx = cnt > 0u ? cnt : 1u;
}

__device__ __forceinline__ void xcd_barrier(const XcdBarrier& b) {
    asm volatile("s_waitcnt vmcnt(0)" ::: "memory");
    __syncthreads();
    if (threadIdx.x == 0) {
        unsigned* bar = b.bar;
        __builtin_amdgcn_s_waitcnt(0);
        unsigned nloc = b.st[0], nx = b.st[1];
        if (nloc == 0u) { xcd_barrier_complete(bar, b.x, nloc, nx); b.st[0] = nloc; b.st[1] = nx; }
        const unsigned old = xb_add(&bar[XB_XSUB(b.x)], 1u);
        const unsigned gen = old / nloc;
        if (old + 1u == (gen + 1u) * nloc) {
            __builtin_amdgcn_fence(__ATOMIC_RELEASE, "agent");
            asm volatile("s_waitcnt vmcnt(0)" ::: "memory");
            const unsigned og = xb_add(&bar[XB_TOP], 1u);
            const unsigned tg = og / nx;
            if (og + 1u == (tg + 1u) * nx) xb_add(&bar[XB_TOPGEN], 1u);
            else XB_SPIN(xb_ld(&bar[XB_TOPGEN]) == tg, bar);
            __builtin_amdgcn_fence(__ATOMIC_ACQUIRE, "agent");
            xb_add(&bar[XB_XGEN(b.x)], 1u);
            asm volatile("s_waitcnt vmcnt(0)" ::: "memory");
        } else {
            XB_SPIN(xb_ld(&bar[XB_XGEN(b.x)]) == gen, bar);
            __builtin_amdgcn_fence(__ATOMIC_ACQUIRE, "agent");
            asm volatile("s_waitcnt vmcnt(0)" ::: "memory");
        }
    }
    __syncthreads();
}


typedef f32x4 AccT[2][2][4][2];
struct EpiInProj {
    static constexpr bool MID = false;
    bf16 *YG, *QB, *KB, *VB, *GT; const LAS float* gl;
    __device__ __forceinline__ void mid(AccT&, const pg8::Unit&, int, int, int, int) const {}
    __device__ __forceinline__ void operator()(AccT& acc, const pg8::Unit& u, int wr, int wc, int fr, int fq) const {
        asm volatile("" : "+v"(fr), "+v"(fq));
        const int pn = u.pn; const size_t row0 = (size_t)u.orow + wr * 64 + fr;
        if (pn < 4) {
#pragma unroll
            for (int ai = 0; ai < 2; ++ai)
#pragma unroll
                for (int m = 0; m < 4; ++m) { const size_t row = row0 + ai * 128 + m * 16; f32x4 y[2];
#pragma unroll
                    for (int n = 0; n < 2; ++n) { const f32x4 a = acc[ai][0][m][n], g = acc[ai][1][m][n];
                        y[n] = (f32x4){a[0] * sigmoidf_fast(g[0]), a[1] * sigmoidf_fast(g[1]), a[2] * sigmoidf_fast(g[2]), a[3] * sigmoidf_fast(g[3])}; }
                    __builtin_nontemporal_store(pack8(y[0], y[1]), (v4u*)(YG + row * 512 + pn * 128 + wc * 32 + 8 * fq)); }
        } else if (pn < 8) {
            const bool isq = pn < 6; bf16* base = isq ? QB : KB; const LAS float* gp = gl + (isq ? 0 : 64); const float sc = isq ? 0.125f * 1.4426950408889634f : 1.0f;
            f32x4 gv[2][2];
#pragma unroll
            for (int bj = 0; bj < 2; ++bj)
#pragma unroll
                for (int n = 0; n < 2; ++n) gv[bj][n] = *(const LAS f32x4*)(gp + 32 * bj + 8 * fq + 4 * n) * sc;
#pragma unroll
            for (int ai = 0; ai < 2; ++ai)
#pragma unroll
                for (int m = 0; m < 4; ++m) { const size_t row = row0 + ai * 128 + m * 16; float ss = 0.f;
#pragma unroll
                    for (int bj = 0; bj < 2; ++bj)
#pragma unroll
                        for (int n = 0; n < 2; ++n) { const f32x4 a = acc[ai][bj][m][n]; ss += (a[0] * a[0] + a[1] * a[1]) + (a[2] * a[2] + a[3] * a[3]); }
                    ss += __shfl_xor(ss, 16); ss += __shfl_xor(ss, 32);
                    const float rinv = 1.0f / sqrtf(ss * (1.0f / 64.0f) + EPS);
#pragma unroll
                    for (int bj = 0; bj < 2; ++bj)
                        __builtin_nontemporal_store(pack8(acc[ai][bj][m][0] * rinv * gv[bj][0], acc[ai][bj][m][1] * rinv * gv[bj][1]), (v4u*)(base + row * 512 + (pn & 1) * 256 + wc * 64 + bj * 32 + 8 * fq)); }
        } else if (pn < 10) {
#pragma unroll
            for (int ai = 0; ai < 2; ++ai)
#pragma unroll
                for (int m = 0; m < 4; ++m) { const size_t row = row0 + ai * 128 + m * 16;
#pragma unroll
                    for (int bj = 0; bj < 2; ++bj) __builtin_nontemporal_store(pack8(acc[ai][bj][m][0], acc[ai][bj][m][1]), (v4u*)(VB + row * 512 + (pn - 8) * 256 + bj * 128 + wc * 32 + 8 * fq)); }
        } else {
#pragma unroll
            for (int ai = 0; ai < 2; ++ai)
#pragma unroll
                for (int m = 0; m < 4; ++m) { const size_t row = row0 + ai * 128 + m * 16; f32x4 rr[2], gg[2];
#pragma unroll
                    for (int n = 0; n < 2; ++n)
#pragma unroll
                        for (int j = 0; j < 4; ++j) { const float e0 = __builtin_amdgcn_exp2f(-1.4426950408889634f * acc[ai][0][m][n][j]), e1 = fminf(__builtin_amdgcn_exp2f(-1.4426950408889634f * acc[ai][1][m][n][j]), 1e30f);
                            gg[n][j] = __builtin_amdgcn_rcpf(1.0f + e1); rr[n][j] = (1.0f + e1) * __builtin_amdgcn_rcpf(1.0f + e0); }
                    const size_t o = row * 1024 + (pn - 10) * 128 + wc * 32 + 8 * fq;
                    __builtin_nontemporal_store(pack8(rr[0], rr[1]), (v4u*)(GT + o)); __builtin_nontemporal_store(pack8(gg[0], gg[1]), (v4u*)(GT + (size_t)NTOK * 1024 + o)); }
        }
    }
};
struct EpiMerged {
    static constexpr bool MID = true;
    const bf16* GR; const bf16* G1; bf16* MG;
    __device__ __forceinline__ void mid(AccT& acc, const pg8::Unit& u, int wr, int wc, int fr, int fq) const {
        asm volatile("" : "+v"(fr), "+v"(fq));
        const size_t row0 = (size_t)u.orow + wr * 64 + fr; const int col0 = u.pn * 256 + wc * 32 + 8 * fq;
        v4u w0[2][4][2];
#pragma unroll
        for (int ai = 0; ai < 2; ++ai)
#pragma unroll
            for (int m = 0; m < 4; ++m)
#pragma unroll
                for (int bj = 0; bj < 2; ++bj) w0[ai][m][bj] = *(const v4u*)(GR + (row0 + ai * 128 + m * 16) * 1024 + col0 + bj * 128);
        __builtin_amdgcn_sched_barrier(0);
#pragma unroll
        for (int ai = 0; ai < 2; ++ai)
#pragma unroll
            for (int m = 0; m < 4; ++m)
#pragma unroll
                for (int bj = 0; bj < 2; ++bj) { f32x4 a0, a1; unpack8(w0[ai][m][bj], a0, a1); acc[ai][bj][m][0] = acc[ai][bj][m][0] * a0; acc[ai][bj][m][1] = acc[ai][bj][m][1] * a1; }
        __builtin_amdgcn_sched_barrier(0);
    }
    __device__ __forceinline__ void operator()(AccT& acc, const pg8::Unit& u, int wr, int wc, int fr, int fq) const {
        asm volatile("" : "+v"(fr), "+v"(fq));
        const size_t row0 = (size_t)u.orow + wr * 64 + fr; const int col0 = u.pn * 256 + wc * 32 + 8 * fq;
        v4u w1[2][4][2];
#pragma unroll
        for (int ai = 0; ai < 2; ++ai)
#pragma unroll
            for (int m = 0; m < 4; ++m)
#pragma unroll
                for (int bj = 0; bj < 2; ++bj) w1[ai][m][bj] = *(const v4u*)(G1 + (row0 + ai * 128 + m * 16) * 1024 + col0 + bj * 128);
        __builtin_amdgcn_sched_barrier(0);
#pragma unroll
        for (int ai = 0; ai < 2; ++ai)
#pragma unroll
            for (int m = 0; m < 4; ++m) { const size_t row = row0 + ai * 128 + m * 16;
#pragma unroll
                for (int bj = 0; bj < 2; ++bj) { f32x4 b0, b1; unpack8(w1[ai][m][bj], b0, b1);
                    *(v4u*)(MG + row * 1024 + col0 + bj * 128) = pack8(acc[ai][bj][m][0] * b0, acc[ai][bj][m][1] * b1); } }
    }
};
struct EpiOut {
    static constexpr bool MID = false;
    const float* x; bf16* XMB; unsigned char* XM8;
    __device__ __forceinline__ void mid(AccT&, const pg8::Unit&, int, int, int, int) const {}
    __device__ __forceinline__ void operator()(AccT& acc, const pg8::Unit& u, int wr, int wc, int fr, int fq) const {
        asm volatile("" : "+v"(fr), "+v"(fq));
        const size_t row0 = (size_t)u.orow + wr * 64 + fr; const int col0 = u.pn * 256 + wc * 32 + 8 * fq;
#pragma unroll
        for (int ai = 0; ai < 2; ++ai) {
            f32x4 xv[4][2][2];
#pragma unroll
            for (int m = 0; m < 4; ++m) { const size_t off = (row0 + ai * 128 + m * 16) * 1024 + col0;
#pragma unroll
                for (int bj = 0; bj < 2; ++bj) { xv[m][bj][0] = __builtin_nontemporal_load((const f32x4*)(x + off + bj * 128)); xv[m][bj][1] = __builtin_nontemporal_load((const f32x4*)(x + off + bj * 128 + 4)); } }
            __builtin_amdgcn_sched_barrier(0);
#pragma unroll
            for (int m = 0; m < 4; ++m) { const size_t off = (row0 + ai * 128 + m * 16) * 1024 + col0;
#pragma unroll
                for (int bj = 0; bj < 2; ++bj) { const f32x4 o0 = xv[m][bj][0] + acc[ai][bj][m][0], o1 = xv[m][bj][1] + acc[ai][bj][m][1];
                    *(v4u*)(XMB + off + bj * 128) = pack8(o0, o1);
                    v2u w8; w8.x = pg8::pack4_fp8(o0[0], o0[1], o0[2], o0[3]); w8.y = pg8::pack4_fp8(o1[0], o1[1], o1[2], o1[3]); *(v2u*)(XM8 + off + bj * 128) = w8; } }
            __builtin_amdgcn_sched_barrier(0);
        }
    }
};
struct EpiGateUp {
    static constexpr bool MID = false;
    const int* LIST; unsigned char* HP8; const LAS int* m2;
    __device__ __forceinline__ void mid(AccT&, const pg8::Unit&, int, int, int, int) const {}
    __device__ __forceinline__ void operator()(AccT& acc, const pg8::Unit& u, int wr, int wc, int fr, int fq) const {
        asm volatile("" : "+v"(fr), "+v"(fq));
        typedef int i32x4 __attribute__((ext_vector_type(4)));
        i32x4 ent[2][4];
#pragma unroll
        for (int ai = 0; ai < 2; ++ai)
#pragma unroll
            for (int m = 0; m < 4; ++m) { const int r = ai * 128 + wr * 64 + m * 16 + fr; ent[ai][m] = (r < u.nvalid) ? *(const i32x4*)(LIST + (size_t)(u.lrow + r) * 4) : (i32x4){-1, 0, 0, 0}; }
#pragma unroll
        for (int ai = 0; ai < 2; ++ai)
#pragma unroll
            for (int m = 0; m < 4; ++m) { const i32x4 en = ent[ai][m]; if (en[0] < 0) continue;
                const float rs = __int_as_float(en[3]) * (1.0f / 64.0f), w8 = __int_as_float(en[2]) * 8.0f;
                const int dst = en[1]; const size_t drow = (size_t)m2[dst >> 17] * 256 + ((dst >> 1) & 0xffff);
                float h[8];
#pragma unroll
                for (int n = 0; n < 2; ++n)
#pragma unroll
                    for (int j = 0; j < 4; ++j) { const float g = acc[ai][0][m][n][j] * rs, up = acc[ai][1][m][n][j] * rs; h[4 * n + j] = __builtin_amdgcn_fmed3f(g * sigmoidf_fast(g) * up * w8, -448.f, 448.f); }
                v2u o8; o8.x = pg8::pack4_fp8(h[0], h[1], h[2], h[3]); o8.y = pg8::pack4_fp8(h[4], h[5], h[6], h[7]);
                *(v2u*)(HP8 + drow * 1024 + (dst & 1) * 512 + u.pn * 128 + wc * 32 + 8 * fq) = o8; }
    }
};
struct EpiDownAdd {
    static constexpr bool MID = false;
    const int* CTOK; const bf16* XMB; float* out;
    __device__ __forceinline__ void mid(AccT&, const pg8::Unit&, int, int, int, int) const {}
    __device__ __forceinline__ void operator()(AccT& acc, const pg8::Unit& u, int wr, int wc, int fr, int fq) const {
        asm volatile("" : "+v"(fr), "+v"(fq));
        const int col0 = u.pn * 256 + wc * 32 + 8 * fq;
        int tokall[2][4];
#pragma unroll
        for (int ai = 0; ai < 2; ++ai)
#pragma unroll
            for (int m = 0; m < 4; ++m) { const int r = ai * 128 + wr * 64 + m * 16 + fr; tokall[ai][m] = (r < u.nvalid) ? CTOK[u.lrow + r] : -1; }
#pragma unroll
        for (int ai = 0; ai < 2; ++ai) {
            int tok[4];
#pragma unroll
            for (int m = 0; m < 4; ++m) tok[m] = tokall[ai][m];
            v4u xw[4][2];
#pragma unroll
            for (int m = 0; m < 4; ++m) { const size_t off = (size_t)(tok[m] < 0 ? 0 : tok[m]) * 1024 + col0;
#pragma unroll
                for (int bj = 0; bj < 2; ++bj) xw[m][bj] = *(const v4u*)(XMB + off + bj * 128); }
            __builtin_amdgcn_sched_barrier(0);
#pragma unroll
            for (int m = 0; m < 4; ++m) { if (tok[m] < 0) continue; const size_t off = (size_t)tok[m] * 1024 + col0;
#pragma unroll
                for (int bj = 0; bj < 2; ++bj) { f32x4 x0, x1; unpack8(xw[m][bj], x0, x1);
                    __builtin_nontemporal_store(x0 + acc[ai][bj][m][0] * (1.0f / 256.0f), (f32x4*)(out + off + bj * 128)); __builtin_nontemporal_store(x1 + acc[ai][bj][m][1] * (1.0f / 256.0f), (f32x4*)(out + off + bj * 128 + 4)); } }
            __builtin_amdgcn_sched_barrier(0);
        }
    }
};
struct MoeOrder {
    int G, c, total; const LAS int* meta;
    __device__ __forceinline__ bool next(int i, pg8::Unit& u) const {
        const int L = i * G + c; if (L >= total * 4) return false;
        const int blk = L >> 2, lane = threadIdx.x & 63;
        const int e = __builtin_amdgcn_readfirstlane(__builtin_popcountll(__ballot(lane < NEXP - 1 && meta[1 + lane] <= blk)));
        const int pre = __builtin_amdgcn_readfirstlane(meta[e]), cnt = __builtin_amdgcn_readfirstlane(meta[64 + e]); const int rb = blk - pre;
        u.pn = L & 3; u.pm = rb; u.e = e; u.e2 = e; u.lrow = e * LCAP + rb * 256; u.nvalid = min(256, cnt - rb * 256); u.orow = blk * 256; u.arow = 0; return true;
    }
};
struct ClassOrder {
    int G, c, total; const LAS int* m2;
    __device__ __forceinline__ bool next(int i, pg8::Unit& u) const {
        const int L = i * G + c; if (L >= total * 4) return false;
        const int blk = L >> 2, lane = threadIdx.x & 63;
        const int n0 = __builtin_popcountll(__ballot(m2[1 + lane] <= blk)), n1 = __builtin_popcountll(__ballot(lane + 65 <= NCLS - 1 && m2[65 + lane] <= blk));
        const int cls = __builtin_amdgcn_readfirstlane(n0 + n1);
        const int pre = __builtin_amdgcn_readfirstlane(m2[cls]), cnt = __builtin_amdgcn_readfirstlane(m2[128 + cls]); const int rb = blk - pre;
        const int g = cls / 28; int p = cls % 28, a = 0;
        while (p >= 7 - a) { p -= 7 - a; ++a; }
        u.e = g * 8 + a; u.e2 = g * 8 + a + 1 + p; u.pn = L & 3; u.pm = rb; u.lrow = cls * NTOK + rb * 256; u.nvalid = min(256, cnt - rb * 256); u.orow = blk * 256; u.arow = u.orow; return true;
    }
};
__device__ __forceinline__ void moe_meta(LAS int* meta, LAS int* m2, const unsigned* ctl) {
    const int tid = threadIdx.x;
    if (tid < NEXP) meta[64 + tid] = (int)__hip_atomic_load(ctl + tid, __ATOMIC_RELAXED, __HIP_MEMORY_SCOPE_AGENT);
    if (tid >= 64 && tid < 64 + NCLS) m2[128 + tid - 64] = (int)__hip_atomic_load(ctl + tid, __ATOMIC_RELAXED, __HIP_MEMORY_SCOPE_AGENT);
    __syncthreads();
    if (tid == 0) { int p = 0;
        for (int e = 0; e < NEXP; ++e) { meta[e] = p; p += (meta[64 + e] + 255) >> 8; }
        meta[NEXP] = p; }
    if (tid == 64) { int p = 0;
        for (int c = 0; c < NCLS; ++c) { m2[c] = p; p += (m2[128 + c] + 255) >> 8; }
        m2[NCLS] = p; }
    __syncthreads();
}

__device__ __forceinline__ void transpose_item(const float* W, int N, int k0, int n0, bf16* WT, int dpitch, int drow0, int dcol0, const float* kscale, LAS float* scr, int lane) {
    const int kr = lane >> 3, nc = (lane & 7) * 4;
    f32x4 v[8];
#pragma unroll
    for (int i = 0; i < 8; ++i) v[i] = *(const f32x4*)(W + (size_t)(k0 + i * 8 + kr) * N + n0 + nc);
    if (kscale) {
#pragma unroll
        for (int i = 0; i < 8; ++i) v[i] = v[i] * kscale[k0 + i * 8 + kr]; }
#pragma unroll
    for (int i = 0; i < 8; ++i) { LAS float* d = scr + (i * 8 + kr) * 33 + nc; d[0] = v[i][0]; d[1] = v[i][1]; d[2] = v[i][2]; d[3] = v[i][3]; }
    asm volatile("s_waitcnt lgkmcnt(0)" ::: "memory");
    const int c = lane & 7;
#pragma unroll
    for (int j = 0; j < 4; ++j) { const int n = (lane >> 3) + 8 * j; const LAS float* s = scr + (8 * c) * 33 + n;
        v4u o; o.x = cvt_pk_bf16(s[0 * 33], s[1 * 33]); o.y = cvt_pk_bf16(s[2 * 33], s[3 * 33]); o.z = cvt_pk_bf16(s[4 * 33], s[5 * 33]); o.w = cvt_pk_bf16(s[6 * 33], s[7 * 33]);
        *(v4u*)(WT + (size_t)(drow0 + n) * dpitch + dcol0 + k0 + 8 * c) = o; }
    asm volatile("s_waitcnt lgkmcnt(0)" ::: "memory");
}
__device__ __forceinline__ void transpose_item_fp8(const float* W, int N, int k0, int n0, unsigned char* WT, int dpitch, int drow0, const float* kscale, float mul, LAS float* scr, int lane) {
    const int kr = lane >> 3, nc = (lane & 7) * 4;
    f32x4 v[8];
#pragma unroll
    for (int i = 0; i < 8; ++i) v[i] = *(const f32x4*)(W + (size_t)(k0 + i * 8 + kr) * N + n0 + nc);
#pragma unroll
    for (int i = 0; i < 8; ++i) v[i] = v[i] * (kscale ? kscale[k0 + i * 8 + kr] * mul : mul);
#pragma unroll
    for (int i = 0; i < 8; ++i) { LAS float* d = scr + (i * 8 + kr) * 33 + nc; d[0] = v[i][0]; d[1] = v[i][1]; d[2] = v[i][2]; d[3] = v[i][3]; }
    asm volatile("s_waitcnt lgkmcnt(0)" ::: "memory");
    const int c = lane & 7;
#pragma unroll
    for (int j = 0; j < 4; ++j) { const int n = (lane >> 3) + 8 * j; const LAS float* s = scr + (8 * c) * 33 + n;
        v2u o; o.x = pg8::pack4_fp8(s[0 * 33], s[1 * 33], s[2 * 33], s[3 * 33]); o.y = pg8::pack4_fp8(s[4 * 33], s[5 * 33], s[6 * 33], s[7 * 33]);
        *(v2u*)(WT + (size_t)(drow0 + n) * dpitch + k0 + 8 * c) = o; }
    asm volatile("s_waitcnt lgkmcnt(0)" ::: "memory");
}
__device__ __forceinline__ int inproj_phys(int c) {
    if (c < 512) return (c >> 7) * 256 + (c & 127);
    if (c < 1024) { c -= 512; return (c >> 7) * 256 + 128 + (c & 127); }
    if (c < 2048) { const int sec = (c - 1024) >> 8, cl = (c - 1024) & 255, s = cl >> 6, d = cl & 63; return 1024 + sec * 256 + ((d >> 5) << 7) + (s << 5) + (d & 31); }
    if (c < 2560) return c;
    { int j = c - 2560; const int hi = j >= 1024; j &= 1023; return 2560 + (j >> 7) * 256 + hi * 128 + (j & 127); }
}
struct Ptrs {
    const float *x, *attn_norm_g, *w_in, *conv_dw_w, *conv_dw_b, *conv_ln_g, *conv_ln_b, *w_conv_out, *q_norm_g, *k_norm_g, *lq1, *lk1, *lq2, *lk2, *subln_g,
        *w_attn_out, *w_out, *ffn_norm_g, *w_rg, *b_rg, *w_re, *b_re, *w_gate, *w_up, *w_down;
    float* out; unsigned char* ws;
};

__device__ __forceinline__ void p0_prologue(const Ptrs& P, LAS unsigned char* lds, int vcu, int G) {
    const int tid = threadIdx.x, lane = tid & 63, wave = __builtin_amdgcn_readfirstlane(tid >> 6);
    LAS float* scr = (LAS float*)(lds + wave * 16384);
    const int gw = vcu * NWAVES + wave, NGW = G * NWAVES;
    bf16* WIN = (bf16*)(P.ws + WS_WIN); bf16* WCA = (bf16*)(P.ws + WS_WCA); bf16* WOUT = (bf16*)(P.ws + WS_WOUT);
    constexpr int I_IN = (DMODEL / 64) * (IN_COLS / 32), I_C = (CONV_CH / 64) * (DMODEL / 32), I_O = (DMODEL / 64) * (DMODEL / 32);
    for (int it = gw; it < I_IN + 2 * I_C + I_O; it += NGW) {
        int r = it;
        if (r < I_IN) { const int kb = r / (IN_COLS / 32), nb = r % (IN_COLS / 32); transpose_item(P.w_in, IN_COLS, kb * 64, nb * 32, WIN, 1024, inproj_phys(nb * 32), 0, nullptr, scr, lane); continue; } r -= I_IN;
        if (r < I_C) { const int kb = r / 32, nb = r % 32; transpose_item(P.w_conv_out, DMODEL, kb * 64, nb * 32, WCA, 1024, nb * 32, 0, nullptr, scr, lane); continue; } r -= I_C;
        if (r < I_C) { const int kb = r / 32, nb = r % 32; transpose_item(P.w_attn_out, DMODEL, kb * 64, nb * 32, WCA, 1024, nb * 32, 512, nullptr, scr, lane); continue; } r -= I_C;
        { const int kb = r / 32, nb = r % 32; transpose_item(P.w_out, DMODEL, kb * 64, nb * 32, WOUT, 1024, nb * 32, 0, nullptr, scr, lane); }
    }
    bf16* WRhi = (bf16*)(P.ws + WS_WR); bf16* WRlo = WRhi + 64 * 1024;
    for (int idx = vcu * NTHREADS + tid; idx < 64 * 1024; idx += G * NTHREADS) {
        const int n = idx >> 10, k = idx & 1023; float v = 0.f;
        if (n < 4) v = P.w_rg[k * 4 + n]; else if (n < 36) v = P.w_re[k * 32 + (n - 4)];
        v *= P.ffn_norm_g[k];
        const unsigned hb = cvt_pk_bf16(v, 0.f) & 0xffffu; const float hf = __uint_as_float(hb << 16);
        WRhi[idx] = (bf16)hb; WRlo[idx] = (bf16)(cvt_pk_bf16(v - hf, 0.f) & 0xffffu);
    }
    bf16* HB = (bf16*)(P.ws + WS_A);
    f32x4 gq[4];
#pragma unroll
    for (int j = 0; j < 4; ++j) gq[j] = ((const f32x4*)P.attn_norm_g)[64 * j + lane];
    for (int m = gw; m < NTOK; m += NGW) {
        const f32x4* xr = (const f32x4*)(P.x + (size_t)m * DMODEL) + lane; f32x4 v[4]; float s = 0.f;
#pragma unroll
        for (int j = 0; j < 4; ++j) { v[j] = xr[64 * j]; s += (v[j][0] * v[j][0] + v[j][1] * v[j][1]) + (v[j][2] * v[j][2] + v[j][3] * v[j][3]); }
        const float r = 1.0f / sqrtf(wave_sum(s) * (1.0f / DMODEL) + EPS);
        v2u* o8 = (v2u*)(HB + (size_t)m * DMODEL) + lane;
#pragma unroll
        for (int j = 0; j < 4; ++j) { const f32x4 y = v[j] * r * gq[j]; v2u w; w.x = cvt_pk_bf16(y[0], y[1]); w.y = cvt_pk_bf16(y[2], y[3]); o8[64 * j] = w; }
    }
}

__device__ __forceinline__ void conv_phase(const Ptrs& P, LAS unsigned char* lds, int first, int stride) {
    const int tid = threadIdx.x, lane = tid & 63, wave = __builtin_amdgcn_readfirstlane(tid >> 6);
    const bf16* YG = (const bf16*)(P.ws + WS_YG); bf16* CA = (bf16*)(P.ws + WS_CA);
    LAS bf16* yt = (LAS bf16*)lds; LAS float* co = (LAS float*)(lds + 62 * 1024);
    constexpr int NT = NTOK / 32;
    if (first >= NT) return;
    float w[CONV_W];
#pragma unroll
    for (int j = 0; j < CONV_W; ++j) w[j] = P.conv_dw_w[j * CONV_CH + tid];
    const float bias = P.conv_dw_b[tid];
    const f32x4 g0 = ((const f32x4*)P.conv_ln_g)[lane], g1 = ((const f32x4*)P.conv_ln_g)[64 + lane], b0 = ((const f32x4*)P.conv_ln_b)[lane], b1 = ((const f32x4*)P.conv_ln_b)[64 + lane];
    v4u pre[8];
#define CONV_FETCH(tile) do { const int b_ = (tile) / (SEQ / 32), t0_ = ((tile) % (SEQ / 32)) * 32; _Pragma("unroll") for (int p = 0; p < 8; ++p) { const int q = tid + NTHREADS * p; const int row = q >> 6, ch = q & 63, t = t0_ - 30 + row; \
        pre[p] = (v4u){0u, 0u, 0u, 0u}; if (q < 62 * 64 && t >= 0) pre[p] = *(const v4u*)(YG + ((size_t)(b_ * SEQ + t)) * 512 + ch * 8); } } while (0)
    CONV_FETCH(first);
    for (int tile = first; tile < NT; tile += stride) {
        const int b = tile / (SEQ / 32), t0 = (tile % (SEQ / 32)) * 32;
#pragma unroll
        for (int p = 0; p < 8; ++p) { const int q = tid + NTHREADS * p; if (q < 62 * 64) *(LAS v4u*)(yt + (q >> 6) * 512 + (q & 63) * 8) = pre[p]; }
        __syncthreads();
        if (tile + stride < NT) CONV_FETCH(tile + stride);
        float yv[62];
#pragma unroll
        for (int i = 0; i < 62; ++i) yv[i] = __uint_as_float((unsigned)yt[i * 512 + tid] << 16);
#pragma unroll
        for (int t = 0; t < 32; ++t) { float a = bias;
#pragma unroll
            for (int j = 0; j < CONV_W; ++j) a += w[j] * yv[t + j];
            co[t * 512 + tid] = a; }
        __syncthreads();
#pragma unroll
        for (int rr = 0; rr < 4; ++rr) { const int row = wave * 4 + rr;
            const f32x4 v0 = *(const LAS f32x4*)(co + row * 512 + lane * 4), v1 = *(const LAS f32x4*)(co + row * 512 + 256 + lane * 4);
            const float mean = wave_sum((v0[0] + v0[1]) + (v0[2] + v0[3]) + (v1[0] + v1[1]) + (v1[2] + v1[3])) * (1.0f / CONV_CH);
            const f32x4 d0 = v0 - mean, d1 = v1 - mean;
            const float var = wave_sum((d0[0] * d0[0] + d0[1] * d0[1]) + (d0[2] * d0[2] + d0[3] * d0[3]) + (d1[0] * d1[0] + d1[1] * d1[1]) + (d1[2] * d1[2] + d1[3] * d1[3])) * (1.0f / CONV_CH);
            const float rstd = 1.0f / sqrtf(var + EPS);
            f32x4 y0 = d0 * rstd * g0 + b0, y1 = d1 * rstd * g1 + b1;
#pragma unroll
            for (int j = 0; j < 4; ++j) { y0[j] = y0[j] * sigmoidf_fast(y0[j]); y1[j] = y1[j] * sigmoidf_fast(y1[j]); }
            bf16* orow = CA + ((size_t)(b * SEQ + t0 + row)) * 1024;
            v2u o0, o1; o0.x = cvt_pk_bf16(y0[0], y0[1]); o0.y = cvt_pk_bf16(y0[2], y0[3]); o1.x = cvt_pk_bf16(y1[0], y1[1]); o1.y = cvt_pk_bf16(y1[2], y1[3]);
            *(v2u*)(orow + lane * 4) = o0; *(v2u*)(orow + 256 + lane * 4) = o1; }
        __syncthreads();
    }
#undef CONV_FETCH
}

__device__ __forceinline__ void attn_pair(const Ptrs& P, LAS unsigned char* lds, char* lds_generic, int p) {
    const int tid = threadIdx.x, lane = tid & 63, wave = __builtin_amdgcn_readfirstlane(tid >> 6);
    const int bh = p >> 3, s = p & 7, b = bh >> 2, h = bh & 3;
    const __hip_bfloat16* QB = (const __hip_bfloat16*)(P.ws + WS_QB); const __hip_bfloat16* KB = (const __hip_bfloat16*)(P.ws + WS_KB); const __hip_bfloat16* VB = (const __hip_bfloat16*)(P.ws + WS_VB);
    __hip_bfloat16* OT = (__hip_bfloat16*)(P.ws + WS_A); bf16* CA = (bf16*)(P.ws + WS_CA);
    float mstat;
    { int l0 = lane; asm volatile("" : "+v"(l0));
      float a = fabsf(P.q_norm_g[l0]), b = fabsf(P.k_norm_g[l0]);
#pragma unroll
      for (int o = 1; o < 64; o <<= 1) { a = fmaxf(a, __shfl_xor(a, o)); b = fmaxf(b, __shfl_xor(b, o)); }
      mstat = __int_as_float(__builtin_amdgcn_readfirstlane(__float_as_int(0.125f * 1.4426950408889634f * 64.0f * 1.02f * a * b))); }
    float lam;
    { int l1 = lane; asm volatile("" : "+v"(l1));
      lam = __int_as_float(__builtin_amdgcn_readfirstlane(__float_as_int(__expf(wave_sum(P.lq1[l1] * P.lk1[l1])) - __expf(wave_sum(P.lq2[l1] * P.lk2[l1])) + 0.2f))); }
    int s0 = 0; bool pre = false;
#pragma unroll 1
    for (int u4 = 0; u4 < 4; ++u4) { const int i = u4 >> 1, c = u4 & 1;
        const int qb = (i == 0) ? s : 15 - s;
        const __hip_bfloat16* q_ = QB + (size_t)b * SEQ * 512 + (h * 2 + c) * 64; const __hip_bfloat16* k_ = KB + (size_t)b * SEQ * 512 + (h * 2 + c) * 64; const __hip_bfloat16* v_ = VB + (size_t)b * SEQ * 512 + h * 128;
        const __hip_bfloat16* kn_ = (u4 < 3) ? KB + (size_t)b * SEQ * 512 + (h * 2 + (c ^ 1)) * 64 : nullptr;
        __hip_bfloat16* o_ = OT + (size_t)b * SEQ * 1024 + (h * 2) * 128;
        const __hip_bfloat16* o1_ = c ? o_ : nullptr; unsigned short* ca_ = CA + (size_t)b * SEQ * 1024 + 512 + h * 128;
        int sn;
        if (mstat <= 40.0f) sn = attn_body::attn_unit<8, true>(mstat, qb * 256, q_, k_, v_, o_, lds_generic, o1_, lam, P.subln_g, ca_, kn_, v_, s0, pre);
        else sn = attn_body::attn_unit<8, false>(0.f, qb * 256, q_, k_, v_, o_, lds_generic, o1_, lam, P.subln_g, ca_, kn_, v_, s0, pre);
        s0 = sn; pre = (kn_ != nullptr); }
}

__device__ __forceinline__ void router_tile(const Ptrs& P, LAS unsigned char* lds, int tile) {
    const int tid = threadIdx.x, lane = tid & 63, wave = __builtin_amdgcn_readfirstlane(tid >> 6), r32 = lane & 31, hi = lane >> 5;
    const bf16* WRhi = (const bf16*)(P.ws + WS_WR); const bf16* WRlo = WRhi + 64 * 1024;
    int* LIST = (int*)(P.ws + WS_LIST); int* CTOK = (int*)(P.ws + WS_CTOK); unsigned* cnt = (unsigned*)(P.ws + WS_CTL); unsigned* ccnt = cnt + 64;
    LAS float* lg = (LAS float*)(lds + wave * 8448);
    LAS int* hist = (LAS int*)(lds + HIST_OFF); LAS int* hbase = hist + 32; LAS int* hist2 = hist + 64; LAS int* hbase2 = hist2 + NCLS;
    if (tid < 32) hist[tid] = 0;
    if (tid >= 64 && tid < 64 + NCLS) hist2[tid - 64] = 0;
    __syncthreads();
    const int tbase = tile * 256 + wave * 32;
    const bf16* xr = (const bf16*)(P.ws + WS_CA) + (size_t)(tbase + r32) * DMODEL + 8 * hi;
    const bf16* bh0 = WRhi + (size_t)r32 * 1024 + 8 * hi; const bf16* bl0 = WRlo + (size_t)r32 * 1024 + 8 * hi;
    f32x16 acc0 = {}, acc1 = {}; float ssq = 0.f;
#pragma unroll 4
    for (int ks = 0; ks < 64; ++ks) {
        const v4u xa = *(const v4u*)(xr + ks * 16);
        f32x4 x0, x1; unpack8(xa, x0, x1);
        ssq += (x0[0] * x0[0] + x0[1] * x0[1]) + (x0[2] * x0[2] + x0[3] * x0[3]) + (x1[0] * x1[0] + x1[1] * x1[1]) + (x1[2] * x1[2] + x1[3] * x1[3]);
        const bf16x8 a_hi = __builtin_bit_cast(bf16x8, xa);
        const bf16x8 bh_0 = *(const bf16x8*)(bh0 + ks * 16), bh_1 = *(const bf16x8*)(bh0 + 32 * 1024 + ks * 16), bl_0 = *(const bf16x8*)(bl0 + ks * 16), bl_1 = *(const bf16x8*)(bl0 + 32 * 1024 + ks * 16);
        acc0 = __builtin_amdgcn_mfma_f32_32x32x16_bf16(a_hi, bh_0, acc0, 0, 0, 0); acc1 = __builtin_amdgcn_mfma_f32_32x32x16_bf16(a_hi, bh_1, acc1, 0, 0, 0);
        acc0 = __builtin_amdgcn_mfma_f32_32x32x16_bf16(a_hi, bl_0, acc0, 0, 0, 0); acc1 = __builtin_amdgcn_mfma_f32_32x32x16_bf16(a_hi, bl_1, acc1, 0, 0, 0);
    }
    ssq += __shfl_xor(ssq, 32);
    const float rs = 1.0f / sqrtf(ssq * (1.0f / DMODEL) + EPS);
#pragma unroll
    for (int r = 0; r < 16; ++r) { const int m = (r & 3) + 8 * (r >> 2) + 4 * hi; lg[m * 66 + r32] = acc0[r]; lg[m * 66 + 32 + r32] = acc1[r]; }
    asm volatile("s_waitcnt lgkmcnt(0)" ::: "memory");
    int ea = 0, eb = 0, cls = 0, lpa = 0, lpb = 0, lpc = 0; float wa = 0.f, wb = 0.f;
    if (lane < 32) {
        const LAS float* L = lg + lane * 66;
        float gl[4];
#pragma unroll
        for (int j = 0; j < 4; ++j) gl[j] = L[j] * rs + P.b_rg[j];
        int gs = 0; float gm = gl[0];
#pragma unroll
        for (int j = 1; j < 4; ++j) if (gl[j] > gm) { gm = gl[j]; gs = j; }
        float gsum = 0.f;
#pragma unroll
        for (int j = 0; j < 4; ++j) gsum += __expf(gl[j] - gm);
        const float gw = 1.0f / gsum;
        float l0 = -INFINITY, l1 = -INFINITY; int i0 = 0, i1 = 0;
#pragma unroll
        for (int j = 0; j < 8; ++j) { const float v = L[4 + gs * 8 + j] * rs + P.b_re[gs * 8 + j];
            if (v > l0) { l1 = l0; i1 = i0; l0 = v; i0 = j; } else if (v > l1) { l1 = v; i1 = j; } }
        const float q = __expf(l1 - l0), inv = 1.0f / (1.0f + q);
        const float w0 = inv * gw, w1 = q * inv * gw;
        const int a = min(i0, i1), b = max(i0, i1);
        wa = (i0 < i1) ? w0 : w1; wb = (i0 < i1) ? w1 : w0;
        ea = gs * 8 + a; eb = gs * 8 + b; cls = gs * 28 + (a * (15 - a)) / 2 + (b - a - 1);
        lpa = __hip_atomic_fetch_add(&hist[ea], 1, __ATOMIC_RELAXED, __HIP_MEMORY_SCOPE_WORKGROUP); lpb = __hip_atomic_fetch_add(&hist[eb], 1, __ATOMIC_RELAXED, __HIP_MEMORY_SCOPE_WORKGROUP);
        lpc = __hip_atomic_fetch_add(&hist2[cls], 1, __ATOMIC_RELAXED, __HIP_MEMORY_SCOPE_WORKGROUP);
    }
    __syncthreads();
    if (tid < 32) hbase[tid] = (int)atomicAdd(cnt + tid, (unsigned)hist[tid]);
    if (tid >= 64 && tid < 64 + NCLS) { const int c = tid - 64; const int n = hist2[c]; hbase2[c] = n ? (int)atomicAdd(ccnt + c, (unsigned)n) : 0; }
    __syncthreads();
    if (lane < 32) { const int t = tbase + lane; const int pa = hbase[ea] + lpa, pb = hbase[eb] + lpb, pc = hbase2[cls] + lpc;
        typedef int i32x4 __attribute__((ext_vector_type(4)));
        const int dst = (cls << 17) | (pc << 1);
        *(i32x4*)(LIST + (size_t)(ea * LCAP + pa) * 4) = (i32x4){t, dst, __float_as_int(wa), __float_as_int(rs)};
        *(i32x4*)(LIST + (size_t)(eb * LCAP + pb) * 4) = (i32x4){t, dst | 1, __float_as_int(wb), __float_as_int(rs)};
        CTOK[(size_t)cls * NTOK + pc] = t; }
    __syncthreads();
}

__device__ __forceinline__ void p5_convert(const Ptrs& P, LAS unsigned char* lds, int vcu, int G) {
    const int tid = threadIdx.x, lane = tid & 63, wave = __builtin_amdgcn_readfirstlane(tid >> 6);
    LAS float* scr = (LAS float*)(lds + wave * 16384);
    const int gw = vcu * NWAVES + wave, NGW = G * NWAVES;
    unsigned char* WGU = P.ws + WS_WGU; unsigned char* WD = P.ws + WS_WD;
    constexpr int I_G = (DMODEL / 64) * (DEXP / 32);
    constexpr int I_D = (DEXP / 64) * (DMODEL / 32);
    constexpr int PER_E = 2 * I_G + I_D;
    constexpr int NITEMS = NEXP * PER_E, NRW = (NTOK / 256) * NWAVES;
    const bool split = (G == 256) && (NITEMS == NRW * 10 + (256 * NWAVES - NRW) * 14);
    const bool rwg = (int)blockIdx.x < NTOK / 256; const int wv = ((int)blockIdx.x - (rwg ? 0 : NTOK / 256)) * NWAVES + wave;
    const int it0 = split ? (rwg ? wv : NRW * 10 + wv) : gw, itn = split ? (rwg ? NRW * 10 : NITEMS) : NITEMS, its = split ? NRW : NGW;
    for (int it = it0; it < itn; it += its) {
        const int e = it / PER_E; int r = it % PER_E;
        if (r < 2 * I_G) { const int up = r / I_G; r %= I_G; const int kb = r / (DEXP / 32), nb = r % (DEXP / 32), n0 = nb * 32;
            const float* W = (up ? P.w_up : P.w_gate) + (size_t)e * DMODEL * DEXP;
            transpose_item_fp8(W, DEXP, kb * 64, n0, WGU + (size_t)e * 1024 * 1024, 1024, (n0 >> 7) * 256 + up * 128 + (n0 & 127), P.ffn_norm_g, 64.f, scr, lane);
        } else { r -= 2 * I_G; const int kb = r / (DMODEL / 32), nb = r % (DMODEL / 32);
            transpose_item_fp8(P.w_down + (size_t)e * DEXP * DMODEL, DMODEL, kb * 64, nb * 32, WD + (size_t)e * 1024 * 512, 512, nb * 32, nullptr, 32.f, scr, lane); }
    }
}

struct Args { Ptrs p; int ph_lo, ph_hi, use_cg, pad; };
__global__ void __launch_bounds__(NTHREADS, 2) mega_fwd(Args args) {
    extern __shared__ __attribute__((aligned(16))) unsigned char lds_raw[];
    LAS unsigned char* lds = (LAS unsigned char*)lds_raw;
    const Ptrs& P = args.p;
    const int tid = threadIdx.x, lane = tid & 63;
    const int G = gridDim.x, bx = blockIdx.x; const int vcu = (G % 8 == 0) ? (bx % 8) * (G / 8) + bx / 8 : bx;
    const int lo = args.ph_lo, hi = args.ph_hi;
    LAS int* meta = (LAS int*)(lds + META_OFF);
    if (tid < 2) ((volatile LAS unsigned*)(lds + BARST_OFF))[tid] = 0u;
    __syncthreads();
    XcdBarrier bar = xcd_barrier_post((unsigned*)(P.ws + WS_CTL) + 1024, (volatile LAS unsigned*)(lds + BARST_OFF));
#ifndef PHASE_MASK
#define PHASE_MASK 0xff
#endif
#ifndef DUP_PHASE
#define DUP_PHASE -1
#endif
#define REPS(k) for (int rep_ = 0; rep_ < ((DUP_PHASE == (k)) ? 2 : 1); ++rep_)
#define REPBAR() do { if (rep_) xcd_barrier(bar); } while (0)
#define IN(k) (((PHASE_MASK >> (k)) & 1) && lo <= (k) && (k) < hi)
#define SEAM(k) do { if (IN(k) && IN((k) + 1)) xcd_barrier(bar); } while (0)
    bf16* WS16 = (bf16*)P.ws;
    if (IN(0)) REPS(0) { REPBAR(); p0_prologue(P, lds, vcu, G); }
    SEAM(0);
    if (IN(1)) REPS(1) { REPBAR();
        pg8::Gemm g{(const bf16*)(P.ws + WS_A), (const bf16*)(P.ws + WS_WIN), DMODEL, 0, nullptr};
        pg8::StaticOrder S; S.init(NTOK, IN_COLS, G, bx);
        LAS float* gl = (LAS float*)(lds + RING_BYTES + 8192);
        if (tid < 128) gl[tid] = (tid < 64) ? P.q_norm_g[tid] : P.k_norm_g[tid - 64];
        __syncthreads();
        EpiInProj E{(bf16*)(P.ws + WS_YG), (bf16*)(P.ws + WS_QB), (bf16*)(P.ws + WS_KB), (bf16*)(P.ws + WS_VB), (bf16*)(P.ws + WS_GT), gl};
#if defined(DUMP_SEL) && DUMP_SEL == 5
        EpiRaw ER{(bf16*)(P.ws + WS_QB)};
        pg8::gemm_phase<EpiRaw, pg8::StaticOrder, false, true>(lds, g, S, ER);
#else
        pg8::gemm_phase<EpiInProj, pg8::StaticOrder, false, true>(lds, g, S, E);
#endif
    }
    SEAM(1);
    if (IN(2)) {
        REPS(2) { REPBAR();
        for (int p = vcu; p < 256; p += G) attn_pair(P, lds, (char*)lds_raw, p);
        __syncthreads(); }
        REPS(20) { REPBAR();
        conv_phase(P, lds, bx, G); }
    }
    SEAM(2);
    if (IN(3)) REPS(3) { REPBAR();
        pg8::Gemm g{(const bf16*)(P.ws + WS_CA), (const bf16*)(P.ws + WS_WCA), DMODEL, 0, nullptr};
        pg8::StaticOrder S; S.init(NTOK, DMODEL, G, bx);
        EpiMerged E{(const bf16*)(P.ws + WS_GT), (const bf16*)(P.ws + WS_GT) + (size_t)NTOK * 1024, (bf16*)(P.ws + WS_MG)};
        pg8::gemm_phase<EpiMerged, pg8::StaticOrder, false, true>(lds, g, S, E);
    }
    SEAM(3);
    if (IN(4)) REPS(4) { REPBAR();
        pg8::Gemm g{(const bf16*)(P.ws + WS_MG), (const bf16*)(P.ws + WS_WOUT), DMODEL, 0, nullptr};
        pg8::StaticOrder S; S.init(NTOK, DMODEL, G, bx);
        EpiOut E{P.x, (bf16*)(P.ws + WS_CA), P.ws + WS_XM};
        pg8::gemm_phase<EpiOut, pg8::StaticOrder, false, true>(lds, g, S, E);
    }
    SEAM(4);
    if (IN(5)) {
        for (int t = bx; t < NTOK / 256; t += G) router_tile(P, lds, t);
        REPS(5) { REPBAR(); p5_convert(P, lds, vcu, G); }
    }
    SEAM(5);
    LAS int* meta2 = (LAS int*)(lds + META2_OFF);
    if (IN(6)) REPS(6) { REPBAR();
        moe_meta(meta, meta2, (const unsigned*)(P.ws + WS_CTL));
        pg8::Gemm g{(const bf16*)(P.ws + WS_XM), (const bf16*)(P.ws + WS_WGU), DMODEL / 2, (size_t)1024 * 1024, (const int*)(P.ws + WS_LIST), 4};
        MoeOrder S{G, bx, __builtin_amdgcn_readfirstlane(meta[NEXP]), meta};
        EpiGateUp E{(const int*)(P.ws + WS_LIST), P.ws + WS_A, meta2};
        pg8::gemm_phase<EpiGateUp, MoeOrder, true, true, true>(lds, g, S, E);
    }
    SEAM(6);
    if (IN(7)) REPS(7) { REPBAR();
        moe_meta(meta, meta2, (const unsigned*)(P.ws + WS_CTL));
        pg8::Gemm g{(const bf16*)(P.ws + WS_A), (const bf16*)(P.ws + WS_WD), DMODEL / 2, (size_t)1024 * 512, nullptr, 0, DEXP / 2};
        ClassOrder S{G, bx, __builtin_amdgcn_readfirstlane(meta2[NCLS]), meta2};
        EpiDownAdd E{(const int*)(P.ws + WS_CTOK), (const bf16*)(P.ws + WS_CA), P.out};
        pg8::gemm_phase<EpiDownAdd, ClassOrder, false, true, true, true>(lds, g, S, E);
    }
#if defined(DUMP_SEL)
    xcd_barrier(bar);
    { const bf16* YG = (const bf16*)(P.ws + WS_YG); const bf16* QB = (const bf16*)(P.ws + WS_QB); const bf16* KB = (const bf16*)(P.ws + WS_KB); const bf16* VB = (const bf16*)(P.ws + WS_VB);
      const bf16* GT = (const bf16*)(P.ws + WS_GT); const bf16* CA = (const bf16*)(P.ws + WS_CA); const bf16* MG = (const bf16*)(P.ws + WS_MG);
      for (size_t i = (size_t)bx * NTHREADS + tid; i < (size_t)NTOK * 1024; i += (size_t)G * NTHREADS) { const size_t t = i >> 10; const int c = (int)(i & 1023); float v = 0.f;
#if DUMP_SEL == 1
          v = bf_lo(YG[t * 512 + (c & 511)]) + bf_lo(QB[t * 512 + (c & 511)]) + 2.f * bf_lo(KB[t * 512 + (c & 511)]) + 3.f * bf_lo(VB[t * 512 + (c & 511)]) + bf_lo(GT[t * 2048 + c]) + bf_lo(GT[t * 2048 + 1024 + c]);
#elif DUMP_SEL == 2
          v = bf_lo(CA[t * 1024 + c]);
#elif DUMP_SEL == 4
          { const bf16* HB = (const bf16*)(P.ws + WS_A); const bf16* WIN = (const bf16*)(P.ws + WS_WIN); v = bf_lo(HB[i]) + 30.f * bf_lo(WIN[i % ((size_t)IN_COLS * 1024)]); }
#elif DUMP_SEL == 5
          { const bf16* R = (const bf16*)(P.ws + WS_QB); v = bf_lo(R[t * 4608 + c]) + bf_lo(R[t * 4608 + 1024 + c]) + bf_lo(R[t * 4608 + 2048 + c]) + bf_lo(R[t * 4608 + 3072 + c]) + bf_lo(R[t * 4608 + 4096 + (c & 511)]); }
#elif DUMP_SEL == 3
          v = bf_lo(MG[t * 1024 + c]);
#endif
          P.out[i] = v; } }
#endif
    (void)WS16;
#undef IN
#undef SEAM
}

extern "C" void kernel_launch(void* const* d_in, const int* in_sizes, int n_in, void* d_out, int out_size, void* d_ws, size_t ws_size, hipStream_t stream) {
    static int grid = 0;
    if (grid == 0) {
        if (n_in != 25 || in_sizes[0] != NTOK * DMODEL || out_size != NTOK * DMODEL || ws_size < WS_END) {
            fprintf(stderr, "kernel_launch: unexpected shapes (n_in %d, in0 %d, out %d, ws %zu); nothing launched\n", n_in, n_in > 0 ? in_sizes[0] : -1, out_size, ws_size); grid = -1; return; }
        int dev = 0, cus = 0, per_cu = 0;
        if (hipGetDevice(&dev) != hipSuccess || hipDeviceGetAttribute(&cus, hipDeviceAttributeMultiprocessorCount, dev) != hipSuccess) { grid = -1; return; }
        if (hipFuncSetAttribute((const void*)mega_fwd, hipFuncAttributeMaxDynamicSharedMemorySize, LDS_BYTES) != hipSuccess) { fprintf(stderr, "kernel_launch: hipFuncSetAttribute failed\n"); grid = -1; return; }
        if (hipOccupancyMaxActiveBlocksPerMultiprocessor(&per_cu, (const void*)mega_fwd, NTHREADS, LDS_BYTES) != hipSuccess || per_cu < 1) { fprintf(stderr, "kernel_launch: the occupancy query reports %d workgroups per CU for this kernel and LDS size; nothing launched\n", per_cu); grid = -1; return; }
        (void)hipGetLastError();
        grid = cus;
    }
    if (grid < 0) return;
    (void)hipMemsetAsync((char*)d_ws + WS_CTL, 0, CTL_ZERO_BYTES, stream);
    Args a{};
    const float** pp = (const float**)&a.p;
    for (int i = 0; i < 25; ++i) pp[i] = (const float*)d_in[i];
    a.p.out = (float*)d_out; a.p.ws = (unsigned char*)d_ws;
#if MK_PER_PHASE
    for (int ph = 0; ph < N_PHASES; ++ph) { a.ph_lo = ph; a.ph_hi = ph + 1; void* params[] = {&a};
        hipError_t e = hipLaunchCooperativeKernel((const void*)mega_fwd, dim3(grid), dim3(NTHREADS), params, LDS_BYTES, stream);
        if (e != hipSuccess) { fprintf(stderr, "launch %d failed: %s\n", ph, hipGetErrorString(e)); break; } }
#else
    a.ph_lo = 0; a.ph_hi = N_PHASES; void* params[] = {&a};
    hipError_t e = hipLaunchCooperativeKernel((const void*)mega_fwd, dim3(grid), dim3(NTHREADS), params, LDS_BYTES, stream);
    if (e != hipSuccess) fprintf(stderr, "cooperative launch failed: %s (grid %d)\n", hipGetErrorString(e), grid);
#endif
}
```

```cpp
#include <hip/hip_runtime.h>
#include <hip/hip_bf16.h>
#include <hip/hip_cooperative_groups.h>
#include <cstdio>
#include <cstdint>
#include <cmath>
namespace cg = cooperative_groups;

constexpr int BATCH = 8, SEQ = 4096, DMODEL = 1024, NTOK = BATCH * SEQ;
constexpr int CONV_CH = 512, CONV_W = 31, NHEADS = 4, IN_COLS = 4608;
constexpr int NEXP = 32, DEXP = 512, LCAP = NTOK;
constexpr int NCLS = 4 * 28;
constexpr int CROWS = NTOK + NCLS * 256;
constexpr int MOE_ROWS = 2 * NTOK + NEXP * 256;
constexpr float EPS = 1e-6f;

namespace pg8 {
#define PG8_LAS __attribute__((address_space(3)))
typedef unsigned short bf16_t;
typedef short bf16x8 __attribute__((ext_vector_type(8)));
typedef float f32x4 __attribute__((ext_vector_type(4)));
typedef unsigned u32x4 __attribute__((ext_vector_type(4)));
constexpr int BM = 256, BK = 64, HALF = 128, HTB = HALF * BK * 2  , STAGE_BYTES = 8 * HTB, NXCD = 8, WGM = 8;

__host__ __device__ __forceinline__ int lds_byte(int r, int c) { const int st = (r >> 4) * 2 + (c >> 5), rr = r & 15, cc = c & 31, ob = rr * 64 + cc * 2; return st * 1024 + (ob ^ (((ob >> 9) & 1) << 5)); }
__host__ __device__ __forceinline__ void stage_rc(int b, int& R, int& C) { const int st = b / 1024, sb = b % 1024, swz = sb ^ (((sb >> 9) & 1) << 5); R = (st >> 1) * 16 + swz / 64; C = (st & 1) * 32 + (swz % 64) / 2; }
__host__ __device__ __forceinline__ int perm32(int rho) { const int n = rho >> 4, i = rho & 15; return 8 * (i >> 2) + 4 * n + (i & 3); }

struct Unit { int pm, pn, arow, e, e2, lrow, nvalid, orow; };
struct Gemm { const bf16_t* A; const bf16_t* Bt; int K; size_t bstride; const int* list; int lstride; int KBrow; };

struct StaticOrder {
    int nM, nN, nwg, G, c;
    __device__ void init(int M, int N, int G_, int c_) { nM = M / BM; nN = N / BM; nwg = nM * nN; G = G_; c = c_; }
    __device__ bool next(int i, Unit& u) const {
        const long L = (long)i * G + c; if (L >= nwg) return false;
        int wgid = (int)L; { const int q = nwg / NXCD, r = nwg % NXCD, xcd = wgid % NXCD, off = wgid / NXCD; wgid = (xcd < r ? xcd * (q + 1) : r * (q + 1) + (xcd - r) * q) + off; }
        const int nig = WGM * nN, gid = wgid / nig, fm = gid * WGM, gsz = (nM - fm) < WGM ? (nM - fm) : WGM;
        u.pm = fm + ((wgid % nig) % gsz); u.pn = (wgid % nig) / gsz; u.arow = u.pm * BM; u.orow = u.arow; u.e = 0; u.e2 = 0; u.lrow = 0; u.nvalid = BM; return true;
    }
};

typedef float f32x2_t __attribute__((ext_vector_type(2))); typedef __bf16 bf16x2_t __attribute__((ext_vector_type(2)));
__device__ __forceinline__ unsigned cvt_pk_bf16(float lo, float hi) { const f32x2_t v = {lo, hi}; const bf16x2_t b = __builtin_convertvector(v, bf16x2_t); return __builtin_bit_cast(unsigned, b); }
typedef int v8i_t __attribute__((ext_vector_type(8))); typedef int v4i_t __attribute__((ext_vector_type(4)));
__device__ __forceinline__ v8i_t cat8(const bf16x8 a, const bf16x8 b) { const v4i_t x = __builtin_bit_cast(v4i_t, a), y = __builtin_bit_cast(v4i_t, b); return (v8i_t){x[0], x[1], x[2], x[3], y[0], y[1], y[2], y[3]}; }
__device__ __forceinline__ unsigned pack4_fp8(float a, float b, float c, float d) { int w = 0; w = __builtin_amdgcn_cvt_pk_fp8_f32(a, b, w, false); w = __builtin_amdgcn_cvt_pk_fp8_f32(c, d, w, true); return (unsigned)w; }
__device__ __forceinline__ float bf_lo(unsigned w) { return __uint_as_float(w << 16); }
__device__ __forceinline__ float bf_hi(unsigned w) { return __uint_as_float(w & 0xffff0000u); }
__device__ __forceinline__ float sigmoidf_fast(float x) { return __builtin_amdgcn_rcpf(1.0f + __builtin_amdgcn_exp2f(-1.4426950408889634f * x)); }
__device__ __forceinline__ u32x4 pack8(const f32x4 a, const f32x4 b) { u32x4 w; w.x = cvt_pk_bf16(a[0], a[1]); w.y = cvt_pk_bf16(a[2], a[3]); w.z = cvt_pk_bf16(b[0], b[1]); w.w = cvt_pk_bf16(b[2], b[3]); return w; }
__device__ __forceinline__ void unpack8(const u32x4 w, f32x4& a, f32x4& b) { a = (f32x4){bf_lo(w.x), bf_hi(w.x), bf_lo(w.y), bf_hi(w.y)}; b = (f32x4){bf_lo(w.z), bf_hi(w.z), bf_lo(w.w), bf_hi(w.w)}; }

template <class Epi, class Sched, bool GATHER, bool ALIGN_EPI, bool FP8 = false, bool BSPLIT = false>
__device__ __forceinline__ void gemm_phase(PG8_LAS unsigned char* lds, const Gemm g, const Sched& S, const Epi& E) {
    const int tid = threadIdx.x, wid = __builtin_amdgcn_readfirstlane(tid >> 6), lane = tid & 63, wr = wid >> 2, wc = wid & 3, fr = lane & 15, fq = lane >> 4;
    const int K = g.K, nt = K / BK, KBp = g.KBrow ? g.KBrow : K;
    unsigned voffB[2]; int Ra[2], Ca[2];
#pragma unroll
    for (int i = 0; i < 2; ++i) { int R, C; stage_rc(tid * 16 + i * 8192, R, C); const int Rb = (R & ~31) + perm32(R & 31); Ra[i] = R; Ca[i] = C; voffB[i] = (unsigned)(Rb * KBp + C) * 2u; }
    const unsigned kstep = (unsigned)(BK * 2);
    const unsigned hstep = (unsigned)HALF * KBp * 2;
    const unsigned tstep = 2 * hstep;
    const char* const gA = (const char*)g.A; const char* const gB = (const char*)g.Bt;
    const unsigned ldsw = (unsigned)wid * 1024u;
    const int aoff = lds_byte(wr * 64 + fr, fq * 8), boff = lds_byte(wc * 32 + fr, fq * 8);
#define PG8_SA(b, h) (((b) * 2 + (h)) * HTB)
#define PG8_SB(b, h) ((4 + (b) * 2 + (h)) * HTB)
#define PG8_STAGE(bufoff, gbase, uoff, voff) do { _Pragma("unroll") for (int _i = 0; _i < 2; ++_i) \
        __builtin_amdgcn_global_load_lds((const unsigned*)((const char*)(gbase) + (unsigned)((uoff) + (voff)[_i])), (PG8_LAS unsigned*)(lds + (bufoff) + ldsw + _i * 8192), 16, 0, 0); } while (0)
#define PG8_LDA(dst, b, h) do { _Pragma("unroll") for (int m = 0; m < 4; ++m) _Pragma("unroll") for (int k = 0; k < 2; ++k) dst[m][k] = *(const PG8_LAS bf16x8*)(lds + PG8_SA(b, h) + aoff + m * 2048 + k * 1024); } while (0)
#define PG8_LDB(dst, b, h) do { _Pragma("unroll") for (int n = 0; n < 2; ++n) _Pragma("unroll") for (int k = 0; k < 2; ++k) dst[n][k] = *(const PG8_LAS bf16x8*)(lds + PG8_SB(b, h) + boff + n * 2048 + k * 1024); } while (0)
#define PG8_MMA(ai, bj, At, Bt) do { __builtin_amdgcn_s_setprio(1); \
        if constexpr (FP8) { _Pragma("unroll") for (int m = 0; m < 4; ++m) _Pragma("unroll") for (int n = 0; n < 2; ++n) \
            asm volatile("v_mfma_scale_f32_16x16x128_f8f6f4 %0, %1, %2, %0, %3, %3 op_sel_hi:[0,0,0]" : "+v"(acc[ai][bj][m][n]) : "v"(cat8(Bt[n][0], Bt[n][1])), "v"(cat8(At[m][0], At[m][1])), "v"(one_e8m0)); } \
        else { _Pragma("unroll") for (int m = 0; m < 4; ++m) _Pragma("unroll") for (int n = 0; n < 2; ++n) _Pragma("unroll") for (int k = 0; k < 2; ++k) \
            acc[ai][bj][m][n] = __builtin_amdgcn_mfma_f32_16x16x32_bf16(Bt[n][k], At[m][k], acc[ai][bj][m][n], 0, 0, 0); } \
        __builtin_amdgcn_s_setprio(0); } while (0)
#define PG8_WAIT_V(n) asm volatile("s_waitcnt vmcnt(" #n ")" ::: "memory")
#define PG8_WAIT_L(n) asm volatile("s_waitcnt lgkmcnt(" #n ")" ::: "memory")
#define PG8_BAR __builtin_amdgcn_s_barrier()
#define PG8_SCHED __builtin_amdgcn_sched_barrier(0)
#define PG8_LOAD_VA(dst, u) do { _Pragma("unroll") for (int _h = 0; _h < 2; ++_h) _Pragma("unroll") for (int _i = 0; _i < 2; ++_i) { const int _row = _h * HALF + Ra[_i]; \
        if constexpr (GATHER) { const int _tok = (_row < (u).nvalid) ? g.list[((u).lrow + _row) * g.lstride] : 0; dst[_h][_i] = (unsigned)(_tok * K + Ca[_i]) * 2u; } \
        else dst[_h][_i] = (unsigned)(_row * K + Ca[_i]) * 2u; } } while (0)
    Unit cur, nxt; int ui = 0;
    if (!S.next(0, cur)) return;
    unsigned vAc[2][2], vAn[2][2];
    PG8_LOAD_VA(vAc, cur);
    f32x4 acc[2][2][4][2];
#pragma unroll
    for (int a = 0; a < 2; ++a)
#pragma unroll
        for (int b = 0; b < 2; ++b)
#pragma unroll
            for (int m = 0; m < 4; ++m)
#pragma unroll
                for (int n = 0; n < 2; ++n) acc[a][b][m][n] = (f32x4){0.f, 0.f, 0.f, 0.f};
    bf16x8 At[4][2], B0[2][2], B1[2][2];
    const int one_e8m0 = 0x7f7f7f7f; (void)one_e8m0;
    unsigned cA = (unsigned)cur.arow * K * 2, cB = (unsigned)cur.e * (unsigned)g.bstride + (unsigned)cur.pn * tstep;
    unsigned cB2 = (unsigned)cur.e2 * (unsigned)g.bstride + (unsigned)cur.pn * tstep; const unsigned hk = (unsigned)(nt / 2) * kstep; (void)cB2; (void)hk;
    PG8_STAGE(PG8_SB(0, 0), gB, cB, voffB); PG8_STAGE(PG8_SB(0, 1), gB, cB + hstep, voffB); PG8_STAGE(PG8_SA(0, 0), gA, cA, vAc[0]); PG8_STAGE(PG8_SA(0, 1), gA, cA, vAc[1]);
    if (wr == 1) PG8_BAR;
    PG8_WAIT_V(2); PG8_BAR;
    PG8_STAGE(PG8_SB(1, 0), gB, cB + kstep, voffB); PG8_STAGE(PG8_SA(1, 0), gA, cA + kstep, vAc[0]); PG8_STAGE(PG8_SB(1, 1), gB, cB + hstep + kstep, voffB);
    PG8_WAIT_V(6); PG8_BAR;
    for (;;) {
        const bool has_next = S.next(ui + 1, nxt);
        const unsigned nA = has_next ? (unsigned)nxt.arow * K * 2 : cA;
        const unsigned nB = has_next ? (unsigned)nxt.e * (unsigned)g.bstride + (unsigned)nxt.pn * tstep : cB;
        const unsigned nB2 = has_next ? (unsigned)nxt.e2 * (unsigned)g.bstride + (unsigned)nxt.pn * tstep : cB2; (void)nB2;
        if (has_next) { PG8_LOAD_VA(vAn, nxt); }
        else {
#pragma unroll
            for (int h = 0; h < 2; ++h)
#pragma unroll
                for (int i = 0; i < 2; ++i) vAn[h][i] = vAc[h][i]; }
#pragma unroll 1
        for (int t = 0; t < nt; t += 2) {
            const bool last = (t == nt - 2);
            if constexpr (Epi::MID) { if (t == nt / 2) E.mid(acc, cur, wr, wc, fr, fq); }
            const unsigned a1 = cA + (unsigned)(t + 1) * kstep;
            const unsigned a2 = last ? nA : cA + (unsigned)(t + 2) * kstep;
            unsigned b2 = last ? nB : cB + (unsigned)(t + 2) * kstep;
            if constexpr (BSPLIT) { if (!last && t + 2 >= nt / 2) b2 = cB2 + (unsigned)(t + 2) * kstep - hk; }
            const unsigned a3 = a2 + kstep, b3 = b2 + kstep;
            unsigned v2[2][2];
#pragma unroll
            for (int h = 0; h < 2; ++h)
#pragma unroll
                for (int i = 0; i < 2; ++i) v2[h][i] = vAc[h][i];
            if (last) { asm volatile("" ::: "memory");
#pragma unroll
                for (int h = 0; h < 2; ++h)
#pragma unroll
                    for (int i = 0; i < 2; ++i) v2[h][i] = vAn[h][i]; }
            PG8_LDB(B0, 0, 0); PG8_LDB(B1, 0, 1); PG8_SCHED; PG8_LDA(At, 0, 0); PG8_STAGE(PG8_SA(1, 1), gA, a1, vAc[1]);
            PG8_WAIT_V(8); PG8_WAIT_L(0); PG8_BAR; PG8_MMA(0, 0, At, B0); PG8_MMA(0, 1, At, B1); PG8_BAR; PG8_SCHED;
            PG8_LDA(At, 0, 1); PG8_STAGE(PG8_SB(0, 0), gB, b2, voffB); PG8_STAGE(PG8_SB(0, 1), gB, b2 + hstep, voffB); PG8_STAGE(PG8_SA(0, 0), gA, a2, v2[0]);
            PG8_WAIT_V(8); PG8_WAIT_L(0); PG8_BAR; PG8_MMA(1, 0, At, B0); PG8_MMA(1, 1, At, B1); PG8_BAR; PG8_SCHED;
            PG8_LDB(B0, 1, 0); PG8_LDB(B1, 1, 1); PG8_SCHED; PG8_LDA(At, 1, 0); PG8_STAGE(PG8_SA(0, 1), gA, a2, v2[1]);
            PG8_WAIT_V(8); PG8_WAIT_L(0); PG8_BAR; PG8_MMA(0, 0, At, B0); PG8_MMA(0, 1, At, B1); PG8_BAR; PG8_SCHED;
            PG8_LDA(At, 1, 1); PG8_STAGE(PG8_SB(1, 0), gB, b3, voffB); PG8_STAGE(PG8_SB(1, 1), gB, b3 + hstep, voffB); PG8_STAGE(PG8_SA(1, 0), gA, a3, v2[0]);
            PG8_WAIT_V(8); PG8_WAIT_L(0); PG8_BAR; PG8_MMA(1, 0, At, B0); PG8_MMA(1, 1, At, B1); PG8_BAR; PG8_SCHED;
        }
        if constexpr (ALIGN_EPI) { if (wr == 0) PG8_BAR; }
        if constexpr (FP8) asm volatile("s_nop 15\n\ts_nop 15\n\ts_nop 15\n\ts_nop 15" ::: "memory");
        E(acc, cur, wr, wc, fr, fq);
        if (!has_next) break;
#pragma unroll
        for (int a = 0; a < 2; ++a)
#pragma unroll
            for (int b = 0; b < 2; ++b)
#pragma unroll
                for (int m = 0; m < 4; ++m)
#pragma unroll
                    for (int n = 0; n < 2; ++n) acc[a][b][m][n] = (f32x4){0.f, 0.f, 0.f, 0.f};
        cur = nxt; cA = nA; cB = nB; cB2 = nB2; ++ui;
#pragma unroll
        for (int h = 0; h < 2; ++h)
#pragma unroll
            for (int i = 0; i < 2; ++i) vAc[h][i] = vAn[h][i];
        if constexpr (ALIGN_EPI) { if (wr == 1) PG8_BAR; }
    }
    PG8_WAIT_V(0);
    if constexpr (!ALIGN_EPI) { if (wr == 0) PG8_BAR; }
    PG8_BAR;
#undef PG8_SA
#undef PG8_SB
#undef PG8_STAGE
#undef PG8_LDA
#undef PG8_LDB
#undef PG8_MMA
#undef PG8_WAIT_V
#undef PG8_WAIT_L
#undef PG8_BAR
#undef PG8_SCHED
#undef PG8_LOAD_VA
}
}

namespace attn_body {
using bf16=__hip_bfloat16;
using bf16x8=__attribute__((ext_vector_type(8)))short;
using s16x4=__attribute__((ext_vector_type(4)))short;
using f32x16=__attribute__((ext_vector_type(16)))float;
using u32x4=__attribute__((ext_vector_type(4)))unsigned;
constexpr int D=64, QP=512, KP=512, VP=512, OP=1024;
constexpr int NW=8,QBLK=32,QB=QBLK*NW,KVBLK=64;
constexpr int ATTN_UNIT_ROWS=QB;
__device__ __forceinline__ int crow(int r,int hi){return (r&3)+8*(r>>2)+4*hi;}
#define SBAR() __builtin_amdgcn_sched_barrier(0)
__device__ __forceinline__ void cmask(f32x16&p0,f32x16&p1,int jb,int qrel,int hi){
  const float NEG=-INFINITY; int kb=64*jb+4*hi;
  #pragma unroll
  for(int r=0;r<16;++r){int kv=kb+(r&3)+8*(r>>2); if(kv>qrel)p0[r]=NEG; if(kv+32>qrel)p1[r]=NEG;}
}

constexpr int NSLOT=3, SLOTB=8192, VSLOTB=16384;
constexpr int LDS_K=0, LDS_V=NSLOT*SLOTB, LDS_WS=LDS_V+NSLOT*VSLOTB, LDS_OST=LDS_WS+NW*64*4, LDS_BYTES=LDS_OST+NW*4096;
constexpr float C2=0.125f*1.4426950408889634f;
__device__ __forceinline__ void glds16(const void*gsrc,unsigned lds_dst){unsigned keep;
  asm volatile("s_mov_b32 %0, m0\n\ts_mov_b32 m0, %2\n\ts_nop 0\n\tglobal_load_lds_dwordx4 %1, off\n\ts_mov_b32 m0, %0":"=&s"(keep):"v"(gsrc),"s"(lds_dst):"memory");}
__device__ __forceinline__ float max3f(float a,float b,float c){float r;asm("v_max3_f32 %0, %1, %2, %3":"=v"(r):"v"(a),"v"(b),"v"(c));return r;}
__device__ __forceinline__ float max2f(float a,float b){float r;asm("v_max_f32_e32 %0, %1, %2":"=v"(r):"v"(a),"v"(b));return r;}
__device__ __forceinline__ float fadd_s(float a,float b){float r;asm("v_add_f32_e32 %0, %1, %2":"=v"(r):"v"(a),"v"(b));return r;}
__device__ __forceinline__ float fsub_s(float a,float b){float r;asm("v_sub_f32_e32 %0, %1, %2":"=v"(r):"v"(a),"v"(b));return r;}
typedef float f32x2_t __attribute__((ext_vector_type(2))); typedef __bf16 bf16x2_t __attribute__((ext_vector_type(2)));
__device__ __forceinline__ unsigned cvtpk_s(float lo,float hi){f32x2_t v={lo,hi};bf16x2_t b=__builtin_convertvector(v,bf16x2_t);return __builtin_bit_cast(unsigned,b);}
#define WAIT_BAR(N) asm volatile("s_waitcnt vmcnt(" #N ") lgkmcnt(0)\n\ts_barrier":::"memory")

__device__ __forceinline__ void qkt(f32x16&p0,f32x16&p1,const char*Kslot,const bf16x8*qr,const f32x16&negm,int r32,int hi){
  const char*kb=Kslot+hi*1024+r32*16;
  #pragma unroll
  for(int d0=0;d0<4;++d0){
    const bf16x8 b0=*reinterpret_cast<const bf16x8*>(kb+d0*2048);
    const bf16x8 b1=*reinterpret_cast<const bf16x8*>(kb+d0*2048+512);
    if(d0==0){p0=__builtin_amdgcn_mfma_f32_32x32x16_bf16(b0,qr[0],negm,0,0,0);p1=__builtin_amdgcn_mfma_f32_32x32x16_bf16(b1,qr[0],negm,0,0,0);}
    else{p0=__builtin_amdgcn_mfma_f32_32x32x16_bf16(b0,qr[d0],p0,0,0,0);p1=__builtin_amdgcn_mfma_f32_32x32x16_bf16(b1,qr[d0],p1,0,0,0);}}
}
typedef __attribute__((address_space(3))) const char* lds_cptr;
typedef short v4i16_t __attribute__((ext_vector_type(4)));
__device__ __forceinline__ void kload8(bf16x8*kf,lds_cptr kp){
  kf[0]=*(const __attribute__((address_space(3))) bf16x8*)(kp);      kf[1]=*(const __attribute__((address_space(3))) bf16x8*)(kp+512);
  kf[2]=*(const __attribute__((address_space(3))) bf16x8*)(kp+2048); kf[3]=*(const __attribute__((address_space(3))) bf16x8*)(kp+2560);
  kf[4]=*(const __attribute__((address_space(3))) bf16x8*)(kp+4096); kf[5]=*(const __attribute__((address_space(3))) bf16x8*)(kp+4608);
  kf[6]=*(const __attribute__((address_space(3))) bf16x8*)(kp+6144); kf[7]=*(const __attribute__((address_space(3))) bf16x8*)(kp+6656);
}
__device__ __forceinline__ void kload2(bf16x8*kf,lds_cptr kp,int j){ kf[2*j]=*(const __attribute__((address_space(3))) bf16x8*)(kp+j*2048); kf[2*j+1]=*(const __attribute__((address_space(3))) bf16x8*)(kp+j*2048+512); }
__device__ __forceinline__ s16x4 vtr(lds_cptr p){ return __builtin_bit_cast(s16x4,__builtin_amdgcn_ds_read_tr16_b64_v4i16((__attribute__((address_space(3))) v4i16_t*)p)); }
__device__ __forceinline__ float rowmax(const f32x16&p0,const f32x16&p1){
  float a=max3f(p0[0],p0[1],p1[0]),b=max3f(p0[2],p0[3],p1[1]);a=max3f(a,p1[2],p1[3]);
  #pragma unroll
  for(int r=4;r<16;r+=4){a=max3f(a,p0[r],p0[r+1]);b=max3f(b,p0[r+2],p0[r+3]);a=max3f(a,p1[r],p1[r+1]);b=max3f(b,p1[r+2],p1[r+3]);}
  const float m=max2f(a,b);
  auto rr=__builtin_amdgcn_permlane32_swap(__float_as_uint(m),__float_as_uint(m),false,false);
  return max2f(__uint_as_float(rr[0]),__uint_as_float(rr[1]));
}
__device__ __forceinline__ void pv(f32x16*o,int vb,bf16x8 pa0,bf16x8 pa1,bf16x8 pa2,bf16x8 pa3){
  #pragma unroll
  for(int d0=0;d0<4;++d0){s16x4 lo[4],hi[4];
    #pragma unroll
    for(int ks=0;ks<4;++ks){
      asm volatile("ds_read_b64_tr_b16 %0,%1 offset:%c2":"=&v"(lo[ks]):"v"(vb),"i"(d0*4096+ks*1024):"memory");
      asm volatile("ds_read_b64_tr_b16 %0,%1 offset:%c2":"=&v"(hi[ks]):"v"(vb),"i"(d0*4096+ks*1024+512):"memory");}
    asm volatile("s_waitcnt lgkmcnt(0)":::"memory");SBAR();
    #define PK(k) (bf16x8){lo[k][0],lo[k][1],lo[k][2],lo[k][3],hi[k][0],hi[k][1],hi[k][2],hi[k][3]}
    o[d0]=__builtin_amdgcn_mfma_f32_32x32x16_bf16(pa0,PK(0),o[d0],0,0,0);
    o[d0]=__builtin_amdgcn_mfma_f32_32x32x16_bf16(pa1,PK(1),o[d0],0,0,0);
    o[d0]=__builtin_amdgcn_mfma_f32_32x32x16_bf16(pa2,PK(2),o[d0],0,0,0);
    o[d0]=__builtin_amdgcn_mfma_f32_32x32x16_bf16(pa3,PK(3),o[d0],0,0,0);
    #undef PK
  }
}

#ifndef ATTN_STORE16
#define ATTN_STORE16(p,v) (*(u32x4*)(p)=(v))
#endif
template<int THRL,bool STAT> __device__ __forceinline__ int attn_unit(float mstat,int q0,const bf16*Q,const bf16*__restrict__ K,const bf16*__restrict__ V,bf16*O,char*shm,const bf16*O1,float lam,const float*subg,unsigned short*CAo,const bf16*Knext,const bf16*Vnext,int s0,bool pre){
  #define NXT_(x) (((x)==(NSLOT-1)*SLOTB)?0:(x)+SLOTB)
  const int s1=NXT_(s0),s2=NXT_(s1);
  int tid_=threadIdx.x; asm volatile("":"+v"(tid_));
  const int tid=tid_,lane=tid&63,r32=lane&31,hi=lane>>5; const int wid=__builtin_amdgcn_readfirstlane(tid>>6);
  const bf16*Qw=Q+(long)(q0+wid*QBLK)*QP;
  const bf16*Kh=K,*Vh=V;
  const unsigned lds0=(unsigned)(uintptr_t)shm;
  float*wsf=(float*)(shm+LDS_WS)+wid*64;
  const bf16*ksrc=Kh+(long)lane*KP+wid*8;
  const bf16*vsrc=Vh+(long)(16*(wid&3)+(lane>>2))*VP+(wid>>2)*32+(lane&3)*8;
  const unsigned kdst=lds0+LDS_K+wid*1024, vdst=lds0+LDS_V+wid*1024;
  #define DMA_K(t,slot) glds16(ksrc+(long)(t)*KVBLK*KP,(unsigned)__builtin_amdgcn_readfirstlane(kdst+(slot)))
  #define DMA_V(t,slot) do{ glds16(vsrc+(long)(t)*KVBLK*VP,(unsigned)__builtin_amdgcn_readfirstlane(vdst+2*(slot))); glds16(vsrc+(long)(t)*KVBLK*VP+64,(unsigned)__builtin_amdgcn_readfirstlane(vdst+2*(slot)+8192)); }while(0)
  const int vb0=(int)(lds0+LDS_V)+((lane>>4)&1)*32+(lane&3)*8+(4*hi+((lane&15)>>2))*64;
  const char*Kbase=shm+LDS_K; bf16x8 kf[8];
  const lds_cptr shm3=(lds_cptr)shm; const lds_cptr kp0=shm3+LDS_K+hi*1024+r32*16; const lds_cptr vp0=shm3+LDS_V+((lane>>4)&1)*32+(lane&3)*8+(4*hi+((lane&15)>>2))*64;
  const int NT=(q0+QB)/KVBLK;
  if(!pre){DMA_K(0,s0);DMA_V(0,s0);DMA_K(1,s1);}
  bf16x8 qr[4];
  #pragma unroll
  for(int d0=0;d0<4;++d0)qr[d0]=*reinterpret_cast<const bf16x8*>(&Qw[(long)r32*QP+d0*16+hi*8]);
  float mhat=0.f,l_reg=0.f;f32x16 o[4];{float zz=0.f;asm volatile("":"+v"(zz));
  #pragma unroll
  for(int r=0;r<16;++r){o[0][r]=zz;o[1][r]=zz;o[2][r]=zz;o[3][r]=zz;}}
  f32x16 negm;{float zn=0.f;asm volatile("":"+v"(zn));
  #pragma unroll
  for(int r=0;r<16;++r)negm[r]=zn;}
  asm volatile("":"+v"(negm));
  const int qrel=wid*QBLK+r32;
  #define CMASK(P0,P1,t) do{int jb_=(t)-(NT-4); if(jb_>=0)cmask(P0,P1,jb_,qrel,hi);}while(0)
  bool resc=false;
  #define START(P0,P1) do{ float rm; if constexpr (STAT) rm=mstat; else rm=rowmax(P0,P1); resc=false; \
    { const float dl=rm; mhat=fadd_s(mhat,dl); \
      _Pragma("unroll") for(int r=0;r<16;++r){P0[r]=fsub_s(P0[r],dl);P1[r]=fsub_s(P1[r],dl);} \
      _Pragma("unroll") for(int r=0;r<16;++r)negm[r]=-mhat; asm volatile("":"+v"(negm)); } \
    _Pragma("unroll") for(int r=0;r<16;++r)P0[r]=__builtin_amdgcn_exp2f(P0[r]); }while(0)
  #define RESC() do{ if(resc){ asm volatile("s_waitcnt lgkmcnt(0)":::"memory"); \
      _Pragma("unroll") for(int d_=0;d_<4;++d_) _Pragma("unroll") for(int r=0;r<16;++r)o[d_][r]*=wsf[crow(r,hi)]; } }while(0)
  f32x16 pA0,pA1,pB0,pB1;
  int sl_prev=s0,sl_cur=s0,sl_next=s1;
  #define ROT() do{sl_prev=sl_cur;sl_cur=sl_next;sl_next=(sl_next==(NSLOT-1)*SLOTB)?0:sl_next+SLOTB;}while(0)
  if(!pre){DMA_K(2,s2);}
  WAIT_BAR(4);
  qkt(pA0,pA1,Kbase+s0,qr,negm,r32,hi);asm volatile("s_nop 15\n\ts_nop 7":"+v"(pA0),"+v"(pA1));CMASK(pA0,pA1,0);
  START(pA0,pA1);
  _Pragma("unroll") for(int r=0;r<16;++r)pA1[r]=__builtin_amdgcn_exp2f(pA1[r]);
  WAIT_BAR(0);
  DMA_K(3,s0);DMA_V(1,s1);
  ROT();
  kload8(kf,kp0+sl_cur);
  WAIT_BAR(3);
  s16x4 vlo[8],vhi[8]; u32x4 pw0,pw1,pw2,pw3;
  #define PKW(P,B) cvtpk_s(P[B],P[B+1])
  #define PAF(k) __builtin_bit_cast(bf16x8,pw##k)
  #define VFR(i) (bf16x8){vlo[i][0],vlo[i][1],vlo[i][2],vlo[i][3],vhi[i][0],vhi[i][1],vhi[i][2],vhi[i][3]}
  #define PIN(x) asm volatile("":"+v"(x))
  #define MX3(a,b,c) __builtin_fmaxf(__builtin_fmaxf((a),(b)),(c))
  #define GAPA(MF,A0,A1,A2,A3,W0,W1,PW) do{ MF; sacc+=A0; sacc+=A1; sacc+=A2; sacc+=A3; PIN(sacc); W0; W1; PIN(PW); SBAR(); }while(0)
  #define EX(v) __builtin_amdgcn_exp2f(v)
  #define GAPB2(MF,X,B) do{ MF; X[B]=EX(X[B]); X[B+1]=EX(X[B+1]); PIN(X); SBAR(); }while(0)
  #define VRD2(i) do{ vlo[i]=vtr(vp_+((((i)>>2)+2)*4096+((i)&3)*1024)); vhi[i]=vtr(vp_+((((i)>>2)+2)*4096+((i)&3)*1024+512)); }while(0)
  #define VRD(i) do{ vlo[i]=vtr(vp_+(((i)>>2)*4096+((i)&3)*1024)); vhi[i]=vtr(vp_+(((i)>>2)*4096+((i)&3)*1024+512)); }while(0)
  #define KRD(G,j) do{ if(G){ kload2(kf,kp0+sl_next,j); SBAR(); } }while(0)
  #define STEP(C0,C1,P0,P1,t,GK,GV,GL) do{ SBAR(); \
    const lds_cptr vp_=vp0+2*sl_prev; \
    VRD(0); SBAR(); float sacc=(P0[0]+P0[1]); \
    GAPA(C0=__builtin_amdgcn_mfma_f32_32x32x16_bf16(kf[0],qr[0],negm,0,0,0), P0[2],P0[3],P0[4],P0[5],     pw0[0]=PKW(P0,0), pw0[1]=PKW(P0,2), pw0); \
    VRD(4); SBAR(); GAPA(C1=__builtin_amdgcn_mfma_f32_32x32x16_bf16(kf[1],qr[0],negm,0,0,0), P0[6],P0[7],P0[8],P0[9],     pw0[2]=PKW(P0,4), pw0[3]=PKW(P0,6), pw0); \
    VRD(1); SBAR(); GAPA(C0=__builtin_amdgcn_mfma_f32_32x32x16_bf16(kf[2],qr[1],C0,0,0,0),   P0[10],P0[11],P0[12],P0[13], pw1[0]=PKW(P0,8), pw1[1]=PKW(P0,10), pw1); \
    VRD(5); SBAR(); GAPA(C1=__builtin_amdgcn_mfma_f32_32x32x16_bf16(kf[3],qr[1],C1,0,0,0),   P0[14],P0[15],P1[0],P1[1],   pw1[2]=PKW(P0,12),pw1[3]=PKW(P0,14), pw1); \
    VRD(2); SBAR(); GAPA(C0=__builtin_amdgcn_mfma_f32_32x32x16_bf16(kf[4],qr[2],C0,0,0,0),   P1[2],P1[3],P1[4],P1[5],     pw2[0]=PKW(P1,0), pw2[1]=PKW(P1,2), pw2); \
    VRD(6); SBAR(); GAPA(C1=__builtin_amdgcn_mfma_f32_32x32x16_bf16(kf[5],qr[2],C1,0,0,0),   P1[6],P1[7],P1[8],P1[9],     pw2[2]=PKW(P1,4), pw2[3]=PKW(P1,6), pw2); \
    VRD(3); SBAR(); GAPA(C0=__builtin_amdgcn_mfma_f32_32x32x16_bf16(kf[6],qr[3],C0,0,0,0),   P1[10],P1[11],P1[12],P1[13], pw3[0]=PKW(P1,8), pw3[1]=PKW(P1,10), pw3); \
    VRD(7); SBAR(); GAPA(C1=__builtin_amdgcn_mfma_f32_32x32x16_bf16(kf[7],qr[3],C1,0,0,0),   P1[14],P1[15],0.f,0.f,       pw3[2]=PKW(P1,12),pw3[3]=PKW(P1,14), pw3); \
    l_reg+=sacc; \
    if(GK){DMA_K((t)+3,sl_cur);} if(GV){DMA_V((t)+1,sl_next);} \
    CMASK(C0,C1,t); \
    if constexpr (!STAT) { float a=MX3(C0[0],C0[1],C1[0]),b=MX3(C0[2],C0[3],C1[1]); a=MX3(a,C1[2],C1[3]); \
      _Pragma("unroll") for(int r=4;r<16;r+=4){a=MX3(a,C0[r],C0[r+1]);b=MX3(b,C0[r+2],C0[r+3]);a=MX3(a,C1[r],C1[r+1]);b=MX3(b,C1[r+2],C1[r+3]);} \
      float rm=__builtin_fmaxf(a,b); { auto rr=__builtin_amdgcn_permlane32_swap(__float_as_uint(rm),__float_as_uint(rm),false,false); rm=__builtin_fmaxf(__uint_as_float(rr[0]),__uint_as_float(rr[1])); } \
      resc=false; \
      if(__builtin_expect(__any(rm>(float)THRL),0)){ const float dl=__builtin_fmaxf(rm,0.f); mhat+=dl; \
        _Pragma("unroll") for(int r=0;r<16;++r){C0[r]-=dl;C1[r]-=dl;} \
        _Pragma("unroll") for(int r=0;r<16;++r)negm[r]=-mhat; asm volatile("":"+v"(negm)); \
        const float f=__builtin_amdgcn_exp2f(-dl); l_reg*=f; if(hi==0)wsf[r32]=f; resc=true; } } \
    SBAR(); \
    GAPB2(o[0]=__builtin_amdgcn_mfma_f32_32x32x16_bf16(PAF(0),VFR(0),o[0],0,0,0), C0,0);  VRD2(0); SBAR(); \
    GAPB2(o[1]=__builtin_amdgcn_mfma_f32_32x32x16_bf16(PAF(0),VFR(4),o[1],0,0,0), C0,2);  VRD2(4); SBAR(); \
    GAPB2(o[0]=__builtin_amdgcn_mfma_f32_32x32x16_bf16(PAF(1),VFR(1),o[0],0,0,0), C0,4);  VRD2(1); SBAR(); \
    GAPB2(o[1]=__builtin_amdgcn_mfma_f32_32x32x16_bf16(PAF(1),VFR(5),o[1],0,0,0), C0,6);  VRD2(5); SBAR(); \
    GAPB2(o[0]=__builtin_amdgcn_mfma_f32_32x32x16_bf16(PAF(2),VFR(2),o[0],0,0,0), C0,8);  VRD2(2); SBAR(); \
    GAPB2(o[1]=__builtin_amdgcn_mfma_f32_32x32x16_bf16(PAF(2),VFR(6),o[1],0,0,0), C0,10); VRD2(6); SBAR(); \
    GAPB2(o[0]=__builtin_amdgcn_mfma_f32_32x32x16_bf16(PAF(3),VFR(3),o[0],0,0,0), C0,12); VRD2(3); SBAR(); \
    GAPB2(o[1]=__builtin_amdgcn_mfma_f32_32x32x16_bf16(PAF(3),VFR(7),o[1],0,0,0), C0,14); VRD2(7); SBAR(); \
    GAPB2(o[2]=__builtin_amdgcn_mfma_f32_32x32x16_bf16(PAF(0),VFR(0),o[2],0,0,0), C1,0); \
    GAPB2(o[3]=__builtin_amdgcn_mfma_f32_32x32x16_bf16(PAF(0),VFR(4),o[3],0,0,0), C1,2); \
    KRD(GL,0); GAPB2(o[2]=__builtin_amdgcn_mfma_f32_32x32x16_bf16(PAF(1),VFR(1),o[2],0,0,0), C1,4); \
    KRD(GL,1); GAPB2(o[3]=__builtin_amdgcn_mfma_f32_32x32x16_bf16(PAF(1),VFR(5),o[3],0,0,0), C1,6); \
    KRD(GL,2); GAPB2(o[2]=__builtin_amdgcn_mfma_f32_32x32x16_bf16(PAF(2),VFR(2),o[2],0,0,0), C1,8); \
    KRD(GL,3); GAPB2(o[3]=__builtin_amdgcn_mfma_f32_32x32x16_bf16(PAF(2),VFR(6),o[3],0,0,0), C1,10); \
    GAPB2(o[2]=__builtin_amdgcn_mfma_f32_32x32x16_bf16(PAF(3),VFR(3),o[2],0,0,0), C1,12); \
    GAPB2(o[3]=__builtin_amdgcn_mfma_f32_32x32x16_bf16(PAF(3),VFR(7),o[3],0,0,0), C1,14); \
    }while(0)
  int t=1;
  #undef CMASK
  #define CMASK(P0,P1,t) do{}while(0)
  for(;t+5<NT;t+=2){
    STEP(pB0,pB1,pA0,pA1,t,true,true,true);     WAIT_BAR(3); RESC(); ROT();
    STEP(pA0,pA1,pB0,pB1,t+1,true,true,true);   WAIT_BAR(3); RESC(); ROT();
  }
  #undef CMASK
  #define CMASK(P0,P1,t) do{int jb_=(t)-(NT-4); if(jb_>=0)cmask(P0,P1,jb_,qrel,hi);}while(0)
  #define ENDW(tt) do{ if((tt)+3<NT){WAIT_BAR(3);} else if((tt)+2<NT){WAIT_BAR(2);} else {WAIT_BAR(0);} }while(0)
  for(;t+1<NT;t+=2){
    STEP(pB0,pB1,pA0,pA1,t,(t+3<NT),(t+1<NT),(t+1<NT));       ENDW(t);   RESC(); ROT();
    STEP(pA0,pA1,pB0,pB1,t+1,(t+4<NT),(t+2<NT),(t+2<NT));     ENDW(t+1); RESC(); ROT();
  }
  int snext=0;
  if(Knext!=nullptr){
    const int p0=sl_next,p1=NXT_(p0),p2=NXT_(p1); snext=p0;
    const bf16*kn=Knext+(long)lane*KP+wid*8; const bf16*vn=Vnext+(long)(16*(wid&3)+(lane>>2))*VP+(wid>>2)*32+(lane&3)*8;
    glds16(kn,(unsigned)__builtin_amdgcn_readfirstlane(kdst+p0));
    glds16(vn,(unsigned)__builtin_amdgcn_readfirstlane(vdst+2*p0)); glds16(vn+64,(unsigned)__builtin_amdgcn_readfirstlane(vdst+2*p0+8192));
    glds16(kn+(long)KVBLK*KP,(unsigned)__builtin_amdgcn_readfirstlane(kdst+p1)); glds16(kn+(long)2*KVBLK*KP,(unsigned)__builtin_amdgcn_readfirstlane(kdst+p2)); }
  STEP(pB0,pB1,pA0,pA1,NT-1,false,false,false); RESC();
  { float sacc=pB0[0]+pB0[1]; _Pragma("unroll") for(int r=2;r<16;++r)sacc+=pB0[r]; _Pragma("unroll") for(int r=0;r<16;++r)sacc+=pB1[r]; l_reg+=sacc;
    pw0=(u32x4){PKW(pB0,0),PKW(pB0,2),PKW(pB0,4),PKW(pB0,6)};pw1=(u32x4){PKW(pB0,8),PKW(pB0,10),PKW(pB0,12),PKW(pB0,14)};pw2=(u32x4){PKW(pB1,0),PKW(pB1,2),PKW(pB1,4),PKW(pB1,6)};pw3=(u32x4){PKW(pB1,8),PKW(pB1,10),PKW(pB1,12),PKW(pB1,14)};
    SBAR(); pv(o,vb0+2*sl_cur,PAF(0),PAF(1),PAF(2),PAF(3)); }
  #undef PKW
  #undef PAF
  #undef VFR
  #undef PIN
  #undef MX3
  #undef GAPA
  #undef GAPB2
  #undef VRD2
  #undef EX
  #undef VRD
  #undef KRD
  #undef STEP
  #undef ENDW
  {auto rr=__builtin_amdgcn_permlane32_swap(__float_as_uint(l_reg),__float_as_uint(l_reg),false,false);l_reg=__uint_as_float(rr[0])+__uint_as_float(rr[1]);}
  if(hi==0)wsf[32+r32]=l_reg;asm volatile("s_waitcnt lgkmcnt(0)":::"memory");
  float rli[16];
  #pragma unroll
  for(int r=0;r<16;++r)rli[r]=__builtin_amdgcn_rcpf(wsf[32+crow(r,hi)]);
  bf16*Ow=O+(long)(q0+wid*QBLK)*OP;
  bf16*stg=(bf16*)(shm+LDS_OST)+wid*2048;
  if(O1==nullptr){
    #pragma unroll
    for(int hf=0;hf<2;++hf){
      #pragma unroll
      for(int r=0;r<16;++r){const int orow=crow(r,hi);
        #pragma unroll
        for(int d0=0;d0<2;++d0)stg[orow*64+d0*32+r32]=__float2bfloat16(o[2*hf+d0][r]*rli[r]);}
      asm volatile("s_waitcnt lgkmcnt(0)":::"memory");
      #pragma unroll
      for(int i=0;i<4;++i){const int row=i*8+(lane>>3),ch=lane&7; const u32x4 v=*(const u32x4*)(stg+row*64+ch*8); ATTN_STORE16(Ow+(long)row*OP+hf*64+ch*8,v);}
      asm volatile("s_waitcnt lgkmcnt(0)":::"memory"); }
  } else {
    const bf16*O1w=O1+(long)(q0+wid*QBLK)*OP; unsigned long long p1[2][4][2];
    #pragma unroll
    for(int hf=0;hf<2;++hf)
      #pragma unroll
      for(int i=0;i<4;++i){const int row=i*8+(lane>>3),ch=lane&7; unsigned long long*a=(unsigned long long*)(O1w+(long)row*OP+hf*64+ch*8);
        p1[hf][i][0]=__hip_atomic_load(a,__ATOMIC_RELAXED,__HIP_MEMORY_SCOPE_AGENT); p1[hf][i][1]=__hip_atomic_load(a+1,__ATOMIC_RELAXED,__HIP_MEMORY_SCOPE_AGENT);}
    float dd[2][4][8]; float ssp[4]={0.f,0.f,0.f,0.f};
    #pragma unroll
    for(int hf=0;hf<2;++hf){
      #pragma unroll
      for(int r=0;r<16;++r){const int orow=crow(r,hi);
        #pragma unroll
        for(int d0=0;d0<2;++d0)stg[orow*64+d0*32+r32]=__float2bfloat16(o[2*hf+d0][r]*rli[r]);}
      asm volatile("s_waitcnt lgkmcnt(0)":::"memory");
      #pragma unroll
      for(int i=0;i<4;++i){const int row=i*8+(lane>>3),ch=lane&7; const u32x4 v=*(const u32x4*)(stg+row*64+ch*8);
        const unsigned w1[4]={(unsigned)p1[hf][i][0],(unsigned)(p1[hf][i][0]>>32),(unsigned)p1[hf][i][1],(unsigned)(p1[hf][i][1]>>32)};
        #pragma unroll
        for(int j=0;j<4;++j){ const float a0=__uint_as_float(w1[j]<<16)-lam*__uint_as_float(v[j]<<16), a1=__uint_as_float(w1[j]&0xffff0000u)-lam*__uint_as_float(v[j]&0xffff0000u);
          dd[hf][i][2*j]=a0; dd[hf][i][2*j+1]=a1; ssp[i]+=a0*a0+a1*a1; } }
      asm volatile("s_waitcnt lgkmcnt(0)":::"memory"); }
    #pragma unroll
    for(int i=0;i<4;++i){ float ss=ssp[i]; ss+=__shfl_xor(ss,1); ss+=__shfl_xor(ss,2); ss+=__shfl_xor(ss,4);
      const float rn=1.0f/sqrtf(ss*(1.0f/128.0f)+1e-6f)*0.8f;
      const int row=i*8+(lane>>3),ch=lane&7;
      #pragma unroll
      for(int hf=0;hf<2;++hf){ const float*gp=subg+hf*64+ch*8; u32x4 w;
        w[0]=cvtpk_s(dd[hf][i][0]*rn*gp[0],dd[hf][i][1]*rn*gp[1]); w[1]=cvtpk_s(dd[hf][i][2]*rn*gp[2],dd[hf][i][3]*rn*gp[3]);
        w[2]=cvtpk_s(dd[hf][i][4]*rn*gp[4],dd[hf][i][5]*rn*gp[5]); w[3]=cvtpk_s(dd[hf][i][6]*rn*gp[6],dd[hf][i][7]*rn*gp[7]);
        *(u32x4*)(CAo+(long)(q0+wid*QBLK+row)*1024+hf*64+ch*8)=w; } }
  }
  asm volatile("s_waitcnt lgkmcnt(0)\n\ts_barrier":::"memory");
  #undef DMA_K
  #undef DMA_V
  #undef CMASK
  #undef START
  #undef RESC
  #undef ROT
  #undef NXT_
  return snext;
}
constexpr int ATTN_LDS_BYTES=LDS_BYTES;
#undef SBAR
#undef WAIT_BAR
}

constexpr int NWAVES = 8, NTHREADS = NWAVES * 64;
#ifndef MK_PER_PHASE
#define MK_PER_PHASE 0
#endif
#ifndef RUN_PHASES
#define RUN_PHASES 8
#endif
constexpr int N_PHASES = RUN_PHASES;

constexpr size_t MiB = 1u << 20;
constexpr size_t WS_CTL = 0, CTL_ZERO_BYTES = 65536;
constexpr size_t WS_RS = 1 * MiB;
constexpr size_t WS_TINFO = 2 * MiB;
constexpr size_t WS_WR = 3 * MiB;
constexpr size_t WS_LTOK = 4 * MiB, WS_LW = 8 * MiB;
constexpr size_t WS_WIN = 16 * MiB, WS_WCA = 25 * MiB, WS_WOUT = 27 * MiB;
constexpr size_t WS_A = 32 * MiB;
constexpr size_t WS_QB = 112 * MiB, WS_KB = 144 * MiB, WS_VB = 176 * MiB, WS_YG = 208 * MiB;
constexpr size_t WS_MG = 112 * MiB, WS_XM = 176 * MiB;
constexpr size_t WS_GT = 240 * MiB;
constexpr size_t WS_WGU = 240 * MiB, WS_WD = 304 * MiB;
constexpr size_t WS_CA = 368 * MiB;
constexpr size_t WS_YB = 112 * MiB;
constexpr size_t WS_LIST = 432 * MiB;
constexpr size_t WS_CTOK = 448 * MiB;
constexpr size_t WS_END = 464 * MiB;
static_assert(WS_A + (size_t)CROWS * 1024 <= WS_QB && WS_WD + (size_t)NEXP * 1024 * 512 <= WS_CA, "d_ws map");
static_assert(WS_WIN + (size_t)IN_COLS * 1024 * 2 <= WS_WCA, "d_ws map");

constexpr int RING_BYTES = 131072;
constexpr int META_OFF = RING_BYTES;
constexpr int HIST_OFF = RING_BYTES + 1024;
constexpr int BARST_OFF = RING_BYTES + 3072;
constexpr int META2_OFF = RING_BYTES + 4096;
constexpr int LDS_BYTES = 147456;

#define GAS __attribute__((address_space(1)))
#define LAS __attribute__((address_space(3)))
typedef unsigned short bf16;
typedef unsigned v4u __attribute__((ext_vector_type(4)));
typedef unsigned v2u __attribute__((ext_vector_type(2)));
typedef float f32x4 __attribute__((ext_vector_type(4)));
typedef float f32x16 __attribute__((ext_vector_type(16)));
typedef short bf16x8 __attribute__((ext_vector_type(8)));
using pg8::cvt_pk_bf16; using pg8::bf_lo; using pg8::bf_hi; using pg8::sigmoidf_fast; using pg8::pack8; using pg8::unpack8;

__device__ __forceinline__ float wave_sum(float v) {
    v += __int_as_float(__builtin_amdgcn_update_dpp(0, __float_as_int(v), 0xB1, 0xf, 0xf, true));
    v += __int_as_float(__builtin_amdgcn_update_dpp(0, __float_as_int(v), 0x4E, 0xf, 0xf, true));
    v += __int_as_float(__builtin_amdgcn_update_dpp(0, __float_as_int(v), 0x141, 0xf, 0xf, true));
    v += __int_as_float(__builtin_amdgcn_update_dpp(0, __float_as_int(v), 0x140, 0xf, 0xf, true));
    const int iv = __float_as_int(v);
    return (__int_as_float(__builtin_amdgcn_readlane(iv, 0)) + __int_as_float(__builtin_amdgcn_readlane(iv, 16))) + (__int_as_float(__builtin_amdgcn_readlane(iv, 32)) + __int_as_float(__builtin_amdgcn_readlane(iv, 48)));
}
__device__ __forceinline__ float bf16_round(float x) { return bf_lo(cvt_pk_bf16(x, 0.f) & 0xffffu); }

#define XB_TMO      128
#define XB_XCNT(j)  (256  + 64 * (j))
#define XB_XSUB(j)  (1280 + 64 * (j))
#define XB_XGEN(j)  (2304 + 64 * (j))
#define XB_TOP      3328
#define XB_TOPGEN   3392
#define XCD_BAR_WORDS 3456
#define XB_SPIN_CAP (1u << 18)

__device__ __forceinline__ unsigned xb_ld(unsigned* p)              { return __hip_atomic_load(p, __ATOMIC_RELAXED, __HIP_MEMORY_SCOPE_AGENT); }
__device__ __forceinline__ unsigned xb_add(unsigned* p, unsigned v) { return __hip_atomic_fetch_add(p, v, __ATOMIC_RELAXED, __HIP_MEMORY_SCOPE_AGENT); }
__device__ __forceinline__ unsigned xb_xcc_id() { return (unsigned)__builtin_amdgcn_s_getreg((3 << 11) | 20) & 0xFu; }
#define XB_SPIN(cond, bar) do { unsigned _sp = 0; while (cond) { __builtin_amdgcn_s_sleep(1); \
    if ((++_sp & 255u) == 0u) { if (xb_ld(&(bar)[XB_TMO])) break; if (_sp > XB_SPIN_CAP) { atomicAdd(&(bar)[XB_TMO], 1u); break; } } } } while (0)

struct XcdBarrier {
    unsigned* bar; unsigned x;
    volatile LAS unsigned* st;
};

__device__ __forceinline__ XcdBarrier xcd_barrier_post(unsigned* bar, volatile LAS unsigned* st) {
    XcdBarrier b; b.bar = bar; b.x = xb_xcc_id(); b.st = st;
    if (threadIdx.x == 0) (void)xb_add(&bar[XB_XCNT(b.x)], 1u);
    return b;
}
__device__ __forceinline__ void xcd_barrier_complete(unsigned* bar, unsigned x, unsigned& nloc, unsigned& nx) {
    const unsigned G = gridDim.x * gridDim.y * gridDim.z;
    unsigned sum, cnt, mine, sp = 0u;
    for (;;) {
        sum = 0u; cnt = 0u; mine = 0u;
#pragma unroll
        for (unsigned j = 0; j < 16; ++j) { const unsigned c = xb_ld(&bar[XB_XCNT(j)]); sum += c; cnt += (c > 0u) ? 1u : 0u; mine = (j == x) ? c : mine; }
        if (sum == G) break;
        __builtin_amdgcn_s_sleep(1);
        if ((++sp & 255u) == 0u) { if (xb_ld(&bar[XB_TMO])) break; if (sp > XB_SPIN_CAP) { atomicAdd(&bar[XB_TMO], 1u); break; } }
    }
    nloc = mine > 0u ? mine : 1u; nx = cnt > 0u ? cnt : 1u;
}

__device__ __forceinline__ void xcd_barrier(const XcdBarrier& b) {
    asm volatile("s_waitcnt vmcnt(0)" ::: "memory");
    __syncthreads();
    if (threadIdx.x == 0) {
        unsigned* bar = b.bar;
        __builtin_amdgcn_s_waitcnt(0);
        unsigned nloc = b.st[0], nx = b.st[1];
        if (nloc == 0u) { xcd_barrier_complete(bar, b.x, nloc, nx); b.st[0] = nloc; b.st[1] = nx; }
        const unsigned old = xb_add(&bar[XB_XSUB(b.x)], 1u);
        const unsigned gen = old / nloc;
        if (old + 1u == (gen + 1u) * nloc) {
            __builtin_amdgcn_fence(__ATOMIC_RELEASE, "agent");
            asm volatile("s_waitcnt vmcnt(0)" ::: "memory");
            const unsigned og = xb_add(&bar[XB_TOP], 1u);
            const unsigned tg = og / nx;
            if (og + 1u == (tg + 1u) * nx) xb_add(&bar[XB_TOPGEN], 1u);
            else XB_SPIN(xb_ld(&bar[XB_TOPGEN]) == tg, bar);
            __builtin_amdgcn_fence(__ATOMIC_ACQUIRE, "agent");
            xb_add(&bar[XB_XGEN(b.x)], 1u);
            asm volatile("s_waitcnt vmcnt(0)" ::: "memory");
        } else {
            XB_SPIN(xb_ld(&bar[XB_XGEN(b.x)]) == gen, bar);
            __builtin_amdgcn_fence(__ATOMIC_ACQUIRE, "agent");
            asm volatile("s_waitcnt vmcnt(0)" ::: "memory");
        }
    }
    __syncthreads();
}


typedef f32x4 AccT[2][2][4][2];
struct EpiInProj {
    static constexpr bool MID = false;
    bf16 *YG, *QB, *KB, *VB, *GT; const LAS float* gl;
    __device__ __forceinline__ void mid(AccT&, const pg8::Unit&, int, int, int, int) const {}
    __device__ __forceinline__ void operator()(AccT& acc, const pg8::Unit& u, int wr, int wc, int fr, int fq) const {
        asm volatile("" : "+v"(fr), "+v"(fq));
        const int pn = u.pn; const size_t row0 = (size_t)u.orow + wr * 64 + fr;
        if (pn < 4) {
#pragma unroll
            for (int ai = 0; ai < 2; ++ai)
#pragma unroll
                for (int m = 0; m < 4; ++m) { const size_t row = row0 + ai * 128 + m * 16; f32x4 y[2];
#pragma unroll
                    for (int n = 0; n < 2; ++n) { const f32x4 a = acc[ai][0][m][n], g = acc[ai][1][m][n];
                        y[n] = (f32x4){a[0] * sigmoidf_fast(g[0]), a[1] * sigmoidf_fast(g[1]), a[2] * sigmoidf_fast(g[2]), a[3] * sigmoidf_fast(g[3])}; }
                    __builtin_nontemporal_store(pack8(y[0], y[1]), (v4u*)(YG + row * 512 + pn * 128 + wc * 32 + 8 * fq)); }
        } else if (pn < 8) {
            const bool isq = pn < 6; bf16* base = isq ? QB : KB; const LAS float* gp = gl + (isq ? 0 : 64); const float sc = isq ? 0.125f * 1.4426950408889634f : 1.0f;
            f32x4 gv[2][2];
#pragma unroll
            for (int bj = 0; bj < 2; ++bj)
#pragma unroll
                for (int n = 0; n < 2; ++n) gv[bj][n] = *(const LAS f32x4*)(gp + 32 * bj + 8 * fq + 4 * n) * sc;
#pragma unroll
            for (int ai = 0; ai < 2; ++ai)
#pragma unroll
                for (int m = 0; m < 4; ++m) { const size_t row = row0 + ai * 128 + m * 16; float ss = 0.f;
#pragma unroll
                    for (int bj = 0; bj < 2; ++bj)
#pragma unroll
                        for (int n = 0; n < 2; ++n) { const f32x4 a = acc[ai][bj][m][n]; ss += (a[0] * a[0] + a[1] * a[1]) + (a[2] * a[2] + a[3] * a[3]); }
                    ss += __shfl_xor(ss, 16); ss += __shfl_xor(ss, 32);
                    const float rinv = 1.0f / sqrtf(ss * (1.0f / 64.0f) + EPS);
#pragma unroll
                    for (int bj = 0; bj < 2; ++bj)
                        __builtin_nontemporal_store(pack8(acc[ai][bj][m][0] * rinv * gv[bj][0], acc[ai][bj][m][1] * rinv * gv[bj][1]), (v4u*)(base + row * 512 + (pn & 1) * 256 + wc * 64 + bj * 32 + 8 * fq)); }
        } else if (pn < 10) {
#pragma unroll
            for (int ai = 0; ai < 2; ++ai)
#pragma unroll
                for (int m = 0; m < 4; ++m) { const size_t row = row0 + ai * 128 + m * 16;
#pragma unroll
                    for (int bj = 0; bj < 2; ++bj) __builtin_nontemporal_store(pack8(acc[ai][bj][m][0], acc[ai][bj][m][1]), (v4u*)(VB + row * 512 + (pn - 8) * 256 + bj * 128 + wc * 32 + 8 * fq)); }
        } else {
#pragma unroll
            for (int ai = 0; ai < 2; ++ai)
#pragma unroll
                for (int m = 0; m < 4; ++m) { const size_t row = row0 + ai * 128 + m * 16; f32x4 rr[2], gg[2];
#pragma unroll
                    for (int n = 0; n < 2; ++n)
#pragma unroll
                        for (int j = 0; j < 4; ++j) { const float e0 = __builtin_amdgcn_exp2f(-1.4426950408889634f * acc[ai][0][m][n][j]), e1 = fminf(__builtin_amdgcn_exp2f(-1.4426950408889634f * acc[ai][1][m][n][j]), 1e30f);
                            gg[n][j] = __builtin_amdgcn_rcpf(1.0f + e1); rr[n][j] = (1.0f + e1) * __builtin_amdgcn_rcpf(1.0f + e0); }
                    const size_t o = row * 1024 + (pn - 10) * 128 + wc * 32 + 8 * fq;
                    __builtin_nontemporal_store(pack8(rr[0], rr[1]), (v4u*)(GT + o)); __builtin_nontemporal_store(pack8(gg[0], gg[1]), (v4u*)(GT + (size_t)NTOK * 1024 + o)); }
        }
    }
};
struct EpiMerged {
    static constexpr bool MID = true;
    const bf16* GR; const bf16* G1; bf16* MG;
    __device__ __forceinline__ void mid(AccT& acc, const pg8::Unit& u, int wr, int wc, int fr, int fq) const {
        asm volatile("" : "+v"(fr), "+v"(fq));
        const size_t row0 = (size_t)u.orow + wr * 64 + fr; const int col0 = u.pn * 256 + wc * 32 + 8 * fq;
        v4u w0[2][4][2];
#pragma unroll
        for (int ai = 0; ai < 2; ++ai)
#pragma unroll
            for (int m = 0; m < 4; ++m)
#pragma unroll
                for (int bj = 0; bj < 2; ++bj) w0[ai][m][bj] = *(const v4u*)(GR + (row0 + ai * 128 + m * 16) * 1024 + col0 + bj * 128);
        __builtin_amdgcn_sched_barrier(0);
#pragma unroll
        for (int ai = 0; ai < 2; ++ai)
#pragma unroll
            for (int m = 0; m < 4; ++m)
#pragma unroll
                for (int bj = 0; bj < 2; ++bj) { f32x4 a0, a1; unpack8(w0[ai][m][bj], a0, a1); acc[ai][bj][m][0] = acc[ai][bj][m][0] * a0; acc[ai][bj][m][1] = acc[ai][bj][m][1] * a1; }
        __builtin_amdgcn_sched_barrier(0);
    }
    __device__ __forceinline__ void operator()(AccT& acc, const pg8::Unit& u, int wr, int wc, int fr, int fq) const {
        asm volatile("" : "+v"(fr), "+v"(fq));
        const size_t row0 = (size_t)u.orow + wr * 64 + fr; const int col0 = u.pn * 256 + wc * 32 + 8 * fq;
        v4u w1[2][4][2];
#pragma unroll
        for (int ai = 0; ai < 2; ++ai)
#pragma unroll
            for (int m = 0; m < 4; ++m)
#pragma unroll
                for (int bj = 0; bj < 2; ++bj) w1[ai][m][bj] = *(const v4u*)(G1 + (row0 + ai * 128 + m * 16) * 1024 + col0 + bj * 128);
        __builtin_amdgcn_sched_barrier(0);
#pragma unroll
        for (int ai = 0; ai < 2; ++ai)
#pragma unroll
            for (int m = 0; m < 4; ++m) { const size_t row = row0 + ai * 128 + m * 16;
#pragma unroll
                for (int bj = 0; bj < 2; ++bj) { f32x4 b0, b1; unpack8(w1[ai][m][bj], b0, b1);
                    *(v4u*)(MG + row * 1024 + col0 + bj * 128) = pack8(acc[ai][bj][m][0] * b0, acc[ai][bj][m][1] * b1); } }
    }
};
struct EpiOut {
    static constexpr bool MID = false;
    const float* x; bf16* XMB; unsigned char* XM8;
    __device__ __forceinline__ void mid(AccT&, const pg8::Unit&, int, int, int, int) const {}
    __device__ __forceinline__ void operator()(AccT& acc, const pg8::Unit& u, int wr, int wc, int fr, int fq) const {
        asm volatile("" : "+v"(fr), "+v"(fq));
        const size_t row0 = (size_t)u.orow + wr * 64 + fr; const int col0 = u.pn * 256 + wc * 32 + 8 * fq;
#pragma unroll
        for (int ai = 0; ai < 2; ++ai) {
            f32x4 xv[4][2][2];
#pragma unroll
            for (int m = 0; m < 4; ++m) { const size_t off = (row0 + ai * 128 + m * 16) * 1024 + col0;
#pragma unroll
                for (int bj = 0; bj < 2; ++bj) { xv[m][bj][0] = __builtin_nontemporal_load((const f32x4*)(x + off + bj * 128)); xv[m][bj][1] = __builtin_nontemporal_load((const f32x4*)(x + off + bj * 128 + 4)); } }
            __builtin_amdgcn_sched_barrier(0);
#pragma unroll
            for (int m = 0; m < 4; ++m) { const size_t off = (row0 + ai * 128 + m * 16) * 1024 + col0;
#pragma unroll
                for (int bj = 0; bj < 2; ++bj) { const f32x4 o0 = xv[m][bj][0] + acc[ai][bj][m][0], o1 = xv[m][bj][1] + acc[ai][bj][m][1];
                    *(v4u*)(XMB + off + bj * 128) = pack8(o0, o1);
                    v2u w8; w8.x = pg8::pack4_fp8(o0[0], o0[1], o0[2], o0[3]); w8.y = pg8::pack4_fp8(o1[0], o1[1], o1[2], o1[3]); *(v2u*)(XM8 + off + bj * 128) = w8; } }
            __builtin_amdgcn_sched_barrier(0);
        }
    }
};
struct EpiGateUp {
    static constexpr bool MID = false;
    const int* LIST; unsigned char* HP8; const LAS int* m2;
    __device__ __forceinline__ void mid(AccT&, const pg8::Unit&, int, int, int, int) const {}
    __device__ __forceinline__ void operator()(AccT& acc, const pg8::Unit& u, int wr, int wc, int fr, int fq) const {
        asm volatile("" : "+v"(fr), "+v"(fq));
        typedef int i32x4 __attribute__((ext_vector_type(4)));
        i32x4 ent[2][4];
#pragma unroll
        for (int ai = 0; ai < 2; ++ai)
#pragma unroll
            for (int m = 0; m < 4; ++m) { const int r = ai * 128 + wr * 64 + m * 16 + fr; ent[ai][m] = (r < u.nvalid) ? *(const i32x4*)(LIST + (size_t)(u.lrow + r) * 4) : (i32x4){-1, 0, 0, 0}; }
#pragma unroll
        for (int ai = 0; ai < 2; ++ai)
#pragma unroll
            for (int m = 0; m < 4; ++m) { const i32x4 en = ent[ai][m]; if (en[0] < 0) continue;
                const float rs = __int_as_float(en[3]) * (1.0f / 64.0f), w8 = __int_as_float(en[2]) * 8.0f;
                const int dst = en[1]; const size_t drow = (size_t)m2[dst >> 17] * 256 + ((dst >> 1) & 0xffff);
                float h[8];
#pragma unroll
                for (int n = 0; n < 2; ++n)
#pragma unroll
                    for (int j = 0; j < 4; ++j) { const float g = acc[ai][0][m][n][j] * rs, up = acc[ai][1][m][n][j] * rs; h[4 * n + j] = __builtin_amdgcn_fmed3f(g * sigmoidf_fast(g) * up * w8, -448.f, 448.f); }
                v2u o8; o8.x = pg8::pack4_fp8(h[0], h[1], h[2], h[3]); o8.y = pg8::pack4_fp8(h[4], h[5], h[6], h[7]);
                *(v2u*)(HP8 + drow * 1024 + (dst & 1) * 512 + u.pn * 128 + wc * 32 + 8 * fq) = o8; }
    }
};
struct EpiDownAdd {
    static constexpr bool MID = false;
    const int* CTOK; const bf16* XMB; float* out;
    __device__ __forceinline__ void mid(AccT&, const pg8::Unit&, int, int, int, int) const {}
    __device__ __forceinline__ void operator()(AccT& acc, const pg8::Unit& u, int wr, int wc, int fr, int fq) const {
        asm volatile("" : "+v"(fr), "+v"(fq));
        const int col0 = u.pn * 256 + wc * 32 + 8 * fq;
        int tokall[2][4];
#pragma unroll
        for (int ai = 0; ai < 2; ++ai)
#pragma unroll
            for (int m = 0; m < 4; ++m) { const int r = ai * 128 + wr * 64 + m * 16 + fr; tokall[ai][m] = (r < u.nvalid) ? CTOK[u.lrow + r] : -1; }
        v4u xw[2][4][2];
#pragma unroll
        for (int ai = 0; ai < 2; ++ai)
#pragma unroll
            for (int m = 0; m < 4; ++m) { const int tk = tokall[ai][m]; const size_t off = (size_t)(tk < 0 ? 0 : tk) * 1024 + col0;
#pragma unroll
                for (int bj = 0; bj < 2; ++bj) xw[ai][m][bj] = *(const v4u*)(XMB + off + bj * 128); }
        __builtin_amdgcn_sched_barrier(0);
#pragma unroll
        for (int ai = 0; ai < 2; ++ai)
#pragma unroll
            for (int m = 0; m < 4; ++m) { const int tk = tokall[ai][m]; if (tk < 0) continue; const size_t off = (size_t)tk * 1024 + col0;
#pragma unroll
                for (int bj = 0; bj < 2; ++bj) { f32x4 x0, x1; unpack8(xw[ai][m][bj], x0, x1);
                    __builtin_nontemporal_store(x0 + acc[ai][bj][m][0] * (1.0f / 256.0f), (f32x4*)(out + off + bj * 128)); __builtin_nontemporal_store(x1 + acc[ai][bj][m][1] * (1.0f / 256.0f), (f32x4*)(out + off + bj * 128 + 4)); } }
    }
};
struct MoeOrder {
    int G, c, total; const LAS int* meta;
    __device__ __forceinline__ bool next(int i, pg8::Unit& u) const {
        const int L = i * G + c; if (L >= total * 4) return false;
        const int blk = L >> 2, lane = threadIdx.x & 63;
        const int e = __builtin_amdgcn_readfirstlane(__builtin_popcountll(__ballot(lane < NEXP - 1 && meta[1 + lane] <= blk)));
        const int pre = __builtin_amdgcn_readfirstlane(meta[e]), cnt = __builtin_amdgcn_readfirstlane(meta[64 + e]); const int rb = blk - pre;
        u.pn = L & 3; u.pm = rb; u.e = e; u.e2 = e; u.lrow = e * LCAP + rb * 256; u.nvalid = min(256, cnt - rb * 256); u.orow = blk * 256; u.arow = 0; return true;
    }
};
struct ClassOrder {
    int G, c, total; const LAS int* m2;
    __device__ __forceinline__ bool next(int i, pg8::Unit& u) const {
        const int L = i * G + c; if (L >= total * 4) return false;
        const int blk = L >> 2, lane = threadIdx.x & 63;
        const int n0 = __builtin_popcountll(__ballot(m2[1 + lane] <= blk)), n1 = __builtin_popcountll(__ballot(lane + 65 <= NCLS - 1 && m2[65 + lane] <= blk));
        const int cls = __builtin_amdgcn_readfirstlane(n0 + n1);
        const int pre = __builtin_amdgcn_readfirstlane(m2[cls]), cnt = __builtin_amdgcn_readfirstlane(m2[128 + cls]); const int rb = blk - pre;
        const int g = cls / 28; int p = cls % 28, a = 0;
        while (p >= 7 - a) { p -= 7 - a; ++a; }
        u.e = g * 8 + a; u.e2 = g * 8 + a + 1 + p; u.pn = L & 3; u.pm = rb; u.lrow = cls * NTOK + rb * 256; u.nvalid = min(256, cnt - rb * 256); u.orow = blk * 256; u.arow = u.orow; return true;
    }
};
__device__ __forceinline__ void moe_meta(LAS int* meta, LAS int* m2, const unsigned* ctl) {
    const int tid = threadIdx.x;
    if (tid < NEXP) meta[64 + tid] = (int)__hip_atomic_load(ctl + tid, __ATOMIC_RELAXED, __HIP_MEMORY_SCOPE_AGENT);
    if (tid >= 64 && tid < 64 + NCLS) m2[128 + tid - 64] = (int)__hip_atomic_load(ctl + tid, __ATOMIC_RELAXED, __HIP_MEMORY_SCOPE_AGENT);
    __syncthreads();
    if (tid == 0) { int p = 0;
        for (int e = 0; e < NEXP; ++e) { meta[e] = p; p += (meta[64 + e] + 255) >> 8; }
        meta[NEXP] = p; }
    if (tid == 64) { int p = 0;
        for (int c = 0; c < NCLS; ++c) { m2[c] = p; p += (m2[128 + c] + 255) >> 8; }
        m2[NCLS] = p; }
    __syncthreads();
}

__device__ __forceinline__ void transpose_item(const float* W, int N, int k0, int n0, bf16* WT, int dpitch, int drow0, int dcol0, const float* kscale, LAS float* scr, int lane) {
    const int kr = lane >> 3, nc = (lane & 7) * 4;
    f32x4 v[8];
#pragma unroll
    for (int i = 0; i < 8; ++i) v[i] = *(const f32x4*)(W + (size_t)(k0 + i * 8 + kr) * N + n0 + nc);
    if (kscale) {
#pragma unroll
        for (int i = 0; i < 8; ++i) v[i] = v[i] * kscale[k0 + i * 8 + kr]; }
#pragma unroll
    for (int i = 0; i < 8; ++i) { LAS float* d = scr + (i * 8 + kr) * 33 + nc; d[0] = v[i][0]; d[1] = v[i][1]; d[2] = v[i][2]; d[3] = v[i][3]; }
    asm volatile("s_waitcnt lgkmcnt(0)" ::: "memory");
    const int c = lane & 7;
#pragma unroll
    for (int j = 0; j < 4; ++j) { const int n = (lane >> 3) + 8 * j; const LAS float* s = scr + (8 * c) * 33 + n;
        v4u o; o.x = cvt_pk_bf16(s[0 * 33], s[1 * 33]); o.y = cvt_pk_bf16(s[2 * 33], s[3 * 33]); o.z = cvt_pk_bf16(s[4 * 33], s[5 * 33]); o.w = cvt_pk_bf16(s[6 * 33], s[7 * 33]);
        *(v4u*)(WT + (size_t)(drow0 + n) * dpitch + dcol0 + k0 + 8 * c) = o; }
    asm volatile("s_waitcnt lgkmcnt(0)" ::: "memory");
}
__device__ __forceinline__ void transpose_item_fp8(const float* W, int N, int k0, int n0, unsigned char* WT, int dpitch, int drow0, const float* kscale, float mul, LAS float* scr, int lane) {
    const int kr = lane >> 3, nc = (lane & 7) * 4;
    f32x4 v[8];
#pragma unroll
    for (int i = 0; i < 8; ++i) v[i] = *(const f32x4*)(W + (size_t)(k0 + i * 8 + kr) * N + n0 + nc);
#pragma unroll
    for (int i = 0; i < 8; ++i) v[i] = v[i] * (kscale ? kscale[k0 + i * 8 + kr] * mul : mul);
#pragma unroll
    for (int i = 0; i < 8; ++i) { LAS float* d = scr + (i * 8 + kr) * 33 + nc; d[0] = v[i][0]; d[1] = v[i][1]; d[2] = v[i][2]; d[3] = v[i][3]; }
    asm volatile("s_waitcnt lgkmcnt(0)" ::: "memory");
    const int c = lane & 7;
#pragma unroll
    for (int j = 0; j < 4; ++j) { const int n = (lane >> 3) + 8 * j; const LAS float* s = scr + (8 * c) * 33 + n;
        v2u o; o.x = pg8::pack4_fp8(s[0 * 33], s[1 * 33], s[2 * 33], s[3 * 33]); o.y = pg8::pack4_fp8(s[4 * 33], s[5 * 33], s[6 * 33], s[7 * 33]);
        *(v2u*)(WT + (size_t)(drow0 + n) * dpitch + k0 + 8 * c) = o; }
    asm volatile("s_waitcnt lgkmcnt(0)" ::: "memory");
}
__device__ __forceinline__ int inproj_phys(int c) {
    if (c < 512) return (c >> 7) * 256 + (c & 127);
    if (c < 1024) { c -= 512; return (c >> 7) * 256 + 128 + (c & 127); }
    if (c < 2048) { const int sec = (c - 1024) >> 8, cl = (c - 1024) & 255, s = cl >> 6, d = cl & 63; return 1024 + sec * 256 + ((d >> 5) << 7) + (s << 5) + (d & 31); }
    if (c < 2560) return c;
    { int j = c - 2560; const int hi = j >= 1024; j &= 1023; return 2560 + (j >> 7) * 256 + hi * 128 + (j & 127); }
}
struct Ptrs {
    const float *x, *attn_norm_g, *w_in, *conv_dw_w, *conv_dw_b, *conv_ln_g, *conv_ln_b, *w_conv_out, *q_norm_g, *k_norm_g, *lq1, *lk1, *lq2, *lk2, *subln_g,
        *w_attn_out, *w_out, *ffn_norm_g, *w_rg, *b_rg, *w_re, *b_re, *w_gate, *w_up, *w_down;
    float* out; unsigned char* ws;
};

__device__ __forceinline__ void p0_prologue(const Ptrs& P, LAS unsigned char* lds, int vcu, int G) {
    const int tid = threadIdx.x, lane = tid & 63, wave = __builtin_amdgcn_readfirstlane(tid >> 6);
    LAS float* scr = (LAS float*)(lds + wave * 16384);
    const int gw = vcu * NWAVES + wave, NGW = G * NWAVES;
    bf16* WIN = (bf16*)(P.ws + WS_WIN); bf16* WCA = (bf16*)(P.ws + WS_WCA); bf16* WOUT = (bf16*)(P.ws + WS_WOUT);
    constexpr int I_IN = (DMODEL / 64) * (IN_COLS / 32), I_C = (CONV_CH / 64) * (DMODEL / 32), I_O = (DMODEL / 64) * (DMODEL / 32);
    for (int it = gw; it < I_IN + 2 * I_C + I_O; it += NGW) {
        int r = it;
        if (r < I_IN) { const int kb = r / (IN_COLS / 32), nb = r % (IN_COLS / 32); transpose_item(P.w_in, IN_COLS, kb * 64, nb * 32, WIN, 1024, inproj_phys(nb * 32), 0, nullptr, scr, lane); continue; } r -= I_IN;
        if (r < I_C) { const int kb = r / 32, nb = r % 32; transpose_item(P.w_conv_out, DMODEL, kb * 64, nb * 32, WCA, 1024, nb * 32, 0, nullptr, scr, lane); continue; } r -= I_C;
        if (r < I_C) { const int kb = r / 32, nb = r % 32; transpose_item(P.w_attn_out, DMODEL, kb * 64, nb * 32, WCA, 1024, nb * 32, 512, nullptr, scr, lane); continue; } r -= I_C;
        { const int kb = r / 32, nb = r % 32; transpose_item(P.w_out, DMODEL, kb * 64, nb * 32, WOUT, 1024, nb * 32, 0, nullptr, scr, lane); }
    }
    bf16* WRhi = (bf16*)(P.ws + WS_WR); bf16* WRlo = WRhi + 64 * 1024;
    for (int idx = vcu * NTHREADS + tid; idx < 64 * 1024; idx += G * NTHREADS) {
        const int n = idx >> 10, k = idx & 1023; float v = 0.f;
        if (n < 4) v = P.w_rg[k * 4 + n]; else if (n < 36) v = P.w_re[k * 32 + (n - 4)];
        v *= P.ffn_norm_g[k];
        const unsigned hb = cvt_pk_bf16(v, 0.f) & 0xffffu; const float hf = __uint_as_float(hb << 16);
        WRhi[idx] = (bf16)hb; WRlo[idx] = (bf16)(cvt_pk_bf16(v - hf, 0.f) & 0xffffu);
    }
    bf16* HB = (bf16*)(P.ws + WS_A);
    f32x4 gq[4];
#pragma unroll
    for (int j = 0; j < 4; ++j) gq[j] = ((const f32x4*)P.attn_norm_g)[64 * j + lane];
    for (int m = gw; m < NTOK; m += NGW) {
        const f32x4* xr = (const f32x4*)(P.x + (size_t)m * DMODEL) + lane; f32x4 v[4]; float s = 0.f;
#pragma unroll
        for (int j = 0; j < 4; ++j) { v[j] = xr[64 * j]; s += (v[j][0] * v[j][0] + v[j][1] * v[j][1]) + (v[j][2] * v[j][2] + v[j][3] * v[j][3]); }
        const float r = 1.0f / sqrtf(wave_sum(s) * (1.0f / DMODEL) + EPS);
        v2u* o8 = (v2u*)(HB + (size_t)m * DMODEL) + lane;
#pragma unroll
        for (int j = 0; j < 4; ++j) { const f32x4 y = v[j] * r * gq[j]; v2u w; w.x = cvt_pk_bf16(y[0], y[1]); w.y = cvt_pk_bf16(y[2], y[3]); o8[64 * j] = w; }
    }
}

__device__ __forceinline__ void conv_phase(const Ptrs& P, LAS unsigned char* lds, int first, int stride) {
    const int tid = threadIdx.x, lane = tid & 63, wave = __builtin_amdgcn_readfirstlane(tid >> 6);
    const bf16* YG = (const bf16*)(P.ws + WS_YG); bf16* CA = (bf16*)(P.ws + WS_CA);
    LAS bf16* yt = (LAS bf16*)lds; LAS float* co = (LAS float*)(lds + 62 * 1024);
    constexpr int NT = NTOK / 32;
    if (first >= NT) return;
    float w[CONV_W];
#pragma unroll
    for (int j = 0; j < CONV_W; ++j) w[j] = P.conv_dw_w[j * CONV_CH + tid];
    const float bias = P.conv_dw_b[tid];
    const f32x4 g0 = ((const f32x4*)P.conv_ln_g)[lane], g1 = ((const f32x4*)P.conv_ln_g)[64 + lane], b0 = ((const f32x4*)P.conv_ln_b)[lane], b1 = ((const f32x4*)P.conv_ln_b)[64 + lane];
    v4u pre[8];
#define CONV_FETCH(tile) do { const int b_ = (tile) / (SEQ / 32), t0_ = ((tile) % (SEQ / 32)) * 32; _Pragma("unroll") for (int p = 0; p < 8; ++p) { const int q = tid + NTHREADS * p; const int row = q >> 6, ch = q & 63, t = t0_ - 30 + row; \
        pre[p] = (v4u){0u, 0u, 0u, 0u}; if (q < 62 * 64 && t >= 0) pre[p] = *(const v4u*)(YG + ((size_t)(b_ * SEQ + t)) * 512 + ch * 8); } } while (0)
    CONV_FETCH(first);
    for (int tile = first; tile < NT; tile += stride) {
        const int b = tile / (SEQ / 32), t0 = (tile % (SEQ / 32)) * 32;
#pragma unroll
        for (int p = 0; p < 8; ++p) { const int q = tid + NTHREADS * p; if (q < 62 * 64) *(LAS v4u*)(yt + (q >> 6) * 512 + (q & 63) * 8) = pre[p]; }
        __syncthreads();
        if (tile + stride < NT) CONV_FETCH(tile + stride);
        float yv[62];
#pragma unroll
        for (int i = 0; i < 62; ++i) yv[i] = __uint_as_float((unsigned)yt[i * 512 + tid] << 16);
#pragma unroll
        for (int t = 0; t < 32; ++t) { float a = bias;
#pragma unroll
            for (int j = 0; j < CONV_W; ++j) a += w[j] * yv[t + j];
            co[t * 512 + tid] = a; }
        __syncthreads();
#pragma unroll
        for (int rr = 0; rr < 4; ++rr) { const int row = wave * 4 + rr;
            const f32x4 v0 = *(const LAS f32x4*)(co + row * 512 + lane * 4), v1 = *(const LAS f32x4*)(co + row * 512 + 256 + lane * 4);
            const float mean = wave_sum((v0[0] + v0[1]) + (v0[2] + v0[3]) + (v1[0] + v1[1]) + (v1[2] + v1[3])) * (1.0f / CONV_CH);
            const f32x4 d0 = v0 - mean, d1 = v1 - mean;
            const float var = wave_sum((d0[0] * d0[0] + d0[1] * d0[1]) + (d0[2] * d0[2] + d0[3] * d0[3]) + (d1[0] * d1[0] + d1[1] * d1[1]) + (d1[2] * d1[2] + d1[3] * d1[3])) * (1.0f / CONV_CH);
            const float rstd = 1.0f / sqrtf(var + EPS);
            f32x4 y0 = d0 * rstd * g0 + b0, y1 = d1 * rstd * g1 + b1;
#pragma unroll
            for (int j = 0; j < 4; ++j) { y0[j] = y0[j] * sigmoidf_fast(y0[j]); y1[j] = y1[j] * sigmoidf_fast(y1[j]); }
            bf16* orow = CA + ((size_t)(b * SEQ + t0 + row)) * 1024;
            v2u o0, o1; o0.x = cvt_pk_bf16(y0[0], y0[1]); o0.y = cvt_pk_bf16(y0[2], y0[3]); o1.x = cvt_pk_bf16(y1[0], y1[1]); o1.y = cvt_pk_bf16(y1[2], y1[3]);
            *(v2u*)(orow + lane * 4) = o0; *(v2u*)(orow + 256 + lane * 4) = o1; }
        __syncthreads();
    }
#undef CONV_FETCH
}

__device__ __forceinline__ void attn_pair(const Ptrs& P, LAS unsigned char* lds, char* lds_generic, int p) {
    const int tid = threadIdx.x, lane = tid & 63, wave = __builtin_amdgcn_readfirstlane(tid >> 6);
    const int bh = p >> 3, s = p & 7, b = bh >> 2, h = bh & 3;
    const __hip_bfloat16* QB = (const __hip_bfloat16*)(P.ws + WS_QB); const __hip_bfloat16* KB = (const __hip_bfloat16*)(P.ws + WS_KB); const __hip_bfloat16* VB = (const __hip_bfloat16*)(P.ws + WS_VB);
    __hip_bfloat16* OT = (__hip_bfloat16*)(P.ws + WS_A); bf16* CA = (bf16*)(P.ws + WS_CA);
    float mstat;
    { int l0 = lane; asm volatile("" : "+v"(l0));
      float a = fabsf(P.q_norm_g[l0]), b = fabsf(P.k_norm_g[l0]);
#pragma unroll
      for (int o = 1; o < 64; o <<= 1) { a = fmaxf(a, __shfl_xor(a, o)); b = fmaxf(b, __shfl_xor(b, o)); }
      mstat = __int_as_float(__builtin_amdgcn_readfirstlane(__float_as_int(0.125f * 1.4426950408889634f * 64.0f * 1.02f * a * b))); }
    float lam;
    { int l1 = lane; asm volatile("" : "+v"(l1));
      lam = __int_as_float(__builtin_amdgcn_readfirstlane(__float_as_int(__expf(wave_sum(P.lq1[l1] * P.lk1[l1])) - __expf(wave_sum(P.lq2[l1] * P.lk2[l1])) + 0.2f))); }
    int s0 = 0; bool pre = false;
#pragma unroll 1
    for (int u4 = 0; u4 < 4; ++u4) { const int i = u4 >> 1, c = u4 & 1;
        const int qb = (i == 0) ? s : 15 - s;
        const __hip_bfloat16* q_ = QB + (size_t)b * SEQ * 512 + (h * 2 + c) * 64; const __hip_bfloat16* k_ = KB + (size_t)b * SEQ * 512 + (h * 2 + c) * 64; const __hip_bfloat16* v_ = VB + (size_t)b * SEQ * 512 + h * 128;
        const __hip_bfloat16* kn_ = (u4 < 3) ? KB + (size_t)b * SEQ * 512 + (h * 2 + (c ^ 1)) * 64 : nullptr;
        __hip_bfloat16* o_ = OT + (size_t)b * SEQ * 1024 + (h * 2) * 128;
        const __hip_bfloat16* o1_ = c ? o_ : nullptr; unsigned short* ca_ = CA + (size_t)b * SEQ * 1024 + 512 + h * 128;
        int sn;
        if (mstat <= 40.0f) sn = attn_body::attn_unit<8, true>(mstat, qb * 256, q_, k_, v_, o_, lds_generic, o1_, lam, P.subln_g, ca_, kn_, v_, s0, pre);
        else sn = attn_body::attn_unit<8, false>(0.f, qb * 256, q_, k_, v_, o_, lds_generic, o1_, lam, P.subln_g, ca_, kn_, v_, s0, pre);
        s0 = sn; pre = (kn_ != nullptr); }
}

__device__ __forceinline__ void router_tile(const Ptrs& P, LAS unsigned char* lds, int tile) {
    const int tid = threadIdx.x, lane = tid & 63, wave = __builtin_amdgcn_readfirstlane(tid >> 6), r32 = lane & 31, hi = lane >> 5;
    const bf16* WRhi = (const bf16*)(P.ws + WS_WR); const bf16* WRlo = WRhi + 64 * 1024;
    int* LIST = (int*)(P.ws + WS_LIST); int* CTOK = (int*)(P.ws + WS_CTOK); unsigned* cnt = (unsigned*)(P.ws + WS_CTL); unsigned* ccnt = cnt + 64;
    LAS float* lg = (LAS float*)(lds + wave * 8448);
    LAS int* hist = (LAS int*)(lds + HIST_OFF); LAS int* hbase = hist + 32; LAS int* hist2 = hist + 64; LAS int* hbase2 = hist2 + NCLS;
    if (tid < 32) hist[tid] = 0;
    if (tid >= 64 && tid < 64 + NCLS) hist2[tid - 64] = 0;
    __syncthreads();
    const int tbase = tile * 256 + wave * 32;
    const bf16* xr = (const bf16*)(P.ws + WS_CA) + (size_t)(tbase + r32) * DMODEL + 8 * hi;
    const bf16* bh0 = WRhi + (size_t)r32 * 1024 + 8 * hi; const bf16* bl0 = WRlo + (size_t)r32 * 1024 + 8 * hi;
    f32x16 acc0 = {}, acc1 = {}; float ssq = 0.f;
#pragma unroll 4
    for (int ks = 0; ks < 64; ++ks) {
        const v4u xa = *(const v4u*)(xr + ks * 16);
        f32x4 x0, x1; unpack8(xa, x0, x1);
        ssq += (x0[0] * x0[0] + x0[1] * x0[1]) + (x0[2] * x0[2] + x0[3] * x0[3]) + (x1[0] * x1[0] + x1[1] * x1[1]) + (x1[2] * x1[2] + x1[3] * x1[3]);
        const bf16x8 a_hi = __builtin_bit_cast(bf16x8, xa);
        const bf16x8 bh_0 = *(const bf16x8*)(bh0 + ks * 16), bh_1 = *(const bf16x8*)(bh0 + 32 * 1024 + ks * 16), bl_0 = *(const bf16x8*)(bl0 + ks * 16), bl_1 = *(const bf16x8*)(bl0 + 32 * 1024 + ks * 16);
        acc0 = __builtin_amdgcn_mfma_f32_32x32x16_bf16(a_hi, bh_0, acc0, 0, 0, 0); acc1 = __builtin_amdgcn_mfma_f32_32x32x16_bf16(a_hi, bh_1, acc1, 0, 0, 0);
        acc0 = __builtin_amdgcn_mfma_f32_32x32x16_bf16(a_hi, bl_0, acc0, 0, 0, 0); acc1 = __builtin_amdgcn_mfma_f32_32x32x16_bf16(a_hi, bl_1, acc1, 0, 0, 0);
    }
    ssq += __shfl_xor(ssq, 32);
    const float rs = 1.0f / sqrtf(ssq * (1.0f / DMODEL) + EPS);
#pragma unroll
    for (int r = 0; r < 16; ++r) { const int m = (r & 3) + 8 * (r >> 2) + 4 * hi; lg[m * 66 + r32] = acc0[r]; lg[m * 66 + 32 + r32] = acc1[r]; }
    asm volatile("s_waitcnt lgkmcnt(0)" ::: "memory");
    int ea = 0, eb = 0, cls = 0, lpa = 0, lpb = 0, lpc = 0; float wa = 0.f, wb = 0.f;
    if (lane < 32) {
        const LAS float* L = lg + lane * 66;
        float gl[4];
#pragma unroll
        for (int j = 0; j < 4; ++j) gl[j] = L[j] * rs + P.b_rg[j];
        int gs = 0; float gm = gl[0];
#pragma unroll
        for (int j = 1; j < 4; ++j) if (gl[j] > gm) { gm = gl[j]; gs = j; }
        float gsum = 0.f;
#pragma unroll
        for (int j = 0; j < 4; ++j) gsum += __expf(gl[j] - gm);
        const float gw = 1.0f / gsum;
        float l0 = -INFINITY, l1 = -INFINITY; int i0 = 0, i1 = 0;
#pragma unroll
        for (int j = 0; j < 8; ++j) { const float v = L[4 + gs * 8 + j] * rs + P.b_re[gs * 8 + j];
            if (v > l0) { l1 = l0; i1 = i0; l0 = v; i0 = j; } else if (v > l1) { l1 = v; i1 = j; } }
        const float q = __expf(l1 - l0), inv = 1.0f / (1.0f + q);
        const float w0 = inv * gw, w1 = q * inv * gw;
        const int a = min(i0, i1), b = max(i0, i1);
        wa = (i0 < i1) ? w0 : w1; wb = (i0 < i1) ? w1 : w0;
        ea = gs * 8 + a; eb = gs * 8 + b; cls = gs * 28 + (a * (15 - a)) / 2 + (b - a - 1);
        lpa = __hip_atomic_fetch_add(&hist[ea], 1, __ATOMIC_RELAXED, __HIP_MEMORY_SCOPE_WORKGROUP); lpb = __hip_atomic_fetch_add(&hist[eb], 1, __ATOMIC_RELAXED, __HIP_MEMORY_SCOPE_WORKGROUP);
        lpc = __hip_atomic_fetch_add(&hist2[cls], 1, __ATOMIC_RELAXED, __HIP_MEMORY_SCOPE_WORKGROUP);
    }
    __syncthreads();
    if (tid < 32) hbase[tid] = (int)atomicAdd(cnt + tid, (unsigned)hist[tid]);
    if (tid >= 64 && tid < 64 + NCLS) { const int c = tid - 64; const int n = hist2[c]; hbase2[c] = n ? (int)atomicAdd(ccnt + c, (unsigned)n) : 0; }
    __syncthreads();
    if (lane < 32) { const int t = tbase + lane; const int pa = hbase[ea] + lpa, pb = hbase[eb] + lpb, pc = hbase2[cls] + lpc;
        typedef int i32x4 __attribute__((ext_vector_type(4)));
        const int dst = (cls << 17) | (pc << 1);
        *(i32x4*)(LIST + (size_t)(ea * LCAP + pa) * 4) = (i32x4){t, dst, __float_as_int(wa), __float_as_int(rs)};
        *(i32x4*)(LIST + (size_t)(eb * LCAP + pb) * 4) = (i32x4){t, dst | 1, __float_as_int(wb), __float_as_int(rs)};
        CTOK[(size_t)cls * NTOK + pc] = t; }
    __syncthreads();
}

__device__ __forceinline__ void p5_convert(const Ptrs& P, LAS unsigned char* lds, int vcu, int G) {
    const int tid = threadIdx.x, lane = tid & 63, wave = __builtin_amdgcn_readfirstlane(tid >> 6);
    LAS float* scr = (LAS float*)(lds + wave * 16384);
    const int gw = vcu * NWAVES + wave, NGW = G * NWAVES;
    unsigned char* WGU = P.ws + WS_WGU; unsigned char* WD = P.ws + WS_WD;
    constexpr int I_G = (DMODEL / 64) * (DEXP / 32);
    constexpr int I_D = (DEXP / 64) * (DMODEL / 32);
    constexpr int PER_E = 2 * I_G + I_D;
    constexpr int NITEMS = NEXP * PER_E, NRW = (NTOK / 256) * NWAVES;
    const bool split = (G == 256) && (NITEMS == NRW * 10 + (256 * NWAVES - NRW) * 14);
    const bool rwg = (int)blockIdx.x < NTOK / 256; const int wv = ((int)blockIdx.x - (rwg ? 0 : NTOK / 256)) * NWAVES + wave;
    const int it0 = split ? (rwg ? wv : NRW * 10 + wv) : gw, itn = split ? (rwg ? NRW * 10 : NITEMS) : NITEMS, its = split ? NRW : NGW;
    for (int it = it0; it < itn; it += its) {
        const int e = it / PER_E; int r = it % PER_E;
        if (r < 2 * I_G) { const int up = r / I_G; r %= I_G; const int kb = r / (DEXP / 32), nb = r % (DEXP / 32), n0 = nb * 32;
            const float* W = (up ? P.w_up : P.w_gate) + (size_t)e * DMODEL * DEXP;
            transpose_item_fp8(W, DEXP, kb * 64, n0, WGU + (size_t)e * 1024 * 1024, 1024, (n0 >> 7) * 256 + up * 128 + (n0 & 127), P.ffn_norm_g, 64.f, scr, lane);
        } else { r -= 2 * I_G; const int kb = r / (DMODEL / 32), nb = r % (DMODEL / 32);
            transpose_item_fp8(P.w_down + (size_t)e * DEXP * DMODEL, DMODEL, kb * 64, nb * 32, WD + (size_t)e * 1024 * 512, 512, nb * 32, nullptr, 32.f, scr, lane); }
    }
}

struct Args { Ptrs p; int ph_lo, ph_hi, use_cg, pad; };
__global__ void __launch_bounds__(NTHREADS, 2) mega_fwd(Args args) {
    extern __shared__ __attribute__((aligned(16))) unsigned char lds_raw[];
    LAS unsigned char* lds = (LAS unsigned char*)lds_raw;
    const Ptrs& P = args.p;
    const int tid = threadIdx.x, lane = tid & 63;
    const int G = gridDim.x, bx = blockIdx.x; const int vcu = (G % 8 == 0) ? (bx % 8) * (G / 8) + bx / 8 : bx;
    const int lo = args.ph_lo, hi = args.ph_hi;
    LAS int* meta = (LAS int*)(lds + META_OFF);
    if (tid < 2) ((volatile LAS unsigned*)(lds + BARST_OFF))[tid] = 0u;
    __syncthreads();
    XcdBarrier bar = xcd_barrier_post((unsigned*)(P.ws + WS_CTL) + 1024, (volatile LAS unsigned*)(lds + BARST_OFF));
#ifndef PHASE_MASK
#define PHASE_MASK 0xff
#endif
#ifndef DUP_PHASE
#define DUP_PHASE -1
#endif
#define REPS(k) for (int rep_ = 0; rep_ < ((DUP_PHASE == (k)) ? 2 : 1); ++rep_)
#define REPBAR() do { if (rep_) xcd_barrier(bar); } while (0)
#define IN(k) (((PHASE_MASK >> (k)) & 1) && lo <= (k) && (k) < hi)
#define SEAM(k) do { if (IN(k) && IN((k) + 1)) xcd_barrier(bar); } while (0)
    bf16* WS16 = (bf16*)P.ws;
    if (IN(0)) REPS(0) { REPBAR(); p0_prologue(P, lds, vcu, G); }
    SEAM(0);
    if (IN(1)) REPS(1) { REPBAR();
        pg8::Gemm g{(const bf16*)(P.ws + WS_A), (const bf16*)(P.ws + WS_WIN), DMODEL, 0, nullptr};
        pg8::StaticOrder S; S.init(NTOK, IN_COLS, G, bx);
        LAS float* gl = (LAS float*)(lds + RING_BYTES + 8192);
        if (tid < 128) gl[tid] = (tid < 64) ? P.q_norm_g[tid] : P.k_norm_g[tid - 64];
        __syncthreads();
        EpiInProj E{(bf16*)(P.ws + WS_YG), (bf16*)(P.ws + WS_QB), (bf16*)(P.ws + WS_KB), (bf16*)(P.ws + WS_VB), (bf16*)(P.ws + WS_GT), gl};
#if defined(DUMP_SEL) && DUMP_SEL == 5
        EpiRaw ER{(bf16*)(P.ws + WS_QB)};
        pg8::gemm_phase<EpiRaw, pg8::StaticOrder, false, true>(lds, g, S, ER);
#else
        pg8::gemm_phase<EpiInProj, pg8::StaticOrder, false, true>(lds, g, S, E);
#endif
    }
    SEAM(1);
    if (IN(2)) {
        REPS(2) { REPBAR();
        for (int p = vcu; p < 256; p += G) attn_pair(P, lds, (char*)lds_raw, p);
        __syncthreads(); }
        REPS(20) { REPBAR();
        conv_phase(P, lds, bx, G); }
    }
    SEAM(2);
    if (IN(3)) REPS(3) { REPBAR();
        pg8::Gemm g{(const bf16*)(P.ws + WS_CA), (const bf16*)(P.ws + WS_WCA), DMODEL, 0, nullptr};
        pg8::StaticOrder S; S.init(NTOK, DMODEL, G, bx);
        EpiMerged E{(const bf16*)(P.ws + WS_GT), (const bf16*)(P.ws + WS_GT) + (size_t)NTOK * 1024, (bf16*)(P.ws + WS_MG)};
        pg8::gemm_phase<EpiMerged, pg8::StaticOrder, false, true>(lds, g, S, E);
    }
    SEAM(3);
    if (IN(4)) REPS(4) { REPBAR();
        pg8::Gemm g{(const bf16*)(P.ws + WS_MG), (const bf16*)(P.ws + WS_WOUT), DMODEL, 0, nullptr};
        pg8::StaticOrder S; S.init(NTOK, DMODEL, G, bx);
        EpiOut E{P.x, (bf16*)(P.ws + WS_CA), P.ws + WS_XM};
        pg8::gemm_phase<EpiOut, pg8::StaticOrder, false, true>(lds, g, S, E);
    }
    SEAM(4);
    if (IN(5)) {
        for (int t = bx; t < NTOK / 256; t += G) router_tile(P, lds, t);
        REPS(5) { REPBAR(); p5_convert(P, lds, vcu, G); }
    }
    SEAM(5);
    LAS int* meta2 = (LAS int*)(lds + META2_OFF);
    if (IN(6)) REPS(6) { REPBAR();
        moe_meta(meta, meta2, (const unsigned*)(P.ws + WS_CTL));
        pg8::Gemm g{(const bf16*)(P.ws + WS_XM), (const bf16*)(P.ws + WS_WGU), DMODEL / 2, (size_t)1024 * 1024, (const int*)(P.ws + WS_LIST), 4};
        MoeOrder S{G, bx, __builtin_amdgcn_readfirstlane(meta[NEXP]), meta};
        EpiGateUp E{(const int*)(P.ws + WS_LIST), P.ws + WS_A, meta2};
        pg8::gemm_phase<EpiGateUp, MoeOrder, true, true, true>(lds, g, S, E);
    }
    SEAM(6);
    if (IN(7)) REPS(7) { REPBAR();
        moe_meta(meta, meta2, (const unsigned*)(P.ws + WS_CTL));
        pg8::Gemm g{(const bf16*)(P.ws + WS_A), (const bf16*)(P.ws + WS_WD), DMODEL / 2, (size_t)1024 * 512, nullptr, 0, DEXP / 2};
        ClassOrder S{G, bx, __builtin_amdgcn_readfirstlane(meta2[NCLS]), meta2};
        EpiDownAdd E{(const int*)(P.ws + WS_CTOK), (const bf16*)(P.ws + WS_CA), P.out};
        pg8::gemm_phase<EpiDownAdd, ClassOrder, false, true, true, true>(lds, g, S, E);
    }
#if defined(DUMP_SEL)
    xcd_barrier(bar);
    { const bf16* YG = (const bf16*)(P.ws + WS_YG); const bf16* QB = (const bf16*)(P.ws + WS_QB); const bf16* KB = (const bf16*)(P.ws + WS_KB); const bf16* VB = (const bf16*)(P.ws + WS_VB);
      const bf16* GT = (const bf16*)(P.ws + WS_GT); const bf16* CA = (const bf16*)(P.ws + WS_CA); const bf16* MG = (const bf16*)(P.ws + WS_MG);
      for (size_t i = (size_t)bx * NTHREADS + tid; i < (size_t)NTOK * 1024; i += (size_t)G * NTHREADS) { const size_t t = i >> 10; const int c = (int)(i & 1023); float v = 0.f;
#if DUMP_SEL == 1
          v = bf_lo(YG[t * 512 + (c & 511)]) + bf_lo(QB[t * 512 + (c & 511)]) + 2.f * bf_lo(KB[t * 512 + (c & 511)]) + 3.f * bf_lo(VB[t * 512 + (c & 511)]) + bf_lo(GT[t * 2048 + c]) + bf_lo(GT[t * 2048 + 1024 + c]);
#elif DUMP_SEL == 2
          v = bf_lo(CA[t * 1024 + c]);
#elif DUMP_SEL == 4
          { const bf16* HB = (const bf16*)(P.ws + WS_A); const bf16* WIN = (const bf16*)(P.ws + WS_WIN); v = bf_lo(HB[i]) + 30.f * bf_lo(WIN[i % ((size_t)IN_COLS * 1024)]); }
#elif DUMP_SEL == 5
          { const bf16* R = (const bf16*)(P.ws + WS_QB); v = bf_lo(R[t * 4608 + c]) + bf_lo(R[t * 4608 + 1024 + c]) + bf_lo(R[t * 4608 + 2048 + c]) + bf_lo(R[t * 4608 + 3072 + c]) + bf_lo(R[t * 4608 + 4096 + (c & 511)]); }
#elif DUMP_SEL == 3
          v = bf_lo(MG[t * 1024 + c]);
#endif
          P.out[i] = v; } }
#endif
    (void)WS16;
#undef IN
#undef SEAM
}

extern "C" void kernel_launch(void* const* d_in, const int* in_sizes, int n_in, void* d_out, int out_size, void* d_ws, size_t ws_size, hipStream_t stream) {
    static int grid = 0;
    if (grid == 0) {
        if (n_in != 25 || in_sizes[0] != NTOK * DMODEL || out_size != NTOK * DMODEL || ws_size < WS_END) {
            fprintf(stderr, "kernel_launch: unexpected shapes (n_in %d, in0 %d, out %d, ws %zu); nothing launched\n", n_in, n_in > 0 ? in_sizes[0] : -1, out_size, ws_size); grid = -1; return; }
        int dev = 0, cus = 0, per_cu = 0;
        if (hipGetDevice(&dev) != hipSuccess || hipDeviceGetAttribute(&cus, hipDeviceAttributeMultiprocessorCount, dev) != hipSuccess) { grid = -1; return; }
        if (hipFuncSetAttribute((const void*)mega_fwd, hipFuncAttributeMaxDynamicSharedMemorySize, LDS_BYTES) != hipSuccess) { fprintf(stderr, "kernel_launch: hipFuncSetAttribute failed\n"); grid = -1; return; }
        if (hipOccupancyMaxActiveBlocksPerMultiprocessor(&per_cu, (const void*)mega_fwd, NTHREADS, LDS_BYTES) != hipSuccess || per_cu < 1) { fprintf(stderr, "kernel_launch: the occupancy query reports %d workgroups per CU for this kernel and LDS size; nothing launched\n", per_cu); grid = -1; return; }
        (void)hipGetLastError();
        grid = cus;
    }
    if (grid < 0) return;
    (void)hipMemsetAsync((char*)d_ws + WS_CTL, 0, CTL_ZERO_BYTES, stream);
    Args a{};
    const float** pp = (const float**)&a.p;
    for (int i = 0; i < 25; ++i) pp[i] = (const float*)d_in[i];
    a.p.out = (float*)d_out; a.p.ws = (unsigned char*)d_ws;
#if MK_PER_PHASE
    for (int ph = 0; ph < N_PHASES; ++ph) { a.ph_lo = ph; a.ph_hi = ph + 1; void* params[] = {&a};
        hipError_t e = hipLaunchCooperativeKernel((const void*)mega_fwd, dim3(grid), dim3(NTHREADS), params, LDS_BYTES, stream);
        if (e != hipSuccess) { fprintf(stderr, "launch %d failed: %s\n", ph, hipGetErrorString(e)); break; } }
#else
    a.ph_lo = 0; a.ph_hi = N_PHASES; void* params[] = {&a};
    hipError_t e = hipLaunchCooperativeKernel((const void*)mega_fwd, dim3(grid), dim3(NTHREADS), params, LDS_BYTES, stream);
    if (e != hipSuccess) fprintf(stderr, "cooperative launch failed: %s (grid %d)\n", hipGetErrorString(e), grid);
#endif
}
```

```cpp
#include <hip/hip_runtime.h>
#include <hip/hip_bf16.h>
#include <hip/hip_cooperative_groups.h>
#include <cstdio>
#include <cstdint>
#include <cmath>
namespace cg = cooperative_groups;

constexpr int BATCH = 8, SEQ = 4096, DMODEL = 1024, NTOK = BATCH * SEQ;
constexpr int CONV_CH = 512, CONV_W = 31, NHEADS = 4, IN_COLS = 4608;
constexpr int NEXP = 32, DEXP = 512, LCAP = NTOK;
constexpr int NCLS = 4 * 28;
constexpr int CROWS = NTOK + NCLS * 256;
constexpr int MOE_ROWS = 2 * NTOK + NEXP * 256;
constexpr float EPS = 1e-6f;

namespace pg8 {
#define PG8_LAS __attribute__((address_space(3)))
typedef unsigned short bf16_t;
typedef short bf16x8 __attribute__((ext_vector_type(8)));
typedef float f32x4 __attribute__((ext_vector_type(4)));
typedef unsigned u32x4 __attribute__((ext_vector_type(4)));
constexpr int BM = 256, BK = 64, HALF = 128, HTB = HALF * BK * 2  , STAGE_BYTES = 8 * HTB, NXCD = 8, WGM = 8;

__host__ __device__ __forceinline__ int lds_byte(int r, int c) { const int st = (r >> 4) * 2 + (c >> 5), rr = r & 15, cc = c & 31, ob = rr * 64 + cc * 2; return st * 1024 + (ob ^ (((ob >> 9) & 1) << 5)); }
__host__ __device__ __forceinline__ void stage_rc(int b, int& R, int& C) { const int st = b / 1024, sb = b % 1024, swz = sb ^ (((sb >> 9) & 1) << 5); R = (st >> 1) * 16 + swz / 64; C = (st & 1) * 32 + (swz % 64) / 2; }
__host__ __device__ __forceinline__ int perm32(int rho) { const int n = rho >> 4, i = rho & 15; return 8 * (i >> 2) + 4 * n + (i & 3); }

struct Unit { int pm, pn, arow, e, e2, lrow, nvalid, orow; };
struct Gemm { const bf16_t* A; const bf16_t* Bt; int K; size_t bstride; const int* list; int lstride; int KBrow; };

struct StaticOrder {
    int nM, nN, nwg, G, c;
    __device__ void init(int M, int N, int G_, int c_) { nM = M / BM; nN = N / BM; nwg = nM * nN; G = G_; c = c_; }
    __device__ bool next(int i, Unit& u) const {
        const long L = (long)i * G + c; if (L >= nwg) return false;
        int wgid = (int)L; { const int q = nwg / NXCD, r = nwg % NXCD, xcd = wgid % NXCD, off = wgid / NXCD; wgid = (xcd < r ? xcd * (q + 1) : r * (q + 1) + (xcd - r) * q) + off; }
        const int nig = WGM * nN, gid = wgid / nig, fm = gid * WGM, gsz = (nM - fm) < WGM ? (nM - fm) : WGM;
        u.pm = fm + ((wgid % nig) % gsz); u.pn = (wgid % nig) / gsz; u.arow = u.pm * BM; u.orow = u.arow; u.e = 0; u.e2 = 0; u.lrow = 0; u.nvalid = BM; return true;
    }
};

typedef float f32x2_t __attribute__((ext_vector_type(2))); typedef __bf16 bf16x2_t __attribute__((ext_vector_type(2)));
__device__ __forceinline__ unsigned cvt_pk_bf16(float lo, float hi) { const f32x2_t v = {lo, hi}; const bf16x2_t b = __builtin_convertvector(v, bf16x2_t); return __builtin_bit_cast(unsigned, b); }
typedef int v8i_t __attribute__((ext_vector_type(8))); typedef int v4i_t __attribute__((ext_vector_type(4)));
__device__ __forceinline__ v8i_t cat8(const bf16x8 a, const bf16x8 b) { const v4i_t x = __builtin_bit_cast(v4i_t, a), y = __builtin_bit_cast(v4i_t, b); return (v8i_t){x[0], x[1], x[2], x[3], y[0], y[1], y[2], y[3]}; }
__device__ __forceinline__ unsigned pack4_fp8(float a, float b, float c, float d) { int w = 0; w = __builtin_amdgcn_cvt_pk_fp8_f32(a, b, w, false); w = __builtin_amdgcn_cvt_pk_fp8_f32(c, d, w, true); return (unsigned)w; }
__device__ __forceinline__ float bf_lo(unsigned w) { return __uint_as_float(w << 16); }
__device__ __forceinline__ float bf_hi(unsigned w) { return __uint_as_float(w & 0xffff0000u); }
__device__ __forceinline__ float sigmoidf_fast(float x) { return __builtin_amdgcn_rcpf(1.0f + __builtin_amdgcn_exp2f(-1.4426950408889634f * x)); }
__device__ __forceinline__ u32x4 pack8(const f32x4 a, const f32x4 b) { u32x4 w; w.x = cvt_pk_bf16(a[0], a[1]); w.y = cvt_pk_bf16(a[2], a[3]); w.z = cvt_pk_bf16(b[0], b[1]); w.w = cvt_pk_bf16(b[2], b[3]); return w; }
__device__ __forceinline__ void unpack8(const u32x4 w, f32x4& a, f32x4& b) { a = (f32x4){bf_lo(w.x), bf_hi(w.x), bf_lo(w.y), bf_hi(w.y)}; b = (f32x4){bf_lo(w.z), bf_hi(w.z), bf_lo(w.w), bf_hi(w.w)}; }

template <class Epi, class Sched, bool GATHER, bool ALIGN_EPI, bool FP8 = false, bool BSPLIT = false>
__device__ __forceinline__ void gemm_phase(PG8_LAS unsigned char* lds, const Gemm g, const Sched& S, const Epi& E) {
    const int tid = threadIdx.x, wid = __builtin_amdgcn_readfirstlane(tid >> 6), lane = tid & 63, wr = wid >> 2, wc = wid & 3, fr = lane & 15, fq = lane >> 4;
    const int K = g.K, nt = K / BK, KBp = g.KBrow ? g.KBrow : K;
    unsigned voffB[2]; int Ra[2], Ca[2];
#pragma unroll
    for (int i = 0; i < 2; ++i) { int R, C; stage_rc(tid * 16 + i * 8192, R, C); const int Rb = (R & ~31) + perm32(R & 31); Ra[i] = R; Ca[i] = C; voffB[i] = (unsigned)(Rb * KBp + C) * 2u; }
    const unsigned kstep = (unsigned)(BK * 2);
    const unsigned hstep = (unsigned)HALF * KBp * 2;
    const unsigned tstep = 2 * hstep;
    const char* const gA = (const char*)g.A; const char* const gB = (const char*)g.Bt;
    const unsigned ldsw = (unsigned)wid * 1024u;
    const int aoff = lds_byte(wr * 64 + fr, fq * 8), boff = lds_byte(wc * 32 + fr, fq * 8);
#define PG8_SA(b, h) (((b) * 2 + (h)) * HTB)
#define PG8_SB(b, h) ((4 + (b) * 2 + (h)) * HTB)
#define PG8_STAGE(bufoff, gbase, uoff, voff) do { _Pragma("unroll") for (int _i = 0; _i < 2; ++_i) \
        __builtin_amdgcn_global_load_lds((const unsigned*)((const char*)(gbase) + (unsigned)((uoff) + (voff)[_i])), (PG8_LAS unsigned*)(lds + (bufoff) + ldsw + _i * 8192), 16, 0, 0); } while (0)
#define PG8_LDA(dst, b, h) do { _Pragma("unroll") for (int m = 0; m < 4; ++m) _Pragma("unroll") for (int k = 0; k < 2; ++k) dst[m][k] = *(const PG8_LAS bf16x8*)(lds + PG8_SA(b, h) + aoff + m * 2048 + k * 1024); } while (0)
#define PG8_LDB(dst, b, h) do { _Pragma("unroll") for (int n = 0; n < 2; ++n) _Pragma("unroll") for (int k = 0; k < 2; ++k) dst[n][k] = *(const PG8_LAS bf16x8*)(lds + PG8_SB(b, h) + boff + n * 2048 + k * 1024); } while (0)
#define PG8_MMA(ai, bj, At, Bt) do { __builtin_amdgcn_s_setprio(1); \
        if constexpr (FP8) { _Pragma("unroll") for (int m = 0; m < 4; ++m) _Pragma("unroll") for (int n = 0; n < 2; ++n) \
            asm volatile("v_mfma_scale_f32_16x16x128_f8f6f4 %0, %1, %2, %0, %3, %3 op_sel_hi:[0,0,0]" : "+v"(acc[ai][bj][m][n]) : "v"(cat8(Bt[n][0], Bt[n][1])), "v"(cat8(At[m][0], At[m][1])), "v"(one_e8m0)); } \
        else { _Pragma("unroll") for (int m = 0; m < 4; ++m) _Pragma("unroll") for (int n = 0; n < 2; ++n) _Pragma("unroll") for (int k = 0; k < 2; ++k) \
            acc[ai][bj][m][n] = __builtin_amdgcn_mfma_f32_16x16x32_bf16(Bt[n][k], At[m][k], acc[ai][bj][m][n], 0, 0, 0); } \
        __builtin_amdgcn_s_setprio(0); } while (0)
#define PG8_WAIT_V(n) asm volatile("s_waitcnt vmcnt(" #n ")" ::: "memory")
#define PG8_WAIT_L(n) asm volatile("s_waitcnt lgkmcnt(" #n ")" ::: "memory")
#define PG8_BAR __builtin_amdgcn_s_barrier()
#define PG8_SCHED __builtin_amdgcn_sched_barrier(0)
#define PG8_LOAD_VA(dst, u) do { _Pragma("unroll") for (int _h = 0; _h < 2; ++_h) _Pragma("unroll") for (int _i = 0; _i < 2; ++_i) { const int _row = _h * HALF + Ra[_i]; \
        if constexpr (GATHER) { const int _tok = (_row < (u).nvalid) ? g.list[((u).lrow + _row) * g.lstride] : 0; dst[_h][_i] = (unsigned)(_tok * K + Ca[_i]) * 2u; } \
        else dst[_h][_i] = (unsigned)(_row * K + Ca[_i]) * 2u; } } while (0)
    Unit cur, nxt; int ui = 0;
    if (!S.next(0, cur)) return;
    unsigned vAc[2][2], vAn[2][2];
    PG8_LOAD_VA(vAc, cur);
    f32x4 acc[2][2][4][2];
#pragma unroll
    for (int a = 0; a < 2; ++a)
#pragma unroll
        for (int b = 0; b < 2; ++b)
#pragma unroll
            for (int m = 0; m < 4; ++m)
#pragma unroll
                for (int n = 0; n < 2; ++n) acc[a][b][m][n] = (f32x4){0.f, 0.f, 0.f, 0.f};
    bf16x8 At[4][2], B0[2][2], B1[2][2];
    const int one_e8m0 = 0x7f7f7f7f; (void)one_e8m0;
    unsigned cA = (unsigned)cur.arow * K * 2, cB = (unsigned)cur.e * (unsigned)g.bstride + (unsigned)cur.pn * tstep;
    unsigned cB2 = (unsigned)cur.e2 * (unsigned)g.bstride + (unsigned)cur.pn * tstep; const unsigned hk = (unsigned)(nt / 2) * kstep; (void)cB2; (void)hk;
    PG8_STAGE(PG8_SB(0, 0), gB, cB, voffB); PG8_STAGE(PG8_SB(0, 1), gB, cB + hstep, voffB); PG8_STAGE(PG8_SA(0, 0), gA, cA, vAc[0]); PG8_STAGE(PG8_SA(0, 1), gA, cA, vAc[1]);
    if (wr == 1) PG8_BAR;
    PG8_WAIT_V(2); PG8_BAR;
    PG8_STAGE(PG8_SB(1, 0), gB, cB + kstep, voffB); PG8_STAGE(PG8_SA(1, 0), gA, cA + kstep, vAc[0]); PG8_STAGE(PG8_SB(1, 1), gB, cB + hstep + kstep, voffB);
    PG8_WAIT_V(6); PG8_BAR;
    for (;;) {
        const bool has_next = S.next(ui + 1, nxt);
        const unsigned nA = has_next ? (unsigned)nxt.arow * K * 2 : cA;
        const unsigned nB = has_next ? (unsigned)nxt.e * (unsigned)g.bstride + (unsigned)nxt.pn * tstep : cB;
        const unsigned nB2 = has_next ? (unsigned)nxt.e2 * (unsigned)g.bstride + (unsigned)nxt.pn * tstep : cB2; (void)nB2;
        if (has_next) { PG8_LOAD_VA(vAn, nxt); }
        else {
#pragma unroll
            for (int h = 0; h < 2; ++h)
#pragma unroll
                for (int i = 0; i < 2; ++i) vAn[h][i] = vAc[h][i]; }
#pragma unroll 1
        for (int t = 0; t < nt; t += 2) {
            const bool last = (t == nt - 2);
            if constexpr (Epi::MID) { if (t == nt / 2) E.mid(acc, cur, wr, wc, fr, fq); }
            const unsigned a1 = cA + (unsigned)(t + 1) * kstep;
            const unsigned a2 = last ? nA : cA + (unsigned)(t + 2) * kstep;
            unsigned b2 = last ? nB : cB + (unsigned)(t + 2) * kstep;
            if constexpr (BSPLIT) { if (!last && t + 2 >= nt / 2) b2 = cB2 + (unsigned)(t + 2) * kstep - hk; }
            const unsigned a3 = a2 + kstep, b3 = b2 + kstep;
            unsigned v2[2][2];
#pragma unroll
            for (int h = 0; h < 2; ++h)
#pragma unroll
                for (int i = 0; i < 2; ++i) v2[h][i] = vAc[h][i];
            if (last) { asm volatile("" ::: "memory");
#pragma unroll
                for (int h = 0; h < 2; ++h)
#pragma unroll
                    for (int i = 0; i < 2; ++i) v2[h][i] = vAn[h][i]; }
            PG8_LDB(B0, 0, 0); PG8_LDB(B1, 0, 1); PG8_SCHED; PG8_LDA(At, 0, 0); PG8_STAGE(PG8_SA(1, 1), gA, a1, vAc[1]);
            PG8_WAIT_V(8); PG8_WAIT_L(0); PG8_BAR; PG8_MMA(0, 0, At, B0); PG8_MMA(0, 1, At, B1); PG8_BAR; PG8_SCHED;
            PG8_LDA(At, 0, 1); PG8_STAGE(PG8_SB(0, 0), gB, b2, voffB); PG8_STAGE(PG8_SB(0, 1), gB, b2 + hstep, voffB); PG8_STAGE(PG8_SA(0, 0), gA, a2, v2[0]);
            PG8_WAIT_V(8); PG8_WAIT_L(0); PG8_BAR; PG8_MMA(1, 0, At, B0); PG8_MMA(1, 1, At, B1); PG8_BAR; PG8_SCHED;
            PG8_LDB(B0, 1, 0); PG8_LDB(B1, 1, 1); PG8_SCHED; PG8_LDA(At, 1, 0); PG8_STAGE(PG8_SA(0, 1), gA, a2, v2[1]);
            PG8_WAIT_V(8); PG8_WAIT_L(0); PG8_BAR; PG8_MMA(0, 0, At, B0); PG8_MMA(0, 1, At, B1); PG8_BAR; PG8_SCHED;
            PG8_LDA(At, 1, 1); PG8_STAGE(PG8_SB(1, 0), gB, b3, voffB); PG8_STAGE(PG8_SB(1, 1), gB, b3 + hstep, voffB); PG8_STAGE(PG8_SA(1, 0), gA, a3, v2[0]);
            PG8_WAIT_V(8); PG8_WAIT_L(0); PG8_BAR; PG8_MMA(1, 0, At, B0); PG8_MMA(1, 1, At, B1); PG8_BAR; PG8_SCHED;
        }
        if constexpr (ALIGN_EPI) { if (wr == 0) PG8_BAR; }
        if constexpr (FP8) asm volatile("s_nop 15\n\ts_nop 15\n\ts_nop 15\n\ts_nop 15" ::: "memory");
        E(acc, cur, wr, wc, fr, fq);
        if (!has_next) break;
#pragma unroll
        for (int a = 0; a < 2; ++a)
#pragma unroll
            for (int b = 0; b < 2; ++b)
#pragma unroll
                for (int m = 0; m < 4; ++m)
#pragma unroll
                    for (int n = 0; n < 2; ++n) acc[a][b][m][n] = (f32x4){0.f, 0.f, 0.f, 0.f};
        cur = nxt; cA = nA; cB = nB; cB2 = nB2; ++ui;
#pragma unroll
        for (int h = 0; h < 2; ++h)
#pragma unroll
            for (int i = 0; i < 2; ++i) vAc[h][i] = vAn[h][i];
        if constexpr (ALIGN_EPI) { if (wr == 1) PG8_BAR; }
    }
    PG8_WAIT_V(0);
    if constexpr (!ALIGN_EPI) { if (wr == 0) PG8_BAR; }
    PG8_BAR;
#undef PG8_SA
#undef PG8_SB
#undef PG8_STAGE
#undef PG8_LDA
#undef PG8_LDB
#undef PG8_MMA
#undef PG8_WAIT_V
#undef PG8_WAIT_L
#undef PG8_BAR
#undef PG8_SCHED
#undef PG8_LOAD_VA
}
}

namespace attn_body {
using bf16=__hip_bfloat16;
using bf16x8=__attribute__((ext_vector_type(8)))short;
using s16x4=__attribute__((ext_vector_type(4)))short;
using f32x16=__attribute__((ext_vector_type(16)))float;
using u32x4=__attribute__((ext_vector_type(4)))unsigned;
constexpr int D=64, QP=512, KP=512, VP=512, OP=1024;
constexpr int NW=8,QBLK=32,QB=QBLK*NW,KVBLK=64;
constexpr int ATTN_UNIT_ROWS=QB;
__device__ __forceinline__ int crow(int r,int hi){return (r&3)+8*(r>>2)+4*hi;}
#define SBAR() __builtin_amdgcn_sched_barrier(0)
__device__ __forceinline__ void cmask(f32x16&p0,f32x16&p1,int jb,int qrel,int hi){
  const float NEG=-INFINITY; int kb=64*jb+4*hi;
  #pragma unroll
  for(int r=0;r<16;++r){int kv=kb+(r&3)+8*(r>>2); if(kv>qrel)p0[r]=NEG; if(kv+32>qrel)p1[r]=NEG;}
}

constexpr int NSLOT=3, SLOTB=8192, VSLOTB=16384;
constexpr int LDS_K=0, LDS_V=NSLOT*SLOTB, LDS_WS=LDS_V+NSLOT*VSLOTB, LDS_OST=LDS_WS+NW*64*4, LDS_BYTES=LDS_OST+NW*4096;
constexpr float C2=0.125f*1.4426950408889634f;
__device__ __forceinline__ void glds16(const void*gsrc,unsigned lds_dst){unsigned keep;
  asm volatile("s_mov_b32 %0, m0\n\ts_mov_b32 m0, %2\n\ts_nop 0\n\tglobal_load_lds_dwordx4 %1, off\n\ts_mov_b32 m0, %0":"=&s"(keep):"v"(gsrc),"s"(lds_dst):"memory");}
__device__ __forceinline__ float max3f(float a,float b,float c){float r;asm("v_max3_f32 %0, %1, %2, %3":"=v"(r):"v"(a),"v"(b),"v"(c));return r;}
__device__ __forceinline__ float max2f(float a,float b){float r;asm("v_max_f32_e32 %0, %1, %2":"=v"(r):"v"(a),"v"(b));return r;}
__device__ __forceinline__ float fadd_s(float a,float b){float r;asm("v_add_f32_e32 %0, %1, %2":"=v"(r):"v"(a),"v"(b));return r;}
__device__ __forceinline__ float fsub_s(float a,float b){float r;asm("v_sub_f32_e32 %0, %1, %2":"=v"(r):"v"(a),"v"(b));return r;}
typedef float f32x2_t __attribute__((ext_vector_type(2))); typedef __bf16 bf16x2_t __attribute__((ext_vector_type(2)));
__device__ __forceinline__ unsigned cvtpk_s(float lo,float hi){f32x2_t v={lo,hi};bf16x2_t b=__builtin_convertvector(v,bf16x2_t);return __builtin_bit_cast(unsigned,b);}
#define WAIT_BAR(N) asm volatile("s_waitcnt vmcnt(" #N ") lgkmcnt(0)\n\ts_barrier":::"memory")

__device__ __forceinline__ void qkt(f32x16&p0,f32x16&p1,const char*Kslot,const bf16x8*qr,const f32x16&negm,int r32,int hi){
  const char*kb=Kslot+hi*1024+r32*16;
  #pragma unroll
  for(int d0=0;d0<4;++d0){
    const bf16x8 b0=*reinterpret_cast<const bf16x8*>(kb+d0*2048);
    const bf16x8 b1=*reinterpret_cast<const bf16x8*>(kb+d0*2048+512);
    if(d0==0){p0=__builtin_amdgcn_mfma_f32_32x32x16_bf16(b0,qr[0],negm,0,0,0);p1=__builtin_amdgcn_mfma_f32_32x32x16_bf16(b1,qr[0],negm,0,0,0);}
    else{p0=__builtin_amdgcn_mfma_f32_32x32x16_bf16(b0,qr[d0],p0,0,0,0);p1=__builtin_amdgcn_mfma_f32_32x32x16_bf16(b1,qr[d0],p1,0,0,0);}}
}
typedef __attribute__((address_space(3))) const char* lds_cptr;
typedef short v4i16_t __attribute__((ext_vector_type(4)));
__device__ __forceinline__ void kload8(bf16x8*kf,lds_cptr kp){
  kf[0]=*(const __attribute__((address_space(3))) bf16x8*)(kp);      kf[1]=*(const __attribute__((address_space(3))) bf16x8*)(kp+512);
  kf[2]=*(const __attribute__((address_space(3))) bf16x8*)(kp+2048); kf[3]=*(const __attribute__((address_space(3))) bf16x8*)(kp+2560);
  kf[4]=*(const __attribute__((address_space(3))) bf16x8*)(kp+4096); kf[5]=*(const __attribute__((address_space(3))) bf16x8*)(kp+4608);
  kf[6]=*(const __attribute__((address_space(3))) bf16x8*)(kp+6144); kf[7]=*(const __attribute__((address_space(3))) bf16x8*)(kp+6656);
}
__device__ __forceinline__ void kload2(bf16x8*kf,lds_cptr kp,int j){ kf[2*j]=*(const __attribute__((address_space(3))) bf16x8*)(kp+j*2048); kf[2*j+1]=*(const __attribute__((address_space(3))) bf16x8*)(kp+j*2048+512); }
__device__ __forceinline__ s16x4 vtr(lds_cptr p){ return __builtin_bit_cast(s16x4,__builtin_amdgcn_ds_read_tr16_b64_v4i16((__attribute__((address_space(3))) v4i16_t*)p)); }
__device__ __forceinline__ float rowmax(const f32x16&p0,const f32x16&p1){
  float a=max3f(p0[0],p0[1],p1[0]),b=max3f(p0[2],p0[3],p1[1]);a=max3f(a,p1[2],p1[3]);
  #pragma unroll
  for(int r=4;r<16;r+=4){a=max3f(a,p0[r],p0[r+1]);b=max3f(b,p0[r+2],p0[r+3]);a=max3f(a,p1[r],p1[r+1]);b=max3f(b,p1[r+2],p1[r+3]);}
  const float m=max2f(a,b);
  auto rr=__builtin_amdgcn_permlane32_swap(__float_as_uint(m),__float_as_uint(m),false,false);
  return max2f(__uint_as_float(rr[0]),__uint_as_float(rr[1]));
}
__device__ __forceinline__ void pv(f32x16*o,int vb,bf16x8 pa0,bf16x8 pa1,bf16x8 pa2,bf16x8 pa3){
  #pragma unroll
  for(int d0=0;d0<4;++d0){s16x4 lo[4],hi[4];
    #pragma unroll
    for(int ks=0;ks<4;++ks){
      asm volatile("ds_read_b64_tr_b16 %0,%1 offset:%c2":"=&v"(lo[ks]):"v"(vb),"i"(d0*4096+ks*1024):"memory");
      asm volatile("ds_read_b64_tr_b16 %0,%1 offset:%c2":"=&v"(hi[ks]):"v"(vb),"i"(d0*4096+ks*1024+512):"memory");}
    asm volatile("s_waitcnt lgkmcnt(0)":::"memory");SBAR();
    #define PK(k) (bf16x8){lo[k][0],lo[k][1],lo[k][2],lo[k][3],hi[k][0],hi[k][1],hi[k][2],hi[k][3]}
    o[d0]=__builtin_amdgcn_mfma_f32_32x32x16_bf16(pa0,PK(0),o[d0],0,0,0);
    o[d0]=__builtin_amdgcn_mfma_f32_32x32x16_bf16(pa1,PK(1),o[d0],0,0,0);
    o[d0]=__builtin_amdgcn_mfma_f32_32x32x16_bf16(pa2,PK(2),o[d0],0,0,0);
    o[d0]=__builtin_amdgcn_mfma_f32_32x32x16_bf16(pa3,PK(3),o[d0],0,0,0);
    #undef PK
  }
}

#ifndef ATTN_STORE16
#define ATTN_STORE16(p,v) (*(u32x4*)(p)=(v))
#endif
template<int THRL,bool STAT> __device__ __forceinline__ int attn_unit(float mstat,int q0,const bf16*Q,const bf16*__restrict__ K,const bf16*__restrict__ V,bf16*O,char*shm,const bf16*O1,float lam,const float*subg,unsigned short*CAo,const bf16*Knext,const bf16*Vnext,int s0,bool pre){
  #define NXT_(x) (((x)==(NSLOT-1)*SLOTB)?0:(x)+SLOTB)
  const int s1=NXT_(s0),s2=NXT_(s1);
  int tid_=threadIdx.x; asm volatile("":"+v"(tid_));
  const int tid=tid_,lane=tid&63,r32=lane&31,hi=lane>>5; const int wid=__builtin_amdgcn_readfirstlane(tid>>6);
  const bf16*Qw=Q+(long)(q0+wid*QBLK)*QP;
  const bf16*Kh=K,*Vh=V;
  const unsigned lds0=(unsigned)(uintptr_t)shm;
  float*wsf=(float*)(shm+LDS_WS)+wid*64;
  const bf16*ksrc=Kh+(long)lane*KP+wid*8;
  const bf16*vsrc=Vh+(long)(16*(wid&3)+(lane>>2))*VP+(wid>>2)*32+(lane&3)*8;
  const unsigned kdst=lds0+LDS_K+wid*1024, vdst=lds0+LDS_V+wid*1024;
  #define DMA_K(t,slot) glds16(ksrc+(long)(t)*KVBLK*KP,(unsigned)__builtin_amdgcn_readfirstlane(kdst+(slot)))
  #define DMA_V(t,slot) do{ glds16(vsrc+(long)(t)*KVBLK*VP,(unsigned)__builtin_amdgcn_readfirstlane(vdst+2*(slot))); glds16(vsrc+(long)(t)*KVBLK*VP+64,(unsigned)__builtin_amdgcn_readfirstlane(vdst+2*(slot)+8192)); }while(0)
  const int vb0=(int)(lds0+LDS_V)+((lane>>4)&1)*32+(lane&3)*8+(4*hi+((lane&15)>>2))*64;
  const char*Kbase=shm+LDS_K; bf16x8 kf[8];
  const lds_cptr shm3=(lds_cptr)shm; const lds_cptr kp0=shm3+LDS_K+hi*1024+r32*16; const lds_cptr vp0=shm3+LDS_V+((lane>>4)&1)*32+(lane&3)*8+(4*hi+((lane&15)>>2))*64;
  const int NT=(q0+QB)/KVBLK;
  if(!pre){DMA_K(0,s0);DMA_V(0,s0);DMA_K(1,s1);}
  bf16x8 qr[4];
  #pragma unroll
  for(int d0=0;d0<4;++d0)qr[d0]=*reinterpret_cast<const bf16x8*>(&Qw[(long)r32*QP+d0*16+hi*8]);
  float mhat=0.f,l_reg=0.f;f32x16 o[4];{float zz=0.f;asm volatile("":"+v"(zz));
  #pragma unroll
  for(int r=0;r<16;++r){o[0][r]=zz;o[1][r]=zz;o[2][r]=zz;o[3][r]=zz;}}
  f32x16 negm;{float zn=0.f;asm volatile("":"+v"(zn));
  #pragma unroll
  for(int r=0;r<16;++r)negm[r]=zn;}
  asm volatile("":"+v"(negm));
  const int qrel=wid*QBLK+r32;
  #define CMASK(P0,P1,t) do{int jb_=(t)-(NT-4); if(jb_>=0)cmask(P0,P1,jb_,qrel,hi);}while(0)
  bool resc=false;
  #define START(P0,P1) do{ float rm; if constexpr (STAT) rm=mstat; else rm=rowmax(P0,P1); resc=false; \
    { const float dl=rm; mhat=fadd_s(mhat,dl); \
      _Pragma("unroll") for(int r=0;r<16;++r){P0[r]=fsub_s(P0[r],dl);P1[r]=fsub_s(P1[r],dl);} \
      _Pragma("unroll") for(int r=0;r<16;++r)negm[r]=-mhat; asm volatile("":"+v"(negm)); } \
    _Pragma("unroll") for(int r=0;r<16;++r)P0[r]=__builtin_amdgcn_exp2f(P0[r]); }while(0)
  #define RESC() do{ if(resc){ asm volatile("s_waitcnt lgkmcnt(0)":::"memory"); \
      _Pragma("unroll") for(int d_=0;d_<4;++d_) _Pragma("unroll") for(int r=0;r<16;++r)o[d_][r]*=wsf[crow(r,hi)]; } }while(0)
  f32x16 pA0,pA1,pB0,pB1;
  int sl_prev=s0,sl_cur=s0,sl_next=s1;
  #define ROT() do{sl_prev=sl_cur;sl_cur=sl_next;sl_next=(sl_next==(NSLOT-1)*SLOTB)?0:sl_next+SLOTB;}while(0)
  if(!pre){DMA_K(2,s2);}
  WAIT_BAR(4);
  qkt(pA0,pA1,Kbase+s0,qr,negm,r32,hi);asm volatile("s_nop 15\n\ts_nop 7":"+v"(pA0),"+v"(pA1));CMASK(pA0,pA1,0);
  START(pA0,pA1);
  _Pragma("unroll") for(int r=0;r<16;++r)pA1[r]=__builtin_amdgcn_exp2f(pA1[r]);
  WAIT_BAR(0);
  DMA_K(3,s0);DMA_V(1,s1);
  ROT();
  kload8(kf,kp0+sl_cur);
  WAIT_BAR(3);
  s16x4 vlo[8],vhi[8]; u32x4 pw0,pw1,pw2,pw3;
  #define PKW(P,B) cvtpk_s(P[B],P[B+1])
  #define PAF(k) __builtin_bit_cast(bf16x8,pw##k)
  #define VFR(i) (bf16x8){vlo[i][0],vlo[i][1],vlo[i][2],vlo[i][3],vhi[i][0],vhi[i][1],vhi[i][2],vhi[i][3]}
  #define PIN(x) asm volatile("":"+v"(x))
  #define MX3(a,b,c) __builtin_fmaxf(__builtin_fmaxf((a),(b)),(c))
  #define GAPA(MF,A0,A1,A2,A3,W0,W1,PW) do{ MF; sacc+=A0; sacc+=A1; sacc+=A2; sacc+=A3; PIN(sacc); W0; W1; PIN(PW); SBAR(); }while(0)
  #define EX(v) __builtin_amdgcn_exp2f(v)
  #define GAPB2(MF,X,B) do{ MF; X[B]=EX(X[B]); X[B+1]=EX(X[B+1]); PIN(X); SBAR(); }while(0)
  #define VRD2(i) do{ vlo[i]=vtr(vp_+((((i)>>2)+2)*4096+((i)&3)*1024)); vhi[i]=vtr(vp_+((((i)>>2)+2)*4096+((i)&3)*1024+512)); }while(0)
  #define VRD(i) do{ vlo[i]=vtr(vp_+(((i)>>2)*4096+((i)&3)*1024)); vhi[i]=vtr(vp_+(((i)>>2)*4096+((i)&3)*1024+512)); }while(0)
  #define KRD(G,j) do{ if(G){ kload2(kf,kp0+sl_next,j); SBAR(); } }while(0)
  #define STEP(C0,C1,P0,P1,t,GK,GV,GL) do{ SBAR(); \
    const lds_cptr vp_=vp0+2*sl_prev; \
    VRD(0); SBAR(); float sacc=(P0[0]+P0[1]); \
    GAPA(C0=__builtin_amdgcn_mfma_f32_32x32x16_bf16(kf[0],qr[0],negm,0,0,0), P0[2],P0[3],P0[4],P0[5],     pw0[0]=PKW(P0,0), pw0[1]=PKW(P0,2), pw0); \
    VRD(4); SBAR(); GAPA(C1=__builtin_amdgcn_mfma_f32_32x32x16_bf16(kf[1],qr[0],negm,0,0,0), P0[6],P0[7],P0[8],P0[9],     pw0[2]=PKW(P0,4), pw0[3]=PKW(P0,6), pw0); \
    VRD(1); SBAR(); GAPA(C0=__builtin_amdgcn_mfma_f32_32x32x16_bf16(kf[2],qr[1],C0,0,0,0),   P0[10],P0[11],P0[12],P0[13], pw1[0]=PKW(P0,8), pw1[1]=PKW(P0,10), pw1); \
    VRD(5); SBAR(); GAPA(C1=__builtin_amdgcn_mfma_f32_32x32x16_bf16(kf[3],qr[1],C1,0,0,0),   P0[14],P0[15],P1[0],P1[1],   pw1[2]=PKW(P0,12),pw1[3]=PKW(P0,14), pw1); \
    VRD(2); SBAR(); GAPA(C0=__builtin_amdgcn_mfma_f32_32x32x16_bf16(kf[4],qr[2],C0,0,0,0),   P1[2],P1[3],P1[4],P1[5],     pw2[0]=PKW(P1,0), pw2[1]=PKW(P1,2), pw2); \
    VRD(6); SBAR(); GAPA(C1=__builtin_amdgcn_mfma_f32_32x32x16_bf16(kf[5],qr[2],C1,0,0,0),   P1[6],P1[7],P1[8],P1[9],     pw2[2]=PKW(P1,4), pw2[3]=PKW(P1,6), pw2); \
    VRD(3); SBAR(); GAPA(C0=__builtin_amdgcn_mfma_f32_32x32x16_bf16(kf[6],qr[3],C0,0,0,0),   P1[10],P1[11],P1[12],P1[13], pw3[0]=PKW(P1,8), pw3[1]=PKW(P1,10), pw3); \
    VRD(7); SBAR(); GAPA(C1=__builtin_amdgcn_mfma_f32_32x32x16_bf16(kf[7],qr[3],C1,0,0,0),   P1[14],P1[15],0.f,0.f,       pw3[2]=PKW(P1,12),pw3[3]=PKW(P1,14), pw3); \
    l_reg+=sacc; \
    if(GK){DMA_K((t)+3,sl_cur);} if(GV){DMA_V((t)+1,sl_next);} \
    CMASK(C0,C1,t); \
    if constexpr (!STAT) { float a=MX3(C0[0],C0[1],C1[0]),b=MX3(C0[2],C0[3],C1[1]); a=MX3(a,C1[2],C1[3]); \
      _Pragma("unroll") for(int r=4;r<16;r+=4){a=MX3(a,C0[r],C0[r+1]);b=MX3(b,C0[r+2],C0[r+3]);a=MX3(a,C1[r],C1[r+1]);b=MX3(b,C1[r+2],C1[r+3]);} \
      float rm=__builtin_fmaxf(a,b); { auto rr=__builtin_amdgcn_permlane32_swap(__float_as_uint(rm),__float_as_uint(rm),false,false); rm=__builtin_fmaxf(__uint_as_float(rr[0]),__uint_as_float(rr[1])); } \
      resc=false; \
      if(__builtin_expect(__any(rm>(float)THRL),0)){ const float dl=__builtin_fmaxf(rm,0.f); mhat+=dl; \
        _Pragma("unroll") for(int r=0;r<16;++r){C0[r]-=dl;C1[r]-=dl;} \
        _Pragma("unroll") for(int r=0;r<16;++r)negm[r]=-mhat; asm volatile("":"+v"(negm)); \
        const float f=__builtin_amdgcn_exp2f(-dl); l_reg*=f; if(hi==0)wsf[r32]=f; resc=true; } } \
    SBAR(); \
    GAPB2(o[0]=__builtin_amdgcn_mfma_f32_32x32x16_bf16(PAF(0),VFR(0),o[0],0,0,0), C0,0);  VRD2(0); SBAR(); \
    GAPB2(o[1]=__builtin_amdgcn_mfma_f32_32x32x16_bf16(PAF(0),VFR(4),o[1],0,0,0), C0,2);  VRD2(4); SBAR(); \
    GAPB2(o[0]=__builtin_amdgcn_mfma_f32_32x32x16_bf16(PAF(1),VFR(1),o[0],0,0,0), C0,4);  VRD2(1); SBAR(); \
    GAPB2(o[1]=__builtin_amdgcn_mfma_f32_32x32x16_bf16(PAF(1),VFR(5),o[1],0,0,0), C0,6);  VRD2(5); SBAR(); \
    GAPB2(o[0]=__builtin_amdgcn_mfma_f32_32x32x16_bf16(PAF(2),VFR(2),o[0],0,0,0), C0,8);  VRD2(2); SBAR(); \
    GAPB2(o[1]=__builtin_amdgcn_mfma_f32_32x32x16_bf16(PAF(2),VFR(6),o[1],0,0,0), C0,10); VRD2(6); SBAR(); \
    GAPB2(o[0]=__builtin_amdgcn_mfma_f32_32x32x16_bf16(PAF(3),VFR(3),o[0],0,0,0), C0,12); VRD2(3); SBAR(); \
    GAPB2(o[1]=__builtin_amdgcn_mfma_f32_32x32x16_bf16(PAF(3),VFR(7),o[1],0,0,0), C0,14); VRD2(7); SBAR(); \
    GAPB2(o[2]=__builtin_amdgcn_mfma_f32_32x32x16_bf16(PAF(0),VFR(0),o[2],0,0,0), C1,0); \
    GAPB2(o[3]=__builtin_amdgcn_mfma_f32_32x32x16_bf16(PAF(0),VFR(4),o[3],0,0,0), C1,2); \
    KRD(GL,0); GAPB2(o[2]=__builtin_amdgcn_mfma_f32_32x32x16_bf16(PAF(1),VFR(1),o[2],0,0,0), C1,4); \
    KRD(GL,1); GAPB2(o[3]=__builtin_amdgcn_mfma_f32_32x32x16_bf16(PAF(1),VFR(5),o[3],0,0,0), C1,6); \
    KRD(GL,2); GAPB2(o[2]=__builtin_amdgcn_mfma_f32_32x32x16_bf16(PAF(2),VFR(2),o[2],0,0,0), C1,8); \
    KRD(GL,3); GAPB2(o[3]=__builtin_amdgcn_mfma_f32_32x32x16_bf16(PAF(2),VFR(6),o[3],0,0,0), C1,10); \
    GAPB2(o[2]=__builtin_amdgcn_mfma_f32_32x32x16_bf16(PAF(3),VFR(3),o[2],0,0,0), C1,12); \
    GAPB2(o[3]=__builtin_amdgcn_mfma_f32_32x32x16_bf16(PAF(3),VFR(7),o[3],0,0,0), C1,14); \
    }while(0)
  int t=1;
  #undef CMASK
  #define CMASK(P0,P1,t) do{}while(0)
  for(;t+5<NT;t+=2){
    STEP(pB0,pB1,pA0,pA1,t,true,true,true);     WAIT_BAR(3); RESC(); ROT();
    STEP(pA0,pA1,pB0,pB1,t+1,true,true,true);   WAIT_BAR(3); RESC(); ROT();
  }
  #undef CMASK
  #define CMASK(P0,P1,t) do{int jb_=(t)-(NT-4); if(jb_>=0)cmask(P0,P1,jb_,qrel,hi);}while(0)
  #define ENDW(tt) do{ if((tt)+3<NT){WAIT_BAR(3);} else if((tt)+2<NT){WAIT_BAR(2);} else {WAIT_BAR(0);} }while(0)
  for(;t+1<NT;t+=2){
    STEP(pB0,pB1,pA0,pA1,t,(t+3<NT),(t+1<NT),(t+1<NT));       ENDW(t);   RESC(); ROT();
    STEP(pA0,pA1,pB0,pB1,t+1,(t+4<NT),(t+2<NT),(t+2<NT));     ENDW(t+1); RESC(); ROT();
  }
  int snext=0;
  if(Knext!=nullptr){
    const int p0=sl_next,p1=NXT_(p0),p2=NXT_(p1); snext=p0;
    const bf16*kn=Knext+(long)lane*KP+wid*8; const bf16*vn=Vnext+(long)(16*(wid&3)+(lane>>2))*VP+(wid>>2)*32+(lane&3)*8;
    glds16(kn,(unsigned)__builtin_amdgcn_readfirstlane(kdst+p0));
    glds16(vn,(unsigned)__builtin_amdgcn_readfirstlane(vdst+2*p0)); glds16(vn+64,(unsigned)__builtin_amdgcn_readfirstlane(vdst+2*p0+8192));
    glds16(kn+(long)KVBLK*KP,(unsigned)__builtin_amdgcn_readfirstlane(kdst+p1)); glds16(kn+(long)2*KVBLK*KP,(unsigned)__builtin_amdgcn_readfirstlane(kdst+p2)); }
  STEP(pB0,pB1,pA0,pA1,NT-1,false,false,false); RESC();
  { float sacc=pB0[0]+pB0[1]; _Pragma("unroll") for(int r=2;r<16;++r)sacc+=pB0[r]; _Pragma("unroll") for(int r=0;r<16;++r)sacc+=pB1[r]; l_reg+=sacc;
    pw0=(u32x4){PKW(pB0,0),PKW(pB0,2),PKW(pB0,4),PKW(pB0,6)};pw1=(u32x4){PKW(pB0,8),PKW(pB0,10),PKW(pB0,12),PKW(pB0,14)};pw2=(u32x4){PKW(pB1,0),PKW(pB1,2),PKW(pB1,4),PKW(pB1,6)};pw3=(u32x4){PKW(pB1,8),PKW(pB1,10),PKW(pB1,12),PKW(pB1,14)};
    SBAR(); pv(o,vb0+2*sl_cur,PAF(0),PAF(1),PAF(2),PAF(3)); }
  #undef PKW
  #undef PAF
  #undef VFR
  #undef PIN
  #undef MX3
  #undef GAPA
  #undef GAPB2
  #undef VRD2
  #undef EX
  #undef VRD
  #undef KRD
  #undef STEP
  #undef ENDW
  {auto rr=__builtin_amdgcn_permlane32_swap(__float_as_uint(l_reg),__float_as_uint(l_reg),false,false);l_reg=__uint_as_float(rr[0])+__uint_as_float(rr[1]);}
  if(hi==0)wsf[32+r32]=l_reg;asm volatile("s_waitcnt lgkmcnt(0)":::"memory");
  float rli[16];
  #pragma unroll
  for(int r=0;r<16;++r)rli[r]=__builtin_amdgcn_rcpf(wsf[32+crow(r,hi)]);
  bf16*Ow=O+(long)(q0+wid*QBLK)*OP;
  bf16*stg=(bf16*)(shm+LDS_OST)+wid*2048;
  if(O1==nullptr){
    #pragma unroll
    for(int hf=0;hf<2;++hf){
      #pragma unroll
      for(int r=0;r<16;++r){const int orow=crow(r,hi);
        #pragma unroll
        for(int d0=0;d0<2;++d0)stg[orow*64+d0*32+r32]=__float2bfloat16(o[2*hf+d0][r]*rli[r]);}
      asm volatile("s_waitcnt lgkmcnt(0)":::"memory");
      #pragma unroll
      for(int i=0;i<4;++i){const int row=i*8+(lane>>3),ch=lane&7; const u32x4 v=*(const u32x4*)(stg+row*64+ch*8); ATTN_STORE16(Ow+(long)row*OP+hf*64+ch*8,v);}
      asm volatile("s_waitcnt lgkmcnt(0)":::"memory"); }
  } else {
    const bf16*O1w=O1+(long)(q0+wid*QBLK)*OP; unsigned long long p1[2][4][2];
    #pragma unroll
    for(int hf=0;hf<2;++hf)
      #pragma unroll
      for(int i=0;i<4;++i){const int row=i*8+(lane>>3),ch=lane&7; unsigned long long*a=(unsigned long long*)(O1w+(long)row*OP+hf*64+ch*8);
        p1[hf][i][0]=__hip_atomic_load(a,__ATOMIC_RELAXED,__HIP_MEMORY_SCOPE_AGENT); p1[hf][i][1]=__hip_atomic_load(a+1,__ATOMIC_RELAXED,__HIP_MEMORY_SCOPE_AGENT);}
    float dd[2][4][8]; float ssp[4]={0.f,0.f,0.f,0.f};
    #pragma unroll
    for(int hf=0;hf<2;++hf){
      #pragma unroll
      for(int r=0;r<16;++r){const int orow=crow(r,hi);
        #pragma unroll
        for(int d0=0;d0<2;++d0)stg[orow*64+d0*32+r32]=__float2bfloat16(o[2*hf+d0][r]*rli[r]);}
      asm volatile("s_waitcnt lgkmcnt(0)":::"memory");
      #pragma unroll
      for(int i=0;i<4;++i){const int row=i*8+(lane>>3),ch=lane&7; const u32x4 v=*(const u32x4*)(stg+row*64+ch*8);
        const unsigned w1[4]={(unsigned)p1[hf][i][0],(unsigned)(p1[hf][i][0]>>32),(unsigned)p1[hf][i][1],(unsigned)(p1[hf][i][1]>>32)};
        #pragma unroll
        for(int j=0;j<4;++j){ const float a0=__uint_as_float(w1[j]<<16)-lam*__uint_as_float(v[j]<<16), a1=__uint_as_float(w1[j]&0xffff0000u)-lam*__uint_as_float(v[j]&0xffff0000u);
          dd[hf][i][2*j]=a0; dd[hf][i][2*j+1]=a1; ssp[i]+=a0*a0+a1*a1; } }
      asm volatile("s_waitcnt lgkmcnt(0)":::"memory"); }
    #pragma unroll
    for(int i=0;i<4;++i){ float ss=ssp[i]; ss+=__shfl_xor(ss,1); ss+=__shfl_xor(ss,2); ss+=__shfl_xor(ss,4);
      const float rn=1.0f/sqrtf(ss*(1.0f/128.0f)+1e-6f)*0.8f;
      const int row=i*8+(lane>>3),ch=lane&7;
      #pragma unroll
      for(int hf=0;hf<2;++hf){ const float*gp=subg+hf*64+ch*8; u32x4 w;
        w[0]=cvtpk_s(dd[hf][i][0]*rn*gp[0],dd[hf][i][1]*rn*gp[1]); w[1]=cvtpk_s(dd[hf][i][2]*rn*gp[2],dd[hf][i][3]*rn*gp[3]);
        w[2]=cvtpk_s(dd[hf][i][4]*rn*gp[4],dd[hf][i][5]*rn*gp[5]); w[3]=cvtpk_s(dd[hf][i][6]*rn*gp[6],dd[hf][i][7]*rn*gp[7]);
        *(u32x4*)(CAo+(long)(q0+wid*QBLK+row)*1024+hf*64+ch*8)=w; } }
  }
  asm volatile("s_waitcnt lgkmcnt(0)\n\ts_barrier":::"memory");
  #undef DMA_K
  #undef DMA_V
  #undef CMASK
  #undef START
  #undef RESC
  #undef ROT
  #undef NXT_
  return snext;
}
constexpr int ATTN_LDS_BYTES=LDS_BYTES;
#undef SBAR
#undef WAIT_BAR
}

constexpr int NWAVES = 8, NTHREADS = NWAVES * 64;
#ifndef MK_PER_PHASE
#define MK_PER_PHASE 0
#endif
#ifndef RUN_PHASES
#define RUN_PHASES 8
#endif
constexpr int N_PHASES = RUN_PHASES;

constexpr size_t MiB = 1u << 20;
constexpr size_t WS_CTL = 0, CTL_ZERO_BYTES = 65536;
constexpr size_t WS_RS = 1 * MiB;
constexpr size_t WS_TINFO = 2 * MiB;
constexpr size_t WS_WR = 3 * MiB;
constexpr size_t WS_LTOK = 4 * MiB, WS_LW = 8 * MiB;
constexpr size_t WS_WIN = 16 * MiB, WS_WCA = 25 * MiB, WS_WOUT = 27 * MiB;
constexpr size_t WS_A = 32 * MiB;
constexpr size_t WS_QB = 112 * MiB, WS_KB = 144 * MiB, WS_VB = 176 * MiB, WS_YG = 208 * MiB;
constexpr size_t WS_MG = 112 * MiB, WS_XM = 176 * MiB;
constexpr size_t WS_GT = 240 * MiB;
constexpr size_t WS_WGU = 240 * MiB, WS_WD = 304 * MiB;
constexpr size_t WS_CA = 368 * MiB;
constexpr size_t WS_YB = 112 * MiB;
constexpr size_t WS_LIST = 432 * MiB;
constexpr size_t WS_CTOK = 448 * MiB;
constexpr size_t WS_END = 464 * MiB;
static_assert(WS_A + (size_t)CROWS * 1024 <= WS_QB && WS_WD + (size_t)NEXP * 1024 * 512 <= WS_CA, "d_ws map");
static_assert(WS_WIN + (size_t)IN_COLS * 1024 * 2 <= WS_WCA, "d_ws map");

constexpr int RING_BYTES = 131072;
constexpr int META_OFF = RING_BYTES;
constexpr int HIST_OFF = RING_BYTES + 1024;
constexpr int BARST_OFF = RING_BYTES + 3072;
constexpr int META2_OFF = RING_BYTES + 4096;
constexpr int LDS_BYTES = 147456;

#define GAS __attribute__((address_space(1)))
#define LAS __attribute__((address_space(3)))
typedef unsigned short bf16;
typedef unsigned v4u __attribute__((ext_vector_type(4)));
typedef unsigned v2u __attribute__((ext_vector_type(2)));
typedef float f32x4 __attribute__((ext_vector_type(4)));
typedef float f32x16 __attribute__((ext_vector_type(16)));
typedef short bf16x8 __attribute__((ext_vector_type(8)));
using pg8::cvt_pk_bf16; using pg8::bf_lo; using pg8::bf_hi; using pg8::sigmoidf_fast; using pg8::pack8; using pg8::unpack8;

__device__ __forceinline__ float wave_sum(float v) {
    v += __int_as_float(__builtin_amdgcn_update_dpp(0, __float_as_int(v), 0xB1, 0xf, 0xf, true));
    v += __int_as_float(__builtin_amdgcn_update_dpp(0, __float_as_int(v), 0x4E, 0xf, 0xf, true));
    v += __int_as_float(__builtin_amdgcn_update_dpp(0, __float_as_int(v), 0x141, 0xf, 0xf, true));
    v += __int_as_float(__builtin_amdgcn_update_dpp(0, __float_as_int(v), 0x140, 0xf, 0xf, true));
    const int iv = __float_as_int(v);
    return (__int_as_float(__builtin_amdgcn_readlane(iv, 0)) + __int_as_float(__builtin_amdgcn_readlane(iv, 16))) + (__int_as_float(__builtin_amdgcn_readlane(iv, 32)) + __int_as_float(__builtin_amdgcn_readlane(iv, 48)));
}
__device__ __forceinline__ float bf16_round(float x) { return bf_lo(cvt_pk_bf16(x, 0.f) & 0xffffu); }

#define XB_TMO      128
#define XB_XCNT(j)  (256  + 64 * (j))
#define XB_XSUB(j)  (1280 + 64 * (j))
#define XB_XGEN(j)  (2304 + 64 * (j))
#define XB_TOP      3328
#define XB_TOPGEN   3392
#define XCD_BAR_WORDS 3456
#define XB_SPIN_CAP (1u << 18)

__device__ __forceinline__ unsigned xb_ld(unsigned* p)              { return __hip_atomic_load(p, __ATOMIC_RELAXED, __HIP_MEMORY_SCOPE_AGENT); }
__device__ __forceinline__ unsigned xb_add(unsigned* p, unsigned v) { return __hip_atomic_fetch_add(p, v, __ATOMIC_RELAXED, __HIP_MEMORY_SCOPE_AGENT); }
__device__ __forceinline__ unsigned xb_xcc_id() { return (unsigned)__builtin_amdgcn_s_getreg((3 << 11) | 20) & 0xFu; }
#define XB_SPIN(cond, bar) do { unsigned _sp = 0; while (cond) { __builtin_amdgcn_s_sleep(1); \
    if ((++_sp & 255u) == 0u) { if (xb_ld(&(bar)[XB_TMO])) break; if (_sp > XB_SPIN_CAP) { atomicAdd(&(bar)[XB_TMO], 1u); break; } } } } while (0)

struct XcdBarrier {
    unsigned* bar; unsigned x;
    volatile LAS unsigned* st;
};

__device__ __forceinline__ XcdBarrier xcd_barrier_post(unsigned* bar, volatile LAS unsigned* st) {
    XcdBarrier b; b.bar = bar; b.x = xb_xcc_id(); b.st = st;
    if (threadIdx.x == 0) (void)xb_add(&bar[XB_XCNT(b.x)], 1u);
    return b;
}
__device__ __forceinline__ void xcd_barrier_complete(unsigned* bar, unsigned x, unsigned& nloc, unsigned& nx) {
    const unsigned G = gridDim.x * gridDim.y * gridDim.z;
    unsigned sum, cnt, mine, sp = 0u;
    for (;;) {
        sum = 0u; cnt = 0u; mine = 0u;
#pragma unroll
        for (unsigned j = 0; j < 16; ++j) { const unsigned c = xb_ld(&bar[XB_XCNT(j)]); sum += c; cnt += (c > 0u) ? 1u : 0u; mine = (j == x) ? c : mine; }
        if (sum == G) break;
        __builtin_amdgcn_s_sleep(1);
        if ((++sp & 255u) == 0u) { if (xb_ld(&bar[XB_TMO])) break; if (sp > XB_SPIN_CAP) { atomicAdd(&bar[XB_TMO], 1u); break; } }
    }
    nloc = mine > 0u ? mine : 1u; nx = cnt > 0u ? cnt : 1u;
}

__device__ __forceinline__ void xcd_barrier(const XcdBarrier& b) {
    asm volatile("s_waitcnt vmcnt(0)" ::: "memory");
    __syncthreads();
    if (threadIdx.x == 0) {
        unsigned* bar = b.bar;
        __builtin_amdgcn_s_waitcnt(0);
        unsigned nloc = b.st[0], nx = b.st[1];
        if (nloc == 0u) { xcd_barrier_complete(bar, b.x, nloc, nx); b.st[0] = nloc; b.st[1] = nx; }
        const unsigned old = xb_add(&bar[XB_XSUB(b.x)], 1u);
        const unsigned gen = old / nloc;
        if (old + 1u == (gen + 1u) * nloc) {
            __builtin_amdgcn_fence(__ATOMIC_RELEASE, "agent");
            asm volatile("s_waitcnt vmcnt(0)" ::: "memory");
            const unsigned og = xb_add(&bar[XB_TOP], 1u);
            const unsigned tg = og / nx;
            if (og + 1u == (tg + 1u) * nx) xb_add(&bar[XB_TOPGEN], 1u);
            else XB_SPIN(xb_ld(&bar[XB_TOPGEN]) == tg, bar);
            __builtin_amdgcn_fence(__ATOMIC_ACQUIRE, "agent");
            xb_add(&bar[XB_XGEN(b.x)], 1u);
            asm volatile("s_waitcnt vmcnt(0)" ::: "memory");
        } else {
            XB_SPIN(xb_ld(&bar[XB_XGEN(b.x)]) == gen, bar);
            __builtin_amdgcn_fence(__ATOMIC_ACQUIRE, "agent");
            asm volatile("s_waitcnt vmcnt(0)" ::: "memory");
        }
    }
    __syncthreads();
}


typedef f32x4 AccT[2][2][4][2];
struct EpiInProj {
    static constexpr bool MID = false;
    bf16 *YG, *QB, *KB, *VB, *GT; const LAS float* gl;
    __device__ __forceinline__ void mid(AccT&, const pg8::Unit&, int, int, int, int) const {}
    __device__ __forceinline__ void operator()(AccT& acc, const pg8::Unit& u, int wr, int wc, int fr, int fq) const {
        asm volatile("" : "+v"(fr), "+v"(fq));
        const int pn = u.pn; const size_t row0 = (size_t)u.orow + wr * 64 + fr;
        if (pn < 4) {
#pragma unroll
            for (int ai = 0; ai < 2; ++ai)
#pragma unroll
                for (int m = 0; m < 4; ++m) { const size_t row = row0 + ai * 128 + m * 16; f32x4 y[2];
#pragma unroll
                    for (int n = 0; n < 2; ++n) { const f32x4 a = acc[ai][0][m][n], g = acc[ai][1][m][n];
                        y[n] = (f32x4){a[0] * sigmoidf_fast(g[0]), a[1] * sigmoidf_fast(g[1]), a[2] * sigmoidf_fast(g[2]), a[3] * sigmoidf_fast(g[3])}; }
                    __builtin_nontemporal_store(pack8(y[0], y[1]), (v4u*)(YG + row * 512 + pn * 128 + wc * 32 + 8 * fq)); }
        } else if (pn < 8) {
            const bool isq = pn < 6; bf16* base = isq ? QB : KB; const LAS float* gp = gl + (isq ? 0 : 64); const float sc = isq ? 0.125f * 1.4426950408889634f : 1.0f;
            f32x4 gv[2][2];
#pragma unroll
            for (int bj = 0; bj < 2; ++bj)
#pragma unroll
                for (int n = 0; n < 2; ++n) gv[bj][n] = *(const LAS f32x4*)(gp + 32 * bj + 8 * fq + 4 * n) * sc;
#pragma unroll
            for (int ai = 0; ai < 2; ++ai)
#pragma unroll
                for (int m = 0; m < 4; ++m) { const size_t row = row0 + ai * 128 + m * 16; float ss = 0.f;
#pragma unroll
                    for (int bj = 0; bj < 2; ++bj)
#pragma unroll
                        for (int n = 0; n < 2; ++n) { const f32x4 a = acc[ai][bj][m][n]; ss += (a[0] * a[0] + a[1] * a[1]) + (a[2] * a[2] + a[3] * a[3]); }
                    ss += __shfl_xor(ss, 16); ss += __shfl_xor(ss, 32);
                    const float rinv = 1.0f / sqrtf(ss * (1.0f / 64.0f) + EPS);
#pragma unroll
                    for (int bj = 0; bj < 2; ++bj)
                        __builtin_nontemporal_store(pack8(acc[ai][bj][m][0] * rinv * gv[bj][0], acc[ai][bj][m][1] * rinv * gv[bj][1]), (v4u*)(base + row * 512 + (pn & 1) * 256 + wc * 64 + bj * 32 + 8 * fq)); }
        } else if (pn < 10) {
#pragma unroll
            for (int ai = 0; ai < 2; ++ai)
#pragma unroll
                for (int m = 0; m < 4; ++m) { const size_t row = row0 + ai * 128 + m * 16;
#pragma unroll
                    for (int bj = 0; bj < 2; ++bj) __builtin_nontemporal_store(pack8(acc[ai][bj][m][0], acc[ai][bj][m][1]), (v4u*)(VB + row * 512 + (pn - 8) * 256 + bj * 128 + wc * 32 + 8 * fq)); }
        } else {
#pragma unroll
            for (int ai = 0; ai < 2; ++ai)
#pragma unroll
                for (int m = 0; m < 4; ++m) { const size_t row = row0 + ai * 128 + m * 16; f32x4 rr[2], gg[2];
#pragma unroll
                    for (int n = 0; n < 2; ++n)
#pragma unroll
                        for (int j = 0; j < 4; ++j) { const float e0 = __builtin_amdgcn_exp2f(-1.4426950408889634f * acc[ai][0][m][n][j]), e1 = fminf(__builtin_amdgcn_exp2f(-1.4426950408889634f * acc[ai][1][m][n][j]), 1e30f);
                            gg[n][j] = __builtin_amdgcn_rcpf(1.0f + e1); rr[n][j] = (1.0f + e1) * __builtin_amdgcn_rcpf(1.0f + e0); }
                    const size_t o = row * 1024 + (pn - 10) * 128 + wc * 32 + 8 * fq;
                    __builtin_nontemporal_store(pack8(rr[0], rr[1]), (v4u*)(GT + o)); __builtin_nontemporal_store(pack8(gg[0], gg[1]), (v4u*)(GT + (size_t)NTOK * 1024 + o)); }
        }
    }
};
struct EpiMerged {
    static constexpr bool MID = true;
    const bf16* GR; const bf16* G1; bf16* MG;
    __device__ __forceinline__ void mid(AccT& acc, const pg8::Unit& u, int wr, int wc, int fr, int fq) const {
        asm volatile("" : "+v"(fr), "+v"(fq));
        const size_t row0 = (size_t)u.orow + wr * 64 + fr; const int col0 = u.pn * 256 + wc * 32 + 8 * fq;
        v4u w0[2][4][2];
#pragma unroll
        for (int ai = 0; ai < 2; ++ai)
#pragma unroll
            for (int m = 0; m < 4; ++m)
#pragma unroll
                for (int bj = 0; bj < 2; ++bj) w0[ai][m][bj] = *(const v4u*)(GR + (row0 + ai * 128 + m * 16) * 1024 + col0 + bj * 128);
        __builtin_amdgcn_sched_barrier(0);
#pragma unroll
        for (int ai = 0; ai < 2; ++ai)
#pragma unroll
            for (int m = 0; m < 4; ++m)
#pragma unroll
                for (int bj = 0; bj < 2; ++bj) { f32x4 a0, a1; unpack8(w0[ai][m][bj], a0, a1); acc[ai][bj][m][0] = acc[ai][bj][m][0] * a0; acc[ai][bj][m][1] = acc[ai][bj][m][1] * a1; }
        __builtin_amdgcn_sched_barrier(0);
    }
    __device__ __forceinline__ void operator()(AccT& acc, const pg8::Unit& u, int wr, int wc, int fr, int fq) const {
        asm volatile("" : "+v"(fr), "+v"(fq));
        const size_t row0 = (size_t)u.orow + wr * 64 + fr; const int col0 = u.pn * 256 + wc * 32 + 8 * fq;
        v4u w1[2][4][2];
#pragma unroll
        for (int ai = 0; ai < 2; ++ai)
#pragma unroll
            for (int m = 0; m < 4; ++m)
#pragma unroll
                for (int bj = 0; bj < 2; ++bj) w1[ai][m][bj] = *(const v4u*)(G1 + (row0 + ai * 128 + m * 16) * 1024 + col0 + bj * 128);
        __builtin_amdgcn_sched_barrier(0);
#pragma unroll
        for (int ai = 0; ai < 2; ++ai)
#pragma unroll
            for (int m = 0; m < 4; ++m) { const size_t row = row0 + ai * 128 + m * 16;
#pragma unroll
                for (int bj = 0; bj < 2; ++bj) { f32x4 b0, b1; unpack8(w1[ai][m][bj], b0, b1);
                    *(v4u*)(MG + row * 1024 + col0 + bj * 128) = pack8(acc[ai][bj][m][0] * b0, acc[ai][bj][m][1] * b1); } }
    }
};
struct EpiOut {
    static constexpr bool MID = false;
    const float* x; bf16* XMB; unsigned char* XM8;
    __device__ __forceinline__ void mid(AccT&, const pg8::Unit&, int, int, int, int) const {}
    __device__ __forceinline__ void operator()(AccT& acc, const pg8::Unit& u, int wr, int wc, int fr, int fq) const {
        asm volatile("" : "+v"(fr), "+v"(fq));
        const size_t row0 = (size_t)u.orow + wr * 64 + fr; const int col0 = u.pn * 256 + wc * 32 + 8 * fq;
#pragma unroll
        for (int ai = 0; ai < 2; ++ai) {
            f32x4 xv[4][2][2];
#pragma unroll
            for (int m = 0; m < 4; ++m) { const size_t off = (row0 + ai * 128 + m * 16) * 1024 + col0;
#pragma unroll
                for (int bj = 0; bj < 2; ++bj) { xv[m][bj][0] = __builtin_nontemporal_load((const f32x4*)(x + off + bj * 128)); xv[m][bj][1] = __builtin_nontemporal_load((const f32x4*)(x + off + bj * 128 + 4)); } }
            __builtin_amdgcn_sched_barrier(0);
#pragma unroll
            for (int m = 0; m < 4; ++m) { const size_t off = (row0 + ai * 128 + m * 16) * 1024 + col0;
#pragma unroll
                for (int bj = 0; bj < 2; ++bj) { const f32x4 o0 = xv[m][bj][0] + acc[ai][bj][m][0], o1 = xv[m][bj][1] + acc[ai][bj][m][1];
                    *(v4u*)(XMB + off + bj * 128) = pack8(o0, o1);
                    v2u w8; w8.x = pg8::pack4_fp8(o0[0], o0[1], o0[2], o0[3]); w8.y = pg8::pack4_fp8(o1[0], o1[1], o1[2], o1[3]); *(v2u*)(XM8 + off + bj * 128) = w8; } }
            __builtin_amdgcn_sched_barrier(0);
        }
    }
};
struct EpiGateUp {
    static constexpr bool MID = false;
    const int* LIST; unsigned char* HP8; const LAS int* m2;
    __device__ __forceinline__ void mid(AccT&, const pg8::Unit&, int, int, int, int) const {}
    __device__ __forceinline__ void operator()(AccT& acc, const pg8::Unit& u, int wr, int wc, int fr, int fq) const {
        asm volatile("" : "+v"(fr), "+v"(fq));
        typedef int i32x4 __attribute__((ext_vector_type(4)));
        i32x4 ent[2][4];
#pragma unroll
        for (int ai = 0; ai < 2; ++ai)
#pragma unroll
            for (int m = 0; m < 4; ++m) { const int r = ai * 128 + wr * 64 + m * 16 + fr; ent[ai][m] = (r < u.nvalid) ? *(const i32x4*)(LIST + (size_t)(u.lrow + r) * 4) : (i32x4){-1, 0, 0, 0}; }
#pragma unroll
        for (int ai = 0; ai < 2; ++ai)
#pragma unroll
            for (int m = 0; m < 4; ++m) { const i32x4 en = ent[ai][m]; if (en[0] < 0) continue;
                const float rs = __int_as_float(en[3]) * (1.0f / 64.0f), w8 = __int_as_float(en[2]) * 8.0f;
                const int dst = en[1]; const size_t drow = (size_t)m2[dst >> 17] * 256 + ((dst >> 1) & 0xffff);
                float h[8];
#pragma unroll
                for (int n = 0; n < 2; ++n)
#pragma unroll
                    for (int j = 0; j < 4; ++j) { const float g = acc[ai][0][m][n][j] * rs, up = acc[ai][1][m][n][j] * rs; h[4 * n + j] = __builtin_amdgcn_fmed3f(g * sigmoidf_fast(g) * up * w8, -448.f, 448.f); }
                v2u o8; o8.x = pg8::pack4_fp8(h[0], h[1], h[2], h[3]); o8.y = pg8::pack4_fp8(h[4], h[5], h[6], h[7]);
                *(v2u*)(HP8 + drow * 1024 + (dst & 1) * 512 + u.pn * 128 + wc * 32 + 8 * fq) = o8; }
    }
};
struct EpiDownAdd {
    static constexpr bool MID = false;
    const int* CTOK; const bf16* XMB; float* out;
    __device__ __forceinline__ void mid(AccT&, const pg8::Unit&, int, int, int, int) const {}
    __device__ __forceinline__ void operator()(AccT& acc, const pg8::Unit& u, int wr, int wc, int fr, int fq) const {
        asm volatile("" : "+v"(fr), "+v"(fq));
        const int col0 = u.pn * 256 + wc * 32 + 8 * fq;
        int tokall[2][4];
#pragma unroll
        for (int ai = 0; ai < 2; ++ai)
#pragma unroll
            for (int m = 0; m < 4; ++m) { const int r = ai * 128 + wr * 64 + m * 16 + fr; tokall[ai][m] = (r < u.nvalid) ? CTOK[u.lrow + r] : -1; }
        v4u xw[2][4][2];
#pragma unroll
        for (int ai = 0; ai < 2; ++ai)
#pragma unroll
            for (int m = 0; m < 4; ++m) { const int tk = tokall[ai][m]; const size_t off = (size_t)(tk < 0 ? 0 : tk) * 1024 + col0;
#pragma unroll
                for (int bj = 0; bj < 2; ++bj) xw[ai][m][bj] = *(const v4u*)(XMB + off + bj * 128); }
        __builtin_amdgcn_sched_barrier(0);
#pragma unroll
        for (int ai = 0; ai < 2; ++ai)
#pragma unroll
            for (int m = 0; m < 4; ++m) { const int tk = tokall[ai][m]; if (tk < 0) continue; const size_t off = (size_t)tk * 1024 + col0;
#pragma unroll
                for (int bj = 0; bj < 2; ++bj) { f32x4 x0, x1; unpack8(xw[ai][m][bj], x0, x1);
                    __builtin_nontemporal_store(x0 + acc[ai][bj][m][0] * (1.0f / 256.0f), (f32x4*)(out + off + bj * 128)); __builtin_nontemporal_store(x1 + acc[ai][bj][m][1] * (1.0f / 256.0f), (f32x4*)(out + off + bj * 128 + 4)); } }
    }
};
struct MoeOrder {
    int G, c, total; const LAS int* meta;
    __device__ __forceinline__ bool next(int i, pg8::Unit& u) const {
        const int L = i * G + c; if (L >= total * 4) return false;
        const int blk = L >> 2, lane = threadIdx.x & 63;
        const int e = __builtin_amdgcn_readfirstlane(__builtin_popcountll(__ballot(lane < NEXP - 1 && meta[1 + lane] <= blk)));
        const int pre = __builtin_amdgcn_readfirstlane(meta[e]), cnt = __builtin_amdgcn_readfirstlane(meta[64 + e]); const int rb = blk - pre;
        u.pn = L & 3; u.pm = rb; u.e = e; u.e2 = e; u.lrow = e * LCAP + rb * 256; u.nvalid = min(256, cnt - rb * 256); u.orow = blk * 256; u.arow = 0; return true;
    }
};
struct ClassOrder {
    int G, c, total; const LAS int* m2;
    __device__ __forceinline__ bool next(int i, pg8::Unit& u) const {
        const int L = i * G + c; if (L >= total * 4) return false;
        const int blk = L >> 2, lane = threadIdx.x & 63;
        const int n0 = __builtin_popcountll(__ballot(m2[1 + lane] <= blk)), n1 = __builtin_popcountll(__ballot(lane + 65 <= NCLS - 1 && m2[65 + lane] <= blk));
        const int cls = __builtin_amdgcn_readfirstlane(n0 + n1);
        const int pre = __builtin_amdgcn_readfirstlane(m2[cls]), cnt = __builtin_amdgcn_readfirstlane(m2[128 + cls]); const int rb = blk - pre;
        const int g = cls / 28; int p = cls % 28, a = 0;
        while (p >= 7 - a) { p -= 7 - a; ++a; }
        u.e = g * 8 + a; u.e2 = g * 8 + a + 1 + p; u.pn = L & 3; u.pm = rb; u.lrow = cls * NTOK + rb * 256; u.nvalid = min(256, cnt - rb * 256); u.orow = blk * 256; u.arow = u.orow; return true;
    }
};
__device__ __forceinline__ void moe_meta(LAS int* meta, LAS int* m2, const unsigned* ctl) {
    const int tid = threadIdx.x;
    if (tid < NEXP) meta[64 + tid] = (int)__hip_atomic_load(ctl + tid, __ATOMIC_RELAXED, __HIP_MEMORY_SCOPE_AGENT);
    if (tid >= 64 && tid < 64 + NCLS) m2[128 + tid - 64] = (int)__hip_atomic_load(ctl + tid, __ATOMIC_RELAXED, __HIP_MEMORY_SCOPE_AGENT);
    __syncthreads();
    if (tid == 0) { int p = 0;
        for (int e = 0; e < NEXP; ++e) { meta[e] = p; p += (meta[64 + e] + 255) >> 8; }
        meta[NEXP] = p; }
    if (tid == 64) { int p = 0;
        for (int c = 0; c < NCLS; ++c) { m2[c] = p; p += (m2[128 + c] + 255) >> 8; }
        m2[NCLS] = p; }
    __syncthreads();
}

__device__ __forceinline__ void transpose_item(const float* W, int N, int k0, int n0, bf16* WT, int dpitch, int drow0, int dcol0, const float* kscale, LAS float* scr, int lane) {
    const int kr = lane >> 3, nc = (lane & 7) * 4;
    f32x4 v[8];
#pragma unroll
    for (int i = 0; i < 8; ++i) v[i] = *(const f32x4*)(W + (size_t)(k0 + i * 8 + kr) * N + n0 + nc);
    if (kscale) {
#pragma unroll
        for (int i = 0; i < 8; ++i) v[i] = v[i] * kscale[k0 + i * 8 + kr]; }
#pragma unroll
    for (int i = 0; i < 8; ++i) { LAS float* d = scr + (i * 8 + kr) * 33 + nc; d[0] = v[i][0]; d[1] = v[i][1]; d[2] = v[i][2]; d[3] = v[i][3]; }
    asm volatile("s_waitcnt lgkmcnt(0)" ::: "memory");
    const int c = lane & 7;
#pragma unroll
    for (int j = 0; j < 4; ++j) { const int n = (lane >> 3) + 8 * j; const LAS float* s = scr + (8 * c) * 33 + n;
        v4u o; o.x = cvt_pk_bf16(s[0 * 33], s[1 * 33]); o.y = cvt_pk_bf16(s[2 * 33], s[3 * 33]); o.z = cvt_pk_bf16(s[4 * 33], s[5 * 33]); o.w = cvt_pk_bf16(s[6 * 33], s[7 * 33]);
        *(v4u*)(WT + (size_t)(drow0 + n) * dpitch + dcol0 + k0 + 8 * c) = o; }
    asm volatile("s_waitcnt lgkmcnt(0)" ::: "memory");
}
__device__ __forceinline__ void transpose_item_fp8(const float* W, int N, int k0, int n0, unsigned char* WT, int dpitch, int drow0, const float* kscale, float mul, LAS float* scr, int lane) {
    const int kr = lane >> 3, nc = (lane & 7) * 4;
    f32x4 v[8];
#pragma unroll
    for (int i = 0; i < 8; ++i) v[i] = *(const f32x4*)(W + (size_t)(k0 + i * 8 + kr) * N + n0 + nc);
#pragma unroll
    for (int i = 0; i < 8; ++i) v[i] = v[i] * (kscale ? kscale[k0 + i * 8 + kr] * mul : mul);
#pragma unroll
    for (int i = 0; i < 8; ++i) { LAS float* d = scr + (i * 8 + kr) * 33 + nc; d[0] = v[i][0]; d[1] = v[i][1]; d[2] = v[i][2]; d[3] = v[i][3]; }
    asm volatile("s_waitcnt lgkmcnt(0)" ::: "memory");
    const int c = lane & 7;
#pragma unroll
    for (int j = 0; j < 4; ++j) { const int n = (lane >> 3) + 8 * j; const LAS float* s = scr + (8 * c) * 33 + n;
        v2u o; o.x = pg8::pack4_fp8(s[0 * 33], s[1 * 33], s[2 * 33], s[3 * 33]); o.y = pg8::pack4_fp8(s[4 * 33], s[5 * 33], s[6 * 33], s[7 * 33]);
        *(v2u*)(WT + (size_t)(drow0 + n) * dpitch + k0 + 8 * c) = o; }
    asm volatile("s_waitcnt lgkmcnt(0)" ::: "memory");
}
__device__ __forceinline__ int inproj_phys(int c) {
    if (c < 512) return (c >> 7) * 256 + (c & 127);
    if (c < 1024) { c -= 512; return (c >> 7) * 256 + 128 + (c & 127); }
    if (c < 2048) { const int sec = (c - 1024) >> 8, cl = (c - 1024) & 255, s = cl >> 6, d = cl & 63; return 1024 + sec * 256 + ((d >> 5) << 7) + (s << 5) + (d & 31); }
    if (c < 2560) return c;
    { int j = c - 2560; const int hi = j >= 1024; j &= 1023; return 2560 + (j >> 7) * 256 + hi * 128 + (j & 127); }
}
struct Ptrs {
    const float *x, *attn_norm_g, *w_in, *conv_dw_w, *conv_dw_b, *conv_ln_g, *conv_ln_b, *w_conv_out, *q_norm_g, *k_norm_g, *lq1, *lk1, *lq2, *lk2, *subln_g,
        *w_attn_out, *w_out, *ffn_norm_g, *w_rg, *b_rg, *w_re, *b_re, *w_gate, *w_up, *w_down;
    float* out; unsigned char* ws;
};

__device__ __forceinline__ void p0_prologue(const Ptrs& P, LAS unsigned char* lds, int vcu, int G) {
    const int tid = threadIdx.x, lane = tid & 63, wave = __builtin_amdgcn_readfirstlane(tid >> 6);
    LAS float* scr = (LAS float*)(lds + wave * 16384);
    const int gw = vcu * NWAVES + wave, NGW = G * NWAVES;
    bf16* WIN = (bf16*)(P.ws + WS_WIN); bf16* WCA = (bf16*)(P.ws + WS_WCA); bf16* WOUT = (bf16*)(P.ws + WS_WOUT);
    constexpr int I_IN = (DMODEL / 64) * (IN_COLS / 32), I_C = (CONV_CH / 64) * (DMODEL / 32), I_O = (DMODEL / 64) * (DMODEL / 32);
    for (int it = gw; it < I_IN + 2 * I_C + I_O; it += NGW) {
        int r = it;
        if (r < I_IN) { const int kb = r / (IN_COLS / 32), nb = r % (IN_COLS / 32); transpose_item(P.w_in, IN_COLS, kb * 64, nb * 32, WIN, 1024, inproj_phys(nb * 32), 0, nullptr, scr, lane); continue; } r -= I_IN;
        if (r < I_C) { const int kb = r / 32, nb = r % 32; transpose_item(P.w_conv_out, DMODEL, kb * 64, nb * 32, WCA, 1024, nb * 32, 0, nullptr, scr, lane); continue; } r -= I_C;
        if (r < I_C) { const int kb = r / 32, nb = r % 32; transpose_item(P.w_attn_out, DMODEL, kb * 64, nb * 32, WCA, 1024, nb * 32, 512, nullptr, scr, lane); continue; } r -= I_C;
        { const int kb = r / 32, nb = r % 32; transpose_item(P.w_out, DMODEL, kb * 64, nb * 32, WOUT, 1024, nb * 32, 0, nullptr, scr, lane); }
    }
    bf16* WRhi = (bf16*)(P.ws + WS_WR); bf16* WRlo = WRhi + 64 * 1024;
    for (int idx = vcu * NTHREADS + tid; idx < 64 * 1024; idx += G * NTHREADS) {
        const int n = idx >> 10, k = idx & 1023; float v = 0.f;
        if (n < 4) v = P.w_rg[k * 4 + n]; else if (n < 36) v = P.w_re[k * 32 + (n - 4)];
        v *= P.ffn_norm_g[k];
        const unsigned hb = cvt_pk_bf16(v, 0.f) & 0xffffu; const float hf = __uint_as_float(hb << 16);
        WRhi[idx] = (bf16)hb; WRlo[idx] = (bf16)(cvt_pk_bf16(v - hf, 0.f) & 0xffffu);
    }
    bf16* HB = (bf16*)(P.ws + WS_A);
    f32x4 gq[4];
#pragma unroll
    for (int j = 0; j < 4; ++j) gq[j] = ((const f32x4*)P.attn_norm_g)[64 * j + lane];
    constexpr int RPT = 4;
    for (int m = gw; m < NTOK; m += RPT * NGW) {
        f32x4 v[RPT][4];
#pragma unroll
        for (int q = 0; q < RPT; ++q) { const int mq = m + q * NGW; const f32x4* xr = (const f32x4*)(P.x + (size_t)(mq < NTOK ? mq : m) * DMODEL) + lane;
#pragma unroll
            for (int j = 0; j < 4; ++j) v[q][j] = __builtin_nontemporal_load(xr + 64 * j); }
#pragma unroll
        for (int q = 0; q < RPT; ++q) { const int mq = m + q * NGW; float ss = 0.f;
#pragma unroll
            for (int j = 0; j < 4; ++j) ss += (v[q][j][0] * v[q][j][0] + v[q][j][1] * v[q][j][1]) + (v[q][j][2] * v[q][j][2] + v[q][j][3] * v[q][j][3]);
            const float r = 1.0f / sqrtf(wave_sum(ss) * (1.0f / DMODEL) + EPS);
            if (mq < NTOK) { v2u* o8 = (v2u*)(HB + (size_t)mq * DMODEL) + lane;
#pragma unroll
                for (int j = 0; j < 4; ++j) { const f32x4 y = v[q][j] * r * gq[j]; v2u w; w.x = cvt_pk_bf16(y[0], y[1]); w.y = cvt_pk_bf16(y[2], y[3]); o8[64 * j] = w; } } }
    }
}

__device__ __forceinline__ void conv_phase(const Ptrs& P, LAS unsigned char* lds, int first, int stride) {
    const int tid = threadIdx.x, lane = tid & 63, wave = __builtin_amdgcn_readfirstlane(tid >> 6);
    const bf16* YG = (const bf16*)(P.ws + WS_YG); bf16* CA = (bf16*)(P.ws + WS_CA);
    LAS bf16* yt = (LAS bf16*)lds; LAS float* co = (LAS float*)(lds + 62 * 1024);
    constexpr int NT = NTOK / 32;
    if (first >= NT) return;
    float w[CONV_W];
#pragma unroll
    for (int j = 0; j < CONV_W; ++j) w[j] = P.conv_dw_w[j * CONV_CH + tid];
    const float bias = P.conv_dw_b[tid];
    const f32x4 g0 = ((const f32x4*)P.conv_ln_g)[lane], g1 = ((const f32x4*)P.conv_ln_g)[64 + lane], b0 = ((const f32x4*)P.conv_ln_b)[lane], b1 = ((const f32x4*)P.conv_ln_b)[64 + lane];
    v4u pre[8];
#define CONV_FETCH(tile) do { const int b_ = (tile) / (SEQ / 32), t0_ = ((tile) % (SEQ / 32)) * 32; _Pragma("unroll") for (int p = 0; p < 8; ++p) { const int q = tid + NTHREADS * p; const int row = q >> 6, ch = q & 63, t = t0_ - 30 + row; \
        pre[p] = (v4u){0u, 0u, 0u, 0u}; if (q < 62 * 64 && t >= 0) pre[p] = *(const v4u*)(YG + ((size_t)(b_ * SEQ + t)) * 512 + ch * 8); } } while (0)
    CONV_FETCH(first);
    for (int tile = first; tile < NT; tile += stride) {
        const int b = tile / (SEQ / 32), t0 = (tile % (SEQ / 32)) * 32;
#pragma unroll
        for (int p = 0; p < 8; ++p) { const int q = tid + NTHREADS * p; if (q < 62 * 64) *(LAS v4u*)(yt + (q >> 6) * 512 + (q & 63) * 8) = pre[p]; }
        __syncthreads();
        if (tile + stride < NT) CONV_FETCH(tile + stride);
        float yv[62];
#pragma unroll
        for (int i = 0; i < 62; ++i) yv[i] = __uint_as_float((unsigned)yt[i * 512 + tid] << 16);
#pragma unroll
        for (int t = 0; t < 32; ++t) { float a = bias;
#pragma unroll
            for (int j = 0; j < CONV_W; ++j) a += w[j] * yv[t + j];
            co[t * 512 + tid] = a; }
        __syncthreads();
#pragma unroll
        for (int rr = 0; rr < 4; ++rr) { const int row = wave * 4 + rr;
            const f32x4 v0 = *(const LAS f32x4*)(co + row * 512 + lane * 4), v1 = *(const LAS f32x4*)(co + row * 512 + 256 + lane * 4);
            const float mean = wave_sum((v0[0] + v0[1]) + (v0[2] + v0[3]) + (v1[0] + v1[1]) + (v1[2] + v1[3])) * (1.0f / CONV_CH);
            const f32x4 d0 = v0 - mean, d1 = v1 - mean;
            const float var = wave_sum((d0[0] * d0[0] + d0[1] * d0[1]) + (d0[2] * d0[2] + d0[3] * d0[3]) + (d1[0] * d1[0] + d1[1] * d1[1]) + (d1[2] * d1[2] + d1[3] * d1[3])) * (1.0f / CONV_CH);
            const float rstd = 1.0f / sqrtf(var + EPS);
            f32x4 y0 = d0 * rstd * g0 + b0, y1 = d1 * rstd * g1 + b1;
#pragma unroll
            for (int j = 0; j < 4; ++j) { y0[j] = y0[j] * sigmoidf_fast(y0[j]); y1[j] = y1[j] * sigmoidf_fast(y1[j]); }
            bf16* orow = CA + ((size_t)(b * SEQ + t0 + row)) * 1024;
            v2u o0, o1; o0.x = cvt_pk_bf16(y0[0], y0[1]); o0.y = cvt_pk_bf16(y0[2], y0[3]); o1.x = cvt_pk_bf16(y1[0], y1[1]); o1.y = cvt_pk_bf16(y1[2], y1[3]);
            *(v2u*)(orow + lane * 4) = o0; *(v2u*)(orow + 256 + lane * 4) = o1; }
        __syncthreads();
    }
#undef CONV_FETCH
}

__device__ __forceinline__ void attn_pair(const Ptrs& P, LAS unsigned char* lds, char* lds_generic, int p) {
    const int tid = threadIdx.x, lane = tid & 63, wave = __builtin_amdgcn_readfirstlane(tid >> 6);
    const int bh = p >> 3, s = p & 7, b = bh >> 2, h = bh & 3;
    const __hip_bfloat16* QB = (const __hip_bfloat16*)(P.ws + WS_QB); const __hip_bfloat16* KB = (const __hip_bfloat16*)(P.ws + WS_KB); const __hip_bfloat16* VB = (const __hip_bfloat16*)(P.ws + WS_VB);
    __hip_bfloat16* OT = (__hip_bfloat16*)(P.ws + WS_A); bf16* CA = (bf16*)(P.ws + WS_CA);
    float mstat;
    { int l0 = lane; asm volatile("" : "+v"(l0));
      float a = fabsf(P.q_norm_g[l0]), b = fabsf(P.k_norm_g[l0]);
#pragma unroll
      for (int o = 1; o < 64; o <<= 1) { a = fmaxf(a, __shfl_xor(a, o)); b = fmaxf(b, __shfl_xor(b, o)); }
      mstat = __int_as_float(__builtin_amdgcn_readfirstlane(__float_as_int(0.125f * 1.4426950408889634f * 64.0f * 1.02f * a * b))); }
    float lam;
    { int l1 = lane; asm volatile("" : "+v"(l1));
      lam = __int_as_float(__builtin_amdgcn_readfirstlane(__float_as_int(__expf(wave_sum(P.lq1[l1] * P.lk1[l1])) - __expf(wave_sum(P.lq2[l1] * P.lk2[l1])) + 0.2f))); }
    int s0 = 0; bool pre = false;
#pragma unroll 1
    for (int u4 = 0; u4 < 4; ++u4) { const int i = u4 >> 1, c = u4 & 1;
        const int qb = (i == 0) ? s : 15 - s;
        const __hip_bfloat16* q_ = QB + (size_t)b * SEQ * 512 + (h * 2 + c) * 64; const __hip_bfloat16* k_ = KB + (size_t)b * SEQ * 512 + (h * 2 + c) * 64; const __hip_bfloat16* v_ = VB + (size_t)b * SEQ * 512 + h * 128;
        const __hip_bfloat16* kn_ = (u4 < 3) ? KB + (size_t)b * SEQ * 512 + (h * 2 + (c ^ 1)) * 64 : nullptr;
        __hip_bfloat16* o_ = OT + (size_t)b * SEQ * 1024 + (h * 2) * 128;
        const __hip_bfloat16* o1_ = c ? o_ : nullptr; unsigned short* ca_ = CA + (size_t)b * SEQ * 1024 + 512 + h * 128;
        int sn;
        if (mstat <= 40.0f) sn = attn_body::attn_unit<8, true>(mstat, qb * 256, q_, k_, v_, o_, lds_generic, o1_, lam, P.subln_g, ca_, kn_, v_, s0, pre);
        else sn = attn_body::attn_unit<8, false>(0.f, qb * 256, q_, k_, v_, o_, lds_generic, o1_, lam, P.subln_g, ca_, kn_, v_, s0, pre);
        s0 = sn; pre = (kn_ != nullptr); }
}

__device__ __forceinline__ void router_tile(const Ptrs& P, LAS unsigned char* lds, int tile) {
    const int tid = threadIdx.x, lane = tid & 63, wave = __builtin_amdgcn_readfirstlane(tid >> 6), r32 = lane & 31, hi = lane >> 5;
    const bf16* WRhi = (const bf16*)(P.ws + WS_WR); const bf16* WRlo = WRhi + 64 * 1024;
    int* LIST = (int*)(P.ws + WS_LIST); int* CTOK = (int*)(P.ws + WS_CTOK); unsigned* cnt = (unsigned*)(P.ws + WS_CTL); unsigned* ccnt = cnt + 64;
    LAS float* lg = (LAS float*)(lds + wave * 8448);
    LAS int* hist = (LAS int*)(lds + HIST_OFF); LAS int* hbase = hist + 32; LAS int* hist2 = hist + 64; LAS int* hbase2 = hist2 + NCLS;
    if (tid < 32) hist[tid] = 0;
    if (tid >= 64 && tid < 64 + NCLS) hist2[tid - 64] = 0;
    __syncthreads();
    const int tbase = tile * 256 + wave * 32;
    const bf16* xr = (const bf16*)(P.ws + WS_CA) + (size_t)(tbase + r32) * DMODEL + 8 * hi;
    const bf16* bh0 = WRhi + (size_t)r32 * 1024 + 8 * hi; const bf16* bl0 = WRlo + (size_t)r32 * 1024 + 8 * hi;
    f32x16 acc0 = {}, acc1 = {}; float ssq = 0.f;
#pragma unroll 4
    for (int ks = 0; ks < 64; ++ks) {
        const v4u xa = *(const v4u*)(xr + ks * 16);
        f32x4 x0, x1; unpack8(xa, x0, x1);
        ssq += (x0[0] * x0[0] + x0[1] * x0[1]) + (x0[2] * x0[2] + x0[3] * x0[3]) + (x1[0] * x1[0] + x1[1] * x1[1]) + (x1[2] * x1[2] + x1[3] * x1[3]);
        const bf16x8 a_hi = __builtin_bit_cast(bf16x8, xa);
        const bf16x8 bh_0 = *(const bf16x8*)(bh0 + ks * 16), bh_1 = *(const bf16x8*)(bh0 + 32 * 1024 + ks * 16), bl_0 = *(const bf16x8*)(bl0 + ks * 16), bl_1 = *(const bf16x8*)(bl0 + 32 * 1024 + ks * 16);
        acc0 = __builtin_amdgcn_mfma_f32_32x32x16_bf16(a_hi, bh_0, acc0, 0, 0, 0); acc1 = __builtin_amdgcn_mfma_f32_32x32x16_bf16(a_hi, bh_1, acc1, 0, 0, 0);
        acc0 = __builtin_amdgcn_mfma_f32_32x32x16_bf16(a_hi, bl_0, acc0, 0, 0, 0); acc1 = __builtin_amdgcn_mfma_f32_32x32x16_bf16(a_hi, bl_1, acc1, 0, 0, 0);
    }
    ssq += __shfl_xor(ssq, 32);
    const float rs = 1.0f / sqrtf(ssq * (1.0f / DMODEL) + EPS);
#pragma unroll
    for (int r = 0; r < 16; ++r) { const int m = (r & 3) + 8 * (r >> 2) + 4 * hi; lg[m * 66 + r32] = acc0[r]; lg[m * 66 + 32 + r32] = acc1[r]; }
    asm volatile("s_waitcnt lgkmcnt(0)" ::: "memory");
    int ea = 0, eb = 0, cls = 0, lpa = 0, lpb = 0, lpc = 0; float wa = 0.f, wb = 0.f;
    if (lane < 32) {
        const LAS float* L = lg + lane * 66;
        float gl[4];
#pragma unroll
        for (int j = 0; j < 4; ++j) gl[j] = L[j] * rs + P.b_rg[j];
        int gs = 0; float gm = gl[0];
#pragma unroll
        for (int j = 1; j < 4; ++j) if (gl[j] > gm) { gm = gl[j]; gs = j; }
        float gsum = 0.f;
#pragma unroll
        for (int j = 0; j < 4; ++j) gsum += __expf(gl[j] - gm);
        const float gw = 1.0f / gsum;
        float l0 = -INFINITY, l1 = -INFINITY; int i0 = 0, i1 = 0;
#pragma unroll
        for (int j = 0; j < 8; ++j) { const float v = L[4 + gs * 8 + j] * rs + P.b_re[gs * 8 + j];
            if (v > l0) { l1 = l0; i1 = i0; l0 = v; i0 = j; } else if (v > l1) { l1 = v; i1 = j; } }
        const float q = __expf(l1 - l0), inv = 1.0f / (1.0f + q);
        const float w0 = inv * gw, w1 = q * inv * gw;
        const int a = min(i0, i1), b = max(i0, i1);
        wa = (i0 < i1) ? w0 : w1; wb = (i0 < i1) ? w1 : w0;
        ea = gs * 8 + a; eb = gs * 8 + b; cls = gs * 28 + (a * (15 - a)) / 2 + (b - a - 1);
        lpa = __hip_atomic_fetch_add(&hist[ea], 1, __ATOMIC_RELAXED, __HIP_MEMORY_SCOPE_WORKGROUP); lpb = __hip_atomic_fetch_add(&hist[eb], 1, __ATOMIC_RELAXED, __HIP_MEMORY_SCOPE_WORKGROUP);
        lpc = __hip_atomic_fetch_add(&hist2[cls], 1, __ATOMIC_RELAXED, __HIP_MEMORY_SCOPE_WORKGROUP);
    }
    __syncthreads();
    if (tid < 32) hbase[tid] = (int)atomicAdd(cnt + tid, (unsigned)hist[tid]);
    if (tid >= 64 && tid < 64 + NCLS) { const int c = tid - 64; const int n = hist2[c]; hbase2[c] = n ? (int)atomicAdd(ccnt + c, (unsigned)n) : 0; }
    __syncthreads();
    if (lane < 32) { const int t = tbase + lane; const int pa = hbase[ea] + lpa, pb = hbase[eb] + lpb, pc = hbase2[cls] + lpc;
        typedef int i32x4 __attribute__((ext_vector_type(4)));
        const int dst = (cls << 17) | (pc << 1);
        *(i32x4*)(LIST + (size_t)(ea * LCAP + pa) * 4) = (i32x4){t, dst, __float_as_int(wa), __float_as_int(rs)};
        *(i32x4*)(LIST + (size_t)(eb * LCAP + pb) * 4) = (i32x4){t, dst | 1, __float_as_int(wb), __float_as_int(rs)};
        CTOK[(size_t)cls * NTOK + pc] = t; }
    __syncthreads();
}

__device__ __forceinline__ void p5_convert(const Ptrs& P, LAS unsigned char* lds, int vcu, int G) {
    const int tid = threadIdx.x, lane = tid & 63, wave = __builtin_amdgcn_readfirstlane(tid >> 6);
    LAS float* scr = (LAS float*)(lds + wave * 16384);
    const int gw = vcu * NWAVES + wave, NGW = G * NWAVES;
    unsigned char* WGU = P.ws + WS_WGU; unsigned char* WD = P.ws + WS_WD;
    constexpr int I_G = (DMODEL / 64) * (DEXP / 32);
    constexpr int I_D = (DEXP / 64) * (DMODEL / 32);
    constexpr int PER_E = 2 * I_G + I_D;
    constexpr int NITEMS = NEXP * PER_E, NRW = (NTOK / 256) * NWAVES;
    const bool split = (G == 256) && (NITEMS == NRW * 10 + (256 * NWAVES - NRW) * 14);
    const bool rwg = (int)blockIdx.x < NTOK / 256; const int wv = ((int)blockIdx.x - (rwg ? 0 : NTOK / 256)) * NWAVES + wave;
    const int it0 = split ? (rwg ? wv : NRW * 10 + wv) : gw, itn = split ? (rwg ? NRW * 10 : NITEMS) : NITEMS, its = split ? NRW : NGW;
    for (int it = it0; it < itn; it += its) {
        const int e = it / PER_E; int r = it % PER_E;
        if (r < 2 * I_G) { const int up = r / I_G; r %= I_G; const int kb = r / (DEXP / 32), nb = r % (DEXP / 32), n0 = nb * 32;
            const float* W = (up ? P.w_up : P.w_gate) + (size_t)e * DMODEL * DEXP;
            transpose_item_fp8(W, DEXP, kb * 64, n0, WGU + (size_t)e * 1024 * 1024, 1024, (n0 >> 7) * 256 + up * 128 + (n0 & 127), P.ffn_norm_g, 64.f, scr, lane);
        } else { r -= 2 * I_G; const int kb = r / (DMODEL / 32), nb = r % (DMODEL / 32);
            transpose_item_fp8(P.w_down + (size_t)e * DEXP * DMODEL, DMODEL, kb * 64, nb * 32, WD + (size_t)e * 1024 * 512, 512, nb * 32, nullptr, 32.f, scr, lane); }
    }
}

struct Args { Ptrs p; int ph_lo, ph_hi, use_cg, pad; };
__global__ void __launch_bounds__(NTHREADS, 2) mega_fwd(Args args) {
    extern __shared__ __attribute__((aligned(16))) unsigned char lds_raw[];
    LAS unsigned char* lds = (LAS unsigned char*)lds_raw;
    const Ptrs& P = args.p;
    const int tid = threadIdx.x, lane = tid & 63;
    const int G = gridDim.x, bx = blockIdx.x; const int vcu = (G % 8 == 0) ? (bx % 8) * (G / 8) + bx / 8 : bx;
    const int lo = args.ph_lo, hi = args.ph_hi;
    LAS int* meta = (LAS int*)(lds + META_OFF);
    if (tid < 2) ((volatile LAS unsigned*)(lds + BARST_OFF))[tid] = 0u;
    __syncthreads();
    XcdBarrier bar = xcd_barrier_post((unsigned*)(P.ws + WS_CTL) + 1024, (volatile LAS unsigned*)(lds + BARST_OFF));
#ifndef PHASE_MASK
#define PHASE_MASK 0xff
#endif
#ifndef DUP_PHASE
#define DUP_PHASE -1
#endif
#define REPS(k) for (int rep_ = 0; rep_ < ((DUP_PHASE == (k)) ? 2 : 1); ++rep_)
#define REPBAR() do { if (rep_) xcd_barrier(bar); } while (0)
#define IN(k) (((PHASE_MASK >> (k)) & 1) && lo <= (k) && (k) < hi)
#define SEAM(k) do { if (IN(k) && IN((k) + 1)) xcd_barrier(bar); } while (0)
    bf16* WS16 = (bf16*)P.ws;
    if (IN(0)) REPS(0) { REPBAR(); p0_prologue(P, lds, vcu, G); }
    SEAM(0);
    if (IN(1)) REPS(1) { REPBAR();
        pg8::Gemm g{(const bf16*)(P.ws + WS_A), (const bf16*)(P.ws + WS_WIN), DMODEL, 0, nullptr};
        pg8::StaticOrder S; S.init(NTOK, IN_COLS, G, bx);
        LAS float* gl = (LAS float*)(lds + RING_BYTES + 8192);
        if (tid < 128) gl[tid] = (tid < 64) ? P.q_norm_g[tid] : P.k_norm_g[tid - 64];
        __syncthreads();
        EpiInProj E{(bf16*)(P.ws + WS_YG), (bf16*)(P.ws + WS_QB), (bf16*)(P.ws + WS_KB), (bf16*)(P.ws + WS_VB), (bf16*)(P.ws + WS_GT), gl};
#if defined(DUMP_SEL) && DUMP_SEL == 5
        EpiRaw ER{(bf16*)(P.ws + WS_QB)};
        pg8::gemm_phase<EpiRaw, pg8::StaticOrder, false, true>(lds, g, S, ER);
#else
        pg8::gemm_phase<EpiInProj, pg8::StaticOrder, false, true>(lds, g, S, E);
#endif
    }
    SEAM(1);
    if (IN(2)) {
        REPS(2) { REPBAR();
        for (int p = vcu; p < 256; p += G) attn_pair(P, lds, (char*)lds_raw, p);
        __syncthreads(); }
        REPS(20) { REPBAR();
        conv_phase(P, lds, bx, G); }
    }
    SEAM(2);
    if (IN(3)) REPS(3) { REPBAR();
        pg8::Gemm g{(const bf16*)(P.ws + WS_CA), (const bf16*)(P.ws + WS_WCA), DMODEL, 0, nullptr};
        pg8::StaticOrder S; S.init(NTOK, DMODEL, G, bx);
        EpiMerged E{(const bf16*)(P.ws + WS_GT), (const bf16*)(P.ws + WS_GT) + (size_t)NTOK * 1024, (bf16*)(P.ws + WS_MG)};
        pg8::gemm_phase<EpiMerged, pg8::StaticOrder, false, true>(lds, g, S, E);
    }
    SEAM(3);
    if (IN(4)) REPS(4) { REPBAR();
        pg8::Gemm g{(const bf16*)(P.ws + WS_MG), (const bf16*)(P.ws + WS_WOUT), DMODEL, 0, nullptr};
        pg8::StaticOrder S; S.init(NTOK, DMODEL, G, bx);
        EpiOut E{P.x, (bf16*)(P.ws + WS_CA), P.ws + WS_XM};
        pg8::gemm_phase<EpiOut, pg8::StaticOrder, false, true>(lds, g, S, E);
    }
    SEAM(4);
    if (IN(5)) {
        for (int t = bx; t < NTOK / 256; t += G) router_tile(P, lds, t);
        REPS(5) { REPBAR(); p5_convert(P, lds, vcu, G); }
    }
    SEAM(5);
    LAS int* meta2 = (LAS int*)(lds + META2_OFF);
    if (IN(6)) REPS(6) { REPBAR();
        moe_meta(meta, meta2, (const unsigned*)(P.ws + WS_CTL));
        pg8::Gemm g{(const bf16*)(P.ws + WS_XM), (const bf16*)(P.ws + WS_WGU), DMODEL / 2, (size_t)1024 * 1024, (const int*)(P.ws + WS_LIST), 4};
        MoeOrder S{G, bx, __builtin_amdgcn_readfirstlane(meta[NEXP]), meta};
        EpiGateUp E{(const int*)(P.ws + WS_LIST), P.ws + WS_A, meta2};
        pg8::gemm_phase<EpiGateUp, MoeOrder, true, true, true>(lds, g, S, E);
    }
    SEAM(6);
    if (IN(7)) REPS(7) { REPBAR();
        moe_meta(meta, meta2, (const unsigned*)(P.ws + WS_CTL));
        pg8::Gemm g{(const bf16*)(P.ws + WS_A), (const bf16*)(P.ws + WS_WD), DMODEL / 2, (size_t)1024 * 512, nullptr, 0, DEXP / 2};
        ClassOrder S{G, bx, __builtin_amdgcn_readfirstlane(meta2[NCLS]), meta2};
        EpiDownAdd E{(const int*)(P.ws + WS_CTOK), (const bf16*)(P.ws + WS_CA), P.out};
        pg8::gemm_phase<EpiDownAdd, ClassOrder, false, true, true, true>(lds, g, S, E);
    }
#if defined(DUMP_SEL)
    xcd_barrier(bar);
    { const bf16* YG = (const bf16*)(P.ws + WS_YG); const bf16* QB = (const bf16*)(P.ws + WS_QB); const bf16* KB = (const bf16*)(P.ws + WS_KB); const bf16* VB = (const bf16*)(P.ws + WS_VB);
      const bf16* GT = (const bf16*)(P.ws + WS_GT); const bf16* CA = (const bf16*)(P.ws + WS_CA); const bf16* MG = (const bf16*)(P.ws + WS_MG);
      for (size_t i = (size_t)bx * NTHREADS + tid; i < (size_t)NTOK * 1024; i += (size_t)G * NTHREADS) { const size_t t = i >> 10; const int c = (int)(i & 1023); float v = 0.f;
#if DUMP_SEL == 1
          v = bf_lo(YG[t * 512 + (c & 511)]) + bf_lo(QB[t * 512 + (c & 511)]) + 2.f * bf_lo(KB[t * 512 + (c & 511)]) + 3.f * bf_lo(VB[t * 512 + (c & 511)]) + bf_lo(GT[t * 2048 + c]) + bf_lo(GT[t * 2048 + 1024 + c]);
#elif DUMP_SEL == 2
          v = bf_lo(CA[t * 1024 + c]);
#elif DUMP_SEL == 4
          { const bf16* HB = (const bf16*)(P.ws + WS_A); const bf16* WIN = (const bf16*)(P.ws + WS_WIN); v = bf_lo(HB[i]) + 30.f * bf_lo(WIN[i % ((size_t)IN_COLS * 1024)]); }
#elif DUMP_SEL == 5
          { const bf16* R = (const bf16*)(P.ws + WS_QB); v = bf_lo(R[t * 4608 + c]) + bf_lo(R[t * 4608 + 1024 + c]) + bf_lo(R[t * 4608 + 2048 + c]) + bf_lo(R[t * 4608 + 3072 + c]) + bf_lo(R[t * 4608 + 4096 + (c & 511)]); }
#elif DUMP_SEL == 3
          v = bf_lo(MG[t * 1024 + c]);
#endif
          P.out[i] = v; } }
#endif
    (void)WS16;
#undef IN
#undef SEAM
}

extern "C" void kernel_launch(void* const* d_in, const int* in_sizes, int n_in, void* d_out, int out_size, void* d_ws, size_t ws_size, hipStream_t stream) {
    static int grid = 0;
    if (grid == 0) {
        if (n_in != 25 || in_sizes[0] != NTOK * DMODEL || out_size != NTOK * DMODEL || ws_size < WS_END) {
            fprintf(stderr, "kernel_launch: unexpected shapes (n_in %d, in0 %d, out %d, ws %zu); nothing launched\n", n_in, n_in > 0 ? in_sizes[0] : -1, out_size, ws_size); grid = -1; return; }
        int dev = 0, cus = 0, per_cu = 0;
        if (hipGetDevice(&dev) != hipSuccess || hipDeviceGetAttribute(&cus, hipDeviceAttributeMultiprocessorCount, dev) != hipSuccess) { grid = -1; return; }
        if (hipFuncSetAttribute((const void*)mega_fwd, hipFuncAttributeMaxDynamicSharedMemorySize, LDS_BYTES) != hipSuccess) { fprintf(stderr, "kernel_launch: hipFuncSetAttribute failed\n"); grid = -1; return; }
        if (hipOccupancyMaxActiveBlocksPerMultiprocessor(&per_cu, (const void*)mega_fwd, NTHREADS, LDS_BYTES) != hipSuccess || per_cu < 1) { fprintf(stderr, "kernel_launch: the occupancy query reports %d workgroups per CU for this kernel and LDS size; nothing launched\n", per_cu); grid = -1; return; }
        (void)hipGetLastError();
        grid = cus;
    }
    if (grid < 0) return;
    (void)hipMemsetAsync((char*)d_ws + WS_CTL, 0, CTL_ZERO_BYTES, stream);
    Args a{};
    const float** pp = (const float**)&a.p;
    for (int i = 0; i < 25; ++i) pp[i] = (const float*)d_in[i];
    a.p.out = (float*)d_out; a.p.ws = (unsigned char*)d_ws;
#if MK_PER_PHASE
    for (int ph = 0; ph < N_PHASES; ++ph) { a.ph_lo = ph; a.ph_hi = ph + 1; void* params[] = {&a};
        hipError_t e = hipLaunchCooperativeKernel((const void*)mega_fwd, dim3(grid), dim3(NTHREADS), params, LDS_BYTES, stream);
        if (e != hipSuccess) { fprintf(stderr, "launch %d failed: %s\n", ph, hipGetErrorString(e)); break; } }
#else
    a.ph_lo = 0; a.ph_hi = N_PHASES; void* params[] = {&a};
    hipError_t e = hipLaunchCooperativeKernel((const void*)mega_fwd, dim3(grid), dim3(NTHREADS), params, LDS_BYTES, stream);
    if (e != hipSuccess) fprintf(stderr, "cooperative launch failed: %s (grid %d)\n", hipGetErrorString(e), grid);
#endif
}
```

```cpp
#include <hip/hip_runtime.h>
#include <hip/hip_bf16.h>
#include <hip/hip_cooperative_groups.h>
#include <cstdio>
#include <cstdint>
#include <cmath>
namespace cg = cooperative_groups;
__device__ __forceinline__ int tid_opaque() { int t = threadIdx.x; asm volatile("" : "+v"(t)); return t; }

constexpr int BATCH = 8, SEQ = 4096, DMODEL = 1024, NTOK = BATCH * SEQ;
constexpr int CONV_CH = 512, CONV_W = 31, NHEADS = 4, IN_COLS = 4608;
constexpr int NEXP = 32, DEXP = 512, LCAP = NTOK;
constexpr int NCLS = 4 * 28;
constexpr int CROWS = NTOK + NCLS * 256;
constexpr int MOE_ROWS = 2 * NTOK + NEXP * 256;
constexpr float EPS = 1e-6f;

namespace pg8 {
#define PG8_LAS __attribute__((address_space(3)))
typedef unsigned short bf16_t;
typedef short bf16x8 __attribute__((ext_vector_type(8)));
typedef float f32x4 __attribute__((ext_vector_type(4)));
typedef unsigned u32x4 __attribute__((ext_vector_type(4)));
constexpr int BM = 256, BK = 64, HALF = 128, HTB = HALF * BK * 2  , STAGE_BYTES = 8 * HTB, NXCD = 8, WGM = 8;

__host__ __device__ __forceinline__ int lds_byte(int r, int c) { const int st = (r >> 4) * 2 + (c >> 5), rr = r & 15, cc = c & 31, ob = rr * 64 + cc * 2; return st * 1024 + (ob ^ (((ob >> 9) & 1) << 5)); }
__host__ __device__ __forceinline__ void stage_rc(int b, int& R, int& C) { const int st = b / 1024, sb = b % 1024, swz = sb ^ (((sb >> 9) & 1) << 5); R = (st >> 1) * 16 + swz / 64; C = (st & 1) * 32 + (swz % 64) / 2; }
__host__ __device__ __forceinline__ int perm32(int rho) { const int n = rho >> 4, i = rho & 15; return 8 * (i >> 2) + 4 * n + (i & 3); }

struct Unit { int pm, pn, arow, e, e2, lrow, nvalid, orow; };
struct Gemm { const bf16_t* A; const bf16_t* Bt; int K; size_t bstride; const int* list; int lstride; int KBrow; };

struct StaticOrder {
    int nM, nN, nwg, G, c;
    __device__ void init(int M, int N, int G_, int c_) { nM = M / BM; nN = N / BM; nwg = nM * nN; G = G_; c = c_; }
    __device__ bool next(int i, Unit& u) const {
        const long L = (long)i * G + c; if (L >= nwg) return false;
        int wgid = (int)L; { const int q = nwg / NXCD, r = nwg % NXCD, xcd = wgid % NXCD, off = wgid / NXCD; wgid = (xcd < r ? xcd * (q + 1) : r * (q + 1) + (xcd - r) * q) + off; }
        const int nig = WGM * nN, gid = wgid / nig, fm = gid * WGM, gsz = (nM - fm) < WGM ? (nM - fm) : WGM;
        u.pm = fm + ((wgid % nig) % gsz); u.pn = (wgid % nig) / gsz; u.arow = u.pm * BM; u.orow = u.arow; u.e = 0; u.e2 = 0; u.lrow = 0; u.nvalid = BM; return true;
    }
};

typedef float f32x2_t __attribute__((ext_vector_type(2))); typedef __bf16 bf16x2_t __attribute__((ext_vector_type(2)));
__device__ __forceinline__ unsigned cvt_pk_bf16(float lo, float hi) { const f32x2_t v = {lo, hi}; const bf16x2_t b = __builtin_convertvector(v, bf16x2_t); return __builtin_bit_cast(unsigned, b); }
typedef int v8i_t __attribute__((ext_vector_type(8))); typedef int v4i_t __attribute__((ext_vector_type(4)));
__device__ __forceinline__ v8i_t cat8(const bf16x8 a, const bf16x8 b) { const v4i_t x = __builtin_bit_cast(v4i_t, a), y = __builtin_bit_cast(v4i_t, b); return (v8i_t){x[0], x[1], x[2], x[3], y[0], y[1], y[2], y[3]}; }
__device__ __forceinline__ unsigned pack4_fp8(float a, float b, float c, float d) { int w = 0; w = __builtin_amdgcn_cvt_pk_fp8_f32(a, b, w, false); w = __builtin_amdgcn_cvt_pk_fp8_f32(c, d, w, true); return (unsigned)w; }
__device__ __forceinline__ float bf_lo(unsigned w) { return __uint_as_float(w << 16); }
__device__ __forceinline__ float bf_hi(unsigned w) { return __uint_as_float(w & 0xffff0000u); }
__device__ __forceinline__ float sigmoidf_fast(float x) { return __builtin_amdgcn_rcpf(1.0f + __builtin_amdgcn_exp2f(-1.4426950408889634f * x)); }
__device__ __forceinline__ u32x4 pack8(const f32x4 a, const f32x4 b) { u32x4 w; w.x = cvt_pk_bf16(a[0], a[1]); w.y = cvt_pk_bf16(a[2], a[3]); w.z = cvt_pk_bf16(b[0], b[1]); w.w = cvt_pk_bf16(b[2], b[3]); return w; }
__device__ __forceinline__ void unpack8(const u32x4 w, f32x4& a, f32x4& b) { a = (f32x4){bf_lo(w.x), bf_hi(w.x), bf_lo(w.y), bf_hi(w.y)}; b = (f32x4){bf_lo(w.z), bf_hi(w.z), bf_lo(w.w), bf_hi(w.w)}; }

template <class Epi, class Sched, bool GATHER, bool ALIGN_EPI, bool FP8 = false, bool BSPLIT = false>
__device__ __forceinline__ void gemm_phase(PG8_LAS unsigned char* lds, const Gemm g, const Sched& S, const Epi& E) {
    const int tid = tid_opaque(), wid = __builtin_amdgcn_readfirstlane(tid >> 6), lane = tid & 63, wr = wid >> 2, wc = wid & 3, fr = lane & 15, fq = lane >> 4;
    const int K = g.K, nt = K / BK, KBp = g.KBrow ? g.KBrow : K;
    unsigned voffB[2]; int Ra[2], Ca[2];
#pragma unroll
    for (int i = 0; i < 2; ++i) { int R, C; stage_rc(tid * 16 + i * 8192, R, C); const int Rb = (R & ~31) + perm32(R & 31); Ra[i] = R; Ca[i] = C; voffB[i] = (unsigned)(Rb * KBp + C) * 2u; }
    const unsigned kstep = (unsigned)(BK * 2);
    const unsigned hstep = (unsigned)HALF * KBp * 2;
    const unsigned tstep = 2 * hstep;
    const char* const gA = (const char*)g.A; const char* const gB = (const char*)g.Bt;
    const unsigned ldsw = (unsigned)wid * 1024u;
    const int aoff = lds_byte(wr * 64 + fr, fq * 8), boff = lds_byte(wc * 32 + fr, fq * 8);
#define PG8_SA(b, h) (((b) * 2 + (h)) * HTB)
#define PG8_SB(b, h) ((4 + (b) * 2 + (h)) * HTB)
#define PG8_STAGE(bufoff, gbase, uoff, voff) do { _Pragma("unroll") for (int _i = 0; _i < 2; ++_i) \
        __builtin_amdgcn_global_load_lds((const unsigned*)((const char*)(gbase) + (unsigned)((uoff) + (voff)[_i])), (PG8_LAS unsigned*)(lds + (bufoff) + ldsw + _i * 8192), 16, 0, 0); } while (0)
#define PG8_LDA(dst, b, h) do { _Pragma("unroll") for (int m = 0; m < 4; ++m) _Pragma("unroll") for (int k = 0; k < 2; ++k) dst[m][k] = *(const PG8_LAS bf16x8*)(lds + PG8_SA(b, h) + aoff + m * 2048 + k * 1024); } while (0)
#define PG8_LDB(dst, b, h) do { _Pragma("unroll") for (int n = 0; n < 2; ++n) _Pragma("unroll") for (int k = 0; k < 2; ++k) dst[n][k] = *(const PG8_LAS bf16x8*)(lds + PG8_SB(b, h) + boff + n * 2048 + k * 1024); } while (0)
#define PG8_MMA(ai, bj, At, Bt) do { __builtin_amdgcn_s_setprio(1); \
        if constexpr (FP8) { _Pragma("unroll") for (int m = 0; m < 4; ++m) _Pragma("unroll") for (int n = 0; n < 2; ++n) \
            asm volatile("v_mfma_scale_f32_16x16x128_f8f6f4 %0, %1, %2, %0, %3, %3 op_sel_hi:[0,0,0]" : "+v"(acc[ai][bj][m][n]) : "v"(cat8(Bt[n][0], Bt[n][1])), "v"(cat8(At[m][0], At[m][1])), "v"(one_e8m0)); } \
        else { _Pragma("unroll") for (int m = 0; m < 4; ++m) _Pragma("unroll") for (int n = 0; n < 2; ++n) _Pragma("unroll") for (int k = 0; k < 2; ++k) \
            acc[ai][bj][m][n] = __builtin_amdgcn_mfma_f32_16x16x32_bf16(Bt[n][k], At[m][k], acc[ai][bj][m][n], 0, 0, 0); } \
        __builtin_amdgcn_s_setprio(0); } while (0)
#define PG8_WAIT_V(n) asm volatile("s_waitcnt vmcnt(" #n ")" ::: "memory")
#define PG8_WAIT_L(n) asm volatile("s_waitcnt lgkmcnt(" #n ")" ::: "memory")
#define PG8_BAR __builtin_amdgcn_s_barrier()
#define PG8_SCHED __builtin_amdgcn_sched_barrier(0)
#define PG8_LOAD_VA(dst, u) do { _Pragma("unroll") for (int _h = 0; _h < 2; ++_h) _Pragma("unroll") for (int _i = 0; _i < 2; ++_i) { const int _row = _h * HALF + Ra[_i]; \
        if constexpr (GATHER) { const int _tok = (_row < (u).nvalid) ? g.list[((u).lrow + _row) * g.lstride] : 0; dst[_h][_i] = (unsigned)(_tok * K + Ca[_i]) * 2u; } \
        else dst[_h][_i] = (unsigned)(_row * K + Ca[_i]) * 2u; } } while (0)
    Unit cur, nxt; int ui = 0;
    if (!S.next(0, cur)) return;
    unsigned vAc[2][2], vAn[2][2];
    PG8_LOAD_VA(vAc, cur);
    f32x4 acc[2][2][4][2];
#pragma unroll
    for (int a = 0; a < 2; ++a)
#pragma unroll
        for (int b = 0; b < 2; ++b)
#pragma unroll
            for (int m = 0; m < 4; ++m)
#pragma unroll
                for (int n = 0; n < 2; ++n) acc[a][b][m][n] = (f32x4){0.f, 0.f, 0.f, 0.f};
    bf16x8 At[4][2], B0[2][2], B1[2][2];
    const int one_e8m0 = 0x7f7f7f7f; (void)one_e8m0;
    unsigned cA = (unsigned)cur.arow * K * 2, cB = (unsigned)cur.e * (unsigned)g.bstride + (unsigned)cur.pn * tstep;
    unsigned cB2 = (unsigned)cur.e2 * (unsigned)g.bstride + (unsigned)cur.pn * tstep; const unsigned hk = (unsigned)(nt / 2) * kstep; (void)cB2; (void)hk;
    PG8_STAGE(PG8_SB(0, 0), gB, cB, voffB); PG8_STAGE(PG8_SB(0, 1), gB, cB + hstep, voffB); PG8_STAGE(PG8_SA(0, 0), gA, cA, vAc[0]); PG8_STAGE(PG8_SA(0, 1), gA, cA, vAc[1]);
    if (wr == 1) PG8_BAR;
    PG8_WAIT_V(2); PG8_BAR;
    PG8_STAGE(PG8_SB(1, 0), gB, cB + kstep, voffB); PG8_STAGE(PG8_SA(1, 0), gA, cA + kstep, vAc[0]); PG8_STAGE(PG8_SB(1, 1), gB, cB + hstep + kstep, voffB);
    PG8_WAIT_V(6); PG8_BAR;
    for (;;) {
        const bool has_next = S.next(ui + 1, nxt);
        const unsigned nA = has_next ? (unsigned)nxt.arow * K * 2 : cA;
        const unsigned nB = has_next ? (unsigned)nxt.e * (unsigned)g.bstride + (unsigned)nxt.pn * tstep : cB;
        const unsigned nB2 = has_next ? (unsigned)nxt.e2 * (unsigned)g.bstride + (unsigned)nxt.pn * tstep : cB2; (void)nB2;
        if (has_next) { PG8_LOAD_VA(vAn, nxt); }
        else {
#pragma unroll
            for (int h = 0; h < 2; ++h)
#pragma unroll
                for (int i = 0; i < 2; ++i) vAn[h][i] = vAc[h][i]; }
#pragma unroll 1
        for (int t = 0; t < nt; t += 2) {
            const bool last = (t == nt - 2);
            if constexpr (Epi::MID) { if (t == nt / 2) E.mid(acc, cur, wr, wc, fr, fq); }
            const unsigned a1 = cA + (unsigned)(t + 1) * kstep;
            const unsigned a2 = last ? nA : cA + (unsigned)(t + 2) * kstep;
            unsigned b2 = last ? nB : cB + (unsigned)(t + 2) * kstep;
            if constexpr (BSPLIT) { if (!last && t + 2 >= nt / 2) b2 = cB2 + (unsigned)(t + 2) * kstep - hk; }
            const unsigned a3 = a2 + kstep, b3 = b2 + kstep;
            unsigned v2[2][2];
#pragma unroll
            for (int h = 0; h < 2; ++h)
#pragma unroll
                for (int i = 0; i < 2; ++i) v2[h][i] = vAc[h][i];
            if (last) { asm volatile("" ::: "memory");
#pragma unroll
                for (int h = 0; h < 2; ++h)
#pragma unroll
                    for (int i = 0; i < 2; ++i) v2[h][i] = vAn[h][i]; }
            PG8_LDB(B0, 0, 0); PG8_LDB(B1, 0, 1); PG8_SCHED; PG8_LDA(At, 0, 0); PG8_STAGE(PG8_SA(1, 1), gA, a1, vAc[1]);
            PG8_WAIT_V(8); PG8_WAIT_L(0); PG8_BAR; PG8_MMA(0, 0, At, B0); PG8_MMA(0, 1, At, B1); PG8_BAR; PG8_SCHED;
            PG8_LDA(At, 0, 1); PG8_STAGE(PG8_SB(0, 0), gB, b2, voffB); PG8_STAGE(PG8_SB(0, 1), gB, b2 + hstep, voffB); PG8_STAGE(PG8_SA(0, 0), gA, a2, v2[0]);
            PG8_WAIT_V(8); PG8_WAIT_L(0); PG8_BAR; PG8_MMA(1, 0, At, B0); PG8_MMA(1, 1, At, B1); PG8_BAR; PG8_SCHED;
            PG8_LDB(B0, 1, 0); PG8_LDB(B1, 1, 1); PG8_SCHED; PG8_LDA(At, 1, 0); PG8_STAGE(PG8_SA(0, 1), gA, a2, v2[1]);
            PG8_WAIT_V(8); PG8_WAIT_L(0); PG8_BAR; PG8_MMA(0, 0, At, B0); PG8_MMA(0, 1, At, B1); PG8_BAR; PG8_SCHED;
            PG8_LDA(At, 1, 1); PG8_STAGE(PG8_SB(1, 0), gB, b3, voffB); PG8_STAGE(PG8_SB(1, 1), gB, b3 + hstep, voffB); PG8_STAGE(PG8_SA(1, 0), gA, a3, v2[0]);
            PG8_WAIT_V(8); PG8_WAIT_L(0); PG8_BAR; PG8_MMA(1, 0, At, B0); PG8_MMA(1, 1, At, B1); PG8_BAR; PG8_SCHED;
        }
        if constexpr (ALIGN_EPI) { if (wr == 0) PG8_BAR; }
        if constexpr (FP8) asm volatile("s_nop 15\n\ts_nop 15\n\ts_nop 15\n\ts_nop 15" ::: "memory");
        E(acc, cur, wr, wc, fr, fq);
        if (!has_next) break;
#pragma unroll
        for (int a = 0; a < 2; ++a)
#pragma unroll
            for (int b = 0; b < 2; ++b)
#pragma unroll
                for (int m = 0; m < 4; ++m)
#pragma unroll
                    for (int n = 0; n < 2; ++n) acc[a][b][m][n] = (f32x4){0.f, 0.f, 0.f, 0.f};
        cur = nxt; cA = nA; cB = nB; cB2 = nB2; ++ui;
#pragma unroll
        for (int h = 0; h < 2; ++h)
#pragma unroll
            for (int i = 0; i < 2; ++i) vAc[h][i] = vAn[h][i];
        if constexpr (ALIGN_EPI) { if (wr == 1) PG8_BAR; }
    }
    PG8_WAIT_V(0);
    if constexpr (!ALIGN_EPI) { if (wr == 0) PG8_BAR; }
    PG8_BAR;
#undef PG8_SA
#undef PG8_SB
#undef PG8_STAGE
#undef PG8_LDA
#undef PG8_LDB
#undef PG8_MMA
#undef PG8_WAIT_V
#undef PG8_WAIT_L
#undef PG8_BAR
#undef PG8_SCHED
#undef PG8_LOAD_VA
}
}

namespace attn_body {
using bf16=__hip_bfloat16;
using bf16x8=__attribute__((ext_vector_type(8)))short;
using s16x4=__attribute__((ext_vector_type(4)))short;
using f32x16=__attribute__((ext_vector_type(16)))float;
using u32x4=__attribute__((ext_vector_type(4)))unsigned;
constexpr int D=64, QP=512, KP=512, VP=512, OP=1024;
constexpr int NW=8,QBLK=32,QB=QBLK*NW,KVBLK=64;
constexpr int ATTN_UNIT_ROWS=QB;
__device__ __forceinline__ int crow(int r,int hi){return (r&3)+8*(r>>2)+4*hi;}
#define SBAR() __builtin_amdgcn_sched_barrier(0)
__device__ __forceinline__ void cmask(f32x16&p0,f32x16&p1,int jb,int qrel,int hi){
  const float NEG=-INFINITY; int kb=64*jb+4*hi;
  #pragma unroll
  for(int r=0;r<16;++r){int kv=kb+(r&3)+8*(r>>2); if(kv>qrel)p0[r]=NEG; if(kv+32>qrel)p1[r]=NEG;}
}

constexpr int NSLOT=3, SLOTB=8192, VSLOTB=16384;
constexpr int LDS_K=0, LDS_V=NSLOT*SLOTB, LDS_WS=LDS_V+NSLOT*VSLOTB, LDS_OST=LDS_WS+NW*64*4, LDS_BYTES=LDS_OST+NW*4096;
constexpr float C2=0.125f*1.4426950408889634f;
__device__ __forceinline__ void glds16(const void*gsrc,unsigned lds_dst){unsigned keep;
  asm volatile("s_mov_b32 %0, m0\n\ts_mov_b32 m0, %2\n\ts_nop 0\n\tglobal_load_lds_dwordx4 %1, off\n\ts_mov_b32 m0, %0":"=&s"(keep):"v"(gsrc),"s"(lds_dst):"memory");}
__device__ __forceinline__ float max3f(float a,float b,float c){float r;asm("v_max3_f32 %0, %1, %2, %3":"=v"(r):"v"(a),"v"(b),"v"(c));return r;}
__device__ __forceinline__ float max2f(float a,float b){float r;asm("v_max_f32_e32 %0, %1, %2":"=v"(r):"v"(a),"v"(b));return r;}
__device__ __forceinline__ float fadd_s(float a,float b){float r;asm("v_add_f32_e32 %0, %1, %2":"=v"(r):"v"(a),"v"(b));return r;}
__device__ __forceinline__ float fsub_s(float a,float b){float r;asm("v_sub_f32_e32 %0, %1, %2":"=v"(r):"v"(a),"v"(b));return r;}
typedef float f32x2_t __attribute__((ext_vector_type(2))); typedef __bf16 bf16x2_t __attribute__((ext_vector_type(2)));
__device__ __forceinline__ unsigned cvtpk_s(float lo,float hi){f32x2_t v={lo,hi};bf16x2_t b=__builtin_convertvector(v,bf16x2_t);return __builtin_bit_cast(unsigned,b);}
#define WAIT_BAR(N) asm volatile("s_waitcnt vmcnt(" #N ") lgkmcnt(0)\n\ts_barrier":::"memory")

__device__ __forceinline__ void qkt(f32x16&p0,f32x16&p1,const char*Kslot,const bf16x8*qr,const f32x16&negm,int r32,int hi){
  const char*kb=Kslot+hi*1024+r32*16;
  #pragma unroll
  for(int d0=0;d0<4;++d0){
    const bf16x8 b0=*reinterpret_cast<const bf16x8*>(kb+d0*2048);
    const bf16x8 b1=*reinterpret_cast<const bf16x8*>(kb+d0*2048+512);
    if(d0==0){p0=__builtin_amdgcn_mfma_f32_32x32x16_bf16(b0,qr[0],negm,0,0,0);p1=__builtin_amdgcn_mfma_f32_32x32x16_bf16(b1,qr[0],negm,0,0,0);}
    else{p0=__builtin_amdgcn_mfma_f32_32x32x16_bf16(b0,qr[d0],p0,0,0,0);p1=__builtin_amdgcn_mfma_f32_32x32x16_bf16(b1,qr[d0],p1,0,0,0);}}
}
typedef __attribute__((address_space(3))) const char* lds_cptr;
typedef short v4i16_t __attribute__((ext_vector_type(4)));
__device__ __forceinline__ void kload8(bf16x8*kf,lds_cptr kp){
  kf[0]=*(const __attribute__((address_space(3))) bf16x8*)(kp);      kf[1]=*(const __attribute__((address_space(3))) bf16x8*)(kp+512);
  kf[2]=*(const __attribute__((address_space(3))) bf16x8*)(kp+2048); kf[3]=*(const __attribute__((address_space(3))) bf16x8*)(kp+2560);
  kf[4]=*(const __attribute__((address_space(3))) bf16x8*)(kp+4096); kf[5]=*(const __attribute__((address_space(3))) bf16x8*)(kp+4608);
  kf[6]=*(const __attribute__((address_space(3))) bf16x8*)(kp+6144); kf[7]=*(const __attribute__((address_space(3))) bf16x8*)(kp+6656);
}
__device__ __forceinline__ void kload2(bf16x8*kf,lds_cptr kp,int j){ kf[2*j]=*(const __attribute__((address_space(3))) bf16x8*)(kp+j*2048); kf[2*j+1]=*(const __attribute__((address_space(3))) bf16x8*)(kp+j*2048+512); }
__device__ __forceinline__ s16x4 vtr(lds_cptr p){ return __builtin_bit_cast(s16x4,__builtin_amdgcn_ds_read_tr16_b64_v4i16((__attribute__((address_space(3))) v4i16_t*)p)); }
__device__ __forceinline__ float rowmax(const f32x16&p0,const f32x16&p1){
  float a=max3f(p0[0],p0[1],p1[0]),b=max3f(p0[2],p0[3],p1[1]);a=max3f(a,p1[2],p1[3]);
  #pragma unroll
  for(int r=4;r<16;r+=4){a=max3f(a,p0[r],p0[r+1]);b=max3f(b,p0[r+2],p0[r+3]);a=max3f(a,p1[r],p1[r+1]);b=max3f(b,p1[r+2],p1[r+3]);}
  const float m=max2f(a,b);
  auto rr=__builtin_amdgcn_permlane32_swap(__float_as_uint(m),__float_as_uint(m),false,false);
  return max2f(__uint_as_float(rr[0]),__uint_as_float(rr[1]));
}
__device__ __forceinline__ void pv(f32x16*o,int vb,bf16x8 pa0,bf16x8 pa1,bf16x8 pa2,bf16x8 pa3){
  #pragma unroll
  for(int d0=0;d0<4;++d0){s16x4 lo[4],hi[4];
    #pragma unroll
    for(int ks=0;ks<4;++ks){
      asm volatile("ds_read_b64_tr_b16 %0,%1 offset:%c2":"=&v"(lo[ks]):"v"(vb),"i"(d0*4096+ks*1024):"memory");
      asm volatile("ds_read_b64_tr_b16 %0,%1 offset:%c2":"=&v"(hi[ks]):"v"(vb),"i"(d0*4096+ks*1024+512):"memory");}
    asm volatile("s_waitcnt lgkmcnt(0)":::"memory");SBAR();
    #define PK(k) (bf16x8){lo[k][0],lo[k][1],lo[k][2],lo[k][3],hi[k][0],hi[k][1],hi[k][2],hi[k][3]}
    o[d0]=__builtin_amdgcn_mfma_f32_32x32x16_bf16(pa0,PK(0),o[d0],0,0,0);
    o[d0]=__builtin_amdgcn_mfma_f32_32x32x16_bf16(pa1,PK(1),o[d0],0,0,0);
    o[d0]=__builtin_amdgcn_mfma_f32_32x32x16_bf16(pa2,PK(2),o[d0],0,0,0);
    o[d0]=__builtin_amdgcn_mfma_f32_32x32x16_bf16(pa3,PK(3),o[d0],0,0,0);
    #undef PK
  }
}

#ifndef ATTN_STORE16
#define ATTN_STORE16(p,v) (*(u32x4*)(p)=(v))
#endif
template<int THRL,bool STAT> __device__ __forceinline__ int attn_unit(float mstat,int q0,const bf16*Q,const bf16*__restrict__ K,const bf16*__restrict__ V,bf16*O,char*shm,const bf16*O1,float lam,const float*subg,unsigned short*CAo,const bf16*Knext,const bf16*Vnext,int s0,bool pre){
  #define NXT_(x) (((x)==(NSLOT-1)*SLOTB)?0:(x)+SLOTB)
  const int s1=NXT_(s0),s2=NXT_(s1);
  int tid_=threadIdx.x; asm volatile("":"+v"(tid_));
  const int tid=tid_,lane=tid&63,r32=lane&31,hi=lane>>5; const int wid=__builtin_amdgcn_readfirstlane(tid>>6);
  const bf16*Qw=Q+(long)(q0+wid*QBLK)*QP;
  const bf16*Kh=K,*Vh=V;
  const unsigned lds0=(unsigned)(uintptr_t)shm;
  float*wsf=(float*)(shm+LDS_WS)+wid*64;
  const bf16*ksrc=Kh+(long)lane*KP+wid*8;
  const bf16*vsrc=Vh+(long)(16*(wid&3)+(lane>>2))*VP+(wid>>2)*32+(lane&3)*8;
  const unsigned kdst=lds0+LDS_K+wid*1024, vdst=lds0+LDS_V+wid*1024;
  #define DMA_K(t,slot) glds16(ksrc+(long)(t)*KVBLK*KP,(unsigned)__builtin_amdgcn_readfirstlane(kdst+(slot)))
  #define DMA_V(t,slot) do{ glds16(vsrc+(long)(t)*KVBLK*VP,(unsigned)__builtin_amdgcn_readfirstlane(vdst+2*(slot))); glds16(vsrc+(long)(t)*KVBLK*VP+64,(unsigned)__builtin_amdgcn_readfirstlane(vdst+2*(slot)+8192)); }while(0)
  const int vb0=(int)(lds0+LDS_V)+((lane>>4)&1)*32+(lane&3)*8+(4*hi+((lane&15)>>2))*64;
  const char*Kbase=shm+LDS_K; bf16x8 kf[8];
  const lds_cptr shm3=(lds_cptr)shm; const lds_cptr kp0=shm3+LDS_K+hi*1024+r32*16; const lds_cptr vp0=shm3+LDS_V+((lane>>4)&1)*32+(lane&3)*8+(4*hi+((lane&15)>>2))*64;
  const int NT=(q0+QB)/KVBLK;
  if(!pre){DMA_K(0,s0);DMA_V(0,s0);DMA_K(1,s1);}
  bf16x8 qr[4];
  #pragma unroll
  for(int d0=0;d0<4;++d0)qr[d0]=*reinterpret_cast<const bf16x8*>(&Qw[(long)r32*QP+d0*16+hi*8]);
  float mhat=0.f,l_reg=0.f;f32x16 o[4];{float zz=0.f;asm volatile("":"+v"(zz));
  #pragma unroll
  for(int r=0;r<16;++r){o[0][r]=zz;o[1][r]=zz;o[2][r]=zz;o[3][r]=zz;}}
  f32x16 negm;{float zn=0.f;asm volatile("":"+v"(zn));
  #pragma unroll
  for(int r=0;r<16;++r)negm[r]=zn;}
  asm volatile("":"+v"(negm));
  const int qrel=wid*QBLK+r32;
  #define CMASK(P0,P1,t) do{int jb_=(t)-(NT-4); if(jb_>=0)cmask(P0,P1,jb_,qrel,hi);}while(0)
  bool resc=false;
  #define START(P0,P1) do{ float rm; if constexpr (STAT) rm=mstat; else rm=rowmax(P0,P1); resc=false; \
    { const float dl=rm; mhat=fadd_s(mhat,dl); \
      _Pragma("unroll") for(int r=0;r<16;++r){P0[r]=fsub_s(P0[r],dl);P1[r]=fsub_s(P1[r],dl);} \
      _Pragma("unroll") for(int r=0;r<16;++r)negm[r]=-mhat; asm volatile("":"+v"(negm)); } \
    _Pragma("unroll") for(int r=0;r<16;++r)P0[r]=__builtin_amdgcn_exp2f(P0[r]); }while(0)
  #define RESC() do{ if(resc){ asm volatile("s_waitcnt lgkmcnt(0)":::"memory"); \
      _Pragma("unroll") for(int d_=0;d_<4;++d_) _Pragma("unroll") for(int r=0;r<16;++r)o[d_][r]*=wsf[crow(r,hi)]; } }while(0)
  f32x16 pA0,pA1,pB0,pB1;
  int sl_prev=s0,sl_cur=s0,sl_next=s1;
  #define ROT() do{sl_prev=sl_cur;sl_cur=sl_next;sl_next=(sl_next==(NSLOT-1)*SLOTB)?0:sl_next+SLOTB;}while(0)
  if(!pre){DMA_K(2,s2);}
  WAIT_BAR(4);
  qkt(pA0,pA1,Kbase+s0,qr,negm,r32,hi);asm volatile("s_nop 15\n\ts_nop 7":"+v"(pA0),"+v"(pA1));CMASK(pA0,pA1,0);
  START(pA0,pA1);
  _Pragma("unroll") for(int r=0;r<16;++r)pA1[r]=__builtin_amdgcn_exp2f(pA1[r]);
  WAIT_BAR(0);
  DMA_K(3,s0);DMA_V(1,s1);
  ROT();
  kload8(kf,kp0+sl_cur);
  WAIT_BAR(3);
  s16x4 vlo[8],vhi[8]; u32x4 pw0,pw1,pw2,pw3;
  #define PKW(P,B) cvtpk_s(P[B],P[B+1])
  #define PAF(k) __builtin_bit_cast(bf16x8,pw##k)
  #define VFR(i) (bf16x8){vlo[i][0],vlo[i][1],vlo[i][2],vlo[i][3],vhi[i][0],vhi[i][1],vhi[i][2],vhi[i][3]}
  #define PIN(x) asm volatile("":"+v"(x))
  #define MX3(a,b,c) __builtin_fmaxf(__builtin_fmaxf((a),(b)),(c))
  #define GAPA(MF,A0,A1,A2,A3,W0,W1,PW) do{ MF; sacc+=A0; sacc+=A1; sacc+=A2; sacc+=A3; PIN(sacc); W0; W1; PIN(PW); SBAR(); }while(0)
  #define EX(v) __builtin_amdgcn_exp2f(v)
  #define GAPB2(MF,X,B) do{ MF; X[B]=EX(X[B]); X[B+1]=EX(X[B+1]); PIN(X); SBAR(); }while(0)
  #define VRD2(i) do{ vlo[i]=vtr(vp_+((((i)>>2)+2)*4096+((i)&3)*1024)); vhi[i]=vtr(vp_+((((i)>>2)+2)*4096+((i)&3)*1024+512)); }while(0)
  #define VRD(i) do{ vlo[i]=vtr(vp_+(((i)>>2)*4096+((i)&3)*1024)); vhi[i]=vtr(vp_+(((i)>>2)*4096+((i)&3)*1024+512)); }while(0)
  #define KRD(G,j) do{ if(G){ kload2(kf,kp0+sl_next,j); SBAR(); } }while(0)
  #define STEP(C0,C1,P0,P1,t,GK,GV,GL) do{ SBAR(); \
    const lds_cptr vp_=vp0+2*sl_prev; \
    VRD(0); SBAR(); float sacc=(P0[0]+P0[1]); \
    GAPA(C0=__builtin_amdgcn_mfma_f32_32x32x16_bf16(kf[0],qr[0],negm,0,0,0), P0[2],P0[3],P0[4],P0[5],     pw0[0]=PKW(P0,0), pw0[1]=PKW(P0,2), pw0); \
    VRD(4); SBAR(); GAPA(C1=__builtin_amdgcn_mfma_f32_32x32x16_bf16(kf[1],qr[0],negm,0,0,0), P0[6],P0[7],P0[8],P0[9],     pw0[2]=PKW(P0,4), pw0[3]=PKW(P0,6), pw0); \
    VRD(1); SBAR(); GAPA(C0=__builtin_amdgcn_mfma_f32_32x32x16_bf16(kf[2],qr[1],C0,0,0,0),   P0[10],P0[11],P0[12],P0[13], pw1[0]=PKW(P0,8), pw1[1]=PKW(P0,10), pw1); \
    VRD(5); SBAR(); GAPA(C1=__builtin_amdgcn_mfma_f32_32x32x16_bf16(kf[3],qr[1],C1,0,0,0),   P0[14],P0[15],P1[0],P1[1],   pw1[2]=PKW(P0,12),pw1[3]=PKW(P0,14), pw1); \
    VRD(2); SBAR(); GAPA(C0=__builtin_amdgcn_mfma_f32_32x32x16_bf16(kf[4],qr[2],C0,0,0,0),   P1[2],P1[3],P1[4],P1[5],     pw2[0]=PKW(P1,0), pw2[1]=PKW(P1,2), pw2); \
    VRD(6); SBAR(); GAPA(C1=__builtin_amdgcn_mfma_f32_32x32x16_bf16(kf[5],qr[2],C1,0,0,0),   P1[6],P1[7],P1[8],P1[9],     pw2[2]=PKW(P1,4), pw2[3]=PKW(P1,6), pw2); \
    VRD(3); SBAR(); GAPA(C0=__builtin_amdgcn_mfma_f32_32x32x16_bf16(kf[6],qr[3],C0,0,0,0),   P1[10],P1[11],P1[12],P1[13], pw3[0]=PKW(P1,8), pw3[1]=PKW(P1,10), pw3); \
    VRD(7); SBAR(); GAPA(C1=__builtin_amdgcn_mfma_f32_32x32x16_bf16(kf[7],qr[3],C1,0,0,0),   P1[14],P1[15],0.f,0.f,       pw3[2]=PKW(P1,12),pw3[3]=PKW(P1,14), pw3); \
    l_reg+=sacc; \
    if(GK){DMA_K((t)+3,sl_cur);} if(GV){DMA_V((t)+1,sl_next);} \
    CMASK(C0,C1,t); \
    if constexpr (!STAT) { float a=MX3(C0[0],C0[1],C1[0]),b=MX3(C0[2],C0[3],C1[1]); a=MX3(a,C1[2],C1[3]); \
      _Pragma("unroll") for(int r=4;r<16;r+=4){a=MX3(a,C0[r],C0[r+1]);b=MX3(b,C0[r+2],C0[r+3]);a=MX3(a,C1[r],C1[r+1]);b=MX3(b,C1[r+2],C1[r+3]);} \
      float rm=__builtin_fmaxf(a,b); { auto rr=__builtin_amdgcn_permlane32_swap(__float_as_uint(rm),__float_as_uint(rm),false,false); rm=__builtin_fmaxf(__uint_as_float(rr[0]),__uint_as_float(rr[1])); } \
      resc=false; \
      if(__builtin_expect(__any(rm>(float)THRL),0)){ const float dl=__builtin_fmaxf(rm,0.f); mhat+=dl; \
        _Pragma("unroll") for(int r=0;r<16;++r){C0[r]-=dl;C1[r]-=dl;} \
        _Pragma("unroll") for(int r=0;r<16;++r)negm[r]=-mhat; asm volatile("":"+v"(negm)); \
        const float f=__builtin_amdgcn_exp2f(-dl); l_reg*=f; if(hi==0)wsf[r32]=f; resc=true; } } \
    SBAR(); \
    GAPB2(o[0]=__builtin_amdgcn_mfma_f32_32x32x16_bf16(PAF(0),VFR(0),o[0],0,0,0), C0,0);  VRD2(0); SBAR(); \
    GAPB2(o[1]=__builtin_amdgcn_mfma_f32_32x32x16_bf16(PAF(0),VFR(4),o[1],0,0,0), C0,2);  VRD2(4); SBAR(); \
    GAPB2(o[0]=__builtin_amdgcn_mfma_f32_32x32x16_bf16(PAF(1),VFR(1),o[0],0,0,0), C0,4);  VRD2(1); SBAR(); \
    GAPB2(o[1]=__builtin_amdgcn_mfma_f32_32x32x16_bf16(PAF(1),VFR(5),o[1],0,0,0), C0,6);  VRD2(5); SBAR(); \
    GAPB2(o[0]=__builtin_amdgcn_mfma_f32_32x32x16_bf16(PAF(2),VFR(2),o[0],0,0,0), C0,8);  VRD2(2); SBAR(); \
    GAPB2(o[1]=__builtin_amdgcn_mfma_f32_32x32x16_bf16(PAF(2),VFR(6),o[1],0,0,0), C0,10); VRD2(6); SBAR(); \
    GAPB2(o[0]=__builtin_amdgcn_mfma_f32_32x32x16_bf16(PAF(3),VFR(3),o[0],0,0,0), C0,12); VRD2(3); SBAR(); \
    GAPB2(o[1]=__builtin_amdgcn_mfma_f32_32x32x16_bf16(PAF(3),VFR(7),o[1],0,0,0), C0,14); VRD2(7); SBAR(); \
    GAPB2(o[2]=__builtin_amdgcn_mfma_f32_32x32x16_bf16(PAF(0),VFR(0),o[2],0,0,0), C1,0); \
    GAPB2(o[3]=__builtin_amdgcn_mfma_f32_32x32x16_bf16(PAF(0),VFR(4),o[3],0,0,0), C1,2); \
    KRD(GL,0); GAPB2(o[2]=__builtin_amdgcn_mfma_f32_32x32x16_bf16(PAF(1),VFR(1),o[2],0,0,0), C1,4); \
    KRD(GL,1); GAPB2(o[3]=__builtin_amdgcn_mfma_f32_32x32x16_bf16(PAF(1),VFR(5),o[3],0,0,0), C1,6); \
    KRD(GL,2); GAPB2(o[2]=__builtin_amdgcn_mfma_f32_32x32x16_bf16(PAF(2),VFR(2),o[2],0,0,0), C1,8); \
    KRD(GL,3); GAPB2(o[3]=__builtin_amdgcn_mfma_f32_32x32x16_bf16(PAF(2),VFR(6),o[3],0,0,0), C1,10); \
    GAPB2(o[2]=__builtin_amdgcn_mfma_f32_32x32x16_bf16(PAF(3),VFR(3),o[2],0,0,0), C1,12); \
    GAPB2(o[3]=__builtin_amdgcn_mfma_f32_32x32x16_bf16(PAF(3),VFR(7),o[3],0,0,0), C1,14); \
    }while(0)
  int t=1;
  #undef CMASK
  #define CMASK(P0,P1,t) do{}while(0)
  for(;t+5<NT;t+=2){
    STEP(pB0,pB1,pA0,pA1,t,true,true,true);     WAIT_BAR(3); RESC(); ROT();
    STEP(pA0,pA1,pB0,pB1,t+1,true,true,true);   WAIT_BAR(3); RESC(); ROT();
  }
  #undef CMASK
  #define CMASK(P0,P1,t) do{int jb_=(t)-(NT-4); if(jb_>=0)cmask(P0,P1,jb_,qrel,hi);}while(0)
  #define ENDW(tt) do{ if((tt)+3<NT){WAIT_BAR(3);} else if((tt)+2<NT){WAIT_BAR(2);} else {WAIT_BAR(0);} }while(0)
  for(;t+1<NT;t+=2){
    STEP(pB0,pB1,pA0,pA1,t,(t+3<NT),(t+1<NT),(t+1<NT));       ENDW(t);   RESC(); ROT();
    STEP(pA0,pA1,pB0,pB1,t+1,(t+4<NT),(t+2<NT),(t+2<NT));     ENDW(t+1); RESC(); ROT();
  }
  int snext=0;
  if(Knext!=nullptr){
    const int p0=sl_next,p1=NXT_(p0),p2=NXT_(p1); snext=p0;
    const bf16*kn=Knext+(long)lane*KP+wid*8; const bf16*vn=Vnext+(long)(16*(wid&3)+(lane>>2))*VP+(wid>>2)*32+(lane&3)*8;
    glds16(kn,(unsigned)__builtin_amdgcn_readfirstlane(kdst+p0));
    glds16(vn,(unsigned)__builtin_amdgcn_readfirstlane(vdst+2*p0)); glds16(vn+64,(unsigned)__builtin_amdgcn_readfirstlane(vdst+2*p0+8192));
    glds16(kn+(long)KVBLK*KP,(unsigned)__builtin_amdgcn_readfirstlane(kdst+p1)); glds16(kn+(long)2*KVBLK*KP,(unsigned)__builtin_amdgcn_readfirstlane(kdst+p2)); }
  STEP(pB0,pB1,pA0,pA1,NT-1,false,false,false); RESC();
  { float sacc=pB0[0]+pB0[1]; _Pragma("unroll") for(int r=2;r<16;++r)sacc+=pB0[r]; _Pragma("unroll") for(int r=0;r<16;++r)sacc+=pB1[r]; l_reg+=sacc;
    pw0=(u32x4){PKW(pB0,0),PKW(pB0,2),PKW(pB0,4),PKW(pB0,6)};pw1=(u32x4){PKW(pB0,8),PKW(pB0,10),PKW(pB0,12),PKW(pB0,14)};pw2=(u32x4){PKW(pB1,0),PKW(pB1,2),PKW(pB1,4),PKW(pB1,6)};pw3=(u32x4){PKW(pB1,8),PKW(pB1,10),PKW(pB1,12),PKW(pB1,14)};
    SBAR(); pv(o,vb0+2*sl_cur,PAF(0),PAF(1),PAF(2),PAF(3)); }
  #undef PKW
  #undef PAF
  #undef VFR
  #undef PIN
  #undef MX3
  #undef GAPA
  #undef GAPB2
  #undef VRD2
  #undef EX
  #undef VRD
  #undef KRD
  #undef STEP
  #undef ENDW
  {auto rr=__builtin_amdgcn_permlane32_swap(__float_as_uint(l_reg),__float_as_uint(l_reg),false,false);l_reg=__uint_as_float(rr[0])+__uint_as_float(rr[1]);}
  if(hi==0)wsf[32+r32]=l_reg;asm volatile("s_waitcnt lgkmcnt(0)":::"memory");
  float rli[16];
  #pragma unroll
  for(int r=0;r<16;++r)rli[r]=__builtin_amdgcn_rcpf(wsf[32+crow(r,hi)]);
  bf16*Ow=O+(long)(q0+wid*QBLK)*OP;
  bf16*stg=(bf16*)(shm+LDS_OST)+wid*2048;
  if(O1==nullptr){
    #pragma unroll
    for(int hf=0;hf<2;++hf){
      #pragma unroll
      for(int r=0;r<16;++r){const int orow=crow(r,hi);
        #pragma unroll
        for(int d0=0;d0<2;++d0)stg[orow*64+d0*32+r32]=__float2bfloat16(o[2*hf+d0][r]*rli[r]);}
      asm volatile("s_waitcnt lgkmcnt(0)":::"memory");
      #pragma unroll
      for(int i=0;i<4;++i){const int row=i*8+(lane>>3),ch=lane&7; const u32x4 v=*(const u32x4*)(stg+row*64+ch*8); ATTN_STORE16(Ow+(long)row*OP+hf*64+ch*8,v);}
      asm volatile("s_waitcnt lgkmcnt(0)":::"memory"); }
  } else {
    const bf16*O1w=O1+(long)(q0+wid*QBLK)*OP; unsigned long long p1[2][4][2];
    #pragma unroll
    for(int hf=0;hf<2;++hf)
      #pragma unroll
      for(int i=0;i<4;++i){const int row=i*8+(lane>>3),ch=lane&7; unsigned long long*a=(unsigned long long*)(O1w+(long)row*OP+hf*64+ch*8);
        p1[hf][i][0]=__hip_atomic_load(a,__ATOMIC_RELAXED,__HIP_MEMORY_SCOPE_AGENT); p1[hf][i][1]=__hip_atomic_load(a+1,__ATOMIC_RELAXED,__HIP_MEMORY_SCOPE_AGENT);}
    float dd[2][4][8]; float ssp[4]={0.f,0.f,0.f,0.f};
    #pragma unroll
    for(int hf=0;hf<2;++hf){
      #pragma unroll
      for(int r=0;r<16;++r){const int orow=crow(r,hi);
        #pragma unroll
        for(int d0=0;d0<2;++d0)stg[orow*64+d0*32+r32]=__float2bfloat16(o[2*hf+d0][r]*rli[r]);}
      asm volatile("s_waitcnt lgkmcnt(0)":::"memory");
      #pragma unroll
      for(int i=0;i<4;++i){const int row=i*8+(lane>>3),ch=lane&7; const u32x4 v=*(const u32x4*)(stg+row*64+ch*8);
        const unsigned w1[4]={(unsigned)p1[hf][i][0],(unsigned)(p1[hf][i][0]>>32),(unsigned)p1[hf][i][1],(unsigned)(p1[hf][i][1]>>32)};
        #pragma unroll
        for(int j=0;j<4;++j){ const float a0=__uint_as_float(w1[j]<<16)-lam*__uint_as_float(v[j]<<16), a1=__uint_as_float(w1[j]&0xffff0000u)-lam*__uint_as_float(v[j]&0xffff0000u);
          dd[hf][i][2*j]=a0; dd[hf][i][2*j+1]=a1; ssp[i]+=a0*a0+a1*a1; } }
      asm volatile("s_waitcnt lgkmcnt(0)":::"memory"); }
    #pragma unroll
    for(int i=0;i<4;++i){ float ss=ssp[i];
      ss+=__int_as_float(__builtin_amdgcn_update_dpp(0,__float_as_int(ss),0xB1,0xf,0xf,true)); ss+=__int_as_float(__builtin_amdgcn_update_dpp(0,__float_as_int(ss),0x4E,0xf,0xf,true)); ss+=__int_as_float(__builtin_amdgcn_update_dpp(0,__float_as_int(ss),0x141,0xf,0xf,true));
      const float rn=1.0f/sqrtf(ss*(1.0f/128.0f)+1e-6f)*0.8f;
      const int row=i*8+(lane>>3),ch=lane&7;
      #pragma unroll
      for(int hf=0;hf<2;++hf){ const float*gp=subg+hf*64+ch*8; u32x4 w;
        w[0]=cvtpk_s(dd[hf][i][0]*rn*gp[0],dd[hf][i][1]*rn*gp[1]); w[1]=cvtpk_s(dd[hf][i][2]*rn*gp[2],dd[hf][i][3]*rn*gp[3]);
        w[2]=cvtpk_s(dd[hf][i][4]*rn*gp[4],dd[hf][i][5]*rn*gp[5]); w[3]=cvtpk_s(dd[hf][i][6]*rn*gp[6],dd[hf][i][7]*rn*gp[7]);
        *(u32x4*)(CAo+(long)(q0+wid*QBLK+row)*1024+hf*64+ch*8)=w; } }
  }
  asm volatile("s_waitcnt lgkmcnt(0)\n\ts_barrier":::"memory");
  #undef DMA_K
  #undef DMA_V
  #undef CMASK
  #undef START
  #undef RESC
  #undef ROT
  #undef NXT_
  return snext;
}
constexpr int ATTN_LDS_BYTES=LDS_BYTES;
#undef SBAR
#undef WAIT_BAR
}

constexpr int NWAVES = 8, NTHREADS = NWAVES * 64;
#ifndef MK_PER_PHASE
#define MK_PER_PHASE 0
#endif
#ifndef RUN_PHASES
#define RUN_PHASES 8
#endif
constexpr int N_PHASES = RUN_PHASES;

constexpr size_t MiB = 1u << 20;
constexpr size_t WS_CTL = 0, CTL_ZERO_BYTES = 65536;
constexpr size_t WS_RS = 1 * MiB;
constexpr size_t WS_TINFO = 2 * MiB;
constexpr size_t WS_WR = 3 * MiB;
constexpr size_t WS_LTOK = 4 * MiB, WS_LW = 8 * MiB;
constexpr size_t WS_WIN = 16 * MiB, WS_WCA = 25 * MiB, WS_WOUT = 27 * MiB;
constexpr size_t WS_A = 32 * MiB;
constexpr size_t WS_QB = 112 * MiB, WS_KB = 144 * MiB, WS_VB = 176 * MiB, WS_YG = 208 * MiB;
constexpr size_t WS_MG = 112 * MiB, WS_XM = 176 * MiB;
constexpr size_t WS_GT = 240 * MiB;
constexpr size_t WS_WGU = 240 * MiB, WS_WD = 304 * MiB;
constexpr size_t WS_CA = 368 * MiB;
constexpr size_t WS_YB = 112 * MiB;
constexpr size_t WS_LIST = 432 * MiB;
constexpr size_t WS_CTOK = 448 * MiB;
constexpr size_t WS_END = 464 * MiB;
static_assert(WS_A + (size_t)CROWS * 1024 <= WS_QB && WS_WD + (size_t)NEXP * 1024 * 512 <= WS_CA, "d_ws map");
static_assert(WS_WIN + (size_t)IN_COLS * 1024 * 2 <= WS_WCA, "d_ws map");

constexpr int RING_BYTES = 131072;
constexpr int META_OFF = RING_BYTES;
constexpr int HIST_OFF = RING_BYTES + 1024;
constexpr int BARST_OFF = RING_BYTES + 3072;
constexpr int META2_OFF = RING_BYTES + 4096;
constexpr int LDS_BYTES = 147456;

#define GAS __attribute__((address_space(1)))
#define LAS __attribute__((address_space(3)))
typedef unsigned short bf16;
typedef unsigned v4u __attribute__((ext_vector_type(4)));
typedef unsigned v2u __attribute__((ext_vector_type(2)));
typedef float f32x4 __attribute__((ext_vector_type(4)));
typedef float f32x16 __attribute__((ext_vector_type(16)));
typedef short bf16x8 __attribute__((ext_vector_type(8)));
using pg8::cvt_pk_bf16; using pg8::bf_lo; using pg8::bf_hi; using pg8::sigmoidf_fast; using pg8::pack8; using pg8::unpack8;

__device__ __forceinline__ float wave_sum(float v) {
    v += __int_as_float(__builtin_amdgcn_update_dpp(0, __float_as_int(v), 0xB1, 0xf, 0xf, true));
    v += __int_as_float(__builtin_amdgcn_update_dpp(0, __float_as_int(v), 0x4E, 0xf, 0xf, true));
    v += __int_as_float(__builtin_amdgcn_update_dpp(0, __float_as_int(v), 0x141, 0xf, 0xf, true));
    v += __int_as_float(__builtin_amdgcn_update_dpp(0, __float_as_int(v), 0x140, 0xf, 0xf, true));
    const int iv = __float_as_int(v);
    return (__int_as_float(__builtin_amdgcn_readlane(iv, 0)) + __int_as_float(__builtin_amdgcn_readlane(iv, 16))) + (__int_as_float(__builtin_amdgcn_readlane(iv, 32)) + __int_as_float(__builtin_amdgcn_readlane(iv, 48)));
}
__device__ __forceinline__ float wave_max(float v) {
    v = fmaxf(v, __int_as_float(__builtin_amdgcn_update_dpp(0, __float_as_int(v), 0xB1, 0xf, 0xf, true)));
    v = fmaxf(v, __int_as_float(__builtin_amdgcn_update_dpp(0, __float_as_int(v), 0x4E, 0xf, 0xf, true)));
    v = fmaxf(v, __int_as_float(__builtin_amdgcn_update_dpp(0, __float_as_int(v), 0x141, 0xf, 0xf, true)));
    v = fmaxf(v, __int_as_float(__builtin_amdgcn_update_dpp(0, __float_as_int(v), 0x140, 0xf, 0xf, true)));
    const int iv = __float_as_int(v);
    return fmaxf(fmaxf(__int_as_float(__builtin_amdgcn_readlane(iv, 0)), __int_as_float(__builtin_amdgcn_readlane(iv, 16))), fmaxf(__int_as_float(__builtin_amdgcn_readlane(iv, 32)), __int_as_float(__builtin_amdgcn_readlane(iv, 48))));
}
__device__ __forceinline__ float bf16_round(float x) { return bf_lo(cvt_pk_bf16(x, 0.f) & 0xffffu); }

#define XB_TMO      128
#define XB_XCNT(j)  (256  + 64 * (j))
#define XB_XSUB(j)  (1280 + 64 * (j))
#define XB_XGEN(j)  (2304 + 64 * (j))
#define XB_TOP      3328
#define XB_TOPGEN   3392
#define XCD_BAR_WORDS 3456
#define XB_SPIN_CAP (1u << 18)

__device__ __forceinline__ unsigned xb_ld(unsigned* p)              { return __hip_atomic_load(p, __ATOMIC_RELAXED, __HIP_MEMORY_SCOPE_AGENT); }
__device__ __forceinline__ unsigned xb_add(unsigned* p, unsigned v) { return __hip_atomic_fetch_add(p, v, __ATOMIC_RELAXED, __HIP_MEMORY_SCOPE_AGENT); }
__device__ __forceinline__ unsigned xb_xcc_id() { return (unsigned)__builtin_amdgcn_s_getreg((3 << 11) | 20) & 0xFu; }
#define XB_SPIN(cond, bar) do { unsigned _sp = 0; while (cond) { __builtin_amdgcn_s_sleep(1); \
    if ((++_sp & 255u) == 0u) { if (xb_ld(&(bar)[XB_TMO])) break; if (_sp > XB_SPIN_CAP) { atomicAdd(&(bar)[XB_TMO], 1u); break; } } } } while (0)

struct XcdBarrier {
    unsigned* bar; unsigned x;
    volatile LAS unsigned* st;
};

__device__ __forceinline__ XcdBarrier xcd_barrier_post(unsigned* bar, volatile LAS unsigned* st) {
    XcdBarrier b; b.bar = bar; b.x = xb_xcc_id(); b.st = st;
    if (threadIdx.x == 0) (void)xb_add(&bar[XB_XCNT(b.x)], 1u);
    return b;
}
__device__ __forceinline__ void xcd_barrier_complete(unsigned* bar, unsigned x, unsigned& nloc, unsigned& nx) {
    const unsigned G = gridDim.x * gridDim.y * gridDim.z;
    unsigned sum, cnt, mine, sp = 0u;
    for (;;) {
        sum = 0u; cnt = 0u; mine = 0u;
#pragma unroll
        for (unsigned j = 0; j < 16; ++j) { const unsigned c = xb_ld(&bar[XB_XCNT(j)]); sum += c; cnt += (c > 0u) ? 1u : 0u; mine = (j == x) ? c : mine; }
        if (sum == G) break;
        __builtin_amdgcn_s_sleep(1);
        if ((++sp & 255u) == 0u) { if (xb_ld(&bar[XB_TMO])) break; if (sp > XB_SPIN_CAP) { atomicAdd(&bar[XB_TMO], 1u); break; } }
    }
    nloc = mine > 0u ? mine : 1u; nx = cnt > 0u ? cnt : 1u;
}

__device__ __forceinline__ void xcd_barrier(const XcdBarrier& b) {
    asm volatile("s_waitcnt vmcnt(0)" ::: "memory");
    __syncthreads();
    if (threadIdx.x == 0) {
        unsigned* bar = b.bar;
        __builtin_amdgcn_s_waitcnt(0);
        unsigned nloc = b.st[0], nx = b.st[1];
        if (nloc == 0u) { xcd_barrier_complete(bar, b.x, nloc, nx); b.st[0] = nloc; b.st[1] = nx; }
        const unsigned old = xb_add(&bar[XB_XSUB(b.x)], 1u);
        const unsigned gen = old / nloc;
        if (old + 1u == (gen + 1u) * nloc) {
            __builtin_amdgcn_fence(__ATOMIC_RELEASE, "agent");
            asm volatile("s_waitcnt vmcnt(0)" ::: "memory");
            const unsigned og = xb_add(&bar[XB_TOP], 1u);
            const unsigned tg = og / nx;
            if (og + 1u == (tg + 1u) * nx) xb_add(&bar[XB_TOPGEN], 1u);
            else XB_SPIN(xb_ld(&bar[XB_TOPGEN]) == tg, bar);
            __builtin_amdgcn_fence(__ATOMIC_ACQUIRE, "agent");
            xb_add(&bar[XB_XGEN(b.x)], 1u);
            asm volatile("s_waitcnt vmcnt(0)" ::: "memory");
        } else {
            XB_SPIN(xb_ld(&bar[XB_XGEN(b.x)]) == gen, bar);
            __builtin_amdgcn_fence(__ATOMIC_ACQUIRE, "agent");
            asm volatile("s_waitcnt vmcnt(0)" ::: "memory");
        }
    }
    __syncthreads();
}


typedef f32x4 AccT[2][2][4][2];
struct EpiInProj {
    static constexpr bool MID = false;
    bf16 *YG, *QB, *KB, *VB, *GT; const LAS float* gl;
    __device__ __forceinline__ void mid(AccT&, const pg8::Unit&, int, int, int, int) const {}
    __device__ __forceinline__ void operator()(AccT& acc, const pg8::Unit& u, int wr, int wc, int fr, int fq) const {
        asm volatile("" : "+v"(fr), "+v"(fq));
        const int pn = u.pn; const size_t row0 = (size_t)u.orow + wr * 64 + fr;
        if (pn < 4) {
#pragma unroll
            for (int ai = 0; ai < 2; ++ai)
#pragma unroll
                for (int m = 0; m < 4; ++m) { const size_t row = row0 + ai * 128 + m * 16; f32x4 y[2];
#pragma unroll
                    for (int n = 0; n < 2; ++n) { const f32x4 a = acc[ai][0][m][n], g = acc[ai][1][m][n];
                        y[n] = (f32x4){a[0] * sigmoidf_fast(g[0]), a[1] * sigmoidf_fast(g[1]), a[2] * sigmoidf_fast(g[2]), a[3] * sigmoidf_fast(g[3])}; }
                    __builtin_nontemporal_store(pack8(y[0], y[1]), (v4u*)(YG + row * 512 + pn * 128 + wc * 32 + 8 * fq)); }
        } else if (pn < 8) {
            const bool isq = pn < 6; bf16* base = isq ? QB : KB; const LAS float* gp = gl + (isq ? 0 : 64); const float sc = isq ? 0.125f * 1.4426950408889634f : 1.0f;
            f32x4 gv[2][2];
#pragma unroll
            for (int bj = 0; bj < 2; ++bj)
#pragma unroll
                for (int n = 0; n < 2; ++n) gv[bj][n] = *(const LAS f32x4*)(gp + 32 * bj + 8 * fq + 4 * n) * sc;
#pragma unroll
            for (int ai = 0; ai < 2; ++ai)
#pragma unroll
                for (int m = 0; m < 4; ++m) { const size_t row = row0 + ai * 128 + m * 16; float ss = 0.f;
#pragma unroll
                    for (int bj = 0; bj < 2; ++bj)
#pragma unroll
                        for (int n = 0; n < 2; ++n) { const f32x4 a = acc[ai][bj][m][n]; ss += (a[0] * a[0] + a[1] * a[1]) + (a[2] * a[2] + a[3] * a[3]); }
                    ss += __shfl_xor(ss, 16); ss += __shfl_xor(ss, 32);
                    const float rinv = 1.0f / sqrtf(ss * (1.0f / 64.0f) + EPS);
#pragma unroll
                    for (int bj = 0; bj < 2; ++bj)
                        __builtin_nontemporal_store(pack8(acc[ai][bj][m][0] * rinv * gv[bj][0], acc[ai][bj][m][1] * rinv * gv[bj][1]), (v4u*)(base + row * 512 + (pn & 1) * 256 + wc * 64 + bj * 32 + 8 * fq)); }
        } else if (pn < 10) {
#pragma unroll
            for (int ai = 0; ai < 2; ++ai)
#pragma unroll
                for (int m = 0; m < 4; ++m) { const size_t row = row0 + ai * 128 + m * 16;
#pragma unroll
                    for (int bj = 0; bj < 2; ++bj) __builtin_nontemporal_store(pack8(acc[ai][bj][m][0], acc[ai][bj][m][1]), (v4u*)(VB + row * 512 + (pn - 8) * 256 + bj * 128 + wc * 32 + 8 * fq)); }
        } else {
#pragma unroll
            for (int ai = 0; ai < 2; ++ai)
#pragma unroll
                for (int m = 0; m < 4; ++m) { const size_t row = row0 + ai * 128 + m * 16; f32x4 rr[2], gg[2];
#pragma unroll
                    for (int n = 0; n < 2; ++n)
#pragma unroll
                        for (int j = 0; j < 4; ++j) { const float e0 = __builtin_amdgcn_exp2f(-1.4426950408889634f * acc[ai][0][m][n][j]), e1 = fminf(__builtin_amdgcn_exp2f(-1.4426950408889634f * acc[ai][1][m][n][j]), 1e30f);
                            gg[n][j] = __builtin_amdgcn_rcpf(1.0f + e1); rr[n][j] = (1.0f + e1) * __builtin_amdgcn_rcpf(1.0f + e0); }
                    const size_t o = row * 1024 + (pn - 10) * 128 + wc * 32 + 8 * fq;
                    __builtin_nontemporal_store(pack8(rr[0], rr[1]), (v4u*)(GT + o)); __builtin_nontemporal_store(pack8(gg[0], gg[1]), (v4u*)(GT + (size_t)NTOK * 1024 + o)); }
        }
    }
};
struct EpiMerged {
    static constexpr bool MID = true;
    const bf16* GR; const bf16* G1; bf16* MG;
    __device__ __forceinline__ void mid(AccT& acc, const pg8::Unit& u, int wr, int wc, int fr, int fq) const {
        asm volatile("" : "+v"(fr), "+v"(fq));
        const size_t row0 = (size_t)u.orow + wr * 64 + fr; const int col0 = u.pn * 256 + wc * 32 + 8 * fq;
        v4u w0[2][4][2];
#pragma unroll
        for (int ai = 0; ai < 2; ++ai)
#pragma unroll
            for (int m = 0; m < 4; ++m)
#pragma unroll
                for (int bj = 0; bj < 2; ++bj) w0[ai][m][bj] = *(const v4u*)(GR + (row0 + ai * 128 + m * 16) * 1024 + col0 + bj * 128);
        __builtin_amdgcn_sched_barrier(0);
#pragma unroll
        for (int ai = 0; ai < 2; ++ai)
#pragma unroll
            for (int m = 0; m < 4; ++m)
#pragma unroll
                for (int bj = 0; bj < 2; ++bj) { f32x4 a0, a1; unpack8(w0[ai][m][bj], a0, a1); acc[ai][bj][m][0] = acc[ai][bj][m][0] * a0; acc[ai][bj][m][1] = acc[ai][bj][m][1] * a1; }
        __builtin_amdgcn_sched_barrier(0);
    }
    __device__ __forceinline__ void operator()(AccT& acc, const pg8::Unit& u, int wr, int wc, int fr, int fq) const {
        asm volatile("" : "+v"(fr), "+v"(fq));
        const size_t row0 = (size_t)u.orow + wr * 64 + fr; const int col0 = u.pn * 256 + wc * 32 + 8 * fq;
        v4u w1[2][4][2];
#pragma unroll
        for (int ai = 0; ai < 2; ++ai)
#pragma unroll
            for (int m = 0; m < 4; ++m)
#pragma unroll
                for (int bj = 0; bj < 2; ++bj) w1[ai][m][bj] = *(const v4u*)(G1 + (row0 + ai * 128 + m * 16) * 1024 + col0 + bj * 128);
        __builtin_amdgcn_sched_barrier(0);
#pragma unroll
        for (int ai = 0; ai < 2; ++ai)
#pragma unroll
            for (int m = 0; m < 4; ++m) { const size_t row = row0 + ai * 128 + m * 16;
#pragma unroll
                for (int bj = 0; bj < 2; ++bj) { f32x4 b0, b1; unpack8(w1[ai][m][bj], b0, b1);
                    *(v4u*)(MG + row * 1024 + col0 + bj * 128) = pack8(acc[ai][bj][m][0] * b0, acc[ai][bj][m][1] * b1); } }
    }
};
struct EpiOut {
    static constexpr bool MID = false;
    const float* x; bf16* XMB; unsigned char* XM8;
    __device__ __forceinline__ void mid(AccT&, const pg8::Unit&, int, int, int, int) const {}
    __device__ __forceinline__ void operator()(AccT& acc, const pg8::Unit& u, int wr, int wc, int fr, int fq) const {
        asm volatile("" : "+v"(fr), "+v"(fq));
        const size_t row0 = (size_t)u.orow + wr * 64 + fr; const int col0 = u.pn * 256 + wc * 32 + 8 * fq;
#pragma unroll
        for (int ai = 0; ai < 2; ++ai) {
            f32x4 xv[4][2][2];
#pragma unroll
            for (int m = 0; m < 4; ++m) { const size_t off = (row0 + ai * 128 + m * 16) * 1024 + col0;
#pragma unroll
                for (int bj = 0; bj < 2; ++bj) { xv[m][bj][0] = __builtin_nontemporal_load((const f32x4*)(x + off + bj * 128)); xv[m][bj][1] = __builtin_nontemporal_load((const f32x4*)(x + off + bj * 128 + 4)); } }
            __builtin_amdgcn_sched_barrier(0);
#pragma unroll
            for (int m = 0; m < 4; ++m) { const size_t off = (row0 + ai * 128 + m * 16) * 1024 + col0;
#pragma unroll
                for (int bj = 0; bj < 2; ++bj) { const f32x4 o0 = xv[m][bj][0] + acc[ai][bj][m][0], o1 = xv[m][bj][1] + acc[ai][bj][m][1];
                    *(v4u*)(XMB + off + bj * 128) = pack8(o0, o1);
                    v2u w8; w8.x = pg8::pack4_fp8(o0[0], o0[1], o0[2], o0[3]); w8.y = pg8::pack4_fp8(o1[0], o1[1], o1[2], o1[3]); *(v2u*)(XM8 + off + bj * 128) = w8; } }
            __builtin_amdgcn_sched_barrier(0);
        }
    }
};
struct EpiGateUp {
    static constexpr bool MID = false;
    const int* LIST; unsigned char* HP8; const LAS int* m2;
    __device__ __forceinline__ void mid(AccT&, const pg8::Unit&, int, int, int, int) const {}
    __device__ __forceinline__ void operator()(AccT& acc, const pg8::Unit& u, int wr, int wc, int fr, int fq) const {
        asm volatile("" : "+v"(fr), "+v"(fq));
        typedef int i32x4 __attribute__((ext_vector_type(4)));
        i32x4 ent[2][4];
#pragma unroll
        for (int ai = 0; ai < 2; ++ai)
#pragma unroll
            for (int m = 0; m < 4; ++m) { const int r = ai * 128 + wr * 64 + m * 16 + fr; ent[ai][m] = (r < u.nvalid) ? *(const i32x4*)(LIST + (size_t)(u.lrow + r) * 4) : (i32x4){-1, 0, 0, 0}; }
#pragma unroll
        for (int ai = 0; ai < 2; ++ai)
#pragma unroll
            for (int m = 0; m < 4; ++m) { const i32x4 en = ent[ai][m]; if (en[0] < 0) continue;
                const float rs = __int_as_float(en[3]) * (1.0f / 64.0f), w8 = __int_as_float(en[2]) * 8.0f;
                const int dst = en[1]; const size_t drow = (size_t)m2[dst >> 17] * 256 + ((dst >> 1) & 0xffff);
                float h[8];
#pragma unroll
                for (int n = 0; n < 2; ++n)
#pragma unroll
                    for (int j = 0; j < 4; ++j) { const float g = acc[ai][0][m][n][j] * rs, up = acc[ai][1][m][n][j] * rs; h[4 * n + j] = __builtin_amdgcn_fmed3f(g * sigmoidf_fast(g) * up * w8, -448.f, 448.f); }
                v2u o8; o8.x = pg8::pack4_fp8(h[0], h[1], h[2], h[3]); o8.y = pg8::pack4_fp8(h[4], h[5], h[6], h[7]);
                *(v2u*)(HP8 + drow * 1024 + (dst & 1) * 512 + u.pn * 128 + wc * 32 + 8 * fq) = o8; }
    }
};
struct EpiDownAdd {
    static constexpr bool MID = false;
    const int* CTOK; const bf16* XMB; float* out;
    __device__ __forceinline__ void mid(AccT&, const pg8::Unit&, int, int, int, int) const {}
    __device__ __forceinline__ void operator()(AccT& acc, const pg8::Unit& u, int wr, int wc, int fr, int fq) const {
        asm volatile("" : "+v"(fr), "+v"(fq));
        const int col0 = u.pn * 256 + wc * 32 + 8 * fq;
        int tokall[2][4];
#pragma unroll
        for (int ai = 0; ai < 2; ++ai)
#pragma unroll
            for (int m = 0; m < 4; ++m) { const int r = ai * 128 + wr * 64 + m * 16 + fr; tokall[ai][m] = (r < u.nvalid) ? CTOK[u.lrow + r] : -1; }
        v4u xw[2][4][2];
#pragma unroll
        for (int ai = 0; ai < 2; ++ai)
#pragma unroll
            for (int m = 0; m < 4; ++m) { const int tk = tokall[ai][m]; const size_t off = (size_t)(tk < 0 ? 0 : tk) * 1024 + col0;
#pragma unroll
                for (int bj = 0; bj < 2; ++bj) xw[ai][m][bj] = *(const v4u*)(XMB + off + bj * 128); }
        __builtin_amdgcn_sched_barrier(0);
#pragma unroll
        for (int ai = 0; ai < 2; ++ai)
#pragma unroll
            for (int m = 0; m < 4; ++m) { const int tk = tokall[ai][m]; if (tk < 0) continue; const size_t off = (size_t)tk * 1024 + col0;
#pragma unroll
                for (int bj = 0; bj < 2; ++bj) { f32x4 x0, x1; unpack8(xw[ai][m][bj], x0, x1);
                    __builtin_nontemporal_store(x0 + acc[ai][bj][m][0] * (1.0f / 256.0f), (f32x4*)(out + off + bj * 128)); __builtin_nontemporal_store(x1 + acc[ai][bj][m][1] * (1.0f / 256.0f), (f32x4*)(out + off + bj * 128 + 4)); } }
    }
};
struct MoeOrder {
    int G, c, total; const LAS int* meta;
    __device__ __forceinline__ bool next(int i, pg8::Unit& u) const {
        const int L = i * G + c; if (L >= total * 4) return false;
        const int blk = L >> 2; int lane = threadIdx.x & 63; asm volatile("" : "+v"(lane));
        const int e = __builtin_amdgcn_readfirstlane(__builtin_popcountll(__ballot(lane < NEXP - 1 && meta[1 + lane] <= blk)));
        const int pre = __builtin_amdgcn_readfirstlane(meta[e]), cnt = __builtin_amdgcn_readfirstlane(meta[64 + e]); const int rb = blk - pre;
        u.pn = L & 3; u.pm = rb; u.e = e; u.e2 = e; u.lrow = e * LCAP + rb * 256; u.nvalid = min(256, cnt - rb * 256); u.orow = blk * 256; u.arow = 0; return true;
    }
};
struct ClassOrder {
    int G, c, total; const LAS int* m2;
    __device__ __forceinline__ bool next(int i, pg8::Unit& u) const {
        const int L = i * G + c; if (L >= total * 4) return false;
        const int blk = L >> 2; int lane = threadIdx.x & 63; asm volatile("" : "+v"(lane));
        const int n0 = __builtin_popcountll(__ballot(m2[1 + lane] <= blk)), n1 = __builtin_popcountll(__ballot(lane + 65 <= NCLS - 1 && m2[65 + lane] <= blk));
        const int cls = __builtin_amdgcn_readfirstlane(n0 + n1);
        const int pre = __builtin_amdgcn_readfirstlane(m2[cls]), cnt = __builtin_amdgcn_readfirstlane(m2[128 + cls]); const int rb = blk - pre;
        const int g = cls / 28; int p = cls % 28, a = 0;
        while (p >= 7 - a) { p -= 7 - a; ++a; }
        u.e = g * 8 + a; u.e2 = g * 8 + a + 1 + p; u.pn = L & 3; u.pm = rb; u.lrow = cls * NTOK + rb * 256; u.nvalid = min(256, cnt - rb * 256); u.orow = blk * 256; u.arow = u.orow; return true;
    }
};
__device__ __forceinline__ void moe_meta(LAS int* meta, LAS int* m2, const unsigned* ctl) {
    const int tid = tid_opaque();
    if (tid < NEXP) meta[64 + tid] = (int)__hip_atomic_load(ctl + tid, __ATOMIC_RELAXED, __HIP_MEMORY_SCOPE_AGENT);
    if (tid >= 64 && tid < 64 + NCLS) m2[128 + tid - 64] = (int)__hip_atomic_load(ctl + tid, __ATOMIC_RELAXED, __HIP_MEMORY_SCOPE_AGENT);
    __syncthreads();
    if (tid == 0) { int p = 0;
        for (int e = 0; e < NEXP; ++e) { meta[e] = p; p += (meta[64 + e] + 255) >> 8; }
        meta[NEXP] = p; }
    if (tid == 64) { int p = 0;
        for (int c = 0; c < NCLS; ++c) { m2[c] = p; p += (m2[128 + c] + 255) >> 8; }
        m2[NCLS] = p; }
    __syncthreads();
}

__device__ __forceinline__ void transpose_item(const float* W, int N, int k0, int n0, bf16* WT, int dpitch, int drow0, int dcol0, const float* kscale, LAS float* scr, int lane) {
    const int kr = lane >> 3, nc = (lane & 7) * 4;
    f32x4 v[8];
#pragma unroll
    for (int i = 0; i < 8; ++i) v[i] = *(const f32x4*)(W + (size_t)(k0 + i * 8 + kr) * N + n0 + nc);
    if (kscale) {
#pragma unroll
        for (int i = 0; i < 8; ++i) v[i] = v[i] * kscale[k0 + i * 8 + kr]; }
#pragma unroll
    for (int i = 0; i < 8; ++i) { LAS float* d = scr + (i * 8 + kr) * 33 + nc; d[0] = v[i][0]; d[1] = v[i][1]; d[2] = v[i][2]; d[3] = v[i][3]; }
    asm volatile("s_waitcnt lgkmcnt(0)" ::: "memory");
    const int c = lane & 7;
#pragma unroll
    for (int j = 0; j < 4; ++j) { const int n = (lane >> 3) + 8 * j; const LAS float* s = scr + (8 * c) * 33 + n;
        v4u o; o.x = cvt_pk_bf16(s[0 * 33], s[1 * 33]); o.y = cvt_pk_bf16(s[2 * 33], s[3 * 33]); o.z = cvt_pk_bf16(s[4 * 33], s[5 * 33]); o.w = cvt_pk_bf16(s[6 * 33], s[7 * 33]);
        *(v4u*)(WT + (size_t)(drow0 + n) * dpitch + dcol0 + k0 + 8 * c) = o; }
    asm volatile("s_waitcnt lgkmcnt(0)" ::: "memory");
}
__device__ __forceinline__ void t8_load(f32x4 (&v)[8], const float* W, int N, int k0, int n0, int lane) {
    const int kr = lane >> 3, nc = (lane & 7) * 4;
#pragma unroll
    for (int i = 0; i < 8; ++i) v[i] = __builtin_nontemporal_load((const f32x4*)(W + (size_t)(k0 + i * 8 + kr) * N + n0 + nc));
}
__device__ __forceinline__ void t8_finish(f32x4 (&v)[8], int k0, unsigned char* WT, int dpitch, int drow0, const float* kscale, float mul, LAS float* scr, int lane) {
    const int kr = lane >> 3, nc = (lane & 7) * 4;
#pragma unroll
    for (int i = 0; i < 8; ++i) v[i] = v[i] * (kscale ? kscale[k0 + i * 8 + kr] * mul : mul);
#pragma unroll
    for (int i = 0; i < 8; ++i) { LAS float* d = scr + (i * 8 + kr) * 33 + nc; d[0] = v[i][0]; d[1] = v[i][1]; d[2] = v[i][2]; d[3] = v[i][3]; }
    asm volatile("s_waitcnt lgkmcnt(0)" ::: "memory");
    const int c = lane & 7;
#pragma unroll
    for (int j = 0; j < 4; ++j) { const int n = (lane >> 3) + 8 * j; const LAS float* s = scr + (8 * c) * 33 + n;
        v2u o; o.x = pg8::pack4_fp8(s[0 * 33], s[1 * 33], s[2 * 33], s[3 * 33]); o.y = pg8::pack4_fp8(s[4 * 33], s[5 * 33], s[6 * 33], s[7 * 33]);
        *(v2u*)(WT + (size_t)(drow0 + n) * dpitch + k0 + 8 * c) = o; }
    asm volatile("s_waitcnt lgkmcnt(0)" ::: "memory");
}
__device__ __forceinline__ void transpose_item_fp8(const float* W, int N, int k0, int n0, unsigned char* WT, int dpitch, int drow0, const float* kscale, float mul, LAS float* scr, int lane) {
    f32x4 v[8]; t8_load(v, W, N, k0, n0, lane); t8_finish(v, k0, WT, dpitch, drow0, kscale, mul, scr, lane);
}
__device__ __forceinline__ int inproj_phys(int c) {
    if (c < 512) return (c >> 7) * 256 + (c & 127);
    if (c < 1024) { c -= 512; return (c >> 7) * 256 + 128 + (c & 127); }
    if (c < 2048) { const int sec = (c - 1024) >> 8, cl = (c - 1024) & 255, s = cl >> 6, d = cl & 63; return 1024 + sec * 256 + ((d >> 5) << 7) + (s << 5) + (d & 31); }
    if (c < 2560) return c;
    { int j = c - 2560; const int hi = j >= 1024; j &= 1023; return 2560 + (j >> 7) * 256 + hi * 128 + (j & 127); }
}
struct Ptrs {
    const float *x, *attn_norm_g, *w_in, *conv_dw_w, *conv_dw_b, *conv_ln_g, *conv_ln_b, *w_conv_out, *q_norm_g, *k_norm_g, *lq1, *lk1, *lq2, *lk2, *subln_g,
        *w_attn_out, *w_out, *ffn_norm_g, *w_rg, *b_rg, *w_re, *b_re, *w_gate, *w_up, *w_down;
    float* out; unsigned char* ws;
};

__device__ __forceinline__ void p0_prologue(const Ptrs& P, LAS unsigned char* lds, int vcu, int G) {
    const int tid = tid_opaque(), lane = tid & 63, wave = __builtin_amdgcn_readfirstlane(tid >> 6);
    LAS float* scr = (LAS float*)(lds + wave * 16384);
    const int gw = vcu * NWAVES + wave, NGW = G * NWAVES;
    bf16* WIN = (bf16*)(P.ws + WS_WIN); bf16* WCA = (bf16*)(P.ws + WS_WCA); bf16* WOUT = (bf16*)(P.ws + WS_WOUT);
    constexpr int I_IN = (DMODEL / 64) * (IN_COLS / 32), I_C = (CONV_CH / 64) * (DMODEL / 32), I_O = (DMODEL / 64) * (DMODEL / 32);
    for (int it = gw; it < I_IN + 2 * I_C + I_O; it += NGW) {
        int r = it;
        if (r < I_IN) { const int kb = r / (IN_COLS / 32), nb = r % (IN_COLS / 32); transpose_item(P.w_in, IN_COLS, kb * 64, nb * 32, WIN, 1024, inproj_phys(nb * 32), 0, nullptr, scr, lane); continue; } r -= I_IN;
        if (r < I_C) { const int kb = r / 32, nb = r % 32; transpose_item(P.w_conv_out, DMODEL, kb * 64, nb * 32, WCA, 1024, nb * 32, 0, nullptr, scr, lane); continue; } r -= I_C;
        if (r < I_C) { const int kb = r / 32, nb = r % 32; transpose_item(P.w_attn_out, DMODEL, kb * 64, nb * 32, WCA, 1024, nb * 32, 512, nullptr, scr, lane); continue; } r -= I_C;
        { const int kb = r / 32, nb = r % 32; transpose_item(P.w_out, DMODEL, kb * 64, nb * 32, WOUT, 1024, nb * 32, 0, nullptr, scr, lane); }
    }
    bf16* WRhi = (bf16*)(P.ws + WS_WR); bf16* WRlo = WRhi + 64 * 1024;
    for (int idx = vcu * NTHREADS + tid; idx < 64 * 1024; idx += G * NTHREADS) {
        const int n = idx >> 10, k = idx & 1023; float v = 0.f;
        if (n < 4) v = P.w_rg[k * 4 + n]; else if (n < 36) v = P.w_re[k * 32 + (n - 4)];
        v *= P.ffn_norm_g[k];
        const unsigned hb = cvt_pk_bf16(v, 0.f) & 0xffffu; const float hf = __uint_as_float(hb << 16);
        WRhi[idx] = (bf16)hb; WRlo[idx] = (bf16)(cvt_pk_bf16(v - hf, 0.f) & 0xffffu);
    }
    bf16* HB = (bf16*)(P.ws + WS_A);
    f32x4 gq[4];
#pragma unroll
    for (int j = 0; j < 4; ++j) gq[j] = ((const f32x4*)P.attn_norm_g)[64 * j + lane];
    constexpr int RPT = 4;
    for (int m = gw; m < NTOK; m += RPT * NGW) {
        f32x4 v[RPT][4];
#pragma unroll
        for (int q = 0; q < RPT; ++q) { const int mq = m + q * NGW; const f32x4* xr = (const f32x4*)(P.x + (size_t)(mq < NTOK ? mq : m) * DMODEL) + lane;
#pragma unroll
            for (int j = 0; j < 4; ++j) v[q][j] = __builtin_nontemporal_load(xr + 64 * j); }
#pragma unroll
        for (int q = 0; q < RPT; ++q) { const int mq = m + q * NGW; float ss = 0.f;
#pragma unroll
            for (int j = 0; j < 4; ++j) ss += (v[q][j][0] * v[q][j][0] + v[q][j][1] * v[q][j][1]) + (v[q][j][2] * v[q][j][2] + v[q][j][3] * v[q][j][3]);
            const float r = 1.0f / sqrtf(wave_sum(ss) * (1.0f / DMODEL) + EPS);
            if (mq < NTOK) { v2u* o8 = (v2u*)(HB + (size_t)mq * DMODEL) + lane;
#pragma unroll
                for (int j = 0; j < 4; ++j) { const f32x4 y = v[q][j] * r * gq[j]; v2u w; w.x = cvt_pk_bf16(y[0], y[1]); w.y = cvt_pk_bf16(y[2], y[3]); o8[64 * j] = w; } } }
    }
}

__device__ __forceinline__ void conv_phase(const Ptrs& P, LAS unsigned char* lds, int first, int stride) {
    const int tid = tid_opaque(), lane = tid & 63, wave = __builtin_amdgcn_readfirstlane(tid >> 6);
    const bf16* YG = (const bf16*)(P.ws + WS_YG); bf16* CA = (bf16*)(P.ws + WS_CA);
    LAS bf16* yt = (LAS bf16*)lds; LAS float* co = (LAS float*)(lds + 62 * 1024);
    constexpr int NT = NTOK / 32;
    if (first >= NT) return;
    float w[CONV_W];
#pragma unroll
    for (int j = 0; j < CONV_W; ++j) w[j] = P.conv_dw_w[j * CONV_CH + tid];
    const float bias = P.conv_dw_b[tid];
    const f32x4 g0 = ((const f32x4*)P.conv_ln_g)[lane], g1 = ((const f32x4*)P.conv_ln_g)[64 + lane], b0 = ((const f32x4*)P.conv_ln_b)[lane], b1 = ((const f32x4*)P.conv_ln_b)[64 + lane];
    v4u pre[8];
#define CONV_FETCH(tile) do { const int b_ = (tile) / (SEQ / 32), t0_ = ((tile) % (SEQ / 32)) * 32; _Pragma("unroll") for (int p = 0; p < 8; ++p) { const int q = tid + NTHREADS * p; const int row = q >> 6, ch = q & 63, t = t0_ - 30 + row; \
        pre[p] = (v4u){0u, 0u, 0u, 0u}; if (q < 62 * 64 && t >= 0) pre[p] = *(const v4u*)(YG + ((size_t)(b_ * SEQ + t)) * 512 + ch * 8); } } while (0)
    CONV_FETCH(first);
    for (int tile = first; tile < NT; tile += stride) {
        const int b = tile / (SEQ / 32), t0 = (tile % (SEQ / 32)) * 32;
#pragma unroll
        for (int p = 0; p < 8; ++p) { const int q = tid + NTHREADS * p; if (q < 62 * 64) *(LAS v4u*)(yt + (q >> 6) * 512 + (q & 63) * 8) = pre[p]; }
        __syncthreads();
        if (tile + stride < NT) CONV_FETCH(tile + stride);
        float yv[62];
#pragma unroll
        for (int i = 0; i < 62; ++i) yv[i] = __uint_as_float((unsigned)yt[i * 512 + tid] << 16);
#pragma unroll
        for (int t = 0; t < 32; ++t) { float a = bias;
#pragma unroll
            for (int j = 0; j < CONV_W; ++j) a += w[j] * yv[t + j];
            co[t * 512 + tid] = a; }
        __syncthreads();
#pragma unroll
        for (int rr = 0; rr < 4; ++rr) { const int row = wave * 4 + rr;
            const f32x4 v0 = *(const LAS f32x4*)(co + row * 512 + lane * 4), v1 = *(const LAS f32x4*)(co + row * 512 + 256 + lane * 4);
            const float mean = wave_sum((v0[0] + v0[1]) + (v0[2] + v0[3]) + (v1[0] + v1[1]) + (v1[2] + v1[3])) * (1.0f / CONV_CH);
            const f32x4 d0 = v0 - mean, d1 = v1 - mean;
            const float var = wave_sum((d0[0] * d0[0] + d0[1] * d0[1]) + (d0[2] * d0[2] + d0[3] * d0[3]) + (d1[0] * d1[0] + d1[1] * d1[1]) + (d1[2] * d1[2] + d1[3] * d1[3])) * (1.0f / CONV_CH);
            const float rstd = 1.0f / sqrtf(var + EPS);
            f32x4 y0 = d0 * rstd * g0 + b0, y1 = d1 * rstd * g1 + b1;
#pragma unroll
            for (int j = 0; j < 4; ++j) { y0[j] = y0[j] * sigmoidf_fast(y0[j]); y1[j] = y1[j] * sigmoidf_fast(y1[j]); }
            bf16* orow = CA + ((size_t)(b * SEQ + t0 + row)) * 1024;
            v2u o0, o1; o0.x = cvt_pk_bf16(y0[0], y0[1]); o0.y = cvt_pk_bf16(y0[2], y0[3]); o1.x = cvt_pk_bf16(y1[0], y1[1]); o1.y = cvt_pk_bf16(y1[2], y1[3]);
            *(v2u*)(orow + lane * 4) = o0; *(v2u*)(orow + 256 + lane * 4) = o1; }
        __syncthreads();
    }
#undef CONV_FETCH
}

__device__ __forceinline__ void attn_pair(const Ptrs& P, LAS unsigned char* lds, char* lds_generic, int p) {
    const int tid = tid_opaque(), lane = tid & 63, wave = __builtin_amdgcn_readfirstlane(tid >> 6);
    const int bh = p >> 3, s = p & 7, b = bh >> 2, h = bh & 3;
    const __hip_bfloat16* QB = (const __hip_bfloat16*)(P.ws + WS_QB); const __hip_bfloat16* KB = (const __hip_bfloat16*)(P.ws + WS_KB); const __hip_bfloat16* VB = (const __hip_bfloat16*)(P.ws + WS_VB);
    __hip_bfloat16* OT = (__hip_bfloat16*)(P.ws + WS_A); bf16* CA = (bf16*)(P.ws + WS_CA);
    float mstat;
    { int l0 = lane; asm volatile("" : "+v"(l0));
      const float a = wave_max(fabsf(P.q_norm_g[l0])), b = wave_max(fabsf(P.k_norm_g[l0]));
      mstat = __int_as_float(__builtin_amdgcn_readfirstlane(__float_as_int(0.125f * 1.4426950408889634f * 64.0f * 1.02f * a * b))); }
    float lam;
    { int l1 = lane; asm volatile("" : "+v"(l1));
      lam = __int_as_float(__builtin_amdgcn_readfirstlane(__float_as_int(__expf(wave_sum(P.lq1[l1] * P.lk1[l1])) - __expf(wave_sum(P.lq2[l1] * P.lk2[l1])) + 0.2f))); }
    int s0 = 0; bool pre = false;
#pragma unroll 1
    for (int u4 = 0; u4 < 4; ++u4) { const int i = u4 >> 1, c = u4 & 1;
        const int qb = (i == 0) ? s : 15 - s;
        const __hip_bfloat16* q_ = QB + (size_t)b * SEQ * 512 + (h * 2 + c) * 64; const __hip_bfloat16* k_ = KB + (size_t)b * SEQ * 512 + (h * 2 + c) * 64; const __hip_bfloat16* v_ = VB + (size_t)b * SEQ * 512 + h * 128;
        const __hip_bfloat16* kn_ = (u4 < 3) ? KB + (size_t)b * SEQ * 512 + (h * 2 + (c ^ 1)) * 64 : nullptr;
        __hip_bfloat16* o_ = OT + (size_t)b * SEQ * 1024 + (h * 2) * 128;
        const __hip_bfloat16* o1_ = c ? o_ : nullptr; unsigned short* ca_ = CA + (size_t)b * SEQ * 1024 + 512 + h * 128;
        int sn;
        if (mstat <= 40.0f) sn = attn_body::attn_unit<8, true>(mstat, qb * 256, q_, k_, v_, o_, lds_generic, o1_, lam, P.subln_g, ca_, kn_, v_, s0, pre);
        else sn = attn_body::attn_unit<8, false>(0.f, qb * 256, q_, k_, v_, o_, lds_generic, o1_, lam, P.subln_g, ca_, kn_, v_, s0, pre);
        s0 = sn; pre = (kn_ != nullptr); }
}

__device__ __forceinline__ void router_tile(const Ptrs& P, LAS unsigned char* lds, int tile) {
    const int tid = tid_opaque(), lane = tid & 63, wave = __builtin_amdgcn_readfirstlane(tid >> 6), r32 = lane & 31, hi = lane >> 5;
    const bf16* WRhi = (const bf16*)(P.ws + WS_WR); const bf16* WRlo = WRhi + 64 * 1024;
    int* LIST = (int*)(P.ws + WS_LIST); int* CTOK = (int*)(P.ws + WS_CTOK); unsigned* cnt = (unsigned*)(P.ws + WS_CTL); unsigned* ccnt = cnt + 64;
    LAS float* lg = (LAS float*)(lds + wave * 8448);
    LAS int* hist = (LAS int*)(lds + HIST_OFF); LAS int* hbase = hist + 32; LAS int* hist2 = hist + 64; LAS int* hbase2 = hist2 + NCLS;
    if (tid < 32) hist[tid] = 0;
    if (tid >= 64 && tid < 64 + NCLS) hist2[tid - 64] = 0;
    __syncthreads();
    const int tbase = tile * 256 + wave * 32;
    const bf16* xr = (const bf16*)(P.ws + WS_CA) + (size_t)(tbase + r32) * DMODEL + 8 * hi;
    const bf16* bh0 = WRhi + (size_t)r32 * 1024 + 8 * hi; const bf16* bl0 = WRlo + (size_t)r32 * 1024 + 8 * hi;
    f32x16 acc0 = {}, acc1 = {}; float ssq = 0.f;
#pragma unroll 4
    for (int ks = 0; ks < 64; ++ks) {
        const v4u xa = *(const v4u*)(xr + ks * 16);
        f32x4 x0, x1; unpack8(xa, x0, x1);
        ssq += (x0[0] * x0[0] + x0[1] * x0[1]) + (x0[2] * x0[2] + x0[3] * x0[3]) + (x1[0] * x1[0] + x1[1] * x1[1]) + (x1[2] * x1[2] + x1[3] * x1[3]);
        const bf16x8 a_hi = __builtin_bit_cast(bf16x8, xa);
        const bf16x8 bh_0 = *(const bf16x8*)(bh0 + ks * 16), bh_1 = *(const bf16x8*)(bh0 + 32 * 1024 + ks * 16), bl_0 = *(const bf16x8*)(bl0 + ks * 16), bl_1 = *(const bf16x8*)(bl0 + 32 * 1024 + ks * 16);
        acc0 = __builtin_amdgcn_mfma_f32_32x32x16_bf16(a_hi, bh_0, acc0, 0, 0, 0); acc1 = __builtin_amdgcn_mfma_f32_32x32x16_bf16(a_hi, bh_1, acc1, 0, 0, 0);
        acc0 = __builtin_amdgcn_mfma_f32_32x32x16_bf16(a_hi, bl_0, acc0, 0, 0, 0); acc1 = __builtin_amdgcn_mfma_f32_32x32x16_bf16(a_hi, bl_1, acc1, 0, 0, 0);
    }
    ssq += __shfl_xor(ssq, 32);
    const float rs = 1.0f / sqrtf(ssq * (1.0f / DMODEL) + EPS);
#pragma unroll
    for (int r = 0; r < 16; ++r) { const int m = (r & 3) + 8 * (r >> 2) + 4 * hi; lg[m * 66 + r32] = acc0[r]; lg[m * 66 + 32 + r32] = acc1[r]; }
    asm volatile("s_waitcnt lgkmcnt(0)" ::: "memory");
    int ea = 0, eb = 0, cls = 0, lpa = 0, lpb = 0, lpc = 0; float wa = 0.f, wb = 0.f;
    if (lane < 32) {
        const LAS float* L = lg + lane * 66;
        float gl[4];
#pragma unroll
        for (int j = 0; j < 4; ++j) gl[j] = L[j] * rs + P.b_rg[j];
        int gs = 0; float gm = gl[0];
#pragma unroll
        for (int j = 1; j < 4; ++j) if (gl[j] > gm) { gm = gl[j]; gs = j; }
        float gsum = 0.f;
#pragma unroll
        for (int j = 0; j < 4; ++j) gsum += __expf(gl[j] - gm);
        const float gw = 1.0f / gsum;
        float l0 = -INFINITY, l1 = -INFINITY; int i0 = 0, i1 = 0;
#pragma unroll
        for (int j = 0; j < 8; ++j) { const float v = L[4 + gs * 8 + j] * rs + P.b_re[gs * 8 + j];
            if (v > l0) { l1 = l0; i1 = i0; l0 = v; i0 = j; } else if (v > l1) { l1 = v; i1 = j; } }
        const float q = __expf(l1 - l0), inv = 1.0f / (1.0f + q);
        const float w0 = inv * gw, w1 = q * inv * gw;
        const int a = min(i0, i1), b = max(i0, i1);
        wa = (i0 < i1) ? w0 : w1; wb = (i0 < i1) ? w1 : w0;
        ea = gs * 8 + a; eb = gs * 8 + b; cls = gs * 28 + (a * (15 - a)) / 2 + (b - a - 1);
        lpa = __hip_atomic_fetch_add(&hist[ea], 1, __ATOMIC_RELAXED, __HIP_MEMORY_SCOPE_WORKGROUP); lpb = __hip_atomic_fetch_add(&hist[eb], 1, __ATOMIC_RELAXED, __HIP_MEMORY_SCOPE_WORKGROUP);
        lpc = __hip_atomic_fetch_add(&hist2[cls], 1, __ATOMIC_RELAXED, __HIP_MEMORY_SCOPE_WORKGROUP);
    }
    __syncthreads();
    if (tid < 32) hbase[tid] = (int)atomicAdd(cnt + tid, (unsigned)hist[tid]);
    if (tid >= 64 && tid < 64 + NCLS) { const int c = tid - 64; const int n = hist2[c]; hbase2[c] = n ? (int)atomicAdd(ccnt + c, (unsigned)n) : 0; }
    __syncthreads();
    if (lane < 32) { const int t = tbase + lane; const int pa = hbase[ea] + lpa, pb = hbase[eb] + lpb, pc = hbase2[cls] + lpc;
        typedef int i32x4 __attribute__((ext_vector_type(4)));
        const int dst = (cls << 17) | (pc << 1);
        *(i32x4*)(LIST + (size_t)(ea * LCAP + pa) * 4) = (i32x4){t, dst, __float_as_int(wa), __float_as_int(rs)};
        *(i32x4*)(LIST + (size_t)(eb * LCAP + pb) * 4) = (i32x4){t, dst | 1, __float_as_int(wb), __float_as_int(rs)};
        CTOK[(size_t)cls * NTOK + pc] = t; }
    __syncthreads();
}

__device__ __forceinline__ void p5_convert(const Ptrs& P, LAS unsigned char* lds, int vcu, int G) {
    const int tid = tid_opaque(), lane = tid & 63, wave = __builtin_amdgcn_readfirstlane(tid >> 6);
    LAS float* scr = (LAS float*)(lds + wave * 16384);
    const int gw = vcu * NWAVES + wave, NGW = G * NWAVES;
    unsigned char* WGU = P.ws + WS_WGU; unsigned char* WD = P.ws + WS_WD;
    constexpr int I_G = (DMODEL / 64) * (DEXP / 32);
    constexpr int I_D = (DEXP / 64) * (DMODEL / 32);
    constexpr int PER_E = 2 * I_G + I_D;
    constexpr int NITEMS = NEXP * PER_E, NRW = (NTOK / 256) * NWAVES;
    const bool split = (G == 256) && (NITEMS == NRW * 8 + (256 * NWAVES - NRW) * 16);
    const bool rwg = (int)blockIdx.x < NTOK / 256; const int wv = ((int)blockIdx.x - (rwg ? 0 : NTOK / 256)) * NWAVES + wave;
    const int it0 = split ? (rwg ? wv : NRW * 8 + wv) : gw, itn = split ? (rwg ? NRW * 8 : NITEMS) : NITEMS, its = split ? NRW : NGW;
    struct Item { const float* W; int N, k0, n0; unsigned char* WT; int dpitch, drow0; const float* ks; float mul; };
    auto decode = [&](int it) { Item q; const int e = it / PER_E; int r = it % PER_E;
        if (r < 2 * I_G) { const int up = r / I_G; r %= I_G; const int kb = r / (DEXP / 32), nb = r % (DEXP / 32), n0 = nb * 32;
            q.W = (up ? P.w_up : P.w_gate) + (size_t)e * DMODEL * DEXP; q.N = DEXP; q.k0 = kb * 64; q.n0 = n0; q.WT = WGU + (size_t)e * 1024 * 1024; q.dpitch = 1024; q.drow0 = (n0 >> 7) * 256 + up * 128 + (n0 & 127); q.ks = P.ffn_norm_g; q.mul = 64.f;
        } else { r -= 2 * I_G; const int kb = r / (DMODEL / 32), nb = r % (DMODEL / 32);
            q.W = P.w_down + (size_t)e * DEXP * DMODEL; q.N = DMODEL; q.k0 = kb * 64; q.n0 = nb * 32; q.WT = WD + (size_t)e * 1024 * 512; q.dpitch = 512; q.drow0 = nb * 32; q.ks = nullptr; q.mul = 32.f; }
        return q; };
    for (int it = it0; it < itn; it += 4 * its) {
        const bool h1 = it + its < itn, h2 = it + 2 * its < itn, h3 = it + 3 * its < itn;
        const Item a = decode(it), b = decode(h1 ? it + its : it), c = decode(h2 ? it + 2 * its : it), d = decode(h3 ? it + 3 * its : it);
        f32x4 va[8], vb[8], vc[8], vd[8];
        t8_load(va, a.W, a.N, a.k0, a.n0, lane); t8_load(vb, b.W, b.N, b.k0, b.n0, lane); t8_load(vc, c.W, c.N, c.k0, c.n0, lane); t8_load(vd, d.W, d.N, d.k0, d.n0, lane);
        t8_finish(va, a.k0, a.WT, a.dpitch, a.drow0, a.ks, a.mul, scr, lane);
        if (h1) t8_finish(vb, b.k0, b.WT, b.dpitch, b.drow0, b.ks, b.mul, scr, lane);
        if (h2) t8_finish(vc, c.k0, c.WT, c.dpitch, c.drow0, c.ks, c.mul, scr, lane);
        if (h3) t8_finish(vd, d.k0, d.WT, d.dpitch, d.drow0, d.ks, d.mul, scr, lane);
    }
}

struct Args { Ptrs p; int ph_lo, ph_hi, use_cg, pad; };
__global__ void __launch_bounds__(NTHREADS, 2) mega_fwd(Args args) {
    extern __shared__ __attribute__((aligned(16))) unsigned char lds_raw[];
    LAS unsigned char* lds = (LAS unsigned char*)lds_raw;
    const Ptrs& P = args.p;
    const int tid = tid_opaque();
    const int G = gridDim.x, bx = blockIdx.x; const int vcu = (G % 8 == 0) ? (bx % 8) * (G / 8) + bx / 8 : bx;
    const int lo = args.ph_lo, hi = args.ph_hi;
    LAS int* meta = (LAS int*)(lds + META_OFF);
    if (tid < 2) ((volatile LAS unsigned*)(lds + BARST_OFF))[tid] = 0u;
    __syncthreads();
    XcdBarrier bar = xcd_barrier_post((unsigned*)(P.ws + WS_CTL) + 1024, (volatile LAS unsigned*)(lds + BARST_OFF));
#ifndef PHASE_MASK
#define PHASE_MASK 0xff
#endif
#ifndef DUP_PHASE
#define DUP_PHASE -1
#endif
#define REPS(k) for (int rep_ = 0; rep_ < ((DUP_PHASE == (k)) ? 2 : 1); ++rep_)
#define REPBAR() do { if (rep_) xcd_barrier(bar); } while (0)
#define IN(k) (((PHASE_MASK >> (k)) & 1) && lo <= (k) && (k) < hi)
#define SEAM(k) do { if (IN(k) && IN((k) + 1)) xcd_barrier(bar); } while (0)
    bf16* WS16 = (bf16*)P.ws;
    if (IN(0)) REPS(0) { REPBAR(); p0_prologue(P, lds, vcu, G); }
    SEAM(0);
    if (IN(1)) REPS(1) { REPBAR();
        pg8::Gemm g{(const bf16*)(P.ws + WS_A), (const bf16*)(P.ws + WS_WIN), DMODEL, 0, nullptr};
        pg8::StaticOrder S; S.init(NTOK, IN_COLS, G, bx);
        LAS float* gl = (LAS float*)(lds + RING_BYTES + 8192);
        if (tid < 128) gl[tid] = (tid < 64) ? P.q_norm_g[tid] : P.k_norm_g[tid - 64];
        __syncthreads();
        EpiInProj E{(bf16*)(P.ws + WS_YG), (bf16*)(P.ws + WS_QB), (bf16*)(P.ws + WS_KB), (bf16*)(P.ws + WS_VB), (bf16*)(P.ws + WS_GT), gl};
#if defined(DUMP_SEL) && DUMP_SEL == 5
        EpiRaw ER{(bf16*)(P.ws + WS_QB)};
        pg8::gemm_phase<EpiRaw, pg8::StaticOrder, false, true>(lds, g, S, ER);
#else
        pg8::gemm_phase<EpiInProj, pg8::StaticOrder, false, true>(lds, g, S, E);
#endif
    }
    SEAM(1);
    if (IN(2)) {
        REPS(2) { REPBAR();
        for (int p = vcu; p < 256; p += G) attn_pair(P, lds, (char*)lds_raw, p);
        __syncthreads(); }
        REPS(20) { REPBAR();
        conv_phase(P, lds, bx, G); }
    }
    SEAM(2);
    if (IN(3)) REPS(3) { REPBAR();
        pg8::Gemm g{(const bf16*)(P.ws + WS_CA), (const bf16*)(P.ws + WS_WCA), DMODEL, 0, nullptr};
        pg8::StaticOrder S; S.init(NTOK, DMODEL, G, bx);
        EpiMerged E{(const bf16*)(P.ws + WS_GT), (const bf16*)(P.ws + WS_GT) + (size_t)NTOK * 1024, (bf16*)(P.ws + WS_MG)};
        pg8::gemm_phase<EpiMerged, pg8::StaticOrder, false, true>(lds, g, S, E);
    }
    SEAM(3);
    if (IN(4)) REPS(4) { REPBAR();
        pg8::Gemm g{(const bf16*)(P.ws + WS_MG), (const bf16*)(P.ws + WS_WOUT), DMODEL, 0, nullptr};
        pg8::StaticOrder S; S.init(NTOK, DMODEL, G, bx);
        EpiOut E{P.x, (bf16*)(P.ws + WS_CA), P.ws + WS_XM};
        pg8::gemm_phase<EpiOut, pg8::StaticOrder, false, true>(lds, g, S, E);
    }
    SEAM(4);
    if (IN(5)) {
        for (int t = bx; t < NTOK / 256; t += G) router_tile(P, lds, t);
        REPS(5) { REPBAR(); p5_convert(P, lds, vcu, G); }
    }
    SEAM(5);
    LAS int* meta2 = (LAS int*)(lds + META2_OFF);
    if (IN(6)) REPS(6) { REPBAR();
        moe_meta(meta, meta2, (const unsigned*)(P.ws + WS_CTL));
        pg8::Gemm g{(const bf16*)(P.ws + WS_XM), (const bf16*)(P.ws + WS_WGU), DMODEL / 2, (size_t)1024 * 1024, (const int*)(P.ws + WS_LIST), 4};
        MoeOrder S{G, bx, __builtin_amdgcn_readfirstlane(meta[NEXP]), meta};
        EpiGateUp E{(const int*)(P.ws + WS_LIST), P.ws + WS_A, meta2};
        pg8::gemm_phase<EpiGateUp, MoeOrder, true, true, true>(lds, g, S, E);
    }
    SEAM(6);
    if (IN(7)) REPS(7) { REPBAR();
        moe_meta(meta, meta2, (const unsigned*)(P.ws + WS_CTL));
        pg8::Gemm g{(const bf16*)(P.ws + WS_A), (const bf16*)(P.ws + WS_WD), DMODEL / 2, (size_t)1024 * 512, nullptr, 0, DEXP / 2};
        ClassOrder S{G, bx, __builtin_amdgcn_readfirstlane(meta2[NCLS]), meta2};
        EpiDownAdd E{(const int*)(P.ws + WS_CTOK), (const bf16*)(P.ws + WS_CA), P.out};
        pg8::gemm_phase<EpiDownAdd, ClassOrder, false, true, true, true>(lds, g, S, E);
    }
#if defined(DUMP_SEL)
    xcd_barrier(bar);
    { const bf16* YG = (const bf16*)(P.ws + WS_YG); const bf16* QB = (const bf16*)(P.ws + WS_QB); const bf16* KB = (const bf16*)(P.ws + WS_KB); const bf16* VB = (const bf16*)(P.ws + WS_VB);
      const bf16* GT = (const bf16*)(P.ws + WS_GT); const bf16* CA = (const bf16*)(P.ws + WS_CA); const bf16* MG = (const bf16*)(P.ws + WS_MG);
      for (size_t i = (size_t)bx * NTHREADS + tid; i < (size_t)NTOK * 1024; i += (size_t)G * NTHREADS) { const size_t t = i >> 10; const int c = (int)(i & 1023); float v = 0.f;
#if DUMP_SEL == 1
          v = bf_lo(YG[t * 512 + (c & 511)]) + bf_lo(QB[t * 512 + (c & 511)]) + 2.f * bf_lo(KB[t * 512 + (c & 511)]) + 3.f * bf_lo(VB[t * 512 + (c & 511)]) + bf_lo(GT[t * 2048 + c]) + bf_lo(GT[t * 2048 + 1024 + c]);
#elif DUMP_SEL == 2
          v = bf_lo(CA[t * 1024 + c]);
#elif DUMP_SEL == 4
          { const bf16* HB = (const bf16*)(P.ws + WS_A); const bf16* WIN = (const bf16*)(P.ws + WS_WIN); v = bf_lo(HB[i]) + 30.f * bf_lo(WIN[i % ((size_t)IN_COLS * 1024)]); }
#elif DUMP_SEL == 5
          { const bf16* R = (const bf16*)(P.ws + WS_QB); v = bf_lo(R[t * 4608 + c]) + bf_lo(R[t * 4608 + 1024 + c]) + bf_lo(R[t * 4608 + 2048 + c]) + bf_lo(R[t * 4608 + 3072 + c]) + bf_lo(R[t * 4608 + 4096 + (c & 511)]); }
#elif DUMP_SEL == 3
          v = bf_lo(MG[t * 1024 + c]);
#endif
          P.out[i] = v; } }
#endif
    (void)WS16;
#undef IN
#undef SEAM
}

extern "C" void kernel_launch(void* const* d_in, const int* in_sizes, int n_in, void* d_out, int out_size, void* d_ws, size_t ws_size, hipStream_t stream) {
    static int grid = 0;
    if (grid == 0) {
        if (n_in != 25 || in_sizes[0] != NTOK * DMODEL || out_size != NTOK * DMODEL || ws_size < WS_END) {
            fprintf(stderr, "kernel_launch: unexpected shapes (n_in %d, in0 %d, out %d, ws %zu); nothing launched\n", n_in, n_in > 0 ? in_sizes[0] : -1, out_size, ws_size); grid = -1; return; }
        int dev = 0, cus = 0, per_cu = 0;
        if (hipGetDevice(&dev) != hipSuccess || hipDeviceGetAttribute(&cus, hipDeviceAttributeMultiprocessorCount, dev) != hipSuccess) { grid = -1; return; }
        if (hipFuncSetAttribute((const void*)mega_fwd, hipFuncAttributeMaxDynamicSharedMemorySize, LDS_BYTES) != hipSuccess) { fprintf(stderr, "kernel_launch: hipFuncSetAttribute failed\n"); grid = -1; return; }
        if (hipOccupancyMaxActiveBlocksPerMultiprocessor(&per_cu, (const void*)mega_fwd, NTHREADS, LDS_BYTES) != hipSuccess || per_cu < 1) { fprintf(stderr, "kernel_launch: the occupancy query reports %d workgroups per CU for this kernel and LDS size; nothing launched\n", per_cu); grid = -1; return; }
        (void)hipGetLastError();
        grid = cus;
    }
    if (grid < 0) return;
    (void)hipMemsetAsync((char*)d_ws + WS_CTL, 0, CTL_ZERO_BYTES, stream);
    Args a{};
    const float** pp = (const float**)&a.p;
    for (int i = 0; i < 25; ++i) pp[i] = (const float*)d_in[i];
    a.p.out = (float*)d_out; a.p.ws = (unsigned char*)d_ws;
#if MK_PER_PHASE
    for (int ph = 0; ph < N_PHASES; ++ph) { a.ph_lo = ph; a.ph_hi = ph + 1; void* params[] = {&a};
        hipError_t e = hipLaunchCooperativeKernel((const void*)mega_fwd, dim3(grid), dim3(NTHREADS), params, LDS_BYTES, stream);
        if (e != hipSuccess) { fprintf(stderr, "launch %d failed: %s\n", ph, hipGetErrorString(e)); break; } }
#else
    a.ph_lo = 0; a.ph_hi = N_PHASES; void* params[] = {&a};
    hipError_t e = hipLaunchCooperativeKernel((const void*)mega_fwd, dim3(grid), dim3(NTHREADS), params, LDS_BYTES, stream);
    if (e != hipSuccess) fprintf(stderr, "cooperative launch failed: %s (grid %d)\n", hipGetErrorString(e), grid);
#endif
}
```

```cpp
#include <hip/hip_runtime.h>
#include <hip/hip_bf16.h>
#include <hip/hip_cooperative_groups.h>
#include <cstdio>
#include <cstdint>
#include <cmath>
namespace cg = cooperative_groups;
__device__ __forceinline__ int tid_opaque() { int t = threadIdx.x; asm volatile("" : "+v"(t)); return t; }

constexpr int BATCH = 8, SEQ = 4096, DMODEL = 1024, NTOK = BATCH * SEQ;
constexpr int CONV_CH = 512, CONV_W = 31, NHEADS = 4, IN_COLS = 4608;
constexpr int NEXP = 32, DEXP = 512, LCAP = NTOK;
constexpr int NCLS = 4 * 28;
constexpr int CROWS = NTOK + NCLS * 256;
constexpr int MOE_ROWS = 2 * NTOK + NEXP * 256;
constexpr float EPS = 1e-6f;

namespace pg8 {
#define PG8_LAS __attribute__((address_space(3)))
typedef unsigned short bf16_t;
typedef short bf16x8 __attribute__((ext_vector_type(8)));
typedef float f32x4 __attribute__((ext_vector_type(4)));
typedef unsigned u32x4 __attribute__((ext_vector_type(4)));
constexpr int BM = 256, BK = 64, HALF = 128, HTB = HALF * BK * 2  , STAGE_BYTES = 8 * HTB, NXCD = 8, WGM = 8;

__host__ __device__ __forceinline__ int lds_byte(int r, int c) { const int st = (r >> 4) * 2 + (c >> 5), rr = r & 15, cc = c & 31, ob = rr * 64 + cc * 2; return st * 1024 + (ob ^ (((ob >> 9) & 1) << 5)); }
__host__ __device__ __forceinline__ void stage_rc(int b, int& R, int& C) { const int st = b / 1024, sb = b % 1024, swz = sb ^ (((sb >> 9) & 1) << 5); R = (st >> 1) * 16 + swz / 64; C = (st & 1) * 32 + (swz % 64) / 2; }
__host__ __device__ __forceinline__ int perm32(int rho) { const int n = rho >> 4, i = rho & 15; return 8 * (i >> 2) + 4 * n + (i & 3); }

struct Unit { int pm, pn, arow, e, e2, lrow, nvalid, orow; };
struct Gemm { const bf16_t* A; const bf16_t* Bt; int K; size_t bstride; const int* list; int lstride; int KBrow; };

struct StaticOrder {
    int nM, nN, nwg, G, c;
    __device__ void init(int M, int N, int G_, int c_) { nM = M / BM; nN = N / BM; nwg = nM * nN; G = G_; c = c_; }
    __device__ bool next(int i, Unit& u) const {
        const long L = (long)i * G + c; if (L >= nwg) return false;
        int wgid = (int)L; { const int q = nwg / NXCD, r = nwg % NXCD, xcd = wgid % NXCD, off = wgid / NXCD; wgid = (xcd < r ? xcd * (q + 1) : r * (q + 1) + (xcd - r) * q) + off; }
        const int nig = WGM * nN, gid = wgid / nig, fm = gid * WGM, gsz = (nM - fm) < WGM ? (nM - fm) : WGM;
        u.pm = fm + ((wgid % nig) % gsz); u.pn = (wgid % nig) / gsz; u.arow = u.pm * BM; u.orow = u.arow; u.e = 0; u.e2 = 0; u.lrow = 0; u.nvalid = BM; return true;
    }
};

typedef float f32x2_t __attribute__((ext_vector_type(2))); typedef __bf16 bf16x2_t __attribute__((ext_vector_type(2)));
__device__ __forceinline__ unsigned cvt_pk_bf16(float lo, float hi) { const f32x2_t v = {lo, hi}; const bf16x2_t b = __builtin_convertvector(v, bf16x2_t); return __builtin_bit_cast(unsigned, b); }
typedef int v8i_t __attribute__((ext_vector_type(8))); typedef int v4i_t __attribute__((ext_vector_type(4)));
__device__ __forceinline__ v8i_t cat8(const bf16x8 a, const bf16x8 b) { const v4i_t x = __builtin_bit_cast(v4i_t, a), y = __builtin_bit_cast(v4i_t, b); return (v8i_t){x[0], x[1], x[2], x[3], y[0], y[1], y[2], y[3]}; }
__device__ __forceinline__ unsigned pack4_fp8(float a, float b, float c, float d) { int w = 0; w = __builtin_amdgcn_cvt_pk_fp8_f32(a, b, w, false); w = __builtin_amdgcn_cvt_pk_fp8_f32(c, d, w, true); return (unsigned)w; }
__device__ __forceinline__ float bf_lo(unsigned w) { return __uint_as_float(w << 16); }
__device__ __forceinline__ float bf_hi(unsigned w) { return __uint_as_float(w & 0xffff0000u); }
__device__ __forceinline__ float sigmoidf_fast(float x) { return __builtin_amdgcn_rcpf(1.0f + __builtin_amdgcn_exp2f(-1.4426950408889634f * x)); }
__device__ __forceinline__ u32x4 pack8(const f32x4 a, const f32x4 b) { u32x4 w; w.x = cvt_pk_bf16(a[0], a[1]); w.y = cvt_pk_bf16(a[2], a[3]); w.z = cvt_pk_bf16(b[0], b[1]); w.w = cvt_pk_bf16(b[2], b[3]); return w; }
__device__ __forceinline__ void unpack8(const u32x4 w, f32x4& a, f32x4& b) { a = (f32x4){bf_lo(w.x), bf_hi(w.x), bf_lo(w.y), bf_hi(w.y)}; b = (f32x4){bf_lo(w.z), bf_hi(w.z), bf_lo(w.w), bf_hi(w.w)}; }

template <class Epi, class Sched, bool GATHER, bool ALIGN_EPI, bool FP8 = false, bool BSPLIT = false>
__device__ __forceinline__ void gemm_phase(PG8_LAS unsigned char* lds, const Gemm g, const Sched& S, const Epi& E) {
    const int tid = tid_opaque(), wid = __builtin_amdgcn_readfirstlane(tid >> 6), lane = tid & 63, wr = wid >> 2, wc = wid & 3, fr = lane & 15, fq = lane >> 4;
    const int K = g.K, nt = K / BK, KBp = g.KBrow ? g.KBrow : K;
    unsigned voffB[2]; int Ra[2], Ca[2];
#pragma unroll
    for (int i = 0; i < 2; ++i) { int R, C; stage_rc(tid * 16 + i * 8192, R, C); const int Rb = (R & ~31) + perm32(R & 31); Ra[i] = R; Ca[i] = C; voffB[i] = (unsigned)(Rb * KBp + C) * 2u; }
    const unsigned kstep = (unsigned)(BK * 2);
    const unsigned hstep = (unsigned)HALF * KBp * 2;
    const unsigned tstep = 2 * hstep;
    const char* const gA = (const char*)g.A; const char* const gB = (const char*)g.Bt;
    const unsigned ldsw = (unsigned)wid * 1024u;
    const int aoff = lds_byte(wr * 64 + fr, fq * 8), boff = lds_byte(wc * 32 + fr, fq * 8);
#define PG8_SA(b, h) (((b) * 2 + (h)) * HTB)
#define PG8_SB(b, h) ((4 + (b) * 2 + (h)) * HTB)
#define PG8_STAGE(bufoff, gbase, uoff, voff) do { _Pragma("unroll") for (int _i = 0; _i < 2; ++_i) \
        __builtin_amdgcn_global_load_lds((const unsigned*)((const char*)(gbase) + (unsigned)((uoff) + (voff)[_i])), (PG8_LAS unsigned*)(lds + (bufoff) + ldsw + _i * 8192), 16, 0, 0); } while (0)
#define PG8_LDA(dst, b, h) do { _Pragma("unroll") for (int m = 0; m < 4; ++m) _Pragma("unroll") for (int k = 0; k < 2; ++k) dst[m][k] = *(const PG8_LAS bf16x8*)(lds + PG8_SA(b, h) + aoff + m * 2048 + k * 1024); } while (0)
#define PG8_LDB(dst, b, h) do { _Pragma("unroll") for (int n = 0; n < 2; ++n) _Pragma("unroll") for (int k = 0; k < 2; ++k) dst[n][k] = *(const PG8_LAS bf16x8*)(lds + PG8_SB(b, h) + boff + n * 2048 + k * 1024); } while (0)
#define PG8_MMA(ai, bj, At, Bt) do { __builtin_amdgcn_s_setprio(1); \
        if constexpr (FP8) { _Pragma("unroll") for (int m = 0; m < 4; ++m) _Pragma("unroll") for (int n = 0; n < 2; ++n) \
            asm volatile("v_mfma_scale_f32_16x16x128_f8f6f4 %0, %1, %2, %0, %3, %3 op_sel_hi:[0,0,0]" : "+v"(acc[ai][bj][m][n]) : "v"(cat8(Bt[n][0], Bt[n][1])), "v"(cat8(At[m][0], At[m][1])), "v"(one_e8m0)); } \
        else { _Pragma("unroll") for (int m = 0; m < 4; ++m) _Pragma("unroll") for (int n = 0; n < 2; ++n) _Pragma("unroll") for (int k = 0; k < 2; ++k) \
            acc[ai][bj][m][n] = __builtin_amdgcn_mfma_f32_16x16x32_bf16(Bt[n][k], At[m][k], acc[ai][bj][m][n], 0, 0, 0); } \
        __builtin_amdgcn_s_setprio(0); } while (0)
#define PG8_WAIT_V(n) asm volatile("s_waitcnt vmcnt(" #n ")" ::: "memory")
#define PG8_WAIT_L(n) asm volatile("s_waitcnt lgkmcnt(" #n ")" ::: "memory")
#define PG8_BAR __builtin_amdgcn_s_barrier()
#define PG8_SCHED __builtin_amdgcn_sched_barrier(0)
#define PG8_LOAD_VA(dst, u) do { _Pragma("unroll") for (int _h = 0; _h < 2; ++_h) _Pragma("unroll") for (int _i = 0; _i < 2; ++_i) { const int _row = _h * HALF + Ra[_i]; \
        if constexpr (GATHER) { const int _tok = (_row < (u).nvalid) ? g.list[((u).lrow + _row) * g.lstride] : 0; dst[_h][_i] = (unsigned)(_tok * K + Ca[_i]) * 2u; } \
        else dst[_h][_i] = (unsigned)(_row * K + Ca[_i]) * 2u; } } while (0)
    Unit cur, nxt; int ui = 0;
    if (!S.next(0, cur)) return;
    typename Epi::Pre pre{};
    unsigned vAc[2][2], vAn[2][2];
    PG8_LOAD_VA(vAc, cur);
    f32x4 acc[2][2][4][2];
#pragma unroll
    for (int a = 0; a < 2; ++a)
#pragma unroll
        for (int b = 0; b < 2; ++b)
#pragma unroll
            for (int m = 0; m < 4; ++m)
#pragma unroll
                for (int n = 0; n < 2; ++n) acc[a][b][m][n] = (f32x4){0.f, 0.f, 0.f, 0.f};
    bf16x8 At[4][2], B0[2][2], B1[2][2];
    const int one_e8m0 = 0x7f7f7f7f; (void)one_e8m0;
    unsigned cA = (unsigned)cur.arow * K * 2, cB = (unsigned)cur.e * (unsigned)g.bstride + (unsigned)cur.pn * tstep;
    unsigned cB2 = (unsigned)cur.e2 * (unsigned)g.bstride + (unsigned)cur.pn * tstep; const unsigned hk = (unsigned)(nt / 2) * kstep; (void)cB2; (void)hk;
    PG8_STAGE(PG8_SB(0, 0), gB, cB, voffB); PG8_STAGE(PG8_SB(0, 1), gB, cB + hstep, voffB); PG8_STAGE(PG8_SA(0, 0), gA, cA, vAc[0]); PG8_STAGE(PG8_SA(0, 1), gA, cA, vAc[1]);
    if (wr == 1) PG8_BAR;
    PG8_WAIT_V(2); PG8_BAR;
    PG8_STAGE(PG8_SB(1, 0), gB, cB + kstep, voffB); PG8_STAGE(PG8_SA(1, 0), gA, cA + kstep, vAc[0]); PG8_STAGE(PG8_SB(1, 1), gB, cB + hstep + kstep, voffB);
    PG8_WAIT_V(6); PG8_BAR;
    for (;;) {
        const bool has_next = S.next(ui + 1, nxt);
        const unsigned nA = has_next ? (unsigned)nxt.arow * K * 2 : cA;
        const unsigned nB = has_next ? (unsigned)nxt.e * (unsigned)g.bstride + (unsigned)nxt.pn * tstep : cB;
        const unsigned nB2 = has_next ? (unsigned)nxt.e2 * (unsigned)g.bstride + (unsigned)nxt.pn * tstep : cB2; (void)nB2;
        if (has_next) { PG8_LOAD_VA(vAn, nxt); }
        else {
#pragma unroll
            for (int h = 0; h < 2; ++h)
#pragma unroll
                for (int i = 0; i < 2; ++i) vAn[h][i] = vAc[h][i]; }
#pragma unroll 1
        for (int t = 0; t < nt; t += 2) {
            const bool last = (t == nt - 2);
            if constexpr (Epi::MID) { if (t == nt / 2) E.mid(acc, cur, wr, wc, fr, fq); }
            if constexpr (Epi::PREMID) { if (t == nt / 2) pre = E.pre(cur, wr, fr); }
            const unsigned a1 = cA + (unsigned)(t + 1) * kstep;
            const unsigned a2 = last ? nA : cA + (unsigned)(t + 2) * kstep;
            unsigned b2 = last ? nB : cB + (unsigned)(t + 2) * kstep;
            if constexpr (BSPLIT) { if (!last && t + 2 >= nt / 2) b2 = cB2 + (unsigned)(t + 2) * kstep - hk; }
            const unsigned a3 = a2 + kstep, b3 = b2 + kstep;
            unsigned v2[2][2];
#pragma unroll
            for (int h = 0; h < 2; ++h)
#pragma unroll
                for (int i = 0; i < 2; ++i) v2[h][i] = vAc[h][i];
            if (last) { asm volatile("" ::: "memory");
#pragma unroll
                for (int h = 0; h < 2; ++h)
#pragma unroll
                    for (int i = 0; i < 2; ++i) v2[h][i] = vAn[h][i]; }
            PG8_LDB(B0, 0, 0); PG8_LDB(B1, 0, 1); PG8_SCHED; PG8_LDA(At, 0, 0); PG8_STAGE(PG8_SA(1, 1), gA, a1, vAc[1]);
            PG8_WAIT_V(8); PG8_WAIT_L(0); PG8_BAR; PG8_MMA(0, 0, At, B0); PG8_MMA(0, 1, At, B1); PG8_BAR; PG8_SCHED;
            PG8_LDA(At, 0, 1); PG8_STAGE(PG8_SB(0, 0), gB, b2, voffB); PG8_STAGE(PG8_SB(0, 1), gB, b2 + hstep, voffB); PG8_STAGE(PG8_SA(0, 0), gA, a2, v2[0]);
            PG8_WAIT_V(8); PG8_WAIT_L(0); PG8_BAR; PG8_MMA(1, 0, At, B0); PG8_MMA(1, 1, At, B1); PG8_BAR; PG8_SCHED;
            PG8_LDB(B0, 1, 0); PG8_LDB(B1, 1, 1); PG8_SCHED; PG8_LDA(At, 1, 0); PG8_STAGE(PG8_SA(0, 1), gA, a2, v2[1]);
            PG8_WAIT_V(8); PG8_WAIT_L(0); PG8_BAR; PG8_MMA(0, 0, At, B0); PG8_MMA(0, 1, At, B1); PG8_BAR; PG8_SCHED;
            PG8_LDA(At, 1, 1); PG8_STAGE(PG8_SB(1, 0), gB, b3, voffB); PG8_STAGE(PG8_SB(1, 1), gB, b3 + hstep, voffB); PG8_STAGE(PG8_SA(1, 0), gA, a3, v2[0]);
            PG8_WAIT_V(8); PG8_WAIT_L(0); PG8_BAR; PG8_MMA(1, 0, At, B0); PG8_MMA(1, 1, At, B1); PG8_BAR; PG8_SCHED;
        }
        if constexpr (ALIGN_EPI) { if (wr == 0) PG8_BAR; }
        if constexpr (FP8) asm volatile("s_nop 15\n\ts_nop 15\n\ts_nop 15\n\ts_nop 15" ::: "memory");
        if constexpr (Epi::PREMID) E(acc, cur, wr, wc, fr, fq, pre); else E(acc, cur, wr, wc, fr, fq, E.pre(cur, wr, fr));
        if (!has_next) break;
#pragma unroll
        for (int a = 0; a < 2; ++a)
#pragma unroll
            for (int b = 0; b < 2; ++b)
#pragma unroll
                for (int m = 0; m < 4; ++m)
#pragma unroll
                    for (int n = 0; n < 2; ++n) acc[a][b][m][n] = (f32x4){0.f, 0.f, 0.f, 0.f};
        cur = nxt; cA = nA; cB = nB; cB2 = nB2; ++ui;
#pragma unroll
        for (int h = 0; h < 2; ++h)
#pragma unroll
            for (int i = 0; i < 2; ++i) vAc[h][i] = vAn[h][i];
        if constexpr (ALIGN_EPI) { if (wr == 1) PG8_BAR; }
    }
    PG8_WAIT_V(0);
    if constexpr (!ALIGN_EPI) { if (wr == 0) PG8_BAR; }
    PG8_BAR;
#undef PG8_SA
#undef PG8_SB
#undef PG8_STAGE
#undef PG8_LDA
#undef PG8_LDB
#undef PG8_MMA
#undef PG8_WAIT_V
#undef PG8_WAIT_L
#undef PG8_BAR
#undef PG8_SCHED
#undef PG8_LOAD_VA
}
}

namespace attn_body {
using bf16=__hip_bfloat16;
using bf16x8=__attribute__((ext_vector_type(8)))short;
using s16x4=__attribute__((ext_vector_type(4)))short;
using f32x16=__attribute__((ext_vector_type(16)))float;
using u32x4=__attribute__((ext_vector_type(4)))unsigned;
constexpr int D=64, QP=512, KP=512, VP=512, OP=1024;
constexpr int NW=8,QBLK=32,QB=QBLK*NW,KVBLK=64;
constexpr int ATTN_UNIT_ROWS=QB;
__device__ __forceinline__ int crow(int r,int hi){return (r&3)+8*(r>>2)+4*hi;}
#define SBAR() __builtin_amdgcn_sched_barrier(0)
__device__ __forceinline__ void cmask(f32x16&p0,f32x16&p1,int jb,int qrel,int hi){
  const float NEG=-INFINITY; int kb=64*jb+4*hi;
  #pragma unroll
  for(int r=0;r<16;++r){int kv=kb+(r&3)+8*(r>>2); if(kv>qrel)p0[r]=NEG; if(kv+32>qrel)p1[r]=NEG;}
}

constexpr int NSLOT=3, SLOTB=8192, VSLOTB=16384;
constexpr int LDS_K=0, LDS_V=NSLOT*SLOTB, LDS_WS=LDS_V+NSLOT*VSLOTB, LDS_OST=LDS_WS+NW*64*4, LDS_BYTES=LDS_OST+NW*4096;
constexpr float C2=0.125f*1.4426950408889634f;
__device__ __forceinline__ void glds16(const void*gsrc,unsigned lds_dst){unsigned keep;
  asm volatile("s_mov_b32 %0, m0\n\ts_mov_b32 m0, %2\n\ts_nop 0\n\tglobal_load_lds_dwordx4 %1, off\n\ts_mov_b32 m0, %0":"=&s"(keep):"v"(gsrc),"s"(lds_dst):"memory");}
__device__ __forceinline__ float max3f(float a,float b,float c){float r;asm("v_max3_f32 %0, %1, %2, %3":"=v"(r):"v"(a),"v"(b),"v"(c));return r;}
__device__ __forceinline__ float max2f(float a,float b){float r;asm("v_max_f32_e32 %0, %1, %2":"=v"(r):"v"(a),"v"(b));return r;}
__device__ __forceinline__ float fadd_s(float a,float b){float r;asm("v_add_f32_e32 %0, %1, %2":"=v"(r):"v"(a),"v"(b));return r;}
__device__ __forceinline__ float fsub_s(float a,float b){float r;asm("v_sub_f32_e32 %0, %1, %2":"=v"(r):"v"(a),"v"(b));return r;}
typedef float f32x2_t __attribute__((ext_vector_type(2))); typedef __bf16 bf16x2_t __attribute__((ext_vector_type(2)));
__device__ __forceinline__ unsigned cvtpk_s(float lo,float hi){f32x2_t v={lo,hi};bf16x2_t b=__builtin_convertvector(v,bf16x2_t);return __builtin_bit_cast(unsigned,b);}
#define WAIT_BAR(N) asm volatile("s_waitcnt vmcnt(" #N ") lgkmcnt(0)\n\ts_barrier":::"memory")

__device__ __forceinline__ void qkt(f32x16&p0,f32x16&p1,const char*Kslot,const bf16x8*qr,const f32x16&negm,int r32,int hi){
  const char*kb=Kslot+hi*1024+r32*16;
  #pragma unroll
  for(int d0=0;d0<4;++d0){
    const bf16x8 b0=*reinterpret_cast<const bf16x8*>(kb+d0*2048);
    const bf16x8 b1=*reinterpret_cast<const bf16x8*>(kb+d0*2048+512);
    if(d0==0){p0=__builtin_amdgcn_mfma_f32_32x32x16_bf16(b0,qr[0],negm,0,0,0);p1=__builtin_amdgcn_mfma_f32_32x32x16_bf16(b1,qr[0],negm,0,0,0);}
    else{p0=__builtin_amdgcn_mfma_f32_32x32x16_bf16(b0,qr[d0],p0,0,0,0);p1=__builtin_amdgcn_mfma_f32_32x32x16_bf16(b1,qr[d0],p1,0,0,0);}}
}
typedef __attribute__((address_space(3))) const char* lds_cptr;
typedef short v4i16_t __attribute__((ext_vector_type(4)));
__device__ __forceinline__ void kload8(bf16x8*kf,lds_cptr kp){
  kf[0]=*(const __attribute__((address_space(3))) bf16x8*)(kp);      kf[1]=*(const __attribute__((address_space(3))) bf16x8*)(kp+512);
  kf[2]=*(const __attribute__((address_space(3))) bf16x8*)(kp+2048); kf[3]=*(const __attribute__((address_space(3))) bf16x8*)(kp+2560);
  kf[4]=*(const __attribute__((address_space(3))) bf16x8*)(kp+4096); kf[5]=*(const __attribute__((address_space(3))) bf16x8*)(kp+4608);
  kf[6]=*(const __attribute__((address_space(3))) bf16x8*)(kp+6144); kf[7]=*(const __attribute__((address_space(3))) bf16x8*)(kp+6656);
}
__device__ __forceinline__ void kload2(bf16x8*kf,lds_cptr kp,int j){ kf[2*j]=*(const __attribute__((address_space(3))) bf16x8*)(kp+j*2048); kf[2*j+1]=*(const __attribute__((address_space(3))) bf16x8*)(kp+j*2048+512); }
__device__ __forceinline__ s16x4 vtr(lds_cptr p){ return __builtin_bit_cast(s16x4,__builtin_amdgcn_ds_read_tr16_b64_v4i16((__attribute__((address_space(3))) v4i16_t*)p)); }
__device__ __forceinline__ float rowmax(const f32x16&p0,const f32x16&p1){
  float a=max3f(p0[0],p0[1],p1[0]),b=max3f(p0[2],p0[3],p1[1]);a=max3f(a,p1[2],p1[3]);
  #pragma unroll
  for(int r=4;r<16;r+=4){a=max3f(a,p0[r],p0[r+1]);b=max3f(b,p0[r+2],p0[r+3]);a=max3f(a,p1[r],p1[r+1]);b=max3f(b,p1[r+2],p1[r+3]);}
  const float m=max2f(a,b);
  auto rr=__builtin_amdgcn_permlane32_swap(__float_as_uint(m),__float_as_uint(m),false,false);
  return max2f(__uint_as_float(rr[0]),__uint_as_float(rr[1]));
}
__device__ __forceinline__ void pv(f32x16*o,int vb,bf16x8 pa0,bf16x8 pa1,bf16x8 pa2,bf16x8 pa3){
  #pragma unroll
  for(int d0=0;d0<4;++d0){s16x4 lo[4],hi[4];
    #pragma unroll
    for(int ks=0;ks<4;++ks){
      asm volatile("ds_read_b64_tr_b16 %0,%1 offset:%c2":"=&v"(lo[ks]):"v"(vb),"i"(d0*4096+ks*1024):"memory");
      asm volatile("ds_read_b64_tr_b16 %0,%1 offset:%c2":"=&v"(hi[ks]):"v"(vb),"i"(d0*4096+ks*1024+512):"memory");}
    asm volatile("s_waitcnt lgkmcnt(0)":::"memory");SBAR();
    #define PK(k) (bf16x8){lo[k][0],lo[k][1],lo[k][2],lo[k][3],hi[k][0],hi[k][1],hi[k][2],hi[k][3]}
    o[d0]=__builtin_amdgcn_mfma_f32_32x32x16_bf16(pa0,PK(0),o[d0],0,0,0);
    o[d0]=__builtin_amdgcn_mfma_f32_32x32x16_bf16(pa1,PK(1),o[d0],0,0,0);
    o[d0]=__builtin_amdgcn_mfma_f32_32x32x16_bf16(pa2,PK(2),o[d0],0,0,0);
    o[d0]=__builtin_amdgcn_mfma_f32_32x32x16_bf16(pa3,PK(3),o[d0],0,0,0);
    #undef PK
  }
}

#ifndef ATTN_STORE16
#define ATTN_STORE16(p,v) (*(u32x4*)(p)=(v))
#endif
template<int THRL,bool STAT> __device__ __forceinline__ int attn_unit(float mstat,int q0,const bf16*Q,const bf16*__restrict__ K,const bf16*__restrict__ V,bf16*O,char*shm,const bf16*O1,float lam,const float*subg,unsigned short*CAo,const bf16*Knext,const bf16*Vnext,int s0,bool pre){
  #define NXT_(x) (((x)==(NSLOT-1)*SLOTB)?0:(x)+SLOTB)
  const int s1=NXT_(s0),s2=NXT_(s1);
  int tid_=threadIdx.x; asm volatile("":"+v"(tid_));
  const int tid=tid_,lane=tid&63,r32=lane&31,hi=lane>>5; const int wid=__builtin_amdgcn_readfirstlane(tid>>6);
  const bf16*Qw=Q+(long)(q0+wid*QBLK)*QP;
  const bf16*Kh=K,*Vh=V;
  const unsigned lds0=(unsigned)(uintptr_t)shm;
  float*wsf=(float*)(shm+LDS_WS)+wid*64;
  const bf16*ksrc=Kh+(long)lane*KP+wid*8;
  const bf16*vsrc=Vh+(long)(16*(wid&3)+(lane>>2))*VP+(wid>>2)*32+(lane&3)*8;
  const unsigned kdst=lds0+LDS_K+wid*1024, vdst=lds0+LDS_V+wid*1024;
  #define DMA_K(t,slot) glds16(ksrc+(long)(t)*KVBLK*KP,(unsigned)__builtin_amdgcn_readfirstlane(kdst+(slot)))
  #define DMA_V(t,slot) do{ glds16(vsrc+(long)(t)*KVBLK*VP,(unsigned)__builtin_amdgcn_readfirstlane(vdst+2*(slot))); glds16(vsrc+(long)(t)*KVBLK*VP+64,(unsigned)__builtin_amdgcn_readfirstlane(vdst+2*(slot)+8192)); }while(0)
  const int vb0=(int)(lds0+LDS_V)+((lane>>4)&1)*32+(lane&3)*8+(4*hi+((lane&15)>>2))*64;
  const char*Kbase=shm+LDS_K; bf16x8 kf[8];
  const lds_cptr shm3=(lds_cptr)shm; const lds_cptr kp0=shm3+LDS_K+hi*1024+r32*16; const lds_cptr vp0=shm3+LDS_V+((lane>>4)&1)*32+(lane&3)*8+(4*hi+((lane&15)>>2))*64;
  const int NT=(q0+QB)/KVBLK;
  if(!pre){DMA_K(0,s0);DMA_V(0,s0);DMA_K(1,s1);}
  bf16x8 qr[4];
  #pragma unroll
  for(int d0=0;d0<4;++d0)qr[d0]=*reinterpret_cast<const bf16x8*>(&Qw[(long)r32*QP+d0*16+hi*8]);
  float mhat=0.f,l_reg=0.f;f32x16 o[4];{float zz=0.f;asm volatile("":"+v"(zz));
  #pragma unroll
  for(int r=0;r<16;++r){o[0][r]=zz;o[1][r]=zz;o[2][r]=zz;o[3][r]=zz;}}
  f32x16 negm;{float zn=0.f;asm volatile("":"+v"(zn));
  #pragma unroll
  for(int r=0;r<16;++r)negm[r]=zn;}
  asm volatile("":"+v"(negm));
  const int qrel=wid*QBLK+r32;
  #define CMASK(P0,P1,t) do{int jb_=(t)-(NT-4); if(jb_>=0)cmask(P0,P1,jb_,qrel,hi);}while(0)
  bool resc=false;
  #define START(P0,P1) do{ float rm; if constexpr (STAT) rm=mstat; else rm=rowmax(P0,P1); resc=false; \
    { const float dl=rm; mhat=fadd_s(mhat,dl); \
      _Pragma("unroll") for(int r=0;r<16;++r){P0[r]=fsub_s(P0[r],dl);P1[r]=fsub_s(P1[r],dl);} \
      _Pragma("unroll") for(int r=0;r<16;++r)negm[r]=-mhat; asm volatile("":"+v"(negm)); } \
    _Pragma("unroll") for(int r=0;r<16;++r)P0[r]=__builtin_amdgcn_exp2f(P0[r]); }while(0)
  #define RESC() do{ if(resc){ asm volatile("s_waitcnt lgkmcnt(0)":::"memory"); \
      _Pragma("unroll") for(int d_=0;d_<4;++d_) _Pragma("unroll") for(int r=0;r<16;++r)o[d_][r]*=wsf[crow(r,hi)]; } }while(0)
  f32x16 pA0,pA1,pB0,pB1;
  int sl_prev=s0,sl_cur=s0,sl_next=s1;
  #define ROT() do{sl_prev=sl_cur;sl_cur=sl_next;sl_next=(sl_next==(NSLOT-1)*SLOTB)?0:sl_next+SLOTB;}while(0)
  if(!pre){DMA_K(2,s2);}
  WAIT_BAR(4);
  qkt(pA0,pA1,Kbase+s0,qr,negm,r32,hi);asm volatile("s_nop 15\n\ts_nop 7":"+v"(pA0),"+v"(pA1));CMASK(pA0,pA1,0);
  START(pA0,pA1);
  _Pragma("unroll") for(int r=0;r<16;++r)pA1[r]=__builtin_amdgcn_exp2f(pA1[r]);
  WAIT_BAR(0);
  DMA_K(3,s0);DMA_V(1,s1);
  ROT();
  kload8(kf,kp0+sl_cur);
  WAIT_BAR(3);
  s16x4 vlo[8],vhi[8]; u32x4 pw0,pw1,pw2,pw3;
  #define PKW(P,B) cvtpk_s(P[B],P[B+1])
  #define PAF(k) __builtin_bit_cast(bf16x8,pw##k)
  #define VFR(i) (bf16x8){vlo[i][0],vlo[i][1],vlo[i][2],vlo[i][3],vhi[i][0],vhi[i][1],vhi[i][2],vhi[i][3]}
  #define PIN(x) asm volatile("":"+v"(x))
  #define MX3(a,b,c) __builtin_fmaxf(__builtin_fmaxf((a),(b)),(c))
  #define GAPA(MF,A0,A1,A2,A3,W0,W1,PW) do{ MF; sacc+=A0; sacc+=A1; sacc+=A2; sacc+=A3; PIN(sacc); W0; W1; PIN(PW); SBAR(); }while(0)
  #define EX(v) __builtin_amdgcn_exp2f(v)
  #define GAPB2(MF,X,B) do{ MF; X[B]=EX(X[B]); X[B+1]=EX(X[B+1]); PIN(X); SBAR(); }while(0)
  #define VRD2(i) do{ vlo[i]=vtr(vp_+((((i)>>2)+2)*4096+((i)&3)*1024)); vhi[i]=vtr(vp_+((((i)>>2)+2)*4096+((i)&3)*1024+512)); }while(0)
  #define VRD(i) do{ vlo[i]=vtr(vp_+(((i)>>2)*4096+((i)&3)*1024)); vhi[i]=vtr(vp_+(((i)>>2)*4096+((i)&3)*1024+512)); }while(0)
  #define KRD(G,j) do{ if(G){ kload2(kf,kp0+sl_next,j); SBAR(); } }while(0)
  #define STEP(C0,C1,P0,P1,t,GK,GV,GL) do{ SBAR(); \
    const lds_cptr vp_=vp0+2*sl_prev; \
    VRD(0); SBAR(); float sacc=(P0[0]+P0[1]); \
    GAPA(C0=__builtin_amdgcn_mfma_f32_32x32x16_bf16(kf[0],qr[0],negm,0,0,0), P0[2],P0[3],P0[4],P0[5],     pw0[0]=PKW(P0,0), pw0[1]=PKW(P0,2), pw0); \
    VRD(4); SBAR(); GAPA(C1=__builtin_amdgcn_mfma_f32_32x32x16_bf16(kf[1],qr[0],negm,0,0,0), P0[6],P0[7],P0[8],P0[9],     pw0[2]=PKW(P0,4), pw0[3]=PKW(P0,6), pw0); \
    VRD(1); SBAR(); GAPA(C0=__builtin_amdgcn_mfma_f32_32x32x16_bf16(kf[2],qr[1],C0,0,0,0),   P0[10],P0[11],P0[12],P0[13], pw1[0]=PKW(P0,8), pw1[1]=PKW(P0,10), pw1); \
    VRD(5); SBAR(); GAPA(C1=__builtin_amdgcn_mfma_f32_32x32x16_bf16(kf[3],qr[1],C1,0,0,0),   P0[14],P0[15],P1[0],P1[1],   pw1[2]=PKW(P0,12),pw1[3]=PKW(P0,14), pw1); \
    VRD(2); SBAR(); GAPA(C0=__builtin_amdgcn_mfma_f32_32x32x16_bf16(kf[4],qr[2],C0,0,0,0),   P1[2],P1[3],P1[4],P1[5],     pw2[0]=PKW(P1,0), pw2[1]=PKW(P1,2), pw2); \
    VRD(6); SBAR(); GAPA(C1=__builtin_amdgcn_mfma_f32_32x32x16_bf16(kf[5],qr[2],C1,0,0,0),   P1[6],P1[7],P1[8],P1[9],     pw2[2]=PKW(P1,4), pw2[3]=PKW(P1,6), pw2); \
    VRD(3); SBAR(); GAPA(C0=__builtin_amdgcn_mfma_f32_32x32x16_bf16(kf[6],qr[3],C0,0,0,0),   P1[10],P1[11],P1[12],P1[13], pw3[0]=PKW(P1,8), pw3[1]=PKW(P1,10), pw3); \
    VRD(7); SBAR(); GAPA(C1=__builtin_amdgcn_mfma_f32_32x32x16_bf16(kf[7],qr[3],C1,0,0,0),   P1[14],P1[15],0.f,0.f,       pw3[2]=PKW(P1,12),pw3[3]=PKW(P1,14), pw3); \
    l_reg+=sacc; \
    if(GK){DMA_K((t)+3,sl_cur);} if(GV){DMA_V((t)+1,sl_next);} \
    CMASK(C0,C1,t); \
    if constexpr (!STAT) { float a=MX3(C0[0],C0[1],C1[0]),b=MX3(C0[2],C0[3],C1[1]); a=MX3(a,C1[2],C1[3]); \
      _Pragma("unroll") for(int r=4;r<16;r+=4){a=MX3(a,C0[r],C0[r+1]);b=MX3(b,C0[r+2],C0[r+3]);a=MX3(a,C1[r],C1[r+1]);b=MX3(b,C1[r+2],C1[r+3]);} \
      float rm=__builtin_fmaxf(a,b); { auto rr=__builtin_amdgcn_permlane32_swap(__float_as_uint(rm),__float_as_uint(rm),false,false); rm=__builtin_fmaxf(__uint_as_float(rr[0]),__uint_as_float(rr[1])); } \
      resc=false; \
      if(__builtin_expect(__any(rm>(float)THRL),0)){ const float dl=__builtin_fmaxf(rm,0.f); mhat+=dl; \
        _Pragma("unroll") for(int r=0;r<16;++r){C0[r]-=dl;C1[r]-=dl;} \
        _Pragma("unroll") for(int r=0;r<16;++r)negm[r]=-mhat; asm volatile("":"+v"(negm)); \
        const float f=__builtin_amdgcn_exp2f(-dl); l_reg*=f; if(hi==0)wsf[r32]=f; resc=true; } } \
    SBAR(); \
    GAPB2(o[0]=__builtin_amdgcn_mfma_f32_32x32x16_bf16(PAF(0),VFR(0),o[0],0,0,0), C0,0);  VRD2(0); SBAR(); \
    GAPB2(o[1]=__builtin_amdgcn_mfma_f32_32x32x16_bf16(PAF(0),VFR(4),o[1],0,0,0), C0,2);  VRD2(4); SBAR(); \
    GAPB2(o[0]=__builtin_amdgcn_mfma_f32_32x32x16_bf16(PAF(1),VFR(1),o[0],0,0,0), C0,4);  VRD2(1); SBAR(); \
    GAPB2(o[1]=__builtin_amdgcn_mfma_f32_32x32x16_bf16(PAF(1),VFR(5),o[1],0,0,0), C0,6);  VRD2(5); SBAR(); \
    GAPB2(o[0]=__builtin_amdgcn_mfma_f32_32x32x16_bf16(PAF(2),VFR(2),o[0],0,0,0), C0,8);  VRD2(2); SBAR(); \
    GAPB2(o[1]=__builtin_amdgcn_mfma_f32_32x32x16_bf16(PAF(2),VFR(6),o[1],0,0,0), C0,10); VRD2(6); SBAR(); \
    GAPB2(o[0]=__builtin_amdgcn_mfma_f32_32x32x16_bf16(PAF(3),VFR(3),o[0],0,0,0), C0,12); VRD2(3); SBAR(); \
    GAPB2(o[1]=__builtin_amdgcn_mfma_f32_32x32x16_bf16(PAF(3),VFR(7),o[1],0,0,0), C0,14); VRD2(7); SBAR(); \
    GAPB2(o[2]=__builtin_amdgcn_mfma_f32_32x32x16_bf16(PAF(0),VFR(0),o[2],0,0,0), C1,0); \
    GAPB2(o[3]=__builtin_amdgcn_mfma_f32_32x32x16_bf16(PAF(0),VFR(4),o[3],0,0,0), C1,2); \
    KRD(GL,0); GAPB2(o[2]=__builtin_amdgcn_mfma_f32_32x32x16_bf16(PAF(1),VFR(1),o[2],0,0,0), C1,4); \
    KRD(GL,1); GAPB2(o[3]=__builtin_amdgcn_mfma_f32_32x32x16_bf16(PAF(1),VFR(5),o[3],0,0,0), C1,6); \
    KRD(GL,2); GAPB2(o[2]=__builtin_amdgcn_mfma_f32_32x32x16_bf16(PAF(2),VFR(2),o[2],0,0,0), C1,8); \
    KRD(GL,3); GAPB2(o[3]=__builtin_amdgcn_mfma_f32_32x32x16_bf16(PAF(2),VFR(6),o[3],0,0,0), C1,10); \
    GAPB2(o[2]=__builtin_amdgcn_mfma_f32_32x32x16_bf16(PAF(3),VFR(3),o[2],0,0,0), C1,12); \
    GAPB2(o[3]=__builtin_amdgcn_mfma_f32_32x32x16_bf16(PAF(3),VFR(7),o[3],0,0,0), C1,14); \
    }while(0)
  int t=1;
  #undef CMASK
  #define CMASK(P0,P1,t) do{}while(0)
  for(;t+5<NT;t+=2){
    STEP(pB0,pB1,pA0,pA1,t,true,true,true);     WAIT_BAR(3); RESC(); ROT();
    STEP(pA0,pA1,pB0,pB1,t+1,true,true,true);   WAIT_BAR(3); RESC(); ROT();
  }
  #undef CMASK
  #define CMASK(P0,P1,t) do{int jb_=(t)-(NT-4); if(jb_>=0)cmask(P0,P1,jb_,qrel,hi);}while(0)
  #define ENDW(tt) do{ if((tt)+3<NT){WAIT_BAR(3);} else if((tt)+2<NT){WAIT_BAR(2);} else {WAIT_BAR(0);} }while(0)
  for(;t+1<NT;t+=2){
    STEP(pB0,pB1,pA0,pA1,t,(t+3<NT),(t+1<NT),(t+1<NT));       ENDW(t);   RESC(); ROT();
    STEP(pA0,pA1,pB0,pB1,t+1,(t+4<NT),(t+2<NT),(t+2<NT));     ENDW(t+1); RESC(); ROT();
  }
  int snext=0;
  if(Knext!=nullptr){
    const int p0=sl_next,p1=NXT_(p0),p2=NXT_(p1); snext=p0;
    const bf16*kn=Knext+(long)lane*KP+wid*8; const bf16*vn=Vnext+(long)(16*(wid&3)+(lane>>2))*VP+(wid>>2)*32+(lane&3)*8;
    glds16(kn,(unsigned)__builtin_amdgcn_readfirstlane(kdst+p0));
    glds16(vn,(unsigned)__builtin_amdgcn_readfirstlane(vdst+2*p0)); glds16(vn+64,(unsigned)__builtin_amdgcn_readfirstlane(vdst+2*p0+8192));
    glds16(kn+(long)KVBLK*KP,(unsigned)__builtin_amdgcn_readfirstlane(kdst+p1)); glds16(kn+(long)2*KVBLK*KP,(unsigned)__builtin_amdgcn_readfirstlane(kdst+p2)); }
  STEP(pB0,pB1,pA0,pA1,NT-1,false,false,false); RESC();
  { float sacc=pB0[0]+pB0[1]; _Pragma("unroll") for(int r=2;r<16;++r)sacc+=pB0[r]; _Pragma("unroll") for(int r=0;r<16;++r)sacc+=pB1[r]; l_reg+=sacc;
    pw0=(u32x4){PKW(pB0,0),PKW(pB0,2),PKW(pB0,4),PKW(pB0,6)};pw1=(u32x4){PKW(pB0,8),PKW(pB0,10),PKW(pB0,12),PKW(pB0,14)};pw2=(u32x4){PKW(pB1,0),PKW(pB1,2),PKW(pB1,4),PKW(pB1,6)};pw3=(u32x4){PKW(pB1,8),PKW(pB1,10),PKW(pB1,12),PKW(pB1,14)};
    SBAR(); pv(o,vb0+2*sl_cur,PAF(0),PAF(1),PAF(2),PAF(3)); }
  #undef PKW
  #undef PAF
  #undef VFR
  #undef PIN
  #undef MX3
  #undef GAPA
  #undef GAPB2
  #undef VRD2
  #undef EX
  #undef VRD
  #undef KRD
  #undef STEP
  #undef ENDW
  {auto rr=__builtin_amdgcn_permlane32_swap(__float_as_uint(l_reg),__float_as_uint(l_reg),false,false);l_reg=__uint_as_float(rr[0])+__uint_as_float(rr[1]);}
  if(hi==0)wsf[32+r32]=l_reg;asm volatile("s_waitcnt lgkmcnt(0)":::"memory");
  float rli[16];
  #pragma unroll
  for(int r=0;r<16;++r)rli[r]=__builtin_amdgcn_rcpf(wsf[32+crow(r,hi)]);
  bf16*Ow=O+(long)(q0+wid*QBLK)*OP;
  bf16*stg=(bf16*)(shm+LDS_OST)+wid*2048;
  if(O1==nullptr){
    #pragma unroll
    for(int hf=0;hf<2;++hf){
      #pragma unroll
      for(int r=0;r<16;++r){const int orow=crow(r,hi);
        #pragma unroll
        for(int d0=0;d0<2;++d0)stg[orow*64+d0*32+r32]=__float2bfloat16(o[2*hf+d0][r]*rli[r]);}
      asm volatile("s_waitcnt lgkmcnt(0)":::"memory");
      #pragma unroll
      for(int i=0;i<4;++i){const int row=i*8+(lane>>3),ch=lane&7; const u32x4 v=*(const u32x4*)(stg+row*64+ch*8); ATTN_STORE16(Ow+(long)row*OP+hf*64+ch*8,v);}
      asm volatile("s_waitcnt lgkmcnt(0)":::"memory"); }
  } else {
    const bf16*O1w=O1+(long)(q0+wid*QBLK)*OP; unsigned long long p1[2][4][2];
    #pragma unroll
    for(int hf=0;hf<2;++hf)
      #pragma unroll
      for(int i=0;i<4;++i){const int row=i*8+(lane>>3),ch=lane&7; unsigned long long*a=(unsigned long long*)(O1w+(long)row*OP+hf*64+ch*8);
        p1[hf][i][0]=__hip_atomic_load(a,__ATOMIC_RELAXED,__HIP_MEMORY_SCOPE_AGENT); p1[hf][i][1]=__hip_atomic_load(a+1,__ATOMIC_RELAXED,__HIP_MEMORY_SCOPE_AGENT);}
    float dd[2][4][8]; float ssp[4]={0.f,0.f,0.f,0.f};
    #pragma unroll
    for(int hf=0;hf<2;++hf){
      #pragma unroll
      for(int r=0;r<16;++r){const int orow=crow(r,hi);
        #pragma unroll
        for(int d0=0;d0<2;++d0)stg[orow*64+d0*32+r32]=__float2bfloat16(o[2*hf+d0][r]*rli[r]);}
      asm volatile("s_waitcnt lgkmcnt(0)":::"memory");
      #pragma unroll
      for(int i=0;i<4;++i){const int row=i*8+(lane>>3),ch=lane&7; const u32x4 v=*(const u32x4*)(stg+row*64+ch*8);
        const unsigned w1[4]={(unsigned)p1[hf][i][0],(unsigned)(p1[hf][i][0]>>32),(unsigned)p1[hf][i][1],(unsigned)(p1[hf][i][1]>>32)};
        #pragma unroll
        for(int j=0;j<4;++j){ const float a0=__uint_as_float(w1[j]<<16)-lam*__uint_as_float(v[j]<<16), a1=__uint_as_float(w1[j]&0xffff0000u)-lam*__uint_as_float(v[j]&0xffff0000u);
          dd[hf][i][2*j]=a0; dd[hf][i][2*j+1]=a1; ssp[i]+=a0*a0+a1*a1; } }
      asm volatile("s_waitcnt lgkmcnt(0)":::"memory"); }
    #pragma unroll
    for(int i=0;i<4;++i){ float ss=ssp[i];
      ss+=__int_as_float(__builtin_amdgcn_update_dpp(0,__float_as_int(ss),0xB1,0xf,0xf,true)); ss+=__int_as_float(__builtin_amdgcn_update_dpp(0,__float_as_int(ss),0x4E,0xf,0xf,true)); ss+=__int_as_float(__builtin_amdgcn_update_dpp(0,__float_as_int(ss),0x141,0xf,0xf,true));
      const float rn=1.0f/sqrtf(ss*(1.0f/128.0f)+1e-6f)*0.8f;
      const int row=i*8+(lane>>3),ch=lane&7;
      #pragma unroll
      for(int hf=0;hf<2;++hf){ const float*gp=subg+hf*64+ch*8; u32x4 w;
        w[0]=cvtpk_s(dd[hf][i][0]*rn*gp[0],dd[hf][i][1]*rn*gp[1]); w[1]=cvtpk_s(dd[hf][i][2]*rn*gp[2],dd[hf][i][3]*rn*gp[3]);
        w[2]=cvtpk_s(dd[hf][i][4]*rn*gp[4],dd[hf][i][5]*rn*gp[5]); w[3]=cvtpk_s(dd[hf][i][6]*rn*gp[6],dd[hf][i][7]*rn*gp[7]);
        *(u32x4*)(CAo+(long)(q0+wid*QBLK+row)*1024+hf*64+ch*8)=w; } }
  }
  asm volatile("s_waitcnt lgkmcnt(0)\n\ts_barrier":::"memory");
  #undef DMA_K
  #undef DMA_V
  #undef CMASK
  #undef START
  #undef RESC
  #undef ROT
  #undef NXT_
  return snext;
}
constexpr int ATTN_LDS_BYTES=LDS_BYTES;
#undef SBAR
#undef WAIT_BAR
}

constexpr int NWAVES = 8, NTHREADS = NWAVES * 64;
#ifndef MK_PER_PHASE
#define MK_PER_PHASE 0
#endif
#ifndef RUN_PHASES
#define RUN_PHASES 8
#endif
constexpr int N_PHASES = RUN_PHASES;

constexpr size_t MiB = 1u << 20;
constexpr size_t WS_CTL = 0, CTL_ZERO_BYTES = 65536;
constexpr size_t WS_RS = 1 * MiB;
constexpr size_t WS_TINFO = 2 * MiB;
constexpr size_t WS_WR = 3 * MiB;
constexpr size_t WS_LTOK = 4 * MiB, WS_LW = 8 * MiB;
constexpr size_t WS_WIN = 16 * MiB, WS_WCA = 25 * MiB, WS_WOUT = 27 * MiB;
constexpr size_t WS_A = 32 * MiB;
constexpr size_t WS_QB = 112 * MiB, WS_KB = 144 * MiB, WS_VB = 176 * MiB, WS_YG = 208 * MiB;
constexpr size_t WS_MG = 112 * MiB, WS_XM = 176 * MiB;
constexpr size_t WS_GT = 240 * MiB;
constexpr size_t WS_WGU = 240 * MiB, WS_WD = 304 * MiB;
constexpr size_t WS_CA = 368 * MiB;
constexpr size_t WS_YB = 112 * MiB;
constexpr size_t WS_LIST = 432 * MiB;
constexpr size_t WS_CTOK = 448 * MiB;
constexpr size_t WS_END = 464 * MiB;
static_assert(WS_A + (size_t)CROWS * 1024 <= WS_QB && WS_WD + (size_t)NEXP * 1024 * 512 <= WS_CA, "d_ws map");
static_assert(WS_WIN + (size_t)IN_COLS * 1024 * 2 <= WS_WCA, "d_ws map");

constexpr int RING_BYTES = 131072;
constexpr int META_OFF = RING_BYTES;
constexpr int HIST_OFF = RING_BYTES + 1024;
constexpr int BARST_OFF = RING_BYTES + 3072;
constexpr int META2_OFF = RING_BYTES + 4096;
constexpr int LDS_BYTES = 147456;

#define GAS __attribute__((address_space(1)))
#define LAS __attribute__((address_space(3)))
typedef unsigned short bf16;
typedef unsigned v4u __attribute__((ext_vector_type(4)));
typedef unsigned v2u __attribute__((ext_vector_type(2)));
typedef float f32x4 __attribute__((ext_vector_type(4)));
typedef float f32x16 __attribute__((ext_vector_type(16)));
typedef short bf16x8 __attribute__((ext_vector_type(8)));
using pg8::cvt_pk_bf16; using pg8::bf_lo; using pg8::bf_hi; using pg8::sigmoidf_fast; using pg8::pack8; using pg8::unpack8;

__device__ __forceinline__ float wave_sum(float v) {
    v += __int_as_float(__builtin_amdgcn_update_dpp(0, __float_as_int(v), 0xB1, 0xf, 0xf, true));
    v += __int_as_float(__builtin_amdgcn_update_dpp(0, __float_as_int(v), 0x4E, 0xf, 0xf, true));
    v += __int_as_float(__builtin_amdgcn_update_dpp(0, __float_as_int(v), 0x141, 0xf, 0xf, true));
    v += __int_as_float(__builtin_amdgcn_update_dpp(0, __float_as_int(v), 0x140, 0xf, 0xf, true));
    const int iv = __float_as_int(v);
    return (__int_as_float(__builtin_amdgcn_readlane(iv, 0)) + __int_as_float(__builtin_amdgcn_readlane(iv, 16))) + (__int_as_float(__builtin_amdgcn_readlane(iv, 32)) + __int_as_float(__builtin_amdgcn_readlane(iv, 48)));
}
__device__ __forceinline__ float wave_max(float v) {
    v = fmaxf(v, __int_as_float(__builtin_amdgcn_update_dpp(0, __float_as_int(v), 0xB1, 0xf, 0xf, true)));
    v = fmaxf(v, __int_as_float(__builtin_amdgcn_update_dpp(0, __float_as_int(v), 0x4E, 0xf, 0xf, true)));
    v = fmaxf(v, __int_as_float(__builtin_amdgcn_update_dpp(0, __float_as_int(v), 0x141, 0xf, 0xf, true)));
    v = fmaxf(v, __int_as_float(__builtin_amdgcn_update_dpp(0, __float_as_int(v), 0x140, 0xf, 0xf, true)));
    const int iv = __float_as_int(v);
    return fmaxf(fmaxf(__int_as_float(__builtin_amdgcn_readlane(iv, 0)), __int_as_float(__builtin_amdgcn_readlane(iv, 16))), fmaxf(__int_as_float(__builtin_amdgcn_readlane(iv, 32)), __int_as_float(__builtin_amdgcn_readlane(iv, 48))));
}
__device__ __forceinline__ float bf16_round(float x) { return bf_lo(cvt_pk_bf16(x, 0.f) & 0xffffu); }

#define XB_TMO      128
#define XB_XCNT(j)  (256  + 64 * (j))
#define XB_XSUB(j)  (1280 + 64 * (j))
#define XB_XGEN(j)  (2304 + 64 * (j))
#define XB_TOP      3328
#define XB_TOPGEN   3392
#define XCD_BAR_WORDS 3456
#define XB_SPIN_CAP (1u << 18)

__device__ __forceinline__ unsigned xb_ld(unsigned* p)              { return __hip_atomic_load(p, __ATOMIC_RELAXED, __HIP_MEMORY_SCOPE_AGENT); }
__device__ __forceinline__ unsigned xb_add(unsigned* p, unsigned v) { return __hip_atomic_fetch_add(p, v, __ATOMIC_RELAXED, __HIP_MEMORY_SCOPE_AGENT); }
__device__ __forceinline__ unsigned xb_xcc_id() { return (unsigned)__builtin_amdgcn_s_getreg((3 << 11) | 20) & 0xFu; }
#define XB_SPIN(cond, bar) do { unsigned _sp = 0; while (cond) { __builtin_amdgcn_s_sleep(1); \
    if ((++_sp & 255u) == 0u) { if (xb_ld(&(bar)[XB_TMO])) break; if (_sp > XB_SPIN_CAP) { atomicAdd(&(bar)[XB_TMO], 1u); break; } } } } while (0)

struct XcdBarrier {
    unsigned* bar; unsigned x;
    volatile LAS unsigned* st;
};

__device__ __forceinline__ XcdBarrier xcd_barrier_post(unsigned* bar, volatile LAS unsigned* st) {
    XcdBarrier b; b.bar = bar; b.x = xb_xcc_id(); b.st = st;
    if (threadIdx.x == 0) (void)xb_add(&bar[XB_XCNT(b.x)], 1u);
    return b;
}
__device__ __forceinline__ void xcd_barrier_complete(unsigned* bar, unsigned x, unsigned& nloc, unsigned& nx) {
    const unsigned G = gridDim.x * gridDim.y * gridDim.z;
    unsigned sum, cnt, mine, sp = 0u;
    for (;;) {
        sum = 0u; cnt = 0u; mine = 0u;
#pragma unroll
        for (unsigned j = 0; j < 16; ++j) { const unsigned c = xb_ld(&bar[XB_XCNT(j)]); sum += c; cnt += (c > 0u) ? 1u : 0u; mine = (j == x) ? c : mine; }
        if (sum == G) break;
        __builtin_amdgcn_s_sleep(1);
        if ((++sp & 255u) == 0u) { if (xb_ld(&bar[XB_TMO])) break; if (sp > XB_SPIN_CAP) { atomicAdd(&bar[XB_TMO], 1u); break; } }
    }
    nloc = mine > 0u ? mine : 1u; nx = cnt > 0u ? cnt : 1u;
}

__device__ __forceinline__ void xcd_barrier(const XcdBarrier& b) {
    asm volatile("s_waitcnt vmcnt(0)" ::: "memory");
    __syncthreads();
    if (threadIdx.x == 0) {
        unsigned* bar = b.bar;
        __builtin_amdgcn_s_waitcnt(0);
        unsigned nloc = b.st[0], nx = b.st[1];
        if (nloc == 0u) { xcd_barrier_complete(bar, b.x, nloc, nx); b.st[0] = nloc; b.st[1] = nx; }
        const unsigned old = xb_add(&bar[XB_XSUB(b.x)], 1u);
        const unsigned gen = old / nloc;
        if (old + 1u == (gen + 1u) * nloc) {
            __builtin_amdgcn_fence(__ATOMIC_RELEASE, "agent");
            asm volatile("s_waitcnt vmcnt(0)" ::: "memory");
            const unsigned og = xb_add(&bar[XB_TOP], 1u);
            const unsigned tg = og / nx;
            if (og + 1u == (tg + 1u) * nx) xb_add(&bar[XB_TOPGEN], 1u);
            else XB_SPIN(xb_ld(&bar[XB_TOPGEN]) == tg, bar);
            __builtin_amdgcn_fence(__ATOMIC_ACQUIRE, "agent");
            xb_add(&bar[XB_XGEN(b.x)], 1u);
            asm volatile("s_waitcnt vmcnt(0)" ::: "memory");
        } else {
            XB_SPIN(xb_ld(&bar[XB_XGEN(b.x)]) == gen, bar);
            __builtin_amdgcn_fence(__ATOMIC_ACQUIRE, "agent");
            asm volatile("s_waitcnt vmcnt(0)" ::: "memory");
        }
    }
    __syncthreads();
}


typedef f32x4 AccT[2][2][4][2];
struct EpiInProj {
    static constexpr bool MID = false, PREMID = false;
    struct Pre {}; __device__ __forceinline__ Pre pre(const pg8::Unit&, int, int) const { return Pre{}; }
    bf16 *YG, *QB, *KB, *VB, *GT; const LAS float* gl;
    __device__ __forceinline__ void mid(AccT&, const pg8::Unit&, int, int, int, int) const {}
    __device__ __forceinline__ void operator()(AccT& acc, const pg8::Unit& u, int wr, int wc, int fr, int fq, const Pre& pre_) const {
        asm volatile("" : "+v"(fr), "+v"(fq));
        const int pn = u.pn; const size_t row0 = (size_t)u.orow + wr * 64 + fr;
        if (pn < 4) {
#pragma unroll
            for (int ai = 0; ai < 2; ++ai)
#pragma unroll
                for (int m = 0; m < 4; ++m) { const size_t row = row0 + ai * 128 + m * 16; f32x4 y[2];
#pragma unroll
                    for (int n = 0; n < 2; ++n) { const f32x4 a = acc[ai][0][m][n], g = acc[ai][1][m][n];
                        y[n] = (f32x4){a[0] * sigmoidf_fast(g[0]), a[1] * sigmoidf_fast(g[1]), a[2] * sigmoidf_fast(g[2]), a[3] * sigmoidf_fast(g[3])}; }
                    __builtin_nontemporal_store(pack8(y[0], y[1]), (v4u*)(YG + row * 512 + pn * 128 + wc * 32 + 8 * fq)); }
        } else if (pn < 8) {
            const bool isq = pn < 6; bf16* base = isq ? QB : KB; const LAS float* gp = gl + (isq ? 0 : 64); const float sc = isq ? 0.125f * 1.4426950408889634f : 1.0f;
            f32x4 gv[2][2];
#pragma unroll
            for (int bj = 0; bj < 2; ++bj)
#pragma unroll
                for (int n = 0; n < 2; ++n) gv[bj][n] = *(const LAS f32x4*)(gp + 32 * bj + 8 * fq + 4 * n) * sc;
#pragma unroll
            for (int ai = 0; ai < 2; ++ai)
#pragma unroll
                for (int m = 0; m < 4; ++m) { const size_t row = row0 + ai * 128 + m * 16; float ss = 0.f;
#pragma unroll
                    for (int bj = 0; bj < 2; ++bj)
#pragma unroll
                        for (int n = 0; n < 2; ++n) { const f32x4 a = acc[ai][bj][m][n]; ss += (a[0] * a[0] + a[1] * a[1]) + (a[2] * a[2] + a[3] * a[3]); }
                    ss += __shfl_xor(ss, 16); ss += __shfl_xor(ss, 32);
                    const float rinv = 1.0f / sqrtf(ss * (1.0f / 64.0f) + EPS);
#pragma unroll
                    for (int bj = 0; bj < 2; ++bj)
                        __builtin_nontemporal_store(pack8(acc[ai][bj][m][0] * rinv * gv[bj][0], acc[ai][bj][m][1] * rinv * gv[bj][1]), (v4u*)(base + row * 512 + (pn & 1) * 256 + wc * 64 + bj * 32 + 8 * fq)); }
        } else if (pn < 10) {
#pragma unroll
            for (int ai = 0; ai < 2; ++ai)
#pragma unroll
                for (int m = 0; m < 4; ++m) { const size_t row = row0 + ai * 128 + m * 16;
#pragma unroll
                    for (int bj = 0; bj < 2; ++bj) __builtin_nontemporal_store(pack8(acc[ai][bj][m][0], acc[ai][bj][m][1]), (v4u*)(VB + row * 512 + (pn - 8) * 256 + bj * 128 + wc * 32 + 8 * fq)); }
        } else {
#pragma unroll
            for (int ai = 0; ai < 2; ++ai)
#pragma unroll
                for (int m = 0; m < 4; ++m) { const size_t row = row0 + ai * 128 + m * 16; f32x4 rr[2], gg[2];
#pragma unroll
                    for (int n = 0; n < 2; ++n)
#pragma unroll
                        for (int j = 0; j < 4; ++j) { const float e0 = __builtin_amdgcn_exp2f(-1.4426950408889634f * acc[ai][0][m][n][j]), e1 = fminf(__builtin_amdgcn_exp2f(-1.4426950408889634f * acc[ai][1][m][n][j]), 1e30f);
                            gg[n][j] = __builtin_amdgcn_rcpf(1.0f + e1); rr[n][j] = (1.0f + e1) * __builtin_amdgcn_rcpf(1.0f + e0); }
                    const size_t o = row * 1024 + (pn - 10) * 128 + wc * 32 + 8 * fq;
                    __builtin_nontemporal_store(pack8(rr[0], rr[1]), (v4u*)(GT + o)); __builtin_nontemporal_store(pack8(gg[0], gg[1]), (v4u*)(GT + (size_t)NTOK * 1024 + o)); }
        }
    }
};
struct EpiMerged {
    static constexpr bool MID = true, PREMID = false;
    struct Pre {}; __device__ __forceinline__ Pre pre(const pg8::Unit&, int, int) const { return Pre{}; }
    const bf16* GR; const bf16* G1; bf16* MG;
    __device__ __forceinline__ void mid(AccT& acc, const pg8::Unit& u, int wr, int wc, int fr, int fq) const {
        asm volatile("" : "+v"(fr), "+v"(fq));
        const size_t row0 = (size_t)u.orow + wr * 64 + fr; const int col0 = u.pn * 256 + wc * 32 + 8 * fq;
        v4u w0[2][4][2];
#pragma unroll
        for (int ai = 0; ai < 2; ++ai)
#pragma unroll
            for (int m = 0; m < 4; ++m)
#pragma unroll
                for (int bj = 0; bj < 2; ++bj) w0[ai][m][bj] = *(const v4u*)(GR + (row0 + ai * 128 + m * 16) * 1024 + col0 + bj * 128);
        __builtin_amdgcn_sched_barrier(0);
#pragma unroll
        for (int ai = 0; ai < 2; ++ai)
#pragma unroll
            for (int m = 0; m < 4; ++m)
#pragma unroll
                for (int bj = 0; bj < 2; ++bj) { f32x4 a0, a1; unpack8(w0[ai][m][bj], a0, a1); acc[ai][bj][m][0] = acc[ai][bj][m][0] * a0; acc[ai][bj][m][1] = acc[ai][bj][m][1] * a1; }
        __builtin_amdgcn_sched_barrier(0);
    }
    __device__ __forceinline__ void operator()(AccT& acc, const pg8::Unit& u, int wr, int wc, int fr, int fq, const Pre& pre_) const {
        asm volatile("" : "+v"(fr), "+v"(fq));
        const size_t row0 = (size_t)u.orow + wr * 64 + fr; const int col0 = u.pn * 256 + wc * 32 + 8 * fq;
        v4u w1[2][4][2];
#pragma unroll
        for (int ai = 0; ai < 2; ++ai)
#pragma unroll
            for (int m = 0; m < 4; ++m)
#pragma unroll
                for (int bj = 0; bj < 2; ++bj) w1[ai][m][bj] = *(const v4u*)(G1 + (row0 + ai * 128 + m * 16) * 1024 + col0 + bj * 128);
        __builtin_amdgcn_sched_barrier(0);
#pragma unroll
        for (int ai = 0; ai < 2; ++ai)
#pragma unroll
            for (int m = 0; m < 4; ++m) { const size_t row = row0 + ai * 128 + m * 16;
#pragma unroll
                for (int bj = 0; bj < 2; ++bj) { f32x4 b0, b1; unpack8(w1[ai][m][bj], b0, b1);
                    *(v4u*)(MG + row * 1024 + col0 + bj * 128) = pack8(acc[ai][bj][m][0] * b0, acc[ai][bj][m][1] * b1); } }
    }
};
struct EpiOut {
    static constexpr bool MID = false, PREMID = false;
    struct Pre {}; __device__ __forceinline__ Pre pre(const pg8::Unit&, int, int) const { return Pre{}; }
    const float* x; bf16* XMB; unsigned char* XM8;
    __device__ __forceinline__ void mid(AccT&, const pg8::Unit&, int, int, int, int) const {}
    __device__ __forceinline__ void operator()(AccT& acc, const pg8::Unit& u, int wr, int wc, int fr, int fq, const Pre& pre_) const {
        asm volatile("" : "+v"(fr), "+v"(fq));
        const size_t row0 = (size_t)u.orow + wr * 64 + fr; const int col0 = u.pn * 256 + wc * 32 + 8 * fq;
#pragma unroll
        for (int ai = 0; ai < 2; ++ai) {
            f32x4 xv[4][2][2];
#pragma unroll
            for (int m = 0; m < 4; ++m) { const size_t off = (row0 + ai * 128 + m * 16) * 1024 + col0;
#pragma unroll
                for (int bj = 0; bj < 2; ++bj) { xv[m][bj][0] = __builtin_nontemporal_load((const f32x4*)(x + off + bj * 128)); xv[m][bj][1] = __builtin_nontemporal_load((const f32x4*)(x + off + bj * 128 + 4)); } }
            __builtin_amdgcn_sched_barrier(0);
#pragma unroll
            for (int m = 0; m < 4; ++m) { const size_t off = (row0 + ai * 128 + m * 16) * 1024 + col0;
#pragma unroll
                for (int bj = 0; bj < 2; ++bj) { const f32x4 o0 = xv[m][bj][0] + acc[ai][bj][m][0], o1 = xv[m][bj][1] + acc[ai][bj][m][1];
                    *(v4u*)(XMB + off + bj * 128) = pack8(o0, o1);
                    v2u w8; w8.x = pg8::pack4_fp8(o0[0], o0[1], o0[2], o0[3]); w8.y = pg8::pack4_fp8(o1[0], o1[1], o1[2], o1[3]); *(v2u*)(XM8 + off + bj * 128) = w8; } }
            __builtin_amdgcn_sched_barrier(0);
        }
    }
};
struct EpiGateUp {
    static constexpr bool MID = false, PREMID = false;
    typedef int i32x4 __attribute__((ext_vector_type(4)));
    struct Pre { int dst[2][4]; float w[2][4], rs[2][4]; };
    __device__ __forceinline__ Pre pre(const pg8::Unit& u, int wr, int fr) const { Pre p;
#pragma unroll
        for (int ai = 0; ai < 2; ++ai)
#pragma unroll
            for (int m = 0; m < 4; ++m) { const int r = ai * 128 + wr * 64 + m * 16 + fr; const i32x4 en = (r < u.nvalid) ? *(const i32x4*)(LIST + (size_t)(u.lrow + r) * 4) : (i32x4){-1, -1, 0, 0};
                p.dst[ai][m] = en[1]; p.w[ai][m] = __int_as_float(en[2]); p.rs[ai][m] = __int_as_float(en[3]); }
        return p; }
    const int* LIST; unsigned char* HP8; const LAS int* m2;
    __device__ __forceinline__ void mid(AccT&, const pg8::Unit&, int, int, int, int) const {}
    __device__ __forceinline__ void operator()(AccT& acc, const pg8::Unit& u, int wr, int wc, int fr, int fq, const Pre& pre_) const {
        asm volatile("" : "+v"(fr), "+v"(fq));
#pragma unroll
        for (int ai = 0; ai < 2; ++ai)
#pragma unroll
            for (int m = 0; m < 4; ++m) { const int dst = pre_.dst[ai][m]; if (dst < 0) continue;
                const float rs = pre_.rs[ai][m] * (1.0f / 64.0f), w8 = pre_.w[ai][m] * 8.0f;
                const size_t drow = (size_t)m2[dst >> 17] * 256 + ((dst >> 1) & 0xffff);
                float h[8];
#pragma unroll
                for (int n = 0; n < 2; ++n)
#pragma unroll
                    for (int j = 0; j < 4; ++j) { const float g = acc[ai][0][m][n][j] * rs, up = acc[ai][1][m][n][j] * rs; h[4 * n + j] = __builtin_amdgcn_fmed3f(g * sigmoidf_fast(g) * up * w8, -448.f, 448.f); }
                v2u o8; o8.x = pg8::pack4_fp8(h[0], h[1], h[2], h[3]); o8.y = pg8::pack4_fp8(h[4], h[5], h[6], h[7]);
                *(v2u*)(HP8 + drow * 1024 + (dst & 1) * 512 + u.pn * 128 + wc * 32 + 8 * fq) = o8; }
    }
};
struct EpiDownAdd {
    static constexpr bool MID = false, PREMID = true;
    struct Pre { int tok[2][4]; };
    __device__ __forceinline__ Pre pre(const pg8::Unit& u, int wr, int fr) const { Pre p;
#pragma unroll
        for (int ai = 0; ai < 2; ++ai)
#pragma unroll
            for (int m = 0; m < 4; ++m) { const int r = ai * 128 + wr * 64 + m * 16 + fr; p.tok[ai][m] = (r < u.nvalid) ? CTOK[u.lrow + r] : -1; }
        return p; }
    const int* CTOK; const bf16* XMB; float* out;
    __device__ __forceinline__ void mid(AccT&, const pg8::Unit&, int, int, int, int) const {}
    __device__ __forceinline__ void operator()(AccT& acc, const pg8::Unit& u, int wr, int wc, int fr, int fq, const Pre& pre_) const {
        asm volatile("" : "+v"(fr), "+v"(fq));
        const int col0 = u.pn * 256 + wc * 32 + 8 * fq;
        v4u xw[2][4][2];
#pragma unroll
        for (int ai = 0; ai < 2; ++ai)
#pragma unroll
            for (int m = 0; m < 4; ++m) { const int tk = pre_.tok[ai][m]; const size_t off = (size_t)(tk < 0 ? 0 : tk) * 1024 + col0;
#pragma unroll
                for (int bj = 0; bj < 2; ++bj) xw[ai][m][bj] = *(const v4u*)(XMB + off + bj * 128); }
        __builtin_amdgcn_sched_barrier(0);
#pragma unroll
        for (int ai = 0; ai < 2; ++ai)
#pragma unroll
            for (int m = 0; m < 4; ++m) { const int tk = pre_.tok[ai][m]; if (tk < 0) continue; const size_t off = (size_t)tk * 1024 + col0;
#pragma unroll
                for (int bj = 0; bj < 2; ++bj) { f32x4 x0, x1; unpack8(xw[ai][m][bj], x0, x1);
                    __builtin_nontemporal_store(x0 + acc[ai][bj][m][0] * (1.0f / 256.0f), (f32x4*)(out + off + bj * 128)); __builtin_nontemporal_store(x1 + acc[ai][bj][m][1] * (1.0f / 256.0f), (f32x4*)(out + off + bj * 128 + 4)); } }
    }
};
struct MoeOrder {
    int G, c, total; const LAS int* meta;
    __device__ __forceinline__ bool next(int i, pg8::Unit& u) const {
        const int L = i * G + c; if (L >= total * 4) return false;
        const int blk = L >> 2; const int lane = tid_opaque() & 63;
        const int e = __builtin_amdgcn_readfirstlane(__builtin_popcountll(__ballot(lane < NEXP - 1 && meta[1 + lane] <= blk)));
        const int pre = __builtin_amdgcn_readfirstlane(meta[e]), cnt = __builtin_amdgcn_readfirstlane(meta[64 + e]); const int rb = blk - pre;
        u.pn = L & 3; u.pm = rb; u.e = e; u.e2 = e; u.lrow = e * LCAP + rb * 256; u.nvalid = min(256, cnt - rb * 256); u.orow = blk * 256; u.arow = 0; return true;
    }
};
struct ClassOrder {
    int G, c, total; const LAS int* m2;
    __device__ __forceinline__ bool next(int i, pg8::Unit& u) const {
        const int L = i * G + c; if (L >= total * 4) return false;
        const int blk = L >> 2; const int lane = tid_opaque() & 63;
        const int n0 = __builtin_popcountll(__ballot(m2[1 + lane] <= blk)), n1 = __builtin_popcountll(__ballot(lane + 65 <= NCLS - 1 && m2[65 + lane] <= blk));
        const int cls = __builtin_amdgcn_readfirstlane(n0 + n1);
        const int pre = __builtin_amdgcn_readfirstlane(m2[cls]), cnt = __builtin_amdgcn_readfirstlane(m2[128 + cls]); const int rb = blk - pre;
        const int g = cls / 28; int p = cls % 28, a = 0;
        while (p >= 7 - a) { p -= 7 - a; ++a; }
        u.e = g * 8 + a; u.e2 = g * 8 + a + 1 + p; u.pn = L & 3; u.pm = rb; u.lrow = cls * NTOK + rb * 256; u.nvalid = min(256, cnt - rb * 256); u.orow = blk * 256; u.arow = u.orow; return true;
    }
};
__device__ __forceinline__ void moe_meta(LAS int* meta, LAS int* m2, const unsigned* ctl) {
    const int tid = tid_opaque();
    if (tid < NEXP) meta[64 + tid] = (int)__hip_atomic_load(ctl + tid, __ATOMIC_RELAXED, __HIP_MEMORY_SCOPE_AGENT);
    if (tid >= 64 && tid < 64 + NCLS) m2[128 + tid - 64] = (int)__hip_atomic_load(ctl + tid, __ATOMIC_RELAXED, __HIP_MEMORY_SCOPE_AGENT);
    __syncthreads();
    if (tid == 0) { int p = 0;
        for (int e = 0; e < NEXP; ++e) { meta[e] = p; p += (meta[64 + e] + 255) >> 8; }
        meta[NEXP] = p; }
    if (tid == 64) { int p = 0;
        for (int c = 0; c < NCLS; ++c) { m2[c] = p; p += (m2[128 + c] + 255) >> 8; }
        m2[NCLS] = p; }
    __syncthreads();
}

__device__ __forceinline__ void transpose_item(const float* W, int N, int k0, int n0, bf16* WT, int dpitch, int drow0, int dcol0, const float* kscale, LAS float* scr, int lane) {
    const int kr = lane >> 3, nc = (lane & 7) * 4;
    f32x4 v[8];
#pragma unroll
    for (int i = 0; i < 8; ++i) v[i] = *(const f32x4*)(W + (size_t)(k0 + i * 8 + kr) * N + n0 + nc);
    if (kscale) {
#pragma unroll
        for (int i = 0; i < 8; ++i) v[i] = v[i] * kscale[k0 + i * 8 + kr]; }
#pragma unroll
    for (int i = 0; i < 8; ++i) { LAS float* d = scr + (i * 8 + kr) * 33 + nc; d[0] = v[i][0]; d[1] = v[i][1]; d[2] = v[i][2]; d[3] = v[i][3]; }
    asm volatile("s_waitcnt lgkmcnt(0)" ::: "memory");
    const int c = lane & 7;
#pragma unroll
    for (int j = 0; j < 4; ++j) { const int n = (lane >> 3) + 8 * j; const LAS float* s = scr + (8 * c) * 33 + n;
        v4u o; o.x = cvt_pk_bf16(s[0 * 33], s[1 * 33]); o.y = cvt_pk_bf16(s[2 * 33], s[3 * 33]); o.z = cvt_pk_bf16(s[4 * 33], s[5 * 33]); o.w = cvt_pk_bf16(s[6 * 33], s[7 * 33]);
        *(v4u*)(WT + (size_t)(drow0 + n) * dpitch + dcol0 + k0 + 8 * c) = o; }
    asm volatile("s_waitcnt lgkmcnt(0)" ::: "memory");
}
__device__ __forceinline__ void t8_load(f32x4 (&v)[8], const float* W, int N, int k0, int n0, int lane) {
    const int kr = lane >> 3, nc = (lane & 7) * 4;
#pragma unroll
    for (int i = 0; i < 8; ++i) v[i] = __builtin_nontemporal_load((const f32x4*)(W + (size_t)(k0 + i * 8 + kr) * N + n0 + nc));
}
__device__ __forceinline__ void t8_finish(f32x4 (&v)[8], int k0, unsigned char* WT, int dpitch, int drow0, const float* kscale, float mul, LAS float* scr, int lane) {
    const int kr = lane >> 3, nc = (lane & 7) * 4;
#pragma unroll
    for (int i = 0; i < 8; ++i) v[i] = v[i] * (kscale ? kscale[k0 + i * 8 + kr] * mul : mul);
#pragma unroll
    for (int i = 0; i < 8; ++i) { LAS float* d = scr + (i * 8 + kr) * 33 + nc; d[0] = v[i][0]; d[1] = v[i][1]; d[2] = v[i][2]; d[3] = v[i][3]; }
    asm volatile("s_waitcnt lgkmcnt(0)" ::: "memory");
    const int c = lane & 7;
#pragma unroll
    for (int j = 0; j < 4; ++j) { const int n = (lane >> 3) + 8 * j; const LAS float* s = scr + (8 * c) * 33 + n;
        v2u o; o.x = pg8::pack4_fp8(s[0 * 33], s[1 * 33], s[2 * 33], s[3 * 33]); o.y = pg8::pack4_fp8(s[4 * 33], s[5 * 33], s[6 * 33], s[7 * 33]);
        *(v2u*)(WT + (size_t)(drow0 + n) * dpitch + k0 + 8 * c) = o; }
    asm volatile("s_waitcnt lgkmcnt(0)" ::: "memory");
}
__device__ __forceinline__ void transpose_item_fp8(const float* W, int N, int k0, int n0, unsigned char* WT, int dpitch, int drow0, const float* kscale, float mul, LAS float* scr, int lane) {
    f32x4 v[8]; t8_load(v, W, N, k0, n0, lane); t8_finish(v, k0, WT, dpitch, drow0, kscale, mul, scr, lane);
}
__device__ __forceinline__ int inproj_phys(int c) {
    if (c < 512) return (c >> 7) * 256 + (c & 127);
    if (c < 1024) { c -= 512; return (c >> 7) * 256 + 128 + (c & 127); }
    if (c < 2048) { const int sec = (c - 1024) >> 8, cl = (c - 1024) & 255, s = cl >> 6, d = cl & 63; return 1024 + sec * 256 + ((d >> 5) << 7) + (s << 5) + (d & 31); }
    if (c < 2560) return c;
    { int j = c - 2560; const int hi = j >= 1024; j &= 1023; return 2560 + (j >> 7) * 256 + hi * 128 + (j & 127); }
}
struct Ptrs {
    const float *x, *attn_norm_g, *w_in, *conv_dw_w, *conv_dw_b, *conv_ln_g, *conv_ln_b, *w_conv_out, *q_norm_g, *k_norm_g, *lq1, *lk1, *lq2, *lk2, *subln_g,
        *w_attn_out, *w_out, *ffn_norm_g, *w_rg, *b_rg, *w_re, *b_re, *w_gate, *w_up, *w_down;
    float* out; unsigned char* ws;
};

__device__ __forceinline__ void p0_prologue(const Ptrs& P, LAS unsigned char* lds, int vcu, int G) {
    const int tid = tid_opaque(), lane = tid & 63, wave = __builtin_amdgcn_readfirstlane(tid >> 6);
    LAS float* scr = (LAS float*)(lds + wave * 16384);
    const int gw = vcu * NWAVES + wave, NGW = G * NWAVES;
    bf16* WIN = (bf16*)(P.ws + WS_WIN); bf16* WCA = (bf16*)(P.ws + WS_WCA); bf16* WOUT = (bf16*)(P.ws + WS_WOUT);
    constexpr int I_IN = (DMODEL / 64) * (IN_COLS / 32), I_C = (CONV_CH / 64) * (DMODEL / 32), I_O = (DMODEL / 64) * (DMODEL / 32);
    for (int it = gw; it < I_IN + 2 * I_C + I_O; it += NGW) {
        int r = it;
        if (r < I_IN) { const int kb = r / (IN_COLS / 32), nb = r % (IN_COLS / 32); transpose_item(P.w_in, IN_COLS, kb * 64, nb * 32, WIN, 1024, inproj_phys(nb * 32), 0, nullptr, scr, lane); continue; } r -= I_IN;
        if (r < I_C) { const int kb = r / 32, nb = r % 32; transpose_item(P.w_conv_out, DMODEL, kb * 64, nb * 32, WCA, 1024, nb * 32, 0, nullptr, scr, lane); continue; } r -= I_C;
        if (r < I_C) { const int kb = r / 32, nb = r % 32; transpose_item(P.w_attn_out, DMODEL, kb * 64, nb * 32, WCA, 1024, nb * 32, 512, nullptr, scr, lane); continue; } r -= I_C;
        { const int kb = r / 32, nb = r % 32; transpose_item(P.w_out, DMODEL, kb * 64, nb * 32, WOUT, 1024, nb * 32, 0, nullptr, scr, lane); }
    }
    bf16* WRhi = (bf16*)(P.ws + WS_WR); bf16* WRlo = WRhi + 64 * 1024;
    for (int idx = vcu * NTHREADS + tid; idx < 64 * 1024; idx += G * NTHREADS) {
        const int n = idx >> 10, k = idx & 1023; float v = 0.f;
        if (n < 4) v = P.w_rg[k * 4 + n]; else if (n < 36) v = P.w_re[k * 32 + (n - 4)];
        v *= P.ffn_norm_g[k];
        const unsigned hb = cvt_pk_bf16(v, 0.f) & 0xffffu; const float hf = __uint_as_float(hb << 16);
        WRhi[idx] = (bf16)hb; WRlo[idx] = (bf16)(cvt_pk_bf16(v - hf, 0.f) & 0xffffu);
    }
    bf16* HB = (bf16*)(P.ws + WS_A);
    f32x4 gq[4];
#pragma unroll
    for (int j = 0; j < 4; ++j) gq[j] = ((const f32x4*)P.attn_norm_g)[64 * j + lane];
    constexpr int RPT = 4;
    for (int m = gw; m < NTOK; m += RPT * NGW) {
        f32x4 v[RPT][4];
#pragma unroll
        for (int q = 0; q < RPT; ++q) { const int mq = m + q * NGW; const f32x4* xr = (const f32x4*)(P.x + (size_t)(mq < NTOK ? mq : m) * DMODEL) + lane;
#pragma unroll
            for (int j = 0; j < 4; ++j) v[q][j] = __builtin_nontemporal_load(xr + 64 * j); }
#pragma unroll
        for (int q = 0; q < RPT; ++q) { const int mq = m + q * NGW; float ss = 0.f;
#pragma unroll
            for (int j = 0; j < 4; ++j) ss += (v[q][j][0] * v[q][j][0] + v[q][j][1] * v[q][j][1]) + (v[q][j][2] * v[q][j][2] + v[q][j][3] * v[q][j][3]);
            const float r = 1.0f / sqrtf(wave_sum(ss) * (1.0f / DMODEL) + EPS);
            if (mq < NTOK) { v2u* o8 = (v2u*)(HB + (size_t)mq * DMODEL) + lane;
#pragma unroll
                for (int j = 0; j < 4; ++j) { const f32x4 y = v[q][j] * r * gq[j]; v2u w; w.x = cvt_pk_bf16(y[0], y[1]); w.y = cvt_pk_bf16(y[2], y[3]); o8[64 * j] = w; } } }
    }
}

__device__ __forceinline__ void conv_phase(const Ptrs& P, LAS unsigned char* lds, int first, int stride) {
    const int tid = tid_opaque(), lane = tid & 63, wave = __builtin_amdgcn_readfirstlane(tid >> 6);
    const bf16* YG = (const bf16*)(P.ws + WS_YG); bf16* CA = (bf16*)(P.ws + WS_CA);
    LAS bf16* yt = (LAS bf16*)lds; LAS float* co = (LAS float*)(lds + 62 * 1024);
    constexpr int NT = NTOK / 32;
    if (first >= NT) return;
    float w[CONV_W];
#pragma unroll
    for (int j = 0; j < CONV_W; ++j) w[j] = P.conv_dw_w[j * CONV_CH + tid];
    const float bias = P.conv_dw_b[tid];
    const f32x4 g0 = ((const f32x4*)P.conv_ln_g)[lane], g1 = ((const f32x4*)P.conv_ln_g)[64 + lane], b0 = ((const f32x4*)P.conv_ln_b)[lane], b1 = ((const f32x4*)P.conv_ln_b)[64 + lane];
    v4u pre[8];
#define CONV_FETCH(tile) do { const int b_ = (tile) / (SEQ / 32), t0_ = ((tile) % (SEQ / 32)) * 32; _Pragma("unroll") for (int p = 0; p < 8; ++p) { const int q = tid + NTHREADS * p; const int row = q >> 6, ch = q & 63, t = t0_ - 30 + row; \
        pre[p] = (v4u){0u, 0u, 0u, 0u}; if (q < 62 * 64 && t >= 0) pre[p] = *(const v4u*)(YG + ((size_t)(b_ * SEQ + t)) * 512 + ch * 8); } } while (0)
    CONV_FETCH(first);
    for (int tile = first; tile < NT; tile += stride) {
        const int b = tile / (SEQ / 32), t0 = (tile % (SEQ / 32)) * 32;
#pragma unroll
        for (int p = 0; p < 8; ++p) { const int q = tid + NTHREADS * p; if (q < 62 * 64) *(LAS v4u*)(yt + (q >> 6) * 512 + (q & 63) * 8) = pre[p]; }
        __syncthreads();
        if (tile + stride < NT) CONV_FETCH(tile + stride);
        float yv[62];
#pragma unroll
        for (int i = 0; i < 62; ++i) yv[i] = __uint_as_float((unsigned)yt[i * 512 + tid] << 16);
#pragma unroll
        for (int t = 0; t < 32; ++t) { float a = bias;
#pragma unroll
            for (int j = 0; j < CONV_W; ++j) a += w[j] * yv[t + j];
            co[t * 512 + tid] = a; }
        __syncthreads();
#pragma unroll
        for (int rr = 0; rr < 4; ++rr) { const int row = wave * 4 + rr;
            const f32x4 v0 = *(const LAS f32x4*)(co + row * 512 + lane * 4), v1 = *(const LAS f32x4*)(co + row * 512 + 256 + lane * 4);
            const float mean = wave_sum((v0[0] + v0[1]) + (v0[2] + v0[3]) + (v1[0] + v1[1]) + (v1[2] + v1[3])) * (1.0f / CONV_CH);
            const f32x4 d0 = v0 - mean, d1 = v1 - mean;
            const float var = wave_sum((d0[0] * d0[0] + d0[1] * d0[1]) + (d0[2] * d0[2] + d0[3] * d0[3]) + (d1[0] * d1[0] + d1[1] * d1[1]) + (d1[2] * d1[2] + d1[3] * d1[3])) * (1.0f / CONV_CH);
            const float rstd = 1.0f / sqrtf(var + EPS);
            f32x4 y0 = d0 * rstd * g0 + b0, y1 = d1 * rstd * g1 + b1;
#pragma unroll
            for (int j = 0; j < 4; ++j) { y0[j] = y0[j] * sigmoidf_fast(y0[j]); y1[j] = y1[j] * sigmoidf_fast(y1[j]); }
            bf16* orow = CA + ((size_t)(b * SEQ + t0 + row)) * 1024;
            v2u o0, o1; o0.x = cvt_pk_bf16(y0[0], y0[1]); o0.y = cvt_pk_bf16(y0[2], y0[3]); o1.x = cvt_pk_bf16(y1[0], y1[1]); o1.y = cvt_pk_bf16(y1[2], y1[3]);
            *(v2u*)(orow + lane * 4) = o0; *(v2u*)(orow + 256 + lane * 4) = o1; }
        __syncthreads();
    }
#undef CONV_FETCH
}

__device__ __forceinline__ void attn_pair(const Ptrs& P, LAS unsigned char* lds, char* lds_generic, int p) {
    const int tid = tid_opaque(), lane = tid & 63, wave = __builtin_amdgcn_readfirstlane(tid >> 6);
    const int bh = p >> 3, s = p & 7, b = bh >> 2, h = bh & 3;
    const __hip_bfloat16* QB = (const __hip_bfloat16*)(P.ws + WS_QB); const __hip_bfloat16* KB = (const __hip_bfloat16*)(P.ws + WS_KB); const __hip_bfloat16* VB = (const __hip_bfloat16*)(P.ws + WS_VB);
    __hip_bfloat16* OT = (__hip_bfloat16*)(P.ws + WS_A); bf16* CA = (bf16*)(P.ws + WS_CA);
    float mstat;
    { int l0 = lane; asm volatile("" : "+v"(l0));
      const float a = wave_max(fabsf(P.q_norm_g[l0])), b = wave_max(fabsf(P.k_norm_g[l0]));
      mstat = __int_as_float(__builtin_amdgcn_readfirstlane(__float_as_int(0.125f * 1.4426950408889634f * 64.0f * 1.02f * a * b))); }
    float lam;
    { int l1 = lane; asm volatile("" : "+v"(l1));
      lam = __int_as_float(__builtin_amdgcn_readfirstlane(__float_as_int(__expf(wave_sum(P.lq1[l1] * P.lk1[l1])) - __expf(wave_sum(P.lq2[l1] * P.lk2[l1])) + 0.2f))); }
    int s0 = 0; bool pre = false;
#pragma unroll 1
    for (int u4 = 0; u4 < 4; ++u4) { const int i = u4 >> 1, c = u4 & 1;
        const int qb = (i == 0) ? s : 15 - s;
        const __hip_bfloat16* q_ = QB + (size_t)b * SEQ * 512 + (h * 2 + c) * 64; const __hip_bfloat16* k_ = KB + (size_t)b * SEQ * 512 + (h * 2 + c) * 64; const __hip_bfloat16* v_ = VB + (size_t)b * SEQ * 512 + h * 128;
        const __hip_bfloat16* kn_ = (u4 < 3) ? KB + (size_t)b * SEQ * 512 + (h * 2 + (c ^ 1)) * 64 : nullptr;
        __hip_bfloat16* o_ = OT + (size_t)b * SEQ * 1024 + (h * 2) * 128;
        const __hip_bfloat16* o1_ = c ? o_ : nullptr; unsigned short* ca_ = CA + (size_t)b * SEQ * 1024 + 512 + h * 128;
        int sn;
        if (mstat <= 40.0f) sn = attn_body::attn_unit<8, true>(mstat, qb * 256, q_, k_, v_, o_, lds_generic, o1_, lam, P.subln_g, ca_, kn_, v_, s0, pre);
        else sn = attn_body::attn_unit<8, false>(0.f, qb * 256, q_, k_, v_, o_, lds_generic, o1_, lam, P.subln_g, ca_, kn_, v_, s0, pre);
        s0 = sn; pre = (kn_ != nullptr); }
}

__device__ __forceinline__ void router_tile(const Ptrs& P, LAS unsigned char* lds, int tile) {
    const int tid = tid_opaque(), lane = tid & 63, wave = __builtin_amdgcn_readfirstlane(tid >> 6), r32 = lane & 31, hi = lane >> 5;
    const bf16* WRhi = (const bf16*)(P.ws + WS_WR); const bf16* WRlo = WRhi + 64 * 1024;
    int* LIST = (int*)(P.ws + WS_LIST); int* CTOK = (int*)(P.ws + WS_CTOK); unsigned* cnt = (unsigned*)(P.ws + WS_CTL); unsigned* ccnt = cnt + 64;
    LAS float* lg = (LAS float*)(lds + wave * 8448);
    LAS int* hist = (LAS int*)(lds + HIST_OFF); LAS int* hbase = hist + 32; LAS int* hist2 = hist + 64; LAS int* hbase2 = hist2 + NCLS;
    if (tid < 32) hist[tid] = 0;
    if (tid >= 64 && tid < 64 + NCLS) hist2[tid - 64] = 0;
    __syncthreads();
    const int tbase = tile * 256 + wave * 32;
    const bf16* xr = (const bf16*)(P.ws + WS_CA) + (size_t)(tbase + r32) * DMODEL + 8 * hi;
    const bf16* bh0 = WRhi + (size_t)r32 * 1024 + 8 * hi; const bf16* bl0 = WRlo + (size_t)r32 * 1024 + 8 * hi;
    f32x16 acc0 = {}, acc1 = {}; float ssq = 0.f;
#pragma unroll 4
    for (int ks = 0; ks < 64; ++ks) {
        const v4u xa = *(const v4u*)(xr + ks * 16);
        f32x4 x0, x1; unpack8(xa, x0, x1);
        ssq += (x0[0] * x0[0] + x0[1] * x0[1]) + (x0[2] * x0[2] + x0[3] * x0[3]) + (x1[0] * x1[0] + x1[1] * x1[1]) + (x1[2] * x1[2] + x1[3] * x1[3]);
        const bf16x8 a_hi = __builtin_bit_cast(bf16x8, xa);
        const bf16x8 bh_0 = *(const bf16x8*)(bh0 + ks * 16), bh_1 = *(const bf16x8*)(bh0 + 32 * 1024 + ks * 16), bl_0 = *(const bf16x8*)(bl0 + ks * 16), bl_1 = *(const bf16x8*)(bl0 + 32 * 1024 + ks * 16);
        acc0 = __builtin_amdgcn_mfma_f32_32x32x16_bf16(a_hi, bh_0, acc0, 0, 0, 0); acc1 = __builtin_amdgcn_mfma_f32_32x32x16_bf16(a_hi, bh_1, acc1, 0, 0, 0);
        acc0 = __builtin_amdgcn_mfma_f32_32x32x16_bf16(a_hi, bl_0, acc0, 0, 0, 0); acc1 = __builtin_amdgcn_mfma_f32_32x32x16_bf16(a_hi, bl_1, acc1, 0, 0, 0);
    }
    ssq += __shfl_xor(ssq, 32);
    const float rs = 1.0f / sqrtf(ssq * (1.0f / DMODEL) + EPS);
#pragma unroll
    for (int r = 0; r < 16; ++r) { const int m = (r & 3) + 8 * (r >> 2) + 4 * hi; lg[m * 66 + r32] = acc0[r]; lg[m * 66 + 32 + r32] = acc1[r]; }
    asm volatile("s_waitcnt lgkmcnt(0)" ::: "memory");
    int ea = 0, eb = 0, cls = 0, lpa = 0, lpb = 0, lpc = 0; float wa = 0.f, wb = 0.f;
    if (lane < 32) {
        const LAS float* L = lg + lane * 66;
        float gl[4];
#pragma unroll
        for (int j = 0; j < 4; ++j) gl[j] = L[j] * rs + P.b_rg[j];
        int gs = 0; float gm = gl[0];
#pragma unroll
        for (int j = 1; j < 4; ++j) if (gl[j] > gm) { gm = gl[j]; gs = j; }
        float gsum = 0.f;
#pragma unroll
        for (int j = 0; j < 4; ++j) gsum += __expf(gl[j] - gm);
        const float gw = 1.0f / gsum;
        float l0 = -INFINITY, l1 = -INFINITY; int i0 = 0, i1 = 0;
#pragma unroll
        for (int j = 0; j < 8; ++j) { const float v = L[4 + gs * 8 + j] * rs + P.b_re[gs * 8 + j];
            if (v > l0) { l1 = l0; i1 = i0; l0 = v; i0 = j; } else if (v > l1) { l1 = v; i1 = j; } }
        const float q = __expf(l1 - l0), inv = 1.0f / (1.0f + q);
        const float w0 = inv * gw, w1 = q * inv * gw;
        const int a = min(i0, i1), b = max(i0, i1);
        wa = (i0 < i1) ? w0 : w1; wb = (i0 < i1) ? w1 : w0;
        ea = gs * 8 + a; eb = gs * 8 + b; cls = gs * 28 + (a * (15 - a)) / 2 + (b - a - 1);
        lpa = __hip_atomic_fetch_add(&hist[ea], 1, __ATOMIC_RELAXED, __HIP_MEMORY_SCOPE_WORKGROUP); lpb = __hip_atomic_fetch_add(&hist[eb], 1, __ATOMIC_RELAXED, __HIP_MEMORY_SCOPE_WORKGROUP);
        lpc = __hip_atomic_fetch_add(&hist2[cls], 1, __ATOMIC_RELAXED, __HIP_MEMORY_SCOPE_WORKGROUP);
    }
    __syncthreads();
    if (tid < 32) hbase[tid] = (int)atomicAdd(cnt + tid, (unsigned)hist[tid]);
    if (tid >= 64 && tid < 64 + NCLS) { const int c = tid - 64; const int n = hist2[c]; hbase2[c] = n ? (int)atomicAdd(ccnt + c, (unsigned)n) : 0; }
    __syncthreads();
    if (lane < 32) { const int t = tbase + lane; const int pa = hbase[ea] + lpa, pb = hbase[eb] + lpb, pc = hbase2[cls] + lpc;
        typedef int i32x4 __attribute__((ext_vector_type(4)));
        const int dst = (cls << 17) | (pc << 1);
        *(i32x4*)(LIST + (size_t)(ea * LCAP + pa) * 4) = (i32x4){t, dst, __float_as_int(wa), __float_as_int(rs)};
        *(i32x4*)(LIST + (size_t)(eb * LCAP + pb) * 4) = (i32x4){t, dst | 1, __float_as_int(wb), __float_as_int(rs)};
        CTOK[(size_t)cls * NTOK + pc] = t; }
    __syncthreads();
}

__device__ __forceinline__ void p5_convert(const Ptrs& P, LAS unsigned char* lds, int vcu, int G) {
    const int tid = tid_opaque(), lane = tid & 63, wave = __builtin_amdgcn_readfirstlane(tid >> 6);
    LAS float* scr = (LAS float*)(lds + wave * 16384);
    const int gw = vcu * NWAVES + wave, NGW = G * NWAVES;
    unsigned char* WGU = P.ws + WS_WGU; unsigned char* WD = P.ws + WS_WD;
    constexpr int I_G = (DMODEL / 64) * (DEXP / 32);
    constexpr int I_D = (DEXP / 64) * (DMODEL / 32);
    constexpr int PER_E = 2 * I_G + I_D;
    constexpr int NITEMS = NEXP * PER_E, NRW = (NTOK / 256) * NWAVES;
    const bool split = (G == 256) && (NITEMS == NRW * 8 + (256 * NWAVES - NRW) * 16);
    const bool rwg = (int)blockIdx.x < NTOK / 256; const int wv = ((int)blockIdx.x - (rwg ? 0 : NTOK / 256)) * NWAVES + wave;
    const int it0 = split ? (rwg ? wv : NRW * 8 + wv) : gw, itn = split ? (rwg ? NRW * 8 : NITEMS) : NITEMS, its = split ? NRW : NGW;
    struct Item { const float* W; int N, k0, n0; unsigned char* WT; int dpitch, drow0; const float* ks; float mul; };
    auto decode = [&](int it) { Item q; const int e = it / PER_E; int r = it % PER_E;
        if (r < 2 * I_G) { const int up = r / I_G; r %= I_G; const int kb = r / (DEXP / 32), nb = r % (DEXP / 32), n0 = nb * 32;
            q.W = (up ? P.w_up : P.w_gate) + (size_t)e * DMODEL * DEXP; q.N = DEXP; q.k0 = kb * 64; q.n0 = n0; q.WT = WGU + (size_t)e * 1024 * 1024; q.dpitch = 1024; q.drow0 = (n0 >> 7) * 256 + up * 128 + (n0 & 127); q.ks = P.ffn_norm_g; q.mul = 64.f;
        } else { r -= 2 * I_G; const int kb = r / (DMODEL / 32), nb = r % (DMODEL / 32);
            q.W = P.w_down + (size_t)e * DEXP * DMODEL; q.N = DMODEL; q.k0 = kb * 64; q.n0 = nb * 32; q.WT = WD + (size_t)e * 1024 * 512; q.dpitch = 512; q.drow0 = nb * 32; q.ks = nullptr; q.mul = 32.f; }
        return q; };
    for (int it = it0; it < itn; it += 4 * its) {
        const bool h1 = it + its < itn, h2 = it + 2 * its < itn, h3 = it + 3 * its < itn;
        const Item a = decode(it), b = decode(h1 ? it + its : it), c = decode(h2 ? it + 2 * its : it), d = decode(h3 ? it + 3 * its : it);
        f32x4 va[8], vb[8], vc[8], vd[8];
        t8_load(va, a.W, a.N, a.k0, a.n0, lane); t8_load(vb, b.W, b.N, b.k0, b.n0, lane); t8_load(vc, c.W, c.N, c.k0, c.n0, lane); t8_load(vd, d.W, d.N, d.k0, d.n0, lane);
        t8_finish(va, a.k0, a.WT, a.dpitch, a.drow0, a.ks, a.mul, scr, lane);
        if (h1) t8_finish(vb, b.k0, b.WT, b.dpitch, b.drow0, b.ks, b.mul, scr, lane);
        if (h2) t8_finish(vc, c.k0, c.WT, c.dpitch, c.drow0, c.ks, c.mul, scr, lane);
        if (h3) t8_finish(vd, d.k0, d.WT, d.dpitch, d.drow0, d.ks, d.mul, scr, lane);
    }
}

struct Args { Ptrs p; int ph_lo, ph_hi, use_cg, pad; };
__global__ void __launch_bounds__(NTHREADS, 2) mega_fwd(Args args) {
    extern __shared__ __attribute__((aligned(16))) unsigned char lds_raw[];
    LAS unsigned char* lds = (LAS unsigned char*)lds_raw;
    const Ptrs& P = args.p;
    const int tid = tid_opaque();
    const int G = gridDim.x, bx = blockIdx.x; const int vcu = (G % 8 == 0) ? (bx % 8) * (G / 8) + bx / 8 : bx;
    const int lo = args.ph_lo, hi = args.ph_hi;
    LAS int* meta = (LAS int*)(lds + META_OFF);
    if (tid < 2) ((volatile LAS unsigned*)(lds + BARST_OFF))[tid] = 0u;
    __syncthreads();
    XcdBarrier bar = xcd_barrier_post((unsigned*)(P.ws + WS_CTL) + 1024, (volatile LAS unsigned*)(lds + BARST_OFF));
#ifndef PHASE_MASK
#define PHASE_MASK 0xff
#endif
#ifndef DUP_PHASE
#define DUP_PHASE -1
#endif
#define REPS(k) for (int rep_ = 0; rep_ < ((DUP_PHASE == (k)) ? 2 : 1); ++rep_)
#define REPBAR() do { if (rep_) xcd_barrier(bar); } while (0)
#define IN(k) (((PHASE_MASK >> (k)) & 1) && lo <= (k) && (k) < hi)
#define SEAM(k) do { if (IN(k) && IN((k) + 1)) xcd_barrier(bar); } while (0)
    bf16* WS16 = (bf16*)P.ws;
    if (IN(0)) REPS(0) { REPBAR(); p0_prologue(P, lds, vcu, G); }
    SEAM(0);
    if (IN(1)) REPS(1) { REPBAR();
        pg8::Gemm g{(const bf16*)(P.ws + WS_A), (const bf16*)(P.ws + WS_WIN), DMODEL, 0, nullptr};
        pg8::StaticOrder S; S.init(NTOK, IN_COLS, G, bx);
        LAS float* gl = (LAS float*)(lds + RING_BYTES + 8192);
        if (tid < 128) gl[tid] = (tid < 64) ? P.q_norm_g[tid] : P.k_norm_g[tid - 64];
        __syncthreads();
        EpiInProj E{(bf16*)(P.ws + WS_YG), (bf16*)(P.ws + WS_QB), (bf16*)(P.ws + WS_KB), (bf16*)(P.ws + WS_VB), (bf16*)(P.ws + WS_GT), gl};
#if defined(DUMP_SEL) && DUMP_SEL == 5
        EpiRaw ER{(bf16*)(P.ws + WS_QB)};
        pg8::gemm_phase<EpiRaw, pg8::StaticOrder, false, true>(lds, g, S, ER);
#else
        pg8::gemm_phase<EpiInProj, pg8::StaticOrder, false, true>(lds, g, S, E);
#endif
    }
    SEAM(1);
    if (IN(2)) {
        REPS(2) { REPBAR();
        for (int p = vcu; p < 256; p += G) attn_pair(P, lds, (char*)lds_raw, p);
        __syncthreads(); }
        REPS(20) { REPBAR();
        conv_phase(P, lds, bx, G); }
    }
    SEAM(2);
    if (IN(3)) REPS(3) { REPBAR();
        pg8::Gemm g{(const bf16*)(P.ws + WS_CA), (const bf16*)(P.ws + WS_WCA), DMODEL, 0, nullptr};
        pg8::StaticOrder S; S.init(NTOK, DMODEL, G, bx);
        EpiMerged E{(const bf16*)(P.ws + WS_GT), (const bf16*)(P.ws + WS_GT) + (size_t)NTOK * 1024, (bf16*)(P.ws + WS_MG)};
        pg8::gemm_phase<EpiMerged, pg8::StaticOrder, false, true>(lds, g, S, E);
    }
    SEAM(3);
    if (IN(4)) REPS(4) { REPBAR();
        pg8::Gemm g{(const bf16*)(P.ws + WS_MG), (const bf16*)(P.ws + WS_WOUT), DMODEL, 0, nullptr};
        pg8::StaticOrder S; S.init(NTOK, DMODEL, G, bx);
        EpiOut E{P.x, (bf16*)(P.ws + WS_CA), P.ws + WS_XM};
        pg8::gemm_phase<EpiOut, pg8::StaticOrder, false, true>(lds, g, S, E);
    }
    SEAM(4);
    if (IN(5)) {
        for (int t = bx; t < NTOK / 256; t += G) router_tile(P, lds, t);
        REPS(5) { REPBAR(); p5_convert(P, lds, vcu, G); }
    }
    SEAM(5);
    LAS int* meta2 = (LAS int*)(lds + META2_OFF);
    if (IN(6)) REPS(6) { REPBAR();
        moe_meta(meta, meta2, (const unsigned*)(P.ws + WS_CTL));
        pg8::Gemm g{(const bf16*)(P.ws + WS_XM), (const bf16*)(P.ws + WS_WGU), DMODEL / 2, (size_t)1024 * 1024, (const int*)(P.ws + WS_LIST), 4};
        MoeOrder S{G, bx, __builtin_amdgcn_readfirstlane(meta[NEXP]), meta};
        EpiGateUp E{(const int*)(P.ws + WS_LIST), P.ws + WS_A, meta2};
        pg8::gemm_phase<EpiGateUp, MoeOrder, true, true, true>(lds, g, S, E);
    }
    SEAM(6);
    if (IN(7)) REPS(7) { REPBAR();
        moe_meta(meta, meta2, (const unsigned*)(P.ws + WS_CTL));
        pg8::Gemm g{(const bf16*)(P.ws + WS_A), (const bf16*)(P.ws + WS_WD), DMODEL / 2, (size_t)1024 * 512, nullptr, 0, DEXP / 2};
        ClassOrder S{G, bx, __builtin_amdgcn_readfirstlane(meta2[NCLS]), meta2};
        EpiDownAdd E{(const int*)(P.ws + WS_CTOK), (const bf16*)(P.ws + WS_CA), P.out};
        pg8::gemm_phase<EpiDownAdd, ClassOrder, false, true, true, true>(lds, g, S, E);
    }
#if defined(DUMP_SEL)
    xcd_barrier(bar);
    { const bf16* YG = (const bf16*)(P.ws + WS_YG); const bf16* QB = (const bf16*)(P.ws + WS_QB); const bf16* KB = (const bf16*)(P.ws + WS_KB); const bf16* VB = (const bf16*)(P.ws + WS_VB);
      const bf16* GT = (const bf16*)(P.ws + WS_GT); const bf16* CA = (const bf16*)(P.ws + WS_CA); const bf16* MG = (const bf16*)(P.ws + WS_MG);
      for (size_t i = (size_t)bx * NTHREADS + tid; i < (size_t)NTOK * 1024; i += (size_t)G * NTHREADS) { const size_t t = i >> 10; const int c = (int)(i & 1023); float v = 0.f;
#if DUMP_SEL == 1
          v = bf_lo(YG[t * 512 + (c & 511)]) + bf_lo(QB[t * 512 + (c & 511)]) + 2.f * bf_lo(KB[t * 512 + (c & 511)]) + 3.f * bf_lo(VB[t * 512 + (c & 511)]) + bf_lo(GT[t * 2048 + c]) + bf_lo(GT[t * 2048 + 1024 + c]);
#elif DUMP_SEL == 2
          v = bf_lo(CA[t * 1024 + c]);
#elif DUMP_SEL == 4
          { const bf16* HB = (const bf16*)(P.ws + WS_A); const bf16* WIN = (const bf16*)(P.ws + WS_WIN); v = bf_lo(HB[i]) + 30.f * bf_lo(WIN[i % ((size_t)IN_COLS * 1024)]); }
#elif DUMP_SEL == 5
          { const bf16* R = (const bf16*)(P.ws + WS_QB); v = bf_lo(R[t * 4608 + c]) + bf_lo(R[t * 4608 + 1024 + c]) + bf_lo(R[t * 4608 + 2048 + c]) + bf_lo(R[t * 4608 + 3072 + c]) + bf_lo(R[t * 4608 + 4096 + (c & 511)]); }
#elif DUMP_SEL == 3
          v = bf_lo(MG[t * 1024 + c]);
#endif
          P.out[i] = v; } }
#endif
    (void)WS16;
#undef IN
#undef SEAM
}

extern "C" void kernel_launch(void* const* d_in, const int* in_sizes, int n_in, void* d_out, int out_size, void* d_ws, size_t ws_size, hipStream_t stream) {
    static int grid = 0;
    if (grid == 0) {
        if (n_in != 25 || in_sizes[0] != NTOK * DMODEL || out_size != NTOK * DMODEL || ws_size < WS_END) {
            fprintf(stderr, "kernel_launch: unexpected shapes (n_in %d, in0 %d, out %d, ws %zu); nothing launched\n", n_in, n_in > 0 ? in_sizes[0] : -1, out_size, ws_size); grid = -1; return; }
        int dev = 0, cus = 0, per_cu = 0;
        if (hipGetDevice(&dev) != hipSuccess || hipDeviceGetAttribute(&cus, hipDeviceAttributeMultiprocessorCount, dev) != hipSuccess) { grid = -1; return; }
        if (hipFuncSetAttribute((const void*)mega_fwd, hipFuncAttributeMaxDynamicSharedMemorySize, LDS_BYTES) != hipSuccess) { fprintf(stderr, "kernel_launch: hipFuncSetAttribute failed\n"); grid = -1; return; }
        if (hipOccupancyMaxActiveBlocksPerMultiprocessor(&per_cu, (const void*)mega_fwd, NTHREADS, LDS_BYTES) != hipSuccess || per_cu < 1) { fprintf(stderr, "kernel_launch: the occupancy query reports %d workgroups per CU for this kernel and LDS size; nothing launched\n", per_cu); grid = -1; return; }
        (void)hipGetLastError();
        grid = cus;
    }
    if (grid < 0) return;
    (void)hipMemsetAsync((char*)d_ws + WS_CTL, 0, CTL_ZERO_BYTES, stream);
    Args a{};
    const float** pp = (const float**)&a.p;
    for (int i = 0; i < 25; ++i) pp[i] = (const float*)d_in[i];
    a.p.out = (float*)d_out; a.p.ws = (unsigned char*)d_ws;
#if MK_PER_PHASE
    for (int ph = 0; ph < N_PHASES; ++ph) { a.ph_lo = ph; a.ph_hi = ph + 1; void* params[] = {&a};
        hipError_t e = hipLaunchCooperativeKernel((const void*)mega_fwd, dim3(grid), dim3(NTHREADS), params, LDS_BYTES, stream);
        if (e != hipSuccess) { fprintf(stderr, "launch %d failed: %s\n", ph, hipGetErrorString(e)); break; } }
#else
    a.ph_lo = 0; a.ph_hi = N_PHASES; void* params[] = {&a};
    hipError_t e = hipLaunchCooperativeKernel((const void*)mega_fwd, dim3(grid), dim3(NTHREADS), params, LDS_BYTES, stream);
    if (e != hipSuccess) fprintf(stderr, "cooperative launch failed: %s (grid %d)\n", hipGetErrorString(e), grid);
#endif
}
```

```cpp
#include <hip/hip_runtime.h>
#include <hip/hip_bf16.h>
#include <hip/hip_cooperative_groups.h>
#include <cstdio>
#include <cstdint>
#include <cmath>
namespace cg = cooperative_groups;
__device__ __forceinline__ int tid_opaque() { int t = threadIdx.x; asm volatile("" : "+v"(t)); return t; }

constexpr int BATCH = 8, SEQ = 4096, DMODEL = 1024, NTOK = BATCH * SEQ;
constexpr int CONV_CH = 512, CONV_W = 31, NHEADS = 4, IN_COLS = 4608;
constexpr int NEXP = 32, DEXP = 512, LCAP = NTOK;
constexpr int NCLS = 4 * 28;
constexpr int CROWS = NTOK + NCLS * 256;
constexpr int MOE_ROWS = 2 * NTOK + NEXP * 256;
constexpr float EPS = 1e-6f;

namespace pg8 {
#define PG8_LAS __attribute__((address_space(3)))
typedef unsigned short bf16_t;
typedef short bf16x8 __attribute__((ext_vector_type(8)));
typedef float f32x4 __attribute__((ext_vector_type(4)));
typedef unsigned u32x4 __attribute__((ext_vector_type(4)));
constexpr int BM = 256, BK = 64, HALF = 128, HTB = HALF * BK * 2  , STAGE_BYTES = 8 * HTB, NXCD = 8, WGM = 8;

__host__ __device__ __forceinline__ int lds_byte(int r, int c) { const int st = (r >> 4) * 2 + (c >> 5), rr = r & 15, cc = c & 31, ob = rr * 64 + cc * 2; return st * 1024 + (ob ^ (((ob >> 9) & 1) << 5)); }
__host__ __device__ __forceinline__ void stage_rc(int b, int& R, int& C) { const int st = b / 1024, sb = b % 1024, swz = sb ^ (((sb >> 9) & 1) << 5); R = (st >> 1) * 16 + swz / 64; C = (st & 1) * 32 + (swz % 64) / 2; }
__host__ __device__ __forceinline__ int perm32(int rho) { const int n = rho >> 4, i = rho & 15; return 8 * (i >> 2) + 4 * n + (i & 3); }

struct Unit { int pm, pn, arow, e, e2, lrow, nvalid, orow; };
struct Gemm { const bf16_t* A; const bf16_t* Bt; int K; size_t bstride; const int* list; int lstride; int KBrow; };

struct StaticOrder {
    int nM, nN, nwg, G, c;
    __device__ void init(int M, int N, int G_, int c_) { nM = M / BM; nN = N / BM; nwg = nM * nN; G = G_; c = c_; }
    __device__ bool next(int i, Unit& u) const {
        const long L = (long)i * G + c; if (L >= nwg) return false;
        int wgid = (int)L; { const int q = nwg / NXCD, r = nwg % NXCD, xcd = wgid % NXCD, off = wgid / NXCD; wgid = (xcd < r ? xcd * (q + 1) : r * (q + 1) + (xcd - r) * q) + off; }
        const int nig = WGM * nN, gid = wgid / nig, fm = gid * WGM, gsz = (nM - fm) < WGM ? (nM - fm) : WGM;
        u.pm = fm + ((wgid % nig) % gsz); u.pn = (wgid % nig) / gsz; u.arow = u.pm * BM; u.orow = u.arow; u.e = 0; u.e2 = 0; u.lrow = 0; u.nvalid = BM; return true;
    }
};

typedef float f32x2_t __attribute__((ext_vector_type(2))); typedef __bf16 bf16x2_t __attribute__((ext_vector_type(2)));
__device__ __forceinline__ unsigned cvt_pk_bf16(float lo, float hi) { const f32x2_t v = {lo, hi}; const bf16x2_t b = __builtin_convertvector(v, bf16x2_t); return __builtin_bit_cast(unsigned, b); }
typedef int v8i_t __attribute__((ext_vector_type(8))); typedef int v4i_t __attribute__((ext_vector_type(4)));
__device__ __forceinline__ v8i_t cat8(const bf16x8 a, const bf16x8 b) { const v4i_t x = __builtin_bit_cast(v4i_t, a), y = __builtin_bit_cast(v4i_t, b); return (v8i_t){x[0], x[1], x[2], x[3], y[0], y[1], y[2], y[3]}; }
__device__ __forceinline__ unsigned pack4_fp8(float a, float b, float c, float d) { int w = 0; w = __builtin_amdgcn_cvt_pk_fp8_f32(a, b, w, false); w = __builtin_amdgcn_cvt_pk_fp8_f32(c, d, w, true); return (unsigned)w; }
__device__ __forceinline__ float bf_lo(unsigned w) { return __uint_as_float(w << 16); }
__device__ __forceinline__ float bf_hi(unsigned w) { return __uint_as_float(w & 0xffff0000u); }
__device__ __forceinline__ float sigmoidf_fast(float x) { return __builtin_amdgcn_rcpf(1.0f + __builtin_amdgcn_exp2f(-1.4426950408889634f * x)); }
__device__ __forceinline__ u32x4 pack8(const f32x4 a, const f32x4 b) { u32x4 w; w.x = cvt_pk_bf16(a[0], a[1]); w.y = cvt_pk_bf16(a[2], a[3]); w.z = cvt_pk_bf16(b[0], b[1]); w.w = cvt_pk_bf16(b[2], b[3]); return w; }
__device__ __forceinline__ void unpack8(const u32x4 w, f32x4& a, f32x4& b) { a = (f32x4){bf_lo(w.x), bf_hi(w.x), bf_lo(w.y), bf_hi(w.y)}; b = (f32x4){bf_lo(w.z), bf_hi(w.z), bf_lo(w.w), bf_hi(w.w)}; }

template <class Epi, class Sched, bool GATHER, bool ALIGN_EPI, bool FP8 = false, bool BSPLIT = false>
__device__ __forceinline__ void gemm_phase(PG8_LAS unsigned char* lds, const Gemm g, const Sched& S, const Epi& E) {
    const int tid = tid_opaque(), wid = __builtin_amdgcn_readfirstlane(tid >> 6), lane = tid & 63, wr = wid >> 2, wc = wid & 3, fr = lane & 15, fq = lane >> 4;
    const int K = g.K, nt = K / BK, KBp = g.KBrow ? g.KBrow : K;
    unsigned voffB[2]; int Ra[2], Ca[2];
#pragma unroll
    for (int i = 0; i < 2; ++i) { int R, C; stage_rc(tid * 16 + i * 8192, R, C); const int Rb = (R & ~31) + perm32(R & 31); Ra[i] = R; Ca[i] = C; voffB[i] = (unsigned)(Rb * KBp + C) * 2u; }
    const unsigned kstep = (unsigned)(BK * 2);
    const unsigned hstep = (unsigned)HALF * KBp * 2;
    const unsigned tstep = 2 * hstep;
    const char* const gA = (const char*)g.A; const char* const gB = (const char*)g.Bt;
    const unsigned ldsw = (unsigned)wid * 1024u;
    const int aoff = lds_byte(wr * 64 + fr, fq * 8), boff = lds_byte(wc * 32 + fr, fq * 8);
#define PG8_SA(b, h) (((b) * 2 + (h)) * HTB)
#define PG8_SB(b, h) ((4 + (b) * 2 + (h)) * HTB)
#define PG8_STAGE(bufoff, gbase, uoff, voff) do { _Pragma("unroll") for (int _i = 0; _i < 2; ++_i) \
        __builtin_amdgcn_global_load_lds((const unsigned*)((const char*)(gbase) + (unsigned)((uoff) + (voff)[_i])), (PG8_LAS unsigned*)(lds + (bufoff) + ldsw + _i * 8192), 16, 0, 0); } while (0)
#define PG8_LDA(dst, b, h) do { _Pragma("unroll") for (int m = 0; m < 4; ++m) _Pragma("unroll") for (int k = 0; k < 2; ++k) dst[m][k] = *(const PG8_LAS bf16x8*)(lds + PG8_SA(b, h) + aoff + m * 2048 + k * 1024); } while (0)
#define PG8_LDB(dst, b, h) do { _Pragma("unroll") for (int n = 0; n < 2; ++n) _Pragma("unroll") for (int k = 0; k < 2; ++k) dst[n][k] = *(const PG8_LAS bf16x8*)(lds + PG8_SB(b, h) + boff + n * 2048 + k * 1024); } while (0)
#define PG8_MMA(ai, bj, At, Bt) do { __builtin_amdgcn_s_setprio(1); \
        if constexpr (FP8) { _Pragma("unroll") for (int m = 0; m < 4; ++m) _Pragma("unroll") for (int n = 0; n < 2; ++n) \
            asm volatile("v_mfma_scale_f32_16x16x128_f8f6f4 %0, %1, %2, %0, %3, %3 op_sel_hi:[0,0,0]" : "+v"(acc[ai][bj][m][n]) : "v"(cat8(Bt[n][0], Bt[n][1])), "v"(cat8(At[m][0], At[m][1])), "v"(one_e8m0)); } \
        else { _Pragma("unroll") for (int m = 0; m < 4; ++m) _Pragma("unroll") for (int n = 0; n < 2; ++n) _Pragma("unroll") for (int k = 0; k < 2; ++k) \
            acc[ai][bj][m][n] = __builtin_amdgcn_mfma_f32_16x16x32_bf16(Bt[n][k], At[m][k], acc[ai][bj][m][n], 0, 0, 0); } \
        __builtin_amdgcn_s_setprio(0); } while (0)
#define PG8_WAIT_V(n) asm volatile("s_waitcnt vmcnt(" #n ")" ::: "memory")
#define PG8_WAIT_L(n) asm volatile("s_waitcnt lgkmcnt(" #n ")" ::: "memory")
#define PG8_BAR __builtin_amdgcn_s_barrier()
#define PG8_SCHED __builtin_amdgcn_sched_barrier(0)
#define PG8_LOAD_VA(dst, u) do { _Pragma("unroll") for (int _h = 0; _h < 2; ++_h) _Pragma("unroll") for (int _i = 0; _i < 2; ++_i) { const int _row = _h * HALF + Ra[_i]; \
        if constexpr (GATHER) { const int _tok = (_row < (u).nvalid) ? g.list[((u).lrow + _row) * g.lstride] : 0; dst[_h][_i] = (unsigned)(_tok * K + Ca[_i]) * 2u; } \
        else dst[_h][_i] = (unsigned)(_row * K + Ca[_i]) * 2u; } } while (0)
    Unit cur, nxt; int ui = 0;
    if (!S.next(0, cur)) return;
    typename Epi::Pre pre{};
    unsigned vAc[2][2], vAn[2][2];
    PG8_LOAD_VA(vAc, cur);
    f32x4 acc[2][2][4][2];
#pragma unroll
    for (int a = 0; a < 2; ++a)
#pragma unroll
        for (int b = 0; b < 2; ++b)
#pragma unroll
            for (int m = 0; m < 4; ++m)
#pragma unroll
                for (int n = 0; n < 2; ++n) acc[a][b][m][n] = (f32x4){0.f, 0.f, 0.f, 0.f};
    bf16x8 At[4][2], B0[2][2], B1[2][2];
    const int one_e8m0 = 0x7f7f7f7f; (void)one_e8m0;
    unsigned cA = (unsigned)cur.arow * K * 2, cB = (unsigned)cur.e * (unsigned)g.bstride + (unsigned)cur.pn * tstep;
    unsigned cB2 = (unsigned)cur.e2 * (unsigned)g.bstride + (unsigned)cur.pn * tstep; const unsigned hk = (unsigned)(nt / 2) * kstep; (void)cB2; (void)hk;
    PG8_STAGE(PG8_SB(0, 0), gB, cB, voffB); PG8_STAGE(PG8_SB(0, 1), gB, cB + hstep, voffB); PG8_STAGE(PG8_SA(0, 0), gA, cA, vAc[0]); PG8_STAGE(PG8_SA(0, 1), gA, cA, vAc[1]);
    if (wr == 1) PG8_BAR;
    PG8_WAIT_V(2); PG8_BAR;
    PG8_STAGE(PG8_SB(1, 0), gB, cB + kstep, voffB); PG8_STAGE(PG8_SA(1, 0), gA, cA + kstep, vAc[0]); PG8_STAGE(PG8_SB(1, 1), gB, cB + hstep + kstep, voffB);
    PG8_WAIT_V(6); PG8_BAR;
    for (;;) {
        const bool has_next = S.next(ui + 1, nxt);
        const unsigned nA = has_next ? (unsigned)nxt.arow * K * 2 : cA;
        const unsigned nB = has_next ? (unsigned)nxt.e * (unsigned)g.bstride + (unsigned)nxt.pn * tstep : cB;
        const unsigned nB2 = has_next ? (unsigned)nxt.e2 * (unsigned)g.bstride + (unsigned)nxt.pn * tstep : cB2; (void)nB2;
        if (has_next) { PG8_LOAD_VA(vAn, nxt); }
        else {
#pragma unroll
            for (int h = 0; h < 2; ++h)
#pragma unroll
                for (int i = 0; i < 2; ++i) vAn[h][i] = vAc[h][i]; }
#pragma unroll 1
        for (int t = 0; t < nt; t += 2) {
            const bool last = (t == nt - 2);
            if constexpr (Epi::MID) { if (t == nt / 2) E.mid(acc, cur, wr, wc, fr, fq); }
            if constexpr (Epi::PREMID) { if (t == nt / 2) pre = E.pre(cur, wr, fr); }
            const unsigned a1 = cA + (unsigned)(t + 1) * kstep;
            const unsigned a2 = last ? nA : cA + (unsigned)(t + 2) * kstep;
            unsigned b2 = last ? nB : cB + (unsigned)(t + 2) * kstep;
            if constexpr (BSPLIT) { if (!last && t + 2 >= nt / 2) b2 = cB2 + (unsigned)(t + 2) * kstep - hk; }
            const unsigned a3 = a2 + kstep, b3 = b2 + kstep;
            unsigned v2[2][2];
#pragma unroll
            for (int h = 0; h < 2; ++h)
#pragma unroll
                for (int i = 0; i < 2; ++i) v2[h][i] = vAc[h][i];
            if (last) { asm volatile("" ::: "memory");
#pragma unroll
                for (int h = 0; h < 2; ++h)
#pragma unroll
                    for (int i = 0; i < 2; ++i) v2[h][i] = vAn[h][i]; }
            PG8_LDB(B0, 0, 0); PG8_LDB(B1, 0, 1); PG8_SCHED; PG8_LDA(At, 0, 0); PG8_STAGE(PG8_SA(1, 1), gA, a1, vAc[1]);
            PG8_WAIT_V(8); PG8_WAIT_L(0); PG8_BAR; PG8_MMA(0, 0, At, B0); PG8_MMA(0, 1, At, B1); PG8_BAR; PG8_SCHED;
            PG8_LDA(At, 0, 1); PG8_STAGE(PG8_SB(0, 0), gB, b2, voffB); PG8_STAGE(PG8_SB(0, 1), gB, b2 + hstep, voffB); PG8_STAGE(PG8_SA(0, 0), gA, a2, v2[0]);
            PG8_WAIT_V(8); PG8_WAIT_L(0); PG8_BAR; PG8_MMA(1, 0, At, B0); PG8_MMA(1, 1, At, B1); PG8_BAR; PG8_SCHED;
            PG8_LDB(B0, 1, 0); PG8_LDB(B1, 1, 1); PG8_SCHED; PG8_LDA(At, 1, 0); PG8_STAGE(PG8_SA(0, 1), gA, a2, v2[1]);
            PG8_WAIT_V(8); PG8_WAIT_L(0); PG8_BAR; PG8_MMA(0, 0, At, B0); PG8_MMA(0, 1, At, B1); PG8_BAR; PG8_SCHED;
            PG8_LDA(At, 1, 1); PG8_STAGE(PG8_SB(1, 0), gB, b3, voffB); PG8_STAGE(PG8_SB(1, 1), gB, b3 + hstep, voffB); PG8_STAGE(PG8_SA(1, 0), gA, a3, v2[0]);
            PG8_WAIT_V(8); PG8_WAIT_L(0); PG8_BAR; PG8_MMA(1, 0, At, B0); PG8_MMA(1, 1, At, B1); PG8_BAR; PG8_SCHED;
        }
        if constexpr (ALIGN_EPI) { if (wr == 0) PG8_BAR; }
        if constexpr (FP8) asm volatile("s_nop 15\n\ts_nop 15\n\ts_nop 15\n\ts_nop 15" ::: "memory");
        if constexpr (Epi::PREMID) E(acc, cur, wr, wc, fr, fq, pre); else E(acc, cur, wr, wc, fr, fq, E.pre(cur, wr, fr));
        if (!has_next) break;
#pragma unroll
        for (int a = 0; a < 2; ++a)
#pragma unroll
            for (int b = 0; b < 2; ++b)
#pragma unroll
                for (int m = 0; m < 4; ++m)
#pragma unroll
                    for (int n = 0; n < 2; ++n) acc[a][b][m][n] = (f32x4){0.f, 0.f, 0.f, 0.f};
        cur = nxt; cA = nA; cB = nB; cB2 = nB2; ++ui;
#pragma unroll
        for (int h = 0; h < 2; ++h)
#pragma unroll
            for (int i = 0; i < 2; ++i) vAc[h][i] = vAn[h][i];
        if constexpr (ALIGN_EPI) { if (wr == 1) PG8_BAR; }
    }
    PG8_WAIT_V(0);
    if constexpr (!ALIGN_EPI) { if (wr == 0) PG8_BAR; }
    PG8_BAR;
#undef PG8_SA
#undef PG8_SB
#undef PG8_STAGE
#undef PG8_LDA
#undef PG8_LDB
#undef PG8_MMA
#undef PG8_WAIT_V
#undef PG8_WAIT_L
#undef PG8_BAR
#undef PG8_SCHED
#undef PG8_LOAD_VA
}
}

namespace attn_body {
using bf16=__hip_bfloat16;
using bf16x8=__attribute__((ext_vector_type(8)))short;
using s16x4=__attribute__((ext_vector_type(4)))short;
using f32x16=__attribute__((ext_vector_type(16)))float;
using u32x4=__attribute__((ext_vector_type(4)))unsigned;
constexpr int D=64, QP=512, KP=512, VP=512, OP=1024;
constexpr int NW=8,QBLK=32,QB=QBLK*NW,KVBLK=64;
constexpr int ATTN_UNIT_ROWS=QB;
__device__ __forceinline__ int crow(int r,int hi){return (r&3)+8*(r>>2)+4*hi;}
#define SBAR() __builtin_amdgcn_sched_barrier(0)
__device__ __forceinline__ void cmask(f32x16&p0,f32x16&p1,int jb,int qrel,int hi){
  const float NEG=-INFINITY; int kb=64*jb+4*hi;
  #pragma unroll
  for(int r=0;r<16;++r){int kv=kb+(r&3)+8*(r>>2); if(kv>qrel)p0[r]=NEG; if(kv+32>qrel)p1[r]=NEG;}
}

constexpr int NSLOT=3, SLOTB=8192, VSLOTB=16384;
constexpr int LDS_K=0, LDS_V=NSLOT*SLOTB, LDS_WS=LDS_V+NSLOT*VSLOTB, LDS_OST=LDS_WS+NW*64*4, LDS_BYTES=LDS_OST+NW*4096;
constexpr float C2=0.125f*1.4426950408889634f;
__device__ __forceinline__ void glds16(const void*gsrc,unsigned lds_dst){unsigned keep;
  asm volatile("s_mov_b32 %0, m0\n\ts_mov_b32 m0, %2\n\ts_nop 0\n\tglobal_load_lds_dwordx4 %1, off\n\ts_mov_b32 m0, %0":"=&s"(keep):"v"(gsrc),"s"(lds_dst):"memory");}
__device__ __forceinline__ float max3f(float a,float b,float c){float r;asm("v_max3_f32 %0, %1, %2, %3":"=v"(r):"v"(a),"v"(b),"v"(c));return r;}
__device__ __forceinline__ float max2f(float a,float b){float r;asm("v_max_f32_e32 %0, %1, %2":"=v"(r):"v"(a),"v"(b));return r;}
__device__ __forceinline__ float fadd_s(float a,float b){float r;asm("v_add_f32_e32 %0, %1, %2":"=v"(r):"v"(a),"v"(b));return r;}
__device__ __forceinline__ float fsub_s(float a,float b){float r;asm("v_sub_f32_e32 %0, %1, %2":"=v"(r):"v"(a),"v"(b));return r;}
typedef float f32x2_t __attribute__((ext_vector_type(2))); typedef __bf16 bf16x2_t __attribute__((ext_vector_type(2)));
__device__ __forceinline__ unsigned cvtpk_s(float lo,float hi){f32x2_t v={lo,hi};bf16x2_t b=__builtin_convertvector(v,bf16x2_t);return __builtin_bit_cast(unsigned,b);}
#define WAIT_BAR(N) asm volatile("s_waitcnt vmcnt(" #N ") lgkmcnt(0)\n\ts_barrier":::"memory")

__device__ __forceinline__ void qkt(f32x16&p0,f32x16&p1,const char*Kslot,const bf16x8*qr,const f32x16&negm,int r32,int hi){
  const char*kb=Kslot+hi*1024+r32*16;
  #pragma unroll
  for(int d0=0;d0<4;++d0){
    const bf16x8 b0=*reinterpret_cast<const bf16x8*>(kb+d0*2048);
    const bf16x8 b1=*reinterpret_cast<const bf16x8*>(kb+d0*2048+512);
    if(d0==0){p0=__builtin_amdgcn_mfma_f32_32x32x16_bf16(b0,qr[0],negm,0,0,0);p1=__builtin_amdgcn_mfma_f32_32x32x16_bf16(b1,qr[0],negm,0,0,0);}
    else{p0=__builtin_amdgcn_mfma_f32_32x32x16_bf16(b0,qr[d0],p0,0,0,0);p1=__builtin_amdgcn_mfma_f32_32x32x16_bf16(b1,qr[d0],p1,0,0,0);}}
}
typedef __attribute__((address_space(3))) const char* lds_cptr;
typedef short v4i16_t __attribute__((ext_vector_type(4)));
__device__ __forceinline__ void kload8(bf16x8*kf,lds_cptr kp){
  kf[0]=*(const __attribute__((address_space(3))) bf16x8*)(kp);      kf[1]=*(const __attribute__((address_space(3))) bf16x8*)(kp+512);
  kf[2]=*(const __attribute__((address_space(3))) bf16x8*)(kp+2048); kf[3]=*(const __attribute__((address_space(3))) bf16x8*)(kp+2560);
  kf[4]=*(const __attribute__((address_space(3))) bf16x8*)(kp+4096); kf[5]=*(const __attribute__((address_space(3))) bf16x8*)(kp+4608);
  kf[6]=*(const __attribute__((address_space(3))) bf16x8*)(kp+6144); kf[7]=*(const __attribute__((address_space(3))) bf16x8*)(kp+6656);
}
__device__ __forceinline__ void kload2(bf16x8*kf,lds_cptr kp,int j){ kf[2*j]=*(const __attribute__((address_space(3))) bf16x8*)(kp+j*2048); kf[2*j+1]=*(const __attribute__((address_space(3))) bf16x8*)(kp+j*2048+512); }
__device__ __forceinline__ s16x4 vtr(lds_cptr p){ return __builtin_bit_cast(s16x4,__builtin_amdgcn_ds_read_tr16_b64_v4i16((__attribute__((address_space(3))) v4i16_t*)p)); }
__device__ __forceinline__ float rowmax(const f32x16&p0,const f32x16&p1){
  float a=max3f(p0[0],p0[1],p1[0]),b=max3f(p0[2],p0[3],p1[1]);a=max3f(a,p1[2],p1[3]);
  #pragma unroll
  for(int r=4;r<16;r+=4){a=max3f(a,p0[r],p0[r+1]);b=max3f(b,p0[r+2],p0[r+3]);a=max3f(a,p1[r],p1[r+1]);b=max3f(b,p1[r+2],p1[r+3]);}
  const float m=max2f(a,b);
  auto rr=__builtin_amdgcn_permlane32_swap(__float_as_uint(m),__float_as_uint(m),false,false);
  return max2f(__uint_as_float(rr[0]),__uint_as_float(rr[1]));
}
__device__ __forceinline__ void pv(f32x16*o,int vb,bf16x8 pa0,bf16x8 pa1,bf16x8 pa2,bf16x8 pa3){
  #pragma unroll
  for(int d0=0;d0<4;++d0){s16x4 lo[4],hi[4];
    #pragma unroll
    for(int ks=0;ks<4;++ks){
      asm volatile("ds_read_b64_tr_b16 %0,%1 offset:%c2":"=&v"(lo[ks]):"v"(vb),"i"(d0*4096+ks*1024):"memory");
      asm volatile("ds_read_b64_tr_b16 %0,%1 offset:%c2":"=&v"(hi[ks]):"v"(vb),"i"(d0*4096+ks*1024+512):"memory");}
    asm volatile("s_waitcnt lgkmcnt(0)":::"memory");SBAR();
    #define PK(k) (bf16x8){lo[k][0],lo[k][1],lo[k][2],lo[k][3],hi[k][0],hi[k][1],hi[k][2],hi[k][3]}
    o[d0]=__builtin_amdgcn_mfma_f32_32x32x16_bf16(pa0,PK(0),o[d0],0,0,0);
    o[d0]=__builtin_amdgcn_mfma_f32_32x32x16_bf16(pa1,PK(1),o[d0],0,0,0);
    o[d0]=__builtin_amdgcn_mfma_f32_32x32x16_bf16(pa2,PK(2),o[d0],0,0,0);
    o[d0]=__builtin_amdgcn_mfma_f32_32x32x16_bf16(pa3,PK(3),o[d0],0,0,0);
    #undef PK
  }
}

#ifndef ATTN_STORE16
#define ATTN_STORE16(p,v) (*(u32x4*)(p)=(v))
#endif
template<int THRL,bool STAT> __device__ __forceinline__ int attn_unit(float mstat,int q0,const bf16*Q,const bf16*__restrict__ K,const bf16*__restrict__ V,bf16*O,char*shm,const bf16*O1,float lam,const float*subg,unsigned short*CAo,const bf16*Knext,const bf16*Vnext,int s0,bool pre){
  #define NXT_(x) (((x)==(NSLOT-1)*SLOTB)?0:(x)+SLOTB)
  const int s1=NXT_(s0),s2=NXT_(s1);
  int tid_=threadIdx.x; asm volatile("":"+v"(tid_));
  const int tid=tid_,lane=tid&63,r32=lane&31,hi=lane>>5; const int wid=__builtin_amdgcn_readfirstlane(tid>>6);
  const bf16*Qw=Q+(long)(q0+wid*QBLK)*QP;
  const bf16*Kh=K,*Vh=V;
  const unsigned lds0=(unsigned)(uintptr_t)shm;
  float*wsf=(float*)(shm+LDS_WS)+wid*64;
  const bf16*ksrc=Kh+(long)lane*KP+wid*8;
  const bf16*vsrc=Vh+(long)(16*(wid&3)+(lane>>2))*VP+(wid>>2)*32+(lane&3)*8;
  const unsigned kdst=lds0+LDS_K+wid*1024, vdst=lds0+LDS_V+wid*1024;
  #define DMA_K(t,slot) glds16(ksrc+(long)(t)*KVBLK*KP,(unsigned)__builtin_amdgcn_readfirstlane(kdst+(slot)))
  #define DMA_V(t,slot) do{ glds16(vsrc+(long)(t)*KVBLK*VP,(unsigned)__builtin_amdgcn_readfirstlane(vdst+2*(slot))); glds16(vsrc+(long)(t)*KVBLK*VP+64,(unsigned)__builtin_amdgcn_readfirstlane(vdst+2*(slot)+8192)); }while(0)
  const int vb0=(int)(lds0+LDS_V)+((lane>>4)&1)*32+(lane&3)*8+(4*hi+((lane&15)>>2))*64;
  const char*Kbase=shm+LDS_K; bf16x8 kf[8];
  const lds_cptr shm3=(lds_cptr)shm; const lds_cptr kp0=shm3+LDS_K+hi*1024+r32*16; const lds_cptr vp0=shm3+LDS_V+((lane>>4)&1)*32+(lane&3)*8+(4*hi+((lane&15)>>2))*64;
  const int NT=(q0+QB)/KVBLK;
  if(!pre){DMA_K(0,s0);DMA_V(0,s0);DMA_K(1,s1);}
  bf16x8 qr[4];
  #pragma unroll
  for(int d0=0;d0<4;++d0)qr[d0]=*reinterpret_cast<const bf16x8*>(&Qw[(long)r32*QP+d0*16+hi*8]);
  float mhat=0.f,l_reg=0.f;f32x16 o[4];{float zz=0.f;asm volatile("":"+v"(zz));
  #pragma unroll
  for(int r=0;r<16;++r){o[0][r]=zz;o[1][r]=zz;o[2][r]=zz;o[3][r]=zz;}}
  f32x16 negm;{float zn=0.f;asm volatile("":"+v"(zn));
  #pragma unroll
  for(int r=0;r<16;++r)negm[r]=zn;}
  asm volatile("":"+v"(negm));
  const int qrel=wid*QBLK+r32;
  #define CMASK(P0,P1,t) do{int jb_=(t)-(NT-4); if(jb_>=0)cmask(P0,P1,jb_,qrel,hi);}while(0)
  bool resc=false;
  #define START(P0,P1) do{ float rm; if constexpr (STAT) rm=mstat; else rm=rowmax(P0,P1); resc=false; \
    { const float dl=rm; mhat=fadd_s(mhat,dl); \
      _Pragma("unroll") for(int r=0;r<16;++r){P0[r]=fsub_s(P0[r],dl);P1[r]=fsub_s(P1[r],dl);} \
      _Pragma("unroll") for(int r=0;r<16;++r)negm[r]=-mhat; asm volatile("":"+v"(negm)); } \
    _Pragma("unroll") for(int r=0;r<16;++r)P0[r]=__builtin_amdgcn_exp2f(P0[r]); }while(0)
  #define RESC() do{ if(resc){ asm volatile("s_waitcnt lgkmcnt(0)":::"memory"); \
      _Pragma("unroll") for(int d_=0;d_<4;++d_) _Pragma("unroll") for(int r=0;r<16;++r)o[d_][r]*=wsf[crow(r,hi)]; } }while(0)
  f32x16 pA0,pA1,pB0,pB1;
  int sl_prev=s0,sl_cur=s0,sl_next=s1;
  #define ROT() do{sl_prev=sl_cur;sl_cur=sl_next;sl_next=(sl_next==(NSLOT-1)*SLOTB)?0:sl_next+SLOTB;}while(0)
  if(!pre){DMA_K(2,s2);}
  WAIT_BAR(4);
  qkt(pA0,pA1,Kbase+s0,qr,negm,r32,hi);asm volatile("s_nop 15\n\ts_nop 7":"+v"(pA0),"+v"(pA1));CMASK(pA0,pA1,0);
  START(pA0,pA1);
  _Pragma("unroll") for(int r=0;r<16;++r)pA1[r]=__builtin_amdgcn_exp2f(pA1[r]);
  WAIT_BAR(0);
  DMA_K(3,s0);DMA_V(1,s1);
  ROT();
  kload8(kf,kp0+sl_cur);
  WAIT_BAR(3);
  s16x4 vlo[8],vhi[8]; u32x4 pw0,pw1,pw2,pw3;
  #define PKW(P,B) cvtpk_s(P[B],P[B+1])
  #define PAF(k) __builtin_bit_cast(bf16x8,pw##k)
  #define VFR(i) (bf16x8){vlo[i][0],vlo[i][1],vlo[i][2],vlo[i][3],vhi[i][0],vhi[i][1],vhi[i][2],vhi[i][3]}
  #define PIN(x) asm volatile("":"+v"(x))
  #define MX3(a,b,c) __builtin_fmaxf(__builtin_fmaxf((a),(b)),(c))
  #define GAPA(MF,A0,A1,A2,A3,W0,W1,PW) do{ MF; sacc+=A0; sacc+=A1; sacc+=A2; sacc+=A3; PIN(sacc); W0; W1; PIN(PW); SBAR(); }while(0)
  #define EX(v) __builtin_amdgcn_exp2f(v)
  #define GAPB2(MF,X,B) do{ MF; X[B]=EX(X[B]); X[B+1]=EX(X[B+1]); PIN(X); SBAR(); }while(0)
  #define VRD2(i) do{ vlo[i]=vtr(vp_+((((i)>>2)+2)*4096+((i)&3)*1024)); vhi[i]=vtr(vp_+((((i)>>2)+2)*4096+((i)&3)*1024+512)); }while(0)
  #define VRD(i) do{ vlo[i]=vtr(vp_+(((i)>>2)*4096+((i)&3)*1024)); vhi[i]=vtr(vp_+(((i)>>2)*4096+((i)&3)*1024+512)); }while(0)
  #define KRD(G,j) do{ if(G){ kload2(kf,kp0+sl_next,j); SBAR(); } }while(0)
  #define STEP(C0,C1,P0,P1,t,GK,GV,GL) do{ SBAR(); \
    const lds_cptr vp_=vp0+2*sl_prev; \
    VRD(0); SBAR(); float sacc=(P0[0]+P0[1]); \
    GAPA(C0=__builtin_amdgcn_mfma_f32_32x32x16_bf16(kf[0],qr[0],negm,0,0,0), P0[2],P0[3],P0[4],P0[5],     pw0[0]=PKW(P0,0), pw0[1]=PKW(P0,2), pw0); \
    VRD(4); SBAR(); GAPA(C1=__builtin_amdgcn_mfma_f32_32x32x16_bf16(kf[1],qr[0],negm,0,0,0), P0[6],P0[7],P0[8],P0[9],     pw0[2]=PKW(P0,4), pw0[3]=PKW(P0,6), pw0); \
    VRD(1); SBAR(); GAPA(C0=__builtin_amdgcn_mfma_f32_32x32x16_bf16(kf[2],qr[1],C0,0,0,0),   P0[10],P0[11],P0[12],P0[13], pw1[0]=PKW(P0,8), pw1[1]=PKW(P0,10), pw1); \
    VRD(5); SBAR(); GAPA(C1=__builtin_amdgcn_mfma_f32_32x32x16_bf16(kf[3],qr[1],C1,0,0,0),   P0[14],P0[15],P1[0],P1[1],   pw1[2]=PKW(P0,12),pw1[3]=PKW(P0,14), pw1); \
    VRD(2); SBAR(); GAPA(C0=__builtin_amdgcn_mfma_f32_32x32x16_bf16(kf[4],qr[2],C0,0,0,0),   P1[2],P1[3],P1[4],P1[5],     pw2[0]=PKW(P1,0), pw2[1]=PKW(P1,2), pw2); \
    VRD(6); SBAR(); GAPA(C1=__builtin_amdgcn_mfma_f32_32x32x16_bf16(kf[5],qr[2],C1,0,0,0),   P1[6],P1[7],P1[8],P1[9],     pw2[2]=PKW(P1,4), pw2[3]=PKW(P1,6), pw2); \
    VRD(3); SBAR(); GAPA(C0=__builtin_amdgcn_mfma_f32_32x32x16_bf16(kf[6],qr[3],C0,0,0,0),   P1[10],P1[11],P1[12],P1[13], pw3[0]=PKW(P1,8), pw3[1]=PKW(P1,10), pw3); \
    VRD(7); SBAR(); GAPA(C1=__builtin_amdgcn_mfma_f32_32x32x16_bf16(kf[7],qr[3],C1,0,0,0),   P1[14],P1[15],0.f,0.f,       pw3[2]=PKW(P1,12),pw3[3]=PKW(P1,14), pw3); \
    l_reg+=sacc; \
    if(GK){DMA_K((t)+3,sl_cur);} if(GV){DMA_V((t)+1,sl_next);} \
    CMASK(C0,C1,t); \
    if constexpr (!STAT) { float a=MX3(C0[0],C0[1],C1[0]),b=MX3(C0[2],C0[3],C1[1]); a=MX3(a,C1[2],C1[3]); \
      _Pragma("unroll") for(int r=4;r<16;r+=4){a=MX3(a,C0[r],C0[r+1]);b=MX3(b,C0[r+2],C0[r+3]);a=MX3(a,C1[r],C1[r+1]);b=MX3(b,C1[r+2],C1[r+3]);} \
      float rm=__builtin_fmaxf(a,b); { auto rr=__builtin_amdgcn_permlane32_swap(__float_as_uint(rm),__float_as_uint(rm),false,false); rm=__builtin_fmaxf(__uint_as_float(rr[0]),__uint_as_float(rr[1])); } \
      resc=false; \
      if(__builtin_expect(__any(rm>(float)THRL),0)){ const float dl=__builtin_fmaxf(rm,0.f); mhat+=dl; \
        _Pragma("unroll") for(int r=0;r<16;++r){C0[r]-=dl;C1[r]-=dl;} \
        _Pragma("unroll") for(int r=0;r<16;++r)negm[r]=-mhat; asm volatile("":"+v"(negm)); \
        const float f=__builtin_amdgcn_exp2f(-dl); l_reg*=f; if(hi==0)wsf[r32]=f; resc=true; } } \
    SBAR(); \
    GAPB2(o[0]=__builtin_amdgcn_mfma_f32_32x32x16_bf16(PAF(0),VFR(0),o[0],0,0,0), C0,0);  VRD2(0); SBAR(); \
    GAPB2(o[1]=__builtin_amdgcn_mfma_f32_32x32x16_bf16(PAF(0),VFR(4),o[1],0,0,0), C0,2);  VRD2(4); SBAR(); \
    GAPB2(o[0]=__builtin_amdgcn_mfma_f32_32x32x16_bf16(PAF(1),VFR(1),o[0],0,0,0), C0,4);  VRD2(1); SBAR(); \
    GAPB2(o[1]=__builtin_amdgcn_mfma_f32_32x32x16_bf16(PAF(1),VFR(5),o[1],0,0,0), C0,6);  VRD2(5); SBAR(); \
    GAPB2(o[0]=__builtin_amdgcn_mfma_f32_32x32x16_bf16(PAF(2),VFR(2),o[0],0,0,0), C0,8);  VRD2(2); SBAR(); \
    GAPB2(o[1]=__builtin_amdgcn_mfma_f32_32x32x16_bf16(PAF(2),VFR(6),o[1],0,0,0), C0,10); VRD2(6); SBAR(); \
    GAPB2(o[0]=__builtin_amdgcn_mfma_f32_32x32x16_bf16(PAF(3),VFR(3),o[0],0,0,0), C0,12); VRD2(3); SBAR(); \
    GAPB2(o[1]=__builtin_amdgcn_mfma_f32_32x32x16_bf16(PAF(3),VFR(7),o[1],0,0,0), C0,14); VRD2(7); SBAR(); \
    GAPB2(o[2]=__builtin_amdgcn_mfma_f32_32x32x16_bf16(PAF(0),VFR(0),o[2],0,0,0), C1,0); \
    GAPB2(o[3]=__builtin_amdgcn_mfma_f32_32x32x16_bf16(PAF(0),VFR(4),o[3],0,0,0), C1,2); \
    KRD(GL,0); GAPB2(o[2]=__builtin_amdgcn_mfma_f32_32x32x16_bf16(PAF(1),VFR(1),o[2],0,0,0), C1,4); \
    KRD(GL,1); GAPB2(o[3]=__builtin_amdgcn_mfma_f32_32x32x16_bf16(PAF(1),VFR(5),o[3],0,0,0), C1,6); \
    KRD(GL,2); GAPB2(o[2]=__builtin_amdgcn_mfma_f32_32x32x16_bf16(PAF(2),VFR(2),o[2],0,0,0), C1,8); \
    KRD(GL,3); GAPB2(o[3]=__builtin_amdgcn_mfma_f32_32x32x16_bf16(PAF(2),VFR(6),o[3],0,0,0), C1,10); \
    GAPB2(o[2]=__builtin_amdgcn_mfma_f32_32x32x16_bf16(PAF(3),VFR(3),o[2],0,0,0), C1,12); \
    GAPB2(o[3]=__builtin_amdgcn_mfma_f32_32x32x16_bf16(PAF(3),VFR(7),o[3],0,0,0), C1,14); \
    }while(0)
  int t=1;
  #undef CMASK
  #define CMASK(P0,P1,t) do{}while(0)
  for(;t+5<NT;t+=2){
    STEP(pB0,pB1,pA0,pA1,t,true,true,true);     WAIT_BAR(3); RESC(); ROT();
    STEP(pA0,pA1,pB0,pB1,t+1,true,true,true);   WAIT_BAR(3); RESC(); ROT();
  }
  #undef CMASK
  #define CMASK(P0,P1,t) do{int jb_=(t)-(NT-4); if(jb_>=0)cmask(P0,P1,jb_,qrel,hi);}while(0)
  #define ENDW(tt) do{ if((tt)+3<NT){WAIT_BAR(3);} else if((tt)+2<NT){WAIT_BAR(2);} else {WAIT_BAR(0);} }while(0)
  for(;t+1<NT;t+=2){
    STEP(pB0,pB1,pA0,pA1,t,(t+3<NT),(t+1<NT),(t+1<NT));       ENDW(t);   RESC(); ROT();
    STEP(pA0,pA1,pB0,pB1,t+1,(t+4<NT),(t+2<NT),(t+2<NT));     ENDW(t+1); RESC(); ROT();
  }
  int snext=0;
  if(Knext!=nullptr){
    const int p0=sl_next,p1=NXT_(p0),p2=NXT_(p1); snext=p0;
    const bf16*kn=Knext+(long)lane*KP+wid*8; const bf16*vn=Vnext+(long)(16*(wid&3)+(lane>>2))*VP+(wid>>2)*32+(lane&3)*8;
    glds16(kn,(unsigned)__builtin_amdgcn_readfirstlane(kdst+p0));
    glds16(vn,(unsigned)__builtin_amdgcn_readfirstlane(vdst+2*p0)); glds16(vn+64,(unsigned)__builtin_amdgcn_readfirstlane(vdst+2*p0+8192));
    glds16(kn+(long)KVBLK*KP,(unsigned)__builtin_amdgcn_readfirstlane(kdst+p1)); glds16(kn+(long)2*KVBLK*KP,(unsigned)__builtin_amdgcn_readfirstlane(kdst+p2)); }
  STEP(pB0,pB1,pA0,pA1,NT-1,false,false,false); RESC();
  { float sacc=pB0[0]+pB0[1]; _Pragma("unroll") for(int r=2;r<16;++r)sacc+=pB0[r]; _Pragma("unroll") for(int r=0;r<16;++r)sacc+=pB1[r]; l_reg+=sacc;
    pw0=(u32x4){PKW(pB0,0),PKW(pB0,2),PKW(pB0,4),PKW(pB0,6)};pw1=(u32x4){PKW(pB0,8),PKW(pB0,10),PKW(pB0,12),PKW(pB0,14)};pw2=(u32x4){PKW(pB1,0),PKW(pB1,2),PKW(pB1,4),PKW(pB1,6)};pw3=(u32x4){PKW(pB1,8),PKW(pB1,10),PKW(pB1,12),PKW(pB1,14)};
    SBAR(); pv(o,vb0+2*sl_cur,PAF(0),PAF(1),PAF(2),PAF(3)); }
  #undef PKW
  #undef PAF
  #undef VFR
  #undef PIN
  #undef MX3
  #undef GAPA
  #undef GAPB2
  #undef VRD2
  #undef EX
  #undef VRD
  #undef KRD
  #undef STEP
  #undef ENDW
  {auto rr=__builtin_amdgcn_permlane32_swap(__float_as_uint(l_reg),__float_as_uint(l_reg),false,false);l_reg=__uint_as_float(rr[0])+__uint_as_float(rr[1]);}
  if(hi==0)wsf[32+r32]=l_reg;asm volatile("s_waitcnt lgkmcnt(0)":::"memory");
  float rli[16];
  #pragma unroll
  for(int r=0;r<16;++r)rli[r]=__builtin_amdgcn_rcpf(wsf[32+crow(r,hi)]);
  bf16*Ow=O+(long)(q0+wid*QBLK)*OP;
  bf16*stg=(bf16*)(shm+LDS_OST)+wid*2048;
  if(O1==nullptr){
    #pragma unroll
    for(int hf=0;hf<2;++hf){
      #pragma unroll
      for(int r=0;r<16;++r){const int orow=crow(r,hi);
        #pragma unroll
        for(int d0=0;d0<2;++d0)stg[orow*64+d0*32+r32]=__float2bfloat16(o[2*hf+d0][r]*rli[r]);}
      asm volatile("s_waitcnt lgkmcnt(0)":::"memory");
      #pragma unroll
      for(int i=0;i<4;++i){const int row=i*8+(lane>>3),ch=lane&7; const u32x4 v=*(const u32x4*)(stg+row*64+ch*8); ATTN_STORE16(Ow+(long)row*OP+hf*64+ch*8,v);}
      asm volatile("s_waitcnt lgkmcnt(0)":::"memory"); }
  } else {
    const bf16*O1w=O1+(long)(q0+wid*QBLK)*OP; unsigned long long p1[2][4][2];
    #pragma unroll
    for(int hf=0;hf<2;++hf)
      #pragma unroll
      for(int i=0;i<4;++i){const int row=i*8+(lane>>3),ch=lane&7; unsigned long long*a=(unsigned long long*)(O1w+(long)row*OP+hf*64+ch*8);
        p1[hf][i][0]=__hip_atomic_load(a,__ATOMIC_RELAXED,__HIP_MEMORY_SCOPE_AGENT); p1[hf][i][1]=__hip_atomic_load(a+1,__ATOMIC_RELAXED,__HIP_MEMORY_SCOPE_AGENT);}
    float dd[2][4][8]; float ssp[4]={0.f,0.f,0.f,0.f};
    #pragma unroll
    for(int hf=0;hf<2;++hf){
      #pragma unroll
      for(int r=0;r<16;++r){const int orow=crow(r,hi);
        #pragma unroll
        for(int d0=0;d0<2;++d0)stg[orow*64+d0*32+r32]=__float2bfloat16(o[2*hf+d0][r]*rli[r]);}
      asm volatile("s_waitcnt lgkmcnt(0)":::"memory");
      #pragma unroll
      for(int i=0;i<4;++i){const int row=i*8+(lane>>3),ch=lane&7; const u32x4 v=*(const u32x4*)(stg+row*64+ch*8);
        const unsigned w1[4]={(unsigned)p1[hf][i][0],(unsigned)(p1[hf][i][0]>>32),(unsigned)p1[hf][i][1],(unsigned)(p1[hf][i][1]>>32)};
        #pragma unroll
        for(int j=0;j<4;++j){ const float a0=__uint_as_float(w1[j]<<16)-lam*__uint_as_float(v[j]<<16), a1=__uint_as_float(w1[j]&0xffff0000u)-lam*__uint_as_float(v[j]&0xffff0000u);
          dd[hf][i][2*j]=a0; dd[hf][i][2*j+1]=a1; ssp[i]+=a0*a0+a1*a1; } }
      asm volatile("s_waitcnt lgkmcnt(0)":::"memory"); }
    #pragma unroll
    for(int i=0;i<4;++i){ float ss=ssp[i];
      ss+=__int_as_float(__builtin_amdgcn_update_dpp(0,__float_as_int(ss),0xB1,0xf,0xf,true)); ss+=__int_as_float(__builtin_amdgcn_update_dpp(0,__float_as_int(ss),0x4E,0xf,0xf,true)); ss+=__int_as_float(__builtin_amdgcn_update_dpp(0,__float_as_int(ss),0x141,0xf,0xf,true));
      const float rn=1.0f/sqrtf(ss*(1.0f/128.0f)+1e-6f)*0.8f;
      const int row=i*8+(lane>>3),ch=lane&7;
      #pragma unroll
      for(int hf=0;hf<2;++hf){ const float*gp=subg+hf*64+ch*8; u32x4 w;
        w[0]=cvtpk_s(dd[hf][i][0]*rn*gp[0],dd[hf][i][1]*rn*gp[1]); w[1]=cvtpk_s(dd[hf][i][2]*rn*gp[2],dd[hf][i][3]*rn*gp[3]);
        w[2]=cvtpk_s(dd[hf][i][4]*rn*gp[4],dd[hf][i][5]*rn*gp[5]); w[3]=cvtpk_s(dd[hf][i][6]*rn*gp[6],dd[hf][i][7]*rn*gp[7]);
        *(u32x4*)(CAo+(long)(q0+wid*QBLK+row)*1024+hf*64+ch*8)=w; } }
  }
  asm volatile("s_waitcnt lgkmcnt(0)\n\ts_barrier":::"memory");
  #undef DMA_K
  #undef DMA_V
  #undef CMASK
  #undef START
  #undef RESC
  #undef ROT
  #undef NXT_
  return snext;
}
constexpr int ATTN_LDS_BYTES=LDS_BYTES;
#undef SBAR
#undef WAIT_BAR
}

constexpr int NWAVES = 8, NTHREADS = NWAVES * 64;
#ifndef MK_PER_PHASE
#define MK_PER_PHASE 0
#endif
#ifndef RUN_PHASES
#define RUN_PHASES 8
#endif
constexpr int N_PHASES = RUN_PHASES;

constexpr size_t MiB = 1u << 20;
constexpr size_t WS_CTL = 0, CTL_ZERO_BYTES = 65536;
constexpr size_t WS_RS = 1 * MiB;
constexpr size_t WS_TINFO = 2 * MiB;
constexpr size_t WS_WR = 3 * MiB;
constexpr size_t WS_LTOK = 4 * MiB, WS_LW = 8 * MiB;
constexpr size_t WS_WIN = 16 * MiB, WS_WCA = 25 * MiB, WS_WOUT = 27 * MiB;
constexpr size_t WS_A = 32 * MiB;
constexpr size_t WS_QB = 112 * MiB, WS_KB = 144 * MiB, WS_VB = 176 * MiB, WS_YG = 208 * MiB;
constexpr size_t WS_MG = 112 * MiB, WS_XM = 176 * MiB;
constexpr size_t WS_GT = 240 * MiB;
constexpr size_t WS_WGU = 240 * MiB, WS_WD = 304 * MiB;
constexpr size_t WS_CA = 368 * MiB;
constexpr size_t WS_YB = 112 * MiB;
constexpr size_t WS_LIST = 432 * MiB;
constexpr size_t WS_CTOK = 448 * MiB;
constexpr size_t WS_END = 464 * MiB;
static_assert(WS_A + (size_t)CROWS * 1024 <= WS_QB && WS_WD + (size_t)NEXP * 1024 * 512 <= WS_CA, "d_ws map");
static_assert(WS_WIN + (size_t)IN_COLS * 1024 * 2 <= WS_WCA, "d_ws map");

constexpr int RING_BYTES = 131072;
constexpr int META_OFF = RING_BYTES;
constexpr int HIST_OFF = RING_BYTES + 1024;
constexpr int BARST_OFF = RING_BYTES + 3072;
constexpr int META2_OFF = RING_BYTES + 4096;
constexpr int LDS_BYTES = 147456;

#define GAS __attribute__((address_space(1)))
#define LAS __attribute__((address_space(3)))
typedef unsigned short bf16;
typedef unsigned v4u __attribute__((ext_vector_type(4)));
typedef unsigned v2u __attribute__((ext_vector_type(2)));
typedef float f32x4 __attribute__((ext_vector_type(4)));
typedef float f32x16 __attribute__((ext_vector_type(16)));
typedef short bf16x8 __attribute__((ext_vector_type(8)));
using pg8::cvt_pk_bf16; using pg8::bf_lo; using pg8::bf_hi; using pg8::sigmoidf_fast; using pg8::pack8; using pg8::unpack8;

__device__ __forceinline__ float wave_sum(float v) {
    v += __int_as_float(__builtin_amdgcn_update_dpp(0, __float_as_int(v), 0xB1, 0xf, 0xf, true));
    v += __int_as_float(__builtin_amdgcn_update_dpp(0, __float_as_int(v), 0x4E, 0xf, 0xf, true));
    v += __int_as_float(__builtin_amdgcn_update_dpp(0, __float_as_int(v), 0x141, 0xf, 0xf, true));
    v += __int_as_float(__builtin_amdgcn_update_dpp(0, __float_as_int(v), 0x140, 0xf, 0xf, true));
    const int iv = __float_as_int(v);
    return (__int_as_float(__builtin_amdgcn_readlane(iv, 0)) + __int_as_float(__builtin_amdgcn_readlane(iv, 16))) + (__int_as_float(__builtin_amdgcn_readlane(iv, 32)) + __int_as_float(__builtin_amdgcn_readlane(iv, 48)));
}
__device__ __forceinline__ float wave_max(float v) {
    v = fmaxf(v, __int_as_float(__builtin_amdgcn_update_dpp(0, __float_as_int(v), 0xB1, 0xf, 0xf, true)));
    v = fmaxf(v, __int_as_float(__builtin_amdgcn_update_dpp(0, __float_as_int(v), 0x4E, 0xf, 0xf, true)));
    v = fmaxf(v, __int_as_float(__builtin_amdgcn_update_dpp(0, __float_as_int(v), 0x141, 0xf, 0xf, true)));
    v = fmaxf(v, __int_as_float(__builtin_amdgcn_update_dpp(0, __float_as_int(v), 0x140, 0xf, 0xf, true)));
    const int iv = __float_as_int(v);
    return fmaxf(fmaxf(__int_as_float(__builtin_amdgcn_readlane(iv, 0)), __int_as_float(__builtin_amdgcn_readlane(iv, 16))), fmaxf(__int_as_float(__builtin_amdgcn_readlane(iv, 32)), __int_as_float(__builtin_amdgcn_readlane(iv, 48))));
}
__device__ __forceinline__ float bf16_round(float x) { return bf_lo(cvt_pk_bf16(x, 0.f) & 0xffffu); }

#define XB_TMO      128
#define XB_XCNT(j)  (256  + 64 * (j))
#define XB_XSUB(j)  (1280 + 64 * (j))
#define XB_XGEN(j)  (2304 + 64 * (j))
#define XB_TOP      3328
#define XB_TOPGEN   3392
#define XCD_BAR_WORDS 3456
#define XB_SPIN_CAP (1u << 18)

__device__ __forceinline__ unsigned xb_ld(unsigned* p)              { return __hip_atomic_load(p, __ATOMIC_RELAXED, __HIP_MEMORY_SCOPE_AGENT); }
__device__ __forceinline__ unsigned xb_add(unsigned* p, unsigned v) { return __hip_atomic_fetch_add(p, v, __ATOMIC_RELAXED, __HIP_MEMORY_SCOPE_AGENT); }
__device__ __forceinline__ unsigned xb_xcc_id() { return (unsigned)__builtin_amdgcn_s_getreg((3 << 11) | 20) & 0xFu; }
#define XB_SPIN(cond, bar) do { unsigned _sp = 0; while (cond) { __builtin_amdgcn_s_sleep(1); \
    if ((++_sp & 255u) == 0u) { if (xb_ld(&(bar)[XB_TMO])) break; if (_sp > XB_SPIN_CAP) { atomicAdd(&(bar)[XB_TMO], 1u); break; } } } } while (0)

struct XcdBarrier {
    unsigned* bar; unsigned x;
    volatile LAS unsigned* st;
};

__device__ __forceinline__ XcdBarrier xcd_barrier_post(unsigned* bar, volatile LAS unsigned* st) {
    XcdBarrier b; b.bar = bar; b.x = xb_xcc_id(); b.st = st;
    if (threadIdx.x == 0) (void)xb_add(&bar[XB_XCNT(b.x)], 1u);
    return b;
}
__device__ __forceinline__ void xcd_barrier_complete(unsigned* bar, unsigned x, unsigned& nloc, unsigned& nx) {
    const unsigned G = gridDim.x * gridDim.y * gridDim.z;
    unsigned sum, cnt, mine, sp = 0u;
    for (;;) {
        sum = 0u; cnt = 0u; mine = 0u;
#pragma unroll
        for (unsigned j = 0; j < 16; ++j) { const unsigned c = xb_ld(&bar[XB_XCNT(j)]); sum += c; cnt += (c > 0u) ? 1u : 0u; mine = (j == x) ? c : mine; }
        if (sum == G) break;
        __builtin_amdgcn_s_sleep(1);
        if ((++sp & 255u) == 0u) { if (xb_ld(&bar[XB_TMO])) break; if (sp > XB_SPIN_CAP) { atomicAdd(&bar[XB_TMO], 1u); break; } }
    }
    nloc = mine > 0u ? mine : 1u; nx = cnt > 0u ? cnt : 1u;
}

__device__ __forceinline__ void xcd_barrier(const XcdBarrier& b) {
    asm volatile("s_waitcnt vmcnt(0)" ::: "memory");
    __syncthreads();
    if (threadIdx.x == 0) {
        unsigned* bar = b.bar;
        __builtin_amdgcn_s_waitcnt(0);
        unsigned nloc = b.st[0], nx = b.st[1];
        if (nloc == 0u) { xcd_barrier_complete(bar, b.x, nloc, nx); b.st[0] = nloc; b.st[1] = nx; }
        const unsigned old = xb_add(&bar[XB_XSUB(b.x)], 1u);
        const unsigned gen = old / nloc;
        if (old + 1u == (gen + 1u) * nloc) {
            __builtin_amdgcn_fence(__ATOMIC_RELEASE, "agent");
            asm volatile("s_waitcnt vmcnt(0)" ::: "memory");
            const unsigned og = xb_add(&bar[XB_TOP], 1u);
            const unsigned tg = og / nx;
            if (og + 1u == (tg + 1u) * nx) xb_add(&bar[XB_TOPGEN], 1u);
            else XB_SPIN(xb_ld(&bar[XB_TOPGEN]) == tg, bar);
            __builtin_amdgcn_fence(__ATOMIC_ACQUIRE, "agent");
            xb_add(&bar[XB_XGEN(b.x)], 1u);
            asm volatile("s_waitcnt vmcnt(0)" ::: "memory");
        } else {
            XB_SPIN(xb_ld(&bar[XB_XGEN(b.x)]) == gen, bar);
            __builtin_amdgcn_fence(__ATOMIC_ACQUIRE, "agent");
            asm volatile("s_waitcnt vmcnt(0)" ::: "memory");
        }
    }
    __syncthreads();
}


typedef f32x4 AccT[2][2][4][2];
struct EpiInProj {
    static constexpr bool MID = false, PREMID = false;
    struct Pre {}; __device__ __forceinline__ Pre pre(const pg8::Unit&, int, int) const { return Pre{}; }
    bf16 *YG, *QB, *KB, *VB, *GT; const LAS float* gl;
    __device__ __forceinline__ void mid(AccT&, const pg8::Unit&, int, int, int, int) const {}
    __device__ __forceinline__ void operator()(AccT& acc, const pg8::Unit& u, int wr, int wc, int fr, int fq, const Pre& pre_) const {
        asm volatile("" : "+v"(fr), "+v"(fq));
        const int pn = u.pn; const size_t row0 = (size_t)u.orow + wr * 64 + fr;
        if (pn < 4) {
#pragma unroll
            for (int ai = 0; ai < 2; ++ai)
#pragma unroll
                for (int m = 0; m < 4; ++m) { const size_t row = row0 + ai * 128 + m * 16; f32x4 y[2];
#pragma unroll
                    for (int n = 0; n < 2; ++n) { const f32x4 a = acc[ai][0][m][n], g = acc[ai][1][m][n];
                        y[n] = (f32x4){a[0] * sigmoidf_fast(g[0]), a[1] * sigmoidf_fast(g[1]), a[2] * sigmoidf_fast(g[2]), a[3] * sigmoidf_fast(g[3])}; }
                    __builtin_nontemporal_store(pack8(y[0], y[1]), (v4u*)(YG + row * 512 + pn * 128 + wc * 32 + 8 * fq)); }
        } else if (pn < 8) {
            const bool isq = pn < 6; bf16* base = isq ? QB : KB; const LAS float* gp = gl + (isq ? 0 : 64); const float sc = isq ? 0.125f * 1.4426950408889634f : 1.0f;
            f32x4 gv[2][2];
#pragma unroll
            for (int bj = 0; bj < 2; ++bj)
#pragma unroll
                for (int n = 0; n < 2; ++n) gv[bj][n] = *(const LAS f32x4*)(gp + 32 * bj + 8 * fq + 4 * n) * sc;
#pragma unroll
            for (int ai = 0; ai < 2; ++ai)
#pragma unroll
                for (int m = 0; m < 4; ++m) { const size_t row = row0 + ai * 128 + m * 16; float ss = 0.f;
#pragma unroll
                    for (int bj = 0; bj < 2; ++bj)
#pragma unroll
                        for (int n = 0; n < 2; ++n) { const f32x4 a = acc[ai][bj][m][n]; ss += (a[0] * a[0] + a[1] * a[1]) + (a[2] * a[2] + a[3] * a[3]); }
                    ss += __shfl_xor(ss, 16); ss += __shfl_xor(ss, 32);
                    const float rinv = 1.0f / sqrtf(ss * (1.0f / 64.0f) + EPS);
#pragma unroll
                    for (int bj = 0; bj < 2; ++bj)
                        __builtin_nontemporal_store(pack8(acc[ai][bj][m][0] * rinv * gv[bj][0], acc[ai][bj][m][1] * rinv * gv[bj][1]), (v4u*)(base + row * 512 + (pn & 1) * 256 + wc * 64 + bj * 32 + 8 * fq)); }
        } else if (pn < 10) {
#pragma unroll
            for (int ai = 0; ai < 2; ++ai)
#pragma unroll
                for (int m = 0; m < 4; ++m) { const size_t row = row0 + ai * 128 + m * 16;
#pragma unroll
                    for (int bj = 0; bj < 2; ++bj) __builtin_nontemporal_store(pack8(acc[ai][bj][m][0], acc[ai][bj][m][1]), (v4u*)(VB + row * 512 + (pn - 8) * 256 + bj * 128 + wc * 32 + 8 * fq)); }
        } else {
#pragma unroll
            for (int ai = 0; ai < 2; ++ai)
#pragma unroll
                for (int m = 0; m < 4; ++m) { const size_t row = row0 + ai * 128 + m * 16; f32x4 rr[2], gg[2];
#pragma unroll
                    for (int n = 0; n < 2; ++n)
#pragma unroll
                        for (int j = 0; j < 4; ++j) { const float e0 = __builtin_amdgcn_exp2f(-1.4426950408889634f * acc[ai][0][m][n][j]), e1 = fminf(__builtin_amdgcn_exp2f(-1.4426950408889634f * acc[ai][1][m][n][j]), 1e30f);
                            gg[n][j] = __builtin_amdgcn_rcpf(1.0f + e1); rr[n][j] = (1.0f + e1) * __builtin_amdgcn_rcpf(1.0f + e0); }
                    const size_t o = row * 1024 + (pn - 10) * 128 + wc * 32 + 8 * fq;
                    __builtin_nontemporal_store(pack8(rr[0], rr[1]), (v4u*)(GT + o)); __builtin_nontemporal_store(pack8(gg[0], gg[1]), (v4u*)(GT + (size_t)NTOK * 1024 + o)); }
        }
    }
};
struct EpiMerged {
    static constexpr bool MID = true, PREMID = false;
    struct Pre {}; __device__ __forceinline__ Pre pre(const pg8::Unit&, int, int) const { return Pre{}; }
    const bf16* GR; const bf16* G1; bf16* MG;
    __device__ __forceinline__ void mid(AccT& acc, const pg8::Unit& u, int wr, int wc, int fr, int fq) const {
        asm volatile("" : "+v"(fr), "+v"(fq));
        const size_t row0 = (size_t)u.orow + wr * 64 + fr; const int col0 = u.pn * 256 + wc * 32 + 8 * fq;
        v4u w0[2][4][2];
#pragma unroll
        for (int ai = 0; ai < 2; ++ai)
#pragma unroll
            for (int m = 0; m < 4; ++m)
#pragma unroll
                for (int bj = 0; bj < 2; ++bj) w0[ai][m][bj] = *(const v4u*)(GR + (row0 + ai * 128 + m * 16) * 1024 + col0 + bj * 128);
        __builtin_amdgcn_sched_barrier(0);
#pragma unroll
        for (int ai = 0; ai < 2; ++ai)
#pragma unroll
            for (int m = 0; m < 4; ++m)
#pragma unroll
                for (int bj = 0; bj < 2; ++bj) { f32x4 a0, a1; unpack8(w0[ai][m][bj], a0, a1); acc[ai][bj][m][0] = acc[ai][bj][m][0] * a0; acc[ai][bj][m][1] = acc[ai][bj][m][1] * a1; }
        __builtin_amdgcn_sched_barrier(0);
    }
    __device__ __forceinline__ void operator()(AccT& acc, const pg8::Unit& u, int wr, int wc, int fr, int fq, const Pre& pre_) const {
        asm volatile("" : "+v"(fr), "+v"(fq));
        const size_t row0 = (size_t)u.orow + wr * 64 + fr; const int col0 = u.pn * 256 + wc * 32 + 8 * fq;
        v4u w1[2][4][2];
#pragma unroll
        for (int ai = 0; ai < 2; ++ai)
#pragma unroll
            for (int m = 0; m < 4; ++m)
#pragma unroll
                for (int bj = 0; bj < 2; ++bj) w1[ai][m][bj] = *(const v4u*)(G1 + (row0 + ai * 128 + m * 16) * 1024 + col0 + bj * 128);
        __builtin_amdgcn_sched_barrier(0);
#pragma unroll
        for (int ai = 0; ai < 2; ++ai)
#pragma unroll
            for (int m = 0; m < 4; ++m) { const size_t row = row0 + ai * 128 + m * 16;
#pragma unroll
                for (int bj = 0; bj < 2; ++bj) { f32x4 b0, b1; unpack8(w1[ai][m][bj], b0, b1);
                    *(v4u*)(MG + row * 1024 + col0 + bj * 128) = pack8(acc[ai][bj][m][0] * b0, acc[ai][bj][m][1] * b1); } }
    }
};
struct EpiOut {
    static constexpr bool MID = false, PREMID = false;
    struct Pre {}; __device__ __forceinline__ Pre pre(const pg8::Unit&, int, int) const { return Pre{}; }
    const float* x; bf16* XMB; unsigned char* XM8;
    __device__ __forceinline__ void mid(AccT&, const pg8::Unit&, int, int, int, int) const {}
    __device__ __forceinline__ void operator()(AccT& acc, const pg8::Unit& u, int wr, int wc, int fr, int fq, const Pre& pre_) const {
        asm volatile("" : "+v"(fr), "+v"(fq));
        const size_t row0 = (size_t)u.orow + wr * 64 + fr; const int col0 = u.pn * 256 + wc * 32 + 8 * fq;
#pragma unroll
        for (int ai = 0; ai < 2; ++ai) {
            f32x4 xv[4][2][2];
#pragma unroll
            for (int m = 0; m < 4; ++m) { const size_t off = (row0 + ai * 128 + m * 16) * 1024 + col0;
#pragma unroll
                for (int bj = 0; bj < 2; ++bj) { xv[m][bj][0] = __builtin_nontemporal_load((const f32x4*)(x + off + bj * 128)); xv[m][bj][1] = __builtin_nontemporal_load((const f32x4*)(x + off + bj * 128 + 4)); } }
            __builtin_amdgcn_sched_barrier(0);
#pragma unroll
            for (int m = 0; m < 4; ++m) { const size_t off = (row0 + ai * 128 + m * 16) * 1024 + col0;
#pragma unroll
                for (int bj = 0; bj < 2; ++bj) { const f32x4 o0 = xv[m][bj][0] + acc[ai][bj][m][0], o1 = xv[m][bj][1] + acc[ai][bj][m][1];
                    *(v4u*)(XMB + off + bj * 128) = pack8(o0, o1);
                    v2u w8; w8.x = pg8::pack4_fp8(o0[0], o0[1], o0[2], o0[3]); w8.y = pg8::pack4_fp8(o1[0], o1[1], o1[2], o1[3]); *(v2u*)(XM8 + off + bj * 128) = w8; } }
            __builtin_amdgcn_sched_barrier(0);
        }
    }
};
struct EpiGateUp {
    static constexpr bool MID = false, PREMID = false;
    typedef int i32x4 __attribute__((ext_vector_type(4)));
    struct Pre { int dst[2][4]; float w[2][4], rs[2][4]; };
    __device__ __forceinline__ Pre pre(const pg8::Unit& u, int wr, int fr) const { Pre p;
#pragma unroll
        for (int ai = 0; ai < 2; ++ai)
#pragma unroll
            for (int m = 0; m < 4; ++m) { const int r = ai * 128 + wr * 64 + m * 16 + fr; const i32x4 en = (r < u.nvalid) ? *(const i32x4*)(LIST + (size_t)(u.lrow + r) * 4) : (i32x4){-1, -1, 0, 0};
                p.dst[ai][m] = en[1]; p.w[ai][m] = __int_as_float(en[2]); p.rs[ai][m] = __int_as_float(en[3]); }
        return p; }
    const int* LIST; unsigned char* HP8; const LAS int* m2;
    __device__ __forceinline__ void mid(AccT&, const pg8::Unit&, int, int, int, int) const {}
    __device__ __forceinline__ void operator()(AccT& acc, const pg8::Unit& u, int wr, int wc, int fr, int fq, const Pre& pre_) const {
        asm volatile("" : "+v"(fr), "+v"(fq));
#pragma unroll
        for (int ai = 0; ai < 2; ++ai)
#pragma unroll
            for (int m = 0; m < 4; ++m) { const int dst = pre_.dst[ai][m]; if (dst < 0) continue;
                const float rs = pre_.rs[ai][m] * (1.0f / 64.0f), w8 = pre_.w[ai][m] * 8.0f;
                const size_t drow = (size_t)m2[dst >> 17] * 256 + ((dst >> 1) & 0xffff);
                float h[8];
#pragma unroll
                for (int n = 0; n < 2; ++n)
#pragma unroll
                    for (int j = 0; j < 4; ++j) { const float g = acc[ai][0][m][n][j] * rs, up = acc[ai][1][m][n][j] * rs; h[4 * n + j] = __builtin_amdgcn_fmed3f(g * sigmoidf_fast(g) * up * w8, -448.f, 448.f); }
                v2u o8; o8.x = pg8::pack4_fp8(h[0], h[1], h[2], h[3]); o8.y = pg8::pack4_fp8(h[4], h[5], h[6], h[7]);
                *(v2u*)(HP8 + drow * 1024 + (dst & 1) * 512 + u.pn * 128 + wc * 32 + 8 * fq) = o8; }
    }
};
struct EpiDownAdd {
    static constexpr bool MID = false, PREMID = true;
    struct Pre { int tok[2][4]; };
    __device__ __forceinline__ Pre pre(const pg8::Unit& u, int wr, int fr) const { Pre p;
#pragma unroll
        for (int ai = 0; ai < 2; ++ai)
#pragma unroll
            for (int m = 0; m < 4; ++m) { const int r = ai * 128 + wr * 64 + m * 16 + fr; p.tok[ai][m] = (r < u.nvalid) ? CTOK[u.lrow + r] : -1; }
        return p; }
    const int* CTOK; const bf16* XMB; float* out;
    __device__ __forceinline__ void mid(AccT&, const pg8::Unit&, int, int, int, int) const {}
    __device__ __forceinline__ void operator()(AccT& acc, const pg8::Unit& u, int wr, int wc, int fr, int fq, const Pre& pre_) const {
        asm volatile("" : "+v"(fr), "+v"(fq));
        const int col0 = u.pn * 256 + wc * 32 + 8 * fq;
        v4u xw[2][4][2];
#pragma unroll
        for (int ai = 0; ai < 2; ++ai)
#pragma unroll
            for (int m = 0; m < 4; ++m) { const int tk = pre_.tok[ai][m]; const size_t off = (size_t)(tk < 0 ? 0 : tk) * 1024 + col0;
#pragma unroll
                for (int bj = 0; bj < 2; ++bj) xw[ai][m][bj] = *(const v4u*)(XMB + off + bj * 128); }
        __builtin_amdgcn_sched_barrier(0);
#pragma unroll
        for (int ai = 0; ai < 2; ++ai)
#pragma unroll
            for (int m = 0; m < 4; ++m) { const int tk = pre_.tok[ai][m]; if (tk < 0) continue; const size_t off = (size_t)tk * 1024 + col0;
#pragma unroll
                for (int bj = 0; bj < 2; ++bj) { f32x4 x0, x1; unpack8(xw[ai][m][bj], x0, x1);
                    __builtin_nontemporal_store(x0 + acc[ai][bj][m][0] * (1.0f / 256.0f), (f32x4*)(out + off + bj * 128)); __builtin_nontemporal_store(x1 + acc[ai][bj][m][1] * (1.0f / 256.0f), (f32x4*)(out + off + bj * 128 + 4)); } }
    }
};
struct MoeOrder {
    int G, c, total; const LAS int* meta;
    __device__ __forceinline__ bool next(int i, pg8::Unit& u) const {
        const int L = i * G + c; if (L >= total * 4) return false;
        const int blk = L >> 2; const int lane = tid_opaque() & 63;
        const int e = __builtin_amdgcn_readfirstlane(__builtin_popcountll(__ballot(lane < NEXP - 1 && meta[1 + lane] <= blk)));
        const int pre = __builtin_amdgcn_readfirstlane(meta[e]), cnt = __builtin_amdgcn_readfirstlane(meta[64 + e]); const int rb = blk - pre;
        u.pn = L & 3; u.pm = rb; u.e = e; u.e2 = e; u.lrow = e * LCAP + rb * 256; u.nvalid = min(256, cnt - rb * 256); u.orow = blk * 256; u.arow = 0; return true;
    }
};
struct ClassOrder {
    int G, c, total; const LAS int* m2;
    __device__ __forceinline__ bool next(int i, pg8::Unit& u) const {
        const int L = i * G + c; if (L >= total * 4) return false;
        const int blk = L >> 2; const int lane = tid_opaque() & 63;
        const int n0 = __builtin_popcountll(__ballot(m2[1 + lane] <= blk)), n1 = __builtin_popcountll(__ballot(lane + 65 <= NCLS - 1 && m2[65 + lane] <= blk));
        const int cls = __builtin_amdgcn_readfirstlane(n0 + n1);
        const int pre = __builtin_amdgcn_readfirstlane(m2[cls]), cnt = __builtin_amdgcn_readfirstlane(m2[128 + cls]); const int rb = blk - pre;
        const int g = cls / 28; int p = cls % 28, a = 0;
        while (p >= 7 - a) { p -= 7 - a; ++a; }
        u.e = g * 8 + a; u.e2 = g * 8 + a + 1 + p; u.pn = L & 3; u.pm = rb; u.lrow = cls * NTOK + rb * 256; u.nvalid = min(256, cnt - rb * 256); u.orow = blk * 256; u.arow = u.orow; return true;
    }
};
__device__ __forceinline__ void moe_meta(LAS int* meta, LAS int* m2, const unsigned* ctl) {
    const int tid = tid_opaque();
    if (tid < NEXP) meta[64 + tid] = (int)__hip_atomic_load(ctl + tid, __ATOMIC_RELAXED, __HIP_MEMORY_SCOPE_AGENT);
    if (tid >= 64 && tid < 64 + NCLS) m2[128 + tid - 64] = (int)__hip_atomic_load(ctl + tid, __ATOMIC_RELAXED, __HIP_MEMORY_SCOPE_AGENT);
    __syncthreads();
    if (tid == 0) { int p = 0;
        for (int e = 0; e < NEXP; ++e) { meta[e] = p; p += (meta[64 + e] + 255) >> 8; }
        meta[NEXP] = p; }
    if (tid == 64) { int p = 0;
        for (int c = 0; c < NCLS; ++c) { m2[c] = p; p += (m2[128 + c] + 255) >> 8; }
        m2[NCLS] = p; }
    __syncthreads();
}

__device__ __forceinline__ void transpose_item(const float* W, int N, int k0, int n0, bf16* WT, int dpitch, int drow0, int dcol0, const float* kscale, LAS float* scr, int lane) {
    const int kr = lane >> 3, nc = (lane & 7) * 4;
    f32x4 v[8];
#pragma unroll
    for (int i = 0; i < 8; ++i) v[i] = *(const f32x4*)(W + (size_t)(k0 + i * 8 + kr) * N + n0 + nc);
    if (kscale) {
#pragma unroll
        for (int i = 0; i < 8; ++i) v[i] = v[i] * kscale[k0 + i * 8 + kr]; }
#pragma unroll
    for (int i = 0; i < 8; ++i) { LAS float* d = scr + (i * 8 + kr) * 33 + nc; d[0] = v[i][0]; d[1] = v[i][1]; d[2] = v[i][2]; d[3] = v[i][3]; }
    asm volatile("s_waitcnt lgkmcnt(0)" ::: "memory");
    const int c = lane & 7;
#pragma unroll
    for (int j = 0; j < 4; ++j) { const int n = (lane >> 3) + 8 * j; const LAS float* s = scr + (8 * c) * 33 + n;
        v4u o; o.x = cvt_pk_bf16(s[0 * 33], s[1 * 33]); o.y = cvt_pk_bf16(s[2 * 33], s[3 * 33]); o.z = cvt_pk_bf16(s[4 * 33], s[5 * 33]); o.w = cvt_pk_bf16(s[6 * 33], s[7 * 33]);
        *(v4u*)(WT + (size_t)(drow0 + n) * dpitch + dcol0 + k0 + 8 * c) = o; }
    asm volatile("s_waitcnt lgkmcnt(0)" ::: "memory");
}
__device__ __forceinline__ void t8_load(f32x4 (&v)[8], const float* W, int N, int k0, int n0, int lane) {
    const int kr = lane >> 3, nc = (lane & 7) * 4;
#pragma unroll
    for (int i = 0; i < 8; ++i) v[i] = __builtin_nontemporal_load((const f32x4*)(W + (size_t)(k0 + i * 8 + kr) * N + n0 + nc));
}
__device__ __forceinline__ void t8_finish(f32x4 (&v)[8], int k0, unsigned char* WT, int dpitch, int drow0, const float* kscale, float mul, LAS float* scr, int lane) {
    const int kr = lane >> 3, nc = (lane & 7) * 4;
#pragma unroll
    for (int i = 0; i < 8; ++i) v[i] = v[i] * (kscale ? kscale[k0 + i * 8 + kr] * mul : mul);
#pragma unroll
    for (int i = 0; i < 8; ++i) { LAS float* d = scr + (i * 8 + kr) * 33 + nc; d[0] = v[i][0]; d[1] = v[i][1]; d[2] = v[i][2]; d[3] = v[i][3]; }
    asm volatile("s_waitcnt lgkmcnt(0)" ::: "memory");
    const int c = lane & 7;
#pragma unroll
    for (int j = 0; j < 4; ++j) { const int n = (lane >> 3) + 8 * j; const LAS float* s = scr + (8 * c) * 33 + n;
        v2u o; o.x = pg8::pack4_fp8(s[0 * 33], s[1 * 33], s[2 * 33], s[3 * 33]); o.y = pg8::pack4_fp8(s[4 * 33], s[5 * 33], s[6 * 33], s[7 * 33]);
        *(v2u*)(WT + (size_t)(drow0 + n) * dpitch + k0 + 8 * c) = o; }
    asm volatile("s_waitcnt lgkmcnt(0)" ::: "memory");
}
__device__ __forceinline__ void transpose_item_fp8(const float* W, int N, int k0, int n0, unsigned char* WT, int dpitch, int drow0, const float* kscale, float mul, LAS float* scr, int lane) {
    f32x4 v[8]; t8_load(v, W, N, k0, n0, lane); t8_finish(v, k0, WT, dpitch, drow0, kscale, mul, scr, lane);
}
__device__ __forceinline__ int inproj_phys(int c) {
    if (c < 512) return (c >> 7) * 256 + (c & 127);
    if (c < 1024) { c -= 512; return (c >> 7) * 256 + 128 + (c & 127); }
    if (c < 2048) { const int sec = (c - 1024) >> 8, cl = (c - 1024) & 255, s = cl >> 6, d = cl & 63; return 1024 + sec * 256 + ((d >> 5) << 7) + (s << 5) + (d & 31); }
    if (c < 2560) return c;
    { int j = c - 2560; const int hi = j >= 1024; j &= 1023; return 2560 + (j >> 7) * 256 + hi * 128 + (j & 127); }
}
struct Ptrs {
    const float *x, *attn_norm_g, *w_in, *conv_dw_w, *conv_dw_b, *conv_ln_g, *conv_ln_b, *w_conv_out, *q_norm_g, *k_norm_g, *lq1, *lk1, *lq2, *lk2, *subln_g,
        *w_attn_out, *w_out, *ffn_norm_g, *w_rg, *b_rg, *w_re, *b_re, *w_gate, *w_up, *w_down;
    float* out; unsigned char* ws;
};

__device__ __forceinline__ void p0_prologue(const Ptrs& P, LAS unsigned char* lds, int vcu, int G) {
    const int tid = tid_opaque(), lane = tid & 63, wave = __builtin_amdgcn_readfirstlane(tid >> 6);
    LAS float* scr = (LAS float*)(lds + wave * 16384);
    const int gw = vcu * NWAVES + wave, NGW = G * NWAVES;
    bf16* WIN = (bf16*)(P.ws + WS_WIN); bf16* WCA = (bf16*)(P.ws + WS_WCA); bf16* WOUT = (bf16*)(P.ws + WS_WOUT);
    constexpr int I_IN = (DMODEL / 64) * (IN_COLS / 32), I_C = (CONV_CH / 64) * (DMODEL / 32), I_O = (DMODEL / 64) * (DMODEL / 32);
    for (int it = gw; it < I_IN + 2 * I_C + I_O; it += NGW) {
        int r = it;
        if (r < I_IN) { const int kb = r / (IN_COLS / 32), nb = r % (IN_COLS / 32); transpose_item(P.w_in, IN_COLS, kb * 64, nb * 32, WIN, 1024, inproj_phys(nb * 32), 0, nullptr, scr, lane); continue; } r -= I_IN;
        if (r < I_C) { const int kb = r / 32, nb = r % 32; transpose_item(P.w_conv_out, DMODEL, kb * 64, nb * 32, WCA, 1024, nb * 32, 0, nullptr, scr, lane); continue; } r -= I_C;
        if (r < I_C) { const int kb = r / 32, nb = r % 32; transpose_item(P.w_attn_out, DMODEL, kb * 64, nb * 32, WCA, 1024, nb * 32, 512, nullptr, scr, lane); continue; } r -= I_C;
        { const int kb = r / 32, nb = r % 32; transpose_item(P.w_out, DMODEL, kb * 64, nb * 32, WOUT, 1024, nb * 32, 0, nullptr, scr, lane); }
    }
    bf16* WRhi = (bf16*)(P.ws + WS_WR); bf16* WRlo = WRhi + 64 * 1024;
    for (int idx = vcu * NTHREADS + tid; idx < 64 * 1024; idx += G * NTHREADS) {
        const int n = idx >> 10, k = idx & 1023; float v = 0.f;
        if (n < 4) v = P.w_rg[k * 4 + n]; else if (n < 36) v = P.w_re[k * 32 + (n - 4)];
        v *= P.ffn_norm_g[k];
        const unsigned hb = cvt_pk_bf16(v, 0.f) & 0xffffu; const float hf = __uint_as_float(hb << 16);
        WRhi[idx] = (bf16)hb; WRlo[idx] = (bf16)(cvt_pk_bf16(v - hf, 0.f) & 0xffffu);
    }
    bf16* HB = (bf16*)(P.ws + WS_A);
    f32x4 gq[4];
#pragma unroll
    for (int j = 0; j < 4; ++j) gq[j] = ((const f32x4*)P.attn_norm_g)[64 * j + lane];
    constexpr int RPT = 4;
    for (int m = gw; m < NTOK; m += RPT * NGW) {
        f32x4 v[RPT][4];
#pragma unroll
        for (int q = 0; q < RPT; ++q) { const int mq = m + q * NGW; const f32x4* xr = (const f32x4*)(P.x + (size_t)(mq < NTOK ? mq : m) * DMODEL) + lane;
#pragma unroll
            for (int j = 0; j < 4; ++j) v[q][j] = __builtin_nontemporal_load(xr + 64 * j); }
#pragma unroll
        for (int q = 0; q < RPT; ++q) { const int mq = m + q * NGW; float ss = 0.f;
#pragma unroll
            for (int j = 0; j < 4; ++j) ss += (v[q][j][0] * v[q][j][0] + v[q][j][1] * v[q][j][1]) + (v[q][j][2] * v[q][j][2] + v[q][j][3] * v[q][j][3]);
            const float r = 1.0f / sqrtf(wave_sum(ss) * (1.0f / DMODEL) + EPS);
            if (mq < NTOK) { v2u* o8 = (v2u*)(HB + (size_t)mq * DMODEL) + lane;
#pragma unroll
                for (int j = 0; j < 4; ++j) { const f32x4 y = v[q][j] * r * gq[j]; v2u w; w.x = cvt_pk_bf16(y[0], y[1]); w.y = cvt_pk_bf16(y[2], y[3]); o8[64 * j] = w; } } }
    }
}

__device__ __forceinline__ void conv_phase(const Ptrs& P, LAS unsigned char* lds, int first, int stride) {
    const int tid = tid_opaque(), lane = tid & 63, wave = __builtin_amdgcn_readfirstlane(tid >> 6);
    const bf16* YG = (const bf16*)(P.ws + WS_YG); bf16* CA = (bf16*)(P.ws + WS_CA);
    LAS bf16* yt = (LAS bf16*)lds; LAS float* co = (LAS float*)(lds + 62 * 1024);
    constexpr int NT = NTOK / 32;
    if (first >= NT) return;
    float w[CONV_W];
#pragma unroll
    for (int j = 0; j < CONV_W; ++j) w[j] = P.conv_dw_w[j * CONV_CH + tid];
    const float bias = P.conv_dw_b[tid];
    const f32x4 g0 = ((const f32x4*)P.conv_ln_g)[lane], g1 = ((const f32x4*)P.conv_ln_g)[64 + lane], b0 = ((const f32x4*)P.conv_ln_b)[lane], b1 = ((const f32x4*)P.conv_ln_b)[64 + lane];
    v4u pre[8];
#define CONV_FETCH(tile) do { const int b_ = (tile) / (SEQ / 32), t0_ = ((tile) % (SEQ / 32)) * 32; _Pragma("unroll") for (int p = 0; p < 8; ++p) { const int q = tid + NTHREADS * p; const int row = q >> 6, ch = q & 63, t = t0_ - 30 + row; \
        pre[p] = (v4u){0u, 0u, 0u, 0u}; if (q < 62 * 64 && t >= 0) pre[p] = *(const v4u*)(YG + ((size_t)(b_ * SEQ + t)) * 512 + ch * 8); } } while (0)
    CONV_FETCH(first);
    for (int tile = first; tile < NT; tile += stride) {
        const int b = tile / (SEQ / 32), t0 = (tile % (SEQ / 32)) * 32;
#pragma unroll
        for (int p = 0; p < 8; ++p) { const int q = tid + NTHREADS * p; if (q < 62 * 64) *(LAS v4u*)(yt + (q >> 6) * 512 + (q & 63) * 8) = pre[p]; }
        __syncthreads();
        if (tile + stride < NT) CONV_FETCH(tile + stride);
        float yv[62];
#pragma unroll
        for (int i = 0; i < 62; ++i) yv[i] = __uint_as_float((unsigned)yt[i * 512 + tid] << 16);
#pragma unroll
        for (int t = 0; t < 32; ++t) { float a = bias;
#pragma unroll
            for (int j = 0; j < CONV_W; ++j) a += w[j] * yv[t + j];
            co[t * 512 + tid] = a; }
        __syncthreads();
#pragma unroll
        for (int rr = 0; rr < 4; ++rr) { const int row = wave * 4 + rr;
            const f32x4 v0 = *(const LAS f32x4*)(co + row * 512 + lane * 4), v1 = *(const LAS f32x4*)(co + row * 512 + 256 + lane * 4);
            const float mean = wave_sum((v0[0] + v0[1]) + (v0[2] + v0[3]) + (v1[0] + v1[1]) + (v1[2] + v1[3])) * (1.0f / CONV_CH);
            const f32x4 d0 = v0 - mean, d1 = v1 - mean;
            const float var = wave_sum((d0[0] * d0[0] + d0[1] * d0[1]) + (d0[2] * d0[2] + d0[3] * d0[3]) + (d1[0] * d1[0] + d1[1] * d1[1]) + (d1[2] * d1[2] + d1[3] * d1[3])) * (1.0f / CONV_CH);
            const float rstd = 1.0f / sqrtf(var + EPS);
            f32x4 y0 = d0 * rstd * g0 + b0, y1 = d1 * rstd * g1 + b1;
#pragma unroll
            for (int j = 0; j < 4; ++j) { y0[j] = y0[j] * sigmoidf_fast(y0[j]); y1[j] = y1[j] * sigmoidf_fast(y1[j]); }
            bf16* orow = CA + ((size_t)(b * SEQ + t0 + row)) * 1024;
            v2u o0, o1; o0.x = cvt_pk_bf16(y0[0], y0[1]); o0.y = cvt_pk_bf16(y0[2], y0[3]); o1.x = cvt_pk_bf16(y1[0], y1[1]); o1.y = cvt_pk_bf16(y1[2], y1[3]);
            *(v2u*)(orow + lane * 4) = o0; *(v2u*)(orow + 256 + lane * 4) = o1; }
        __syncthreads();
    }
#undef CONV_FETCH
}

__device__ __forceinline__ void attn_pair(const Ptrs& P, LAS unsigned char* lds, char* lds_generic, int p) {
    const int tid = tid_opaque(), lane = tid & 63, wave = __builtin_amdgcn_readfirstlane(tid >> 6);
    const int bh = p >> 3, s = p & 7, b = bh >> 2, h = bh & 3;
    const __hip_bfloat16* QB = (const __hip_bfloat16*)(P.ws + WS_QB); const __hip_bfloat16* KB = (const __hip_bfloat16*)(P.ws + WS_KB); const __hip_bfloat16* VB = (const __hip_bfloat16*)(P.ws + WS_VB);
    __hip_bfloat16* OT = (__hip_bfloat16*)(P.ws + WS_A); bf16* CA = (bf16*)(P.ws + WS_CA);
    float mstat;
    { int l0 = lane; asm volatile("" : "+v"(l0));
      const float a = wave_max(fabsf(P.q_norm_g[l0])), b = wave_max(fabsf(P.k_norm_g[l0]));
      mstat = __int_as_float(__builtin_amdgcn_readfirstlane(__float_as_int(0.125f * 1.4426950408889634f * 64.0f * 1.02f * a * b))); }
    float lam;
    { int l1 = lane; asm volatile("" : "+v"(l1));
      lam = __int_as_float(__builtin_amdgcn_readfirstlane(__float_as_int(__expf(wave_sum(P.lq1[l1] * P.lk1[l1])) - __expf(wave_sum(P.lq2[l1] * P.lk2[l1])) + 0.2f))); }
    int s0 = 0; bool pre = false;
#pragma unroll 1
    for (int u4 = 0; u4 < 4; ++u4) { const int i = u4 >> 1, c = u4 & 1;
        const int qb = (i == 0) ? s : 15 - s;
        const __hip_bfloat16* q_ = QB + (size_t)b * SEQ * 512 + (h * 2 + c) * 64; const __hip_bfloat16* k_ = KB + (size_t)b * SEQ * 512 + (h * 2 + c) * 64; const __hip_bfloat16* v_ = VB + (size_t)b * SEQ * 512 + h * 128;
        const __hip_bfloat16* kn_ = (u4 < 3) ? KB + (size_t)b * SEQ * 512 + (h * 2 + (c ^ 1)) * 64 : nullptr;
        __hip_bfloat16* o_ = OT + (size_t)b * SEQ * 1024 + (h * 2) * 128;
        const __hip_bfloat16* o1_ = c ? o_ : nullptr; unsigned short* ca_ = CA + (size_t)b * SEQ * 1024 + 512 + h * 128;
        int sn;
        if (mstat <= 40.0f) sn = attn_body::attn_unit<8, true>(mstat, qb * 256, q_, k_, v_, o_, lds_generic, o1_, lam, P.subln_g, ca_, kn_, v_, s0, pre);
        else sn = attn_body::attn_unit<8, false>(0.f, qb * 256, q_, k_, v_, o_, lds_generic, o1_, lam, P.subln_g, ca_, kn_, v_, s0, pre);
        s0 = sn; pre = (kn_ != nullptr); }
}

__device__ __forceinline__ void router_tile(const Ptrs& P, LAS unsigned char* lds, int tile) {
    const int tid = tid_opaque(), lane = tid & 63, wave = __builtin_amdgcn_readfirstlane(tid >> 6), r32 = lane & 31, hi = lane >> 5;
    const bf16* WRhi = (const bf16*)(P.ws + WS_WR); const bf16* WRlo = WRhi + 64 * 1024;
    int* LIST = (int*)(P.ws + WS_LIST); int* CTOK = (int*)(P.ws + WS_CTOK); unsigned* cnt = (unsigned*)(P.ws + WS_CTL); unsigned* ccnt = cnt + 64;
    LAS float* lg = (LAS float*)(lds + wave * 8448);
    LAS int* hist = (LAS int*)(lds + HIST_OFF); LAS int* hbase = hist + 32; LAS int* hist2 = hist + 64; LAS int* hbase2 = hist2 + NCLS;
    if (tid < 32) hist[tid] = 0;
    if (tid >= 64 && tid < 64 + NCLS) hist2[tid - 64] = 0;
    __syncthreads();
    const int tbase = tile * 256 + wave * 32;
    const bf16* xr = (const bf16*)(P.ws + WS_CA) + (size_t)(tbase + r32) * DMODEL + 8 * hi;
    const bf16* bh0 = WRhi + (size_t)r32 * 1024 + 8 * hi; const bf16* bl0 = WRlo + (size_t)r32 * 1024 + 8 * hi;
    f32x16 acc0 = {}, acc1 = {}; float ssq = 0.f;
#pragma unroll 4
    for (int ks = 0; ks < 64; ++ks) {
        const v4u xa = *(const v4u*)(xr + ks * 16);
        f32x4 x0, x1; unpack8(xa, x0, x1);
        ssq += (x0[0] * x0[0] + x0[1] * x0[1]) + (x0[2] * x0[2] + x0[3] * x0[3]) + (x1[0] * x1[0] + x1[1] * x1[1]) + (x1[2] * x1[2] + x1[3] * x1[3]);
        const bf16x8 a_hi = __builtin_bit_cast(bf16x8, xa);
        const bf16x8 bh_0 = *(const bf16x8*)(bh0 + ks * 16), bh_1 = *(const bf16x8*)(bh0 + 32 * 1024 + ks * 16), bl_0 = *(const bf16x8*)(bl0 + ks * 16), bl_1 = *(const bf16x8*)(bl0 + 32 * 1024 + ks * 16);
        acc0 = __builtin_amdgcn_mfma_f32_32x32x16_bf16(a_hi, bh_0, acc0, 0, 0, 0); acc1 = __builtin_amdgcn_mfma_f32_32x32x16_bf16(a_hi, bh_1, acc1, 0, 0, 0);
        acc0 = __builtin_amdgcn_mfma_f32_32x32x16_bf16(a_hi, bl_0, acc0, 0, 0, 0); acc1 = __builtin_amdgcn_mfma_f32_32x32x16_bf16(a_hi, bl_1, acc1, 0, 0, 0);
    }
    ssq += __shfl_xor(ssq, 32);
    const float rs = 1.0f / sqrtf(ssq * (1.0f / DMODEL) + EPS);
#pragma unroll
    for (int r = 0; r < 16; ++r) { const int m = (r & 3) + 8 * (r >> 2) + 4 * hi; lg[m * 66 + r32] = acc0[r]; lg[m * 66 + 32 + r32] = acc1[r]; }
    asm volatile("s_waitcnt lgkmcnt(0)" ::: "memory");
    int ea = 0, eb = 0, cls = 0, lpa = 0, lpb = 0, lpc = 0; float wa = 0.f, wb = 0.f;
    if (lane < 32) {
        const LAS float* L = lg + lane * 66;
        float gl[4];
#pragma unroll
        for (int j = 0; j < 4; ++j) gl[j] = L[j] * rs + P.b_rg[j];
        int gs = 0; float gm = gl[0];
#pragma unroll
        for (int j = 1; j < 4; ++j) if (gl[j] > gm) { gm = gl[j]; gs = j; }
        float gsum = 0.f;
#pragma unroll
        for (int j = 0; j < 4; ++j) gsum += __expf(gl[j] - gm);
        const float gw = 1.0f / gsum;
        float l0 = -INFINITY, l1 = -INFINITY; int i0 = 0, i1 = 0;
#pragma unroll
        for (int j = 0; j < 8; ++j) { const float v = L[4 + gs * 8 + j] * rs + P.b_re[gs * 8 + j];
            if (v > l0) { l1 = l0; i1 = i0; l0 = v; i0 = j; } else if (v > l1) { l1 = v; i1 = j; } }
        const float q = __expf(l1 - l0), inv = 1.0f / (1.0f + q);
        const float w0 = inv * gw, w1 = q * inv * gw;
        const int a = min(i0, i1), b = max(i0, i1);
        wa = (i0 < i1) ? w0 : w1; wb = (i0 < i1) ? w1 : w0;
        ea = gs * 8 + a; eb = gs * 8 + b; cls = gs * 28 + (a * (15 - a)) / 2 + (b - a - 1);
        lpa = __hip_atomic_fetch_add(&hist[ea], 1, __ATOMIC_RELAXED, __HIP_MEMORY_SCOPE_WORKGROUP); lpb = __hip_atomic_fetch_add(&hist[eb], 1, __ATOMIC_RELAXED, __HIP_MEMORY_SCOPE_WORKGROUP);
        lpc = __hip_atomic_fetch_add(&hist2[cls], 1, __ATOMIC_RELAXED, __HIP_MEMORY_SCOPE_WORKGROUP);
    }
    __syncthreads();
    if (tid < 32) hbase[tid] = (int)atomicAdd(cnt + tid, (unsigned)hist[tid]);
    if (tid >= 64 && tid < 64 + NCLS) { const int c = tid - 64; const int n = hist2[c]; hbase2[c] = n ? (int)atomicAdd(ccnt + c, (unsigned)n) : 0; }
    __syncthreads();
    if (lane < 32) { const int t = tbase + lane; const int pa = hbase[ea] + lpa, pb = hbase[eb] + lpb, pc = hbase2[cls] + lpc;
        typedef int i32x4 __attribute__((ext_vector_type(4)));
        const int dst = (cls << 17) | (pc << 1);
        *(i32x4*)(LIST + (size_t)(ea * LCAP + pa) * 4) = (i32x4){t, dst, __float_as_int(wa), __float_as_int(rs)};
        *(i32x4*)(LIST + (size_t)(eb * LCAP + pb) * 4) = (i32x4){t, dst | 1, __float_as_int(wb), __float_as_int(rs)};
        CTOK[(size_t)cls * NTOK + pc] = t; }
    __syncthreads();
}

__device__ __forceinline__ void p5_convert(const Ptrs& P, LAS unsigned char* lds, int vcu, int G) {
    const int tid = tid_opaque(), lane = tid & 63, wave = __builtin_amdgcn_readfirstlane(tid >> 6);
    LAS float* scr = (LAS float*)(lds + wave * 16384);
    const int gw = vcu * NWAVES + wave, NGW = G * NWAVES;
    unsigned char* WGU = P.ws + WS_WGU; unsigned char* WD = P.ws + WS_WD;
    constexpr int I_G = (DMODEL / 64) * (DEXP / 32);
    constexpr int I_D = (DEXP / 64) * (DMODEL / 32);
    constexpr int PER_E = 2 * I_G + I_D;
    constexpr int NITEMS = NEXP * PER_E, NRW = (NTOK / 256) * NWAVES;
    const bool split = (G == 256) && (NITEMS == NRW * 8 + (256 * NWAVES - NRW) * 16);
    const bool rwg = (int)blockIdx.x < NTOK / 256; const int wv = ((int)blockIdx.x - (rwg ? 0 : NTOK / 256)) * NWAVES + wave;
    const int it0 = split ? (rwg ? wv : NRW * 8 + wv) : gw, itn = split ? (rwg ? NRW * 8 : NITEMS) : NITEMS, its = split ? NRW : NGW;
    struct Item { const float* W; int N, k0, n0; unsigned char* WT; int dpitch, drow0; const float* ks; float mul; };
    auto decode = [&](int it) { Item q; const int e = it / PER_E; int r = it % PER_E;
        if (r < 2 * I_G) { const int up = r / I_G; r %= I_G; const int kb = r / (DEXP / 32), nb = r % (DEXP / 32), n0 = nb * 32;
            q.W = (up ? P.w_up : P.w_gate) + (size_t)e * DMODEL * DEXP; q.N = DEXP; q.k0 = kb * 64; q.n0 = n0; q.WT = WGU + (size_t)e * 1024 * 1024; q.dpitch = 1024; q.drow0 = (n0 >> 7) * 256 + up * 128 + (n0 & 127); q.ks = P.ffn_norm_g; q.mul = 64.f;
        } else { r -= 2 * I_G; const int kb = r / (DMODEL / 32), nb = r % (DMODEL / 32);
            q.W = P.w_down + (size_t)e * DEXP * DMODEL; q.N = DMODEL; q.k0 = kb * 64; q.n0 = nb * 32; q.WT = WD + (size_t)e * 1024 * 512; q.dpitch = 512; q.drow0 = nb * 32; q.ks = nullptr; q.mul = 32.f; }
        return q; };
    for (int it = it0; it < itn; it += 4 * its) {
        const bool h1 = it + its < itn, h2 = it + 2 * its < itn, h3 = it + 3 * its < itn;
        const Item a = decode(it), b = decode(h1 ? it + its : it), c = decode(h2 ? it + 2 * its : it), d = decode(h3 ? it + 3 * its : it);
        f32x4 va[8], vb[8], vc[8], vd[8];
        t8_load(va, a.W, a.N, a.k0, a.n0, lane); t8_load(vb, b.W, b.N, b.k0, b.n0, lane); t8_load(vc, c.W, c.N, c.k0, c.n0, lane); t8_load(vd, d.W, d.N, d.k0, d.n0, lane);
        t8_finish(va, a.k0, a.WT, a.dpitch, a.drow0, a.ks, a.mul, scr, lane);
        if (h1) t8_finish(vb, b.k0, b.WT, b.dpitch, b.drow0, b.ks, b.mul, scr, lane);
        if (h2) t8_finish(vc, c.k0, c.WT, c.dpitch, c.drow0, c.ks, c.mul, scr, lane);
        if (h3) t8_finish(vd, d.k0, d.WT, d.dpitch, d.drow0, d.ks, d.mul, scr, lane);
    }
}

struct Args { Ptrs p; int ph_lo, ph_hi, use_cg, pad; };
__global__ void __launch_bounds__(NTHREADS, 2) mega_fwd(Args args) {
    extern __shared__ __attribute__((aligned(16))) unsigned char lds_raw[];
    LAS unsigned char* lds = (LAS unsigned char*)lds_raw;
    const Ptrs& P = args.p;
    const int tid = tid_opaque();
    const int G = gridDim.x, bx = blockIdx.x; const int vcu = (G % 8 == 0) ? (bx % 8) * (G / 8) + bx / 8 : bx;
    const int lo = args.ph_lo, hi = args.ph_hi;
    LAS int* meta = (LAS int*)(lds + META_OFF);
    if (tid < 2) ((volatile LAS unsigned*)(lds + BARST_OFF))[tid] = 0u;
    __syncthreads();
    XcdBarrier bar = xcd_barrier_post((unsigned*)(P.ws + WS_CTL) + 1024, (volatile LAS unsigned*)(lds + BARST_OFF));
#ifndef PHASE_MASK
#define PHASE_MASK 0xff
#endif
#ifndef DUP_PHASE
#define DUP_PHASE -1
#endif
#define REPS(k) for (int rep_ = 0; rep_ < ((DUP_PHASE == (k)) ? 2 : 1); ++rep_)
#define REPBAR() do { if (rep_) xcd_barrier(bar); } while (0)
#define IN(k) (((PHASE_MASK >> (k)) & 1) && lo <= (k) && (k) < hi)
#define SEAM(k) do { if (IN(k) && IN((k) + 1)) xcd_barrier(bar); } while (0)
    bf16* WS16 = (bf16*)P.ws;
    if (IN(0)) REPS(0) { REPBAR(); p0_prologue(P, lds, vcu, G); }
    SEAM(0);
    if (IN(1)) REPS(1) { REPBAR();
        pg8::Gemm g{(const bf16*)(P.ws + WS_A), (const bf16*)(P.ws + WS_WIN), DMODEL, 0, nullptr};
        pg8::StaticOrder S; S.init(NTOK, IN_COLS, G, bx);
        LAS float* gl = (LAS float*)(lds + RING_BYTES + 8192);
        if (tid < 128) gl[tid] = (tid < 64) ? P.q_norm_g[tid] : P.k_norm_g[tid - 64];
        __syncthreads();
        EpiInProj E{(bf16*)(P.ws + WS_YG), (bf16*)(P.ws + WS_QB), (bf16*)(P.ws + WS_KB), (bf16*)(P.ws + WS_VB), (bf16*)(P.ws + WS_GT), gl};
#if defined(DUMP_SEL) && DUMP_SEL == 5
        EpiRaw ER{(bf16*)(P.ws + WS_QB)};
        pg8::gemm_phase<EpiRaw, pg8::StaticOrder, false, true>(lds, g, S, ER);
#else
        pg8::gemm_phase<EpiInProj, pg8::StaticOrder, false, true>(lds, g, S, E);
#endif
    }
    SEAM(1);
    if (IN(2)) {
        REPS(2) { REPBAR();
        for (int p = vcu; p < 256; p += G) attn_pair(P, lds, (char*)lds_raw, p);
        __syncthreads(); }
        REPS(20) { REPBAR();
        conv_phase(P, lds, bx, G); }
    }
    SEAM(2);
    if (IN(3)) REPS(3) { REPBAR();
        pg8::Gemm g{(const bf16*)(P.ws + WS_CA), (const bf16*)(P.ws + WS_WCA), DMODEL, 0, nullptr};
        pg8::StaticOrder S; S.init(NTOK, DMODEL, G, bx);
        EpiMerged E{(const bf16*)(P.ws + WS_GT), (const bf16*)(P.ws + WS_GT) + (size_t)NTOK * 1024, (bf16*)(P.ws + WS_MG)};
#ifdef SKEW3
        if ((bx >> 3) & 1) { const unsigned long long t0 = __builtin_amdgcn_s_memrealtime(); while ((long long)(__builtin_amdgcn_s_memrealtime() - t0) < SKEW3) __builtin_amdgcn_s_sleep(8); }
#endif
        pg8::gemm_phase<EpiMerged, pg8::StaticOrder, false, true>(lds, g, S, E);
    }
    SEAM(3);
    if (IN(4)) REPS(4) { REPBAR();
        pg8::Gemm g{(const bf16*)(P.ws + WS_MG), (const bf16*)(P.ws + WS_WOUT), DMODEL, 0, nullptr};
        pg8::StaticOrder S; S.init(NTOK, DMODEL, G, bx);
        EpiOut E{P.x, (bf16*)(P.ws + WS_CA), P.ws + WS_XM};
        pg8::gemm_phase<EpiOut, pg8::StaticOrder, false, true>(lds, g, S, E);
    }
    SEAM(4);
    if (IN(5)) {
        for (int t = bx; t < NTOK / 256; t += G) router_tile(P, lds, t);
        REPS(5) { REPBAR(); p5_convert(P, lds, vcu, G); }
    }
    SEAM(5);
    LAS int* meta2 = (LAS int*)(lds + META2_OFF);
    if (IN(6)) REPS(6) { REPBAR();
        moe_meta(meta, meta2, (const unsigned*)(P.ws + WS_CTL));
        pg8::Gemm g{(const bf16*)(P.ws + WS_XM), (const bf16*)(P.ws + WS_WGU), DMODEL / 2, (size_t)1024 * 1024, (const int*)(P.ws + WS_LIST), 4};
        MoeOrder S{G, vcu, __builtin_amdgcn_readfirstlane(meta[NEXP]), meta};
        EpiGateUp E{(const int*)(P.ws + WS_LIST), P.ws + WS_A, meta2};
        pg8::gemm_phase<EpiGateUp, MoeOrder, true, true, true>(lds, g, S, E);
    }
    SEAM(6);
    if (IN(7)) REPS(7) { REPBAR();
        moe_meta(meta, meta2, (const unsigned*)(P.ws + WS_CTL));
        pg8::Gemm g{(const bf16*)(P.ws + WS_A), (const bf16*)(P.ws + WS_WD), DMODEL / 2, (size_t)1024 * 512, nullptr, 0, DEXP / 2};
        ClassOrder S{G, vcu, __builtin_amdgcn_readfirstlane(meta2[NCLS]), meta2};
        EpiDownAdd E{(const int*)(P.ws + WS_CTOK), (const bf16*)(P.ws + WS_CA), P.out};
        pg8::gemm_phase<EpiDownAdd, ClassOrder, false, true, true, true>(lds, g, S, E);
    }
#if defined(DUMP_SEL)
    xcd_barrier(bar);
    { const bf16* YG = (const bf16*)(P.ws + WS_YG); const bf16* QB = (const bf16*)(P.ws + WS_QB); const bf16* KB = (const bf16*)(P.ws + WS_KB); const bf16* VB = (const bf16*)(P.ws + WS_VB);
      const bf16* GT = (const bf16*)(P.ws + WS_GT); const bf16* CA = (const bf16*)(P.ws + WS_CA); const bf16* MG = (const bf16*)(P.ws + WS_MG);
      for (size_t i = (size_t)bx * NTHREADS + tid; i < (size_t)NTOK * 1024; i += (size_t)G * NTHREADS) { const size_t t = i >> 10; const int c = (int)(i & 1023); float v = 0.f;
#if DUMP_SEL == 1
          v = bf_lo(YG[t * 512 + (c & 511)]) + bf_lo(QB[t * 512 + (c & 511)]) + 2.f * bf_lo(KB[t * 512 + (c & 511)]) + 3.f * bf_lo(VB[t * 512 + (c & 511)]) + bf_lo(GT[t * 2048 + c]) + bf_lo(GT[t * 2048 + 1024 + c]);
#elif DUMP_SEL == 2
          v = bf_lo(CA[t * 1024 + c]);
#elif DUMP_SEL == 4
          { const bf16* HB = (const bf16*)(P.ws + WS_A); const bf16* WIN = (const bf16*)(P.ws + WS_WIN); v = bf_lo(HB[i]) + 30.f * bf_lo(WIN[i % ((size_t)IN_COLS * 1024)]); }
#elif DUMP_SEL == 5
          { const bf16* R = (const bf16*)(P.ws + WS_QB); v = bf_lo(R[t * 4608 + c]) + bf_lo(R[t * 4608 + 1024 + c]) + bf_lo(R[t * 4608 + 2048 + c]) + bf_lo(R[t * 4608 + 3072 + c]) + bf_lo(R[t * 4608 + 4096 + (c & 511)]); }
#elif DUMP_SEL == 3
          v = bf_lo(MG[t * 1024 + c]);
#endif
          P.out[i] = v; } }
#endif
    (void)WS16;
#undef IN
#undef SEAM
}

extern "C" void kernel_launch(void* const* d_in, const int* in_sizes, int n_in, void* d_out, int out_size, void* d_ws, size_t ws_size, hipStream_t stream) {
    static int grid = 0;
    if (grid == 0) {
        if (n_in != 25 || in_sizes[0] != NTOK * DMODEL || out_size != NTOK * DMODEL || ws_size < WS_END) {
            fprintf(stderr, "kernel_launch: unexpected shapes (n_in %d, in0 %d, out %d, ws %zu); nothing launched\n", n_in, n_in > 0 ? in_sizes[0] : -1, out_size, ws_size); grid = -1; return; }
        int dev = 0, cus = 0, per_cu = 0;
        if (hipGetDevice(&dev) != hipSuccess || hipDeviceGetAttribute(&cus, hipDeviceAttributeMultiprocessorCount, dev) != hipSuccess) { grid = -1; return; }
        if (hipFuncSetAttribute((const void*)mega_fwd, hipFuncAttributeMaxDynamicSharedMemorySize, LDS_BYTES) != hipSuccess) { fprintf(stderr, "kernel_launch: hipFuncSetAttribute failed\n"); grid = -1; return; }
        if (hipOccupancyMaxActiveBlocksPerMultiprocessor(&per_cu, (const void*)mega_fwd, NTHREADS, LDS_BYTES) != hipSuccess || per_cu < 1) { fprintf(stderr, "kernel_launch: the occupancy query reports %d workgroups per CU for this kernel and LDS size; nothing launched\n", per_cu); grid = -1; return; }
        (void)hipGetLastError();
        grid = cus;
    }
    if (grid < 0) return;
    (void)hipMemsetAsync((char*)d_ws + WS_CTL, 0, CTL_ZERO_BYTES, stream);
    Args a{};
    const float** pp = (const float**)&a.p;
    for (int i = 0; i < 25; ++i) pp[i] = (const float*)d_in[i];
    a.p.out = (float*)d_out; a.p.ws = (unsigned char*)d_ws;
#if MK_PER_PHASE
    for (int ph = 0; ph < N_PHASES; ++ph) { a.ph_lo = ph; a.ph_hi = ph + 1; void* params[] = {&a};
        hipError_t e = hipLaunchCooperativeKernel((const void*)mega_fwd, dim3(grid), dim3(NTHREADS), params, LDS_BYTES, stream);
        if (e != hipSuccess) { fprintf(stderr, "launch %d failed: %s\n", ph, hipGetErrorString(e)); break; } }
#else
    a.ph_lo = 0; a.ph_hi = N_PHASES; void* params[] = {&a};
    hipError_t e = hipLaunchCooperativeKernel((const void*)mega_fwd, dim3(grid), dim3(NTHREADS), params, LDS_BYTES, stream);
    if (e != hipSuccess) fprintf(stderr, "cooperative launch failed: %s (grid %d)\n", hipGetErrorString(e), grid);
#endif
}
```

```cpp
#include <hip/hip_runtime.h>
#include <hip/hip_bf16.h>
#include <hip/hip_cooperative_groups.h>
#include <cstdio>
#include <cstdint>
#include <cmath>
namespace cg = cooperative_groups;
__device__ __forceinline__ int tid_opaque() { int t = threadIdx.x; asm volatile("" : "+v"(t)); return t; }

constexpr int BATCH = 8, SEQ = 4096, DMODEL = 1024, NTOK = BATCH * SEQ;
constexpr int CONV_CH = 512, CONV_W = 31, NHEADS = 4, IN_COLS = 4608;
constexpr int NEXP = 32, DEXP = 512, LCAP = NTOK;
constexpr int NCLS = 4 * 28;
constexpr int CROWS = NTOK + NCLS * 256;
constexpr int MOE_ROWS = 2 * NTOK + NEXP * 256;
constexpr float EPS = 1e-6f;

namespace pg8 {
#define PG8_LAS __attribute__((address_space(3)))
typedef unsigned short bf16_t;
typedef short bf16x8 __attribute__((ext_vector_type(8)));
typedef float f32x4 __attribute__((ext_vector_type(4)));
typedef unsigned u32x4 __attribute__((ext_vector_type(4)));
constexpr int BM = 256, BK = 64, HALF = 128, HTB = HALF * BK * 2  , STAGE_BYTES = 8 * HTB, NXCD = 8, WGM = 8;

__host__ __device__ __forceinline__ int lds_byte(int r, int c) { const int st = (r >> 4) * 2 + (c >> 5), rr = r & 15, cc = c & 31, ob = rr * 64 + cc * 2; return st * 1024 + (ob ^ (((ob >> 9) & 1) << 5)); }
__host__ __device__ __forceinline__ void stage_rc(int b, int& R, int& C) { const int st = b / 1024, sb = b % 1024, swz = sb ^ (((sb >> 9) & 1) << 5); R = (st >> 1) * 16 + swz / 64; C = (st & 1) * 32 + (swz % 64) / 2; }
__host__ __device__ __forceinline__ int perm32(int rho) { const int n = rho >> 4, i = rho & 15; return 8 * (i >> 2) + 4 * n + (i & 3); }

struct Unit { int pm, pn, arow, e, e2, lrow, nvalid, orow; };
struct Gemm { const bf16_t* A; const bf16_t* Bt; int K; size_t bstride; const int* list; int lstride; int KBrow; };

struct StaticOrder {
    int nM, nN, nwg, G, c;
    __device__ void init(int M, int N, int G_, int c_) { nM = M / BM; nN = N / BM; nwg = nM * nN; G = G_; c = c_; }
    __device__ bool next(int i, Unit& u) const {
        const long L = (long)i * G + c; if (L >= nwg) return false;
        int wgid = (int)L; { const int q = nwg / NXCD, r = nwg % NXCD, xcd = wgid % NXCD, off = wgid / NXCD; wgid = (xcd < r ? xcd * (q + 1) : r * (q + 1) + (xcd - r) * q) + off; }
        const int nig = WGM * nN, gid = wgid / nig, fm = gid * WGM, gsz = (nM - fm) < WGM ? (nM - fm) : WGM;
        u.pm = fm + ((wgid % nig) % gsz); u.pn = (wgid % nig) / gsz; u.arow = u.pm * BM; u.orow = u.arow; u.e = 0; u.e2 = 0; u.lrow = 0; u.nvalid = BM; return true;
    }
};

typedef float f32x2_t __attribute__((ext_vector_type(2))); typedef __bf16 bf16x2_t __attribute__((ext_vector_type(2)));
__device__ __forceinline__ unsigned cvt_pk_bf16(float lo, float hi) { const f32x2_t v = {lo, hi}; const bf16x2_t b = __builtin_convertvector(v, bf16x2_t); return __builtin_bit_cast(unsigned, b); }
typedef int v8i_t __attribute__((ext_vector_type(8))); typedef int v4i_t __attribute__((ext_vector_type(4)));
__device__ __forceinline__ v8i_t cat8(const bf16x8 a, const bf16x8 b) { const v4i_t x = __builtin_bit_cast(v4i_t, a), y = __builtin_bit_cast(v4i_t, b); return (v8i_t){x[0], x[1], x[2], x[3], y[0], y[1], y[2], y[3]}; }
__device__ __forceinline__ unsigned pack4_fp8(float a, float b, float c, float d) { int w = 0; w = __builtin_amdgcn_cvt_pk_fp8_f32(a, b, w, false); w = __builtin_amdgcn_cvt_pk_fp8_f32(c, d, w, true); return (unsigned)w; }
__device__ __forceinline__ float bf_lo(unsigned w) { return __uint_as_float(w << 16); }
__device__ __forceinline__ float bf_hi(unsigned w) { return __uint_as_float(w & 0xffff0000u); }
__device__ __forceinline__ float sigmoidf_fast(float x) { return __builtin_amdgcn_rcpf(1.0f + __builtin_amdgcn_exp2f(-1.4426950408889634f * x)); }
__device__ __forceinline__ u32x4 pack8(const f32x4 a, const f32x4 b) { u32x4 w; w.x = cvt_pk_bf16(a[0], a[1]); w.y = cvt_pk_bf16(a[2], a[3]); w.z = cvt_pk_bf16(b[0], b[1]); w.w = cvt_pk_bf16(b[2], b[3]); return w; }
__device__ __forceinline__ void unpack8(const u32x4 w, f32x4& a, f32x4& b) { a = (f32x4){bf_lo(w.x), bf_hi(w.x), bf_lo(w.y), bf_hi(w.y)}; b = (f32x4){bf_lo(w.z), bf_hi(w.z), bf_lo(w.w), bf_hi(w.w)}; }

template <class Epi, class Sched, bool GATHER, bool ALIGN_EPI, bool FP8 = false, bool BSPLIT = false>
__device__ __forceinline__ void gemm_phase(PG8_LAS unsigned char* lds, const Gemm g, const Sched& S, const Epi& E) {
    const int tid = tid_opaque(), wid = __builtin_amdgcn_readfirstlane(tid >> 6), lane = tid & 63, wr = wid >> 2, wc = wid & 3, fr = lane & 15, fq = lane >> 4;
    const int K = g.K, nt = K / BK, KBp = g.KBrow ? g.KBrow : K;
    unsigned voffB[2]; int Ra[2], Ca[2];
#pragma unroll
    for (int i = 0; i < 2; ++i) { int R, C; stage_rc(tid * 16 + i * 8192, R, C); const int Rb = (R & ~31) + perm32(R & 31); Ra[i] = R; Ca[i] = C; voffB[i] = (unsigned)(Rb * KBp + C) * 2u; }
    const unsigned kstep = (unsigned)(BK * 2);
    const unsigned hstep = (unsigned)HALF * KBp * 2;
    const unsigned tstep = 2 * hstep;
    const char* const gA = (const char*)g.A; const char* const gB = (const char*)g.Bt;
    const unsigned ldsw = (unsigned)wid * 1024u;
    const int aoff = lds_byte(wr * 64 + fr, fq * 8), boff = lds_byte(wc * 32 + fr, fq * 8);
#define PG8_SA(b, h) (((b) * 2 + (h)) * HTB)
#define PG8_SB(b, h) ((4 + (b) * 2 + (h)) * HTB)
#define PG8_STAGE(bufoff, gbase, uoff, voff) do { _Pragma("unroll") for (int _i = 0; _i < 2; ++_i) \
        __builtin_amdgcn_global_load_lds((const unsigned*)((const char*)(gbase) + (unsigned)((uoff) + (voff)[_i])), (PG8_LAS unsigned*)(lds + (bufoff) + ldsw + _i * 8192), 16, 0, 0); } while (0)
#define PG8_LDA(dst, b, h) do { _Pragma("unroll") for (int m = 0; m < 4; ++m) _Pragma("unroll") for (int k = 0; k < 2; ++k) dst[m][k] = *(const PG8_LAS bf16x8*)(lds + PG8_SA(b, h) + aoff + m * 2048 + k * 1024); } while (0)
#define PG8_LDB(dst, b, h) do { _Pragma("unroll") for (int n = 0; n < 2; ++n) _Pragma("unroll") for (int k = 0; k < 2; ++k) dst[n][k] = *(const PG8_LAS bf16x8*)(lds + PG8_SB(b, h) + boff + n * 2048 + k * 1024); } while (0)
#define PG8_MMA(ai, bj, At, Bt) do { __builtin_amdgcn_s_setprio(1); \
        if constexpr (FP8) { _Pragma("unroll") for (int m = 0; m < 4; ++m) _Pragma("unroll") for (int n = 0; n < 2; ++n) \
            asm volatile("v_mfma_scale_f32_16x16x128_f8f6f4 %0, %1, %2, %0, %3, %3 op_sel_hi:[0,0,0]" : "+v"(acc[ai][bj][m][n]) : "v"(cat8(Bt[n][0], Bt[n][1])), "v"(cat8(At[m][0], At[m][1])), "v"(one_e8m0)); } \
        else { _Pragma("unroll") for (int m = 0; m < 4; ++m) _Pragma("unroll") for (int n = 0; n < 2; ++n) _Pragma("unroll") for (int k = 0; k < 2; ++k) \
            acc[ai][bj][m][n] = __builtin_amdgcn_mfma_f32_16x16x32_bf16(Bt[n][k], At[m][k], acc[ai][bj][m][n], 0, 0, 0); } \
        __builtin_amdgcn_s_setprio(0); } while (0)
#define PG8_WAIT_V(n) asm volatile("s_waitcnt vmcnt(" #n ")" ::: "memory")
#define PG8_WAIT_L(n) asm volatile("s_waitcnt lgkmcnt(" #n ")" ::: "memory")
#define PG8_BAR __builtin_amdgcn_s_barrier()
#define PG8_SCHED __builtin_amdgcn_sched_barrier(0)
#define PG8_LOAD_VA(dst, u) do { _Pragma("unroll") for (int _h = 0; _h < 2; ++_h) _Pragma("unroll") for (int _i = 0; _i < 2; ++_i) { const int _row = _h * HALF + Ra[_i]; \
        if constexpr (GATHER) { const int _tok = (_row < (u).nvalid) ? g.list[((u).lrow + _row) * g.lstride] : 0; dst[_h][_i] = (unsigned)(_tok * K + Ca[_i]) * 2u; } \
        else dst[_h][_i] = (unsigned)(_row * K + Ca[_i]) * 2u; } } while (0)
    Unit cur, nxt; int ui = 0;
    if (!S.next(0, cur)) return;
    typename Epi::Pre pre{};
    unsigned vAc[2][2], vAn[2][2];
    PG8_LOAD_VA(vAc, cur);
    f32x4 acc[2][2][4][2];
#pragma unroll
    for (int a = 0; a < 2; ++a)
#pragma unroll
        for (int b = 0; b < 2; ++b)
#pragma unroll
            for (int m = 0; m < 4; ++m)
#pragma unroll
                for (int n = 0; n < 2; ++n) acc[a][b][m][n] = (f32x4){0.f, 0.f, 0.f, 0.f};
    bf16x8 At[4][2], B0[2][2], B1[2][2];
    const int one_e8m0 = 0x7f7f7f7f; (void)one_e8m0;
    unsigned cA = (unsigned)cur.arow * K * 2, cB = (unsigned)cur.e * (unsigned)g.bstride + (unsigned)cur.pn * tstep;
    unsigned cB2 = (unsigned)cur.e2 * (unsigned)g.bstride + (unsigned)cur.pn * tstep; const unsigned hk = (unsigned)(nt / 2) * kstep; (void)cB2; (void)hk;
    PG8_STAGE(PG8_SB(0, 0), gB, cB, voffB); PG8_STAGE(PG8_SB(0, 1), gB, cB + hstep, voffB); PG8_STAGE(PG8_SA(0, 0), gA, cA, vAc[0]); PG8_STAGE(PG8_SA(0, 1), gA, cA, vAc[1]);
    if (wr == 1) PG8_BAR;
    PG8_WAIT_V(2); PG8_BAR;
    PG8_STAGE(PG8_SB(1, 0), gB, cB + kstep, voffB); PG8_STAGE(PG8_SA(1, 0), gA, cA + kstep, vAc[0]); PG8_STAGE(PG8_SB(1, 1), gB, cB + hstep + kstep, voffB);
    PG8_WAIT_V(6); PG8_BAR;
    for (;;) {
        const bool has_next = S.next(ui + 1, nxt);
        const unsigned nA = has_next ? (unsigned)nxt.arow * K * 2 : cA;
        const unsigned nB = has_next ? (unsigned)nxt.e * (unsigned)g.bstride + (unsigned)nxt.pn * tstep : cB;
        const unsigned nB2 = has_next ? (unsigned)nxt.e2 * (unsigned)g.bstride + (unsigned)nxt.pn * tstep : cB2; (void)nB2;
        if (has_next) { PG8_LOAD_VA(vAn, nxt); }
        else {
#pragma unroll
            for (int h = 0; h < 2; ++h)
#pragma unroll
                for (int i = 0; i < 2; ++i) vAn[h][i] = vAc[h][i]; }
#pragma unroll 1
        for (int t = 0; t < nt; t += 2) {
            const bool last = (t == nt - 2);
            if constexpr (Epi::MID) { if (t == nt / 2) E.mid(acc, cur, wr, wc, fr, fq); }
            if constexpr (Epi::PREMID) { if (t == nt / 2) pre = E.pre(cur, wr, fr); }
            const unsigned a1 = cA + (unsigned)(t + 1) * kstep;
            const unsigned a2 = last ? nA : cA + (unsigned)(t + 2) * kstep;
            unsigned b2 = last ? nB : cB + (unsigned)(t + 2) * kstep;
            if constexpr (BSPLIT) { if (!last && t + 2 >= nt / 2) b2 = cB2 + (unsigned)(t + 2) * kstep - hk; }
            const unsigned a3 = a2 + kstep, b3 = b2 + kstep;
            unsigned v2[2][2];
#pragma unroll
            for (int h = 0; h < 2; ++h)
#pragma unroll
                for (int i = 0; i < 2; ++i) v2[h][i] = vAc[h][i];
            if (last) { asm volatile("" ::: "memory");
#pragma unroll
                for (int h = 0; h < 2; ++h)
#pragma unroll
                    for (int i = 0; i < 2; ++i) v2[h][i] = vAn[h][i]; }
            PG8_LDB(B0, 0, 0); PG8_LDB(B1, 0, 1); PG8_SCHED; PG8_LDA(At, 0, 0); PG8_STAGE(PG8_SA(1, 1), gA, a1, vAc[1]);
            PG8_WAIT_V(8); PG8_WAIT_L(0); PG8_BAR; PG8_MMA(0, 0, At, B0); PG8_MMA(0, 1, At, B1); PG8_BAR; PG8_SCHED;
            PG8_LDA(At, 0, 1); PG8_STAGE(PG8_SB(0, 0), gB, b2, voffB); PG8_STAGE(PG8_SB(0, 1), gB, b2 + hstep, voffB); PG8_STAGE(PG8_SA(0, 0), gA, a2, v2[0]);
            PG8_WAIT_V(8); PG8_WAIT_L(0); PG8_BAR; PG8_MMA(1, 0, At, B0); PG8_MMA(1, 1, At, B1); PG8_BAR; PG8_SCHED;
            PG8_LDB(B0, 1, 0); PG8_LDB(B1, 1, 1); PG8_SCHED; PG8_LDA(At, 1, 0); PG8_STAGE(PG8_SA(0, 1), gA, a2, v2[1]);
            PG8_WAIT_V(8); PG8_WAIT_L(0); PG8_BAR; PG8_MMA(0, 0, At, B0); PG8_MMA(0, 1, At, B1); PG8_BAR; PG8_SCHED;
            PG8_LDA(At, 1, 1); PG8_STAGE(PG8_SB(1, 0), gB, b3, voffB); PG8_STAGE(PG8_SB(1, 1), gB, b3 + hstep, voffB); PG8_STAGE(PG8_SA(1, 0), gA, a3, v2[0]);
            PG8_WAIT_V(8); PG8_WAIT_L(0); PG8_BAR; PG8_MMA(1, 0, At, B0); PG8_MMA(1, 1, At, B1); PG8_BAR; PG8_SCHED;
        }
        if constexpr (ALIGN_EPI) { if (wr == 0) PG8_BAR; }
        if constexpr (FP8) asm volatile("s_nop 15\n\ts_nop 15\n\ts_nop 15\n\ts_nop 15" ::: "memory");
        if constexpr (Epi::PREMID) E(acc, cur, wr, wc, fr, fq, pre); else E(acc, cur, wr, wc, fr, fq, E.pre(cur, wr, fr));
        if (!has_next) break;
#pragma unroll
        for (int a = 0; a < 2; ++a)
#pragma unroll
            for (int b = 0; b < 2; ++b)
#pragma unroll
                for (int m = 0; m < 4; ++m)
#pragma unroll
                    for (int n = 0; n < 2; ++n) acc[a][b][m][n] = (f32x4){0.f, 0.f, 0.f, 0.f};
        cur = nxt; cA = nA; cB = nB; cB2 = nB2; ++ui;
#pragma unroll
        for (int h = 0; h < 2; ++h)
#pragma unroll
            for (int i = 0; i < 2; ++i) vAc[h][i] = vAn[h][i];
        if constexpr (ALIGN_EPI) { if (wr == 1) PG8_BAR; }
    }
    PG8_WAIT_V(0);
    if constexpr (!ALIGN_EPI) { if (wr == 0) PG8_BAR; }
    PG8_BAR;
#undef PG8_SA
#undef PG8_SB
#undef PG8_STAGE
#undef PG8_LDA
#undef PG8_LDB
#undef PG8_MMA
#undef PG8_WAIT_V
#undef PG8_WAIT_L
#undef PG8_BAR
#undef PG8_SCHED
#undef PG8_LOAD_VA
}
}

namespace attn_body {
using bf16=__hip_bfloat16;
using bf16x8=__attribute__((ext_vector_type(8)))short;
using s16x4=__attribute__((ext_vector_type(4)))short;
using f32x16=__attribute__((ext_vector_type(16)))float;
using u32x4=__attribute__((ext_vector_type(4)))unsigned;
constexpr int D=64, QP=512, KP=512, VP=512, OP=1024;
constexpr int NW=8,QBLK=32,QB=QBLK*NW,KVBLK=64;
constexpr int ATTN_UNIT_ROWS=QB;
__device__ __forceinline__ int crow(int r,int hi){return (r&3)+8*(r>>2)+4*hi;}
#define SBAR() __builtin_amdgcn_sched_barrier(0)
__device__ __forceinline__ void cmask(f32x16&p0,f32x16&p1,int jb,int qrel,int hi){
  const float NEG=-INFINITY; int kb=64*jb+4*hi;
  #pragma unroll
  for(int r=0;r<16;++r){int kv=kb+(r&3)+8*(r>>2); if(kv>qrel)p0[r]=NEG; if(kv+32>qrel)p1[r]=NEG;}
}

constexpr int NSLOT=3, SLOTB=8192, VSLOTB=16384;
constexpr int LDS_K=0, LDS_V=NSLOT*SLOTB, LDS_WS=LDS_V+NSLOT*VSLOTB, LDS_OST=LDS_WS+NW*64*4, LDS_BYTES=LDS_OST+NW*4096;
constexpr float C2=0.125f*1.4426950408889634f;
__device__ __forceinline__ void glds16(const void*gsrc,unsigned lds_dst){unsigned keep;
  asm volatile("s_mov_b32 %0, m0\n\ts_mov_b32 m0, %2\n\ts_nop 0\n\tglobal_load_lds_dwordx4 %1, off\n\ts_mov_b32 m0, %0":"=&s"(keep):"v"(gsrc),"s"(lds_dst):"memory");}
__device__ __forceinline__ float max3f(float a,float b,float c){float r;asm("v_max3_f32 %0, %1, %2, %3":"=v"(r):"v"(a),"v"(b),"v"(c));return r;}
__device__ __forceinline__ float max2f(float a,float b){float r;asm("v_max_f32_e32 %0, %1, %2":"=v"(r):"v"(a),"v"(b));return r;}
__device__ __forceinline__ float fadd_s(float a,float b){float r;asm("v_add_f32_e32 %0, %1, %2":"=v"(r):"v"(a),"v"(b));return r;}
__device__ __forceinline__ float fsub_s(float a,float b){float r;asm("v_sub_f32_e32 %0, %1, %2":"=v"(r):"v"(a),"v"(b));return r;}
typedef float f32x2_t __attribute__((ext_vector_type(2))); typedef __bf16 bf16x2_t __attribute__((ext_vector_type(2)));
__device__ __forceinline__ unsigned cvtpk_s(float lo,float hi){f32x2_t v={lo,hi};bf16x2_t b=__builtin_convertvector(v,bf16x2_t);return __builtin_bit_cast(unsigned,b);}
#define WAIT_BAR(N) asm volatile("s_waitcnt vmcnt(" #N ") lgkmcnt(0)\n\ts_barrier":::"memory")

__device__ __forceinline__ void qkt(f32x16&p0,f32x16&p1,const char*Kslot,const bf16x8*qr,const f32x16&negm,int r32,int hi){
  const char*kb=Kslot+hi*1024+r32*16;
  #pragma unroll
  for(int d0=0;d0<4;++d0){
    const bf16x8 b0=*reinterpret_cast<const bf16x8*>(kb+d0*2048);
    const bf16x8 b1=*reinterpret_cast<const bf16x8*>(kb+d0*2048+512);
    if(d0==0){p0=__builtin_amdgcn_mfma_f32_32x32x16_bf16(b0,qr[0],negm,0,0,0);p1=__builtin_amdgcn_mfma_f32_32x32x16_bf16(b1,qr[0],negm,0,0,0);}
    else{p0=__builtin_amdgcn_mfma_f32_32x32x16_bf16(b0,qr[d0],p0,0,0,0);p1=__builtin_amdgcn_mfma_f32_32x32x16_bf16(b1,qr[d0],p1,0,0,0);}}
}
typedef __attribute__((address_space(3))) const char* lds_cptr;
typedef short v4i16_t __attribute__((ext_vector_type(4)));
__device__ __forceinline__ void kload8(bf16x8*kf,lds_cptr kp){
  kf[0]=*(const __attribute__((address_space(3))) bf16x8*)(kp);      kf[1]=*(const __attribute__((address_space(3))) bf16x8*)(kp+512);
  kf[2]=*(const __attribute__((address_space(3))) bf16x8*)(kp+2048); kf[3]=*(const __attribute__((address_space(3))) bf16x8*)(kp+2560);
  kf[4]=*(const __attribute__((address_space(3))) bf16x8*)(kp+4096); kf[5]=*(const __attribute__((address_space(3))) bf16x8*)(kp+4608);
  kf[6]=*(const __attribute__((address_space(3))) bf16x8*)(kp+6144); kf[7]=*(const __attribute__((address_space(3))) bf16x8*)(kp+6656);
}
__device__ __forceinline__ void kload2(bf16x8*kf,lds_cptr kp,int j){ kf[2*j]=*(const __attribute__((address_space(3))) bf16x8*)(kp+j*2048); kf[2*j+1]=*(const __attribute__((address_space(3))) bf16x8*)(kp+j*2048+512); }
__device__ __forceinline__ s16x4 vtr(lds_cptr p){ return __builtin_bit_cast(s16x4,__builtin_amdgcn_ds_read_tr16_b64_v4i16((__attribute__((address_space(3))) v4i16_t*)p)); }
__device__ __forceinline__ float rowmax(const f32x16&p0,const f32x16&p1){
  float a=max3f(p0[0],p0[1],p1[0]),b=max3f(p0[2],p0[3],p1[1]);a=max3f(a,p1[2],p1[3]);
  #pragma unroll
  for(int r=4;r<16;r+=4){a=max3f(a,p0[r],p0[r+1]);b=max3f(b,p0[r+2],p0[r+3]);a=max3f(a,p1[r],p1[r+1]);b=max3f(b,p1[r+2],p1[r+3]);}
  const float m=max2f(a,b);
  auto rr=__builtin_amdgcn_permlane32_swap(__float_as_uint(m),__float_as_uint(m),false,false);
  return max2f(__uint_as_float(rr[0]),__uint_as_float(rr[1]));
}
__device__ __forceinline__ void pv(f32x16*o,int vb,bf16x8 pa0,bf16x8 pa1,bf16x8 pa2,bf16x8 pa3){
  #pragma unroll
  for(int d0=0;d0<4;++d0){s16x4 lo[4],hi[4];
    #pragma unroll
    for(int ks=0;ks<4;++ks){
      asm volatile("ds_read_b64_tr_b16 %0,%1 offset:%c2":"=&v"(lo[ks]):"v"(vb),"i"(d0*4096+ks*1024):"memory");
      asm volatile("ds_read_b64_tr_b16 %0,%1 offset:%c2":"=&v"(hi[ks]):"v"(vb),"i"(d0*4096+ks*1024+512):"memory");}
    asm volatile("s_waitcnt lgkmcnt(0)":::"memory");SBAR();
    #define PK(k) (bf16x8){lo[k][0],lo[k][1],lo[k][2],lo[k][3],hi[k][0],hi[k][1],hi[k][2],hi[k][3]}
    o[d0]=__builtin_amdgcn_mfma_f32_32x32x16_bf16(pa0,PK(0),o[d0],0,0,0);
    o[d0]=__builtin_amdgcn_mfma_f32_32x32x16_bf16(pa1,PK(1),o[d0],0,0,0);
    o[d0]=__builtin_amdgcn_mfma_f32_32x32x16_bf16(pa2,PK(2),o[d0],0,0,0);
    o[d0]=__builtin_amdgcn_mfma_f32_32x32x16_bf16(pa3,PK(3),o[d0],0,0,0);
    #undef PK
  }
}

#ifndef ATTN_STORE16
#define ATTN_STORE16(p,v) (*(u32x4*)(p)=(v))
#endif
template<int THRL,bool STAT> __device__ __forceinline__ int attn_unit(float mstat,int q0,const bf16*Q,const bf16*__restrict__ K,const bf16*__restrict__ V,bf16*O,char*shm,const bf16*O1,float lam,const float*subg,unsigned short*CAo,const bf16*Knext,const bf16*Vnext,int s0,bool pre){
  #define NXT_(x) (((x)==(NSLOT-1)*SLOTB)?0:(x)+SLOTB)
  const int s1=NXT_(s0),s2=NXT_(s1);
  int tid_=threadIdx.x; asm volatile("":"+v"(tid_));
  const int tid=tid_,lane=tid&63,r32=lane&31,hi=lane>>5; const int wid=__builtin_amdgcn_readfirstlane(tid>>6);
  const bf16*Qw=Q+(long)(q0+wid*QBLK)*QP;
  const bf16*Kh=K,*Vh=V;
  const unsigned lds0=(unsigned)(uintptr_t)shm;
  float*wsf=(float*)(shm+LDS_WS)+wid*64;
  const bf16*ksrc=Kh+(long)lane*KP+wid*8;
  const bf16*vsrc=Vh+(long)(16*(wid&3)+(lane>>2))*VP+(wid>>2)*32+(lane&3)*8;
  const unsigned kdst=lds0+LDS_K+wid*1024, vdst=lds0+LDS_V+wid*1024;
  #define DMA_K(t,slot) glds16(ksrc+(long)(t)*KVBLK*KP,(unsigned)__builtin_amdgcn_readfirstlane(kdst+(slot)))
  #define DMA_V(t,slot) do{ glds16(vsrc+(long)(t)*KVBLK*VP,(unsigned)__builtin_amdgcn_readfirstlane(vdst+2*(slot))); glds16(vsrc+(long)(t)*KVBLK*VP+64,(unsigned)__builtin_amdgcn_readfirstlane(vdst+2*(slot)+8192)); }while(0)
  const int vb0=(int)(lds0+LDS_V)+((lane>>4)&1)*32+(lane&3)*8+(4*hi+((lane&15)>>2))*64;
  const char*Kbase=shm+LDS_K; bf16x8 kf[8];
  const lds_cptr shm3=(lds_cptr)shm; const lds_cptr kp0=shm3+LDS_K+hi*1024+r32*16; const lds_cptr vp0=shm3+LDS_V+((lane>>4)&1)*32+(lane&3)*8+(4*hi+((lane&15)>>2))*64;
  const int NT=(q0+QB)/KVBLK;
  if(!pre){DMA_K(0,s0);DMA_V(0,s0);DMA_K(1,s1);}
  bf16x8 qr[4];
  #pragma unroll
  for(int d0=0;d0<4;++d0)qr[d0]=*reinterpret_cast<const bf16x8*>(&Qw[(long)r32*QP+d0*16+hi*8]);
  float mhat=0.f,l_reg=0.f;f32x16 o[4];{float zz=0.f;asm volatile("":"+v"(zz));
  #pragma unroll
  for(int r=0;r<16;++r){o[0][r]=zz;o[1][r]=zz;o[2][r]=zz;o[3][r]=zz;}}
  f32x16 negm;{float zn=0.f;asm volatile("":"+v"(zn));
  #pragma unroll
  for(int r=0;r<16;++r)negm[r]=zn;}
  asm volatile("":"+v"(negm));
  const int qrel=wid*QBLK+r32;
  #define CMASK(P0,P1,t) do{int jb_=(t)-(NT-4); if(jb_>=0)cmask(P0,P1,jb_,qrel,hi);}while(0)
  bool resc=false;
  #define START(P0,P1) do{ float rm; if constexpr (STAT) rm=mstat; else rm=rowmax(P0,P1); resc=false; \
    { const float dl=rm; mhat=fadd_s(mhat,dl); \
      _Pragma("unroll") for(int r=0;r<16;++r){P0[r]=fsub_s(P0[r],dl);P1[r]=fsub_s(P1[r],dl);} \
      _Pragma("unroll") for(int r=0;r<16;++r)negm[r]=-mhat; asm volatile("":"+v"(negm)); } \
    _Pragma("unroll") for(int r=0;r<16;++r)P0[r]=__builtin_amdgcn_exp2f(P0[r]); }while(0)
  #define RESC() do{ if(resc){ asm volatile("s_waitcnt lgkmcnt(0)":::"memory"); \
      _Pragma("unroll") for(int d_=0;d_<4;++d_) _Pragma("unroll") for(int r=0;r<16;++r)o[d_][r]*=wsf[crow(r,hi)]; } }while(0)
  f32x16 pA0,pA1,pB0,pB1;
  int sl_prev=s0,sl_cur=s0,sl_next=s1;
  #define ROT() do{sl_prev=sl_cur;sl_cur=sl_next;sl_next=(sl_next==(NSLOT-1)*SLOTB)?0:sl_next+SLOTB;}while(0)
  if(!pre){DMA_K(2,s2);}
  WAIT_BAR(4);
  qkt(pA0,pA1,Kbase+s0,qr,negm,r32,hi);asm volatile("s_nop 15\n\ts_nop 7":"+v"(pA0),"+v"(pA1));CMASK(pA0,pA1,0);
  START(pA0,pA1);
  _Pragma("unroll") for(int r=0;r<16;++r)pA1[r]=__builtin_amdgcn_exp2f(pA1[r]);
  WAIT_BAR(0);
  DMA_K(3,s0);DMA_V(1,s1);
  ROT();
  kload8(kf,kp0+sl_cur);
  WAIT_BAR(3);
  s16x4 vlo[8],vhi[8]; u32x4 pw0,pw1,pw2,pw3;
  #define PKW(P,B) cvtpk_s(P[B],P[B+1])
  #define PAF(k) __builtin_bit_cast(bf16x8,pw##k)
  #define VFR(i) (bf16x8){vlo[i][0],vlo[i][1],vlo[i][2],vlo[i][3],vhi[i][0],vhi[i][1],vhi[i][2],vhi[i][3]}
  #define PIN(x) asm volatile("":"+v"(x))
  #define MX3(a,b,c) __builtin_fmaxf(__builtin_fmaxf((a),(b)),(c))
  #define GAPA(MF,A0,A1,A2,A3,W0,W1,PW) do{ MF; sacc+=A0; sacc+=A1; sacc+=A2; sacc+=A3; PIN(sacc); W0; W1; PIN(PW); SBAR(); }while(0)
  #define EX(v) __builtin_amdgcn_exp2f(v)
  #define GAPB2(MF,X,B) do{ MF; X[B]=EX(X[B]); X[B+1]=EX(X[B+1]); PIN(X); SBAR(); }while(0)
  #define VRD2(i) do{ vlo[i]=vtr(vp_+((((i)>>2)+2)*4096+((i)&3)*1024)); vhi[i]=vtr(vp_+((((i)>>2)+2)*4096+((i)&3)*1024+512)); }while(0)
  #define VRD(i) do{ vlo[i]=vtr(vp_+(((i)>>2)*4096+((i)&3)*1024)); vhi[i]=vtr(vp_+(((i)>>2)*4096+((i)&3)*1024+512)); }while(0)
  #define KRD(G,j) do{ if(G){ kload2(kf,kp0+sl_next,j); SBAR(); } }while(0)
  #define STEP(C0,C1,P0,P1,t,GK,GV,GL) do{ SBAR(); \
    const lds_cptr vp_=vp0+2*sl_prev; \
    VRD(0); SBAR(); float sacc=(P0[0]+P0[1]); \
    GAPA(C0=__builtin_amdgcn_mfma_f32_32x32x16_bf16(kf[0],qr[0],negm,0,0,0), P0[2],P0[3],P0[4],P0[5],     pw0[0]=PKW(P0,0), pw0[1]=PKW(P0,2), pw0); \
    VRD(4); SBAR(); GAPA(C1=__builtin_amdgcn_mfma_f32_32x32x16_bf16(kf[1],qr[0],negm,0,0,0), P0[6],P0[7],P0[8],P0[9],     pw0[2]=PKW(P0,4), pw0[3]=PKW(P0,6), pw0); \
    VRD(1); SBAR(); GAPA(C0=__builtin_amdgcn_mfma_f32_32x32x16_bf16(kf[2],qr[1],C0,0,0,0),   P0[10],P0[11],P0[12],P0[13], pw1[0]=PKW(P0,8), pw1[1]=PKW(P0,10), pw1); \
    VRD(5); SBAR(); GAPA(C1=__builtin_amdgcn_mfma_f32_32x32x16_bf16(kf[3],qr[1],C1,0,0,0),   P0[14],P0[15],P1[0],P1[1],   pw1[2]=PKW(P0,12),pw1[3]=PKW(P0,14), pw1); \
    VRD(2); SBAR(); GAPA(C0=__builtin_amdgcn_mfma_f32_32x32x16_bf16(kf[4],qr[2],C0,0,0,0),   P1[2],P1[3],P1[4],P1[5],     pw2[0]=PKW(P1,0), pw2[1]=PKW(P1,2), pw2); \
    VRD(6); SBAR(); GAPA(C1=__builtin_amdgcn_mfma_f32_32x32x16_bf16(kf[5],qr[2],C1,0,0,0),   P1[6],P1[7],P1[8],P1[9],     pw2[2]=PKW(P1,4), pw2[3]=PKW(P1,6), pw2); \
    VRD(3); SBAR(); GAPA(C0=__builtin_amdgcn_mfma_f32_32x32x16_bf16(kf[6],qr[3],C0,0,0,0),   P1[10],P1[11],P1[12],P1[13], pw3[0]=PKW(P1,8), pw3[1]=PKW(P1,10), pw3); \
    VRD(7); SBAR(); GAPA(C1=__builtin_amdgcn_mfma_f32_32x32x16_bf16(kf[7],qr[3],C1,0,0,0),   P1[14],P1[15],0.f,0.f,       pw3[2]=PKW(P1,12),pw3[3]=PKW(P1,14), pw3); \
    l_reg+=sacc; \
    if(GK){DMA_K((t)+3,sl_cur);} if(GV){DMA_V((t)+1,sl_next);} \
    CMASK(C0,C1,t); \
    if constexpr (!STAT) { float a=MX3(C0[0],C0[1],C1[0]),b=MX3(C0[2],C0[3],C1[1]); a=MX3(a,C1[2],C1[3]); \
      _Pragma("unroll") for(int r=4;r<16;r+=4){a=MX3(a,C0[r],C0[r+1]);b=MX3(b,C0[r+2],C0[r+3]);a=MX3(a,C1[r],C1[r+1]);b=MX3(b,C1[r+2],C1[r+3]);} \
      float rm=__builtin_fmaxf(a,b); { auto rr=__builtin_amdgcn_permlane32_swap(__float_as_uint(rm),__float_as_uint(rm),false,false); rm=__builtin_fmaxf(__uint_as_float(rr[0]),__uint_as_float(rr[1])); } \
      resc=false; \
      if(__builtin_expect(__any(rm>(float)THRL),0)){ const float dl=__builtin_fmaxf(rm,0.f); mhat+=dl; \
        _Pragma("unroll") for(int r=0;r<16;++r){C0[r]-=dl;C1[r]-=dl;} \
        _Pragma("unroll") for(int r=0;r<16;++r)negm[r]=-mhat; asm volatile("":"+v"(negm)); \
        const float f=__builtin_amdgcn_exp2f(-dl); l_reg*=f; if(hi==0)wsf[r32]=f; resc=true; } } \
    SBAR(); \
    GAPB2(o[0]=__builtin_amdgcn_mfma_f32_32x32x16_bf16(PAF(0),VFR(0),o[0],0,0,0), C0,0);  VRD2(0); SBAR(); \
    GAPB2(o[1]=__builtin_amdgcn_mfma_f32_32x32x16_bf16(PAF(0),VFR(4),o[1],0,0,0), C0,2);  VRD2(4); SBAR(); \
    GAPB2(o[0]=__builtin_amdgcn_mfma_f32_32x32x16_bf16(PAF(1),VFR(1),o[0],0,0,0), C0,4);  VRD2(1); SBAR(); \
    GAPB2(o[1]=__builtin_amdgcn_mfma_f32_32x32x16_bf16(PAF(1),VFR(5),o[1],0,0,0), C0,6);  VRD2(5); SBAR(); \
    GAPB2(o[0]=__builtin_amdgcn_mfma_f32_32x32x16_bf16(PAF(2),VFR(2),o[0],0,0,0), C0,8);  VRD2(2); SBAR(); \
    GAPB2(o[1]=__builtin_amdgcn_mfma_f32_32x32x16_bf16(PAF(2),VFR(6),o[1],0,0,0), C0,10); VRD2(6); SBAR(); \
    GAPB2(o[0]=__builtin_amdgcn_mfma_f32_32x32x16_bf16(PAF(3),VFR(3),o[0],0,0,0), C0,12); VRD2(3); SBAR(); \
    GAPB2(o[1]=__builtin_amdgcn_mfma_f32_32x32x16_bf16(PAF(3),VFR(7),o[1],0,0,0), C0,14); VRD2(7); SBAR(); \
    GAPB2(o[2]=__builtin_amdgcn_mfma_f32_32x32x16_bf16(PAF(0),VFR(0),o[2],0,0,0), C1,0); \
    GAPB2(o[3]=__builtin_amdgcn_mfma_f32_32x32x16_bf16(PAF(0),VFR(4),o[3],0,0,0), C1,2); \
    KRD(GL,0); GAPB2(o[2]=__builtin_amdgcn_mfma_f32_32x32x16_bf16(PAF(1),VFR(1),o[2],0,0,0), C1,4); \
    KRD(GL,1); GAPB2(o[3]=__builtin_amdgcn_mfma_f32_32x32x16_bf16(PAF(1),VFR(5),o[3],0,0,0), C1,6); \
    KRD(GL,2); GAPB2(o[2]=__builtin_amdgcn_mfma_f32_32x32x16_bf16(PAF(2),VFR(2),o[2],0,0,0), C1,8); \
    KRD(GL,3); GAPB2(o[3]=__builtin_amdgcn_mfma_f32_32x32x16_bf16(PAF(2),VFR(6),o[3],0,0,0), C1,10); \
    GAPB2(o[2]=__builtin_amdgcn_mfma_f32_32x32x16_bf16(PAF(3),VFR(3),o[2],0,0,0), C1,12); \
    GAPB2(o[3]=__builtin_amdgcn_mfma_f32_32x32x16_bf16(PAF(3),VFR(7),o[3],0,0,0), C1,14); \
    }while(0)
  int t=1;
  #undef CMASK
  #define CMASK(P0,P1,t) do{}while(0)
  for(;t+5<NT;t+=2){
    STEP(pB0,pB1,pA0,pA1,t,true,true,true);     WAIT_BAR(3); RESC(); ROT();
    STEP(pA0,pA1,pB0,pB1,t+1,true,true,true);   WAIT_BAR(3); RESC(); ROT();
  }
  #undef CMASK
  #define CMASK(P0,P1,t) do{int jb_=(t)-(NT-4); if(jb_>=0)cmask(P0,P1,jb_,qrel,hi);}while(0)
  #define ENDW(tt) do{ if((tt)+3<NT){WAIT_BAR(3);} else if((tt)+2<NT){WAIT_BAR(2);} else {WAIT_BAR(0);} }while(0)
  for(;t+1<NT;t+=2){
    STEP(pB0,pB1,pA0,pA1,t,(t+3<NT),(t+1<NT),(t+1<NT));       ENDW(t);   RESC(); ROT();
    STEP(pA0,pA1,pB0,pB1,t+1,(t+4<NT),(t+2<NT),(t+2<NT));     ENDW(t+1); RESC(); ROT();
  }
  int snext=0;
  if(Knext!=nullptr){
    const int p0=sl_next,p1=NXT_(p0),p2=NXT_(p1); snext=p0;
    const bf16*kn=Knext+(long)lane*KP+wid*8; const bf16*vn=Vnext+(long)(16*(wid&3)+(lane>>2))*VP+(wid>>2)*32+(lane&3)*8;
    glds16(kn,(unsigned)__builtin_amdgcn_readfirstlane(kdst+p0));
    glds16(vn,(unsigned)__builtin_amdgcn_readfirstlane(vdst+2*p0)); glds16(vn+64,(unsigned)__builtin_amdgcn_readfirstlane(vdst+2*p0+8192));
    glds16(kn+(long)KVBLK*KP,(unsigned)__builtin_amdgcn_readfirstlane(kdst+p1)); glds16(kn+(long)2*KVBLK*KP,(unsigned)__builtin_amdgcn_readfirstlane(kdst+p2)); }
  STEP(pB0,pB1,pA0,pA1,NT-1,false,false,false); RESC();
  { float sacc=pB0[0]+pB0[1]; _Pragma("unroll") for(int r=2;r<16;++r)sacc+=pB0[r]; _Pragma("unroll") for(int r=0;r<16;++r)sacc+=pB1[r]; l_reg+=sacc;
    pw0=(u32x4){PKW(pB0,0),PKW(pB0,2),PKW(pB0,4),PKW(pB0,6)};pw1=(u32x4){PKW(pB0,8),PKW(pB0,10),PKW(pB0,12),PKW(pB0,14)};pw2=(u32x4){PKW(pB1,0),PKW(pB1,2),PKW(pB1,4),PKW(pB1,6)};pw3=(u32x4){PKW(pB1,8),PKW(pB1,10),PKW(pB1,12),PKW(pB1,14)};
    SBAR(); pv(o,vb0+2*sl_cur,PAF(0),PAF(1),PAF(2),PAF(3)); }
  #undef PKW
  #undef PAF
  #undef VFR
  #undef PIN
  #undef MX3
  #undef GAPA
  #undef GAPB2
  #undef VRD2
  #undef EX
  #undef VRD
  #undef KRD
  #undef STEP
  #undef ENDW
  {auto rr=__builtin_amdgcn_permlane32_swap(__float_as_uint(l_reg),__float_as_uint(l_reg),false,false);l_reg=__uint_as_float(rr[0])+__uint_as_float(rr[1]);}
  if(hi==0)wsf[32+r32]=l_reg;asm volatile("s_waitcnt lgkmcnt(0)":::"memory");
  float rli[16];
  #pragma unroll
  for(int r=0;r<16;++r)rli[r]=__builtin_amdgcn_rcpf(wsf[32+crow(r,hi)]);
  bf16*Ow=O+(long)(q0+wid*QBLK)*OP;
  bf16*stg=(bf16*)(shm+LDS_OST)+wid*2048;
  if(O1==nullptr){
    #pragma unroll
    for(int hf=0;hf<2;++hf){
      #pragma unroll
      for(int r=0;r<16;++r){const int orow=crow(r,hi);
        #pragma unroll
        for(int d0=0;d0<2;++d0)stg[orow*64+d0*32+r32]=__float2bfloat16(o[2*hf+d0][r]*rli[r]);}
      asm volatile("s_waitcnt lgkmcnt(0)":::"memory");
      #pragma unroll
      for(int i=0;i<4;++i){const int row=i*8+(lane>>3),ch=lane&7; const u32x4 v=*(const u32x4*)(stg+row*64+ch*8); ATTN_STORE16(Ow+(long)row*OP+hf*64+ch*8,v);}
      asm volatile("s_waitcnt lgkmcnt(0)":::"memory"); }
  } else {
    const bf16*O1w=O1+(long)(q0+wid*QBLK)*OP; unsigned long long p1[2][4][2];
    #pragma unroll
    for(int hf=0;hf<2;++hf)
      #pragma unroll
      for(int i=0;i<4;++i){const int row=i*8+(lane>>3),ch=lane&7; unsigned long long*a=(unsigned long long*)(O1w+(long)row*OP+hf*64+ch*8);
        p1[hf][i][0]=__hip_atomic_load(a,__ATOMIC_RELAXED,__HIP_MEMORY_SCOPE_AGENT); p1[hf][i][1]=__hip_atomic_load(a+1,__ATOMIC_RELAXED,__HIP_MEMORY_SCOPE_AGENT);}
    float dd[2][4][8]; float ssp[4]={0.f,0.f,0.f,0.f};
    #pragma unroll
    for(int hf=0;hf<2;++hf){
      #pragma unroll
      for(int r=0;r<16;++r){const int orow=crow(r,hi);
        #pragma unroll
        for(int d0=0;d0<2;++d0)stg[orow*64+d0*32+r32]=__float2bfloat16(o[2*hf+d0][r]*rli[r]);}
      asm volatile("s_waitcnt lgkmcnt(0)":::"memory");
      #pragma unroll
      for(int i=0;i<4;++i){const int row=i*8+(lane>>3),ch=lane&7; const u32x4 v=*(const u32x4*)(stg+row*64+ch*8);
        const unsigned w1[4]={(unsigned)p1[hf][i][0],(unsigned)(p1[hf][i][0]>>32),(unsigned)p1[hf][i][1],(unsigned)(p1[hf][i][1]>>32)};
        #pragma unroll
        for(int j=0;j<4;++j){ const float a0=__uint_as_float(w1[j]<<16)-lam*__uint_as_float(v[j]<<16), a1=__uint_as_float(w1[j]&0xffff0000u)-lam*__uint_as_float(v[j]&0xffff0000u);
          dd[hf][i][2*j]=a0; dd[hf][i][2*j+1]=a1; ssp[i]+=a0*a0+a1*a1; } }
      asm volatile("s_waitcnt lgkmcnt(0)":::"memory"); }
    #pragma unroll
    for(int i=0;i<4;++i){ float ss=ssp[i];
      ss+=__int_as_float(__builtin_amdgcn_update_dpp(0,__float_as_int(ss),0xB1,0xf,0xf,true)); ss+=__int_as_float(__builtin_amdgcn_update_dpp(0,__float_as_int(ss),0x4E,0xf,0xf,true)); ss+=__int_as_float(__builtin_amdgcn_update_dpp(0,__float_as_int(ss),0x141,0xf,0xf,true));
      const float rn=1.0f/sqrtf(ss*(1.0f/128.0f)+1e-6f)*0.8f;
      const int row=i*8+(lane>>3),ch=lane&7;
      #pragma unroll
      for(int hf=0;hf<2;++hf){ const float*gp=subg+hf*64+ch*8; u32x4 w;
        w[0]=cvtpk_s(dd[hf][i][0]*rn*gp[0],dd[hf][i][1]*rn*gp[1]); w[1]=cvtpk_s(dd[hf][i][2]*rn*gp[2],dd[hf][i][3]*rn*gp[3]);
        w[2]=cvtpk_s(dd[hf][i][4]*rn*gp[4],dd[hf][i][5]*rn*gp[5]); w[3]=cvtpk_s(dd[hf][i][6]*rn*gp[6],dd[hf][i][7]*rn*gp[7]);
        *(u32x4*)(CAo+(long)(q0+wid*QBLK+row)*1024+hf*64+ch*8)=w; } }
  }
  asm volatile("s_waitcnt lgkmcnt(0)\n\ts_barrier":::"memory");
  #undef DMA_K
  #undef DMA_V
  #undef CMASK
  #undef START
  #undef RESC
  #undef ROT
  #undef NXT_
  return snext;
}
constexpr int ATTN_LDS_BYTES=LDS_BYTES;
#undef SBAR
#undef WAIT_BAR
}

constexpr int NWAVES = 8, NTHREADS = NWAVES * 64;
#ifndef MK_PER_PHASE
#define MK_PER_PHASE 0
#endif
#ifndef RUN_PHASES
#define RUN_PHASES 8
#endif
constexpr int N_PHASES = RUN_PHASES;

constexpr size_t MiB = 1u << 20;
constexpr size_t WS_CTL = 0, CTL_ZERO_BYTES = 65536;
constexpr size_t WS_RS = 1 * MiB;
constexpr size_t WS_TINFO = 2 * MiB;
constexpr size_t WS_WR = 3 * MiB;
constexpr size_t WS_LTOK = 4 * MiB, WS_LW = 8 * MiB;
constexpr size_t WS_WIN = 16 * MiB, WS_WCA = 25 * MiB, WS_WOUT = 27 * MiB;
constexpr size_t WS_A = 32 * MiB;
constexpr size_t WS_QB = 112 * MiB, WS_KB = 144 * MiB, WS_VB = 176 * MiB, WS_YG = 208 * MiB;
constexpr size_t WS_MG = 112 * MiB, WS_XM = 176 * MiB;
constexpr size_t WS_GT = 240 * MiB;
constexpr size_t WS_WGU = 240 * MiB, WS_WD = 304 * MiB;
constexpr size_t WS_CA = 368 * MiB;
constexpr size_t WS_YB = 112 * MiB;
constexpr size_t WS_LIST = 432 * MiB;
constexpr size_t WS_CTOK = 448 * MiB;
constexpr size_t WS_XB = 432 * MiB;
constexpr size_t WS_R = 1 * MiB;
constexpr size_t WS_END = 496 * MiB;
static_assert(WS_A + (size_t)CROWS * 1024 <= WS_QB && WS_WD + (size_t)NEXP * 1024 * 512 <= WS_CA, "d_ws map");
static_assert(WS_WIN + (size_t)IN_COLS * 1024 * 2 <= WS_WCA, "d_ws map");

constexpr int RING_BYTES = 131072;
constexpr int META_OFF = RING_BYTES;
constexpr int HIST_OFF = RING_BYTES + 1024;
constexpr int BARST_OFF = RING_BYTES + 3072;
constexpr int META2_OFF = RING_BYTES + 4096;
constexpr int LDS_BYTES = 147456;

#define GAS __attribute__((address_space(1)))
#define LAS __attribute__((address_space(3)))
typedef unsigned short bf16;
typedef unsigned v4u __attribute__((ext_vector_type(4)));
typedef unsigned v2u __attribute__((ext_vector_type(2)));
typedef float f32x4 __attribute__((ext_vector_type(4)));
typedef float f32x16 __attribute__((ext_vector_type(16)));
typedef short bf16x8 __attribute__((ext_vector_type(8)));
using pg8::cvt_pk_bf16; using pg8::bf_lo; using pg8::bf_hi; using pg8::sigmoidf_fast; using pg8::pack8; using pg8::unpack8;

__device__ __forceinline__ float wave_sum(float v) {
    v += __int_as_float(__builtin_amdgcn_update_dpp(0, __float_as_int(v), 0xB1, 0xf, 0xf, true));
    v += __int_as_float(__builtin_amdgcn_update_dpp(0, __float_as_int(v), 0x4E, 0xf, 0xf, true));
    v += __int_as_float(__builtin_amdgcn_update_dpp(0, __float_as_int(v), 0x141, 0xf, 0xf, true));
    v += __int_as_float(__builtin_amdgcn_update_dpp(0, __float_as_int(v), 0x140, 0xf, 0xf, true));
    const int iv = __float_as_int(v);
    return (__int_as_float(__builtin_amdgcn_readlane(iv, 0)) + __int_as_float(__builtin_amdgcn_readlane(iv, 16))) + (__int_as_float(__builtin_amdgcn_readlane(iv, 32)) + __int_as_float(__builtin_amdgcn_readlane(iv, 48)));
}
__device__ __forceinline__ float wave_max(float v) {
    v = fmaxf(v, __int_as_float(__builtin_amdgcn_update_dpp(0, __float_as_int(v), 0xB1, 0xf, 0xf, true)));
    v = fmaxf(v, __int_as_float(__builtin_amdgcn_update_dpp(0, __float_as_int(v), 0x4E, 0xf, 0xf, true)));
    v = fmaxf(v, __int_as_float(__builtin_amdgcn_update_dpp(0, __float_as_int(v), 0x141, 0xf, 0xf, true)));
    v = fmaxf(v, __int_as_float(__builtin_amdgcn_update_dpp(0, __float_as_int(v), 0x140, 0xf, 0xf, true)));
    const int iv = __float_as_int(v);
    return fmaxf(fmaxf(__int_as_float(__builtin_amdgcn_readlane(iv, 0)), __int_as_float(__builtin_amdgcn_readlane(iv, 16))), fmaxf(__int_as_float(__builtin_amdgcn_readlane(iv, 32)), __int_as_float(__builtin_amdgcn_readlane(iv, 48))));
}
__device__ __forceinline__ float bf16_round(float x) { return bf_lo(cvt_pk_bf16(x, 0.f) & 0xffffu); }

#define XB_TMO      128
#define XB_XCNT(j)  (256  + 64 * (j))
#define XB_XSUB(j)  (1280 + 64 * (j))
#define XB_XGEN(j)  (2304 + 64 * (j))
#define XB_TOP      3328
#define XB_TOPGEN   3392
#define XCD_BAR_WORDS 3456
#define XB_SPIN_CAP (1u << 18)

__device__ __forceinline__ unsigned xb_ld(unsigned* p)              { return __hip_atomic_load(p, __ATOMIC_RELAXED, __HIP_MEMORY_SCOPE_AGENT); }
__device__ __forceinline__ unsigned xb_add(unsigned* p, unsigned v) { return __hip_atomic_fetch_add(p, v, __ATOMIC_RELAXED, __HIP_MEMORY_SCOPE_AGENT); }
__device__ __forceinline__ unsigned xb_xcc_id() { return (unsigned)__builtin_amdgcn_s_getreg((3 << 11) | 20) & 0xFu; }
#define XB_SPIN(cond, bar) do { unsigned _sp = 0; while (cond) { __builtin_amdgcn_s_sleep(1); \
    if ((++_sp & 255u) == 0u) { if (xb_ld(&(bar)[XB_TMO])) break; if (_sp > XB_SPIN_CAP) { atomicAdd(&(bar)[XB_TMO], 1u); break; } } } } while (0)

struct XcdBarrier {
    unsigned* bar; unsigned x;
    volatile LAS unsigned* st;
};

__device__ __forceinline__ XcdBarrier xcd_barrier_post(unsigned* bar, volatile LAS unsigned* st) {
    XcdBarrier b; b.bar = bar; b.x = xb_xcc_id(); b.st = st;
    if (threadIdx.x == 0) (void)xb_add(&bar[XB_XCNT(b.x)], 1u);
    return b;
}
__device__ __forceinline__ void xcd_barrier_complete(unsigned* bar, unsigned x, unsigned& nloc, unsigned& nx) {
    const unsigned G = gridDim.x * gridDim.y * gridDim.z;
    unsigned sum, cnt, mine, sp = 0u;
    for (;;) {
        sum = 0u; cnt = 0u; mine = 0u;
#pragma unroll
        for (unsigned j = 0; j < 16; ++j) { const unsigned c = xb_ld(&bar[XB_XCNT(j)]); sum += c; cnt += (c > 0u) ? 1u : 0u; mine = (j == x) ? c : mine; }
        if (sum == G) break;
        __builtin_amdgcn_s_sleep(1);
        if ((++sp & 255u) == 0u) { if (xb_ld(&bar[XB_TMO])) break; if (sp > XB_SPIN_CAP) { atomicAdd(&bar[XB_TMO], 1u); break; } }
    }
    nloc = mine > 0u ? mine : 1u; nx = cnt > 0u ? cnt : 1u;
}

__device__ __forceinline__ void xcd_barrier(const XcdBarrier& b) {
    asm volatile("s_waitcnt vmcnt(0)" ::: "memory");
    __syncthreads();
    if (threadIdx.x == 0) {
        unsigned* bar = b.bar;
        __builtin_amdgcn_s_waitcnt(0);
        unsigned nloc = b.st[0], nx = b.st[1];
        if (nloc == 0u) { xcd_barrier_complete(bar, b.x, nloc, nx); b.st[0] = nloc; b.st[1] = nx; }
        const unsigned old = xb_add(&bar[XB_XSUB(b.x)], 1u);
        const unsigned gen = old / nloc;
        if (old + 1u == (gen + 1u) * nloc) {
            __builtin_amdgcn_fence(__ATOMIC_RELEASE, "agent");
            asm volatile("s_waitcnt vmcnt(0)" ::: "memory");
            const unsigned og = xb_add(&bar[XB_TOP], 1u);
            const unsigned tg = og / nx;
            if (og + 1u == (tg + 1u) * nx) xb_add(&bar[XB_TOPGEN], 1u);
            else XB_SPIN(xb_ld(&bar[XB_TOPGEN]) == tg, bar);
            __builtin_amdgcn_fence(__ATOMIC_ACQUIRE, "agent");
            xb_add(&bar[XB_XGEN(b.x)], 1u);
            asm volatile("s_waitcnt vmcnt(0)" ::: "memory");
        } else {
            XB_SPIN(xb_ld(&bar[XB_XGEN(b.x)]) == gen, bar);
            __builtin_amdgcn_fence(__ATOMIC_ACQUIRE, "agent");
            asm volatile("s_waitcnt vmcnt(0)" ::: "memory");
        }
    }
    __syncthreads();
}


typedef f32x4 AccT[2][2][4][2];
struct EpiInProj {
    static constexpr bool MID = false, PREMID = true;
    struct Pre { float r[2][4]; };
    __device__ __forceinline__ Pre pre(const pg8::Unit& u, int wr, int fr) const { Pre p;
#pragma unroll
        for (int ai = 0; ai < 2; ++ai)
#pragma unroll
            for (int m = 0; m < 4; ++m) p.r[ai][m] = R[u.orow + ai * 128 + wr * 64 + m * 16 + fr];
        return p; }
    bf16 *YG, *QB, *KB, *VB, *GT; const LAS float* gl; const float* R;
    __device__ __forceinline__ void mid(AccT&, const pg8::Unit&, int, int, int, int) const {}
    __device__ __forceinline__ void operator()(AccT& acc, const pg8::Unit& u, int wr, int wc, int fr, int fq, const Pre& pre_) const {
        asm volatile("" : "+v"(fr), "+v"(fq));
        const int pn = u.pn; const size_t row0 = (size_t)u.orow + wr * 64 + fr;
        if (pn < 4) {
#pragma unroll
            for (int ai = 0; ai < 2; ++ai)
#pragma unroll
                for (int m = 0; m < 4; ++m) { const size_t row = row0 + ai * 128 + m * 16; f32x4 y[2]; const float rr = pre_.r[ai][m];
#pragma unroll
                    for (int n = 0; n < 2; ++n) { const f32x4 a = acc[ai][0][m][n] * rr, g = acc[ai][1][m][n] * rr;
                        y[n] = (f32x4){a[0] * sigmoidf_fast(g[0]), a[1] * sigmoidf_fast(g[1]), a[2] * sigmoidf_fast(g[2]), a[3] * sigmoidf_fast(g[3])}; }
                    __builtin_nontemporal_store(pack8(y[0], y[1]), (v4u*)(YG + row * 512 + pn * 128 + wc * 32 + 8 * fq)); }
        } else if (pn < 8) {
            const bool isq = pn < 6; bf16* base = isq ? QB : KB; const LAS float* gp = gl + (isq ? 0 : 64); const float sc = isq ? 0.125f * 1.4426950408889634f : 1.0f;
            f32x4 gv[2][2];
#pragma unroll
            for (int bj = 0; bj < 2; ++bj)
#pragma unroll
                for (int n = 0; n < 2; ++n) gv[bj][n] = *(const LAS f32x4*)(gp + 32 * bj + 8 * fq + 4 * n) * sc;
#pragma unroll
            for (int ai = 0; ai < 2; ++ai)
#pragma unroll
                for (int m = 0; m < 4; ++m) { const size_t row = row0 + ai * 128 + m * 16; float ss = 0.f; const float rr = pre_.r[ai][m];
#pragma unroll
                    for (int bj = 0; bj < 2; ++bj)
#pragma unroll
                        for (int n = 0; n < 2; ++n) { const f32x4 a = acc[ai][bj][m][n]; ss += (a[0] * a[0] + a[1] * a[1]) + (a[2] * a[2] + a[3] * a[3]); }
                    ss += __shfl_xor(ss, 16); ss += __shfl_xor(ss, 32);
                    const float rinv = rr / sqrtf(ss * rr * rr * (1.0f / 64.0f) + EPS);
#pragma unroll
                    for (int bj = 0; bj < 2; ++bj)
                        __builtin_nontemporal_store(pack8(acc[ai][bj][m][0] * rinv * gv[bj][0], acc[ai][bj][m][1] * rinv * gv[bj][1]), (v4u*)(base + row * 512 + (pn & 1) * 256 + wc * 64 + bj * 32 + 8 * fq)); }
        } else if (pn < 10) {
#pragma unroll
            for (int ai = 0; ai < 2; ++ai)
#pragma unroll
                for (int m = 0; m < 4; ++m) { const size_t row = row0 + ai * 128 + m * 16; const float rr = pre_.r[ai][m];
#pragma unroll
                    for (int bj = 0; bj < 2; ++bj) __builtin_nontemporal_store(pack8(acc[ai][bj][m][0] * rr, acc[ai][bj][m][1] * rr), (v4u*)(VB + row * 512 + (pn - 8) * 256 + bj * 128 + wc * 32 + 8 * fq)); }
        } else {
#pragma unroll
            for (int ai = 0; ai < 2; ++ai)
#pragma unroll
                for (int m = 0; m < 4; ++m) { const size_t row = row0 + ai * 128 + m * 16; f32x4 rr[2], gg[2]; const float rz = -1.4426950408889634f * pre_.r[ai][m];
#pragma unroll
                    for (int n = 0; n < 2; ++n)
#pragma unroll
                        for (int j = 0; j < 4; ++j) { const float e0 = __builtin_amdgcn_exp2f(rz * acc[ai][0][m][n][j]), e1 = fminf(__builtin_amdgcn_exp2f(rz * acc[ai][1][m][n][j]), 1e30f);
                            gg[n][j] = __builtin_amdgcn_rcpf(1.0f + e1); rr[n][j] = (1.0f + e1) * __builtin_amdgcn_rcpf(1.0f + e0); }
                    const size_t o = row * 1024 + (pn - 10) * 128 + wc * 32 + 8 * fq;
                    __builtin_nontemporal_store(pack8(rr[0], rr[1]), (v4u*)(GT + o)); __builtin_nontemporal_store(pack8(gg[0], gg[1]), (v4u*)(GT + (size_t)NTOK * 1024 + o)); }
        }
    }
};
struct EpiMerged {
    static constexpr bool MID = true, PREMID = false;
    struct Pre {}; __device__ __forceinline__ Pre pre(const pg8::Unit&, int, int) const { return Pre{}; }
    const bf16* GR; const bf16* G1; bf16* MG;
    __device__ __forceinline__ void mid(AccT& acc, const pg8::Unit& u, int wr, int wc, int fr, int fq) const {
        asm volatile("" : "+v"(fr), "+v"(fq));
        const size_t row0 = (size_t)u.orow + wr * 64 + fr; const int col0 = u.pn * 256 + wc * 32 + 8 * fq;
        v4u w0[2][4][2];
#pragma unroll
        for (int ai = 0; ai < 2; ++ai)
#pragma unroll
            for (int m = 0; m < 4; ++m)
#pragma unroll
                for (int bj = 0; bj < 2; ++bj) w0[ai][m][bj] = *(const v4u*)(GR + (row0 + ai * 128 + m * 16) * 1024 + col0 + bj * 128);
        __builtin_amdgcn_sched_barrier(0);
#pragma unroll
        for (int ai = 0; ai < 2; ++ai)
#pragma unroll
            for (int m = 0; m < 4; ++m)
#pragma unroll
                for (int bj = 0; bj < 2; ++bj) { f32x4 a0, a1; unpack8(w0[ai][m][bj], a0, a1); acc[ai][bj][m][0] = acc[ai][bj][m][0] * a0; acc[ai][bj][m][1] = acc[ai][bj][m][1] * a1; }
        __builtin_amdgcn_sched_barrier(0);
    }
    __device__ __forceinline__ void operator()(AccT& acc, const pg8::Unit& u, int wr, int wc, int fr, int fq, const Pre& pre_) const {
        asm volatile("" : "+v"(fr), "+v"(fq));
        const size_t row0 = (size_t)u.orow + wr * 64 + fr; const int col0 = u.pn * 256 + wc * 32 + 8 * fq;
        v4u w1[2][4][2];
#pragma unroll
        for (int ai = 0; ai < 2; ++ai)
#pragma unroll
            for (int m = 0; m < 4; ++m)
#pragma unroll
                for (int bj = 0; bj < 2; ++bj) w1[ai][m][bj] = *(const v4u*)(G1 + (row0 + ai * 128 + m * 16) * 1024 + col0 + bj * 128);
        __builtin_amdgcn_sched_barrier(0);
#pragma unroll
        for (int ai = 0; ai < 2; ++ai)
#pragma unroll
            for (int m = 0; m < 4; ++m) { const size_t row = row0 + ai * 128 + m * 16;
#pragma unroll
                for (int bj = 0; bj < 2; ++bj) { f32x4 b0, b1; unpack8(w1[ai][m][bj], b0, b1);
                    *(v4u*)(MG + row * 1024 + col0 + bj * 128) = pack8(acc[ai][bj][m][0] * b0, acc[ai][bj][m][1] * b1); } }
    }
};
struct EpiOut {
    static constexpr bool MID = false, PREMID = false;
    struct Pre {}; __device__ __forceinline__ Pre pre(const pg8::Unit&, int, int) const { return Pre{}; }
    const bf16* XB; bf16* XMB; unsigned char* XM8;
    __device__ __forceinline__ void mid(AccT&, const pg8::Unit&, int, int, int, int) const {}
    __device__ __forceinline__ void operator()(AccT& acc, const pg8::Unit& u, int wr, int wc, int fr, int fq, const Pre& pre_) const {
        asm volatile("" : "+v"(fr), "+v"(fq));
        const size_t row0 = (size_t)u.orow + wr * 64 + fr; const int col0 = u.pn * 256 + wc * 32 + 8 * fq;
        v4u xw[2][4][2];
#pragma unroll
        for (int ai = 0; ai < 2; ++ai)
#pragma unroll
            for (int m = 0; m < 4; ++m)
#pragma unroll
                for (int bj = 0; bj < 2; ++bj) xw[ai][m][bj] = __builtin_nontemporal_load((const v4u*)(XB + (row0 + ai * 128 + m * 16) * 1024 + col0 + bj * 128));
        __builtin_amdgcn_sched_barrier(0);
#pragma unroll
        for (int ai = 0; ai < 2; ++ai)
#pragma unroll
            for (int m = 0; m < 4; ++m) { const size_t off = (row0 + ai * 128 + m * 16) * 1024 + col0;
#pragma unroll
                for (int bj = 0; bj < 2; ++bj) { f32x4 x0, x1; unpack8(xw[ai][m][bj], x0, x1); const f32x4 o0 = x0 + acc[ai][bj][m][0], o1 = x1 + acc[ai][bj][m][1];
                    *(v4u*)(XMB + off + bj * 128) = pack8(o0, o1);
                    v2u w8; w8.x = pg8::pack4_fp8(o0[0], o0[1], o0[2], o0[3]); w8.y = pg8::pack4_fp8(o1[0], o1[1], o1[2], o1[3]); *(v2u*)(XM8 + off + bj * 128) = w8; } }
        __builtin_amdgcn_sched_barrier(0);
    }
};
struct EpiGateUp {
    static constexpr bool MID = false, PREMID = false;
    typedef int i32x4 __attribute__((ext_vector_type(4)));
    struct Pre { int dst[2][4]; float w[2][4], rs[2][4]; };
    __device__ __forceinline__ Pre pre(const pg8::Unit& u, int wr, int fr) const { Pre p;
#pragma unroll
        for (int ai = 0; ai < 2; ++ai)
#pragma unroll
            for (int m = 0; m < 4; ++m) { const int r = ai * 128 + wr * 64 + m * 16 + fr; const i32x4 en = (r < u.nvalid) ? *(const i32x4*)(LIST + (size_t)(u.lrow + r) * 4) : (i32x4){-1, -1, 0, 0};
                p.dst[ai][m] = en[1]; p.w[ai][m] = __int_as_float(en[2]); p.rs[ai][m] = __int_as_float(en[3]); }
        return p; }
    const int* LIST; unsigned char* HP8; const LAS int* m2;
    __device__ __forceinline__ void mid(AccT&, const pg8::Unit&, int, int, int, int) const {}
    __device__ __forceinline__ void operator()(AccT& acc, const pg8::Unit& u, int wr, int wc, int fr, int fq, const Pre& pre_) const {
        asm volatile("" : "+v"(fr), "+v"(fq));
#pragma unroll
        for (int ai = 0; ai < 2; ++ai)
#pragma unroll
            for (int m = 0; m < 4; ++m) { const int dst = pre_.dst[ai][m]; if (dst < 0) continue;
                const float rs = pre_.rs[ai][m] * (1.0f / 64.0f), w8 = pre_.w[ai][m] * 8.0f;
                const size_t drow = (size_t)m2[dst >> 17] * 256 + ((dst >> 1) & 0xffff);
                float h[8];
#pragma unroll
                for (int n = 0; n < 2; ++n)
#pragma unroll
                    for (int j = 0; j < 4; ++j) { const float g = acc[ai][0][m][n][j] * rs, up = acc[ai][1][m][n][j] * rs; h[4 * n + j] = __builtin_amdgcn_fmed3f(g * sigmoidf_fast(g) * up * w8, -448.f, 448.f); }
                v2u o8; o8.x = pg8::pack4_fp8(h[0], h[1], h[2], h[3]); o8.y = pg8::pack4_fp8(h[4], h[5], h[6], h[7]);
                *(v2u*)(HP8 + drow * 1024 + (dst & 1) * 512 + u.pn * 128 + wc * 32 + 8 * fq) = o8; }
    }
};
struct EpiDownAdd {
    static constexpr bool MID = false, PREMID = true;
    struct Pre { int tok[2][4]; };
    __device__ __forceinline__ Pre pre(const pg8::Unit& u, int wr, int fr) const { Pre p;
#pragma unroll
        for (int ai = 0; ai < 2; ++ai)
#pragma unroll
            for (int m = 0; m < 4; ++m) { const int r = ai * 128 + wr * 64 + m * 16 + fr; p.tok[ai][m] = (r < u.nvalid) ? CTOK[u.lrow + r] : -1; }
        return p; }
    const int* CTOK; const bf16* XMB; float* out;
    __device__ __forceinline__ void mid(AccT&, const pg8::Unit&, int, int, int, int) const {}
    __device__ __forceinline__ void operator()(AccT& acc, const pg8::Unit& u, int wr, int wc, int fr, int fq, const Pre& pre_) const {
        asm volatile("" : "+v"(fr), "+v"(fq));
        const int col0 = u.pn * 256 + wc * 32 + 8 * fq;
        v4u xw[2][4][2];
#pragma unroll
        for (int ai = 0; ai < 2; ++ai)
#pragma unroll
            for (int m = 0; m < 4; ++m) { const int tk = pre_.tok[ai][m]; const size_t off = (size_t)(tk < 0 ? 0 : tk) * 1024 + col0;
#pragma unroll
                for (int bj = 0; bj < 2; ++bj) xw[ai][m][bj] = *(const v4u*)(XMB + off + bj * 128); }
        __builtin_amdgcn_sched_barrier(0);
#pragma unroll
        for (int ai = 0; ai < 2; ++ai)
#pragma unroll
            for (int m = 0; m < 4; ++m) { const int tk = pre_.tok[ai][m]; if (tk < 0) continue; const size_t off = (size_t)tk * 1024 + col0;
#pragma unroll
                for (int bj = 0; bj < 2; ++bj) { f32x4 x0, x1; unpack8(xw[ai][m][bj], x0, x1);
                    __builtin_nontemporal_store(x0 + acc[ai][bj][m][0] * (1.0f / 256.0f), (f32x4*)(out + off + bj * 128)); __builtin_nontemporal_store(x1 + acc[ai][bj][m][1] * (1.0f / 256.0f), (f32x4*)(out + off + bj * 128 + 4)); } }
    }
};
struct MoeOrder {
    int G, c, total; const LAS int* meta;
    __device__ __forceinline__ bool next(int i, pg8::Unit& u) const {
        const int L = i * G + c; if (L >= total * 4) return false;
        const int blk = L >> 2; const int lane = tid_opaque() & 63;
        const int e = __builtin_amdgcn_readfirstlane(__builtin_popcountll(__ballot(lane < NEXP - 1 && meta[1 + lane] <= blk)));
        const int pre = __builtin_amdgcn_readfirstlane(meta[e]), cnt = __builtin_amdgcn_readfirstlane(meta[64 + e]); const int rb = blk - pre;
        u.pn = L & 3; u.pm = rb; u.e = e; u.e2 = e; u.lrow = e * LCAP + rb * 256; u.nvalid = min(256, cnt - rb * 256); u.orow = blk * 256; u.arow = 0; return true;
    }
};
struct ClassOrder {
    int G, c, total; const LAS int* m2;
    __device__ __forceinline__ bool next(int i, pg8::Unit& u) const {
        const int L = i * G + c; if (L >= total * 4) return false;
        const int blk = L >> 2; const int lane = tid_opaque() & 63;
        const int n0 = __builtin_popcountll(__ballot(m2[1 + lane] <= blk)), n1 = __builtin_popcountll(__ballot(lane + 65 <= NCLS - 1 && m2[65 + lane] <= blk));
        const int cls = __builtin_amdgcn_readfirstlane(n0 + n1);
        const int pre = __builtin_amdgcn_readfirstlane(m2[cls]), cnt = __builtin_amdgcn_readfirstlane(m2[128 + cls]); const int rb = blk - pre;
        const int g = cls / 28; int p = cls % 28, a = 0;
        while (p >= 7 - a) { p -= 7 - a; ++a; }
        u.e = g * 8 + a; u.e2 = g * 8 + a + 1 + p; u.pn = L & 3; u.pm = rb; u.lrow = cls * NTOK + rb * 256; u.nvalid = min(256, cnt - rb * 256); u.orow = blk * 256; u.arow = u.orow; return true;
    }
};
__device__ __forceinline__ void moe_meta(LAS int* meta, LAS int* m2, const unsigned* ctl) {
    const int tid = tid_opaque();
    if (tid < NEXP) meta[64 + tid] = (int)__hip_atomic_load(ctl + tid, __ATOMIC_RELAXED, __HIP_MEMORY_SCOPE_AGENT);
    if (tid >= 64 && tid < 64 + NCLS) m2[128 + tid - 64] = (int)__hip_atomic_load(ctl + tid, __ATOMIC_RELAXED, __HIP_MEMORY_SCOPE_AGENT);
    __syncthreads();
    if (tid == 0) { int p = 0;
        for (int e = 0; e < NEXP; ++e) { meta[e] = p; p += (meta[64 + e] + 255) >> 8; }
        meta[NEXP] = p; }
    if (tid == 64) { int p = 0;
        for (int c = 0; c < NCLS; ++c) { m2[c] = p; p += (m2[128 + c] + 255) >> 8; }
        m2[NCLS] = p; }
    __syncthreads();
}

__device__ __forceinline__ void transpose_item(const float* W, int N, int k0, int n0, bf16* WT, int dpitch, int drow0, int dcol0, const float* kscale, LAS float* scr, int lane) {
    const int kr = lane >> 3, nc = (lane & 7) * 4;
    f32x4 v[8];
#pragma unroll
    for (int i = 0; i < 8; ++i) v[i] = *(const f32x4*)(W + (size_t)(k0 + i * 8 + kr) * N + n0 + nc);
    if (kscale) {
#pragma unroll
        for (int i = 0; i < 8; ++i) v[i] = v[i] * kscale[k0 + i * 8 + kr]; }
#pragma unroll
    for (int i = 0; i < 8; ++i) { LAS float* d = scr + (i * 8 + kr) * 33 + nc; d[0] = v[i][0]; d[1] = v[i][1]; d[2] = v[i][2]; d[3] = v[i][3]; }
    asm volatile("s_waitcnt lgkmcnt(0)" ::: "memory");
    const int c = lane & 7;
#pragma unroll
    for (int j = 0; j < 4; ++j) { const int n = (lane >> 3) + 8 * j; const LAS float* s = scr + (8 * c) * 33 + n;
        v4u o; o.x = cvt_pk_bf16(s[0 * 33], s[1 * 33]); o.y = cvt_pk_bf16(s[2 * 33], s[3 * 33]); o.z = cvt_pk_bf16(s[4 * 33], s[5 * 33]); o.w = cvt_pk_bf16(s[6 * 33], s[7 * 33]);
        *(v4u*)(WT + (size_t)(drow0 + n) * dpitch + dcol0 + k0 + 8 * c) = o; }
    asm volatile("s_waitcnt lgkmcnt(0)" ::: "memory");
}
__device__ __forceinline__ void t8_load(f32x4 (&v)[8], const float* W, int N, int k0, int n0, int lane) {
    const int kr = lane >> 3, nc = (lane & 7) * 4;
#pragma unroll
    for (int i = 0; i < 8; ++i) v[i] = __builtin_nontemporal_load((const f32x4*)(W + (size_t)(k0 + i * 8 + kr) * N + n0 + nc));
}
__device__ __forceinline__ void t8_finish(f32x4 (&v)[8], int k0, unsigned char* WT, int dpitch, int drow0, const float* kscale, float mul, LAS float* scr, int lane) {
    const int kr = lane >> 3, nc = (lane & 7) * 4;
#pragma unroll
    for (int i = 0; i < 8; ++i) v[i] = v[i] * (kscale ? kscale[k0 + i * 8 + kr] * mul : mul);
#pragma unroll
    for (int i = 0; i < 8; ++i) { LAS float* d = scr + (i * 8 + kr) * 33 + nc; d[0] = v[i][0]; d[1] = v[i][1]; d[2] = v[i][2]; d[3] = v[i][3]; }
    asm volatile("s_waitcnt lgkmcnt(0)" ::: "memory");
    const int c = lane & 7;
#pragma unroll
    for (int j = 0; j < 4; ++j) { const int n = (lane >> 3) + 8 * j; const LAS float* s = scr + (8 * c) * 33 + n;
        v2u o; o.x = pg8::pack4_fp8(s[0 * 33], s[1 * 33], s[2 * 33], s[3 * 33]); o.y = pg8::pack4_fp8(s[4 * 33], s[5 * 33], s[6 * 33], s[7 * 33]);
        *(v2u*)(WT + (size_t)(drow0 + n) * dpitch + k0 + 8 * c) = o; }
    asm volatile("s_waitcnt lgkmcnt(0)" ::: "memory");
}
__device__ __forceinline__ void transpose_item_fp8(const float* W, int N, int k0, int n0, unsigned char* WT, int dpitch, int drow0, const float* kscale, float mul, LAS float* scr, int lane) {
    f32x4 v[8]; t8_load(v, W, N, k0, n0, lane); t8_finish(v, k0, WT, dpitch, drow0, kscale, mul, scr, lane);
}
__device__ __forceinline__ int inproj_phys(int c) {
    if (c < 512) return (c >> 7) * 256 + (c & 127);
    if (c < 1024) { c -= 512; return (c >> 7) * 256 + 128 + (c & 127); }
    if (c < 2048) { const int sec = (c - 1024) >> 8, cl = (c - 1024) & 255, s = cl >> 6, d = cl & 63; return 1024 + sec * 256 + ((d >> 5) << 7) + (s << 5) + (d & 31); }
    if (c < 2560) return c;
    { int j = c - 2560; const int hi = j >= 1024; j &= 1023; return 2560 + (j >> 7) * 256 + hi * 128 + (j & 127); }
}
struct Ptrs {
    const float *x, *attn_norm_g, *w_in, *conv_dw_w, *conv_dw_b, *conv_ln_g, *conv_ln_b, *w_conv_out, *q_norm_g, *k_norm_g, *lq1, *lk1, *lq2, *lk2, *subln_g,
        *w_attn_out, *w_out, *ffn_norm_g, *w_rg, *b_rg, *w_re, *b_re, *w_gate, *w_up, *w_down;
    float* out; unsigned char* ws;
};

__device__ __forceinline__ void p0_prologue(const Ptrs& P, LAS unsigned char* lds, int vcu, int G) {
    const int tid = tid_opaque(), lane = tid & 63, wave = __builtin_amdgcn_readfirstlane(tid >> 6);
    LAS float* scr = (LAS float*)(lds + wave * 16384);
    const int gw = vcu * NWAVES + wave, NGW = G * NWAVES;
    bf16* WIN = (bf16*)(P.ws + WS_WIN); bf16* WCA = (bf16*)(P.ws + WS_WCA); bf16* WOUT = (bf16*)(P.ws + WS_WOUT);
    constexpr int I_IN = (DMODEL / 64) * (IN_COLS / 32), I_C = (CONV_CH / 64) * (DMODEL / 32), I_O = (DMODEL / 64) * (DMODEL / 32);
    for (int it = gw; it < I_IN + 2 * I_C + I_O; it += NGW) {
        int r = it;
        if (r < I_IN) { const int kb = r / (IN_COLS / 32), nb = r % (IN_COLS / 32); transpose_item(P.w_in, IN_COLS, kb * 64, nb * 32, WIN, 1024, inproj_phys(nb * 32), 0, P.attn_norm_g, scr, lane); continue; } r -= I_IN;
        if (r < I_C) { const int kb = r / 32, nb = r % 32; transpose_item(P.w_conv_out, DMODEL, kb * 64, nb * 32, WCA, 1024, nb * 32, 0, nullptr, scr, lane); continue; } r -= I_C;
        if (r < I_C) { const int kb = r / 32, nb = r % 32; transpose_item(P.w_attn_out, DMODEL, kb * 64, nb * 32, WCA, 1024, nb * 32, 512, nullptr, scr, lane); continue; } r -= I_C;
        { const int kb = r / 32, nb = r % 32; transpose_item(P.w_out, DMODEL, kb * 64, nb * 32, WOUT, 1024, nb * 32, 0, nullptr, scr, lane); }
    }
    bf16* WRhi = (bf16*)(P.ws + WS_WR); bf16* WRlo = WRhi + 64 * 1024;
    for (int idx = vcu * NTHREADS + tid; idx < 64 * 1024; idx += G * NTHREADS) {
        const int n = idx >> 10, k = idx & 1023; float v = 0.f;
        if (n < 4) v = P.w_rg[k * 4 + n]; else if (n < 36) v = P.w_re[k * 32 + (n - 4)];
        v *= P.ffn_norm_g[k];
        const unsigned hb = cvt_pk_bf16(v, 0.f) & 0xffffu; const float hf = __uint_as_float(hb << 16);
        WRhi[idx] = (bf16)hb; WRlo[idx] = (bf16)(cvt_pk_bf16(v - hf, 0.f) & 0xffffu);
    }
    bf16* HB = (bf16*)(P.ws + WS_XB); float* RR = (float*)(P.ws + WS_R);
    constexpr int RPT = 4;
    for (int m = gw; m < NTOK; m += RPT * NGW) {
        f32x4 v[RPT][4];
#pragma unroll
        for (int q = 0; q < RPT; ++q) { const int mq = m + q * NGW; const f32x4* xr = (const f32x4*)(P.x + (size_t)(mq < NTOK ? mq : m) * DMODEL) + lane;
#pragma unroll
            for (int j = 0; j < 4; ++j) v[q][j] = __builtin_nontemporal_load(xr + 64 * j); }
#pragma unroll
        for (int q = 0; q < RPT; ++q) { const int mq = m + q * NGW; float ss = 0.f;
#pragma unroll
            for (int j = 0; j < 4; ++j) ss += (v[q][j][0] * v[q][j][0] + v[q][j][1] * v[q][j][1]) + (v[q][j][2] * v[q][j][2] + v[q][j][3] * v[q][j][3]);
            const float r = 1.0f / sqrtf(wave_sum(ss) * (1.0f / DMODEL) + EPS);
            if (mq < NTOK) { v2u* o8 = (v2u*)(HB + (size_t)mq * DMODEL) + lane; if (lane == 0) RR[mq] = r;
#pragma unroll
                for (int j = 0; j < 4; ++j) { const f32x4 y = v[q][j]; v2u w; w.x = cvt_pk_bf16(y[0], y[1]); w.y = cvt_pk_bf16(y[2], y[3]); o8[64 * j] = w; } } }
    }
}

__device__ __forceinline__ void conv_phase(const Ptrs& P, LAS unsigned char* lds, int first, int stride) {
    const int tid = tid_opaque(), lane = tid & 63, wave = __builtin_amdgcn_readfirstlane(tid >> 6);
    const bf16* YG = (const bf16*)(P.ws + WS_YG); bf16* CA = (bf16*)(P.ws + WS_CA);
    LAS bf16* yt = (LAS bf16*)lds; LAS float* co = (LAS float*)(lds + 62 * 1024);
    constexpr int NT = NTOK / 32;
    if (first >= NT) return;
    float w[CONV_W];
#pragma unroll
    for (int j = 0; j < CONV_W; ++j) w[j] = P.conv_dw_w[j * CONV_CH + tid];
    const float bias = P.conv_dw_b[tid];
    const f32x4 g0 = ((const f32x4*)P.conv_ln_g)[lane], g1 = ((const f32x4*)P.conv_ln_g)[64 + lane], b0 = ((const f32x4*)P.conv_ln_b)[lane], b1 = ((const f32x4*)P.conv_ln_b)[64 + lane];
    v4u pre[8];
#define CONV_FETCH(tile) do { const int b_ = (tile) / (SEQ / 32), t0_ = ((tile) % (SEQ / 32)) * 32; _Pragma("unroll") for (int p = 0; p < 8; ++p) { const int q = tid + NTHREADS * p; const int row = q >> 6, ch = q & 63, t = t0_ - 30 + row; \
        pre[p] = (v4u){0u, 0u, 0u, 0u}; if (q < 62 * 64 && t >= 0) pre[p] = *(const v4u*)(YG + ((size_t)(b_ * SEQ + t)) * 512 + ch * 8); } } while (0)
    CONV_FETCH(first);
    for (int tile = first; tile < NT; tile += stride) {
        const int b = tile / (SEQ / 32), t0 = (tile % (SEQ / 32)) * 32;
#pragma unroll
        for (int p = 0; p < 8; ++p) { const int q = tid + NTHREADS * p; if (q < 62 * 64) *(LAS v4u*)(yt + (q >> 6) * 512 + (q & 63) * 8) = pre[p]; }
        __syncthreads();
        if (tile + stride < NT) CONV_FETCH(tile + stride);
        float yv[62];
#pragma unroll
        for (int i = 0; i < 62; ++i) yv[i] = __uint_as_float((unsigned)yt[i * 512 + tid] << 16);
#pragma unroll
        for (int t = 0; t < 32; ++t) { float a = bias;
#pragma unroll
            for (int j = 0; j < CONV_W; ++j) a += w[j] * yv[t + j];
            co[t * 512 + tid] = a; }
        __syncthreads();
#pragma unroll
        for (int rr = 0; rr < 4; ++rr) { const int row = wave * 4 + rr;
            const f32x4 v0 = *(const LAS f32x4*)(co + row * 512 + lane * 4), v1 = *(const LAS f32x4*)(co + row * 512 + 256 + lane * 4);
            const float mean = wave_sum((v0[0] + v0[1]) + (v0[2] + v0[3]) + (v1[0] + v1[1]) + (v1[2] + v1[3])) * (1.0f / CONV_CH);
            const f32x4 d0 = v0 - mean, d1 = v1 - mean;
            const float var = wave_sum((d0[0] * d0[0] + d0[1] * d0[1]) + (d0[2] * d0[2] + d0[3] * d0[3]) + (d1[0] * d1[0] + d1[1] * d1[1]) + (d1[2] * d1[2] + d1[3] * d1[3])) * (1.0f / CONV_CH);
            const float rstd = 1.0f / sqrtf(var + EPS);
            f32x4 y0 = d0 * rstd * g0 + b0, y1 = d1 * rstd * g1 + b1;
#pragma unroll
            for (int j = 0; j < 4; ++j) { y0[j] = y0[j] * sigmoidf_fast(y0[j]); y1[j] = y1[j] * sigmoidf_fast(y1[j]); }
            bf16* orow = CA + ((size_t)(b * SEQ + t0 + row)) * 1024;
            v2u o0, o1; o0.x = cvt_pk_bf16(y0[0], y0[1]); o0.y = cvt_pk_bf16(y0[2], y0[3]); o1.x = cvt_pk_bf16(y1[0], y1[1]); o1.y = cvt_pk_bf16(y1[2], y1[3]);
            *(v2u*)(orow + lane * 4) = o0; *(v2u*)(orow + 256 + lane * 4) = o1; }
        __syncthreads();
    }
#undef CONV_FETCH
}

__device__ __forceinline__ void attn_pair(const Ptrs& P, LAS unsigned char* lds, char* lds_generic, int p) {
    const int tid = tid_opaque(), lane = tid & 63, wave = __builtin_amdgcn_readfirstlane(tid >> 6);
    const int bh = p >> 3, s = p & 7, b = bh >> 2, h = bh & 3;
    const __hip_bfloat16* QB = (const __hip_bfloat16*)(P.ws + WS_QB); const __hip_bfloat16* KB = (const __hip_bfloat16*)(P.ws + WS_KB); const __hip_bfloat16* VB = (const __hip_bfloat16*)(P.ws + WS_VB);
    __hip_bfloat16* OT = (__hip_bfloat16*)(P.ws + WS_A); bf16* CA = (bf16*)(P.ws + WS_CA);
    float mstat;
    { int l0 = lane; asm volatile("" : "+v"(l0));
      const float a = wave_max(fabsf(P.q_norm_g[l0])), b = wave_max(fabsf(P.k_norm_g[l0]));
      mstat = __int_as_float(__builtin_amdgcn_readfirstlane(__float_as_int(0.125f * 1.4426950408889634f * 64.0f * 1.02f * a * b))); }
    float lam;
    { int l1 = lane; asm volatile("" : "+v"(l1));
      lam = __int_as_float(__builtin_amdgcn_readfirstlane(__float_as_int(__expf(wave_sum(P.lq1[l1] * P.lk1[l1])) - __expf(wave_sum(P.lq2[l1] * P.lk2[l1])) + 0.2f))); }
    int s0 = 0; bool pre = false;
#pragma unroll 1
    for (int u4 = 0; u4 < 4; ++u4) { const int i = u4 >> 1, c = u4 & 1;
        const int qb = (i == 0) ? s : 15 - s;
        const __hip_bfloat16* q_ = QB + (size_t)b * SEQ * 512 + (h * 2 + c) * 64; const __hip_bfloat16* k_ = KB + (size_t)b * SEQ * 512 + (h * 2 + c) * 64; const __hip_bfloat16* v_ = VB + (size_t)b * SEQ * 512 + h * 128;
        const __hip_bfloat16* kn_ = (u4 < 3) ? KB + (size_t)b * SEQ * 512 + (h * 2 + (c ^ 1)) * 64 : nullptr;
        __hip_bfloat16* o_ = OT + (size_t)b * SEQ * 1024 + (h * 2) * 128;
        const __hip_bfloat16* o1_ = c ? o_ : nullptr; unsigned short* ca_ = CA + (size_t)b * SEQ * 1024 + 512 + h * 128;
        int sn;
        if (mstat <= 40.0f) sn = attn_body::attn_unit<8, true>(mstat, qb * 256, q_, k_, v_, o_, lds_generic, o1_, lam, P.subln_g, ca_, kn_, v_, s0, pre);
        else sn = attn_body::attn_unit<8, false>(0.f, qb * 256, q_, k_, v_, o_, lds_generic, o1_, lam, P.subln_g, ca_, kn_, v_, s0, pre);
        s0 = sn; pre = (kn_ != nullptr); }
}

__device__ __forceinline__ void router_tile(const Ptrs& P, LAS unsigned char* lds, int tile) {
    const int tid = tid_opaque(), lane = tid & 63, wave = __builtin_amdgcn_readfirstlane(tid >> 6), r32 = lane & 31, hi = lane >> 5;
    const bf16* WRhi = (const bf16*)(P.ws + WS_WR); const bf16* WRlo = WRhi + 64 * 1024;
    int* LIST = (int*)(P.ws + WS_LIST); int* CTOK = (int*)(P.ws + WS_CTOK); unsigned* cnt = (unsigned*)(P.ws + WS_CTL); unsigned* ccnt = cnt + 64;
    LAS float* lg = (LAS float*)(lds + wave * 8448);
    LAS int* hist = (LAS int*)(lds + HIST_OFF); LAS int* hbase = hist + 32; LAS int* hist2 = hist + 64; LAS int* hbase2 = hist2 + NCLS;
    if (tid < 32) hist[tid] = 0;
    if (tid >= 64 && tid < 64 + NCLS) hist2[tid - 64] = 0;
    __syncthreads();
    const int tbase = tile * 256 + wave * 32;
    const bf16* xr = (const bf16*)(P.ws + WS_CA) + (size_t)(tbase + r32) * DMODEL + 8 * hi;
    const bf16* bh0 = WRhi + (size_t)r32 * 1024 + 8 * hi; const bf16* bl0 = WRlo + (size_t)r32 * 1024 + 8 * hi;
    f32x16 acc0 = {}, acc1 = {}; float ssq = 0.f;
#pragma unroll 4
    for (int ks = 0; ks < 64; ++ks) {
        const v4u xa = *(const v4u*)(xr + ks * 16);
        f32x4 x0, x1; unpack8(xa, x0, x1);
        ssq += (x0[0] * x0[0] + x0[1] * x0[1]) + (x0[2] * x0[2] + x0[3] * x0[3]) + (x1[0] * x1[0] + x1[1] * x1[1]) + (x1[2] * x1[2] + x1[3] * x1[3]);
        const bf16x8 a_hi = __builtin_bit_cast(bf16x8, xa);
        const bf16x8 bh_0 = *(const bf16x8*)(bh0 + ks * 16), bh_1 = *(const bf16x8*)(bh0 + 32 * 1024 + ks * 16), bl_0 = *(const bf16x8*)(bl0 + ks * 16), bl_1 = *(const bf16x8*)(bl0 + 32 * 1024 + ks * 16);
        acc0 = __builtin_amdgcn_mfma_f32_32x32x16_bf16(a_hi, bh_0, acc0, 0, 0, 0); acc1 = __builtin_amdgcn_mfma_f32_32x32x16_bf16(a_hi, bh_1, acc1, 0, 0, 0);
        acc0 = __builtin_amdgcn_mfma_f32_32x32x16_bf16(a_hi, bl_0, acc0, 0, 0, 0); acc1 = __builtin_amdgcn_mfma_f32_32x32x16_bf16(a_hi, bl_1, acc1, 0, 0, 0);
    }
    ssq += __shfl_xor(ssq, 32);
    const float rs = 1.0f / sqrtf(ssq * (1.0f / DMODEL) + EPS);
#pragma unroll
    for (int r = 0; r < 16; ++r) { const int m = (r & 3) + 8 * (r >> 2) + 4 * hi; lg[m * 66 + r32] = acc0[r]; lg[m * 66 + 32 + r32] = acc1[r]; }
    asm volatile("s_waitcnt lgkmcnt(0)" ::: "memory");
    int ea = 0, eb = 0, cls = 0, lpa = 0, lpb = 0, lpc = 0; float wa = 0.f, wb = 0.f;
    if (lane < 32) {
        const LAS float* L = lg + lane * 66;
        float gl[4];
#pragma unroll
        for (int j = 0; j < 4; ++j) gl[j] = L[j] * rs + P.b_rg[j];
        int gs = 0; float gm = gl[0];
#pragma unroll
        for (int j = 1; j < 4; ++j) if (gl[j] > gm) { gm = gl[j]; gs = j; }
        float gsum = 0.f;
#pragma unroll
        for (int j = 0; j < 4; ++j) gsum += __expf(gl[j] - gm);
        const float gw = 1.0f / gsum;
        float l0 = -INFINITY, l1 = -INFINITY; int i0 = 0, i1 = 0;
#pragma unroll
        for (int j = 0; j < 8; ++j) { const float v = L[4 + gs * 8 + j] * rs + P.b_re[gs * 8 + j];
            if (v > l0) { l1 = l0; i1 = i0; l0 = v; i0 = j; } else if (v > l1) { l1 = v; i1 = j; } }
        const float q = __expf(l1 - l0), inv = 1.0f / (1.0f + q);
        const float w0 = inv * gw, w1 = q * inv * gw;
        const int a = min(i0, i1), b = max(i0, i1);
        wa = (i0 < i1) ? w0 : w1; wb = (i0 < i1) ? w1 : w0;
        ea = gs * 8 + a; eb = gs * 8 + b; cls = gs * 28 + (a * (15 - a)) / 2 + (b - a - 1);
        lpa = __hip_atomic_fetch_add(&hist[ea], 1, __ATOMIC_RELAXED, __HIP_MEMORY_SCOPE_WORKGROUP); lpb = __hip_atomic_fetch_add(&hist[eb], 1, __ATOMIC_RELAXED, __HIP_MEMORY_SCOPE_WORKGROUP);
        lpc = __hip_atomic_fetch_add(&hist2[cls], 1, __ATOMIC_RELAXED, __HIP_MEMORY_SCOPE_WORKGROUP);
    }
    __syncthreads();
    if (tid < 32) hbase[tid] = (int)atomicAdd(cnt + tid, (unsigned)hist[tid]);
    if (tid >= 64 && tid < 64 + NCLS) { const int c = tid - 64; const int n = hist2[c]; hbase2[c] = n ? (int)atomicAdd(ccnt + c, (unsigned)n) : 0; }
    __syncthreads();
    if (lane < 32) { const int t = tbase + lane; const int pa = hbase[ea] + lpa, pb = hbase[eb] + lpb, pc = hbase2[cls] + lpc;
        typedef int i32x4 __attribute__((ext_vector_type(4)));
        const int dst = (cls << 17) | (pc << 1);
        *(i32x4*)(LIST + (size_t)(ea * LCAP + pa) * 4) = (i32x4){t, dst, __float_as_int(wa), __float_as_int(rs)};
        *(i32x4*)(LIST + (size_t)(eb * LCAP + pb) * 4) = (i32x4){t, dst | 1, __float_as_int(wb), __float_as_int(rs)};
        CTOK[(size_t)cls * NTOK + pc] = t; }
    __syncthreads();
}

__device__ __forceinline__ void p5_convert(const Ptrs& P, LAS unsigned char* lds, int vcu, int G) {
    const int tid = tid_opaque(), lane = tid & 63, wave = __builtin_amdgcn_readfirstlane(tid >> 6);
    LAS float* scr = (LAS float*)(lds + wave * 16384);
    const int gw = vcu * NWAVES + wave, NGW = G * NWAVES;
    unsigned char* WGU = P.ws + WS_WGU; unsigned char* WD = P.ws + WS_WD;
    constexpr int I_G = (DMODEL / 64) * (DEXP / 32);
    constexpr int I_D = (DEXP / 64) * (DMODEL / 32);
    constexpr int PER_E = 2 * I_G + I_D;
    constexpr int NITEMS = NEXP * PER_E, NRW = (NTOK / 256) * NWAVES;
    const bool split = (G == 256) && (NITEMS == NRW * 8 + (256 * NWAVES - NRW) * 16);
    const bool rwg = (int)blockIdx.x < NTOK / 256; const int wv = ((int)blockIdx.x - (rwg ? 0 : NTOK / 256)) * NWAVES + wave;
    const int it0 = split ? (rwg ? wv : NRW * 8 + wv) : gw, itn = split ? (rwg ? NRW * 8 : NITEMS) : NITEMS, its = split ? NRW : NGW;
    struct Item { const float* W; int N, k0, n0; unsigned char* WT; int dpitch, drow0; const float* ks; float mul; };
    auto decode = [&](int it) { Item q; const int e = it / PER_E; int r = it % PER_E;
        if (r < 2 * I_G) { const int up = r / I_G; r %= I_G; const int kb = r / (DEXP / 32), nb = r % (DEXP / 32), n0 = nb * 32;
            q.W = (up ? P.w_up : P.w_gate) + (size_t)e * DMODEL * DEXP; q.N = DEXP; q.k0 = kb * 64; q.n0 = n0; q.WT = WGU + (size_t)e * 1024 * 1024; q.dpitch = 1024; q.drow0 = (n0 >> 7) * 256 + up * 128 + (n0 & 127); q.ks = P.ffn_norm_g; q.mul = 64.f;
        } else { r -= 2 * I_G; const int kb = r / (DMODEL / 32), nb = r % (DMODEL / 32);
            q.W = P.w_down + (size_t)e * DEXP * DMODEL; q.N = DMODEL; q.k0 = kb * 64; q.n0 = nb * 32; q.WT = WD + (size_t)e * 1024 * 512; q.dpitch = 512; q.drow0 = nb * 32; q.ks = nullptr; q.mul = 32.f; }
        return q; };
    for (int it = it0; it < itn; it += 4 * its) {
        const bool h1 = it + its < itn, h2 = it + 2 * its < itn, h3 = it + 3 * its < itn;
        const Item a = decode(it), b = decode(h1 ? it + its : it), c = decode(h2 ? it + 2 * its : it), d = decode(h3 ? it + 3 * its : it);
        f32x4 va[8], vb[8], vc[8], vd[8];
        t8_load(va, a.W, a.N, a.k0, a.n0, lane); t8_load(vb, b.W, b.N, b.k0, b.n0, lane); t8_load(vc, c.W, c.N, c.k0, c.n0, lane); t8_load(vd, d.W, d.N, d.k0, d.n0, lane);
        t8_finish(va, a.k0, a.WT, a.dpitch, a.drow0, a.ks, a.mul, scr, lane);
        if (h1) t8_finish(vb, b.k0, b.WT, b.dpitch, b.drow0, b.ks, b.mul, scr, lane);
        if (h2) t8_finish(vc, c.k0, c.WT, c.dpitch, c.drow0, c.ks, c.mul, scr, lane);
        if (h3) t8_finish(vd, d.k0, d.WT, d.dpitch, d.drow0, d.ks, d.mul, scr, lane);
    }
}

struct Args { Ptrs p; int ph_lo, ph_hi, use_cg, pad; };
__global__ void __launch_bounds__(NTHREADS, 2) mega_fwd(Args args) {
    extern __shared__ __attribute__((aligned(16))) unsigned char lds_raw[];
    LAS unsigned char* lds = (LAS unsigned char*)lds_raw;
    const Ptrs& P = args.p;
    const int tid = tid_opaque();
    const int G = gridDim.x, bx = blockIdx.x; const int vcu = (G % 8 == 0) ? (bx % 8) * (G / 8) + bx / 8 : bx;
    const int lo = args.ph_lo, hi = args.ph_hi;
    LAS int* meta = (LAS int*)(lds + META_OFF);
    if (tid < 2) ((volatile LAS unsigned*)(lds + BARST_OFF))[tid] = 0u;
    __syncthreads();
    XcdBarrier bar = xcd_barrier_post((unsigned*)(P.ws + WS_CTL) + 1024, (volatile LAS unsigned*)(lds + BARST_OFF));
#ifndef PHASE_MASK
#define PHASE_MASK 0xff
#endif
#ifndef DUP_PHASE
#define DUP_PHASE -1
#endif
#define REPS(k) for (int rep_ = 0; rep_ < ((DUP_PHASE == (k)) ? 2 : 1); ++rep_)
#define REPBAR() do { if (rep_) xcd_barrier(bar); } while (0)
#define IN(k) (((PHASE_MASK >> (k)) & 1) && lo <= (k) && (k) < hi)
#define SEAM(k) do { if (IN(k) && IN((k) + 1)) xcd_barrier(bar); } while (0)
    bf16* WS16 = (bf16*)P.ws;
    if (IN(0)) REPS(0) { REPBAR(); p0_prologue(P, lds, vcu, G); }
    SEAM(0);
    if (IN(1)) REPS(1) { REPBAR();
        pg8::Gemm g{(const bf16*)(P.ws + WS_XB), (const bf16*)(P.ws + WS_WIN), DMODEL, 0, nullptr};
        pg8::StaticOrder S; S.init(NTOK, IN_COLS, G, bx);
        LAS float* gl = (LAS float*)(lds + RING_BYTES + 8192);
        if (tid < 128) gl[tid] = (tid < 64) ? P.q_norm_g[tid] : P.k_norm_g[tid - 64];
        __syncthreads();
        EpiInProj E{(bf16*)(P.ws + WS_YG), (bf16*)(P.ws + WS_QB), (bf16*)(P.ws + WS_KB), (bf16*)(P.ws + WS_VB), (bf16*)(P.ws + WS_GT), gl, (const float*)(P.ws + WS_R)};
#if defined(DUMP_SEL) && DUMP_SEL == 5
        EpiRaw ER{(bf16*)(P.ws + WS_QB)};
        pg8::gemm_phase<EpiRaw, pg8::StaticOrder, false, true>(lds, g, S, ER);
#else
        pg8::gemm_phase<EpiInProj, pg8::StaticOrder, false, true>(lds, g, S, E);
#endif
    }
    SEAM(1);
    if (IN(2)) {
        REPS(2) { REPBAR();
        for (int p = vcu; p < 256; p += G) attn_pair(P, lds, (char*)lds_raw, p);
        __syncthreads(); }
        REPS(20) { REPBAR();
        conv_phase(P, lds, bx, G); }
    }
    SEAM(2);
    if (IN(3)) REPS(3) { REPBAR();
        pg8::Gemm g{(const bf16*)(P.ws + WS_CA), (const bf16*)(P.ws + WS_WCA), DMODEL, 0, nullptr};
        pg8::StaticOrder S; S.init(NTOK, DMODEL, G, bx);
        EpiMerged E{(const bf16*)(P.ws + WS_GT), (const bf16*)(P.ws + WS_GT) + (size_t)NTOK * 1024, (bf16*)(P.ws + WS_MG)};
#ifdef SKEW3
        if ((bx >> 3) & 1) { const unsigned long long t0 = __builtin_amdgcn_s_memrealtime(); while ((long long)(__builtin_amdgcn_s_memrealtime() - t0) < SKEW3) __builtin_amdgcn_s_sleep(8); }
#endif
        pg8::gemm_phase<EpiMerged, pg8::StaticOrder, false, true>(lds, g, S, E);
    }
    SEAM(3);
    if (IN(4)) REPS(4) { REPBAR();
        pg8::Gemm g{(const bf16*)(P.ws + WS_MG), (const bf16*)(P.ws + WS_WOUT), DMODEL, 0, nullptr};
        pg8::StaticOrder S; S.init(NTOK, DMODEL, G, bx);
        EpiOut E{(const bf16*)(P.ws + WS_XB), (bf16*)(P.ws + WS_CA), P.ws + WS_XM};
        pg8::gemm_phase<EpiOut, pg8::StaticOrder, false, true>(lds, g, S, E);
    }
    SEAM(4);
    if (IN(5)) {
        for (int t = bx; t < NTOK / 256; t += G) router_tile(P, lds, t);
        REPS(5) { REPBAR(); p5_convert(P, lds, vcu, G); }
    }
    SEAM(5);
    LAS int* meta2 = (LAS int*)(lds + META2_OFF);
    if (IN(6)) REPS(6) { REPBAR();
        moe_meta(meta, meta2, (const unsigned*)(P.ws + WS_CTL));
        pg8::Gemm g{(const bf16*)(P.ws + WS_XM), (const bf16*)(P.ws + WS_WGU), DMODEL / 2, (size_t)1024 * 1024, (const int*)(P.ws + WS_LIST), 4};
        MoeOrder S{G, vcu, __builtin_amdgcn_readfirstlane(meta[NEXP]), meta};
        EpiGateUp E{(const int*)(P.ws + WS_LIST), P.ws + WS_A, meta2};
        pg8::gemm_phase<EpiGateUp, MoeOrder, true, true, true>(lds, g, S, E);
    }
    SEAM(6);
    if (IN(7)) REPS(7) { REPBAR();
        moe_meta(meta, meta2, (const unsigned*)(P.ws + WS_CTL));
        pg8::Gemm g{(const bf16*)(P.ws + WS_A), (const bf16*)(P.ws + WS_WD), DMODEL / 2, (size_t)1024 * 512, nullptr, 0, DEXP / 2};
        ClassOrder S{G, vcu, __builtin_amdgcn_readfirstlane(meta2[NCLS]), meta2};
        EpiDownAdd E{(const int*)(P.ws + WS_CTOK), (const bf16*)(P.ws + WS_CA), P.out};
        pg8::gemm_phase<EpiDownAdd, ClassOrder, false, true, true, true>(lds, g, S, E);
    }
#if defined(DUMP_SEL)
    xcd_barrier(bar);
    { const bf16* YG = (const bf16*)(P.ws + WS_YG); const bf16* QB = (const bf16*)(P.ws + WS_QB); const bf16* KB = (const bf16*)(P.ws + WS_KB); const bf16* VB = (const bf16*)(P.ws + WS_VB);
      const bf16* GT = (const bf16*)(P.ws + WS_GT); const bf16* CA = (const bf16*)(P.ws + WS_CA); const bf16* MG = (const bf16*)(P.ws + WS_MG);
      for (size_t i = (size_t)bx * NTHREADS + tid; i < (size_t)NTOK * 1024; i += (size_t)G * NTHREADS) { const size_t t = i >> 10; const int c = (int)(i & 1023); float v = 0.f;
#if DUMP_SEL == 1
          v = bf_lo(YG[t * 512 + (c & 511)]) + bf_lo(QB[t * 512 + (c & 511)]) + 2.f * bf_lo(KB[t * 512 + (c & 511)]) + 3.f * bf_lo(VB[t * 512 + (c & 511)]) + bf_lo(GT[t * 2048 + c]) + bf_lo(GT[t * 2048 + 1024 + c]);
#elif DUMP_SEL == 2
          v = bf_lo(CA[t * 1024 + c]);
#elif DUMP_SEL == 4
          { const bf16* HB = (const bf16*)(P.ws + WS_A); const bf16* WIN = (const bf16*)(P.ws + WS_WIN); v = bf_lo(HB[i]) + 30.f * bf_lo(WIN[i % ((size_t)IN_COLS * 1024)]); }
#elif DUMP_SEL == 5
          { const bf16* R = (const bf16*)(P.ws + WS_QB); v = bf_lo(R[t * 4608 + c]) + bf_lo(R[t * 4608 + 1024 + c]) + bf_lo(R[t * 4608 + 2048 + c]) + bf_lo(R[t * 4608 + 3072 + c]) + bf_lo(R[t * 4608 + 4096 + (c & 511)]); }
#elif DUMP_SEL == 3
          v = bf_lo(MG[t * 1024 + c]);
#endif
          P.out[i] = v; } }
#endif
    (void)WS16;
#undef IN
#undef SEAM
}

extern "C" void kernel_launch(void* const* d_in, const int* in_sizes, int n_in, void* d_out, int out_size, void* d_ws, size_t ws_size, hipStream_t stream) {
    static int grid = 0;
    if (grid == 0) {
        if (n_in != 25 || in_sizes[0] != NTOK * DMODEL || out_size != NTOK * DMODEL || ws_size < WS_END) {
            fprintf(stderr, "kernel_launch: unexpected shapes (n_in %d, in0 %d, out %d, ws %zu); nothing launched\n", n_in, n_in > 0 ? in_sizes[0] : -1, out_size, ws_size); grid = -1; return; }
        int dev = 0, cus = 0, per_cu = 0;
        if (hipGetDevice(&dev) != hipSuccess || hipDeviceGetAttribute(&cus, hipDeviceAttributeMultiprocessorCount, dev) != hipSuccess) { grid = -1; return; }
        if (hipFuncSetAttribute((const void*)mega_fwd, hipFuncAttributeMaxDynamicSharedMemorySize, LDS_BYTES) != hipSuccess) { fprintf(stderr, "kernel_launch: hipFuncSetAttribute failed\n"); grid = -1; return; }
        if (hipOccupancyMaxActiveBlocksPerMultiprocessor(&per_cu, (const void*)mega_fwd, NTHREADS, LDS_BYTES) != hipSuccess || per_cu < 1) { fprintf(stderr, "kernel_launch: the occupancy query reports %d workgroups per CU for this kernel and LDS size; nothing launched\n", per_cu); grid = -1; return; }
        (void)hipGetLastError();
        grid = cus;
    }
    if (grid < 0) return;
    (void)hipMemsetAsync((char*)d_ws + WS_CTL, 0, CTL_ZERO_BYTES, stream);
    Args a{};
    const float** pp = (const float**)&a.p;
    for (int i = 0; i < 25; ++i) pp[i] = (const float*)d_in[i];
    a.p.out = (float*)d_out; a.p.ws = (unsigned char*)d_ws;
#if MK_PER_PHASE
    for (int ph = 0; ph < N_PHASES; ++ph) { a.ph_lo = ph; a.ph_hi = ph + 1; void* params[] = {&a};
        hipError_t e = hipLaunchCooperativeKernel((const void*)mega_fwd, dim3(grid), dim3(NTHREADS), params, LDS_BYTES, stream);
        if (e != hipSuccess) { fprintf(stderr, "launch %d failed: %s\n", ph, hipGetErrorString(e)); break; } }
#else
    a.ph_lo = 0; a.ph_hi = N_PHASES; void* params[] = {&a};
    hipError_t e = hipLaunchCooperativeKernel((const void*)mega_fwd, dim3(grid), dim3(NTHREADS), params, LDS_BYTES, stream);
    if (e != hipSuccess) fprintf(stderr, "cooperative launch failed: %s (grid %d)\n", hipGetErrorString(e), grid);
#endif
}
```

```cpp
#ifndef P5_SPLIT_A
#define P5_SPLIT_A 0
#endif
#include <hip/hip_runtime.h>
#include <hip/hip_bf16.h>
#include <hip/hip_cooperative_groups.h>
#include <cstdio>
#include <cstdint>
#include <cmath>
namespace cg = cooperative_groups;
__device__ __forceinline__ int tid_opaque() { int t = threadIdx.x; asm volatile("" : "+v"(t)); return t; }

constexpr int BATCH = 8, SEQ = 4096, DMODEL = 1024, NTOK = BATCH * SEQ;
constexpr int CONV_CH = 512, CONV_W = 31, NHEADS = 4, IN_COLS = 4608;
constexpr int NEXP = 32, DEXP = 512, LCAP = NTOK;
constexpr int NCLS = 4 * 28;
constexpr int CROWS = NTOK + NCLS * 256;
constexpr int MOE_ROWS = 2 * NTOK + NEXP * 256;
constexpr float EPS = 1e-6f;

namespace pg8 {
#define PG8_LAS __attribute__((address_space(3)))
typedef unsigned short bf16_t;
typedef short bf16x8 __attribute__((ext_vector_type(8)));
typedef float f32x4 __attribute__((ext_vector_type(4)));
typedef unsigned u32x4 __attribute__((ext_vector_type(4)));
constexpr int BM = 256, BK = 64, HALF = 128, HTB = HALF * BK * 2  , STAGE_BYTES = 8 * HTB, NXCD = 8, WGM = 8;

__host__ __device__ __forceinline__ int lds_byte(int r, int c) { const int st = (r >> 4) * 2 + (c >> 5), rr = r & 15, cc = c & 31, ob = rr * 64 + cc * 2; return st * 1024 + (ob ^ (((ob >> 9) & 1) << 5)); }
__host__ __device__ __forceinline__ void stage_rc(int b, int& R, int& C) { const int st = b / 1024, sb = b % 1024, swz = sb ^ (((sb >> 9) & 1) << 5); R = (st >> 1) * 16 + swz / 64; C = (st & 1) * 32 + (swz % 64) / 2; }
__host__ __device__ __forceinline__ int perm32(int rho) { const int n = rho >> 4, i = rho & 15; return 8 * (i >> 2) + 4 * n + (i & 3); }

struct Unit { int pm, pn, arow, e, e2, lrow, nvalid, orow; };
struct Gemm { const bf16_t* A; const bf16_t* Bt; int K; size_t bstride; const int* list; int lstride; int KBrow; };

struct StaticOrder {
    int nM, nN, nwg, G, c;
    __device__ void init(int M, int N, int G_, int c_) { nM = M / BM; nN = N / BM; nwg = nM * nN; G = G_; c = c_; }
    __device__ bool next(int i, Unit& u) const {
        const long L = (long)i * G + c; if (L >= nwg) return false;
        int wgid = (int)L; { const int q = nwg / NXCD, r = nwg % NXCD, xcd = wgid % NXCD, off = wgid / NXCD; wgid = (xcd < r ? xcd * (q + 1) : r * (q + 1) + (xcd - r) * q) + off; }
        const int nig = WGM * nN, gid = wgid / nig, fm = gid * WGM, gsz = (nM - fm) < WGM ? (nM - fm) : WGM;
        u.pm = fm + ((wgid % nig) % gsz); u.pn = (wgid % nig) / gsz; u.arow = u.pm * BM; u.orow = u.arow; u.e = 0; u.e2 = 0; u.lrow = 0; u.nvalid = BM; return true;
    }
};

typedef float f32x2_t __attribute__((ext_vector_type(2))); typedef __bf16 bf16x2_t __attribute__((ext_vector_type(2)));
__device__ __forceinline__ unsigned cvt_pk_bf16(float lo, float hi) { const f32x2_t v = {lo, hi}; const bf16x2_t b = __builtin_convertvector(v, bf16x2_t); return __builtin_bit_cast(unsigned, b); }
typedef int v8i_t __attribute__((ext_vector_type(8))); typedef int v4i_t __attribute__((ext_vector_type(4)));
__device__ __forceinline__ v8i_t cat8(const bf16x8 a, const bf16x8 b) { const v4i_t x = __builtin_bit_cast(v4i_t, a), y = __builtin_bit_cast(v4i_t, b); return (v8i_t){x[0], x[1], x[2], x[3], y[0], y[1], y[2], y[3]}; }
__device__ __forceinline__ unsigned pack4_fp8(float a, float b, float c, float d) { int w = 0; w = __builtin_amdgcn_cvt_pk_fp8_f32(a, b, w, false); w = __builtin_amdgcn_cvt_pk_fp8_f32(c, d, w, true); return (unsigned)w; }
__device__ __forceinline__ float bf_lo(unsigned w) { return __uint_as_float(w << 16); }
__device__ __forceinline__ float bf_hi(unsigned w) { return __uint_as_float(w & 0xffff0000u); }
__device__ __forceinline__ float sigmoidf_fast(float x) { return __builtin_amdgcn_rcpf(1.0f + __builtin_amdgcn_exp2f(-1.4426950408889634f * x)); }
__device__ __forceinline__ u32x4 pack8(const f32x4 a, const f32x4 b) { u32x4 w; w.x = cvt_pk_bf16(a[0], a[1]); w.y = cvt_pk_bf16(a[2], a[3]); w.z = cvt_pk_bf16(b[0], b[1]); w.w = cvt_pk_bf16(b[2], b[3]); return w; }
__device__ __forceinline__ void unpack8(const u32x4 w, f32x4& a, f32x4& b) { a = (f32x4){bf_lo(w.x), bf_hi(w.x), bf_lo(w.y), bf_hi(w.y)}; b = (f32x4){bf_lo(w.z), bf_hi(w.z), bf_lo(w.w), bf_hi(w.w)}; }

template <class Epi, class Sched, bool GATHER, bool ALIGN_EPI, bool FP8 = false, bool BSPLIT = false>
__device__ __forceinline__ void gemm_phase(PG8_LAS unsigned char* lds, const Gemm g, const Sched& S, const Epi& E) {
    const int tid = tid_opaque(), wid = __builtin_amdgcn_readfirstlane(tid >> 6), lane = tid & 63, wr = wid >> 2, wc = wid & 3, fr = lane & 15, fq = lane >> 4;
    const int K = g.K, nt = K / BK, KBp = g.KBrow ? g.KBrow : K;
    unsigned voffB[2]; int Ra[2], Ca[2];
#pragma unroll
    for (int i = 0; i < 2; ++i) { int R, C; stage_rc(tid * 16 + i * 8192, R, C); const int Rb = (R & ~31) + perm32(R & 31); Ra[i] = R; Ca[i] = C; voffB[i] = (unsigned)(Rb * KBp + C) * 2u; }
    const unsigned kstep = (unsigned)(BK * 2);
    const unsigned hstep = (unsigned)HALF * KBp * 2;
    const unsigned tstep = 2 * hstep;
    const char* const gA = (const char*)g.A; const char* const gB = (const char*)g.Bt;
    const unsigned ldsw = (unsigned)wid * 1024u;
    const int aoff = lds_byte(wr * 64 + fr, fq * 8), boff = lds_byte(wc * 32 + fr, fq * 8);
#define PG8_SA(b, h) (((b) * 2 + (h)) * HTB)
#define PG8_SB(b, h) ((4 + (b) * 2 + (h)) * HTB)
#define PG8_STAGE(bufoff, gbase, uoff, voff) do { _Pragma("unroll") for (int _i = 0; _i < 2; ++_i) \
        __builtin_amdgcn_global_load_lds((const unsigned*)((const char*)(gbase) + (unsigned)((uoff) + (voff)[_i])), (PG8_LAS unsigned*)(lds + (bufoff) + ldsw + _i * 8192), 16, 0, 0); } while (0)
#define PG8_LDA(dst, b, h) do { _Pragma("unroll") for (int m = 0; m < 4; ++m) _Pragma("unroll") for (int k = 0; k < 2; ++k) dst[m][k] = *(const PG8_LAS bf16x8*)(lds + PG8_SA(b, h) + aoff + m * 2048 + k * 1024); } while (0)
#define PG8_LDB(dst, b, h) do { _Pragma("unroll") for (int n = 0; n < 2; ++n) _Pragma("unroll") for (int k = 0; k < 2; ++k) dst[n][k] = *(const PG8_LAS bf16x8*)(lds + PG8_SB(b, h) + boff + n * 2048 + k * 1024); } while (0)
#define PG8_MMA(ai, bj, At, Bt) do { __builtin_amdgcn_s_setprio(1); \
        if constexpr (FP8) { _Pragma("unroll") for (int m = 0; m < 4; ++m) _Pragma("unroll") for (int n = 0; n < 2; ++n) \
            asm volatile("v_mfma_scale_f32_16x16x128_f8f6f4 %0, %1, %2, %0, %3, %3 op_sel_hi:[0,0,0]" : "+v"(acc[ai][bj][m][n]) : "v"(cat8(Bt[n][0], Bt[n][1])), "v"(cat8(At[m][0], At[m][1])), "v"(one_e8m0)); } \
        else { _Pragma("unroll") for (int m = 0; m < 4; ++m) _Pragma("unroll") for (int n = 0; n < 2; ++n) _Pragma("unroll") for (int k = 0; k < 2; ++k) \
            acc[ai][bj][m][n] = __builtin_amdgcn_mfma_f32_16x16x32_bf16(Bt[n][k], At[m][k], acc[ai][bj][m][n], 0, 0, 0); } \
        __builtin_amdgcn_s_setprio(0); } while (0)
#define PG8_WAIT_V(n) asm volatile("s_waitcnt vmcnt(" #n ")" ::: "memory")
#define PG8_WAIT_L(n) asm volatile("s_waitcnt lgkmcnt(" #n ")" ::: "memory")
#define PG8_BAR __builtin_amdgcn_s_barrier()
#define PG8_SCHED __builtin_amdgcn_sched_barrier(0)
#define PG8_LOAD_VA(dst, u) do { _Pragma("unroll") for (int _h = 0; _h < 2; ++_h) _Pragma("unroll") for (int _i = 0; _i < 2; ++_i) { const int _row = _h * HALF + Ra[_i]; \
        if constexpr (GATHER) { const int _tok = (_row < (u).nvalid) ? g.list[((u).lrow + _row) * g.lstride] : 0; dst[_h][_i] = (unsigned)(_tok * K + Ca[_i]) * 2u; } \
        else dst[_h][_i] = (unsigned)(_row * K + Ca[_i]) * 2u; } } while (0)
    Unit cur, nxt; int ui = 0;
    if (!S.next(0, cur)) return;
    typename Epi::Pre pre{};
    unsigned vAc[2][2], vAn[2][2];
    PG8_LOAD_VA(vAc, cur);
    f32x4 acc[2][2][4][2];
#pragma unroll
    for (int a = 0; a < 2; ++a)
#pragma unroll
        for (int b = 0; b < 2; ++b)
#pragma unroll
            for (int m = 0; m < 4; ++m)
#pragma unroll
                for (int n = 0; n < 2; ++n) acc[a][b][m][n] = (f32x4){0.f, 0.f, 0.f, 0.f};
    bf16x8 At[4][2], B0[2][2], B1[2][2];
    const int one_e8m0 = 0x7f7f7f7f; (void)one_e8m0;
    unsigned cA = (unsigned)cur.arow * K * 2, cB = (unsigned)cur.e * (unsigned)g.bstride + (unsigned)cur.pn * tstep;
    unsigned cB2 = (unsigned)cur.e2 * (unsigned)g.bstride + (unsigned)cur.pn * tstep; const unsigned hk = (unsigned)(nt / 2) * kstep; (void)cB2; (void)hk;
    PG8_STAGE(PG8_SB(0, 0), gB, cB, voffB); PG8_STAGE(PG8_SB(0, 1), gB, cB + hstep, voffB); PG8_STAGE(PG8_SA(0, 0), gA, cA, vAc[0]); PG8_STAGE(PG8_SA(0, 1), gA, cA, vAc[1]);
    if (wr == 1) PG8_BAR;
    PG8_WAIT_V(2); PG8_BAR;
    PG8_STAGE(PG8_SB(1, 0), gB, cB + kstep, voffB); PG8_STAGE(PG8_SA(1, 0), gA, cA + kstep, vAc[0]); PG8_STAGE(PG8_SB(1, 1), gB, cB + hstep + kstep, voffB);
    PG8_WAIT_V(6); PG8_BAR;
    for (;;) {
        const bool has_next = S.next(ui + 1, nxt);
        const unsigned nA = has_next ? (unsigned)nxt.arow * K * 2 : cA;
        const unsigned nB = has_next ? (unsigned)nxt.e * (unsigned)g.bstride + (unsigned)nxt.pn * tstep : cB;
        const unsigned nB2 = has_next ? (unsigned)nxt.e2 * (unsigned)g.bstride + (unsigned)nxt.pn * tstep : cB2; (void)nB2;
        if (has_next) { PG8_LOAD_VA(vAn, nxt); }
        else {
#pragma unroll
            for (int h = 0; h < 2; ++h)
#pragma unroll
                for (int i = 0; i < 2; ++i) vAn[h][i] = vAc[h][i]; }
#pragma unroll 1
        for (int t = 0; t < nt; t += 2) {
            const bool last = (t == nt - 2);
            if constexpr (Epi::MID) { if (t == nt / 2) E.mid(acc, cur, wr, wc, fr, fq); }
            if constexpr (Epi::PREMID) { if (t == nt / 2) pre = E.pre(cur, wr, fr); }
            const unsigned a1 = cA + (unsigned)(t + 1) * kstep;
            const unsigned a2 = last ? nA : cA + (unsigned)(t + 2) * kstep;
            unsigned b2 = last ? nB : cB + (unsigned)(t + 2) * kstep;
            if constexpr (BSPLIT) { if (!last && t + 2 >= nt / 2) b2 = cB2 + (unsigned)(t + 2) * kstep - hk; }
            const unsigned a3 = a2 + kstep, b3 = b2 + kstep;
            unsigned v2[2][2];
#pragma unroll
            for (int h = 0; h < 2; ++h)
#pragma unroll
                for (int i = 0; i < 2; ++i) v2[h][i] = vAc[h][i];
            if (last) { asm volatile("" ::: "memory");
#pragma unroll
                for (int h = 0; h < 2; ++h)
#pragma unroll
                    for (int i = 0; i < 2; ++i) v2[h][i] = vAn[h][i]; }
            PG8_LDB(B0, 0, 0); PG8_LDB(B1, 0, 1); PG8_SCHED; PG8_LDA(At, 0, 0); PG8_STAGE(PG8_SA(1, 1), gA, a1, vAc[1]);
            PG8_WAIT_V(8); PG8_WAIT_L(0); PG8_BAR; PG8_MMA(0, 0, At, B0); PG8_MMA(0, 1, At, B1); PG8_BAR; PG8_SCHED;
            PG8_LDA(At, 0, 1); PG8_STAGE(PG8_SB(0, 0), gB, b2, voffB); PG8_STAGE(PG8_SB(0, 1), gB, b2 + hstep, voffB); PG8_STAGE(PG8_SA(0, 0), gA, a2, v2[0]);
            PG8_WAIT_V(8); PG8_WAIT_L(0); PG8_BAR; PG8_MMA(1, 0, At, B0); PG8_MMA(1, 1, At, B1); PG8_BAR; PG8_SCHED;
            PG8_LDB(B0, 1, 0); PG8_LDB(B1, 1, 1); PG8_SCHED; PG8_LDA(At, 1, 0); PG8_STAGE(PG8_SA(0, 1), gA, a2, v2[1]);
            PG8_WAIT_V(8); PG8_WAIT_L(0); PG8_BAR; PG8_MMA(0, 0, At, B0); PG8_MMA(0, 1, At, B1); PG8_BAR; PG8_SCHED;
            PG8_LDA(At, 1, 1); PG8_STAGE(PG8_SB(1, 0), gB, b3, voffB); PG8_STAGE(PG8_SB(1, 1), gB, b3 + hstep, voffB); PG8_STAGE(PG8_SA(1, 0), gA, a3, v2[0]);
            PG8_WAIT_V(8); PG8_WAIT_L(0); PG8_BAR; PG8_MMA(1, 0, At, B0); PG8_MMA(1, 1, At, B1); PG8_BAR; PG8_SCHED;
        }
        if constexpr (ALIGN_EPI) { if (wr == 0) PG8_BAR; }
        if constexpr (FP8) asm volatile("s_nop 15\n\ts_nop 15\n\ts_nop 15\n\ts_nop 15" ::: "memory");
        if constexpr (Epi::PREMID) E(acc, cur, wr, wc, fr, fq, pre); else E(acc, cur, wr, wc, fr, fq, E.pre(cur, wr, fr));
        if (!has_next) break;
#pragma unroll
        for (int a = 0; a < 2; ++a)
#pragma unroll
            for (int b = 0; b < 2; ++b)
#pragma unroll
                for (int m = 0; m < 4; ++m)
#pragma unroll
                    for (int n = 0; n < 2; ++n) acc[a][b][m][n] = (f32x4){0.f, 0.f, 0.f, 0.f};
        cur = nxt; cA = nA; cB = nB; cB2 = nB2; ++ui;
#pragma unroll
        for (int h = 0; h < 2; ++h)
#pragma unroll
            for (int i = 0; i < 2; ++i) vAc[h][i] = vAn[h][i];
        if constexpr (ALIGN_EPI) { if (wr == 1) PG8_BAR; }
    }
    PG8_WAIT_V(0);
    if constexpr (!ALIGN_EPI) { if (wr == 0) PG8_BAR; }
    PG8_BAR;
#undef PG8_SA
#undef PG8_SB
#undef PG8_STAGE
#undef PG8_LDA
#undef PG8_LDB
#undef PG8_MMA
#undef PG8_WAIT_V
#undef PG8_WAIT_L
#undef PG8_BAR
#undef PG8_SCHED
#undef PG8_LOAD_VA
}
}

namespace attn_body {
using bf16=__hip_bfloat16;
using bf16x8=__attribute__((ext_vector_type(8)))short;
using s16x4=__attribute__((ext_vector_type(4)))short;
using f32x16=__attribute__((ext_vector_type(16)))float;
using u32x4=__attribute__((ext_vector_type(4)))unsigned;
constexpr int D=64, QP=512, KP=512, VP=512, OP=1024;
constexpr int NW=8,QBLK=32,QB=QBLK*NW,KVBLK=64;
constexpr int ATTN_UNIT_ROWS=QB;
__device__ __forceinline__ int crow(int r,int hi){return (r&3)+8*(r>>2)+4*hi;}
#define SBAR() __builtin_amdgcn_sched_barrier(0)
__device__ __forceinline__ void cmask(f32x16&p0,f32x16&p1,int jb,int qrel,int hi){
  const float NEG=-INFINITY; int kb=64*jb+4*hi;
  #pragma unroll
  for(int r=0;r<16;++r){int kv=kb+(r&3)+8*(r>>2); if(kv>qrel)p0[r]=NEG; if(kv+32>qrel)p1[r]=NEG;}
}

constexpr int NSLOT=3, SLOTB=8192, VSLOTB=16384;
constexpr int LDS_K=0, LDS_V=NSLOT*SLOTB, LDS_WS=LDS_V+NSLOT*VSLOTB, LDS_OST=LDS_WS+NW*64*4, LDS_BYTES=LDS_OST+NW*4096;
constexpr float C2=0.125f*1.4426950408889634f;
__device__ __forceinline__ void glds16(const void*gsrc,unsigned lds_dst){unsigned keep;
  asm volatile("s_mov_b32 %0, m0\n\ts_mov_b32 m0, %2\n\ts_nop 0\n\tglobal_load_lds_dwordx4 %1, off\n\ts_mov_b32 m0, %0":"=&s"(keep):"v"(gsrc),"s"(lds_dst):"memory");}
__device__ __forceinline__ float max3f(float a,float b,float c){float r;asm("v_max3_f32 %0, %1, %2, %3":"=v"(r):"v"(a),"v"(b),"v"(c));return r;}
__device__ __forceinline__ float max2f(float a,float b){float r;asm("v_max_f32_e32 %0, %1, %2":"=v"(r):"v"(a),"v"(b));return r;}
__device__ __forceinline__ float fadd_s(float a,float b){float r;asm("v_add_f32_e32 %0, %1, %2":"=v"(r):"v"(a),"v"(b));return r;}
__device__ __forceinline__ float fsub_s(float a,float b){float r;asm("v_sub_f32_e32 %0, %1, %2":"=v"(r):"v"(a),"v"(b));return r;}
typedef float f32x2_t __attribute__((ext_vector_type(2))); typedef __bf16 bf16x2_t __attribute__((ext_vector_type(2)));
__device__ __forceinline__ unsigned cvtpk_s(float lo,float hi){f32x2_t v={lo,hi};bf16x2_t b=__builtin_convertvector(v,bf16x2_t);return __builtin_bit_cast(unsigned,b);}
#define WAIT_BAR(N) asm volatile("s_waitcnt vmcnt(" #N ") lgkmcnt(0)\n\ts_barrier":::"memory")

__device__ __forceinline__ void qkt(f32x16&p0,f32x16&p1,const char*Kslot,const bf16x8*qr,const f32x16&negm,int r32,int hi){
  const char*kb=Kslot+hi*1024+r32*16;
  #pragma unroll
  for(int d0=0;d0<4;++d0){
    const bf16x8 b0=*reinterpret_cast<const bf16x8*>(kb+d0*2048);
    const bf16x8 b1=*reinterpret_cast<const bf16x8*>(kb+d0*2048+512);
    if(d0==0){p0=__builtin_amdgcn_mfma_f32_32x32x16_bf16(b0,qr[0],negm,0,0,0);p1=__builtin_amdgcn_mfma_f32_32x32x16_bf16(b1,qr[0],negm,0,0,0);}
    else{p0=__builtin_amdgcn_mfma_f32_32x32x16_bf16(b0,qr[d0],p0,0,0,0);p1=__builtin_amdgcn_mfma_f32_32x32x16_bf16(b1,qr[d0],p1,0,0,0);}}
}
typedef __attribute__((address_space(3))) const char* lds_cptr;
typedef short v4i16_t __attribute__((ext_vector_type(4)));
__device__ __forceinline__ void kload8(bf16x8*kf,lds_cptr kp){
  kf[0]=*(const __attribute__((address_space(3))) bf16x8*)(kp);      kf[1]=*(const __attribute__((address_space(3))) bf16x8*)(kp+512);
  kf[2]=*(const __attribute__((address_space(3))) bf16x8*)(kp+2048); kf[3]=*(const __attribute__((address_space(3))) bf16x8*)(kp+2560);
  kf[4]=*(const __attribute__((address_space(3))) bf16x8*)(kp+4096); kf[5]=*(const __attribute__((address_space(3))) bf16x8*)(kp+4608);
  kf[6]=*(const __attribute__((address_space(3))) bf16x8*)(kp+6144); kf[7]=*(const __attribute__((address_space(3))) bf16x8*)(kp+6656);
}
__device__ __forceinline__ void kload2(bf16x8*kf,lds_cptr kp,int j){ kf[2*j]=*(const __attribute__((address_space(3))) bf16x8*)(kp+j*2048); kf[2*j+1]=*(const __attribute__((address_space(3))) bf16x8*)(kp+j*2048+512); }
__device__ __forceinline__ s16x4 vtr(lds_cptr p){ return __builtin_bit_cast(s16x4,__builtin_amdgcn_ds_read_tr16_b64_v4i16((__attribute__((address_space(3))) v4i16_t*)p)); }
__device__ __forceinline__ float rowmax(const f32x16&p0,const f32x16&p1){
  float a=max3f(p0[0],p0[1],p1[0]),b=max3f(p0[2],p0[3],p1[1]);a=max3f(a,p1[2],p1[3]);
  #pragma unroll
  for(int r=4;r<16;r+=4){a=max3f(a,p0[r],p0[r+1]);b=max3f(b,p0[r+2],p0[r+3]);a=max3f(a,p1[r],p1[r+1]);b=max3f(b,p1[r+2],p1[r+3]);}
  const float m=max2f(a,b);
  auto rr=__builtin_amdgcn_permlane32_swap(__float_as_uint(m),__float_as_uint(m),false,false);
  return max2f(__uint_as_float(rr[0]),__uint_as_float(rr[1]));
}
__device__ __forceinline__ void pv(f32x16*o,int vb,bf16x8 pa0,bf16x8 pa1,bf16x8 pa2,bf16x8 pa3){
  #pragma unroll
  for(int d0=0;d0<4;++d0){s16x4 lo[4],hi[4];
    #pragma unroll
    for(int ks=0;ks<4;++ks){
      asm volatile("ds_read_b64_tr_b16 %0,%1 offset:%c2":"=&v"(lo[ks]):"v"(vb),"i"(d0*4096+ks*1024):"memory");
      asm volatile("ds_read_b64_tr_b16 %0,%1 offset:%c2":"=&v"(hi[ks]):"v"(vb),"i"(d0*4096+ks*1024+512):"memory");}
    asm volatile("s_waitcnt lgkmcnt(0)":::"memory");SBAR();
    #define PK(k) (bf16x8){lo[k][0],lo[k][1],lo[k][2],lo[k][3],hi[k][0],hi[k][1],hi[k][2],hi[k][3]}
    o[d0]=__builtin_amdgcn_mfma_f32_32x32x16_bf16(pa0,PK(0),o[d0],0,0,0);
    o[d0]=__builtin_amdgcn_mfma_f32_32x32x16_bf16(pa1,PK(1),o[d0],0,0,0);
    o[d0]=__builtin_amdgcn_mfma_f32_32x32x16_bf16(pa2,PK(2),o[d0],0,0,0);
    o[d0]=__builtin_amdgcn_mfma_f32_32x32x16_bf16(pa3,PK(3),o[d0],0,0,0);
    #undef PK
  }
}

#ifndef ATTN_STORE16
#define ATTN_STORE16(p,v) (*(u32x4*)(p)=(v))
#endif
template<int THRL,bool STAT> __device__ __forceinline__ int attn_unit(float mstat,int q0,const bf16*Q,const bf16*__restrict__ K,const bf16*__restrict__ V,bf16*O,char*shm,const bf16*O1,float lam,const float*subg,unsigned short*CAo,const bf16*Knext,const bf16*Vnext,int s0,bool pre){
  #define NXT_(x) (((x)==(NSLOT-1)*SLOTB)?0:(x)+SLOTB)
  const int s1=NXT_(s0),s2=NXT_(s1);
  int tid_=threadIdx.x; asm volatile("":"+v"(tid_));
  const int tid=tid_,lane=tid&63,r32=lane&31,hi=lane>>5; const int wid=__builtin_amdgcn_readfirstlane(tid>>6);
  const bf16*Qw=Q+(long)(q0+wid*QBLK)*QP;
  const bf16*Kh=K,*Vh=V;
  const unsigned lds0=(unsigned)(uintptr_t)shm;
  float*wsf=(float*)(shm+LDS_WS)+wid*64;
  const bf16*ksrc=Kh+(long)lane*KP+wid*8;
  const bf16*vsrc=Vh+(long)(16*(wid&3)+(lane>>2))*VP+(wid>>2)*32+(lane&3)*8;
  const unsigned kdst=lds0+LDS_K+wid*1024, vdst=lds0+LDS_V+wid*1024;
  #define DMA_K(t,slot) glds16(ksrc+(long)(t)*KVBLK*KP,(unsigned)__builtin_amdgcn_readfirstlane(kdst+(slot)))
  #define DMA_V(t,slot) do{ glds16(vsrc+(long)(t)*KVBLK*VP,(unsigned)__builtin_amdgcn_readfirstlane(vdst+2*(slot))); glds16(vsrc+(long)(t)*KVBLK*VP+64,(unsigned)__builtin_amdgcn_readfirstlane(vdst+2*(slot)+8192)); }while(0)
  const int vb0=(int)(lds0+LDS_V)+((lane>>4)&1)*32+(lane&3)*8+(4*hi+((lane&15)>>2))*64;
  const char*Kbase=shm+LDS_K; bf16x8 kf[8];
  const lds_cptr shm3=(lds_cptr)shm; const lds_cptr kp0=shm3+LDS_K+hi*1024+r32*16; const lds_cptr vp0=shm3+LDS_V+((lane>>4)&1)*32+(lane&3)*8+(4*hi+((lane&15)>>2))*64;
  const int NT=(q0+QB)/KVBLK;
  if(!pre){DMA_K(0,s0);DMA_V(0,s0);DMA_K(1,s1);}
  bf16x8 qr[4];
  #pragma unroll
  for(int d0=0;d0<4;++d0)qr[d0]=*reinterpret_cast<const bf16x8*>(&Qw[(long)r32*QP+d0*16+hi*8]);
  float mhat=0.f,l_reg=0.f;f32x16 o[4];{float zz=0.f;asm volatile("":"+v"(zz));
  #pragma unroll
  for(int r=0;r<16;++r){o[0][r]=zz;o[1][r]=zz;o[2][r]=zz;o[3][r]=zz;}}
  f32x16 negm;{float zn=0.f;asm volatile("":"+v"(zn));
  #pragma unroll
  for(int r=0;r<16;++r)negm[r]=zn;}
  asm volatile("":"+v"(negm));
  const int qrel=wid*QBLK+r32;
  #define CMASK(P0,P1,t) do{int jb_=(t)-(NT-4); if(jb_>=0)cmask(P0,P1,jb_,qrel,hi);}while(0)
  bool resc=false;
  #define START(P0,P1) do{ float rm; if constexpr (STAT) rm=mstat; else rm=rowmax(P0,P1); resc=false; \
    { const float dl=rm; mhat=fadd_s(mhat,dl); \
      _Pragma("unroll") for(int r=0;r<16;++r){P0[r]=fsub_s(P0[r],dl);P1[r]=fsub_s(P1[r],dl);} \
      _Pragma("unroll") for(int r=0;r<16;++r)negm[r]=-mhat; asm volatile("":"+v"(negm)); } \
    _Pragma("unroll") for(int r=0;r<16;++r)P0[r]=__builtin_amdgcn_exp2f(P0[r]); }while(0)
  #define RESC() do{ if(resc){ asm volatile("s_waitcnt lgkmcnt(0)":::"memory"); \
      _Pragma("unroll") for(int d_=0;d_<4;++d_) _Pragma("unroll") for(int r=0;r<16;++r)o[d_][r]*=wsf[crow(r,hi)]; } }while(0)
  f32x16 pA0,pA1,pB0,pB1;
  int sl_prev=s0,sl_cur=s0,sl_next=s1;
  #define ROT() do{sl_prev=sl_cur;sl_cur=sl_next;sl_next=(sl_next==(NSLOT-1)*SLOTB)?0:sl_next+SLOTB;}while(0)
  if(!pre){DMA_K(2,s2);}
  WAIT_BAR(4);
  qkt(pA0,pA1,Kbase+s0,qr,negm,r32,hi);asm volatile("s_nop 15\n\ts_nop 7":"+v"(pA0),"+v"(pA1));CMASK(pA0,pA1,0);
  START(pA0,pA1);
  _Pragma("unroll") for(int r=0;r<16;++r)pA1[r]=__builtin_amdgcn_exp2f(pA1[r]);
  WAIT_BAR(0);
  DMA_K(3,s0);DMA_V(1,s1);
  ROT();
  kload8(kf,kp0+sl_cur);
  WAIT_BAR(3);
  s16x4 vlo[8],vhi[8]; u32x4 pw0,pw1,pw2,pw3;
  #define PKW(P,B) cvtpk_s(P[B],P[B+1])
  #define PAF(k) __builtin_bit_cast(bf16x8,pw##k)
  #define VFR(i) (bf16x8){vlo[i][0],vlo[i][1],vlo[i][2],vlo[i][3],vhi[i][0],vhi[i][1],vhi[i][2],vhi[i][3]}
  #define PIN(x) asm volatile("":"+v"(x))
  #define MX3(a,b,c) __builtin_fmaxf(__builtin_fmaxf((a),(b)),(c))
  #define GAPA(MF,A0,A1,A2,A3,W0,W1,PW) do{ MF; sacc+=A0; sacc+=A1; sacc+=A2; sacc+=A3; PIN(sacc); W0; W1; PIN(PW); SBAR(); }while(0)
  #define EX(v) __builtin_amdgcn_exp2f(v)
  #define GAPB2(MF,X,B) do{ MF; X[B]=EX(X[B]); X[B+1]=EX(X[B+1]); PIN(X); SBAR(); }while(0)
  #define VRD2(i) do{ vlo[i]=vtr(vp_+((((i)>>2)+2)*4096+((i)&3)*1024)); vhi[i]=vtr(vp_+((((i)>>2)+2)*4096+((i)&3)*1024+512)); }while(0)
  #define VRD(i) do{ vlo[i]=vtr(vp_+(((i)>>2)*4096+((i)&3)*1024)); vhi[i]=vtr(vp_+(((i)>>2)*4096+((i)&3)*1024+512)); }while(0)
  #define KRD(G,j) do{ if(G){ kload2(kf,kp0+sl_next,j); SBAR(); } }while(0)
  #define STEP(C0,C1,P0,P1,t,GK,GV,GL) do{ SBAR(); \
    const lds_cptr vp_=vp0+2*sl_prev; \
    VRD(0); SBAR(); float sacc=(P0[0]+P0[1]); \
    GAPA(C0=__builtin_amdgcn_mfma_f32_32x32x16_bf16(kf[0],qr[0],negm,0,0,0), P0[2],P0[3],P0[4],P0[5],     pw0[0]=PKW(P0,0), pw0[1]=PKW(P0,2), pw0); \
    VRD(4); SBAR(); GAPA(C1=__builtin_amdgcn_mfma_f32_32x32x16_bf16(kf[1],qr[0],negm,0,0,0), P0[6],P0[7],P0[8],P0[9],     pw0[2]=PKW(P0,4), pw0[3]=PKW(P0,6), pw0); \
    VRD(1); SBAR(); GAPA(C0=__builtin_amdgcn_mfma_f32_32x32x16_bf16(kf[2],qr[1],C0,0,0,0),   P0[10],P0[11],P0[12],P0[13], pw1[0]=PKW(P0,8), pw1[1]=PKW(P0,10), pw1); \
    VRD(5); SBAR(); GAPA(C1=__builtin_amdgcn_mfma_f32_32x32x16_bf16(kf[3],qr[1],C1,0,0,0),   P0[14],P0[15],P1[0],P1[1],   pw1[2]=PKW(P0,12),pw1[3]=PKW(P0,14), pw1); \
    VRD(2); SBAR(); GAPA(C0=__builtin_amdgcn_mfma_f32_32x32x16_bf16(kf[4],qr[2],C0,0,0,0),   P1[2],P1[3],P1[4],P1[5],     pw2[0]=PKW(P1,0), pw2[1]=PKW(P1,2), pw2); \
    VRD(6); SBAR(); GAPA(C1=__builtin_amdgcn_mfma_f32_32x32x16_bf16(kf[5],qr[2],C1,0,0,0),   P1[6],P1[7],P1[8],P1[9],     pw2[2]=PKW(P1,4), pw2[3]=PKW(P1,6), pw2); \
    VRD(3); SBAR(); GAPA(C0=__builtin_amdgcn_mfma_f32_32x32x16_bf16(kf[6],qr[3],C0,0,0,0),   P1[10],P1[11],P1[12],P1[13], pw3[0]=PKW(P1,8), pw3[1]=PKW(P1,10), pw3); \
    VRD(7); SBAR(); GAPA(C1=__builtin_amdgcn_mfma_f32_32x32x16_bf16(kf[7],qr[3],C1,0,0,0),   P1[14],P1[15],0.f,0.f,       pw3[2]=PKW(P1,12),pw3[3]=PKW(P1,14), pw3); \
    l_reg+=sacc; \
    if(GK){DMA_K((t)+3,sl_cur);} if(GV){DMA_V((t)+1,sl_next);} \
    CMASK(C0,C1,t); \
    if constexpr (!STAT) { float a=MX3(C0[0],C0[1],C1[0]),b=MX3(C0[2],C0[3],C1[1]); a=MX3(a,C1[2],C1[3]); \
      _Pragma("unroll") for(int r=4;r<16;r+=4){a=MX3(a,C0[r],C0[r+1]);b=MX3(b,C0[r+2],C0[r+3]);a=MX3(a,C1[r],C1[r+1]);b=MX3(b,C1[r+2],C1[r+3]);} \
      float rm=__builtin_fmaxf(a,b); { auto rr=__builtin_amdgcn_permlane32_swap(__float_as_uint(rm),__float_as_uint(rm),false,false); rm=__builtin_fmaxf(__uint_as_float(rr[0]),__uint_as_float(rr[1])); } \
      resc=false; \
      if(__builtin_expect(__any(rm>(float)THRL),0)){ const float dl=__builtin_fmaxf(rm,0.f); mhat+=dl; \
        _Pragma("unroll") for(int r=0;r<16;++r){C0[r]-=dl;C1[r]-=dl;} \
        _Pragma("unroll") for(int r=0;r<16;++r)negm[r]=-mhat; asm volatile("":"+v"(negm)); \
        const float f=__builtin_amdgcn_exp2f(-dl); l_reg*=f; if(hi==0)wsf[r32]=f; resc=true; } } \
    SBAR(); \
    GAPB2(o[0]=__builtin_amdgcn_mfma_f32_32x32x16_bf16(PAF(0),VFR(0),o[0],0,0,0), C0,0);  VRD2(0); SBAR(); \
    GAPB2(o[1]=__builtin_amdgcn_mfma_f32_32x32x16_bf16(PAF(0),VFR(4),o[1],0,0,0), C0,2);  VRD2(4); SBAR(); \
    GAPB2(o[0]=__builtin_amdgcn_mfma_f32_32x32x16_bf16(PAF(1),VFR(1),o[0],0,0,0), C0,4);  VRD2(1); SBAR(); \
    GAPB2(o[1]=__builtin_amdgcn_mfma_f32_32x32x16_bf16(PAF(1),VFR(5),o[1],0,0,0), C0,6);  VRD2(5); SBAR(); \
    GAPB2(o[0]=__builtin_amdgcn_mfma_f32_32x32x16_bf16(PAF(2),VFR(2),o[0],0,0,0), C0,8);  VRD2(2); SBAR(); \
    GAPB2(o[1]=__builtin_amdgcn_mfma_f32_32x32x16_bf16(PAF(2),VFR(6),o[1],0,0,0), C0,10); VRD2(6); SBAR(); \
    GAPB2(o[0]=__builtin_amdgcn_mfma_f32_32x32x16_bf16(PAF(3),VFR(3),o[0],0,0,0), C0,12); VRD2(3); SBAR(); \
    GAPB2(o[1]=__builtin_amdgcn_mfma_f32_32x32x16_bf16(PAF(3),VFR(7),o[1],0,0,0), C0,14); VRD2(7); SBAR(); \
    GAPB2(o[2]=__builtin_amdgcn_mfma_f32_32x32x16_bf16(PAF(0),VFR(0),o[2],0,0,0), C1,0); \
    GAPB2(o[3]=__builtin_amdgcn_mfma_f32_32x32x16_bf16(PAF(0),VFR(4),o[3],0,0,0), C1,2); \
    KRD(GL,0); GAPB2(o[2]=__builtin_amdgcn_mfma_f32_32x32x16_bf16(PAF(1),VFR(1),o[2],0,0,0), C1,4); \
    KRD(GL,1); GAPB2(o[3]=__builtin_amdgcn_mfma_f32_32x32x16_bf16(PAF(1),VFR(5),o[3],0,0,0), C1,6); \
    KRD(GL,2); GAPB2(o[2]=__builtin_amdgcn_mfma_f32_32x32x16_bf16(PAF(2),VFR(2),o[2],0,0,0), C1,8); \
    KRD(GL,3); GAPB2(o[3]=__builtin_amdgcn_mfma_f32_32x32x16_bf16(PAF(2),VFR(6),o[3],0,0,0), C1,10); \
    GAPB2(o[2]=__builtin_amdgcn_mfma_f32_32x32x16_bf16(PAF(3),VFR(3),o[2],0,0,0), C1,12); \
    GAPB2(o[3]=__builtin_amdgcn_mfma_f32_32x32x16_bf16(PAF(3),VFR(7),o[3],0,0,0), C1,14); \
    }while(0)
  int t=1;
  #undef CMASK
  #define CMASK(P0,P1,t) do{}while(0)
  for(;t+5<NT;t+=2){
    STEP(pB0,pB1,pA0,pA1,t,true,true,true);     WAIT_BAR(3); RESC(); ROT();
    STEP(pA0,pA1,pB0,pB1,t+1,true,true,true);   WAIT_BAR(3); RESC(); ROT();
  }
  #undef CMASK
  #define CMASK(P0,P1,t) do{int jb_=(t)-(NT-4); if(jb_>=0)cmask(P0,P1,jb_,qrel,hi);}while(0)
  #define ENDW(tt) do{ if((tt)+3<NT){WAIT_BAR(3);} else if((tt)+2<NT){WAIT_BAR(2);} else {WAIT_BAR(0);} }while(0)
  for(;t+1<NT;t+=2){
    STEP(pB0,pB1,pA0,pA1,t,(t+3<NT),(t+1<NT),(t+1<NT));       ENDW(t);   RESC(); ROT();
    STEP(pA0,pA1,pB0,pB1,t+1,(t+4<NT),(t+2<NT),(t+2<NT));     ENDW(t+1); RESC(); ROT();
  }
  int snext=0;
  if(Knext!=nullptr){
    const int p0=sl_next,p1=NXT_(p0),p2=NXT_(p1); snext=p0;
    const bf16*kn=Knext+(long)lane*KP+wid*8; const bf16*vn=Vnext+(long)(16*(wid&3)+(lane>>2))*VP+(wid>>2)*32+(lane&3)*8;
    glds16(kn,(unsigned)__builtin_amdgcn_readfirstlane(kdst+p0));
    glds16(vn,(unsigned)__builtin_amdgcn_readfirstlane(vdst+2*p0)); glds16(vn+64,(unsigned)__builtin_amdgcn_readfirstlane(vdst+2*p0+8192));
    glds16(kn+(long)KVBLK*KP,(unsigned)__builtin_amdgcn_readfirstlane(kdst+p1)); glds16(kn+(long)2*KVBLK*KP,(unsigned)__builtin_amdgcn_readfirstlane(kdst+p2)); }
  STEP(pB0,pB1,pA0,pA1,NT-1,false,false,false); RESC();
  { float sacc=pB0[0]+pB0[1]; _Pragma("unroll") for(int r=2;r<16;++r)sacc+=pB0[r]; _Pragma("unroll") for(int r=0;r<16;++r)sacc+=pB1[r]; l_reg+=sacc;
    pw0=(u32x4){PKW(pB0,0),PKW(pB0,2),PKW(pB0,4),PKW(pB0,6)};pw1=(u32x4){PKW(pB0,8),PKW(pB0,10),PKW(pB0,12),PKW(pB0,14)};pw2=(u32x4){PKW(pB1,0),PKW(pB1,2),PKW(pB1,4),PKW(pB1,6)};pw3=(u32x4){PKW(pB1,8),PKW(pB1,10),PKW(pB1,12),PKW(pB1,14)};
    SBAR(); pv(o,vb0+2*sl_cur,PAF(0),PAF(1),PAF(2),PAF(3)); }
  #undef PKW
  #undef PAF
  #undef VFR
  #undef PIN
  #undef MX3
  #undef GAPA
  #undef GAPB2
  #undef VRD2
  #undef EX
  #undef VRD
  #undef KRD
  #undef STEP
  #undef ENDW
  {auto rr=__builtin_amdgcn_permlane32_swap(__float_as_uint(l_reg),__float_as_uint(l_reg),false,false);l_reg=__uint_as_float(rr[0])+__uint_as_float(rr[1]);}
  if(hi==0)wsf[32+r32]=l_reg;asm volatile("s_waitcnt lgkmcnt(0)":::"memory");
  float rli[16];
  #pragma unroll
  for(int r=0;r<16;++r)rli[r]=__builtin_amdgcn_rcpf(wsf[32+crow(r,hi)]);
  bf16*Ow=O+(long)(q0+wid*QBLK)*OP;
  bf16*stg=(bf16*)(shm+LDS_OST)+wid*2048;
  if(O1==nullptr){
    #pragma unroll
    for(int hf=0;hf<2;++hf){
      #pragma unroll
      for(int r=0;r<16;++r){const int orow=crow(r,hi);
        #pragma unroll
        for(int d0=0;d0<2;++d0)stg[orow*64+d0*32+r32]=__float2bfloat16(o[2*hf+d0][r]*rli[r]);}
      asm volatile("s_waitcnt lgkmcnt(0)":::"memory");
      #pragma unroll
      for(int i=0;i<4;++i){const int row=i*8+(lane>>3),ch=lane&7; const u32x4 v=*(const u32x4*)(stg+row*64+ch*8); ATTN_STORE16(Ow+(long)row*OP+hf*64+ch*8,v);}
      asm volatile("s_waitcnt lgkmcnt(0)":::"memory"); }
  } else {
    const bf16*O1w=O1+(long)(q0+wid*QBLK)*OP; unsigned long long p1[2][4][2];
    #pragma unroll
    for(int hf=0;hf<2;++hf)
      #pragma unroll
      for(int i=0;i<4;++i){const int row=i*8+(lane>>3),ch=lane&7; unsigned long long*a=(unsigned long long*)(O1w+(long)row*OP+hf*64+ch*8);
        p1[hf][i][0]=__hip_atomic_load(a,__ATOMIC_RELAXED,__HIP_MEMORY_SCOPE_AGENT); p1[hf][i][1]=__hip_atomic_load(a+1,__ATOMIC_RELAXED,__HIP_MEMORY_SCOPE_AGENT);}
    float dd[2][4][8]; float ssp[4]={0.f,0.f,0.f,0.f};
    #pragma unroll
    for(int hf=0;hf<2;++hf){
      #pragma unroll
      for(int r=0;r<16;++r){const int orow=crow(r,hi);
        #pragma unroll
        for(int d0=0;d0<2;++d0)stg[orow*64+d0*32+r32]=__float2bfloat16(o[2*hf+d0][r]*rli[r]);}
      asm volatile("s_waitcnt lgkmcnt(0)":::"memory");
      #pragma unroll
      for(int i=0;i<4;++i){const int row=i*8+(lane>>3),ch=lane&7; const u32x4 v=*(const u32x4*)(stg+row*64+ch*8);
        const unsigned w1[4]={(unsigned)p1[hf][i][0],(unsigned)(p1[hf][i][0]>>32),(unsigned)p1[hf][i][1],(unsigned)(p1[hf][i][1]>>32)};
        #pragma unroll
        for(int j=0;j<4;++j){ const float a0=__uint_as_float(w1[j]<<16)-lam*__uint_as_float(v[j]<<16), a1=__uint_as_float(w1[j]&0xffff0000u)-lam*__uint_as_float(v[j]&0xffff0000u);
          dd[hf][i][2*j]=a0; dd[hf][i][2*j+1]=a1; ssp[i]+=a0*a0+a1*a1; } }
      asm volatile("s_waitcnt lgkmcnt(0)":::"memory"); }
    #pragma unroll
    for(int i=0;i<4;++i){ float ss=ssp[i];
      ss+=__int_as_float(__builtin_amdgcn_update_dpp(0,__float_as_int(ss),0xB1,0xf,0xf,true)); ss+=__int_as_float(__builtin_amdgcn_update_dpp(0,__float_as_int(ss),0x4E,0xf,0xf,true)); ss+=__int_as_float(__builtin_amdgcn_update_dpp(0,__float_as_int(ss),0x141,0xf,0xf,true));
      const float rn=1.0f/sqrtf(ss*(1.0f/128.0f)+1e-6f)*0.8f;
      const int row=i*8+(lane>>3),ch=lane&7;
      #pragma unroll
      for(int hf=0;hf<2;++hf){ const float*gp=subg+hf*64+ch*8; u32x4 w;
        w[0]=cvtpk_s(dd[hf][i][0]*rn*gp[0],dd[hf][i][1]*rn*gp[1]); w[1]=cvtpk_s(dd[hf][i][2]*rn*gp[2],dd[hf][i][3]*rn*gp[3]);
        w[2]=cvtpk_s(dd[hf][i][4]*rn*gp[4],dd[hf][i][5]*rn*gp[5]); w[3]=cvtpk_s(dd[hf][i][6]*rn*gp[6],dd[hf][i][7]*rn*gp[7]);
        *(u32x4*)(CAo+(long)(q0+wid*QBLK+row)*1024+hf*64+ch*8)=w; } }
  }
  asm volatile("s_waitcnt lgkmcnt(0)\n\ts_barrier":::"memory");
  #undef DMA_K
  #undef DMA_V
  #undef CMASK
  #undef START
  #undef RESC
  #undef ROT
  #undef NXT_
  return snext;
}
constexpr int ATTN_LDS_BYTES=LDS_BYTES;
#undef SBAR
#undef WAIT_BAR
}

constexpr int NWAVES = 8, NTHREADS = NWAVES * 64;
#ifndef MK_PER_PHASE
#define MK_PER_PHASE 0
#endif
#ifndef RUN_PHASES
#define RUN_PHASES 8
#endif
constexpr int N_PHASES = RUN_PHASES;

constexpr size_t MiB = 1u << 20;
constexpr size_t WS_CTL = 0, CTL_ZERO_BYTES = 65536;
constexpr size_t WS_RS = 1 * MiB;
constexpr size_t WS_TINFO = 2 * MiB;
constexpr size_t WS_WR = 3 * MiB;
constexpr size_t WS_LTOK = 4 * MiB, WS_LW = 8 * MiB;
constexpr size_t WS_WIN = 16 * MiB, WS_WCA = 25 * MiB, WS_WOUT = 27 * MiB;
constexpr size_t WS_A = 32 * MiB;
constexpr size_t WS_QB = 112 * MiB, WS_KB = 144 * MiB, WS_VB = 176 * MiB, WS_YG = 208 * MiB;
constexpr size_t WS_MG = 112 * MiB, WS_XM = 176 * MiB;
constexpr size_t WS_GT = 240 * MiB;
constexpr size_t WS_WGU = 240 * MiB, WS_WD = 304 * MiB;
constexpr size_t WS_CA = 368 * MiB;
constexpr size_t WS_YB = 112 * MiB;
constexpr size_t WS_LIST = 432 * MiB;
constexpr size_t WS_CTOK = 448 * MiB;
constexpr size_t WS_XB = 432 * MiB;
constexpr size_t WS_R = 1 * MiB;
constexpr size_t WS_END = 496 * MiB;
static_assert(WS_A + (size_t)CROWS * 1024 <= WS_QB && WS_WD + (size_t)NEXP * 1024 * 512 <= WS_CA, "d_ws map");
static_assert(WS_WIN + (size_t)IN_COLS * 1024 * 2 <= WS_WCA, "d_ws map");

constexpr int RING_BYTES = 131072;
constexpr int META_OFF = RING_BYTES;
constexpr int HIST_OFF = RING_BYTES + 1024;
constexpr int BARST_OFF = RING_BYTES + 3072;
constexpr int META2_OFF = RING_BYTES + 4096;
constexpr int LDS_BYTES = 147456;

#define GAS __attribute__((address_space(1)))
#define LAS __attribute__((address_space(3)))
typedef unsigned short bf16;
typedef unsigned v4u __attribute__((ext_vector_type(4)));
typedef unsigned v2u __attribute__((ext_vector_type(2)));
typedef float f32x4 __attribute__((ext_vector_type(4)));
typedef float f32x16 __attribute__((ext_vector_type(16)));
typedef short bf16x8 __attribute__((ext_vector_type(8)));
using pg8::cvt_pk_bf16; using pg8::bf_lo; using pg8::bf_hi; using pg8::sigmoidf_fast; using pg8::pack8; using pg8::unpack8;

__device__ __forceinline__ float wave_sum(float v) {
    v += __int_as_float(__builtin_amdgcn_update_dpp(0, __float_as_int(v), 0xB1, 0xf, 0xf, true));
    v += __int_as_float(__builtin_amdgcn_update_dpp(0, __float_as_int(v), 0x4E, 0xf, 0xf, true));
    v += __int_as_float(__builtin_amdgcn_update_dpp(0, __float_as_int(v), 0x141, 0xf, 0xf, true));
    v += __int_as_float(__builtin_amdgcn_update_dpp(0, __float_as_int(v), 0x140, 0xf, 0xf, true));
    const int iv = __float_as_int(v);
    return (__int_as_float(__builtin_amdgcn_readlane(iv, 0)) + __int_as_float(__builtin_amdgcn_readlane(iv, 16))) + (__int_as_float(__builtin_amdgcn_readlane(iv, 32)) + __int_as_float(__builtin_amdgcn_readlane(iv, 48)));
}
__device__ __forceinline__ float wave_max(float v) {
    v = fmaxf(v, __int_as_float(__builtin_amdgcn_update_dpp(0, __float_as_int(v), 0xB1, 0xf, 0xf, true)));
    v = fmaxf(v, __int_as_float(__builtin_amdgcn_update_dpp(0, __float_as_int(v), 0x4E, 0xf, 0xf, true)));
    v = fmaxf(v, __int_as_float(__builtin_amdgcn_update_dpp(0, __float_as_int(v), 0x141, 0xf, 0xf, true)));
    v = fmaxf(v, __int_as_float(__builtin_amdgcn_update_dpp(0, __float_as_int(v), 0x140, 0xf, 0xf, true)));
    const int iv = __float_as_int(v);
    return fmaxf(fmaxf(__int_as_float(__builtin_amdgcn_readlane(iv, 0)), __int_as_float(__builtin_amdgcn_readlane(iv, 16))), fmaxf(__int_as_float(__builtin_amdgcn_readlane(iv, 32)), __int_as_float(__builtin_amdgcn_readlane(iv, 48))));
}
__device__ __forceinline__ float bf16_round(float x) { return bf_lo(cvt_pk_bf16(x, 0.f) & 0xffffu); }

#define XB_TMO      128
#define XB_XCNT(j)  (256  + 64 * (j))
#define XB_XSUB(j)  (1280 + 64 * (j))
#define XB_XGEN(j)  (2304 + 64 * (j))
#define XB_TOP      3328
#define XB_TOPGEN   3392
#define XCD_BAR_WORDS 3456
#define XB_SPIN_CAP (1u << 18)

__device__ __forceinline__ unsigned xb_ld(unsigned* p)              { return __hip_atomic_load(p, __ATOMIC_RELAXED, __HIP_MEMORY_SCOPE_AGENT); }
__device__ __forceinline__ unsigned xb_add(unsigned* p, unsigned v) { return __hip_atomic_fetch_add(p, v, __ATOMIC_RELAXED, __HIP_MEMORY_SCOPE_AGENT); }
__device__ __forceinline__ unsigned xb_xcc_id() { return (unsigned)__builtin_amdgcn_s_getreg((3 << 11) | 20) & 0xFu; }
#define XB_SPIN(cond, bar) do { unsigned _sp = 0; while (cond) { __builtin_amdgcn_s_sleep(1); \
    if ((++_sp & 255u) == 0u) { if (xb_ld(&(bar)[XB_TMO])) break; if (_sp > XB_SPIN_CAP) { atomicAdd(&(bar)[XB_TMO], 1u); break; } } } } while (0)

struct XcdBarrier {
    unsigned* bar; unsigned x;
    volatile LAS unsigned* st;
};

__device__ __forceinline__ XcdBarrier xcd_barrier_post(unsigned* bar, volatile LAS unsigned* st) {
    XcdBarrier b; b.bar = bar; b.x = xb_xcc_id(); b.st = st;
    if (threadIdx.x == 0) (void)xb_add(&bar[XB_XCNT(b.x)], 1u);
    return b;
}
__device__ __forceinline__ void xcd_barrier_complete(unsigned* bar, unsigned x, unsigned& nloc, unsigned& nx) {
    const unsigned G = gridDim.x * gridDim.y * gridDim.z;
    unsigned sum, cnt, mine, sp = 0u;
    for (;;) {
        sum = 0u; cnt = 0u; mine = 0u;
#pragma unroll
        for (unsigned j = 0; j < 16; ++j) { const unsigned c = xb_ld(&bar[XB_XCNT(j)]); sum += c; cnt += (c > 0u) ? 1u : 0u; mine = (j == x) ? c : mine; }
        if (sum == G) break;
        __builtin_amdgcn_s_sleep(1);
        if ((++sp & 255u) == 0u) { if (xb_ld(&bar[XB_TMO])) break; if (sp > XB_SPIN_CAP) { atomicAdd(&bar[XB_TMO], 1u); break; } }
    }
    nloc = mine > 0u ? mine : 1u; nx = cnt > 0u ? cnt : 1u;
}

__device__ __forceinline__ void xcd_barrier(const XcdBarrier& b) {
    asm volatile("s_waitcnt vmcnt(0)" ::: "memory");
    __syncthreads();
    if (threadIdx.x == 0) {
        unsigned* bar = b.bar;
        __builtin_amdgcn_s_waitcnt(0);
        unsigned nloc = b.st[0], nx = b.st[1];
        if (nloc == 0u) { xcd_barrier_complete(bar, b.x, nloc, nx); b.st[0] = nloc; b.st[1] = nx; }
        const unsigned old = xb_add(&bar[XB_XSUB(b.x)], 1u);
        const unsigned gen = old / nloc;
        if (old + 1u == (gen + 1u) * nloc) {
            __builtin_amdgcn_fence(__ATOMIC_RELEASE, "agent");
            asm volatile("s_waitcnt vmcnt(0)" ::: "memory");
            const unsigned og = xb_add(&bar[XB_TOP], 1u);
            const unsigned tg = og / nx;
            if (og + 1u == (tg + 1u) * nx) xb_add(&bar[XB_TOPGEN], 1u);
            else XB_SPIN(xb_ld(&bar[XB_TOPGEN]) == tg, bar);
            __builtin_amdgcn_fence(__ATOMIC_ACQUIRE, "agent");
            xb_add(&bar[XB_XGEN(b.x)], 1u);
            asm volatile("s_waitcnt vmcnt(0)" ::: "memory");
        } else {
            XB_SPIN(xb_ld(&bar[XB_XGEN(b.x)]) == gen, bar);
            __builtin_amdgcn_fence(__ATOMIC_ACQUIRE, "agent");
            asm volatile("s_waitcnt vmcnt(0)" ::: "memory");
        }
    }
    __syncthreads();
}


typedef f32x4 AccT[2][2][4][2];
struct EpiInProj {
    static constexpr bool MID = false, PREMID = true;
    struct Pre { float r[2][4]; };
    __device__ __forceinline__ Pre pre(const pg8::Unit& u, int wr, int fr) const { Pre p;
#pragma unroll
        for (int ai = 0; ai < 2; ++ai)
#pragma unroll
            for (int m = 0; m < 4; ++m) p.r[ai][m] = R[u.orow + ai * 128 + wr * 64 + m * 16 + fr];
        return p; }
    bf16 *YG, *QB, *KB, *VB, *GT; const LAS float* gl; const float* R;
    __device__ __forceinline__ void mid(AccT&, const pg8::Unit&, int, int, int, int) const {}
    __device__ __forceinline__ void operator()(AccT& acc, const pg8::Unit& u, int wr, int wc, int fr, int fq, const Pre& pre_) const {
        asm volatile("" : "+v"(fr), "+v"(fq));
        const int pn = u.pn; const size_t row0 = (size_t)u.orow + wr * 64 + fr;
        if (pn < 4) {
#pragma unroll
            for (int ai = 0; ai < 2; ++ai)
#pragma unroll
                for (int m = 0; m < 4; ++m) { const size_t row = row0 + ai * 128 + m * 16; f32x4 y[2]; const float rr = pre_.r[ai][m];
#pragma unroll
                    for (int n = 0; n < 2; ++n) { const f32x4 a = acc[ai][0][m][n] * rr, g = acc[ai][1][m][n] * rr;
                        y[n] = (f32x4){a[0] * sigmoidf_fast(g[0]), a[1] * sigmoidf_fast(g[1]), a[2] * sigmoidf_fast(g[2]), a[3] * sigmoidf_fast(g[3])}; }
                    __builtin_nontemporal_store(pack8(y[0], y[1]), (v4u*)(YG + row * 512 + pn * 128 + wc * 32 + 8 * fq)); }
        } else if (pn < 8) {
            const bool isq = pn < 6; bf16* base = isq ? QB : KB; const LAS float* gp = gl + (isq ? 0 : 64); const float sc = isq ? 0.125f * 1.4426950408889634f : 1.0f;
            f32x4 gv[2][2];
#pragma unroll
            for (int bj = 0; bj < 2; ++bj)
#pragma unroll
                for (int n = 0; n < 2; ++n) gv[bj][n] = *(const LAS f32x4*)(gp + 32 * bj + 8 * fq + 4 * n) * sc;
#pragma unroll
            for (int ai = 0; ai < 2; ++ai)
#pragma unroll
                for (int m = 0; m < 4; ++m) { const size_t row = row0 + ai * 128 + m * 16; float ss = 0.f; const float rr = pre_.r[ai][m];
#pragma unroll
                    for (int bj = 0; bj < 2; ++bj)
#pragma unroll
                        for (int n = 0; n < 2; ++n) { const f32x4 a = acc[ai][bj][m][n]; ss += (a[0] * a[0] + a[1] * a[1]) + (a[2] * a[2] + a[3] * a[3]); }
                    ss += __shfl_xor(ss, 16); ss += __shfl_xor(ss, 32);
                    const float rinv = rr / sqrtf(ss * rr * rr * (1.0f / 64.0f) + EPS);
#pragma unroll
                    for (int bj = 0; bj < 2; ++bj)
                        __builtin_nontemporal_store(pack8(acc[ai][bj][m][0] * rinv * gv[bj][0], acc[ai][bj][m][1] * rinv * gv[bj][1]), (v4u*)(base + row * 512 + (pn & 1) * 256 + wc * 64 + bj * 32 + 8 * fq)); }
        } else if (pn < 10) {
#pragma unroll
            for (int ai = 0; ai < 2; ++ai)
#pragma unroll
                for (int m = 0; m < 4; ++m) { const size_t row = row0 + ai * 128 + m * 16; const float rr = pre_.r[ai][m];
#pragma unroll
                    for (int bj = 0; bj < 2; ++bj) __builtin_nontemporal_store(pack8(acc[ai][bj][m][0] * rr, acc[ai][bj][m][1] * rr), (v4u*)(VB + row * 512 + (pn - 8) * 256 + bj * 128 + wc * 32 + 8 * fq)); }
        } else {
#pragma unroll
            for (int ai = 0; ai < 2; ++ai)
#pragma unroll
                for (int m = 0; m < 4; ++m) { const size_t row = row0 + ai * 128 + m * 16; f32x4 rr[2], gg[2]; const float rz = -1.4426950408889634f * pre_.r[ai][m];
#pragma unroll
                    for (int n = 0; n < 2; ++n)
#pragma unroll
                        for (int j = 0; j < 4; ++j) { const float e0 = __builtin_amdgcn_exp2f(rz * acc[ai][0][m][n][j]), e1 = fminf(__builtin_amdgcn_exp2f(rz * acc[ai][1][m][n][j]), 1e30f);
                            gg[n][j] = __builtin_amdgcn_rcpf(1.0f + e1); rr[n][j] = (1.0f + e1) * __builtin_amdgcn_rcpf(1.0f + e0); }
                    const size_t o = row * 1024 + (pn - 10) * 128 + wc * 32 + 8 * fq;
                    __builtin_nontemporal_store(pack8(rr[0], rr[1]), (v4u*)(GT + o)); __builtin_nontemporal_store(pack8(gg[0], gg[1]), (v4u*)(GT + (size_t)NTOK * 1024 + o)); }
        }
    }
};
struct EpiMerged {
    static constexpr bool MID = true, PREMID = false;
    struct Pre {}; __device__ __forceinline__ Pre pre(const pg8::Unit&, int, int) const { return Pre{}; }
    const bf16* GR; const bf16* G1; bf16* MG;
    __device__ __forceinline__ void mid(AccT& acc, const pg8::Unit& u, int wr, int wc, int fr, int fq) const {
        asm volatile("" : "+v"(fr), "+v"(fq));
        const size_t row0 = (size_t)u.orow + wr * 64 + fr; const int col0 = u.pn * 256 + wc * 32 + 8 * fq;
        v4u w0[2][4][2];
#pragma unroll
        for (int ai = 0; ai < 2; ++ai)
#pragma unroll
            for (int m = 0; m < 4; ++m)
#pragma unroll
                for (int bj = 0; bj < 2; ++bj) w0[ai][m][bj] = *(const v4u*)(GR + (row0 + ai * 128 + m * 16) * 1024 + col0 + bj * 128);
        __builtin_amdgcn_sched_barrier(0);
#pragma unroll
        for (int ai = 0; ai < 2; ++ai)
#pragma unroll
            for (int m = 0; m < 4; ++m)
#pragma unroll
                for (int bj = 0; bj < 2; ++bj) { f32x4 a0, a1; unpack8(w0[ai][m][bj], a0, a1); acc[ai][bj][m][0] = acc[ai][bj][m][0] * a0; acc[ai][bj][m][1] = acc[ai][bj][m][1] * a1; }
        __builtin_amdgcn_sched_barrier(0);
    }
    __device__ __forceinline__ void operator()(AccT& acc, const pg8::Unit& u, int wr, int wc, int fr, int fq, const Pre& pre_) const {
        asm volatile("" : "+v"(fr), "+v"(fq));
        const size_t row0 = (size_t)u.orow + wr * 64 + fr; const int col0 = u.pn * 256 + wc * 32 + 8 * fq;
        v4u w1[2][4][2];
#pragma unroll
        for (int ai = 0; ai < 2; ++ai)
#pragma unroll
            for (int m = 0; m < 4; ++m)
#pragma unroll
                for (int bj = 0; bj < 2; ++bj) w1[ai][m][bj] = *(const v4u*)(G1 + (row0 + ai * 128 + m * 16) * 1024 + col0 + bj * 128);
        __builtin_amdgcn_sched_barrier(0);
#pragma unroll
        for (int ai = 0; ai < 2; ++ai)
#pragma unroll
            for (int m = 0; m < 4; ++m) { const size_t row = row0 + ai * 128 + m * 16;
#pragma unroll
                for (int bj = 0; bj < 2; ++bj) { f32x4 b0, b1; unpack8(w1[ai][m][bj], b0, b1);
                    *(v4u*)(MG + row * 1024 + col0 + bj * 128) = pack8(acc[ai][bj][m][0] * b0, acc[ai][bj][m][1] * b1); } }
    }
};
struct EpiOut {
    static constexpr bool MID = false, PREMID = false;
    struct Pre {}; __device__ __forceinline__ Pre pre(const pg8::Unit&, int, int) const { return Pre{}; }
    const bf16* XB; bf16* XMB; unsigned char* XM8;
    __device__ __forceinline__ void mid(AccT&, const pg8::Unit&, int, int, int, int) const {}
    __device__ __forceinline__ void operator()(AccT& acc, const pg8::Unit& u, int wr, int wc, int fr, int fq, const Pre& pre_) const {
        asm volatile("" : "+v"(fr), "+v"(fq));
        const size_t row0 = (size_t)u.orow + wr * 64 + fr; const int col0 = u.pn * 256 + wc * 32 + 8 * fq;
        v4u xw[2][4][2];
#pragma unroll
        for (int ai = 0; ai < 2; ++ai)
#pragma unroll
            for (int m = 0; m < 4; ++m)
#pragma unroll
                for (int bj = 0; bj < 2; ++bj) xw[ai][m][bj] = __builtin_nontemporal_load((const v4u*)(XB + (row0 + ai * 128 + m * 16) * 1024 + col0 + bj * 128));
        __builtin_amdgcn_sched_barrier(0);
#pragma unroll
        for (int ai = 0; ai < 2; ++ai)
#pragma unroll
            for (int m = 0; m < 4; ++m) { const size_t off = (row0 + ai * 128 + m * 16) * 1024 + col0;
#pragma unroll
                for (int bj = 0; bj < 2; ++bj) { f32x4 x0, x1; unpack8(xw[ai][m][bj], x0, x1); const f32x4 o0 = x0 + acc[ai][bj][m][0], o1 = x1 + acc[ai][bj][m][1];
                    *(v4u*)(XMB + off + bj * 128) = pack8(o0, o1);
                    v2u w8; w8.x = pg8::pack4_fp8(o0[0], o0[1], o0[2], o0[3]); w8.y = pg8::pack4_fp8(o1[0], o1[1], o1[2], o1[3]); *(v2u*)(XM8 + off + bj * 128) = w8; } }
        __builtin_amdgcn_sched_barrier(0);
    }
};
struct EpiGateUp {
    static constexpr bool MID = false, PREMID = false;
    typedef int i32x4 __attribute__((ext_vector_type(4)));
    struct Pre { int dst[2][4]; float w[2][4], rs[2][4]; };
    __device__ __forceinline__ Pre pre(const pg8::Unit& u, int wr, int fr) const { Pre p;
#pragma unroll
        for (int ai = 0; ai < 2; ++ai)
#pragma unroll
            for (int m = 0; m < 4; ++m) { const int r = ai * 128 + wr * 64 + m * 16 + fr; const i32x4 en = (r < u.nvalid) ? *(const i32x4*)(LIST + (size_t)(u.lrow + r) * 4) : (i32x4){-1, -1, 0, 0};
                p.dst[ai][m] = en[1]; p.w[ai][m] = __int_as_float(en[2]); p.rs[ai][m] = __int_as_float(en[3]); }
        return p; }
    const int* LIST; unsigned char* HP8; const LAS int* m2;
    __device__ __forceinline__ void mid(AccT&, const pg8::Unit&, int, int, int, int) const {}
    __device__ __forceinline__ void operator()(AccT& acc, const pg8::Unit& u, int wr, int wc, int fr, int fq, const Pre& pre_) const {
        asm volatile("" : "+v"(fr), "+v"(fq));
#pragma unroll
        for (int ai = 0; ai < 2; ++ai)
#pragma unroll
            for (int m = 0; m < 4; ++m) { const int dst = pre_.dst[ai][m]; if (dst < 0) continue;
                const float rs = pre_.rs[ai][m] * (1.0f / 64.0f), w8 = pre_.w[ai][m] * 8.0f;
                const size_t drow = (size_t)m2[dst >> 17] * 256 + ((dst >> 1) & 0xffff);
                float h[8];
#pragma unroll
                for (int n = 0; n < 2; ++n)
#pragma unroll
                    for (int j = 0; j < 4; ++j) { const float g = acc[ai][0][m][n][j] * rs, up = acc[ai][1][m][n][j] * rs; h[4 * n + j] = __builtin_amdgcn_fmed3f(g * sigmoidf_fast(g) * up * w8, -448.f, 448.f); }
                v2u o8; o8.x = pg8::pack4_fp8(h[0], h[1], h[2], h[3]); o8.y = pg8::pack4_fp8(h[4], h[5], h[6], h[7]);
                *(v2u*)(HP8 + drow * 1024 + (dst & 1) * 512 + u.pn * 128 + wc * 32 + 8 * fq) = o8; }
    }
};
struct EpiDownAdd {
    static constexpr bool MID = false, PREMID = true;
    struct Pre { int tok[2][4]; };
    __device__ __forceinline__ Pre pre(const pg8::Unit& u, int wr, int fr) const { Pre p;
#pragma unroll
        for (int ai = 0; ai < 2; ++ai)
#pragma unroll
            for (int m = 0; m < 4; ++m) { const int r = ai * 128 + wr * 64 + m * 16 + fr; p.tok[ai][m] = (r < u.nvalid) ? CTOK[u.lrow + r] : -1; }
        return p; }
    const int* CTOK; const bf16* XMB; float* out;
    __device__ __forceinline__ void mid(AccT&, const pg8::Unit&, int, int, int, int) const {}
    __device__ __forceinline__ void operator()(AccT& acc, const pg8::Unit& u, int wr, int wc, int fr, int fq, const Pre& pre_) const {
        asm volatile("" : "+v"(fr), "+v"(fq));
        const int col0 = u.pn * 256 + wc * 32 + 8 * fq;
        v4u xw[2][4][2];
#pragma unroll
        for (int ai = 0; ai < 2; ++ai)
#pragma unroll
            for (int m = 0; m < 4; ++m) { const int tk = pre_.tok[ai][m]; const size_t off = (size_t)(tk < 0 ? 0 : tk) * 1024 + col0;
#pragma unroll
                for (int bj = 0; bj < 2; ++bj) xw[ai][m][bj] = *(const v4u*)(XMB + off + bj * 128); }
        __builtin_amdgcn_sched_barrier(0);
#pragma unroll
        for (int ai = 0; ai < 2; ++ai)
#pragma unroll
            for (int m = 0; m < 4; ++m) { const int tk = pre_.tok[ai][m]; if (tk < 0) continue; const size_t off = (size_t)tk * 1024 + col0;
#pragma unroll
                for (int bj = 0; bj < 2; ++bj) { f32x4 x0, x1; unpack8(xw[ai][m][bj], x0, x1);
                    __builtin_nontemporal_store(x0 + acc[ai][bj][m][0] * (1.0f / 256.0f), (f32x4*)(out + off + bj * 128)); __builtin_nontemporal_store(x1 + acc[ai][bj][m][1] * (1.0f / 256.0f), (f32x4*)(out + off + bj * 128 + 4)); } }
    }
};
struct MoeOrder {
    int G, c, total; const LAS int* meta;
    __device__ __forceinline__ bool next(int i, pg8::Unit& u) const {
        const int L = i * G + c; if (L >= total * 4) return false;
        const int blk = L >> 2; const int lane = tid_opaque() & 63;
        const int e = __builtin_amdgcn_readfirstlane(__builtin_popcountll(__ballot(lane < NEXP - 1 && meta[1 + lane] <= blk)));
        const int pre = __builtin_amdgcn_readfirstlane(meta[e]), cnt = __builtin_amdgcn_readfirstlane(meta[64 + e]); const int rb = blk - pre;
        u.pn = L & 3; u.pm = rb; u.e = e; u.e2 = e; u.lrow = e * LCAP + rb * 256; u.nvalid = min(256, cnt - rb * 256); u.orow = blk * 256; u.arow = 0; return true;
    }
};
struct ClassOrder {
    int G, c, total; const LAS int* m2;
    __device__ __forceinline__ bool next(int i, pg8::Unit& u) const {
        const int L = i * G + c; if (L >= total * 4) return false;
        const int blk = L >> 2; const int lane = tid_opaque() & 63;
        const int n0 = __builtin_popcountll(__ballot(m2[1 + lane] <= blk)), n1 = __builtin_popcountll(__ballot(lane + 65 <= NCLS - 1 && m2[65 + lane] <= blk));
        const int cls = __builtin_amdgcn_readfirstlane(n0 + n1);
        const int pre = __builtin_amdgcn_readfirstlane(m2[cls]), cnt = __builtin_amdgcn_readfirstlane(m2[128 + cls]); const int rb = blk - pre;
        const int g = cls / 28; int p = cls % 28, a = 0;
        while (p >= 7 - a) { p -= 7 - a; ++a; }
        u.e = g * 8 + a; u.e2 = g * 8 + a + 1 + p; u.pn = L & 3; u.pm = rb; u.lrow = cls * NTOK + rb * 256; u.nvalid = min(256, cnt - rb * 256); u.orow = blk * 256; u.arow = u.orow; return true;
    }
};
__device__ __forceinline__ void moe_meta(LAS int* meta, LAS int* m2, const unsigned* ctl) {
    const int tid = tid_opaque();
    if (tid < NEXP) meta[64 + tid] = (int)__hip_atomic_load(ctl + tid, __ATOMIC_RELAXED, __HIP_MEMORY_SCOPE_AGENT);
    if (tid >= 64 && tid < 64 + NCLS) m2[128 + tid - 64] = (int)__hip_atomic_load(ctl + tid, __ATOMIC_RELAXED, __HIP_MEMORY_SCOPE_AGENT);
    __syncthreads();
    if (tid == 0) { int p = 0;
        for (int e = 0; e < NEXP; ++e) { meta[e] = p; p += (meta[64 + e] + 255) >> 8; }
        meta[NEXP] = p; }
    if (tid == 64) { int p = 0;
        for (int c = 0; c < NCLS; ++c) { m2[c] = p; p += (m2[128 + c] + 255) >> 8; }
        m2[NCLS] = p; }
    __syncthreads();
}

__device__ __forceinline__ void transpose_item(const float* W, int N, int k0, int n0, bf16* WT, int dpitch, int drow0, int dcol0, const float* kscale, LAS float* scr, int lane) {
    const int kr = lane >> 3, nc = (lane & 7) * 4;
    f32x4 v[8];
#pragma unroll
    for (int i = 0; i < 8; ++i) v[i] = *(const f32x4*)(W + (size_t)(k0 + i * 8 + kr) * N + n0 + nc);
    if (kscale) {
#pragma unroll
        for (int i = 0; i < 8; ++i) v[i] = v[i] * kscale[k0 + i * 8 + kr]; }
#pragma unroll
    for (int i = 0; i < 8; ++i) { LAS float* d = scr + (i * 8 + kr) * 33 + nc; d[0] = v[i][0]; d[1] = v[i][1]; d[2] = v[i][2]; d[3] = v[i][3]; }
    asm volatile("s_waitcnt lgkmcnt(0)" ::: "memory");
    const int c = lane & 7;
#pragma unroll
    for (int j = 0; j < 4; ++j) { const int n = (lane >> 3) + 8 * j; const LAS float* s = scr + (8 * c) * 33 + n;
        v4u o; o.x = cvt_pk_bf16(s[0 * 33], s[1 * 33]); o.y = cvt_pk_bf16(s[2 * 33], s[3 * 33]); o.z = cvt_pk_bf16(s[4 * 33], s[5 * 33]); o.w = cvt_pk_bf16(s[6 * 33], s[7 * 33]);
        *(v4u*)(WT + (size_t)(drow0 + n) * dpitch + dcol0 + k0 + 8 * c) = o; }
    asm volatile("s_waitcnt lgkmcnt(0)" ::: "memory");
}
__device__ __forceinline__ void t8_load(f32x4 (&v)[8], const float* W, int N, int k0, int n0, int lane) {
    const int kr = lane >> 3, nc = (lane & 7) * 4;
#pragma unroll
    for (int i = 0; i < 8; ++i) v[i] = __builtin_nontemporal_load((const f32x4*)(W + (size_t)(k0 + i * 8 + kr) * N + n0 + nc));
}
__device__ __forceinline__ void t8_finish(f32x4 (&v)[8], int k0, unsigned char* WT, int dpitch, int drow0, const float* kscale, float mul, LAS float* scr, int lane) {
    const int kr = lane >> 3, nc = (lane & 7) * 4;
#pragma unroll
    for (int i = 0; i < 8; ++i) v[i] = v[i] * (kscale ? kscale[k0 + i * 8 + kr] * mul : mul);
#pragma unroll
    for (int i = 0; i < 8; ++i) { LAS float* d = scr + (i * 8 + kr) * 33 + nc; d[0] = v[i][0]; d[1] = v[i][1]; d[2] = v[i][2]; d[3] = v[i][3]; }
    asm volatile("s_waitcnt lgkmcnt(0)" ::: "memory");
    const int c = lane & 7;
#pragma unroll
    for (int j = 0; j < 4; ++j) { const int n = (lane >> 3) + 8 * j; const LAS float* s = scr + (8 * c) * 33 + n;
        v2u o; o.x = pg8::pack4_fp8(s[0 * 33], s[1 * 33], s[2 * 33], s[3 * 33]); o.y = pg8::pack4_fp8(s[4 * 33], s[5 * 33], s[6 * 33], s[7 * 33]);
        *(v2u*)(WT + (size_t)(drow0 + n) * dpitch + k0 + 8 * c) = o; }
    asm volatile("s_waitcnt lgkmcnt(0)" ::: "memory");
}
__device__ __forceinline__ void transpose_item_fp8(const float* W, int N, int k0, int n0, unsigned char* WT, int dpitch, int drow0, const float* kscale, float mul, LAS float* scr, int lane) {
    f32x4 v[8]; t8_load(v, W, N, k0, n0, lane); t8_finish(v, k0, WT, dpitch, drow0, kscale, mul, scr, lane);
}
__device__ __forceinline__ int inproj_phys(int c) {
    if (c < 512) return (c >> 7) * 256 + (c & 127);
    if (c < 1024) { c -= 512; return (c >> 7) * 256 + 128 + (c & 127); }
    if (c < 2048) { const int sec = (c - 1024) >> 8, cl = (c - 1024) & 255, s = cl >> 6, d = cl & 63; return 1024 + sec * 256 + ((d >> 5) << 7) + (s << 5) + (d & 31); }
    if (c < 2560) return c;
    { int j = c - 2560; const int hi = j >= 1024; j &= 1023; return 2560 + (j >> 7) * 256 + hi * 128 + (j & 127); }
}
struct Ptrs {
    const float *x, *attn_norm_g, *w_in, *conv_dw_w, *conv_dw_b, *conv_ln_g, *conv_ln_b, *w_conv_out, *q_norm_g, *k_norm_g, *lq1, *lk1, *lq2, *lk2, *subln_g,
        *w_attn_out, *w_out, *ffn_norm_g, *w_rg, *b_rg, *w_re, *b_re, *w_gate, *w_up, *w_down;
    float* out; unsigned char* ws;
};

__device__ __forceinline__ void p0_prologue(const Ptrs& P, LAS unsigned char* lds, int vcu, int G) {
    const int tid = tid_opaque(), lane = tid & 63, wave = __builtin_amdgcn_readfirstlane(tid >> 6);
    LAS float* scr = (LAS float*)(lds + wave * 16384);
    const int gw = vcu * NWAVES + wave, NGW = G * NWAVES;
    bf16* WIN = (bf16*)(P.ws + WS_WIN); bf16* WCA = (bf16*)(P.ws + WS_WCA); bf16* WOUT = (bf16*)(P.ws + WS_WOUT);
    constexpr int I_IN = (DMODEL / 64) * (IN_COLS / 32), I_C = (CONV_CH / 64) * (DMODEL / 32), I_O = (DMODEL / 64) * (DMODEL / 32);
    for (int it = gw; it < I_IN + 2 * I_C + I_O; it += NGW) {
        int r = it;
        if (r < I_IN) { const int kb = r / (IN_COLS / 32), nb = r % (IN_COLS / 32); transpose_item(P.w_in, IN_COLS, kb * 64, nb * 32, WIN, 1024, inproj_phys(nb * 32), 0, P.attn_norm_g, scr, lane); continue; } r -= I_IN;
        if (r < I_C) { const int kb = r / 32, nb = r % 32; transpose_item(P.w_conv_out, DMODEL, kb * 64, nb * 32, WCA, 1024, nb * 32, 0, nullptr, scr, lane); continue; } r -= I_C;
        if (r < I_C) { const int kb = r / 32, nb = r % 32; transpose_item(P.w_attn_out, DMODEL, kb * 64, nb * 32, WCA, 1024, nb * 32, 512, nullptr, scr, lane); continue; } r -= I_C;
        { const int kb = r / 32, nb = r % 32; transpose_item(P.w_out, DMODEL, kb * 64, nb * 32, WOUT, 1024, nb * 32, 0, nullptr, scr, lane); }
    }
    bf16* WRhi = (bf16*)(P.ws + WS_WR); bf16* WRlo = WRhi + 64 * 1024;
    for (int idx = vcu * NTHREADS + tid; idx < 64 * 1024; idx += G * NTHREADS) {
        const int n = idx >> 10, k = idx & 1023; float v = 0.f;
        if (n < 4) v = P.w_rg[k * 4 + n]; else if (n < 36) v = P.w_re[k * 32 + (n - 4)];
        v *= P.ffn_norm_g[k];
        const unsigned hb = cvt_pk_bf16(v, 0.f) & 0xffffu; const float hf = __uint_as_float(hb << 16);
        WRhi[idx] = (bf16)hb; WRlo[idx] = (bf16)(cvt_pk_bf16(v - hf, 0.f) & 0xffffu);
    }
    bf16* HB = (bf16*)(P.ws + WS_XB); float* RR = (float*)(P.ws + WS_R);
    constexpr int RPT = 4;
    for (int m = gw; m < NTOK; m += RPT * NGW) {
        f32x4 v[RPT][4];
#pragma unroll
        for (int q = 0; q < RPT; ++q) { const int mq = m + q * NGW; const f32x4* xr = (const f32x4*)(P.x + (size_t)(mq < NTOK ? mq : m) * DMODEL) + lane;
#pragma unroll
            for (int j = 0; j < 4; ++j) v[q][j] = __builtin_nontemporal_load(xr + 64 * j); }
#pragma unroll
        for (int q = 0; q < RPT; ++q) { const int mq = m + q * NGW; float ss = 0.f;
#pragma unroll
            for (int j = 0; j < 4; ++j) ss += (v[q][j][0] * v[q][j][0] + v[q][j][1] * v[q][j][1]) + (v[q][j][2] * v[q][j][2] + v[q][j][3] * v[q][j][3]);
            const float r = 1.0f / sqrtf(wave_sum(ss) * (1.0f / DMODEL) + EPS);
            if (mq < NTOK) { v2u* o8 = (v2u*)(HB + (size_t)mq * DMODEL) + lane; if (lane == 0) RR[mq] = r;
#pragma unroll
                for (int j = 0; j < 4; ++j) { const f32x4 y = v[q][j]; v2u w; w.x = cvt_pk_bf16(y[0], y[1]); w.y = cvt_pk_bf16(y[2], y[3]); o8[64 * j] = w; } } }
    }
}

__device__ __forceinline__ void conv_phase(const Ptrs& P, LAS unsigned char* lds, int first, int stride) {
    const int tid = tid_opaque(), lane = tid & 63, wave = __builtin_amdgcn_readfirstlane(tid >> 6);
    const bf16* YG = (const bf16*)(P.ws + WS_YG); bf16* CA = (bf16*)(P.ws + WS_CA);
    LAS bf16* yt = (LAS bf16*)lds; LAS float* co = (LAS float*)(lds + 62 * 1024);
    constexpr int NT = NTOK / 32;
    if (first >= NT) return;
    float w[CONV_W];
#pragma unroll
    for (int j = 0; j < CONV_W; ++j) w[j] = P.conv_dw_w[j * CONV_CH + tid];
    const float bias = P.conv_dw_b[tid];
    const f32x4 g0 = ((const f32x4*)P.conv_ln_g)[lane], g1 = ((const f32x4*)P.conv_ln_g)[64 + lane], b0 = ((const f32x4*)P.conv_ln_b)[lane], b1 = ((const f32x4*)P.conv_ln_b)[64 + lane];
    v4u pre[8];
#define CONV_FETCH(tile) do { const int b_ = (tile) / (SEQ / 32), t0_ = ((tile) % (SEQ / 32)) * 32; _Pragma("unroll") for (int p = 0; p < 8; ++p) { const int q = tid + NTHREADS * p; const int row = q >> 6, ch = q & 63, t = t0_ - 30 + row; \
        pre[p] = (v4u){0u, 0u, 0u, 0u}; if (q < 62 * 64 && t >= 0) pre[p] = *(const v4u*)(YG + ((size_t)(b_ * SEQ + t)) * 512 + ch * 8); } } while (0)
    CONV_FETCH(first);
    for (int tile = first; tile < NT; tile += stride) {
        const int b = tile / (SEQ / 32), t0 = (tile % (SEQ / 32)) * 32;
#pragma unroll
        for (int p = 0; p < 8; ++p) { const int q = tid + NTHREADS * p; if (q < 62 * 64) *(LAS v4u*)(yt + (q >> 6) * 512 + (q & 63) * 8) = pre[p]; }
        __syncthreads();
        if (tile + stride < NT) CONV_FETCH(tile + stride);
        float yv[62];
#pragma unroll
        for (int i = 0; i < 62; ++i) yv[i] = __uint_as_float((unsigned)yt[i * 512 + tid] << 16);
#pragma unroll
        for (int t = 0; t < 32; ++t) { float a = bias;
#pragma unroll
            for (int j = 0; j < CONV_W; ++j) a += w[j] * yv[t + j];
            co[t * 512 + tid] = a; }
        __syncthreads();
#pragma unroll
        for (int rr = 0; rr < 4; ++rr) { const int row = wave * 4 + rr;
            const f32x4 v0 = *(const LAS f32x4*)(co + row * 512 + lane * 4), v1 = *(const LAS f32x4*)(co + row * 512 + 256 + lane * 4);
            const float mean = wave_sum((v0[0] + v0[1]) + (v0[2] + v0[3]) + (v1[0] + v1[1]) + (v1[2] + v1[3])) * (1.0f / CONV_CH);
            const f32x4 d0 = v0 - mean, d1 = v1 - mean;
            const float var = wave_sum((d0[0] * d0[0] + d0[1] * d0[1]) + (d0[2] * d0[2] + d0[3] * d0[3]) + (d1[0] * d1[0] + d1[1] * d1[1]) + (d1[2] * d1[2] + d1[3] * d1[3])) * (1.0f / CONV_CH);
            const float rstd = 1.0f / sqrtf(var + EPS);
            f32x4 y0 = d0 * rstd * g0 + b0, y1 = d1 * rstd * g1 + b1;
#pragma unroll
            for (int j = 0; j < 4; ++j) { y0[j] = y0[j] * sigmoidf_fast(y0[j]); y1[j] = y1[j] * sigmoidf_fast(y1[j]); }
            bf16* orow = CA + ((size_t)(b * SEQ + t0 + row)) * 1024;
            v2u o0, o1; o0.x = cvt_pk_bf16(y0[0], y0[1]); o0.y = cvt_pk_bf16(y0[2], y0[3]); o1.x = cvt_pk_bf16(y1[0], y1[1]); o1.y = cvt_pk_bf16(y1[2], y1[3]);
            *(v2u*)(orow + lane * 4) = o0; *(v2u*)(orow + 256 + lane * 4) = o1; }
        __syncthreads();
    }
#undef CONV_FETCH
}

__device__ __forceinline__ void attn_pair(const Ptrs& P, LAS unsigned char* lds, char* lds_generic, int p) {
    const int tid = tid_opaque(), lane = tid & 63, wave = __builtin_amdgcn_readfirstlane(tid >> 6);
    const int bh = p >> 3, s = p & 7, b = bh >> 2, h = bh & 3;
    const __hip_bfloat16* QB = (const __hip_bfloat16*)(P.ws + WS_QB); const __hip_bfloat16* KB = (const __hip_bfloat16*)(P.ws + WS_KB); const __hip_bfloat16* VB = (const __hip_bfloat16*)(P.ws + WS_VB);
    __hip_bfloat16* OT = (__hip_bfloat16*)(P.ws + WS_A); bf16* CA = (bf16*)(P.ws + WS_CA);
    float mstat;
    { int l0 = lane; asm volatile("" : "+v"(l0));
      const float a = wave_max(fabsf(P.q_norm_g[l0])), b = wave_max(fabsf(P.k_norm_g[l0]));
      mstat = __int_as_float(__builtin_amdgcn_readfirstlane(__float_as_int(0.125f * 1.4426950408889634f * 64.0f * 1.02f * a * b))); }
    float lam;
    { int l1 = lane; asm volatile("" : "+v"(l1));
      lam = __int_as_float(__builtin_amdgcn_readfirstlane(__float_as_int(__expf(wave_sum(P.lq1[l1] * P.lk1[l1])) - __expf(wave_sum(P.lq2[l1] * P.lk2[l1])) + 0.2f))); }
    int s0 = 0; bool pre = false;
#pragma unroll 1
    for (int u4 = 0; u4 < 4; ++u4) { const int i = u4 >> 1, c = u4 & 1;
        const int qb = (i == 0) ? s : 15 - s;
        const __hip_bfloat16* q_ = QB + (size_t)b * SEQ * 512 + (h * 2 + c) * 64; const __hip_bfloat16* k_ = KB + (size_t)b * SEQ * 512 + (h * 2 + c) * 64; const __hip_bfloat16* v_ = VB + (size_t)b * SEQ * 512 + h * 128;
        const __hip_bfloat16* kn_ = (u4 < 3) ? KB + (size_t)b * SEQ * 512 + (h * 2 + (c ^ 1)) * 64 : nullptr;
        __hip_bfloat16* o_ = OT + (size_t)b * SEQ * 1024 + (h * 2) * 128;
        const __hip_bfloat16* o1_ = c ? o_ : nullptr; unsigned short* ca_ = CA + (size_t)b * SEQ * 1024 + 512 + h * 128;
        int sn;
        if (mstat <= 40.0f) sn = attn_body::attn_unit<8, true>(mstat, qb * 256, q_, k_, v_, o_, lds_generic, o1_, lam, P.subln_g, ca_, kn_, v_, s0, pre);
        else sn = attn_body::attn_unit<8, false>(0.f, qb * 256, q_, k_, v_, o_, lds_generic, o1_, lam, P.subln_g, ca_, kn_, v_, s0, pre);
        s0 = sn; pre = (kn_ != nullptr); }
}

__device__ __forceinline__ void router_tile(const Ptrs& P, LAS unsigned char* lds, int tile) {
    const int tid = tid_opaque(), lane = tid & 63, wave = __builtin_amdgcn_readfirstlane(tid >> 6), r32 = lane & 31, hi = lane >> 5;
    const bf16* WRhi = (const bf16*)(P.ws + WS_WR); const bf16* WRlo = WRhi + 64 * 1024;
    int* LIST = (int*)(P.ws + WS_LIST); int* CTOK = (int*)(P.ws + WS_CTOK); unsigned* cnt = (unsigned*)(P.ws + WS_CTL); unsigned* ccnt = cnt + 64;
    LAS float* lg = (LAS float*)(lds + wave * 8448);
    LAS int* hist = (LAS int*)(lds + HIST_OFF); LAS int* hbase = hist + 32; LAS int* hist2 = hist + 64; LAS int* hbase2 = hist2 + NCLS;
    if (tid < 32) hist[tid] = 0;
    if (tid >= 64 && tid < 64 + NCLS) hist2[tid - 64] = 0;
    __syncthreads();
    const int tbase = tile * 256 + wave * 32;
    const bf16* xr = (const bf16*)(P.ws + WS_CA) + (size_t)(tbase + r32) * DMODEL + 8 * hi;
    const bf16* bh0 = WRhi + (size_t)r32 * 1024 + 8 * hi; const bf16* bl0 = WRlo + (size_t)r32 * 1024 + 8 * hi;
    f32x16 acc0 = {}, acc1 = {}; float ssq = 0.f;
#pragma unroll 4
    for (int ks = 0; ks < 64; ++ks) {
        const v4u xa = *(const v4u*)(xr + ks * 16);
        f32x4 x0, x1; unpack8(xa, x0, x1);
        ssq += (x0[0] * x0[0] + x0[1] * x0[1]) + (x0[2] * x0[2] + x0[3] * x0[3]) + (x1[0] * x1[0] + x1[1] * x1[1]) + (x1[2] * x1[2] + x1[3] * x1[3]);
        const bf16x8 a_hi = __builtin_bit_cast(bf16x8, xa);
        const bf16x8 bh_0 = *(const bf16x8*)(bh0 + ks * 16), bh_1 = *(const bf16x8*)(bh0 + 32 * 1024 + ks * 16), bl_0 = *(const bf16x8*)(bl0 + ks * 16), bl_1 = *(const bf16x8*)(bl0 + 32 * 1024 + ks * 16);
        acc0 = __builtin_amdgcn_mfma_f32_32x32x16_bf16(a_hi, bh_0, acc0, 0, 0, 0); acc1 = __builtin_amdgcn_mfma_f32_32x32x16_bf16(a_hi, bh_1, acc1, 0, 0, 0);
        acc0 = __builtin_amdgcn_mfma_f32_32x32x16_bf16(a_hi, bl_0, acc0, 0, 0, 0); acc1 = __builtin_amdgcn_mfma_f32_32x32x16_bf16(a_hi, bl_1, acc1, 0, 0, 0);
    }
    ssq += __shfl_xor(ssq, 32);
    const float rs = 1.0f / sqrtf(ssq * (1.0f / DMODEL) + EPS);
#pragma unroll
    for (int r = 0; r < 16; ++r) { const int m = (r & 3) + 8 * (r >> 2) + 4 * hi; lg[m * 66 + r32] = acc0[r]; lg[m * 66 + 32 + r32] = acc1[r]; }
    asm volatile("s_waitcnt lgkmcnt(0)" ::: "memory");
    int ea = 0, eb = 0, cls = 0, lpa = 0, lpb = 0, lpc = 0; float wa = 0.f, wb = 0.f;
    if (lane < 32) {
        const LAS float* L = lg + lane * 66;
        float gl[4];
#pragma unroll
        for (int j = 0; j < 4; ++j) gl[j] = L[j] * rs + P.b_rg[j];
        int gs = 0; float gm = gl[0];
#pragma unroll
        for (int j = 1; j < 4; ++j) if (gl[j] > gm) { gm = gl[j]; gs = j; }
        float gsum = 0.f;
#pragma unroll
        for (int j = 0; j < 4; ++j) gsum += __expf(gl[j] - gm);
        const float gw = 1.0f / gsum;
        float l0 = -INFINITY, l1 = -INFINITY; int i0 = 0, i1 = 0;
#pragma unroll
        for (int j = 0; j < 8; ++j) { const float v = L[4 + gs * 8 + j] * rs + P.b_re[gs * 8 + j];
            if (v > l0) { l1 = l0; i1 = i0; l0 = v; i0 = j; } else if (v > l1) { l1 = v; i1 = j; } }
        const float q = __expf(l1 - l0), inv = 1.0f / (1.0f + q);
        const float w0 = inv * gw, w1 = q * inv * gw;
        const int a = min(i0, i1), b = max(i0, i1);
        wa = (i0 < i1) ? w0 : w1; wb = (i0 < i1) ? w1 : w0;
        ea = gs * 8 + a; eb = gs * 8 + b; cls = gs * 28 + (a * (15 - a)) / 2 + (b - a - 1);
        lpa = __hip_atomic_fetch_add(&hist[ea], 1, __ATOMIC_RELAXED, __HIP_MEMORY_SCOPE_WORKGROUP); lpb = __hip_atomic_fetch_add(&hist[eb], 1, __ATOMIC_RELAXED, __HIP_MEMORY_SCOPE_WORKGROUP);
        lpc = __hip_atomic_fetch_add(&hist2[cls], 1, __ATOMIC_RELAXED, __HIP_MEMORY_SCOPE_WORKGROUP);
    }
    __syncthreads();
    if (tid < 32) hbase[tid] = (int)atomicAdd(cnt + tid, (unsigned)hist[tid]);
    if (tid >= 64 && tid < 64 + NCLS) { const int c = tid - 64; const int n = hist2[c]; hbase2[c] = n ? (int)atomicAdd(ccnt + c, (unsigned)n) : 0; }
    __syncthreads();
    if (lane < 32) { const int t = tbase + lane; const int pa = hbase[ea] + lpa, pb = hbase[eb] + lpb, pc = hbase2[cls] + lpc;
        typedef int i32x4 __attribute__((ext_vector_type(4)));
        const int dst = (cls << 17) | (pc << 1);
        *(i32x4*)(LIST + (size_t)(ea * LCAP + pa) * 4) = (i32x4){t, dst, __float_as_int(wa), __float_as_int(rs)};
        *(i32x4*)(LIST + (size_t)(eb * LCAP + pb) * 4) = (i32x4){t, dst | 1, __float_as_int(wb), __float_as_int(rs)};
        CTOK[(size_t)cls * NTOK + pc] = t; }
    __syncthreads();
}

__device__ __forceinline__ void p5_convert(const Ptrs& P, LAS unsigned char* lds, int vcu, int G) {
    const int tid = tid_opaque(), lane = tid & 63, wave = __builtin_amdgcn_readfirstlane(tid >> 6);
    LAS float* scr = (LAS float*)(lds + wave * 16384);
    const int gw = vcu * NWAVES + wave, NGW = G * NWAVES;
    unsigned char* WGU = P.ws + WS_WGU; unsigned char* WD = P.ws + WS_WD;
    constexpr int I_G = (DMODEL / 64) * (DEXP / 32);
    constexpr int I_D = (DEXP / 64) * (DMODEL / 32);
    constexpr int PER_E = 2 * I_G + I_D;
    constexpr int NITEMS = NEXP * PER_E, NRW = (NTOK / 256) * NWAVES;
    constexpr int SA = P5_SPLIT_A, SB = 24 - SA;
    const bool split = (G == 256) && (NITEMS == NRW * SA + (256 * NWAVES - NRW) * SB);
    const bool rwg = (int)blockIdx.x < NTOK / 256; const int wv = ((int)blockIdx.x - (rwg ? 0 : NTOK / 256)) * NWAVES + wave;
    const int it0 = split ? (rwg ? wv : NRW * SA + wv) : gw, itn = split ? (rwg ? NRW * SA : NITEMS) : NITEMS, its = split ? NRW : NGW;
    struct Item { const float* W; int N, k0, n0; unsigned char* WT; int dpitch, drow0; const float* ks; float mul; };
    auto decode = [&](int it) { Item q; const int e = it / PER_E; int r = it % PER_E;
        if (r < 2 * I_G) { const int up = r / I_G; r %= I_G; const int kb = r / (DEXP / 32), nb = r % (DEXP / 32), n0 = nb * 32;
            q.W = (up ? P.w_up : P.w_gate) + (size_t)e * DMODEL * DEXP; q.N = DEXP; q.k0 = kb * 64; q.n0 = n0; q.WT = WGU + (size_t)e * 1024 * 1024; q.dpitch = 1024; q.drow0 = (n0 >> 7) * 256 + up * 128 + (n0 & 127); q.ks = P.ffn_norm_g; q.mul = 64.f;
        } else { r -= 2 * I_G; const int kb = r / (DMODEL / 32), nb = r % (DMODEL / 32);
            q.W = P.w_down + (size_t)e * DEXP * DMODEL; q.N = DMODEL; q.k0 = kb * 64; q.n0 = nb * 32; q.WT = WD + (size_t)e * 1024 * 512; q.dpitch = 512; q.drow0 = nb * 32; q.ks = nullptr; q.mul = 32.f; }
        return q; };
    for (int it = it0; it < itn; it += 4 * its) {
        const bool h1 = it + its < itn, h2 = it + 2 * its < itn, h3 = it + 3 * its < itn;
        const Item a = decode(it), b = decode(h1 ? it + its : it), c = decode(h2 ? it + 2 * its : it), d = decode(h3 ? it + 3 * its : it);
        f32x4 va[8], vb[8], vc[8], vd[8];
        t8_load(va, a.W, a.N, a.k0, a.n0, lane); t8_load(vb, b.W, b.N, b.k0, b.n0, lane); t8_load(vc, c.W, c.N, c.k0, c.n0, lane); t8_load(vd, d.W, d.N, d.k0, d.n0, lane);
        t8_finish(va, a.k0, a.WT, a.dpitch, a.drow0, a.ks, a.mul, scr, lane);
        if (h1) t8_finish(vb, b.k0, b.WT, b.dpitch, b.drow0, b.ks, b.mul, scr, lane);
        if (h2) t8_finish(vc, c.k0, c.WT, c.dpitch, c.drow0, c.ks, c.mul, scr, lane);
        if (h3) t8_finish(vd, d.k0, d.WT, d.dpitch, d.drow0, d.ks, d.mul, scr, lane);
    }
}

struct Args { Ptrs p; int ph_lo, ph_hi, use_cg, pad; };
__global__ void __launch_bounds__(NTHREADS, 2) mega_fwd(Args args) {
    extern __shared__ __attribute__((aligned(16))) unsigned char lds_raw[];
    LAS unsigned char* lds = (LAS unsigned char*)lds_raw;
    const Ptrs& P = args.p;
    const int tid = tid_opaque();
    const int G = gridDim.x, bx = blockIdx.x; const int vcu = (G % 8 == 0) ? (bx % 8) * (G / 8) + bx / 8 : bx;
    const int lo = args.ph_lo, hi = args.ph_hi;
    LAS int* meta = (LAS int*)(lds + META_OFF);
    if (tid < 2) ((volatile LAS unsigned*)(lds + BARST_OFF))[tid] = 0u;
    __syncthreads();
    XcdBarrier bar = xcd_barrier_post((unsigned*)(P.ws + WS_CTL) + 1024, (volatile LAS unsigned*)(lds + BARST_OFF));
#ifndef PHASE_MASK
#define PHASE_MASK 0xff
#endif
#ifndef DUP_PHASE
#define DUP_PHASE -1
#endif
#define REPS(k) for (int rep_ = 0; rep_ < ((DUP_PHASE == (k)) ? 2 : 1); ++rep_)
#define REPBAR() do { if (rep_) xcd_barrier(bar); } while (0)
#define IN(k) (((PHASE_MASK >> (k)) & 1) && lo <= (k) && (k) < hi)
#define SEAM(k) do { if (IN(k) && IN((k) + 1)) xcd_barrier(bar); } while (0)
    bf16* WS16 = (bf16*)P.ws;
    if (IN(0)) REPS(0) { REPBAR(); p0_prologue(P, lds, vcu, G); }
    SEAM(0);
    if (IN(1)) REPS(1) { REPBAR();
        pg8::Gemm g{(const bf16*)(P.ws + WS_XB), (const bf16*)(P.ws + WS_WIN), DMODEL, 0, nullptr};
        pg8::StaticOrder S; S.init(NTOK, IN_COLS, G, bx);
        LAS float* gl = (LAS float*)(lds + RING_BYTES + 8192);
        if (tid < 128) gl[tid] = (tid < 64) ? P.q_norm_g[tid] : P.k_norm_g[tid - 64];
        __syncthreads();
        EpiInProj E{(bf16*)(P.ws + WS_YG), (bf16*)(P.ws + WS_QB), (bf16*)(P.ws + WS_KB), (bf16*)(P.ws + WS_VB), (bf16*)(P.ws + WS_GT), gl, (const float*)(P.ws + WS_R)};
#if defined(DUMP_SEL) && DUMP_SEL == 5
        EpiRaw ER{(bf16*)(P.ws + WS_QB)};
        pg8::gemm_phase<EpiRaw, pg8::StaticOrder, false, true>(lds, g, S, ER);
#else
        pg8::gemm_phase<EpiInProj, pg8::StaticOrder, false, true>(lds, g, S, E);
#endif
    }
    SEAM(1);
    if (IN(2)) {
        REPS(2) { REPBAR();
        for (int p = vcu; p < 256; p += G) attn_pair(P, lds, (char*)lds_raw, p);
        __syncthreads(); }
        REPS(20) { REPBAR();
        conv_phase(P, lds, bx, G); }
    }
    SEAM(2);
    if (IN(3)) REPS(3) { REPBAR();
        pg8::Gemm g{(const bf16*)(P.ws + WS_CA), (const bf16*)(P.ws + WS_WCA), DMODEL, 0, nullptr};
        pg8::StaticOrder S; S.init(NTOK, DMODEL, G, bx);
        EpiMerged E{(const bf16*)(P.ws + WS_GT), (const bf16*)(P.ws + WS_GT) + (size_t)NTOK * 1024, (bf16*)(P.ws + WS_MG)};
#ifdef SKEW3
        if ((bx >> 3) & 1) { const unsigned long long t0 = __builtin_amdgcn_s_memrealtime(); while ((long long)(__builtin_amdgcn_s_memrealtime() - t0) < SKEW3) __builtin_amdgcn_s_sleep(8); }
#endif
        pg8::gemm_phase<EpiMerged, pg8::StaticOrder, false, true>(lds, g, S, E);
    }
    SEAM(3);
    if (IN(4)) REPS(4) { REPBAR();
        pg8::Gemm g{(const bf16*)(P.ws + WS_MG), (const bf16*)(P.ws + WS_WOUT), DMODEL, 0, nullptr};
        pg8::StaticOrder S; S.init(NTOK, DMODEL, G, bx);
        EpiOut E{(const bf16*)(P.ws + WS_XB), (bf16*)(P.ws + WS_CA), P.ws + WS_XM};
        pg8::gemm_phase<EpiOut, pg8::StaticOrder, false, true>(lds, g, S, E);
    }
    SEAM(4);
    if (IN(5)) {
        for (int t = bx; t < NTOK / 256; t += G) router_tile(P, lds, t);
        REPS(5) { REPBAR(); p5_convert(P, lds, vcu, G); }
    }
    SEAM(5);
    LAS int* meta2 = (LAS int*)(lds + META2_OFF);
    if (IN(6)) REPS(6) { REPBAR();
        moe_meta(meta, meta2, (const unsigned*)(P.ws + WS_CTL));
        pg8::Gemm g{(const bf16*)(P.ws + WS_XM), (const bf16*)(P.ws + WS_WGU), DMODEL / 2, (size_t)1024 * 1024, (const int*)(P.ws + WS_LIST), 4};
        MoeOrder S{G, vcu, __builtin_amdgcn_readfirstlane(meta[NEXP]), meta};
        EpiGateUp E{(const int*)(P.ws + WS_LIST), P.ws + WS_A, meta2};
        pg8::gemm_phase<EpiGateUp, MoeOrder, true, true, true>(lds, g, S, E);
    }
    SEAM(6);
    if (IN(7)) REPS(7) { REPBAR();
        moe_meta(meta, meta2, (const unsigned*)(P.ws + WS_CTL));
        pg8::Gemm g{(const bf16*)(P.ws + WS_A), (const bf16*)(P.ws + WS_WD), DMODEL / 2, (size_t)1024 * 512, nullptr, 0, DEXP / 2};
        ClassOrder S{G, vcu, __builtin_amdgcn_readfirstlane(meta2[NCLS]), meta2};
        EpiDownAdd E{(const int*)(P.ws + WS_CTOK), (const bf16*)(P.ws + WS_CA), P.out};
        pg8::gemm_phase<EpiDownAdd, ClassOrder, false, true, true, true>(lds, g, S, E);
    }
#if defined(DUMP_SEL)
    xcd_barrier(bar);
    { const bf16* YG = (const bf16*)(P.ws + WS_YG); const bf16* QB = (const bf16*)(P.ws + WS_QB); const bf16* KB = (const bf16*)(P.ws + WS_KB); const bf16* VB = (const bf16*)(P.ws + WS_VB);
      const bf16* GT = (const bf16*)(P.ws + WS_GT); const bf16* CA = (const bf16*)(P.ws + WS_CA); const bf16* MG = (const bf16*)(P.ws + WS_MG);
      for (size_t i = (size_t)bx * NTHREADS + tid; i < (size_t)NTOK * 1024; i += (size_t)G * NTHREADS) { const size_t t = i >> 10; const int c = (int)(i & 1023); float v = 0.f;
#if DUMP_SEL == 1
          v = bf_lo(YG[t * 512 + (c & 511)]) + bf_lo(QB[t * 512 + (c & 511)]) + 2.f * bf_lo(KB[t * 512 + (c & 511)]) + 3.f * bf_lo(VB[t * 512 + (c & 511)]) + bf_lo(GT[t * 2048 + c]) + bf_lo(GT[t * 2048 + 1024 + c]);
#elif DUMP_SEL == 2
          v = bf_lo(CA[t * 1024 + c]);
#elif DUMP_SEL == 4
          { const bf16* HB = (const bf16*)(P.ws + WS_A); const bf16* WIN = (const bf16*)(P.ws + WS_WIN); v = bf_lo(HB[i]) + 30.f * bf_lo(WIN[i % ((size_t)IN_COLS * 1024)]); }
#elif DUMP_SEL == 5
          { const bf16* R = (const bf16*)(P.ws + WS_QB); v = bf_lo(R[t * 4608 + c]) + bf_lo(R[t * 4608 + 1024 + c]) + bf_lo(R[t * 4608 + 2048 + c]) + bf_lo(R[t * 4608 + 3072 + c]) + bf_lo(R[t * 4608 + 4096 + (c & 511)]); }
#elif DUMP_SEL == 3
          v = bf_lo(MG[t * 1024 + c]);
#endif
          P.out[i] = v; } }
#endif
    (void)WS16;
#undef IN
#undef SEAM
}

extern "C" void kernel_launch(void* const* d_in, const int* in_sizes, int n_in, void* d_out, int out_size, void* d_ws, size_t ws_size, hipStream_t stream) {
    static int grid = 0;
    if (grid == 0) {
        if (n_in != 25 || in_sizes[0] != NTOK * DMODEL || out_size != NTOK * DMODEL || ws_size < WS_END) {
            fprintf(stderr, "kernel_launch: unexpected shapes (n_in %d, in0 %d, out %d, ws %zu); nothing launched\n", n_in, n_in > 0 ? in_sizes[0] : -1, out_size, ws_size); grid = -1; return; }
        int dev = 0, cus = 0, per_cu = 0;
        if (hipGetDevice(&dev) != hipSuccess || hipDeviceGetAttribute(&cus, hipDeviceAttributeMultiprocessorCount, dev) != hipSuccess) { grid = -1; return; }
        if (hipFuncSetAttribute((const void*)mega_fwd, hipFuncAttributeMaxDynamicSharedMemorySize, LDS_BYTES) != hipSuccess) { fprintf(stderr, "kernel_launch: hipFuncSetAttribute failed\n"); grid = -1; return; }
        if (hipOccupancyMaxActiveBlocksPerMultiprocessor(&per_cu, (const void*)mega_fwd, NTHREADS, LDS_BYTES) != hipSuccess || per_cu < 1) { fprintf(stderr, "kernel_launch: the occupancy query reports %d workgroups per CU for this kernel and LDS size; nothing launched\n", per_cu); grid = -1; return; }
        (void)hipGetLastError();
        grid = cus;
    }
    if (grid < 0) return;
    (void)hipMemsetAsync((char*)d_ws + WS_CTL, 0, CTL_ZERO_BYTES, stream);
    Args a{};
    const float** pp = (const float**)&a.p;
    for (int i = 0; i < 25; ++i) pp[i] = (const float*)d_in[i];
    a.p.out = (float*)d_out; a.p.ws = (unsigned char*)d_ws;
#if MK_PER_PHASE
    for (int ph = 0; ph < N_PHASES; ++ph) { a.ph_lo = ph; a.ph_hi = ph + 1; void* params[] = {&a};
        hipError_t e = hipLaunchCooperativeKernel((const void*)mega_fwd, dim3(grid), dim3(NTHREADS), params, LDS_BYTES, stream);
        if (e != hipSuccess) { fprintf(stderr, "launch %d failed: %s\n", ph, hipGetErrorString(e)); break; } }
#else
    a.ph_lo = 0; a.ph_hi = N_PHASES; void* params[] = {&a};
    hipError_t e = hipLaunchCooperativeKernel((const void*)mega_fwd, dim3(grid), dim3(NTHREADS), params, LDS_BYTES, stream);
    if (e != hipSuccess) fprintf(stderr, "cooperative launch failed: %s (grid %d)\n", hipGetErrorString(e), grid);
#endif
}
```

```cpp
#ifndef P5_SPLIT_A
#define P5_SPLIT_A 8
#endif
#include <hip/hip_runtime.h>
#include <hip/hip_bf16.h>
#include <hip/hip_cooperative_groups.h>
#include <cstdio>
#include <cstdint>
#include <cmath>
namespace cg = cooperative_groups;
__device__ __forceinline__ int tid_opaque() { int t = threadIdx.x; asm volatile("" : "+v"(t)); return t; }

constexpr int BATCH = 8, SEQ = 4096, DMODEL = 1024, NTOK = BATCH * SEQ;
constexpr int CONV_CH = 512, CONV_W = 31, NHEADS = 4, IN_COLS = 4608;
constexpr int NEXP = 32, DEXP = 512, LCAP = NTOK;
constexpr int NCLS = 4 * 28;
constexpr int CROWS = NTOK + NCLS * 256;
constexpr int MOE_ROWS = 2 * NTOK + NEXP * 256;
constexpr float EPS = 1e-6f;

namespace pg8 {
#define PG8_LAS __attribute__((address_space(3)))
typedef unsigned short bf16_t;
typedef short bf16x8 __attribute__((ext_vector_type(8)));
typedef float f32x4 __attribute__((ext_vector_type(4)));
typedef unsigned u32x4 __attribute__((ext_vector_type(4)));
constexpr int BM = 256, BK = 64, HALF = 128, HTB = HALF * BK * 2  , STAGE_BYTES = 8 * HTB, NXCD = 8, WGM = 8;

__host__ __device__ __forceinline__ int lds_byte(int r, int c) { const int st = (r >> 4) * 2 + (c >> 5), rr = r & 15, cc = c & 31, ob = rr * 64 + cc * 2; return st * 1024 + (ob ^ (((ob >> 9) & 1) << 5)); }
__host__ __device__ __forceinline__ void stage_rc(int b, int& R, int& C) { const int st = b / 1024, sb = b % 1024, swz = sb ^ (((sb >> 9) & 1) << 5); R = (st >> 1) * 16 + swz / 64; C = (st & 1) * 32 + (swz % 64) / 2; }
__host__ __device__ __forceinline__ int perm32(int rho) { const int n = rho >> 4, i = rho & 15; return 8 * (i >> 2) + 4 * n + (i & 3); }

struct Unit { int pm, pn, arow, e, e2, lrow, nvalid, orow; };
struct Gemm { const bf16_t* A; const bf16_t* Bt; int K; size_t bstride; const int* list; int lstride; int KBrow; };

struct StaticOrder {
    int nM, nN, nwg, G, c;
    __device__ void init(int M, int N, int G_, int c_) { nM = M / BM; nN = N / BM; nwg = nM * nN; G = G_; c = c_; }
    __device__ bool next(int i, Unit& u) const {
        const long L = (long)i * G + c; if (L >= nwg) return false;
        int wgid = (int)L; { const int q = nwg / NXCD, r = nwg % NXCD, xcd = wgid % NXCD, off = wgid / NXCD; wgid = (xcd < r ? xcd * (q + 1) : r * (q + 1) + (xcd - r) * q) + off; }
        const int nig = WGM * nN, gid = wgid / nig, fm = gid * WGM, gsz = (nM - fm) < WGM ? (nM - fm) : WGM;
        u.pm = fm + ((wgid % nig) % gsz); u.pn = (wgid % nig) / gsz; u.arow = u.pm * BM; u.orow = u.arow; u.e = 0; u.e2 = 0; u.lrow = 0; u.nvalid = BM; return true;
    }
};

typedef float f32x2_t __attribute__((ext_vector_type(2))); typedef __bf16 bf16x2_t __attribute__((ext_vector_type(2)));
__device__ __forceinline__ unsigned cvt_pk_bf16(float lo, float hi) { const f32x2_t v = {lo, hi}; const bf16x2_t b = __builtin_convertvector(v, bf16x2_t); return __builtin_bit_cast(unsigned, b); }
typedef int v8i_t __attribute__((ext_vector_type(8))); typedef int v4i_t __attribute__((ext_vector_type(4)));
__device__ __forceinline__ v8i_t cat8(const bf16x8 a, const bf16x8 b) { const v4i_t x = __builtin_bit_cast(v4i_t, a), y = __builtin_bit_cast(v4i_t, b); return (v8i_t){x[0], x[1], x[2], x[3], y[0], y[1], y[2], y[3]}; }
__device__ __forceinline__ unsigned pack4_fp8(float a, float b, float c, float d) { int w = 0; w = __builtin_amdgcn_cvt_pk_fp8_f32(a, b, w, false); w = __builtin_amdgcn_cvt_pk_fp8_f32(c, d, w, true); return (unsigned)w; }
__device__ __forceinline__ float bf_lo(unsigned w) { return __uint_as_float(w << 16); }
__device__ __forceinline__ float bf_hi(unsigned w) { return __uint_as_float(w & 0xffff0000u); }
__device__ __forceinline__ float sigmoidf_fast(float x) { return __builtin_amdgcn_rcpf(1.0f + __builtin_amdgcn_exp2f(-1.4426950408889634f * x)); }
__device__ __forceinline__ u32x4 pack8(const f32x4 a, const f32x4 b) { u32x4 w; w.x = cvt_pk_bf16(a[0], a[1]); w.y = cvt_pk_bf16(a[2], a[3]); w.z = cvt_pk_bf16(b[0], b[1]); w.w = cvt_pk_bf16(b[2], b[3]); return w; }
__device__ __forceinline__ void unpack8(const u32x4 w, f32x4& a, f32x4& b) { a = (f32x4){bf_lo(w.x), bf_hi(w.x), bf_lo(w.y), bf_hi(w.y)}; b = (f32x4){bf_lo(w.z), bf_hi(w.z), bf_lo(w.w), bf_hi(w.w)}; }

template <class Epi, class Sched, bool GATHER, bool ALIGN_EPI, bool FP8 = false, bool BSPLIT = false>
__device__ __forceinline__ void gemm_phase(PG8_LAS unsigned char* lds, const Gemm g, const Sched& S, const Epi& E) {
    const int tid = tid_opaque(), wid = __builtin_amdgcn_readfirstlane(tid >> 6), lane = tid & 63, wr = wid >> 2, wc = wid & 3, fr = lane & 15, fq = lane >> 4;
    const int K = g.K, nt = K / BK, KBp = g.KBrow ? g.KBrow : K;
    unsigned voffB[2]; int Ra[2], Ca[2];
#pragma unroll
    for (int i = 0; i < 2; ++i) { int R, C; stage_rc(tid * 16 + i * 8192, R, C); const int Rb = (R & ~31) + perm32(R & 31); Ra[i] = R; Ca[i] = C; voffB[i] = (unsigned)(Rb * KBp + C) * 2u; }
    const unsigned kstep = (unsigned)(BK * 2);
    const unsigned hstep = (unsigned)HALF * KBp * 2;
    const unsigned tstep = 2 * hstep;
    const char* const gA = (const char*)g.A; const char* const gB = (const char*)g.Bt;
    const unsigned ldsw = (unsigned)wid * 1024u;
    const int aoff = lds_byte(wr * 64 + fr, fq * 8), boff = lds_byte(wc * 32 + fr, fq * 8);
#define PG8_SA(b, h) (((b) * 2 + (h)) * HTB)
#define PG8_SB(b, h) ((4 + (b) * 2 + (h)) * HTB)
#define PG8_STAGE(bufoff, gbase, uoff, voff) do { _Pragma("unroll") for (int _i = 0; _i < 2; ++_i) \
        __builtin_amdgcn_global_load_lds((const unsigned*)((const char*)(gbase) + (unsigned)((uoff) + (voff)[_i])), (PG8_LAS unsigned*)(lds + (bufoff) + ldsw + _i * 8192), 16, 0, 0); } while (0)
#define PG8_LDA(dst, b, h) do { _Pragma("unroll") for (int m = 0; m < 4; ++m) _Pragma("unroll") for (int k = 0; k < 2; ++k) dst[m][k] = *(const PG8_LAS bf16x8*)(lds + PG8_SA(b, h) + aoff + m * 2048 + k * 1024); } while (0)
#define PG8_LDB(dst, b, h) do { _Pragma("unroll") for (int n = 0; n < 2; ++n) _Pragma("unroll") for (int k = 0; k < 2; ++k) dst[n][k] = *(const PG8_LAS bf16x8*)(lds + PG8_SB(b, h) + boff + n * 2048 + k * 1024); } while (0)
#define PG8_MMA(ai, bj, At, Bt) do { __builtin_amdgcn_s_setprio(1); \
        if constexpr (FP8) { _Pragma("unroll") for (int m = 0; m < 4; ++m) _Pragma("unroll") for (int n = 0; n < 2; ++n) \
            asm volatile("v_mfma_scale_f32_16x16x128_f8f6f4 %0, %1, %2, %0, %3, %3 op_sel_hi:[0,0,0]" : "+v"(acc[ai][bj][m][n]) : "v"(cat8(Bt[n][0], Bt[n][1])), "v"(cat8(At[m][0], At[m][1])), "v"(one_e8m0)); } \
        else { _Pragma("unroll") for (int m = 0; m < 4; ++m) _Pragma("unroll") for (int n = 0; n < 2; ++n) _Pragma("unroll") for (int k = 0; k < 2; ++k) \
            acc[ai][bj][m][n] = __builtin_amdgcn_mfma_f32_16x16x32_bf16(Bt[n][k], At[m][k], acc[ai][bj][m][n], 0, 0, 0); } \
        __builtin_amdgcn_s_setprio(0); } while (0)
#define PG8_WAIT_V(n) asm volatile("s_waitcnt vmcnt(" #n ")" ::: "memory")
#define PG8_WAIT_L(n) asm volatile("s_waitcnt lgkmcnt(" #n ")" ::: "memory")
#define PG8_BAR __builtin_amdgcn_s_barrier()
#define PG8_SCHED __builtin_amdgcn_sched_barrier(0)
#define PG8_LOAD_VA(dst, u) do { _Pragma("unroll") for (int _h = 0; _h < 2; ++_h) _Pragma("unroll") for (int _i = 0; _i < 2; ++_i) { const int _row = _h * HALF + Ra[_i]; \
        if constexpr (GATHER) { const int _tok = (_row < (u).nvalid) ? g.list[((u).lrow + _row) * g.lstride] : 0; dst[_h][_i] = (unsigned)(_tok * K + Ca[_i]) * 2u; } \
        else dst[_h][_i] = (unsigned)(_row * K + Ca[_i]) * 2u; } } while (0)
    Unit cur, nxt; int ui = 0;
    if (!S.next(0, cur)) return;
    typename Epi::Pre pre{};
    unsigned vAc[2][2], vAn[2][2];
    PG8_LOAD_VA(vAc, cur);
    f32x4 acc[2][2][4][2];
#pragma unroll
    for (int a = 0; a < 2; ++a)
#pragma unroll
        for (int b = 0; b < 2; ++b)
#pragma unroll
            for (int m = 0; m < 4; ++m)
#pragma unroll
                for (int n = 0; n < 2; ++n) acc[a][b][m][n] = (f32x4){0.f, 0.f, 0.f, 0.f};
    bf16x8 At[4][2], B0[2][2], B1[2][2];
    const int one_e8m0 = 0x7f7f7f7f; (void)one_e8m0;
    unsigned cA = (unsigned)cur.arow * K * 2, cB = (unsigned)cur.e * (unsigned)g.bstride + (unsigned)cur.pn * tstep;
    unsigned cB2 = (unsigned)cur.e2 * (unsigned)g.bstride + (unsigned)cur.pn * tstep; const unsigned hk = (unsigned)(nt / 2) * kstep; (void)cB2; (void)hk;
    PG8_STAGE(PG8_SB(0, 0), gB, cB, voffB); PG8_STAGE(PG8_SB(0, 1), gB, cB + hstep, voffB); PG8_STAGE(PG8_SA(0, 0), gA, cA, vAc[0]); PG8_STAGE(PG8_SA(0, 1), gA, cA, vAc[1]);
    if (wr == 1) PG8_BAR;
    PG8_WAIT_V(2); PG8_BAR;
    PG8_STAGE(PG8_SB(1, 0), gB, cB + kstep, voffB); PG8_STAGE(PG8_SA(1, 0), gA, cA + kstep, vAc[0]); PG8_STAGE(PG8_SB(1, 1), gB, cB + hstep + kstep, voffB);
    PG8_WAIT_V(6); PG8_BAR;
    for (;;) {
        const bool has_next = S.next(ui + 1, nxt);
        const unsigned nA = has_next ? (unsigned)nxt.arow * K * 2 : cA;
        const unsigned nB = has_next ? (unsigned)nxt.e * (unsigned)g.bstride + (unsigned)nxt.pn * tstep : cB;
        const unsigned nB2 = has_next ? (unsigned)nxt.e2 * (unsigned)g.bstride + (unsigned)nxt.pn * tstep : cB2; (void)nB2;
        if (has_next) { PG8_LOAD_VA(vAn, nxt); }
        else {
#pragma unroll
            for (int h = 0; h < 2; ++h)
#pragma unroll
                for (int i = 0; i < 2; ++i) vAn[h][i] = vAc[h][i]; }
#pragma unroll 1
        for (int t = 0; t < nt; t += 2) {
            const bool last = (t == nt - 2);
            if constexpr (Epi::MID) { if (t == nt / 2) E.mid(acc, cur, wr, wc, fr, fq); }
            if constexpr (Epi::PREMID) { if (t == nt / 2) pre = E.pre(cur, wr, fr); }
            const unsigned a1 = cA + (unsigned)(t + 1) * kstep;
            const unsigned a2 = last ? nA : cA + (unsigned)(t + 2) * kstep;
            unsigned b2 = last ? nB : cB + (unsigned)(t + 2) * kstep;
            if constexpr (BSPLIT) { if (!last && t + 2 >= nt / 2) b2 = cB2 + (unsigned)(t + 2) * kstep - hk; }
            const unsigned a3 = a2 + kstep, b3 = b2 + kstep;
            unsigned v2[2][2];
#pragma unroll
            for (int h = 0; h < 2; ++h)
#pragma unroll
                for (int i = 0; i < 2; ++i) v2[h][i] = vAc[h][i];
            if (last) { asm volatile("" ::: "memory");
#pragma unroll
                for (int h = 0; h < 2; ++h)
#pragma unroll
                    for (int i = 0; i < 2; ++i) v2[h][i] = vAn[h][i]; }
            PG8_LDB(B0, 0, 0); PG8_LDB(B1, 0, 1); PG8_SCHED; PG8_LDA(At, 0, 0); PG8_STAGE(PG8_SA(1, 1), gA, a1, vAc[1]);
            PG8_WAIT_V(8); PG8_WAIT_L(0); PG8_BAR; PG8_MMA(0, 0, At, B0); PG8_MMA(0, 1, At, B1); PG8_BAR; PG8_SCHED;
            PG8_LDA(At, 0, 1); PG8_STAGE(PG8_SB(0, 0), gB, b2, voffB); PG8_STAGE(PG8_SB(0, 1), gB, b2 + hstep, voffB); PG8_STAGE(PG8_SA(0, 0), gA, a2, v2[0]);
            PG8_WAIT_V(8); PG8_WAIT_L(0); PG8_BAR; PG8_MMA(1, 0, At, B0); PG8_MMA(1, 1, At, B1); PG8_BAR; PG8_SCHED;
            PG8_LDB(B0, 1, 0); PG8_LDB(B1, 1, 1); PG8_SCHED; PG8_LDA(At, 1, 0); PG8_STAGE(PG8_SA(0, 1), gA, a2, v2[1]);
            PG8_WAIT_V(8); PG8_WAIT_L(0); PG8_BAR; PG8_MMA(0, 0, At, B0); PG8_MMA(0, 1, At, B1); PG8_BAR; PG8_SCHED;
            PG8_LDA(At, 1, 1); PG8_STAGE(PG8_SB(1, 0), gB, b3, voffB); PG8_STAGE(PG8_SB(1, 1), gB, b3 + hstep, voffB); PG8_STAGE(PG8_SA(1, 0), gA, a3, v2[0]);
            PG8_WAIT_V(8); PG8_WAIT_L(0); PG8_BAR; PG8_MMA(1, 0, At, B0); PG8_MMA(1, 1, At, B1); PG8_BAR; PG8_SCHED;
        }
        if constexpr (ALIGN_EPI) { if (wr == 0) PG8_BAR; }
        if constexpr (FP8) asm volatile("s_nop 15\n\ts_nop 15\n\ts_nop 15\n\ts_nop 15" ::: "memory");
        if constexpr (Epi::PREMID) E(acc, cur, wr, wc, fr, fq, pre); else E(acc, cur, wr, wc, fr, fq, E.pre(cur, wr, fr));
        if (!has_next) break;
#pragma unroll
        for (int a = 0; a < 2; ++a)
#pragma unroll
            for (int b = 0; b < 2; ++b)
#pragma unroll
                for (int m = 0; m < 4; ++m)
#pragma unroll
                    for (int n = 0; n < 2; ++n) acc[a][b][m][n] = (f32x4){0.f, 0.f, 0.f, 0.f};
        cur = nxt; cA = nA; cB = nB; cB2 = nB2; ++ui;
#pragma unroll
        for (int h = 0; h < 2; ++h)
#pragma unroll
            for (int i = 0; i < 2; ++i) vAc[h][i] = vAn[h][i];
        if constexpr (ALIGN_EPI) { if (wr == 1) PG8_BAR; }
    }
    PG8_WAIT_V(0);
    if constexpr (!ALIGN_EPI) { if (wr == 0) PG8_BAR; }
    PG8_BAR;
#undef PG8_SA
#undef PG8_SB
#undef PG8_STAGE
#undef PG8_LDA
#undef PG8_LDB
#undef PG8_MMA
#undef PG8_WAIT_V
#undef PG8_WAIT_L
#undef PG8_BAR
#undef PG8_SCHED
#undef PG8_LOAD_VA
}
}

namespace attn_body {
using bf16=__hip_bfloat16;
using bf16x8=__attribute__((ext_vector_type(8)))short;
using s16x4=__attribute__((ext_vector_type(4)))short;
using f32x16=__attribute__((ext_vector_type(16)))float;
using u32x4=__attribute__((ext_vector_type(4)))unsigned;
constexpr int D=64, QP=512, KP=512, VP=512, OP=1024;
constexpr int NW=8,QBLK=32,QB=QBLK*NW,KVBLK=64;
constexpr int ATTN_UNIT_ROWS=QB;
__device__ __forceinline__ int crow(int r,int hi){return (r&3)+8*(r>>2)+4*hi;}
#define SBAR() __builtin_amdgcn_sched_barrier(0)
__device__ __forceinline__ void cmask(f32x16&p0,f32x16&p1,int jb,int qrel,int hi){
  const float NEG=-INFINITY; int kb=64*jb+4*hi;
  #pragma unroll
  for(int r=0;r<16;++r){int kv=kb+(r&3)+8*(r>>2); if(kv>qrel)p0[r]=NEG; if(kv+32>qrel)p1[r]=NEG;}
}

constexpr int NSLOT=3, SLOTB=8192, VSLOTB=16384;
constexpr int LDS_K=0, LDS_V=NSLOT*SLOTB, LDS_WS=LDS_V+NSLOT*VSLOTB, LDS_OST=LDS_WS+NW*64*4, LDS_BYTES=LDS_OST+NW*4096;
constexpr float C2=0.125f*1.4426950408889634f;
__device__ __forceinline__ void glds16(const void*gsrc,unsigned lds_dst){unsigned keep;
  asm volatile("s_mov_b32 %0, m0\n\ts_mov_b32 m0, %2\n\ts_nop 0\n\tglobal_load_lds_dwordx4 %1, off\n\ts_mov_b32 m0, %0":"=&s"(keep):"v"(gsrc),"s"(lds_dst):"memory");}
__device__ __forceinline__ float max3f(float a,float b,float c){float r;asm("v_max3_f32 %0, %1, %2, %3":"=v"(r):"v"(a),"v"(b),"v"(c));return r;}
__device__ __forceinline__ float max2f(float a,float b){float r;asm("v_max_f32_e32 %0, %1, %2":"=v"(r):"v"(a),"v"(b));return r;}
__device__ __forceinline__ float fadd_s(float a,float b){float r;asm("v_add_f32_e32 %0, %1, %2":"=v"(r):"v"(a),"v"(b));return r;}
__device__ __forceinline__ float fsub_s(float a,float b){float r;asm("v_sub_f32_e32 %0, %1, %2":"=v"(r):"v"(a),"v"(b));return r;}
typedef float f32x2_t __attribute__((ext_vector_type(2))); typedef __bf16 bf16x2_t __attribute__((ext_vector_type(2)));
__device__ __forceinline__ unsigned cvtpk_s(float lo,float hi){f32x2_t v={lo,hi};bf16x2_t b=__builtin_convertvector(v,bf16x2_t);return __builtin_bit_cast(unsigned,b);}
#define WAIT_BAR(N) asm volatile("s_waitcnt vmcnt(" #N ") lgkmcnt(0)\n\ts_barrier":::"memory")

__device__ __forceinline__ void qkt(f32x16&p0,f32x16&p1,const char*Kslot,const bf16x8*qr,const f32x16&negm,int r32,int hi){
  const char*kb=Kslot+hi*1024+r32*16;
  #pragma unroll
  for(int d0=0;d0<4;++d0){
    const bf16x8 b0=*reinterpret_cast<const bf16x8*>(kb+d0*2048);
    const bf16x8 b1=*reinterpret_cast<const bf16x8*>(kb+d0*2048+512);
    if(d0==0){p0=__builtin_amdgcn_mfma_f32_32x32x16_bf16(b0,qr[0],negm,0,0,0);p1=__builtin_amdgcn_mfma_f32_32x32x16_bf16(b1,qr[0],negm,0,0,0);}
    else{p0=__builtin_amdgcn_mfma_f32_32x32x16_bf16(b0,qr[d0],p0,0,0,0);p1=__builtin_amdgcn_mfma_f32_32x32x16_bf16(b1,qr[d0],p1,0,0,0);}}
}
typedef __attribute__((address_space(3))) const char* lds_cptr;
typedef short v4i16_t __attribute__((ext_vector_type(4)));
__device__ __forceinline__ void kload8(bf16x8*kf,lds_cptr kp){
  kf[0]=*(const __attribute__((address_space(3))) bf16x8*)(kp);      kf[1]=*(const __attribute__((address_space(3))) bf16x8*)(kp+512);
  kf[2]=*(const __attribute__((address_space(3))) bf16x8*)(kp+2048); kf[3]=*(const __attribute__((address_space(3))) bf16x8*)(kp+2560);
  kf[4]=*(const __attribute__((address_space(3))) bf16x8*)(kp+4096); kf[5]=*(const __attribute__((address_space(3))) bf16x8*)(kp+4608);
  kf[6]=*(const __attribute__((address_space(3))) bf16x8*)(kp+6144); kf[7]=*(const __attribute__((address_space(3))) bf16x8*)(kp+6656);
}
__device__ __forceinline__ void kload2(bf16x8*kf,lds_cptr kp,int j){ kf[2*j]=*(const __attribute__((address_space(3))) bf16x8*)(kp+j*2048); kf[2*j+1]=*(const __attribute__((address_space(3))) bf16x8*)(kp+j*2048+512); }
__device__ __forceinline__ s16x4 vtr(lds_cptr p){ return __builtin_bit_cast(s16x4,__builtin_amdgcn_ds_read_tr16_b64_v4i16((__attribute__((address_space(3))) v4i16_t*)p)); }
__device__ __forceinline__ float rowmax(const f32x16&p0,const f32x16&p1){
  float a=max3f(p0[0],p0[1],p1[0]),b=max3f(p0[2],p0[3],p1[1]);a=max3f(a,p1[2],p1[3]);
  #pragma unroll
  for(int r=4;r<16;r+=4){a=max3f(a,p0[r],p0[r+1]);b=max3f(b,p0[r+2],p0[r+3]);a=max3f(a,p1[r],p1[r+1]);b=max3f(b,p1[r+2],p1[r+3]);}
  const float m=max2f(a,b);
  auto rr=__builtin_amdgcn_permlane32_swap(__float_as_uint(m),__float_as_uint(m),false,false);
  return max2f(__uint_as_float(rr[0]),__uint_as_float(rr[1]));
}
__device__ __forceinline__ void pv(f32x16*o,int vb,bf16x8 pa0,bf16x8 pa1,bf16x8 pa2,bf16x8 pa3){
  #pragma unroll
  for(int d0=0;d0<4;++d0){s16x4 lo[4],hi[4];
    #pragma unroll
    for(int ks=0;ks<4;++ks){
      asm volatile("ds_read_b64_tr_b16 %0,%1 offset:%c2":"=&v"(lo[ks]):"v"(vb),"i"(d0*4096+ks*1024):"memory");
      asm volatile("ds_read_b64_tr_b16 %0,%1 offset:%c2":"=&v"(hi[ks]):"v"(vb),"i"(d0*4096+ks*1024+512):"memory");}
    asm volatile("s_waitcnt lgkmcnt(0)":::"memory");SBAR();
    #define PK(k) (bf16x8){lo[k][0],lo[k][1],lo[k][2],lo[k][3],hi[k][0],hi[k][1],hi[k][2],hi[k][3]}
    o[d0]=__builtin_amdgcn_mfma_f32_32x32x16_bf16(pa0,PK(0),o[d0],0,0,0);
    o[d0]=__builtin_amdgcn_mfma_f32_32x32x16_bf16(pa1,PK(1),o[d0],0,0,0);
    o[d0]=__builtin_amdgcn_mfma_f32_32x32x16_bf16(pa2,PK(2),o[d0],0,0,0);
    o[d0]=__builtin_amdgcn_mfma_f32_32x32x16_bf16(pa3,PK(3),o[d0],0,0,0);
    #undef PK
  }
}

#ifndef ATTN_STORE16
#define ATTN_STORE16(p,v) (*(u32x4*)(p)=(v))
#endif
template<int THRL,bool STAT> __device__ __forceinline__ int attn_unit(float mstat,int q0,const bf16*Q,const bf16*__restrict__ K,const bf16*__restrict__ V,bf16*O,char*shm,const bf16*O1,float lam,const float*subg,unsigned short*CAo,const bf16*Knext,const bf16*Vnext,int s0,bool pre){
  #define NXT_(x) (((x)==(NSLOT-1)*SLOTB)?0:(x)+SLOTB)
  const int s1=NXT_(s0),s2=NXT_(s1);
  int tid_=threadIdx.x; asm volatile("":"+v"(tid_));
  const int tid=tid_,lane=tid&63,r32=lane&31,hi=lane>>5; const int wid=__builtin_amdgcn_readfirstlane(tid>>6);
  const bf16*Qw=Q+(long)(q0+wid*QBLK)*QP;
  const bf16*Kh=K,*Vh=V;
  const unsigned lds0=(unsigned)(uintptr_t)shm;
  float*wsf=(float*)(shm+LDS_WS)+wid*64;
  const bf16*ksrc=Kh+(long)lane*KP+wid*8;
  const bf16*vsrc=Vh+(long)(16*(wid&3)+(lane>>2))*VP+(wid>>2)*32+(lane&3)*8;
  const unsigned kdst=lds0+LDS_K+wid*1024, vdst=lds0+LDS_V+wid*1024;
  #define DMA_K(t,slot) glds16(ksrc+(long)(t)*KVBLK*KP,(unsigned)__builtin_amdgcn_readfirstlane(kdst+(slot)))
  #define DMA_V(t,slot) do{ glds16(vsrc+(long)(t)*KVBLK*VP,(unsigned)__builtin_amdgcn_readfirstlane(vdst+2*(slot))); glds16(vsrc+(long)(t)*KVBLK*VP+64,(unsigned)__builtin_amdgcn_readfirstlane(vdst+2*(slot)+8192)); }while(0)
  const int vb0=(int)(lds0+LDS_V)+((lane>>4)&1)*32+(lane&3)*8+(4*hi+((lane&15)>>2))*64;
  const char*Kbase=shm+LDS_K; bf16x8 kf[8];
  const lds_cptr shm3=(lds_cptr)shm; const lds_cptr kp0=shm3+LDS_K+hi*1024+r32*16; const lds_cptr vp0=shm3+LDS_V+((lane>>4)&1)*32+(lane&3)*8+(4*hi+((lane&15)>>2))*64;
  const int NT=(q0+QB)/KVBLK;
  if(!pre){DMA_K(0,s0);DMA_V(0,s0);DMA_K(1,s1);}
  bf16x8 qr[4];
  #pragma unroll
  for(int d0=0;d0<4;++d0)qr[d0]=*reinterpret_cast<const bf16x8*>(&Qw[(long)r32*QP+d0*16+hi*8]);
  float mhat=0.f,l_reg=0.f;f32x16 o[4];{float zz=0.f;asm volatile("":"+v"(zz));
  #pragma unroll
  for(int r=0;r<16;++r){o[0][r]=zz;o[1][r]=zz;o[2][r]=zz;o[3][r]=zz;}}
  f32x16 negm;{float zn=0.f;asm volatile("":"+v"(zn));
  #pragma unroll
  for(int r=0;r<16;++r)negm[r]=zn;}
  asm volatile("":"+v"(negm));
  const int qrel=wid*QBLK+r32;
  #define CMASK(P0,P1,t) do{int jb_=(t)-(NT-4); if(jb_>=0)cmask(P0,P1,jb_,qrel,hi);}while(0)
  bool resc=false;
  #define START(P0,P1) do{ float rm; if constexpr (STAT) rm=mstat; else rm=rowmax(P0,P1); resc=false; \
    { const float dl=rm; mhat=fadd_s(mhat,dl); \
      _Pragma("unroll") for(int r=0;r<16;++r){P0[r]=fsub_s(P0[r],dl);P1[r]=fsub_s(P1[r],dl);} \
      _Pragma("unroll") for(int r=0;r<16;++r)negm[r]=-mhat; asm volatile("":"+v"(negm)); } \
    _Pragma("unroll") for(int r=0;r<16;++r)P0[r]=__builtin_amdgcn_exp2f(P0[r]); }while(0)
  #define RESC() do{ if(resc){ asm volatile("s_waitcnt lgkmcnt(0)":::"memory"); \
      _Pragma("unroll") for(int d_=0;d_<4;++d_) _Pragma("unroll") for(int r=0;r<16;++r)o[d_][r]*=wsf[crow(r,hi)]; } }while(0)
  f32x16 pA0,pA1,pB0,pB1;
  int sl_prev=s0,sl_cur=s0,sl_next=s1;
  #define ROT() do{sl_prev=sl_cur;sl_cur=sl_next;sl_next=(sl_next==(NSLOT-1)*SLOTB)?0:sl_next+SLOTB;}while(0)
  if(!pre){DMA_K(2,s2);}
  WAIT_BAR(4);
  qkt(pA0,pA1,Kbase+s0,qr,negm,r32,hi);asm volatile("s_nop 15\n\ts_nop 7":"+v"(pA0),"+v"(pA1));CMASK(pA0,pA1,0);
  START(pA0,pA1);
  _Pragma("unroll") for(int r=0;r<16;++r)pA1[r]=__builtin_amdgcn_exp2f(pA1[r]);
  WAIT_BAR(0);
  DMA_K(3,s0);DMA_V(1,s1);
  ROT();
  kload8(kf,kp0+sl_cur);
  WAIT_BAR(3);
  s16x4 vlo[8],vhi[8]; u32x4 pw0,pw1,pw2,pw3;
  #define PKW(P,B) cvtpk_s(P[B],P[B+1])
  #define PAF(k) __builtin_bit_cast(bf16x8,pw##k)
  #define VFR(i) (bf16x8){vlo[i][0],vlo[i][1],vlo[i][2],vlo[i][3],vhi[i][0],vhi[i][1],vhi[i][2],vhi[i][3]}
  #define PIN(x) asm volatile("":"+v"(x))
  #define MX3(a,b,c) __builtin_fmaxf(__builtin_fmaxf((a),(b)),(c))
  #define GAPA(MF,A0,A1,A2,A3,W0,W1,PW) do{ MF; sacc+=A0; sacc+=A1; sacc+=A2; sacc+=A3; PIN(sacc); W0; W1; PIN(PW); SBAR(); }while(0)
  #define EX(v) __builtin_amdgcn_exp2f(v)
  #define GAPB2(MF,X,B) do{ MF; X[B]=EX(X[B]); X[B+1]=EX(X[B+1]); PIN(X); SBAR(); }while(0)
  #define VRD2(i) do{ vlo[i]=vtr(vp_+((((i)>>2)+2)*4096+((i)&3)*1024)); vhi[i]=vtr(vp_+((((i)>>2)+2)*4096+((i)&3)*1024+512)); }while(0)
  #define VRD(i) do{ vlo[i]=vtr(vp_+(((i)>>2)*4096+((i)&3)*1024)); vhi[i]=vtr(vp_+(((i)>>2)*4096+((i)&3)*1024+512)); }while(0)
  #define KRD(G,j) do{ if(G){ kload2(kf,kp0+sl_next,j); SBAR(); } }while(0)
  #define STEP(C0,C1,P0,P1,t,GK,GV,GL) do{ SBAR(); \
    const lds_cptr vp_=vp0+2*sl_prev; \
    VRD(0); SBAR(); float sacc=(P0[0]+P0[1]); \
    GAPA(C0=__builtin_amdgcn_mfma_f32_32x32x16_bf16(kf[0],qr[0],negm,0,0,0), P0[2],P0[3],P0[4],P0[5],     pw0[0]=PKW(P0,0), pw0[1]=PKW(P0,2), pw0); \
    VRD(4); SBAR(); GAPA(C1=__builtin_amdgcn_mfma_f32_32x32x16_bf16(kf[1],qr[0],negm,0,0,0), P0[6],P0[7],P0[8],P0[9],     pw0[2]=PKW(P0,4), pw0[3]=PKW(P0,6), pw0); \
    VRD(1); SBAR(); GAPA(C0=__builtin_amdgcn_mfma_f32_32x32x16_bf16(kf[2],qr[1],C0,0,0,0),   P0[10],P0[11],P0[12],P0[13], pw1[0]=PKW(P0,8), pw1[1]=PKW(P0,10), pw1); \
    VRD(5); SBAR(); GAPA(C1=__builtin_amdgcn_mfma_f32_32x32x16_bf16(kf[3],qr[1],C1,0,0,0),   P0[14],P0[15],P1[0],P1[1],   pw1[2]=PKW(P0,12),pw1[3]=PKW(P0,14), pw1); \
    VRD(2); SBAR(); GAPA(C0=__builtin_amdgcn_mfma_f32_32x32x16_bf16(kf[4],qr[2],C0,0,0,0),   P1[2],P1[3],P1[4],P1[5],     pw2[0]=PKW(P1,0), pw2[1]=PKW(P1,2), pw2); \
    VRD(6); SBAR(); GAPA(C1=__builtin_amdgcn_mfma_f32_32x32x16_bf16(kf[5],qr[2],C1,0,0,0),   P1[6],P1[7],P1[8],P1[9],     pw2[2]=PKW(P1,4), pw2[3]=PKW(P1,6), pw2); \
    VRD(3); SBAR(); GAPA(C0=__builtin_amdgcn_mfma_f32_32x32x16_bf16(kf[6],qr[3],C0,0,0,0),   P1[10],P1[11],P1[12],P1[13], pw3[0]=PKW(P1,8), pw3[1]=PKW(P1,10), pw3); \
    VRD(7); SBAR(); GAPA(C1=__builtin_amdgcn_mfma_f32_32x32x16_bf16(kf[7],qr[3],C1,0,0,0),   P1[14],P1[15],0.f,0.f,       pw3[2]=PKW(P1,12),pw3[3]=PKW(P1,14), pw3); \
    l_reg+=sacc; \
    if(GK){DMA_K((t)+3,sl_cur);} if(GV){DMA_V((t)+1,sl_next);} \
    CMASK(C0,C1,t); \
    if constexpr (!STAT) { float a=MX3(C0[0],C0[1],C1[0]),b=MX3(C0[2],C0[3],C1[1]); a=MX3(a,C1[2],C1[3]); \
      _Pragma("unroll") for(int r=4;r<16;r+=4){a=MX3(a,C0[r],C0[r+1]);b=MX3(b,C0[r+2],C0[r+3]);a=MX3(a,C1[r],C1[r+1]);b=MX3(b,C1[r+2],C1[r+3]);} \
      float rm=__builtin_fmaxf(a,b); { auto rr=__builtin_amdgcn_permlane32_swap(__float_as_uint(rm),__float_as_uint(rm),false,false); rm=__builtin_fmaxf(__uint_as_float(rr[0]),__uint_as_float(rr[1])); } \
      resc=false; \
      if(__builtin_expect(__any(rm>(float)THRL),0)){ const float dl=__builtin_fmaxf(rm,0.f); mhat+=dl; \
        _Pragma("unroll") for(int r=0;r<16;++r){C0[r]-=dl;C1[r]-=dl;} \
        _Pragma("unroll") for(int r=0;r<16;++r)negm[r]=-mhat; asm volatile("":"+v"(negm)); \
        const float f=__builtin_amdgcn_exp2f(-dl); l_reg*=f; if(hi==0)wsf[r32]=f; resc=true; } } \
    SBAR(); \
    GAPB2(o[0]=__builtin_amdgcn_mfma_f32_32x32x16_bf16(PAF(0),VFR(0),o[0],0,0,0), C0,0);  VRD2(0); SBAR(); \
    GAPB2(o[1]=__builtin_amdgcn_mfma_f32_32x32x16_bf16(PAF(0),VFR(4),o[1],0,0,0), C0,2);  VRD2(4); SBAR(); \
    GAPB2(o[0]=__builtin_amdgcn_mfma_f32_32x32x16_bf16(PAF(1),VFR(1),o[0],0,0,0), C0,4);  VRD2(1); SBAR(); \
    GAPB2(o[1]=__builtin_amdgcn_mfma_f32_32x32x16_bf16(PAF(1),VFR(5),o[1],0,0,0), C0,6);  VRD2(5); SBAR(); \
    GAPB2(o[0]=__builtin_amdgcn_mfma_f32_32x32x16_bf16(PAF(2),VFR(2),o[0],0,0,0), C0,8);  VRD2(2); SBAR(); \
    GAPB2(o[1]=__builtin_amdgcn_mfma_f32_32x32x16_bf16(PAF(2),VFR(6),o[1],0,0,0), C0,10); VRD2(6); SBAR(); \
    GAPB2(o[0]=__builtin_amdgcn_mfma_f32_32x32x16_bf16(PAF(3),VFR(3),o[0],0,0,0), C0,12); VRD2(3); SBAR(); \
    GAPB2(o[1]=__builtin_amdgcn_mfma_f32_32x32x16_bf16(PAF(3),VFR(7),o[1],0,0,0), C0,14); VRD2(7); SBAR(); \
    GAPB2(o[2]=__builtin_amdgcn_mfma_f32_32x32x16_bf16(PAF(0),VFR(0),o[2],0,0,0), C1,0); \
    GAPB2(o[3]=__builtin_amdgcn_mfma_f32_32x32x16_bf16(PAF(0),VFR(4),o[3],0,0,0), C1,2); \
    KRD(GL,0); GAPB2(o[2]=__builtin_amdgcn_mfma_f32_32x32x16_bf16(PAF(1),VFR(1),o[2],0,0,0), C1,4); \
    KRD(GL,1); GAPB2(o[3]=__builtin_amdgcn_mfma_f32_32x32x16_bf16(PAF(1),VFR(5),o[3],0,0,0), C1,6); \
    KRD(GL,2); GAPB2(o[2]=__builtin_amdgcn_mfma_f32_32x32x16_bf16(PAF(2),VFR(2),o[2],0,0,0), C1,8); \
    KRD(GL,3); GAPB2(o[3]=__builtin_amdgcn_mfma_f32_32x32x16_bf16(PAF(2),VFR(6),o[3],0,0,0), C1,10); \
    GAPB2(o[2]=__builtin_amdgcn_mfma_f32_32x32x16_bf16(PAF(3),VFR(3),o[2],0,0,0), C1,12); \
    GAPB2(o[3]=__builtin_amdgcn_mfma_f32_32x32x16_bf16(PAF(3),VFR(7),o[3],0,0,0), C1,14); \
    }while(0)
  int t=1;
  #undef CMASK
  #define CMASK(P0,P1,t) do{}while(0)
  for(;t+5<NT;t+=2){
    STEP(pB0,pB1,pA0,pA1,t,true,true,true);     WAIT_BAR(3); RESC(); ROT();
    STEP(pA0,pA1,pB0,pB1,t+1,true,true,true);   WAIT_BAR(3); RESC(); ROT();
  }
  #undef CMASK
  #define CMASK(P0,P1,t) do{int jb_=(t)-(NT-4); if(jb_>=0)cmask(P0,P1,jb_,qrel,hi);}while(0)
  #define ENDW(tt) do{ if((tt)+3<NT){WAIT_BAR(3);} else if((tt)+2<NT){WAIT_BAR(2);} else {WAIT_BAR(0);} }while(0)
  for(;t+1<NT;t+=2){
    STEP(pB0,pB1,pA0,pA1,t,(t+3<NT),(t+1<NT),(t+1<NT));       ENDW(t);   RESC(); ROT();
    STEP(pA0,pA1,pB0,pB1,t+1,(t+4<NT),(t+2<NT),(t+2<NT));     ENDW(t+1); RESC(); ROT();
  }
  int snext=0;
  if(Knext!=nullptr){
    const int p0=sl_next,p1=NXT_(p0),p2=NXT_(p1); snext=p0;
    const bf16*kn=Knext+(long)lane*KP+wid*8; const bf16*vn=Vnext+(long)(16*(wid&3)+(lane>>2))*VP+(wid>>2)*32+(lane&3)*8;
    glds16(kn,(unsigned)__builtin_amdgcn_readfirstlane(kdst+p0));
    glds16(vn,(unsigned)__builtin_amdgcn_readfirstlane(vdst+2*p0)); glds16(vn+64,(unsigned)__builtin_amdgcn_readfirstlane(vdst+2*p0+8192));
    glds16(kn+(long)KVBLK*KP,(unsigned)__builtin_amdgcn_readfirstlane(kdst+p1)); glds16(kn+(long)2*KVBLK*KP,(unsigned)__builtin_amdgcn_readfirstlane(kdst+p2)); }
  STEP(pB0,pB1,pA0,pA1,NT-1,false,false,false); RESC();
  { float sacc=pB0[0]+pB0[1]; _Pragma("unroll") for(int r=2;r<16;++r)sacc+=pB0[r]; _Pragma("unroll") for(int r=0;r<16;++r)sacc+=pB1[r]; l_reg+=sacc;
    pw0=(u32x4){PKW(pB0,0),PKW(pB0,2),PKW(pB0,4),PKW(pB0,6)};pw1=(u32x4){PKW(pB0,8),PKW(pB0,10),PKW(pB0,12),PKW(pB0,14)};pw2=(u32x4){PKW(pB1,0),PKW(pB1,2),PKW(pB1,4),PKW(pB1,6)};pw3=(u32x4){PKW(pB1,8),PKW(pB1,10),PKW(pB1,12),PKW(pB1,14)};
    SBAR(); pv(o,vb0+2*sl_cur,PAF(0),PAF(1),PAF(2),PAF(3)); }
  #undef PKW
  #undef PAF
  #undef VFR
  #undef PIN
  #undef MX3
  #undef GAPA
  #undef GAPB2
  #undef VRD2
  #undef EX
  #undef VRD
  #undef KRD
  #undef STEP
  #undef ENDW
  {auto rr=__builtin_amdgcn_permlane32_swap(__float_as_uint(l_reg),__float_as_uint(l_reg),false,false);l_reg=__uint_as_float(rr[0])+__uint_as_float(rr[1]);}
  if(hi==0)wsf[32+r32]=l_reg;asm volatile("s_waitcnt lgkmcnt(0)":::"memory");
  float rli[16];
  #pragma unroll
  for(int r=0;r<16;++r)rli[r]=__builtin_amdgcn_rcpf(wsf[32+crow(r,hi)]);
  bf16*Ow=O+(long)(q0+wid*QBLK)*OP;
  bf16*stg=(bf16*)(shm+LDS_OST)+wid*2048;
  if(O1==nullptr){
    #pragma unroll
    for(int hf=0;hf<2;++hf){
      #pragma unroll
      for(int r=0;r<16;++r){const int orow=crow(r,hi);
        #pragma unroll
        for(int d0=0;d0<2;++d0)stg[orow*64+d0*32+r32]=__float2bfloat16(o[2*hf+d0][r]*rli[r]);}
      asm volatile("s_waitcnt lgkmcnt(0)":::"memory");
      #pragma unroll
      for(int i=0;i<4;++i){const int row=i*8+(lane>>3),ch=lane&7; const u32x4 v=*(const u32x4*)(stg+row*64+ch*8); ATTN_STORE16(Ow+(long)row*OP+hf*64+ch*8,v);}
      asm volatile("s_waitcnt lgkmcnt(0)":::"memory"); }
  } else {
    const bf16*O1w=O1+(long)(q0+wid*QBLK)*OP; unsigned long long p1[2][4][2];
    #pragma unroll
    for(int hf=0;hf<2;++hf)
      #pragma unroll
      for(int i=0;i<4;++i){const int row=i*8+(lane>>3),ch=lane&7; unsigned long long*a=(unsigned long long*)(O1w+(long)row*OP+hf*64+ch*8);
        p1[hf][i][0]=__hip_atomic_load(a,__ATOMIC_RELAXED,__HIP_MEMORY_SCOPE_AGENT); p1[hf][i][1]=__hip_atomic_load(a+1,__ATOMIC_RELAXED,__HIP_MEMORY_SCOPE_AGENT);}
    float dd[2][4][8]; float ssp[4]={0.f,0.f,0.f,0.f};
    #pragma unroll
    for(int hf=0;hf<2;++hf){
      #pragma unroll
      for(int r=0;r<16;++r){const int orow=crow(r,hi);
        #pragma unroll
        for(int d0=0;d0<2;++d0)stg[orow*64+d0*32+r32]=__float2bfloat16(o[2*hf+d0][r]*rli[r]);}
      asm volatile("s_waitcnt lgkmcnt(0)":::"memory");
      #pragma unroll
      for(int i=0;i<4;++i){const int row=i*8+(lane>>3),ch=lane&7; const u32x4 v=*(const u32x4*)(stg+row*64+ch*8);
        const unsigned w1[4]={(unsigned)p1[hf][i][0],(unsigned)(p1[hf][i][0]>>32),(unsigned)p1[hf][i][1],(unsigned)(p1[hf][i][1]>>32)};
        #pragma unroll
        for(int j=0;j<4;++j){ const float a0=__uint_as_float(w1[j]<<16)-lam*__uint_as_float(v[j]<<16), a1=__uint_as_float(w1[j]&0xffff0000u)-lam*__uint_as_float(v[j]&0xffff0000u);
          dd[hf][i][2*j]=a0; dd[hf][i][2*j+1]=a1; ssp[i]+=a0*a0+a1*a1; } }
      asm volatile("s_waitcnt lgkmcnt(0)":::"memory"); }
    #pragma unroll
    for(int i=0;i<4;++i){ float ss=ssp[i];
      ss+=__int_as_float(__builtin_amdgcn_update_dpp(0,__float_as_int(ss),0xB1,0xf,0xf,true)); ss+=__int_as_float(__builtin_amdgcn_update_dpp(0,__float_as_int(ss),0x4E,0xf,0xf,true)); ss+=__int_as_float(__builtin_amdgcn_update_dpp(0,__float_as_int(ss),0x141,0xf,0xf,true));
      const float rn=1.0f/sqrtf(ss*(1.0f/128.0f)+1e-6f)*0.8f;
      const int row=i*8+(lane>>3),ch=lane&7;
      #pragma unroll
      for(int hf=0;hf<2;++hf){ const float*gp=subg+hf*64+ch*8; u32x4 w;
        w[0]=cvtpk_s(dd[hf][i][0]*rn*gp[0],dd[hf][i][1]*rn*gp[1]); w[1]=cvtpk_s(dd[hf][i][2]*rn*gp[2],dd[hf][i][3]*rn*gp[3]);
        w[2]=cvtpk_s(dd[hf][i][4]*rn*gp[4],dd[hf][i][5]*rn*gp[5]); w[3]=cvtpk_s(dd[hf][i][6]*rn*gp[6],dd[hf][i][7]*rn*gp[7]);
        *(u32x4*)(CAo+(long)(q0+wid*QBLK+row)*1024+hf*64+ch*8)=w; } }
  }
  asm volatile("s_waitcnt lgkmcnt(0)\n\ts_barrier":::"memory");
  #undef DMA_K
  #undef DMA_V
  #undef CMASK
  #undef START
  #undef RESC
  #undef ROT
  #undef NXT_
  return snext;
}
constexpr int ATTN_LDS_BYTES=LDS_BYTES;
#undef SBAR
#undef WAIT_BAR
}

constexpr int NWAVES = 8, NTHREADS = NWAVES * 64;
#ifndef MK_PER_PHASE
#define MK_PER_PHASE 0
#endif
#ifndef RUN_PHASES
#define RUN_PHASES 8
#endif
constexpr int N_PHASES = RUN_PHASES;

constexpr size_t MiB = 1u << 20;
constexpr size_t WS_CTL = 0, CTL_ZERO_BYTES = 65536;
constexpr size_t WS_RS = 1 * MiB;
constexpr size_t WS_TINFO = 2 * MiB;
constexpr size_t WS_WR = 3 * MiB;
constexpr size_t WS_LTOK = 4 * MiB, WS_LW = 8 * MiB;
constexpr size_t WS_WIN = 16 * MiB, WS_WCA = 25 * MiB, WS_WOUT = 27 * MiB;
constexpr size_t WS_A = 32 * MiB;
constexpr size_t WS_QB = 112 * MiB, WS_KB = 144 * MiB, WS_VB = 176 * MiB, WS_YG = 208 * MiB;
constexpr size_t WS_MG = 112 * MiB, WS_XM = 176 * MiB;
constexpr size_t WS_GT = 240 * MiB;
constexpr size_t WS_WGU = 240 * MiB, WS_WD = 304 * MiB;
constexpr size_t WS_CA = 368 * MiB;
constexpr size_t WS_YB = 112 * MiB;
constexpr size_t WS_LIST = 432 * MiB;
constexpr size_t WS_CTOK = 448 * MiB;
constexpr size_t WS_XB = 432 * MiB;
constexpr size_t WS_R = 1 * MiB;
constexpr size_t WS_END = 496 * MiB;
static_assert(WS_A + (size_t)CROWS * 1024 <= WS_QB && WS_WD + (size_t)NEXP * 1024 * 512 <= WS_CA, "d_ws map");
static_assert(WS_WIN + (size_t)IN_COLS * 1024 * 2 <= WS_WCA, "d_ws map");

constexpr int RING_BYTES = 131072;
constexpr int META_OFF = RING_BYTES;
constexpr int HIST_OFF = RING_BYTES + 1024;
constexpr int BARST_OFF = RING_BYTES + 3072;
constexpr int META2_OFF = RING_BYTES + 4096;
constexpr int LDS_BYTES = 147456;

#define GAS __attribute__((address_space(1)))
#define LAS __attribute__((address_space(3)))
typedef unsigned short bf16;
typedef unsigned v4u __attribute__((ext_vector_type(4)));
typedef unsigned v2u __attribute__((ext_vector_type(2)));
typedef float f32x4 __attribute__((ext_vector_type(4)));
typedef float f32x16 __attribute__((ext_vector_type(16)));
typedef short bf16x8 __attribute__((ext_vector_type(8)));
using pg8::cvt_pk_bf16; using pg8::bf_lo; using pg8::bf_hi; using pg8::sigmoidf_fast; using pg8::pack8; using pg8::unpack8;

__device__ __forceinline__ float wave_sum(float v) {
    v += __int_as_float(__builtin_amdgcn_update_dpp(0, __float_as_int(v), 0xB1, 0xf, 0xf, true));
    v += __int_as_float(__builtin_amdgcn_update_dpp(0, __float_as_int(v), 0x4E, 0xf, 0xf, true));
    v += __int_as_float(__builtin_amdgcn_update_dpp(0, __float_as_int(v), 0x141, 0xf, 0xf, true));
    v += __int_as_float(__builtin_amdgcn_update_dpp(0, __float_as_int(v), 0x140, 0xf, 0xf, true));
    const int iv = __float_as_int(v);
    return (__int_as_float(__builtin_amdgcn_readlane(iv, 0)) + __int_as_float(__builtin_amdgcn_readlane(iv, 16))) + (__int_as_float(__builtin_amdgcn_readlane(iv, 32)) + __int_as_float(__builtin_amdgcn_readlane(iv, 48)));
}
__device__ __forceinline__ float wave_max(float v) {
    v = fmaxf(v, __int_as_float(__builtin_amdgcn_update_dpp(0, __float_as_int(v), 0xB1, 0xf, 0xf, true)));
    v = fmaxf(v, __int_as_float(__builtin_amdgcn_update_dpp(0, __float_as_int(v), 0x4E, 0xf, 0xf, true)));
    v = fmaxf(v, __int_as_float(__builtin_amdgcn_update_dpp(0, __float_as_int(v), 0x141, 0xf, 0xf, true)));
    v = fmaxf(v, __int_as_float(__builtin_amdgcn_update_dpp(0, __float_as_int(v), 0x140, 0xf, 0xf, true)));
    const int iv = __float_as_int(v);
    return fmaxf(fmaxf(__int_as_float(__builtin_amdgcn_readlane(iv, 0)), __int_as_float(__builtin_amdgcn_readlane(iv, 16))), fmaxf(__int_as_float(__builtin_amdgcn_readlane(iv, 32)), __int_as_float(__builtin_amdgcn_readlane(iv, 48))));
}
__device__ __forceinline__ float bf16_round(float x) { return bf_lo(cvt_pk_bf16(x, 0.f) & 0xffffu); }

#define XB_TMO      128
#define XB_XCNT(j)  (256  + 64 * (j))
#define XB_XSUB(j)  (1280 + 64 * (j))
#define XB_XGEN(j)  (2304 + 64 * (j))
#define XB_TOP      3328
#define XB_TOPGEN   3392
#define XCD_BAR_WORDS 3456
#define XB_SPIN_CAP (1u << 18)

__device__ __forceinline__ unsigned xb_ld(unsigned* p)              { return __hip_atomic_load(p, __ATOMIC_RELAXED, __HIP_MEMORY_SCOPE_AGENT); }
__device__ __forceinline__ unsigned xb_add(unsigned* p, unsigned v) { return __hip_atomic_fetch_add(p, v, __ATOMIC_RELAXED, __HIP_MEMORY_SCOPE_AGENT); }
__device__ __forceinline__ unsigned xb_xcc_id() { return (unsigned)__builtin_amdgcn_s_getreg((3 << 11) | 20) & 0xFu; }
#define XB_SPIN(cond, bar) do { unsigned _sp = 0; while (cond) { __builtin_amdgcn_s_sleep(1); \
    if ((++_sp & 255u) == 0u) { if (xb_ld(&(bar)[XB_TMO])) break; if (_sp > XB_SPIN_CAP) { atomicAdd(&(bar)[XB_TMO], 1u); break; } } } } while (0)

struct XcdBarrier {
    unsigned* bar; unsigned x;
    volatile LAS unsigned* st;
};

__device__ __forceinline__ XcdBarrier xcd_barrier_post(unsigned* bar, volatile LAS unsigned* st) {
    XcdBarrier b; b.bar = bar; b.x = xb_xcc_id(); b.st = st;
    if (threadIdx.x == 0) (void)xb_add(&bar[XB_XCNT(b.x)], 1u);
    return b;
}
__device__ __forceinline__ void xcd_barrier_complete(unsigned* bar, unsigned x, unsigned& nloc, unsigned& nx) {
    const unsigned G = gridDim.x * gridDim.y * gridDim.z;
    unsigned sum, cnt, mine, sp = 0u;
    for (;;) {
        sum = 0u; cnt = 0u; mine = 0u;
#pragma unroll
        for (unsigned j = 0; j < 16; ++j) { const unsigned c = xb_ld(&bar[XB_XCNT(j)]); sum += c; cnt += (c > 0u) ? 1u : 0u; mine = (j == x) ? c : mine; }
        if (sum == G) break;
        __builtin_amdgcn_s_sleep(1);
        if ((++sp & 255u) == 0u) { if (xb_ld(&bar[XB_TMO])) break; if (sp > XB_SPIN_CAP) { atomicAdd(&bar[XB_TMO], 1u); break; } }
    }
    nloc = mine > 0u ? mine : 1u; nx = cnt > 0u ? cnt : 1u;
}

__device__ __forceinline__ void xcd_barrier(const XcdBarrier& b) {
    asm volatile("s_waitcnt vmcnt(0)" ::: "memory");
    __syncthreads();
    if (threadIdx.x == 0) {
        unsigned* bar = b.bar;
        __builtin_amdgcn_s_waitcnt(0);
        unsigned nloc = b.st[0], nx = b.st[1];
        if (nloc == 0u) { xcd_barrier_complete(bar, b.x, nloc, nx); b.st[0] = nloc; b.st[1] = nx; }
        const unsigned old = xb_add(&bar[XB_XSUB(b.x)], 1u);
        const unsigned gen = old / nloc;
        if (old + 1u == (gen + 1u) * nloc) {
            __builtin_amdgcn_fence(__ATOMIC_RELEASE, "agent");
            asm volatile("s_waitcnt vmcnt(0)" ::: "memory");
            const unsigned og = xb_add(&bar[XB_TOP], 1u);
            const unsigned tg = og / nx;
            if (og + 1u == (tg + 1u) * nx) xb_add(&bar[XB_TOPGEN], 1u);
            else XB_SPIN(xb_ld(&bar[XB_TOPGEN]) == tg, bar);
            __builtin_amdgcn_fence(__ATOMIC_ACQUIRE, "agent");
            xb_add(&bar[XB_XGEN(b.x)], 1u);
            asm volatile("s_waitcnt vmcnt(0)" ::: "memory");
        } else {
            XB_SPIN(xb_ld(&bar[XB_XGEN(b.x)]) == gen, bar);
            __builtin_amdgcn_fence(__ATOMIC_ACQUIRE, "agent");
            asm volatile("s_waitcnt vmcnt(0)" ::: "memory");
        }
    }
    __syncthreads();
}


typedef f32x4 AccT[2][2][4][2];
struct EpiInProj {
    static constexpr bool MID = false, PREMID = true;
    struct Pre { float r[2][4]; };
    __device__ __forceinline__ Pre pre(const pg8::Unit& u, int wr, int fr) const { Pre p;
#pragma unroll
        for (int ai = 0; ai < 2; ++ai)
#pragma unroll
            for (int m = 0; m < 4; ++m) p.r[ai][m] = R[u.orow + ai * 128 + wr * 64 + m * 16 + fr];
        return p; }
    bf16 *YG, *QB, *KB, *VB, *GT; const LAS float* gl; const float* R;
    __device__ __forceinline__ void mid(AccT&, const pg8::Unit&, int, int, int, int) const {}
    __device__ __forceinline__ void operator()(AccT& acc, const pg8::Unit& u, int wr, int wc, int fr, int fq, const Pre& pre_) const {
        asm volatile("" : "+v"(fr), "+v"(fq));
        const int pn = u.pn; const size_t row0 = (size_t)u.orow + wr * 64 + fr;
        if (pn < 4) {
#pragma unroll
            for (int ai = 0; ai < 2; ++ai)
#pragma unroll
                for (int m = 0; m < 4; ++m) { const size_t row = row0 + ai * 128 + m * 16; f32x4 y[2]; const float rr = pre_.r[ai][m];
#pragma unroll
                    for (int n = 0; n < 2; ++n) { const f32x4 a = acc[ai][0][m][n] * rr, g = acc[ai][1][m][n] * rr;
                        y[n] = (f32x4){a[0] * sigmoidf_fast(g[0]), a[1] * sigmoidf_fast(g[1]), a[2] * sigmoidf_fast(g[2]), a[3] * sigmoidf_fast(g[3])}; }
                    __builtin_nontemporal_store(pack8(y[0], y[1]), (v4u*)(YG + row * 512 + pn * 128 + wc * 32 + 8 * fq)); }
        } else if (pn < 8) {
            const bool isq = pn < 6; bf16* base = isq ? QB : KB; const LAS float* gp = gl + (isq ? 0 : 64); const float sc = isq ? 0.125f * 1.4426950408889634f : 1.0f;
            f32x4 gv[2][2];
#pragma unroll
            for (int bj = 0; bj < 2; ++bj)
#pragma unroll
                for (int n = 0; n < 2; ++n) gv[bj][n] = *(const LAS f32x4*)(gp + 32 * bj + 8 * fq + 4 * n) * sc;
#pragma unroll
            for (int ai = 0; ai < 2; ++ai)
#pragma unroll
                for (int m = 0; m < 4; ++m) { const size_t row = row0 + ai * 128 + m * 16; float ss = 0.f; const float rr = pre_.r[ai][m];
#pragma unroll
                    for (int bj = 0; bj < 2; ++bj)
#pragma unroll
                        for (int n = 0; n < 2; ++n) { const f32x4 a = acc[ai][bj][m][n]; ss += (a[0] * a[0] + a[1] * a[1]) + (a[2] * a[2] + a[3] * a[3]); }
                    ss += __shfl_xor(ss, 16); ss += __shfl_xor(ss, 32);
                    const float rinv = rr / sqrtf(ss * rr * rr * (1.0f / 64.0f) + EPS);
#pragma unroll
                    for (int bj = 0; bj < 2; ++bj)
                        __builtin_nontemporal_store(pack8(acc[ai][bj][m][0] * rinv * gv[bj][0], acc[ai][bj][m][1] * rinv * gv[bj][1]), (v4u*)(base + row * 512 + (pn & 1) * 256 + wc * 64 + bj * 32 + 8 * fq)); }
        } else if (pn < 10) {
#pragma unroll
            for (int ai = 0; ai < 2; ++ai)
#pragma unroll
                for (int m = 0; m < 4; ++m) { const size_t row = row0 + ai * 128 + m * 16; const float rr = pre_.r[ai][m];
#pragma unroll
                    for (int bj = 0; bj < 2; ++bj) __builtin_nontemporal_store(pack8(acc[ai][bj][m][0] * rr, acc[ai][bj][m][1] * rr), (v4u*)(VB + row * 512 + (pn - 8) * 256 + bj * 128 + wc * 32 + 8 * fq)); }
        } else {
#pragma unroll
            for (int ai = 0; ai < 2; ++ai)
#pragma unroll
                for (int m = 0; m < 4; ++m) { const size_t row = row0 + ai * 128 + m * 16; f32x4 rr[2], gg[2]; const float rz = -1.4426950408889634f * pre_.r[ai][m];
#pragma unroll
                    for (int n = 0; n < 2; ++n)
#pragma unroll
                        for (int j = 0; j < 4; ++j) { const float e0 = __builtin_amdgcn_exp2f(rz * acc[ai][0][m][n][j]), e1 = fminf(__builtin_amdgcn_exp2f(rz * acc[ai][1][m][n][j]), 1e30f);
                            gg[n][j] = __builtin_amdgcn_rcpf(1.0f + e1); rr[n][j] = (1.0f + e1) * __builtin_amdgcn_rcpf(1.0f + e0); }
                    const size_t o = row * 1024 + (pn - 10) * 128 + wc * 32 + 8 * fq;
                    __builtin_nontemporal_store(pack8(rr[0], rr[1]), (v4u*)(GT + o)); __builtin_nontemporal_store(pack8(gg[0], gg[1]), (v4u*)(GT + (size_t)NTOK * 1024 + o)); }
        }
    }
};
struct EpiMerged {
    static constexpr bool MID = true, PREMID = false;
    struct Pre {}; __device__ __forceinline__ Pre pre(const pg8::Unit&, int, int) const { return Pre{}; }
    const bf16* GR; const bf16* G1; bf16* MG;
    __device__ __forceinline__ void mid(AccT& acc, const pg8::Unit& u, int wr, int wc, int fr, int fq) const {
        asm volatile("" : "+v"(fr), "+v"(fq));
        const size_t row0 = (size_t)u.orow + wr * 64 + fr; const int col0 = u.pn * 256 + wc * 32 + 8 * fq;
        v4u w0[2][4][2];
#pragma unroll
        for (int ai = 0; ai < 2; ++ai)
#pragma unroll
            for (int m = 0; m < 4; ++m)
#pragma unroll
                for (int bj = 0; bj < 2; ++bj) w0[ai][m][bj] = *(const v4u*)(GR + (row0 + ai * 128 + m * 16) * 1024 + col0 + bj * 128);
        __builtin_amdgcn_sched_barrier(0);
#pragma unroll
        for (int ai = 0; ai < 2; ++ai)
#pragma unroll
            for (int m = 0; m < 4; ++m)
#pragma unroll
                for (int bj = 0; bj < 2; ++bj) { f32x4 a0, a1; unpack8(w0[ai][m][bj], a0, a1); acc[ai][bj][m][0] = acc[ai][bj][m][0] * a0; acc[ai][bj][m][1] = acc[ai][bj][m][1] * a1; }
        __builtin_amdgcn_sched_barrier(0);
    }
    __device__ __forceinline__ void operator()(AccT& acc, const pg8::Unit& u, int wr, int wc, int fr, int fq, const Pre& pre_) const {
        asm volatile("" : "+v"(fr), "+v"(fq));
        const size_t row0 = (size_t)u.orow + wr * 64 + fr; const int col0 = u.pn * 256 + wc * 32 + 8 * fq;
        v4u w1[2][4][2];
#pragma unroll
        for (int ai = 0; ai < 2; ++ai)
#pragma unroll
            for (int m = 0; m < 4; ++m)
#pragma unroll
                for (int bj = 0; bj < 2; ++bj) w1[ai][m][bj] = *(const v4u*)(G1 + (row0 + ai * 128 + m * 16) * 1024 + col0 + bj * 128);
        __builtin_amdgcn_sched_barrier(0);
#pragma unroll
        for (int ai = 0; ai < 2; ++ai)
#pragma unroll
            for (int m = 0; m < 4; ++m) { const size_t row = row0 + ai * 128 + m * 16;
#pragma unroll
                for (int bj = 0; bj < 2; ++bj) { f32x4 b0, b1; unpack8(w1[ai][m][bj], b0, b1);
                    *(v4u*)(MG + row * 1024 + col0 + bj * 128) = pack8(acc[ai][bj][m][0] * b0, acc[ai][bj][m][1] * b1); } }
    }
};
struct EpiOut {
    static constexpr bool MID = false, PREMID = false;
    struct Pre {}; __device__ __forceinline__ Pre pre(const pg8::Unit&, int, int) const { return Pre{}; }
    const bf16* XB; bf16* XMB; unsigned char* XM8;
    __device__ __forceinline__ void mid(AccT&, const pg8::Unit&, int, int, int, int) const {}
    __device__ __forceinline__ void operator()(AccT& acc, const pg8::Unit& u, int wr, int wc, int fr, int fq, const Pre& pre_) const {
        asm volatile("" : "+v"(fr), "+v"(fq));
        const size_t row0 = (size_t)u.orow + wr * 64 + fr; const int col0 = u.pn * 256 + wc * 32 + 8 * fq;
        v4u xw[2][4][2];
#pragma unroll
        for (int ai = 0; ai < 2; ++ai)
#pragma unroll
            for (int m = 0; m < 4; ++m)
#pragma unroll
                for (int bj = 0; bj < 2; ++bj) xw[ai][m][bj] = __builtin_nontemporal_load((const v4u*)(XB + (row0 + ai * 128 + m * 16) * 1024 + col0 + bj * 128));
        __builtin_amdgcn_sched_barrier(0);
#pragma unroll
        for (int ai = 0; ai < 2; ++ai)
#pragma unroll
            for (int m = 0; m < 4; ++m) { const size_t off = (row0 + ai * 128 + m * 16) * 1024 + col0;
#pragma unroll
                for (int bj = 0; bj < 2; ++bj) { f32x4 x0, x1; unpack8(xw[ai][m][bj], x0, x1); const f32x4 o0 = x0 + acc[ai][bj][m][0], o1 = x1 + acc[ai][bj][m][1];
                    *(v4u*)(XMB + off + bj * 128) = pack8(o0, o1);
                    v2u w8; w8.x = pg8::pack4_fp8(o0[0], o0[1], o0[2], o0[3]); w8.y = pg8::pack4_fp8(o1[0], o1[1], o1[2], o1[3]); *(v2u*)(XM8 + off + bj * 128) = w8; } }
        __builtin_amdgcn_sched_barrier(0);
    }
};
struct EpiGateUp {
    static constexpr bool MID = false, PREMID = false;
    typedef int i32x4 __attribute__((ext_vector_type(4)));
    struct Pre { int dst[2][4]; float w[2][4], rs[2][4]; };
    __device__ __forceinline__ Pre pre(const pg8::Unit& u, int wr, int fr) const { Pre p;
#pragma unroll
        for (int ai = 0; ai < 2; ++ai)
#pragma unroll
            for (int m = 0; m < 4; ++m) { const int r = ai * 128 + wr * 64 + m * 16 + fr; const i32x4 en = (r < u.nvalid) ? *(const i32x4*)(LIST + (size_t)(u.lrow + r) * 4) : (i32x4){-1, -1, 0, 0};
                p.dst[ai][m] = en[1]; p.w[ai][m] = __int_as_float(en[2]); p.rs[ai][m] = __int_as_float(en[3]); }
        return p; }
    const int* LIST; unsigned char* HP8; const LAS int* m2;
    __device__ __forceinline__ void mid(AccT&, const pg8::Unit&, int, int, int, int) const {}
    __device__ __forceinline__ void operator()(AccT& acc, const pg8::Unit& u, int wr, int wc, int fr, int fq, const Pre& pre_) const {
        asm volatile("" : "+v"(fr), "+v"(fq));
#pragma unroll
        for (int ai = 0; ai < 2; ++ai)
#pragma unroll
            for (int m = 0; m < 4; ++m) { const int dst = pre_.dst[ai][m]; if (dst < 0) continue;
                const float rs = pre_.rs[ai][m] * (1.0f / 64.0f), w8 = pre_.w[ai][m] * 8.0f;
                const size_t drow = (size_t)m2[dst >> 17] * 256 + ((dst >> 1) & 0xffff);
                float h[8];
#pragma unroll
                for (int n = 0; n < 2; ++n)
#pragma unroll
                    for (int j = 0; j < 4; ++j) { const float g = acc[ai][0][m][n][j] * rs, up = acc[ai][1][m][n][j] * rs; h[4 * n + j] = __builtin_amdgcn_fmed3f(g * sigmoidf_fast(g) * up * w8, -448.f, 448.f); }
                v2u o8; o8.x = pg8::pack4_fp8(h[0], h[1], h[2], h[3]); o8.y = pg8::pack4_fp8(h[4], h[5], h[6], h[7]);
                *(v2u*)(HP8 + drow * 1024 + (dst & 1) * 512 + u.pn * 128 + wc * 32 + 8 * fq) = o8; }
    }
};
struct EpiDownAdd {
    static constexpr bool MID = false, PREMID = true;
    struct Pre { int tok[2][4]; };
    __device__ __forceinline__ Pre pre(const pg8::Unit& u, int wr, int fr) const { Pre p;
#pragma unroll
        for (int ai = 0; ai < 2; ++ai)
#pragma unroll
            for (int m = 0; m < 4; ++m) { const int r = ai * 128 + wr * 64 + m * 16 + fr; p.tok[ai][m] = (r < u.nvalid) ? CTOK[u.lrow + r] : -1; }
        return p; }
    const int* CTOK; const bf16* XMB; float* out;
    __device__ __forceinline__ void mid(AccT&, const pg8::Unit&, int, int, int, int) const {}
    __device__ __forceinline__ void operator()(AccT& acc, const pg8::Unit& u, int wr, int wc, int fr, int fq, const Pre& pre_) const {
        asm volatile("" : "+v"(fr), "+v"(fq));
        const int col0 = u.pn * 256 + wc * 32 + 8 * fq;
        v4u xw[2][4][2];
#pragma unroll
        for (int ai = 0; ai < 2; ++ai)
#pragma unroll
            for (int m = 0; m < 4; ++m) { const int tk = pre_.tok[ai][m]; const size_t off = (size_t)(tk < 0 ? 0 : tk) * 1024 + col0;
#pragma unroll
                for (int bj = 0; bj < 2; ++bj) xw[ai][m][bj] = *(const v4u*)(XMB + off + bj * 128); }
        __builtin_amdgcn_sched_barrier(0);
#pragma unroll
        for (int ai = 0; ai < 2; ++ai)
#pragma unroll
            for (int m = 0; m < 4; ++m) { const int tk = pre_.tok[ai][m]; if (tk < 0) continue; const size_t off = (size_t)tk * 1024 + col0;
#pragma unroll
                for (int bj = 0; bj < 2; ++bj) { f32x4 x0, x1; unpack8(xw[ai][m][bj], x0, x1);
                    __builtin_nontemporal_store(x0 + acc[ai][bj][m][0] * (1.0f / 256.0f), (f32x4*)(out + off + bj * 128)); __builtin_nontemporal_store(x1 + acc[ai][bj][m][1] * (1.0f / 256.0f), (f32x4*)(out + off + bj * 128 + 4)); } }
    }
};
struct MoeOrder {
    int G, c, total; const LAS int* meta;
    __device__ __forceinline__ bool next(int i, pg8::Unit& u) const {
        int cc = c; if (G == 256 && (i + 1) * G > total * 4) cc = ((c & 31) >> 2) * 32 + (c >> 5) * 4 + (c & 3);
        const int L = i * G + cc; if (L >= total * 4) return false;
        const int blk = L >> 2; const int lane = tid_opaque() & 63;
        const int e = __builtin_amdgcn_readfirstlane(__builtin_popcountll(__ballot(lane < NEXP - 1 && meta[1 + lane] <= blk)));
        const int pre = __builtin_amdgcn_readfirstlane(meta[e]), cnt = __builtin_amdgcn_readfirstlane(meta[64 + e]); const int rb = blk - pre;
        u.pn = L & 3; u.pm = rb; u.e = e; u.e2 = e; u.lrow = e * LCAP + rb * 256; u.nvalid = min(256, cnt - rb * 256); u.orow = blk * 256; u.arow = 0; return true;
    }
};
struct ClassOrder {
    int G, c, total; const LAS int* m2;
    __device__ __forceinline__ bool next(int i, pg8::Unit& u) const {
        int cc = c; if (G == 256 && (i + 1) * G > total * 4) cc = ((c & 31) >> 2) * 32 + (c >> 5) * 4 + (c & 3);
        const int L = i * G + cc; if (L >= total * 4) return false;
        const int blk = L >> 2; const int lane = tid_opaque() & 63;
        const int n0 = __builtin_popcountll(__ballot(m2[1 + lane] <= blk)), n1 = __builtin_popcountll(__ballot(lane + 65 <= NCLS - 1 && m2[65 + lane] <= blk));
        const int cls = __builtin_amdgcn_readfirstlane(n0 + n1);
        const int pre = __builtin_amdgcn_readfirstlane(m2[cls]), cnt = __builtin_amdgcn_readfirstlane(m2[128 + cls]); const int rb = blk - pre;
        const int g = cls / 28; int p = cls % 28, a = 0;
        while (p >= 7 - a) { p -= 7 - a; ++a; }
        u.e = g * 8 + a; u.e2 = g * 8 + a + 1 + p; u.pn = L & 3; u.pm = rb; u.lrow = cls * NTOK + rb * 256; u.nvalid = min(256, cnt - rb * 256); u.orow = blk * 256; u.arow = u.orow; return true;
    }
};
__device__ __forceinline__ void moe_meta(LAS int* meta, LAS int* m2, const unsigned* ctl) {
    const int tid = tid_opaque();
    if (tid < NEXP) meta[64 + tid] = (int)__hip_atomic_load(ctl + tid, __ATOMIC_RELAXED, __HIP_MEMORY_SCOPE_AGENT);
    if (tid >= 64 && tid < 64 + NCLS) m2[128 + tid - 64] = (int)__hip_atomic_load(ctl + tid, __ATOMIC_RELAXED, __HIP_MEMORY_SCOPE_AGENT);
    __syncthreads();
    if (tid == 0) { int p = 0;
        for (int e = 0; e < NEXP; ++e) { meta[e] = p; p += (meta[64 + e] + 255) >> 8; }
        meta[NEXP] = p; }
    if (tid == 64) { int p = 0;
        for (int c = 0; c < NCLS; ++c) { m2[c] = p; p += (m2[128 + c] + 255) >> 8; }
        m2[NCLS] = p; }
    __syncthreads();
}

__device__ __forceinline__ void transpose_item(const float* W, int N, int k0, int n0, bf16* WT, int dpitch, int drow0, int dcol0, const float* kscale, LAS float* scr, int lane) {
    const int kr = lane >> 3, nc = (lane & 7) * 4;
    f32x4 v[8];
#pragma unroll
    for (int i = 0; i < 8; ++i) v[i] = *(const f32x4*)(W + (size_t)(k0 + i * 8 + kr) * N + n0 + nc);
    if (kscale) {
#pragma unroll
        for (int i = 0; i < 8; ++i) v[i] = v[i] * kscale[k0 + i * 8 + kr]; }
#pragma unroll
    for (int i = 0; i < 8; ++i) { LAS float* d = scr + (i * 8 + kr) * 33 + nc; d[0] = v[i][0]; d[1] = v[i][1]; d[2] = v[i][2]; d[3] = v[i][3]; }
    asm volatile("s_waitcnt lgkmcnt(0)" ::: "memory");
    const int c = lane & 7;
#pragma unroll
    for (int j = 0; j < 4; ++j) { const int n = (lane >> 3) + 8 * j; const LAS float* s = scr + (8 * c) * 33 + n;
        v4u o; o.x = cvt_pk_bf16(s[0 * 33], s[1 * 33]); o.y = cvt_pk_bf16(s[2 * 33], s[3 * 33]); o.z = cvt_pk_bf16(s[4 * 33], s[5 * 33]); o.w = cvt_pk_bf16(s[6 * 33], s[7 * 33]);
        *(v4u*)(WT + (size_t)(drow0 + n) * dpitch + dcol0 + k0 + 8 * c) = o; }
    asm volatile("s_waitcnt lgkmcnt(0)" ::: "memory");
}
__device__ __forceinline__ void t8_load(f32x4 (&v)[8], const float* W, int N, int k0, int n0, int lane) {
    const int kr = lane >> 3, nc = (lane & 7) * 4;
#pragma unroll
    for (int i = 0; i < 8; ++i) v[i] = __builtin_nontemporal_load((const f32x4*)(W + (size_t)(k0 + i * 8 + kr) * N + n0 + nc));
}
__device__ __forceinline__ void t8_finish(f32x4 (&v)[8], int k0, unsigned char* WT, int dpitch, int drow0, const float* kscale, float mul, LAS float* scr, int lane) {
    const int kr = lane >> 3, nc = (lane & 7) * 4;
#pragma unroll
    for (int i = 0; i < 8; ++i) v[i] = v[i] * (kscale ? kscale[k0 + i * 8 + kr] * mul : mul);
#pragma unroll
    for (int i = 0; i < 8; ++i) { LAS float* d = scr + (i * 8 + kr) * 33 + nc; d[0] = v[i][0]; d[1] = v[i][1]; d[2] = v[i][2]; d[3] = v[i][3]; }
    asm volatile("s_waitcnt lgkmcnt(0)" ::: "memory");
    const int c = lane & 7;
#pragma unroll
    for (int j = 0; j < 4; ++j) { const int n = (lane >> 3) + 8 * j; const LAS float* s = scr + (8 * c) * 33 + n;
        v2u o; o.x = pg8::pack4_fp8(s[0 * 33], s[1 * 33], s[2 * 33], s[3 * 33]); o.y = pg8::pack4_fp8(s[4 * 33], s[5 * 33], s[6 * 33], s[7 * 33]);
        *(v2u*)(WT + (size_t)(drow0 + n) * dpitch + k0 + 8 * c) = o; }
    asm volatile("s_waitcnt lgkmcnt(0)" ::: "memory");
}
__device__ __forceinline__ void transpose_item_fp8(const float* W, int N, int k0, int n0, unsigned char* WT, int dpitch, int drow0, const float* kscale, float mul, LAS float* scr, int lane) {
    f32x4 v[8]; t8_load(v, W, N, k0, n0, lane); t8_finish(v, k0, WT, dpitch, drow0, kscale, mul, scr, lane);
}
__device__ __forceinline__ int inproj_phys(int c) {
    if (c < 512) return (c >> 7) * 256 + (c & 127);
    if (c < 1024) { c -= 512; return (c >> 7) * 256 + 128 + (c & 127); }
    if (c < 2048) { const int sec = (c - 1024) >> 8, cl = (c - 1024) & 255, s = cl >> 6, d = cl & 63; return 1024 + sec * 256 + ((d >> 5) << 7) + (s << 5) + (d & 31); }
    if (c < 2560) return c;
    { int j = c - 2560; const int hi = j >= 1024; j &= 1023; return 2560 + (j >> 7) * 256 + hi * 128 + (j & 127); }
}
struct Ptrs {
    const float *x, *attn_norm_g, *w_in, *conv_dw_w, *conv_dw_b, *conv_ln_g, *conv_ln_b, *w_conv_out, *q_norm_g, *k_norm_g, *lq1, *lk1, *lq2, *lk2, *subln_g,
        *w_attn_out, *w_out, *ffn_norm_g, *w_rg, *b_rg, *w_re, *b_re, *w_gate, *w_up, *w_down;
    float* out; unsigned char* ws;
};

__device__ __forceinline__ void p0_prologue(const Ptrs& P, LAS unsigned char* lds, int vcu, int G) {
    const int tid = tid_opaque(), lane = tid & 63, wave = __builtin_amdgcn_readfirstlane(tid >> 6);
    LAS float* scr = (LAS float*)(lds + wave * 16384);
    const int gw = vcu * NWAVES + wave, NGW = G * NWAVES;
    bf16* WIN = (bf16*)(P.ws + WS_WIN); bf16* WCA = (bf16*)(P.ws + WS_WCA); bf16* WOUT = (bf16*)(P.ws + WS_WOUT);
    constexpr int I_IN = (DMODEL / 64) * (IN_COLS / 32), I_C = (CONV_CH / 64) * (DMODEL / 32), I_O = (DMODEL / 64) * (DMODEL / 32);
    for (int it = gw; it < I_IN + 2 * I_C + I_O; it += NGW) {
        int r = it;
        if (r < I_IN) { const int kb = r / (IN_COLS / 32), nb = r % (IN_COLS / 32); transpose_item(P.w_in, IN_COLS, kb * 64, nb * 32, WIN, 1024, inproj_phys(nb * 32), 0, P.attn_norm_g, scr, lane); continue; } r -= I_IN;
        if (r < I_C) { const int kb = r / 32, nb = r % 32; transpose_item(P.w_conv_out, DMODEL, kb * 64, nb * 32, WCA, 1024, nb * 32, 0, nullptr, scr, lane); continue; } r -= I_C;
        if (r < I_C) { const int kb = r / 32, nb = r % 32; transpose_item(P.w_attn_out, DMODEL, kb * 64, nb * 32, WCA, 1024, nb * 32, 512, nullptr, scr, lane); continue; } r -= I_C;
        { const int kb = r / 32, nb = r % 32; transpose_item(P.w_out, DMODEL, kb * 64, nb * 32, WOUT, 1024, nb * 32, 0, nullptr, scr, lane); }
    }
    bf16* WRhi = (bf16*)(P.ws + WS_WR); bf16* WRlo = WRhi + 64 * 1024;
    for (int idx = vcu * NTHREADS + tid; idx < 64 * 1024; idx += G * NTHREADS) {
        const int n = idx >> 10, k = idx & 1023; float v = 0.f;
        if (n < 4) v = P.w_rg[k * 4 + n]; else if (n < 36) v = P.w_re[k * 32 + (n - 4)];
        v *= P.ffn_norm_g[k];
        const unsigned hb = cvt_pk_bf16(v, 0.f) & 0xffffu; const float hf = __uint_as_float(hb << 16);
        const int pos = (((k >> 4) * 4 + (n >> 5)) * 64 + ((k >> 3) & 1) * 32 + (n & 31)) * 8 + (k & 7);
        WRhi[pos] = (bf16)hb; WRhi[pos + 2 * 64 * 8] = (bf16)(cvt_pk_bf16(v - hf, 0.f) & 0xffffu);
    }
    bf16* HB = (bf16*)(P.ws + WS_XB); float* RR = (float*)(P.ws + WS_R);
    constexpr int RPT = 4;
    for (int m = gw; m < NTOK; m += RPT * NGW) {
        f32x4 v[RPT][4];
#pragma unroll
        for (int q = 0; q < RPT; ++q) { const int mq = m + q * NGW; const f32x4* xr = (const f32x4*)(P.x + (size_t)(mq < NTOK ? mq : m) * DMODEL) + lane;
#pragma unroll
            for (int j = 0; j < 4; ++j) v[q][j] = __builtin_nontemporal_load(xr + 64 * j); }
#pragma unroll
        for (int q = 0; q < RPT; ++q) { const int mq = m + q * NGW; float ss = 0.f;
#pragma unroll
            for (int j = 0; j < 4; ++j) ss += (v[q][j][0] * v[q][j][0] + v[q][j][1] * v[q][j][1]) + (v[q][j][2] * v[q][j][2] + v[q][j][3] * v[q][j][3]);
            const float r = 1.0f / sqrtf(wave_sum(ss) * (1.0f / DMODEL) + EPS);
            if (mq < NTOK) { v2u* o8 = (v2u*)(HB + (size_t)mq * DMODEL) + lane; if (lane == 0) RR[mq] = r;
#pragma unroll
                for (int j = 0; j < 4; ++j) { const f32x4 y = v[q][j]; v2u w; w.x = cvt_pk_bf16(y[0], y[1]); w.y = cvt_pk_bf16(y[2], y[3]); o8[64 * j] = w; } } }
    }
}

__device__ __forceinline__ void conv_phase(const Ptrs& P, LAS unsigned char* lds, int first, int stride) {
    const int tid = tid_opaque(), lane = tid & 63, wave = __builtin_amdgcn_readfirstlane(tid >> 6);
    const bf16* YG = (const bf16*)(P.ws + WS_YG); bf16* CA = (bf16*)(P.ws + WS_CA);
    LAS bf16* yt = (LAS bf16*)lds; LAS float* co = (LAS float*)(lds + 62 * 1024);
    constexpr int NT = NTOK / 32;
    if (first >= NT) return;
    float w[CONV_W];
#pragma unroll
    for (int j = 0; j < CONV_W; ++j) w[j] = P.conv_dw_w[j * CONV_CH + tid];
    const float bias = P.conv_dw_b[tid];
    const f32x4 g0 = ((const f32x4*)P.conv_ln_g)[lane], g1 = ((const f32x4*)P.conv_ln_g)[64 + lane], b0 = ((const f32x4*)P.conv_ln_b)[lane], b1 = ((const f32x4*)P.conv_ln_b)[64 + lane];
    v4u pre[8];
#define CONV_FETCH(tile) do { const int b_ = (tile) / (SEQ / 32), t0_ = ((tile) % (SEQ / 32)) * 32; _Pragma("unroll") for (int p = 0; p < 8; ++p) { const int q = tid + NTHREADS * p; const int row = q >> 6, ch = q & 63, t = t0_ - 30 + row; \
        pre[p] = (v4u){0u, 0u, 0u, 0u}; if (q < 62 * 64 && t >= 0) pre[p] = *(const v4u*)(YG + ((size_t)(b_ * SEQ + t)) * 512 + ch * 8); } } while (0)
    CONV_FETCH(first);
    for (int tile = first; tile < NT; tile += stride) {
        const int b = tile / (SEQ / 32), t0 = (tile % (SEQ / 32)) * 32;
#pragma unroll
        for (int p = 0; p < 8; ++p) { const int q = tid + NTHREADS * p; if (q < 62 * 64) *(LAS v4u*)(yt + (q >> 6) * 512 + (q & 63) * 8) = pre[p]; }
        __syncthreads();
        if (tile + stride < NT) CONV_FETCH(tile + stride);
        float yv[62];
#pragma unroll
        for (int i = 0; i < 62; ++i) yv[i] = __uint_as_float((unsigned)yt[i * 512 + tid] << 16);
#pragma unroll
        for (int t = 0; t < 32; ++t) { float a = bias;
#pragma unroll
            for (int j = 0; j < CONV_W; ++j) a += w[j] * yv[t + j];
            co[t * 512 + tid] = a; }
        __syncthreads();
#pragma unroll
        for (int rr = 0; rr < 4; ++rr) { const int row = wave * 4 + rr;
            const f32x4 v0 = *(const LAS f32x4*)(co + row * 512 + lane * 4), v1 = *(const LAS f32x4*)(co + row * 512 + 256 + lane * 4);
            const float mean = wave_sum((v0[0] + v0[1]) + (v0[2] + v0[3]) + (v1[0] + v1[1]) + (v1[2] + v1[3])) * (1.0f / CONV_CH);
            const f32x4 d0 = v0 - mean, d1 = v1 - mean;
            const float var = wave_sum((d0[0] * d0[0] + d0[1] * d0[1]) + (d0[2] * d0[2] + d0[3] * d0[3]) + (d1[0] * d1[0] + d1[1] * d1[1]) + (d1[2] * d1[2] + d1[3] * d1[3])) * (1.0f / CONV_CH);
            const float rstd = 1.0f / sqrtf(var + EPS);
            f32x4 y0 = d0 * rstd * g0 + b0, y1 = d1 * rstd * g1 + b1;
#pragma unroll
            for (int j = 0; j < 4; ++j) { y0[j] = y0[j] * sigmoidf_fast(y0[j]); y1[j] = y1[j] * sigmoidf_fast(y1[j]); }
            bf16* orow = CA + ((size_t)(b * SEQ + t0 + row)) * 1024;
            v2u o0, o1; o0.x = cvt_pk_bf16(y0[0], y0[1]); o0.y = cvt_pk_bf16(y0[2], y0[3]); o1.x = cvt_pk_bf16(y1[0], y1[1]); o1.y = cvt_pk_bf16(y1[2], y1[3]);
            *(v2u*)(orow + lane * 4) = o0; *(v2u*)(orow + 256 + lane * 4) = o1; }
        __syncthreads();
    }
#undef CONV_FETCH
}

__device__ __forceinline__ void attn_pair(const Ptrs& P, LAS unsigned char* lds, char* lds_generic, int p) {
    const int tid = tid_opaque(), lane = tid & 63, wave = __builtin_amdgcn_readfirstlane(tid >> 6);
    const int bh = p >> 3, s = p & 7, b = bh >> 2, h = bh & 3;
    const __hip_bfloat16* QB = (const __hip_bfloat16*)(P.ws + WS_QB); const __hip_bfloat16* KB = (const __hip_bfloat16*)(P.ws + WS_KB); const __hip_bfloat16* VB = (const __hip_bfloat16*)(P.ws + WS_VB);
    __hip_bfloat16* OT = (__hip_bfloat16*)(P.ws + WS_A); bf16* CA = (bf16*)(P.ws + WS_CA);
    float mstat;
    { int l0 = lane; asm volatile("" : "+v"(l0));
      const float a = wave_max(fabsf(P.q_norm_g[l0])), b = wave_max(fabsf(P.k_norm_g[l0]));
      mstat = __int_as_float(__builtin_amdgcn_readfirstlane(__float_as_int(0.125f * 1.4426950408889634f * 64.0f * 1.02f * a * b))); }
    float lam;
    { int l1 = lane; asm volatile("" : "+v"(l1));
      lam = __int_as_float(__builtin_amdgcn_readfirstlane(__float_as_int(__expf(wave_sum(P.lq1[l1] * P.lk1[l1])) - __expf(wave_sum(P.lq2[l1] * P.lk2[l1])) + 0.2f))); }
    int s0 = 0; bool pre = false;
#pragma unroll 1
    for (int u4 = 0; u4 < 4; ++u4) { const int i = u4 >> 1, c = u4 & 1;
        const int qb = (i == 0) ? s : 15 - s;
        const __hip_bfloat16* q_ = QB + (size_t)b * SEQ * 512 + (h * 2 + c) * 64; const __hip_bfloat16* k_ = KB + (size_t)b * SEQ * 512 + (h * 2 + c) * 64; const __hip_bfloat16* v_ = VB + (size_t)b * SEQ * 512 + h * 128;
        const __hip_bfloat16* kn_ = (u4 < 3) ? KB + (size_t)b * SEQ * 512 + (h * 2 + (c ^ 1)) * 64 : nullptr;
        __hip_bfloat16* o_ = OT + (size_t)b * SEQ * 1024 + (h * 2) * 128;
        const __hip_bfloat16* o1_ = c ? o_ : nullptr; unsigned short* ca_ = CA + (size_t)b * SEQ * 1024 + 512 + h * 128;
        int sn;
        if (mstat <= 40.0f) sn = attn_body::attn_unit<8, true>(mstat, qb * 256, q_, k_, v_, o_, lds_generic, o1_, lam, P.subln_g, ca_, kn_, v_, s0, pre);
        else sn = attn_body::attn_unit<8, false>(0.f, qb * 256, q_, k_, v_, o_, lds_generic, o1_, lam, P.subln_g, ca_, kn_, v_, s0, pre);
        s0 = sn; pre = (kn_ != nullptr); }
}

__device__ __forceinline__ void router_tile(const Ptrs& P, LAS unsigned char* lds, int tile) {
    const int tid = tid_opaque(), lane = tid & 63, wave = __builtin_amdgcn_readfirstlane(tid >> 6), r32 = lane & 31, hi = lane >> 5;
    const bf16* WRhi = (const bf16*)(P.ws + WS_WR); const bf16* WRlo = WRhi + 64 * 1024;
    int* LIST = (int*)(P.ws + WS_LIST); int* CTOK = (int*)(P.ws + WS_CTOK); unsigned* cnt = (unsigned*)(P.ws + WS_CTL); unsigned* ccnt = cnt + 64;
    LAS float* lg = (LAS float*)(lds + wave * 16384);
    LAS int* hist = (LAS int*)(lds + HIST_OFF); LAS int* hbase = hist + 32; LAS int* hist2 = hist + 64; LAS int* hbase2 = hist2 + NCLS;
    if (tid < 32) hist[tid] = 0;
    if (tid >= 64 && tid < 64 + NCLS) hist2[tid - 64] = 0;
    __syncthreads();
    const int tbase = tile * 256 + wave * 32;
    LAS unsigned char* ring = lds + wave * 16384;
    const bf16* xg = (const bf16*)(P.ws + WS_CA) + (size_t)(tbase + (lane >> 3)) * DMODEL + (((lane & 7) ^ ((lane >> 3) & 7)) * 8);
    const bf16* wf0 = WRhi + lane * 8;
    f32x16 acc0 = {}, acc1 = {}; float ssq = 0.f;
#define RT_XDMA(c) do { _Pragma("unroll") for (int i_ = 0; i_ < 4; ++i_) \
        __builtin_amdgcn_global_load_lds((const unsigned*)(xg + (size_t)i_ * 8 * DMODEL + (c) * 64), (LAS unsigned*)(ring + ((c) & 3) * 4096 + i_ * 1024), 16, 0, 0); } while (0)
#define RT_WLOAD(dst, c) do { _Pragma("unroll") for (int q_ = 0; q_ < 4; ++q_) _Pragma("unroll") for (int f_ = 0; f_ < 4; ++f_) dst[q_][f_] = *(const bf16x8*)(wf0 + ((((c) * 4 + q_) * 4 + f_) * 64) * 8); } while (0)
    bf16x8 wA[4][4], wB[4][4];
    RT_XDMA(0); RT_XDMA(1); RT_XDMA(2); RT_WLOAD(wA, 0);
    const LAS unsigned char* xrd = ring + r32 * 128;
#define RT_CHUNK(c, wc, wn) do { \
        if ((c) + 1 < 16) RT_WLOAD(wn, (c) + 1); \
        if ((c) + 3 < 16) RT_XDMA((c) + 3); \
        if ((c) + 3 < 16) asm volatile("s_waitcnt vmcnt(24)" ::: "memory"); else if ((c) + 1 < 16) asm volatile("s_waitcnt vmcnt(16)" ::: "memory"); else asm volatile("s_waitcnt vmcnt(0)" ::: "memory"); \
        _Pragma("unroll") for (int q_ = 0; q_ < 4; ++q_) { \
            const v4u xa = *(const LAS v4u*)(xrd + ((c) & 3) * 4096 + (((2 * q_ + hi) ^ (r32 & 7)) * 16)); \
            f32x4 x0, x1; unpack8(xa, x0, x1); \
            ssq += (x0[0] * x0[0] + x0[1] * x0[1]) + (x0[2] * x0[2] + x0[3] * x0[3]) + (x1[0] * x1[0] + x1[1] * x1[1]) + (x1[2] * x1[2] + x1[3] * x1[3]); \
            const bf16x8 a_hi = __builtin_bit_cast(bf16x8, xa); \
            acc0 = __builtin_amdgcn_mfma_f32_32x32x16_bf16(a_hi, wc[q_][0], acc0, 0, 0, 0); acc1 = __builtin_amdgcn_mfma_f32_32x32x16_bf16(a_hi, wc[q_][1], acc1, 0, 0, 0); \
            acc0 = __builtin_amdgcn_mfma_f32_32x32x16_bf16(a_hi, wc[q_][2], acc0, 0, 0, 0); acc1 = __builtin_amdgcn_mfma_f32_32x32x16_bf16(a_hi, wc[q_][3], acc1, 0, 0, 0); } \
        asm volatile("s_waitcnt lgkmcnt(0)" ::: "memory"); } while (0)
#pragma unroll
    for (int c = 0; c < 16; c += 2) { RT_CHUNK(c, wA, wB); RT_CHUNK(c + 1, wB, wA); }
#undef RT_XDMA
#undef RT_WLOAD
#undef RT_CHUNK
    ssq += __shfl_xor(ssq, 32);
    const float rs = 1.0f / sqrtf(ssq * (1.0f / DMODEL) + EPS);
#pragma unroll
    for (int r = 0; r < 16; ++r) { const int m = (r & 3) + 8 * (r >> 2) + 4 * hi; lg[m * 66 + r32] = acc0[r]; lg[m * 66 + 32 + r32] = acc1[r]; }
    asm volatile("s_waitcnt lgkmcnt(0)" ::: "memory");
    int ea = 0, eb = 0, cls = 0, lpa = 0, lpb = 0, lpc = 0; float wa = 0.f, wb = 0.f;
    if (lane < 32) {
        const LAS float* L = lg + lane * 66;
        float gl[4];
#pragma unroll
        for (int j = 0; j < 4; ++j) gl[j] = L[j] * rs + P.b_rg[j];
        int gs = 0; float gm = gl[0];
#pragma unroll
        for (int j = 1; j < 4; ++j) if (gl[j] > gm) { gm = gl[j]; gs = j; }
        float gsum = 0.f;
#pragma unroll
        for (int j = 0; j < 4; ++j) gsum += __expf(gl[j] - gm);
        const float gw = 1.0f / gsum;
        float l0 = -INFINITY, l1 = -INFINITY; int i0 = 0, i1 = 0;
#pragma unroll
        for (int j = 0; j < 8; ++j) { const float v = L[4 + gs * 8 + j] * rs + P.b_re[gs * 8 + j];
            if (v > l0) { l1 = l0; i1 = i0; l0 = v; i0 = j; } else if (v > l1) { l1 = v; i1 = j; } }
        const float q = __expf(l1 - l0), inv = 1.0f / (1.0f + q);
        const float w0 = inv * gw, w1 = q * inv * gw;
        const int a = min(i0, i1), b = max(i0, i1);
        wa = (i0 < i1) ? w0 : w1; wb = (i0 < i1) ? w1 : w0;
        ea = gs * 8 + a; eb = gs * 8 + b; cls = gs * 28 + (a * (15 - a)) / 2 + (b - a - 1);
        lpa = __hip_atomic_fetch_add(&hist[ea], 1, __ATOMIC_RELAXED, __HIP_MEMORY_SCOPE_WORKGROUP); lpb = __hip_atomic_fetch_add(&hist[eb], 1, __ATOMIC_RELAXED, __HIP_MEMORY_SCOPE_WORKGROUP);
        lpc = __hip_atomic_fetch_add(&hist2[cls], 1, __ATOMIC_RELAXED, __HIP_MEMORY_SCOPE_WORKGROUP);
    }
    __syncthreads();
    if (tid < 32) hbase[tid] = (int)atomicAdd(cnt + tid, (unsigned)hist[tid]);
    if (tid >= 64 && tid < 64 + NCLS) { const int c = tid - 64; const int n = hist2[c]; hbase2[c] = n ? (int)atomicAdd(ccnt + c, (unsigned)n) : 0; }
    __syncthreads();
    if (lane < 32) { const int t = tbase + lane; const int pa = hbase[ea] + lpa, pb = hbase[eb] + lpb, pc = hbase2[cls] + lpc;
        typedef int i32x4 __attribute__((ext_vector_type(4)));
        const int dst = (cls << 17) | (pc << 1);
        *(i32x4*)(LIST + (size_t)(ea * LCAP + pa) * 4) = (i32x4){t, dst, __float_as_int(wa), __float_as_int(rs)};
        *(i32x4*)(LIST + (size_t)(eb * LCAP + pb) * 4) = (i32x4){t, dst | 1, __float_as_int(wb), __float_as_int(rs)};
        CTOK[(size_t)cls * NTOK + pc] = t; }
    __syncthreads();
}

__device__ __forceinline__ void p5_convert(const Ptrs& P, LAS unsigned char* lds, int vcu, int G) {
    const int tid = tid_opaque(), lane = tid & 63, wave = __builtin_amdgcn_readfirstlane(tid >> 6);
    LAS float* scr = (LAS float*)(lds + wave * 16384);
    const int gw = vcu * NWAVES + wave, NGW = G * NWAVES;
    unsigned char* WGU = P.ws + WS_WGU; unsigned char* WD = P.ws + WS_WD;
    constexpr int I_G = (DMODEL / 64) * (DEXP / 32);
    constexpr int I_D = (DEXP / 64) * (DMODEL / 32);
    constexpr int PER_E = 2 * I_G + I_D;
    constexpr int NITEMS = NEXP * PER_E, NRW = (NTOK / 256) * NWAVES;
    constexpr int SA = P5_SPLIT_A, SB = 24 - SA;
    const bool split = (G == 256) && (NITEMS == NRW * SA + (256 * NWAVES - NRW) * SB);
    const bool rwg = (int)blockIdx.x < NTOK / 256; const int wv = ((int)blockIdx.x - (rwg ? 0 : NTOK / 256)) * NWAVES + wave;
    const int it0 = split ? (rwg ? wv : NRW * SA + wv) : gw, itn = split ? (rwg ? NRW * SA : NITEMS) : NITEMS, its = split ? NRW : NGW;
    struct Item { const float* W; int N, k0, n0; unsigned char* WT; int dpitch, drow0; const float* ks; float mul; };
    auto decode = [&](int it) { Item q; const int e = it / PER_E; int r = it % PER_E;
        if (r < 2 * I_G) { const int up = r / I_G; r %= I_G; const int kb = r / (DEXP / 32), nb = r % (DEXP / 32), n0 = nb * 32;
            q.W = (up ? P.w_up : P.w_gate) + (size_t)e * DMODEL * DEXP; q.N = DEXP; q.k0 = kb * 64; q.n0 = n0; q.WT = WGU + (size_t)e * 1024 * 1024; q.dpitch = 1024; q.drow0 = (n0 >> 7) * 256 + up * 128 + (n0 & 127); q.ks = P.ffn_norm_g; q.mul = 64.f;
        } else { r -= 2 * I_G; const int kb = r / (DMODEL / 32), nb = r % (DMODEL / 32);
            q.W = P.w_down + (size_t)e * DEXP * DMODEL; q.N = DMODEL; q.k0 = kb * 64; q.n0 = nb * 32; q.WT = WD + (size_t)e * 1024 * 512; q.dpitch = 512; q.drow0 = nb * 32; q.ks = nullptr; q.mul = 32.f; }
        return q; };
    for (int it = it0; it < itn; it += 4 * its) {
        const bool h1 = it + its < itn, h2 = it + 2 * its < itn, h3 = it + 3 * its < itn;
        const Item a = decode(it), b = decode(h1 ? it + its : it), c = decode(h2 ? it + 2 * its : it), d = decode(h3 ? it + 3 * its : it);
        f32x4 va[8], vb[8], vc[8], vd[8];
        t8_load(va, a.W, a.N, a.k0, a.n0, lane); t8_load(vb, b.W, b.N, b.k0, b.n0, lane); t8_load(vc, c.W, c.N, c.k0, c.n0, lane); t8_load(vd, d.W, d.N, d.k0, d.n0, lane);
        t8_finish(va, a.k0, a.WT, a.dpitch, a.drow0, a.ks, a.mul, scr, lane);
        if (h1) t8_finish(vb, b.k0, b.WT, b.dpitch, b.drow0, b.ks, b.mul, scr, lane);
        if (h2) t8_finish(vc, c.k0, c.WT, c.dpitch, c.drow0, c.ks, c.mul, scr, lane);
        if (h3) t8_finish(vd, d.k0, d.WT, d.dpitch, d.drow0, d.ks, d.mul, scr, lane);
    }
}

struct Args { Ptrs p; int ph_lo, ph_hi, use_cg, pad; };
__global__ void __launch_bounds__(NTHREADS, 2) mega_fwd(Args args) {
    extern __shared__ __attribute__((aligned(16))) unsigned char lds_raw[];
    LAS unsigned char* lds = (LAS unsigned char*)lds_raw;
    const Ptrs& P = args.p;
    const int tid = tid_opaque();
    const int G = gridDim.x, bx = blockIdx.x; const int vcu = (G % 8 == 0) ? (bx % 8) * (G / 8) + bx / 8 : bx;
    const int lo = args.ph_lo, hi = args.ph_hi;
    LAS int* meta = (LAS int*)(lds + META_OFF);
    if (tid < 2) ((volatile LAS unsigned*)(lds + BARST_OFF))[tid] = 0u;
    __syncthreads();
    XcdBarrier bar = xcd_barrier_post((unsigned*)(P.ws + WS_CTL) + 1024, (volatile LAS unsigned*)(lds + BARST_OFF));
#ifndef PHASE_MASK
#define PHASE_MASK 0xff
#endif
#ifndef DUP_PHASE
#define DUP_PHASE -1
#endif
#define REPS(k) for (int rep_ = 0; rep_ < ((DUP_PHASE == (k)) ? 2 : 1); ++rep_)
#define REPBAR() do { if (rep_) xcd_barrier(bar); } while (0)
#define IN(k) (((PHASE_MASK >> (k)) & 1) && lo <= (k) && (k) < hi)
#define SEAM(k) do { if (IN(k) && IN((k) + 1)) xcd_barrier(bar); } while (0)
    bf16* WS16 = (bf16*)P.ws;
    if (IN(0)) REPS(0) { REPBAR(); p0_prologue(P, lds, vcu, G); }
    SEAM(0);
    if (IN(1)) REPS(1) { REPBAR();
        pg8::Gemm g{(const bf16*)(P.ws + WS_XB), (const bf16*)(P.ws + WS_WIN), DMODEL, 0, nullptr};
        pg8::StaticOrder S; S.init(NTOK, IN_COLS, G, bx);
        LAS float* gl = (LAS float*)(lds + RING_BYTES + 8192);
        if (tid < 128) gl[tid] = (tid < 64) ? P.q_norm_g[tid] : P.k_norm_g[tid - 64];
        __syncthreads();
        EpiInProj E{(bf16*)(P.ws + WS_YG), (bf16*)(P.ws + WS_QB), (bf16*)(P.ws + WS_KB), (bf16*)(P.ws + WS_VB), (bf16*)(P.ws + WS_GT), gl, (const float*)(P.ws + WS_R)};
#if defined(DUMP_SEL) && DUMP_SEL == 5
        EpiRaw ER{(bf16*)(P.ws + WS_QB)};
        pg8::gemm_phase<EpiRaw, pg8::StaticOrder, false, true>(lds, g, S, ER);
#else
        pg8::gemm_phase<EpiInProj, pg8::StaticOrder, false, true>(lds, g, S, E);
#endif
    }
    SEAM(1);
    if (IN(2)) {
        REPS(2) { REPBAR();
        for (int p = vcu; p < 256; p += G) attn_pair(P, lds, (char*)lds_raw, p);
        __syncthreads(); }
        REPS(20) { REPBAR();
        conv_phase(P, lds, bx, G); }
    }
    SEAM(2);
    if (IN(3)) REPS(3) { REPBAR();
        pg8::Gemm g{(const bf16*)(P.ws + WS_CA), (const bf16*)(P.ws + WS_WCA), DMODEL, 0, nullptr};
        pg8::StaticOrder S; S.init(NTOK, DMODEL, G, bx);
        EpiMerged E{(const bf16*)(P.ws + WS_GT), (const bf16*)(P.ws + WS_GT) + (size_t)NTOK * 1024, (bf16*)(P.ws + WS_MG)};
#ifdef SKEW3
        if ((bx >> 3) & 1) { const unsigned long long t0 = __builtin_amdgcn_s_memrealtime(); while ((long long)(__builtin_amdgcn_s_memrealtime() - t0) < SKEW3) __builtin_amdgcn_s_sleep(8); }
#endif
        pg8::gemm_phase<EpiMerged, pg8::StaticOrder, false, true>(lds, g, S, E);
    }
    SEAM(3);
    if (IN(4)) REPS(4) { REPBAR();
        pg8::Gemm g{(const bf16*)(P.ws + WS_MG), (const bf16*)(P.ws + WS_WOUT), DMODEL, 0, nullptr};
        pg8::StaticOrder S; S.init(NTOK, DMODEL, G, bx);
        EpiOut E{(const bf16*)(P.ws + WS_XB), (bf16*)(P.ws + WS_CA), P.ws + WS_XM};
        pg8::gemm_phase<EpiOut, pg8::StaticOrder, false, true>(lds, g, S, E);
    }
    SEAM(4);
    if (IN(5)) {
        for (int t = bx; t < NTOK / 256; t += G) router_tile(P, lds, t);
        REPS(5) { REPBAR(); p5_convert(P, lds, vcu, G); }
    }
    SEAM(5);
    LAS int* meta2 = (LAS int*)(lds + META2_OFF);
    if (IN(6)) REPS(6) { REPBAR();
        moe_meta(meta, meta2, (const unsigned*)(P.ws + WS_CTL));
        pg8::Gemm g{(const bf16*)(P.ws + WS_XM), (const bf16*)(P.ws + WS_WGU), DMODEL / 2, (size_t)1024 * 1024, (const int*)(P.ws + WS_LIST), 4};
        MoeOrder S{G, vcu, __builtin_amdgcn_readfirstlane(meta[NEXP]), meta};
        EpiGateUp E{(const int*)(P.ws + WS_LIST), P.ws + WS_A, meta2};
        pg8::gemm_phase<EpiGateUp, MoeOrder, true, true, true>(lds, g, S, E);
    }
    SEAM(6);
    if (IN(7)) REPS(7) { REPBAR();
        moe_meta(meta, meta2, (const unsigned*)(P.ws + WS_CTL));
        pg8::Gemm g{(const bf16*)(P.ws + WS_A), (const bf16*)(P.ws + WS_WD), DMODEL / 2, (size_t)1024 * 512, nullptr, 0, DEXP / 2};
        ClassOrder S{G, vcu, __builtin_amdgcn_readfirstlane(meta2[NCLS]), meta2};
        EpiDownAdd E{(const int*)(P.ws + WS_CTOK), (const bf16*)(P.ws + WS_CA), P.out};
        pg8::gemm_phase<EpiDownAdd, ClassOrder, false, true, true, true>(lds, g, S, E);
    }
#if defined(DUMP_SEL)
    xcd_barrier(bar);
    { const bf16* YG = (const bf16*)(P.ws + WS_YG); const bf16* QB = (const bf16*)(P.ws + WS_QB); const bf16* KB = (const bf16*)(P.ws + WS_KB); const bf16* VB = (const bf16*)(P.ws + WS_VB);
      const bf16* GT = (const bf16*)(P.ws + WS_GT); const bf16* CA = (const bf16*)(P.ws + WS_CA); const bf16* MG = (const bf16*)(P.ws + WS_MG);
      for (size_t i = (size_t)bx * NTHREADS + tid; i < (size_t)NTOK * 1024; i += (size_t)G * NTHREADS) { const size_t t = i >> 10; const int c = (int)(i & 1023); float v = 0.f;
#if DUMP_SEL == 1
          v = bf_lo(YG[t * 512 + (c & 511)]) + bf_lo(QB[t * 512 + (c & 511)]) + 2.f * bf_lo(KB[t * 512 + (c & 511)]) + 3.f * bf_lo(VB[t * 512 + (c & 511)]) + bf_lo(GT[t * 2048 + c]) + bf_lo(GT[t * 2048 + 1024 + c]);
#elif DUMP_SEL == 2
          v = bf_lo(CA[t * 1024 + c]);
#elif DUMP_SEL == 4
          { const bf16* HB = (const bf16*)(P.ws + WS_A); const bf16* WIN = (const bf16*)(P.ws + WS_WIN); v = bf_lo(HB[i]) + 30.f * bf_lo(WIN[i % ((size_t)IN_COLS * 1024)]); }
#elif DUMP_SEL == 5
          { const bf16* R = (const bf16*)(P.ws + WS_QB); v = bf_lo(R[t * 4608 + c]) + bf_lo(R[t * 4608 + 1024 + c]) + bf_lo(R[t * 4608 + 2048 + c]) + bf_lo(R[t * 4608 + 3072 + c]) + bf_lo(R[t * 4608 + 4096 + (c & 511)]); }
#elif DUMP_SEL == 3
          v = bf_lo(MG[t * 1024 + c]);
#endif
          P.out[i] = v; } }
#endif
    (void)WS16;
#undef IN
#undef SEAM
}

extern "C" void kernel_launch(void* const* d_in, const int* in_sizes, int n_in, void* d_out, int out_size, void* d_ws, size_t ws_size, hipStream_t stream) {
    static int grid = 0;
    if (grid == 0) {
        if (n_in != 25 || in_sizes[0] != NTOK * DMODEL || out_size != NTOK * DMODEL || ws_size < WS_END) {
            fprintf(stderr, "kernel_launch: unexpected shapes (n_in %d, in0 %d, out %d, ws %zu); nothing launched\n", n_in, n_in > 0 ? in_sizes[0] : -1, out_size, ws_size); grid = -1; return; }
        int dev = 0, cus = 0, per_cu = 0;
        if (hipGetDevice(&dev) != hipSuccess || hipDeviceGetAttribute(&cus, hipDeviceAttributeMultiprocessorCount, dev) != hipSuccess) { grid = -1; return; }
        if (hipFuncSetAttribute((const void*)mega_fwd, hipFuncAttributeMaxDynamicSharedMemorySize, LDS_BYTES) != hipSuccess) { fprintf(stderr, "kernel_launch: hipFuncSetAttribute failed\n"); grid = -1; return; }
        if (hipOccupancyMaxActiveBlocksPerMultiprocessor(&per_cu, (const void*)mega_fwd, NTHREADS, LDS_BYTES) != hipSuccess || per_cu < 1) { fprintf(stderr, "kernel_launch: the occupancy query reports %d workgroups per CU for this kernel and LDS size; nothing launched\n", per_cu); grid = -1; return; }
        (void)hipGetLastError();
        grid = cus;
    }
    if (grid < 0) return;
    (void)hipMemsetAsync((char*)d_ws + WS_CTL, 0, CTL_ZERO_BYTES, stream);
    Args a{};
    const float** pp = (const float**)&a.p;
    for (int i = 0; i < 25; ++i) pp[i] = (const float*)d_in[i];
    a.p.out = (float*)d_out; a.p.ws = (unsigned char*)d_ws;
#if MK_PER_PHASE
    for (int ph = 0; ph < N_PHASES; ++ph) { a.ph_lo = ph; a.ph_hi = ph + 1; void* params[] = {&a};
        hipError_t e = hipLaunchCooperativeKernel((const void*)mega_fwd, dim3(grid), dim3(NTHREADS), params, LDS_BYTES, stream);
        if (e != hipSuccess) { fprintf(stderr, "launch %d failed: %s\n", ph, hipGetErrorString(e)); break; } }
#else
    a.ph_lo = 0; a.ph_hi = N_PHASES; void* params[] = {&a};
    hipError_t e = hipLaunchCooperativeKernel((const void*)mega_fwd, dim3(grid), dim3(NTHREADS), params, LDS_BYTES, stream);
    if (e != hipSuccess) fprintf(stderr, "cooperative launch failed: %s (grid %d)\n", hipGetErrorString(e), grid);
#endif
}
```

```cpp
#ifndef P5_SPLIT_A
#define P5_SPLIT_A 4
#endif
#include <hip/hip_runtime.h>
#include <hip/hip_bf16.h>
#include <hip/hip_cooperative_groups.h>
#include <cstdio>
#include <cstdint>
#include <cmath>
namespace cg = cooperative_groups;
__device__ __forceinline__ int tid_opaque() { int t = threadIdx.x; asm volatile("" : "+v"(t)); return t; }

constexpr int BATCH = 8, SEQ = 4096, DMODEL = 1024, NTOK = BATCH * SEQ;
constexpr int CONV_CH = 512, CONV_W = 31, NHEADS = 4, IN_COLS = 4608;
constexpr int NEXP = 32, DEXP = 512, LCAP = NTOK;
constexpr int NCLS = 4 * 28;
constexpr int CROWS = NTOK + NCLS * 256;
constexpr int MOE_ROWS = 2 * NTOK + NEXP * 256;
constexpr float EPS = 1e-6f;

namespace pg8 {
#define PG8_LAS __attribute__((address_space(3)))
typedef unsigned short bf16_t;
typedef short bf16x8 __attribute__((ext_vector_type(8)));
typedef float f32x4 __attribute__((ext_vector_type(4)));
typedef unsigned u32x4 __attribute__((ext_vector_type(4)));
constexpr int BM = 256, BK = 64, HALF = 128, HTB = HALF * BK * 2  , STAGE_BYTES = 8 * HTB, NXCD = 8, WGM = 8;

__host__ __device__ __forceinline__ int lds_byte(int r, int c) { const int st = (r >> 4) * 2 + (c >> 5), rr = r & 15, cc = c & 31, ob = rr * 64 + cc * 2; return st * 1024 + (ob ^ (((ob >> 9) & 1) << 5)); }
__host__ __device__ __forceinline__ void stage_rc(int b, int& R, int& C) { const int st = b / 1024, sb = b % 1024, swz = sb ^ (((sb >> 9) & 1) << 5); R = (st >> 1) * 16 + swz / 64; C = (st & 1) * 32 + (swz % 64) / 2; }
__host__ __device__ __forceinline__ int perm32(int rho) { const int n = rho >> 4, i = rho & 15; return 8 * (i >> 2) + 4 * n + (i & 3); }

struct Unit { int pm, pn, arow, e, e2, lrow, nvalid, orow; };
struct Gemm { const bf16_t* A; const bf16_t* Bt; int K; size_t bstride; const int* list; int lstride; int KBrow; };

struct StaticOrder {
    int nM, nN, nwg, G, c;
    __device__ void init(int M, int N, int G_, int c_) { nM = M / BM; nN = N / BM; nwg = nM * nN; G = G_; c = c_; }
    __device__ bool next(int i, Unit& u) const {
        const long L = (long)i * G + c; if (L >= nwg) return false;
        int wgid = (int)L; { const int q = nwg / NXCD, r = nwg % NXCD, xcd = wgid % NXCD, off = wgid / NXCD; wgid = (xcd < r ? xcd * (q + 1) : r * (q + 1) + (xcd - r) * q) + off; }
        const int nig = WGM * nN, gid = wgid / nig, fm = gid * WGM, gsz = (nM - fm) < WGM ? (nM - fm) : WGM;
        u.pm = fm + ((wgid % nig) % gsz); u.pn = (wgid % nig) / gsz; u.arow = u.pm * BM; u.orow = u.arow; u.e = 0; u.e2 = 0; u.lrow = 0; u.nvalid = BM; return true;
    }
};

typedef float f32x2_t __attribute__((ext_vector_type(2))); typedef __bf16 bf16x2_t __attribute__((ext_vector_type(2)));
__device__ __forceinline__ unsigned cvt_pk_bf16(float lo, float hi) { const f32x2_t v = {lo, hi}; const bf16x2_t b = __builtin_convertvector(v, bf16x2_t); return __builtin_bit_cast(unsigned, b); }
typedef int v8i_t __attribute__((ext_vector_type(8))); typedef int v4i_t __attribute__((ext_vector_type(4)));
__device__ __forceinline__ v8i_t cat8(const bf16x8 a, const bf16x8 b) { const v4i_t x = __builtin_bit_cast(v4i_t, a), y = __builtin_bit_cast(v4i_t, b); return (v8i_t){x[0], x[1], x[2], x[3], y[0], y[1], y[2], y[3]}; }
__device__ __forceinline__ unsigned pack4_fp8(float a, float b, float c, float d) { int w = 0; w = __builtin_amdgcn_cvt_pk_fp8_f32(a, b, w, false); w = __builtin_amdgcn_cvt_pk_fp8_f32(c, d, w, true); return (unsigned)w; }
__device__ __forceinline__ float bf_lo(unsigned w) { return __uint_as_float(w << 16); }
__device__ __forceinline__ float bf_hi(unsigned w) { return __uint_as_float(w & 0xffff0000u); }
__device__ __forceinline__ float sigmoidf_fast(float x) { return __builtin_amdgcn_rcpf(1.0f + __builtin_amdgcn_exp2f(-1.4426950408889634f * x)); }
__device__ __forceinline__ u32x4 pack8(const f32x4 a, const f32x4 b) { u32x4 w; w.x = cvt_pk_bf16(a[0], a[1]); w.y = cvt_pk_bf16(a[2], a[3]); w.z = cvt_pk_bf16(b[0], b[1]); w.w = cvt_pk_bf16(b[2], b[3]); return w; }
__device__ __forceinline__ void unpack8(const u32x4 w, f32x4& a, f32x4& b) { a = (f32x4){bf_lo(w.x), bf_hi(w.x), bf_lo(w.y), bf_hi(w.y)}; b = (f32x4){bf_lo(w.z), bf_hi(w.z), bf_lo(w.w), bf_hi(w.w)}; }

template <class Epi, class Sched, bool GATHER, bool ALIGN_EPI, bool FP8 = false, bool BSPLIT = false>
__device__ __forceinline__ void gemm_phase(PG8_LAS unsigned char* lds, const Gemm g, const Sched& S, const Epi& E) {
    const int tid = tid_opaque(), wid = __builtin_amdgcn_readfirstlane(tid >> 6), lane = tid & 63, wr = wid >> 2, wc = wid & 3, fr = lane & 15, fq = lane >> 4;
    const int K = g.K, nt = K / BK, KBp = g.KBrow ? g.KBrow : K;
    unsigned voffB[2]; int Ra[2], Ca[2];
#pragma unroll
    for (int i = 0; i < 2; ++i) { int R, C; stage_rc(tid * 16 + i * 8192, R, C); const int Rb = (R & ~31) + perm32(R & 31); Ra[i] = R; Ca[i] = C; voffB[i] = (unsigned)(Rb * KBp + C) * 2u; }
    const unsigned kstep = (unsigned)(BK * 2);
    const unsigned hstep = (unsigned)HALF * KBp * 2;
    const unsigned tstep = 2 * hstep;
    const char* const gA = (const char*)g.A; const char* const gB = (const char*)g.Bt;
    const unsigned ldsw = (unsigned)wid * 1024u;
    const int aoff = lds_byte(wr * 64 + fr, fq * 8), boff = lds_byte(wc * 32 + fr, fq * 8);
#define PG8_SA(b, h) (((b) * 2 + (h)) * HTB)
#define PG8_SB(b, h) ((4 + (b) * 2 + (h)) * HTB)
#define PG8_STAGE(bufoff, gbase, uoff, voff) do { _Pragma("unroll") for (int _i = 0; _i < 2; ++_i) \
        __builtin_amdgcn_global_load_lds((const unsigned*)((const char*)(gbase) + (unsigned)((uoff) + (voff)[_i])), (PG8_LAS unsigned*)(lds + (bufoff) + ldsw + _i * 8192), 16, 0, 0); } while (0)
#define PG8_LDA(dst, b, h) do { _Pragma("unroll") for (int m = 0; m < 4; ++m) _Pragma("unroll") for (int k = 0; k < 2; ++k) dst[m][k] = *(const PG8_LAS bf16x8*)(lds + PG8_SA(b, h) + aoff + m * 2048 + k * 1024); } while (0)
#define PG8_LDB(dst, b, h) do { _Pragma("unroll") for (int n = 0; n < 2; ++n) _Pragma("unroll") for (int k = 0; k < 2; ++k) dst[n][k] = *(const PG8_LAS bf16x8*)(lds + PG8_SB(b, h) + boff + n * 2048 + k * 1024); } while (0)
#define PG8_MMA(ai, bj, At, Bt) do { __builtin_amdgcn_s_setprio(1); \
        if constexpr (FP8) { _Pragma("unroll") for (int m = 0; m < 4; ++m) _Pragma("unroll") for (int n = 0; n < 2; ++n) \
            asm volatile("v_mfma_scale_f32_16x16x128_f8f6f4 %0, %1, %2, %0, %3, %3 op_sel_hi:[0,0,0]" : "+v"(acc[ai][bj][m][n]) : "v"(cat8(Bt[n][0], Bt[n][1])), "v"(cat8(At[m][0], At[m][1])), "v"(one_e8m0)); } \
        else { _Pragma("unroll") for (int m = 0; m < 4; ++m) _Pragma("unroll") for (int n = 0; n < 2; ++n) _Pragma("unroll") for (int k = 0; k < 2; ++k) \
            acc[ai][bj][m][n] = __builtin_amdgcn_mfma_f32_16x16x32_bf16(Bt[n][k], At[m][k], acc[ai][bj][m][n], 0, 0, 0); } \
        __builtin_amdgcn_s_setprio(0); } while (0)
#define PG8_WAIT_V(n) asm volatile("s_waitcnt vmcnt(" #n ")" ::: "memory")
#define PG8_WAIT_L(n) asm volatile("s_waitcnt lgkmcnt(" #n ")" ::: "memory")
#define PG8_BAR __builtin_amdgcn_s_barrier()
#define PG8_SCHED __builtin_amdgcn_sched_barrier(0)
#define PG8_LOAD_VA(dst, u) do { _Pragma("unroll") for (int _h = 0; _h < 2; ++_h) _Pragma("unroll") for (int _i = 0; _i < 2; ++_i) { const int _row = _h * HALF + Ra[_i]; \
        if constexpr (GATHER) { const int _tok = (_row < (u).nvalid) ? g.list[((u).lrow + _row) * g.lstride] : 0; dst[_h][_i] = (unsigned)(_tok * K + Ca[_i]) * 2u; } \
        else dst[_h][_i] = (unsigned)(_row * K + Ca[_i]) * 2u; } } while (0)
    Unit cur, nxt; int ui = 0;
    if (!S.next(0, cur)) return;
    typename Epi::Pre pre{};
    unsigned vAc[2][2], vAn[2][2];
    PG8_LOAD_VA(vAc, cur);
    f32x4 acc[2][2][4][2];
#pragma unroll
    for (int a = 0; a < 2; ++a)
#pragma unroll
        for (int b = 0; b < 2; ++b)
#pragma unroll
            for (int m = 0; m < 4; ++m)
#pragma unroll
                for (int n = 0; n < 2; ++n) acc[a][b][m][n] = (f32x4){0.f, 0.f, 0.f, 0.f};
    bf16x8 At[4][2], B0[2][2], B1[2][2];
    const int one_e8m0 = 0x7f7f7f7f; (void)one_e8m0;
    unsigned cA = (unsigned)cur.arow * K * 2, cB = (unsigned)cur.e * (unsigned)g.bstride + (unsigned)cur.pn * tstep;
    unsigned cB2 = (unsigned)cur.e2 * (unsigned)g.bstride + (unsigned)cur.pn * tstep; const unsigned hk = (unsigned)(nt / 2) * kstep; (void)cB2; (void)hk;
    PG8_STAGE(PG8_SB(0, 0), gB, cB, voffB); PG8_STAGE(PG8_SB(0, 1), gB, cB + hstep, voffB); PG8_STAGE(PG8_SA(0, 0), gA, cA, vAc[0]); PG8_STAGE(PG8_SA(0, 1), gA, cA, vAc[1]);
    if (wr == 1) PG8_BAR;
    PG8_WAIT_V(2); PG8_BAR;
    PG8_STAGE(PG8_SB(1, 0), gB, cB + kstep, voffB); PG8_STAGE(PG8_SA(1, 0), gA, cA + kstep, vAc[0]); PG8_STAGE(PG8_SB(1, 1), gB, cB + hstep + kstep, voffB);
    PG8_WAIT_V(6); PG8_BAR;
    for (;;) {
        const bool has_next = S.next(ui + 1, nxt);
        const unsigned nA = has_next ? (unsigned)nxt.arow * K * 2 : cA;
        const unsigned nB = has_next ? (unsigned)nxt.e * (unsigned)g.bstride + (unsigned)nxt.pn * tstep : cB;
        const unsigned nB2 = has_next ? (unsigned)nxt.e2 * (unsigned)g.bstride + (unsigned)nxt.pn * tstep : cB2; (void)nB2;
        if (has_next) { PG8_LOAD_VA(vAn, nxt); }
        else {
#pragma unroll
            for (int h = 0; h < 2; ++h)
#pragma unroll
                for (int i = 0; i < 2; ++i) vAn[h][i] = vAc[h][i]; }
#pragma unroll 1
        for (int t = 0; t < nt; t += 2) {
            const bool last = (t == nt - 2);
            if constexpr (Epi::MID) { if (t == nt / 2) E.mid(acc, cur, wr, wc, fr, fq); }
            if constexpr (Epi::PREMID) { if (t == nt / 2) pre = E.pre(cur, wr, fr); }
            const unsigned a1 = cA + (unsigned)(t + 1) * kstep;
            const unsigned a2 = last ? nA : cA + (unsigned)(t + 2) * kstep;
            unsigned b2 = last ? nB : cB + (unsigned)(t + 2) * kstep;
            if constexpr (BSPLIT) { if (!last && t + 2 >= nt / 2) b2 = cB2 + (unsigned)(t + 2) * kstep - hk; }
            const unsigned a3 = a2 + kstep, b3 = b2 + kstep;
            unsigned v2[2][2];
#pragma unroll
            for (int h = 0; h < 2; ++h)
#pragma unroll
                for (int i = 0; i < 2; ++i) v2[h][i] = vAc[h][i];
            if (last) { asm volatile("" ::: "memory");
#pragma unroll
                for (int h = 0; h < 2; ++h)
#pragma unroll
                    for (int i = 0; i < 2; ++i) v2[h][i] = vAn[h][i]; }
            PG8_LDB(B0, 0, 0); PG8_LDB(B1, 0, 1); PG8_SCHED; PG8_LDA(At, 0, 0); PG8_STAGE(PG8_SA(1, 1), gA, a1, vAc[1]);
            PG8_WAIT_V(8); PG8_WAIT_L(0); PG8_BAR; PG8_MMA(0, 0, At, B0); PG8_MMA(0, 1, At, B1); PG8_BAR; PG8_SCHED;
            PG8_LDA(At, 0, 1); PG8_STAGE(PG8_SB(0, 0), gB, b2, voffB); PG8_STAGE(PG8_SB(0, 1), gB, b2 + hstep, voffB); PG8_STAGE(PG8_SA(0, 0), gA, a2, v2[0]);
            PG8_WAIT_V(8); PG8_WAIT_L(0); PG8_BAR; PG8_MMA(1, 0, At, B0); PG8_MMA(1, 1, At, B1); PG8_BAR; PG8_SCHED;
            PG8_LDB(B0, 1, 0); PG8_LDB(B1, 1, 1); PG8_SCHED; PG8_LDA(At, 1, 0); PG8_STAGE(PG8_SA(0, 1), gA, a2, v2[1]);
            PG8_WAIT_V(8); PG8_WAIT_L(0); PG8_BAR; PG8_MMA(0, 0, At, B0); PG8_MMA(0, 1, At, B1); PG8_BAR; PG8_SCHED;
            PG8_LDA(At, 1, 1); PG8_STAGE(PG8_SB(1, 0), gB, b3, voffB); PG8_STAGE(PG8_SB(1, 1), gB, b3 + hstep, voffB); PG8_STAGE(PG8_SA(1, 0), gA, a3, v2[0]);
            PG8_WAIT_V(8); PG8_WAIT_L(0); PG8_BAR; PG8_MMA(1, 0, At, B0); PG8_MMA(1, 1, At, B1); PG8_BAR; PG8_SCHED;
        }
        if constexpr (ALIGN_EPI) { if (wr == 0) PG8_BAR; }
        if constexpr (FP8) asm volatile("s_nop 15\n\ts_nop 15\n\ts_nop 15\n\ts_nop 15" ::: "memory");
        if constexpr (Epi::PREMID) E(acc, cur, wr, wc, fr, fq, pre); else E(acc, cur, wr, wc, fr, fq, E.pre(cur, wr, fr));
        if (!has_next) break;
#pragma unroll
        for (int a = 0; a < 2; ++a)
#pragma unroll
            for (int b = 0; b < 2; ++b)
#pragma unroll
                for (int m = 0; m < 4; ++m)
#pragma unroll
                    for (int n = 0; n < 2; ++n) acc[a][b][m][n] = (f32x4){0.f, 0.f, 0.f, 0.f};
        cur = nxt; cA = nA; cB = nB; cB2 = nB2; ++ui;
#pragma unroll
        for (int h = 0; h < 2; ++h)
#pragma unroll
            for (int i = 0; i < 2; ++i) vAc[h][i] = vAn[h][i];
        if constexpr (ALIGN_EPI) { if (wr == 1) PG8_BAR; }
    }
    PG8_WAIT_V(0);
    if constexpr (!ALIGN_EPI) { if (wr == 0) PG8_BAR; }
    PG8_BAR;
#undef PG8_SA
#undef PG8_SB
#undef PG8_STAGE
#undef PG8_LDA
#undef PG8_LDB
#undef PG8_MMA
#undef PG8_WAIT_V
#undef PG8_WAIT_L
#undef PG8_BAR
#undef PG8_SCHED
#undef PG8_LOAD_VA
}
}

namespace attn_body {
using bf16=__hip_bfloat16;
using bf16x8=__attribute__((ext_vector_type(8)))short;
using s16x4=__attribute__((ext_vector_type(4)))short;
using f32x16=__attribute__((ext_vector_type(16)))float;
using u32x4=__attribute__((ext_vector_type(4)))unsigned;
constexpr int D=64, QP=512, KP=512, VP=512, OP=1024;
constexpr int NW=8,QBLK=32,QB=QBLK*NW,KVBLK=64;
constexpr int ATTN_UNIT_ROWS=QB;
__device__ __forceinline__ int crow(int r,int hi){return (r&3)+8*(r>>2)+4*hi;}
#define SBAR() __builtin_amdgcn_sched_barrier(0)
__device__ __forceinline__ void cmask(f32x16&p0,f32x16&p1,int jb,int qrel,int hi){
  const float NEG=-INFINITY; int kb=64*jb+4*hi;
  #pragma unroll
  for(int r=0;r<16;++r){int kv=kb+(r&3)+8*(r>>2); if(kv>qrel)p0[r]=NEG; if(kv+32>qrel)p1[r]=NEG;}
}

constexpr int NSLOT=3, SLOTB=8192, VSLOTB=16384;
constexpr int LDS_K=0, LDS_V=NSLOT*SLOTB, LDS_WS=LDS_V+NSLOT*VSLOTB, LDS_OST=LDS_WS+NW*64*4, LDS_BYTES=LDS_OST+NW*4096;
constexpr float C2=0.125f*1.4426950408889634f;
__device__ __forceinline__ void glds16(const void*gsrc,unsigned lds_dst){unsigned keep;
  asm volatile("s_mov_b32 %0, m0\n\ts_mov_b32 m0, %2\n\ts_nop 0\n\tglobal_load_lds_dwordx4 %1, off\n\ts_mov_b32 m0, %0":"=&s"(keep):"v"(gsrc),"s"(lds_dst):"memory");}
__device__ __forceinline__ float max3f(float a,float b,float c){float r;asm("v_max3_f32 %0, %1, %2, %3":"=v"(r):"v"(a),"v"(b),"v"(c));return r;}
__device__ __forceinline__ float max2f(float a,float b){float r;asm("v_max_f32_e32 %0, %1, %2":"=v"(r):"v"(a),"v"(b));return r;}
__device__ __forceinline__ float fadd_s(float a,float b){float r;asm("v_add_f32_e32 %0, %1, %2":"=v"(r):"v"(a),"v"(b));return r;}
__device__ __forceinline__ float fsub_s(float a,float b){float r;asm("v_sub_f32_e32 %0, %1, %2":"=v"(r):"v"(a),"v"(b));return r;}
typedef float f32x2_t __attribute__((ext_vector_type(2))); typedef __bf16 bf16x2_t __attribute__((ext_vector_type(2)));
__device__ __forceinline__ unsigned cvtpk_s(float lo,float hi){f32x2_t v={lo,hi};bf16x2_t b=__builtin_convertvector(v,bf16x2_t);return __builtin_bit_cast(unsigned,b);}
#define WAIT_BAR(N) asm volatile("s_waitcnt vmcnt(" #N ") lgkmcnt(0)\n\ts_barrier":::"memory")

__device__ __forceinline__ void qkt(f32x16&p0,f32x16&p1,const char*Kslot,const bf16x8*qr,const f32x16&negm,int r32,int hi){
  const char*kb=Kslot+hi*1024+r32*16;
  #pragma unroll
  for(int d0=0;d0<4;++d0){
    const bf16x8 b0=*reinterpret_cast<const bf16x8*>(kb+d0*2048);
    const bf16x8 b1=*reinterpret_cast<const bf16x8*>(kb+d0*2048+512);
    if(d0==0){p0=__builtin_amdgcn_mfma_f32_32x32x16_bf16(b0,qr[0],negm,0,0,0);p1=__builtin_amdgcn_mfma_f32_32x32x16_bf16(b1,qr[0],negm,0,0,0);}
    else{p0=__builtin_amdgcn_mfma_f32_32x32x16_bf16(b0,qr[d0],p0,0,0,0);p1=__builtin_amdgcn_mfma_f32_32x32x16_bf16(b1,qr[d0],p1,0,0,0);}}
}
typedef __attribute__((address_space(3))) const char* lds_cptr;
typedef short v4i16_t __attribute__((ext_vector_type(4)));
__device__ __forceinline__ void kload8(bf16x8*kf,lds_cptr kp){
  kf[0]=*(const __attribute__((address_space(3))) bf16x8*)(kp);      kf[1]=*(const __attribute__((address_space(3))) bf16x8*)(kp+512);
  kf[2]=*(const __attribute__((address_space(3))) bf16x8*)(kp+2048); kf[3]=*(const __attribute__((address_space(3))) bf16x8*)(kp+2560);
  kf[4]=*(const __attribute__((address_space(3))) bf16x8*)(kp+4096); kf[5]=*(const __attribute__((address_space(3))) bf16x8*)(kp+4608);
  kf[6]=*(const __attribute__((address_space(3))) bf16x8*)(kp+6144); kf[7]=*(const __attribute__((address_space(3))) bf16x8*)(kp+6656);
}
__device__ __forceinline__ void kload2(bf16x8*kf,lds_cptr kp,int j){ kf[2*j]=*(const __attribute__((address_space(3))) bf16x8*)(kp+j*2048); kf[2*j+1]=*(const __attribute__((address_space(3))) bf16x8*)(kp+j*2048+512); }
__device__ __forceinline__ s16x4 vtr(lds_cptr p){ return __builtin_bit_cast(s16x4,__builtin_amdgcn_ds_read_tr16_b64_v4i16((__attribute__((address_space(3))) v4i16_t*)p)); }
__device__ __forceinline__ float rowmax(const f32x16&p0,const f32x16&p1){
  float a=max3f(p0[0],p0[1],p1[0]),b=max3f(p0[2],p0[3],p1[1]);a=max3f(a,p1[2],p1[3]);
  #pragma unroll
  for(int r=4;r<16;r+=4){a=max3f(a,p0[r],p0[r+1]);b=max3f(b,p0[r+2],p0[r+3]);a=max3f(a,p1[r],p1[r+1]);b=max3f(b,p1[r+2],p1[r+3]);}
  const float m=max2f(a,b);
  auto rr=__builtin_amdgcn_permlane32_swap(__float_as_uint(m),__float_as_uint(m),false,false);
  return max2f(__uint_as_float(rr[0]),__uint_as_float(rr[1]));
}
__device__ __forceinline__ void pv(f32x16*o,int vb,bf16x8 pa0,bf16x8 pa1,bf16x8 pa2,bf16x8 pa3){
  #pragma unroll
  for(int d0=0;d0<4;++d0){s16x4 lo[4],hi[4];
    #pragma unroll
    for(int ks=0;ks<4;++ks){
      asm volatile("ds_read_b64_tr_b16 %0,%1 offset:%c2":"=&v"(lo[ks]):"v"(vb),"i"(d0*4096+ks*1024):"memory");
      asm volatile("ds_read_b64_tr_b16 %0,%1 offset:%c2":"=&v"(hi[ks]):"v"(vb),"i"(d0*4096+ks*1024+512):"memory");}
    asm volatile("s_waitcnt lgkmcnt(0)":::"memory");SBAR();
    #define PK(k) (bf16x8){lo[k][0],lo[k][1],lo[k][2],lo[k][3],hi[k][0],hi[k][1],hi[k][2],hi[k][3]}
    o[d0]=__builtin_amdgcn_mfma_f32_32x32x16_bf16(pa0,PK(0),o[d0],0,0,0);
    o[d0]=__builtin_amdgcn_mfma_f32_32x32x16_bf16(pa1,PK(1),o[d0],0,0,0);
    o[d0]=__builtin_amdgcn_mfma_f32_32x32x16_bf16(pa2,PK(2),o[d0],0,0,0);
    o[d0]=__builtin_amdgcn_mfma_f32_32x32x16_bf16(pa3,PK(3),o[d0],0,0,0);
    #undef PK
  }
}

#ifndef ATTN_STORE16
#define ATTN_STORE16(p,v) (*(u32x4*)(p)=(v))
#endif
template<int THRL,bool STAT> __device__ __forceinline__ int attn_unit(float mstat,int q0,const bf16*Q,const bf16*__restrict__ K,const bf16*__restrict__ V,bf16*O,char*shm,const bf16*O1,float lam,const float*subg,unsigned short*CAo,const bf16*Knext,const bf16*Vnext,int s0,bool pre){
  #define NXT_(x) (((x)==(NSLOT-1)*SLOTB)?0:(x)+SLOTB)
  const int s1=NXT_(s0),s2=NXT_(s1);
  int tid_=threadIdx.x; asm volatile("":"+v"(tid_));
  const int tid=tid_,lane=tid&63,r32=lane&31,hi=lane>>5; const int wid=__builtin_amdgcn_readfirstlane(tid>>6);
  const bf16*Qw=Q+(long)(q0+wid*QBLK)*QP;
  const bf16*Kh=K,*Vh=V;
  const unsigned lds0=(unsigned)(uintptr_t)shm;
  float*wsf=(float*)(shm+LDS_WS)+wid*64;
  const bf16*ksrc=Kh+(long)lane*KP+wid*8;
  const bf16*vsrc=Vh+(long)(16*(wid&3)+(lane>>2))*VP+(wid>>2)*32+(lane&3)*8;
  const unsigned kdst=lds0+LDS_K+wid*1024, vdst=lds0+LDS_V+wid*1024;
  #define DMA_K(t,slot) glds16(ksrc+(long)(t)*KVBLK*KP,(unsigned)__builtin_amdgcn_readfirstlane(kdst+(slot)))
  #define DMA_V(t,slot) do{ glds16(vsrc+(long)(t)*KVBLK*VP,(unsigned)__builtin_amdgcn_readfirstlane(vdst+2*(slot))); glds16(vsrc+(long)(t)*KVBLK*VP+64,(unsigned)__builtin_amdgcn_readfirstlane(vdst+2*(slot)+8192)); }while(0)
  const int vb0=(int)(lds0+LDS_V)+((lane>>4)&1)*32+(lane&3)*8+(4*hi+((lane&15)>>2))*64;
  const char*Kbase=shm+LDS_K; bf16x8 kf[8];
  const lds_cptr shm3=(lds_cptr)shm; const lds_cptr kp0=shm3+LDS_K+hi*1024+r32*16; const lds_cptr vp0=shm3+LDS_V+((lane>>4)&1)*32+(lane&3)*8+(4*hi+((lane&15)>>2))*64;
  const int NT=(q0+QB)/KVBLK;
  if(!pre){DMA_K(0,s0);DMA_V(0,s0);DMA_K(1,s1);}
  bf16x8 qr[4];
  #pragma unroll
  for(int d0=0;d0<4;++d0)qr[d0]=*reinterpret_cast<const bf16x8*>(&Qw[(long)r32*QP+d0*16+hi*8]);
  float mhat=0.f,l_reg=0.f;f32x16 o[4];{float zz=0.f;asm volatile("":"+v"(zz));
  #pragma unroll
  for(int r=0;r<16;++r){o[0][r]=zz;o[1][r]=zz;o[2][r]=zz;o[3][r]=zz;}}
  f32x16 negm;{float zn=0.f;asm volatile("":"+v"(zn));
  #pragma unroll
  for(int r=0;r<16;++r)negm[r]=zn;}
  asm volatile("":"+v"(negm));
  const int qrel=wid*QBLK+r32;
  #define CMASK(P0,P1,t) do{int jb_=(t)-(NT-4); if(jb_>=0)cmask(P0,P1,jb_,qrel,hi);}while(0)
  bool resc=false;
  #define START(P0,P1) do{ float rm; if constexpr (STAT) rm=mstat; else rm=rowmax(P0,P1); resc=false; \
    { const float dl=rm; mhat=fadd_s(mhat,dl); \
      _Pragma("unroll") for(int r=0;r<16;++r){P0[r]=fsub_s(P0[r],dl);P1[r]=fsub_s(P1[r],dl);} \
      _Pragma("unroll") for(int r=0;r<16;++r)negm[r]=-mhat; asm volatile("":"+v"(negm)); } \
    _Pragma("unroll") for(int r=0;r<16;++r)P0[r]=__builtin_amdgcn_exp2f(P0[r]); }while(0)
  #define RESC() do{ if(resc){ asm volatile("s_waitcnt lgkmcnt(0)":::"memory"); \
      _Pragma("unroll") for(int d_=0;d_<4;++d_) _Pragma("unroll") for(int r=0;r<16;++r)o[d_][r]*=wsf[crow(r,hi)]; } }while(0)
  f32x16 pA0,pA1,pB0,pB1;
  int sl_prev=s0,sl_cur=s0,sl_next=s1;
  #define ROT() do{sl_prev=sl_cur;sl_cur=sl_next;sl_next=(sl_next==(NSLOT-1)*SLOTB)?0:sl_next+SLOTB;}while(0)
  if(!pre){DMA_K(2,s2);}
  WAIT_BAR(4);
  qkt(pA0,pA1,Kbase+s0,qr,negm,r32,hi);asm volatile("s_nop 15\n\ts_nop 7":"+v"(pA0),"+v"(pA1));CMASK(pA0,pA1,0);
  START(pA0,pA1);
  _Pragma("unroll") for(int r=0;r<16;++r)pA1[r]=__builtin_amdgcn_exp2f(pA1[r]);
  WAIT_BAR(0);
  DMA_K(3,s0);DMA_V(1,s1);
  ROT();
  kload8(kf,kp0+sl_cur);
  WAIT_BAR(3);
  s16x4 vlo[8],vhi[8]; u32x4 pw0,pw1,pw2,pw3;
  #define PKW(P,B) cvtpk_s(P[B],P[B+1])
  #define PAF(k) __builtin_bit_cast(bf16x8,pw##k)
  #define VFR(i) (bf16x8){vlo[i][0],vlo[i][1],vlo[i][2],vlo[i][3],vhi[i][0],vhi[i][1],vhi[i][2],vhi[i][3]}
  #define PIN(x) asm volatile("":"+v"(x))
  #define MX3(a,b,c) __builtin_fmaxf(__builtin_fmaxf((a),(b)),(c))
  #define GAPA(MF,A0,A1,A2,A3,W0,W1,PW) do{ MF; sacc+=A0; sacc+=A1; sacc+=A2; sacc+=A3; PIN(sacc); W0; W1; PIN(PW); SBAR(); }while(0)
  #define EX(v) __builtin_amdgcn_exp2f(v)
  #define GAPB2(MF,X,B) do{ MF; X[B]=EX(X[B]); X[B+1]=EX(X[B+1]); PIN(X); SBAR(); }while(0)
  #define VRD2(i) do{ vlo[i]=vtr(vp_+((((i)>>2)+2)*4096+((i)&3)*1024)); vhi[i]=vtr(vp_+((((i)>>2)+2)*4096+((i)&3)*1024+512)); }while(0)
  #define VRD(i) do{ vlo[i]=vtr(vp_+(((i)>>2)*4096+((i)&3)*1024)); vhi[i]=vtr(vp_+(((i)>>2)*4096+((i)&3)*1024+512)); }while(0)
  #define KRD(G,j) do{ if(G){ kload2(kf,kp0+sl_next,j); SBAR(); } }while(0)
  #define STEP(C0,C1,P0,P1,t,GK,GV,GL) do{ SBAR(); \
    const lds_cptr vp_=vp0+2*sl_prev; \
    VRD(0); SBAR(); float sacc=(P0[0]+P0[1]); \
    GAPA(C0=__builtin_amdgcn_mfma_f32_32x32x16_bf16(kf[0],qr[0],negm,0,0,0), P0[2],P0[3],P0[4],P0[5],     pw0[0]=PKW(P0,0), pw0[1]=PKW(P0,2), pw0); \
    VRD(4); SBAR(); GAPA(C1=__builtin_amdgcn_mfma_f32_32x32x16_bf16(kf[1],qr[0],negm,0,0,0), P0[6],P0[7],P0[8],P0[9],     pw0[2]=PKW(P0,4), pw0[3]=PKW(P0,6), pw0); \
    VRD(1); SBAR(); GAPA(C0=__builtin_amdgcn_mfma_f32_32x32x16_bf16(kf[2],qr[1],C0,0,0,0),   P0[10],P0[11],P0[12],P0[13], pw1[0]=PKW(P0,8), pw1[1]=PKW(P0,10), pw1); \
    VRD(5); SBAR(); GAPA(C1=__builtin_amdgcn_mfma_f32_32x32x16_bf16(kf[3],qr[1],C1,0,0,0),   P0[14],P0[15],P1[0],P1[1],   pw1[2]=PKW(P0,12),pw1[3]=PKW(P0,14), pw1); \
    VRD(2); SBAR(); GAPA(C0=__builtin_amdgcn_mfma_f32_32x32x16_bf16(kf[4],qr[2],C0,0,0,0),   P1[2],P1[3],P1[4],P1[5],     pw2[0]=PKW(P1,0), pw2[1]=PKW(P1,2), pw2); \
    VRD(6); SBAR(); GAPA(C1=__builtin_amdgcn_mfma_f32_32x32x16_bf16(kf[5],qr[2],C1,0,0,0),   P1[6],P1[7],P1[8],P1[9],     pw2[2]=PKW(P1,4), pw2[3]=PKW(P1,6), pw2); \
    VRD(3); SBAR(); GAPA(C0=__builtin_amdgcn_mfma_f32_32x32x16_bf16(kf[6],qr[3],C0,0,0,0),   P1[10],P1[11],P1[12],P1[13], pw3[0]=PKW(P1,8), pw3[1]=PKW(P1,10), pw3); \
    VRD(7); SBAR(); GAPA(C1=__builtin_amdgcn_mfma_f32_32x32x16_bf16(kf[7],qr[3],C1,0,0,0),   P1[14],P1[15],0.f,0.f,       pw3[2]=PKW(P1,12),pw3[3]=PKW(P1,14), pw3); \
    l_reg+=sacc; \
    if(GK){DMA_K((t)+3,sl_cur);} if(GV){DMA_V((t)+1,sl_next);} \
    CMASK(C0,C1,t); \
    if constexpr (!STAT) { float a=MX3(C0[0],C0[1],C1[0]),b=MX3(C0[2],C0[3],C1[1]); a=MX3(a,C1[2],C1[3]); \
      _Pragma("unroll") for(int r=4;r<16;r+=4){a=MX3(a,C0[r],C0[r+1]);b=MX3(b,C0[r+2],C0[r+3]);a=MX3(a,C1[r],C1[r+1]);b=MX3(b,C1[r+2],C1[r+3]);} \
      float rm=__builtin_fmaxf(a,b); { auto rr=__builtin_amdgcn_permlane32_swap(__float_as_uint(rm),__float_as_uint(rm),false,false); rm=__builtin_fmaxf(__uint_as_float(rr[0]),__uint_as_float(rr[1])); } \
      resc=false; \
      if(__builtin_expect(__any(rm>(float)THRL),0)){ const float dl=__builtin_fmaxf(rm,0.f); mhat+=dl; \
        _Pragma("unroll") for(int r=0;r<16;++r){C0[r]-=dl;C1[r]-=dl;} \
        _Pragma("unroll") for(int r=0;r<16;++r)negm[r]=-mhat; asm volatile("":"+v"(negm)); \
        const float f=__builtin_amdgcn_exp2f(-dl); l_reg*=f; if(hi==0)wsf[r32]=f; resc=true; } } \
    SBAR(); \
    GAPB2(o[0]=__builtin_amdgcn_mfma_f32_32x32x16_bf16(PAF(0),VFR(0),o[0],0,0,0), C0,0);  VRD2(0); SBAR(); \
    GAPB2(o[1]=__builtin_amdgcn_mfma_f32_32x32x16_bf16(PAF(0),VFR(4),o[1],0,0,0), C0,2);  VRD2(4); SBAR(); \
    GAPB2(o[0]=__builtin_amdgcn_mfma_f32_32x32x16_bf16(PAF(1),VFR(1),o[0],0,0,0), C0,4);  VRD2(1); SBAR(); \
    GAPB2(o[1]=__builtin_amdgcn_mfma_f32_32x32x16_bf16(PAF(1),VFR(5),o[1],0,0,0), C0,6);  VRD2(5); SBAR(); \
    GAPB2(o[0]=__builtin_amdgcn_mfma_f32_32x32x16_bf16(PAF(2),VFR(2),o[0],0,0,0), C0,8);  VRD2(2); SBAR(); \
    GAPB2(o[1]=__builtin_amdgcn_mfma_f32_32x32x16_bf16(PAF(2),VFR(6),o[1],0,0,0), C0,10); VRD2(6); SBAR(); \
    GAPB2(o[0]=__builtin_amdgcn_mfma_f32_32x32x16_bf16(PAF(3),VFR(3),o[0],0,0,0), C0,12); VRD2(3); SBAR(); \
    GAPB2(o[1]=__builtin_amdgcn_mfma_f32_32x32x16_bf16(PAF(3),VFR(7),o[1],0,0,0), C0,14); VRD2(7); SBAR(); \
    GAPB2(o[2]=__builtin_amdgcn_mfma_f32_32x32x16_bf16(PAF(0),VFR(0),o[2],0,0,0), C1,0); \
    GAPB2(o[3]=__builtin_amdgcn_mfma_f32_32x32x16_bf16(PAF(0),VFR(4),o[3],0,0,0), C1,2); \
    KRD(GL,0); GAPB2(o[2]=__builtin_amdgcn_mfma_f32_32x32x16_bf16(PAF(1),VFR(1),o[2],0,0,0), C1,4); \
    KRD(GL,1); GAPB2(o[3]=__builtin_amdgcn_mfma_f32_32x32x16_bf16(PAF(1),VFR(5),o[3],0,0,0), C1,6); \
    KRD(GL,2); GAPB2(o[2]=__builtin_amdgcn_mfma_f32_32x32x16_bf16(PAF(2),VFR(2),o[2],0,0,0), C1,8); \
    KRD(GL,3); GAPB2(o[3]=__builtin_amdgcn_mfma_f32_32x32x16_bf16(PAF(2),VFR(6),o[3],0,0,0), C1,10); \
    GAPB2(o[2]=__builtin_amdgcn_mfma_f32_32x32x16_bf16(PAF(3),VFR(3),o[2],0,0,0), C1,12); \
    GAPB2(o[3]=__builtin_amdgcn_mfma_f32_32x32x16_bf16(PAF(3),VFR(7),o[3],0,0,0), C1,14); \
    }while(0)
  int t=1;
  #undef CMASK
  #define CMASK(P0,P1,t) do{}while(0)
  for(;t+5<NT;t+=2){
    STEP(pB0,pB1,pA0,pA1,t,true,true,true);     WAIT_BAR(3); RESC(); ROT();
    STEP(pA0,pA1,pB0,pB1,t+1,true,true,true);   WAIT_BAR(3); RESC(); ROT();
  }
  #undef CMASK
  #define CMASK(P0,P1,t) do{int jb_=(t)-(NT-4); if(jb_>=0)cmask(P0,P1,jb_,qrel,hi);}while(0)
  #define ENDW(tt) do{ if((tt)+3<NT){WAIT_BAR(3);} else if((tt)+2<NT){WAIT_BAR(2);} else {WAIT_BAR(0);} }while(0)
  for(;t+1<NT;t+=2){
    STEP(pB0,pB1,pA0,pA1,t,(t+3<NT),(t+1<NT),(t+1<NT));       ENDW(t);   RESC(); ROT();
    STEP(pA0,pA1,pB0,pB1,t+1,(t+4<NT),(t+2<NT),(t+2<NT));     ENDW(t+1); RESC(); ROT();
  }
  int snext=0;
  if(Knext!=nullptr){
    const int p0=sl_next,p1=NXT_(p0),p2=NXT_(p1); snext=p0;
    const bf16*kn=Knext+(long)lane*KP+wid*8; const bf16*vn=Vnext+(long)(16*(wid&3)+(lane>>2))*VP+(wid>>2)*32+(lane&3)*8;
    glds16(kn,(unsigned)__builtin_amdgcn_readfirstlane(kdst+p0));
    glds16(vn,(unsigned)__builtin_amdgcn_readfirstlane(vdst+2*p0)); glds16(vn+64,(unsigned)__builtin_amdgcn_readfirstlane(vdst+2*p0+8192));
    glds16(kn+(long)KVBLK*KP,(unsigned)__builtin_amdgcn_readfirstlane(kdst+p1)); glds16(kn+(long)2*KVBLK*KP,(unsigned)__builtin_amdgcn_readfirstlane(kdst+p2)); }
  STEP(pB0,pB1,pA0,pA1,NT-1,false,false,false); RESC();
  { float sacc=pB0[0]+pB0[1]; _Pragma("unroll") for(int r=2;r<16;++r)sacc+=pB0[r]; _Pragma("unroll") for(int r=0;r<16;++r)sacc+=pB1[r]; l_reg+=sacc;
    pw0=(u32x4){PKW(pB0,0),PKW(pB0,2),PKW(pB0,4),PKW(pB0,6)};pw1=(u32x4){PKW(pB0,8),PKW(pB0,10),PKW(pB0,12),PKW(pB0,14)};pw2=(u32x4){PKW(pB1,0),PKW(pB1,2),PKW(pB1,4),PKW(pB1,6)};pw3=(u32x4){PKW(pB1,8),PKW(pB1,10),PKW(pB1,12),PKW(pB1,14)};
    SBAR(); pv(o,vb0+2*sl_cur,PAF(0),PAF(1),PAF(2),PAF(3)); }
  #undef PKW
  #undef PAF
  #undef VFR
  #undef PIN
  #undef MX3
  #undef GAPA
  #undef GAPB2
  #undef VRD2
  #undef EX
  #undef VRD
  #undef KRD
  #undef STEP
  #undef ENDW
  {auto rr=__builtin_amdgcn_permlane32_swap(__float_as_uint(l_reg),__float_as_uint(l_reg),false,false);l_reg=__uint_as_float(rr[0])+__uint_as_float(rr[1]);}
  if(hi==0)wsf[32+r32]=l_reg;asm volatile("s_waitcnt lgkmcnt(0)":::"memory");
  float rli[16];
  #pragma unroll
  for(int r=0;r<16;++r)rli[r]=__builtin_amdgcn_rcpf(wsf[32+crow(r,hi)]);
  bf16*Ow=O+(long)(q0+wid*QBLK)*OP;
  bf16*stg=(bf16*)(shm+LDS_OST)+wid*2048;
  if(O1==nullptr){
    #pragma unroll
    for(int hf=0;hf<2;++hf){
      #pragma unroll
      for(int r=0;r<16;++r){const int orow=crow(r,hi);
        #pragma unroll
        for(int d0=0;d0<2;++d0)stg[orow*64+d0*32+r32]=__float2bfloat16(o[2*hf+d0][r]*rli[r]);}
      asm volatile("s_waitcnt lgkmcnt(0)":::"memory");
      #pragma unroll
      for(int i=0;i<4;++i){const int row=i*8+(lane>>3),ch=lane&7; const u32x4 v=*(const u32x4*)(stg+row*64+ch*8); ATTN_STORE16(Ow+(long)row*OP+hf*64+ch*8,v);}
      asm volatile("s_waitcnt lgkmcnt(0)":::"memory"); }
  } else {
    const bf16*O1w=O1+(long)(q0+wid*QBLK)*OP; unsigned long long p1[2][4][2];
    #pragma unroll
    for(int hf=0;hf<2;++hf)
      #pragma unroll
      for(int i=0;i<4;++i){const int row=i*8+(lane>>3),ch=lane&7; unsigned long long*a=(unsigned long long*)(O1w+(long)row*OP+hf*64+ch*8);
        p1[hf][i][0]=__hip_atomic_load(a,__ATOMIC_RELAXED,__HIP_MEMORY_SCOPE_AGENT); p1[hf][i][1]=__hip_atomic_load(a+1,__ATOMIC_RELAXED,__HIP_MEMORY_SCOPE_AGENT);}
    float dd[2][4][8]; float ssp[4]={0.f,0.f,0.f,0.f};
    #pragma unroll
    for(int hf=0;hf<2;++hf){
      #pragma unroll
      for(int r=0;r<16;++r){const int orow=crow(r,hi);
        #pragma unroll
        for(int d0=0;d0<2;++d0)stg[orow*64+d0*32+r32]=__float2bfloat16(o[2*hf+d0][r]*rli[r]);}
      asm volatile("s_waitcnt lgkmcnt(0)":::"memory");
      #pragma unroll
      for(int i=0;i<4;++i){const int row=i*8+(lane>>3),ch=lane&7; const u32x4 v=*(const u32x4*)(stg+row*64+ch*8);
        const unsigned w1[4]={(unsigned)p1[hf][i][0],(unsigned)(p1[hf][i][0]>>32),(unsigned)p1[hf][i][1],(unsigned)(p1[hf][i][1]>>32)};
        #pragma unroll
        for(int j=0;j<4;++j){ const float a0=__uint_as_float(w1[j]<<16)-lam*__uint_as_float(v[j]<<16), a1=__uint_as_float(w1[j]&0xffff0000u)-lam*__uint_as_float(v[j]&0xffff0000u);
          dd[hf][i][2*j]=a0; dd[hf][i][2*j+1]=a1; ssp[i]+=a0*a0+a1*a1; } }
      asm volatile("s_waitcnt lgkmcnt(0)":::"memory"); }
    #pragma unroll
    for(int i=0;i<4;++i){ float ss=ssp[i];
      ss+=__int_as_float(__builtin_amdgcn_update_dpp(0,__float_as_int(ss),0xB1,0xf,0xf,true)); ss+=__int_as_float(__builtin_amdgcn_update_dpp(0,__float_as_int(ss),0x4E,0xf,0xf,true)); ss+=__int_as_float(__builtin_amdgcn_update_dpp(0,__float_as_int(ss),0x141,0xf,0xf,true));
      const float rn=1.0f/sqrtf(ss*(1.0f/128.0f)+1e-6f)*0.8f;
      const int row=i*8+(lane>>3),ch=lane&7;
      #pragma unroll
      for(int hf=0;hf<2;++hf){ const float*gp=subg+hf*64+ch*8; u32x4 w;
        w[0]=cvtpk_s(dd[hf][i][0]*rn*gp[0],dd[hf][i][1]*rn*gp[1]); w[1]=cvtpk_s(dd[hf][i][2]*rn*gp[2],dd[hf][i][3]*rn*gp[3]);
        w[2]=cvtpk_s(dd[hf][i][4]*rn*gp[4],dd[hf][i][5]*rn*gp[5]); w[3]=cvtpk_s(dd[hf][i][6]*rn*gp[6],dd[hf][i][7]*rn*gp[7]);
        *(u32x4*)(CAo+(long)(q0+wid*QBLK+row)*1024+hf*64+ch*8)=w; } }
  }
  asm volatile("s_waitcnt lgkmcnt(0)\n\ts_barrier":::"memory");
  #undef DMA_K
  #undef DMA_V
  #undef CMASK
  #undef START
  #undef RESC
  #undef ROT
  #undef NXT_
  return snext;
}
constexpr int ATTN_LDS_BYTES=LDS_BYTES;
#undef SBAR
#undef WAIT_BAR
}

constexpr int NWAVES = 8, NTHREADS = NWAVES * 64;
#ifndef MK_PER_PHASE
#define MK_PER_PHASE 0
#endif
#ifndef RUN_PHASES
#define RUN_PHASES 8
#endif
constexpr int N_PHASES = RUN_PHASES;

constexpr size_t MiB = 1u << 20;
constexpr size_t WS_CTL = 0, CTL_ZERO_BYTES = 65536;
constexpr size_t WS_RS = 1 * MiB;
constexpr size_t WS_TINFO = 2 * MiB;
constexpr size_t WS_WR = 3 * MiB;
constexpr size_t WS_LTOK = 4 * MiB, WS_LW = 8 * MiB;
constexpr size_t WS_WIN = 16 * MiB, WS_WCA = 25 * MiB, WS_WOUT = 27 * MiB;
constexpr size_t WS_A = 32 * MiB;
constexpr size_t WS_QB = 112 * MiB, WS_KB = 144 * MiB, WS_VB = 176 * MiB, WS_YG = 208 * MiB;
constexpr size_t WS_MG = 112 * MiB, WS_XM = 176 * MiB;
constexpr size_t WS_GT = 240 * MiB;
constexpr size_t WS_WGU = 240 * MiB, WS_WD = 304 * MiB;
constexpr size_t WS_CA = 368 * MiB;
constexpr size_t WS_YB = 112 * MiB;
constexpr size_t WS_LIST = 432 * MiB;
constexpr size_t WS_CTOK = 448 * MiB;
constexpr size_t WS_XB = 432 * MiB;
constexpr size_t WS_R = 1 * MiB;
constexpr size_t WS_END = 496 * MiB;
static_assert(WS_A + (size_t)CROWS * 1024 <= WS_QB && WS_WD + (size_t)NEXP * 1024 * 512 <= WS_CA, "d_ws map");
static_assert(WS_WIN + (size_t)IN_COLS * 1024 * 2 <= WS_WCA, "d_ws map");

constexpr int RING_BYTES = 131072;
constexpr int META_OFF = RING_BYTES;
constexpr int HIST_OFF = RING_BYTES + 1024;
constexpr int BARST_OFF = RING_BYTES + 3072;
constexpr int META2_OFF = RING_BYTES + 4096;
constexpr int LDS_BYTES = 147456;

#define GAS __attribute__((address_space(1)))
#define LAS __attribute__((address_space(3)))
typedef unsigned short bf16;
typedef unsigned v4u __attribute__((ext_vector_type(4)));
typedef unsigned v2u __attribute__((ext_vector_type(2)));
typedef float f32x4 __attribute__((ext_vector_type(4)));
typedef float f32x16 __attribute__((ext_vector_type(16)));
typedef short bf16x8 __attribute__((ext_vector_type(8)));
using pg8::cvt_pk_bf16; using pg8::bf_lo; using pg8::bf_hi; using pg8::sigmoidf_fast; using pg8::pack8; using pg8::unpack8;

__device__ __forceinline__ float wave_sum(float v) {
    v += __int_as_float(__builtin_amdgcn_update_dpp(0, __float_as_int(v), 0xB1, 0xf, 0xf, true));
    v += __int_as_float(__builtin_amdgcn_update_dpp(0, __float_as_int(v), 0x4E, 0xf, 0xf, true));
    v += __int_as_float(__builtin_amdgcn_update_dpp(0, __float_as_int(v), 0x141, 0xf, 0xf, true));
    v += __int_as_float(__builtin_amdgcn_update_dpp(0, __float_as_int(v), 0x140, 0xf, 0xf, true));
    const int iv = __float_as_int(v);
    return (__int_as_float(__builtin_amdgcn_readlane(iv, 0)) + __int_as_float(__builtin_amdgcn_readlane(iv, 16))) + (__int_as_float(__builtin_amdgcn_readlane(iv, 32)) + __int_as_float(__builtin_amdgcn_readlane(iv, 48)));
}
__device__ __forceinline__ float wave_max(float v) {
    v = fmaxf(v, __int_as_float(__builtin_amdgcn_update_dpp(0, __float_as_int(v), 0xB1, 0xf, 0xf, true)));
    v = fmaxf(v, __int_as_float(__builtin_amdgcn_update_dpp(0, __float_as_int(v), 0x4E, 0xf, 0xf, true)));
    v = fmaxf(v, __int_as_float(__builtin_amdgcn_update_dpp(0, __float_as_int(v), 0x141, 0xf, 0xf, true)));
    v = fmaxf(v, __int_as_float(__builtin_amdgcn_update_dpp(0, __float_as_int(v), 0x140, 0xf, 0xf, true)));
    const int iv = __float_as_int(v);
    return fmaxf(fmaxf(__int_as_float(__builtin_amdgcn_readlane(iv, 0)), __int_as_float(__builtin_amdgcn_readlane(iv, 16))), fmaxf(__int_as_float(__builtin_amdgcn_readlane(iv, 32)), __int_as_float(__builtin_amdgcn_readlane(iv, 48))));
}
__device__ __forceinline__ float bf16_round(float x) { return bf_lo(cvt_pk_bf16(x, 0.f) & 0xffffu); }

#define XB_TMO      128
#define XB_XCNT(j)  (256  + 64 * (j))
#define XB_XSUB(j)  (1280 + 64 * (j))
#define XB_XGEN(j)  (2304 + 64 * (j))
#define XB_TOP      3328
#define XB_TOPGEN   3392
#define XCD_BAR_WORDS 3456
#define XB_SPIN_CAP (1u << 18)

__device__ __forceinline__ unsigned xb_ld(unsigned* p)              { return __hip_atomic_load(p, __ATOMIC_RELAXED, __HIP_MEMORY_SCOPE_AGENT); }
__device__ __forceinline__ unsigned xb_add(unsigned* p, unsigned v) { return __hip_atomic_fetch_add(p, v, __ATOMIC_RELAXED, __HIP_MEMORY_SCOPE_AGENT); }
__device__ __forceinline__ unsigned xb_xcc_id() { return (unsigned)__builtin_amdgcn_s_getreg((3 << 11) | 20) & 0xFu; }
#define XB_SPIN(cond, bar) do { unsigned _sp = 0; while (cond) { __builtin_amdgcn_s_sleep(1); \
    if ((++_sp & 255u) == 0u) { if (xb_ld(&(bar)[XB_TMO])) break; if (_sp > XB_SPIN_CAP) { atomicAdd(&(bar)[XB_TMO], 1u); break; } } } } while (0)

struct XcdBarrier {
    unsigned* bar; unsigned x;
    volatile LAS unsigned* st;
};

__device__ __forceinline__ XcdBarrier xcd_barrier_post(unsigned* bar, volatile LAS unsigned* st) {
    XcdBarrier b; b.bar = bar; b.x = xb_xcc_id(); b.st = st;
    if (threadIdx.x == 0) (void)xb_add(&bar[XB_XCNT(b.x)], 1u);
    return b;
}
__device__ __forceinline__ void xcd_barrier_complete(unsigned* bar, unsigned x, unsigned& nloc, unsigned& nx) {
    const unsigned G = gridDim.x * gridDim.y * gridDim.z;
    unsigned sum, cnt, mine, sp = 0u;
    for (;;) {
        sum = 0u; cnt = 0u; mine = 0u;
#pragma unroll
        for (unsigned j = 0; j < 16; ++j) { const unsigned c = xb_ld(&bar[XB_XCNT(j)]); sum += c; cnt += (c > 0u) ? 1u : 0u; mine = (j == x) ? c : mine; }
        if (sum == G) break;
        __builtin_amdgcn_s_sleep(1);
        if ((++sp & 255u) == 0u) { if (xb_ld(&bar[XB_TMO])) break; if (sp > XB_SPIN_CAP) { atomicAdd(&bar[XB_TMO], 1u); break; } }
    }
    nloc = mine > 0u ? mine : 1u; nx = cnt > 0u ? cnt : 1u;
}

__device__ __forceinline__ void xcd_barrier(const XcdBarrier& b) {
    asm volatile("s_waitcnt vmcnt(0)" ::: "memory");
    __syncthreads();
    if (threadIdx.x == 0) {
        unsigned* bar = b.bar;
        __builtin_amdgcn_s_waitcnt(0);
        unsigned nloc = b.st[0], nx = b.st[1];
        if (nloc == 0u) { xcd_barrier_complete(bar, b.x, nloc, nx); b.st[0] = nloc; b.st[1] = nx; }
        const unsigned old = xb_add(&bar[XB_XSUB(b.x)], 1u);
        const unsigned gen = old / nloc;
        if (old + 1u == (gen + 1u) * nloc) {
            __builtin_amdgcn_fence(__ATOMIC_RELEASE, "agent");
            asm volatile("s_waitcnt vmcnt(0)" ::: "memory");
            const unsigned og = xb_add(&bar[XB_TOP], 1u);
            const unsigned tg = og / nx;
            if (og + 1u == (tg + 1u) * nx) xb_add(&bar[XB_TOPGEN], 1u);
            else XB_SPIN(xb_ld(&bar[XB_TOPGEN]) == tg, bar);
            __builtin_amdgcn_fence(__ATOMIC_ACQUIRE, "agent");
            xb_add(&bar[XB_XGEN(b.x)], 1u);
            asm volatile("s_waitcnt vmcnt(0)" ::: "memory");
        } else {
            XB_SPIN(xb_ld(&bar[XB_XGEN(b.x)]) == gen, bar);
            __builtin_amdgcn_fence(__ATOMIC_ACQUIRE, "agent");
            asm volatile("s_waitcnt vmcnt(0)" ::: "memory");
        }
    }
    __syncthreads();
}


typedef f32x4 AccT[2][2][4][2];
struct EpiInProj {
    static constexpr bool MID = false, PREMID = true;
    struct Pre { float r[2][4]; };
    __device__ __forceinline__ Pre pre(const pg8::Unit& u, int wr, int fr) const { Pre p;
#pragma unroll
        for (int ai = 0; ai < 2; ++ai)
#pragma unroll
            for (int m = 0; m < 4; ++m) p.r[ai][m] = R[u.orow + ai * 128 + wr * 64 + m * 16 + fr];
        return p; }
    bf16 *YG, *QB, *KB, *VB, *GT; const LAS float* gl; const float* R;
    __device__ __forceinline__ void mid(AccT&, const pg8::Unit&, int, int, int, int) const {}
    __device__ __forceinline__ void operator()(AccT& acc, const pg8::Unit& u, int wr, int wc, int fr, int fq, const Pre& pre_) const {
        asm volatile("" : "+v"(fr), "+v"(fq));
        const int pn = u.pn; const size_t row0 = (size_t)u.orow + wr * 64 + fr;
        if (pn < 4) {
#pragma unroll
            for (int ai = 0; ai < 2; ++ai)
#pragma unroll
                for (int m = 0; m < 4; ++m) { const size_t row = row0 + ai * 128 + m * 16; f32x4 y[2]; const float rr = pre_.r[ai][m];
#pragma unroll
                    for (int n = 0; n < 2; ++n) { const f32x4 a = acc[ai][0][m][n] * rr, g = acc[ai][1][m][n] * rr;
                        y[n] = (f32x4){a[0] * sigmoidf_fast(g[0]), a[1] * sigmoidf_fast(g[1]), a[2] * sigmoidf_fast(g[2]), a[3] * sigmoidf_fast(g[3])}; }
                    __builtin_nontemporal_store(pack8(y[0], y[1]), (v4u*)(YG + row * 512 + pn * 128 + wc * 32 + 8 * fq)); }
        } else if (pn < 8) {
            const bool isq = pn < 6; bf16* base = isq ? QB : KB; const LAS float* gp = gl + (isq ? 0 : 64); const float sc = isq ? 0.125f * 1.4426950408889634f : 1.0f;
            f32x4 gv[2][2];
#pragma unroll
            for (int bj = 0; bj < 2; ++bj)
#pragma unroll
                for (int n = 0; n < 2; ++n) gv[bj][n] = *(const LAS f32x4*)(gp + 32 * bj + 8 * fq + 4 * n) * sc;
#pragma unroll
            for (int ai = 0; ai < 2; ++ai)
#pragma unroll
                for (int m = 0; m < 4; ++m) { const size_t row = row0 + ai * 128 + m * 16; float ss = 0.f; const float rr = pre_.r[ai][m];
#pragma unroll
                    for (int bj = 0; bj < 2; ++bj)
#pragma unroll
                        for (int n = 0; n < 2; ++n) { const f32x4 a = acc[ai][bj][m][n]; ss += (a[0] * a[0] + a[1] * a[1]) + (a[2] * a[2] + a[3] * a[3]); }
                    ss += __shfl_xor(ss, 16); ss += __shfl_xor(ss, 32);
                    const float rinv = rr / sqrtf(ss * rr * rr * (1.0f / 64.0f) + EPS);
#pragma unroll
                    for (int bj = 0; bj < 2; ++bj)
                        __builtin_nontemporal_store(pack8(acc[ai][bj][m][0] * rinv * gv[bj][0], acc[ai][bj][m][1] * rinv * gv[bj][1]), (v4u*)(base + row * 512 + (pn & 1) * 256 + wc * 64 + bj * 32 + 8 * fq)); }
        } else if (pn < 10) {
#pragma unroll
            for (int ai = 0; ai < 2; ++ai)
#pragma unroll
                for (int m = 0; m < 4; ++m) { const size_t row = row0 + ai * 128 + m * 16; const float rr = pre_.r[ai][m];
#pragma unroll
                    for (int bj = 0; bj < 2; ++bj) __builtin_nontemporal_store(pack8(acc[ai][bj][m][0] * rr, acc[ai][bj][m][1] * rr), (v4u*)(VB + row * 512 + (pn - 8) * 256 + bj * 128 + wc * 32 + 8 * fq)); }
        } else {
#pragma unroll
            for (int ai = 0; ai < 2; ++ai)
#pragma unroll
                for (int m = 0; m < 4; ++m) { const size_t row = row0 + ai * 128 + m * 16; f32x4 rr[2], gg[2]; const float rz = -1.4426950408889634f * pre_.r[ai][m];
#pragma unroll
                    for (int n = 0; n < 2; ++n)
#pragma unroll
                        for (int j = 0; j < 4; ++j) { const float e0 = __builtin_amdgcn_exp2f(rz * acc[ai][0][m][n][j]), e1 = fminf(__builtin_amdgcn_exp2f(rz * acc[ai][1][m][n][j]), 1e30f);
                            gg[n][j] = __builtin_amdgcn_rcpf(1.0f + e1); rr[n][j] = (1.0f + e1) * __builtin_amdgcn_rcpf(1.0f + e0); }
                    const size_t o = row * 1024 + (pn - 10) * 128 + wc * 32 + 8 * fq;
                    __builtin_nontemporal_store(pack8(rr[0], rr[1]), (v4u*)(GT + o)); __builtin_nontemporal_store(pack8(gg[0], gg[1]), (v4u*)(GT + (size_t)NTOK * 1024 + o)); }
        }
    }
};
struct EpiMerged {
    static constexpr bool MID = true, PREMID = false;
    struct Pre {}; __device__ __forceinline__ Pre pre(const pg8::Unit&, int, int) const { return Pre{}; }
    const bf16* GR; const bf16* G1; bf16* MG;
    __device__ __forceinline__ void mid(AccT& acc, const pg8::Unit& u, int wr, int wc, int fr, int fq) const {
        asm volatile("" : "+v"(fr), "+v"(fq));
        const size_t row0 = (size_t)u.orow + wr * 64 + fr; const int col0 = u.pn * 256 + wc * 32 + 8 * fq;
        v4u w0[2][4][2];
#pragma unroll
        for (int ai = 0; ai < 2; ++ai)
#pragma unroll
            for (int m = 0; m < 4; ++m)
#pragma unroll
                for (int bj = 0; bj < 2; ++bj) w0[ai][m][bj] = *(const v4u*)(GR + (row0 + ai * 128 + m * 16) * 1024 + col0 + bj * 128);
        __builtin_amdgcn_sched_barrier(0);
#pragma unroll
        for (int ai = 0; ai < 2; ++ai)
#pragma unroll
            for (int m = 0; m < 4; ++m)
#pragma unroll
                for (int bj = 0; bj < 2; ++bj) { f32x4 a0, a1; unpack8(w0[ai][m][bj], a0, a1); acc[ai][bj][m][0] = acc[ai][bj][m][0] * a0; acc[ai][bj][m][1] = acc[ai][bj][m][1] * a1; }
        __builtin_amdgcn_sched_barrier(0);
    }
    __device__ __forceinline__ void operator()(AccT& acc, const pg8::Unit& u, int wr, int wc, int fr, int fq, const Pre& pre_) const {
        asm volatile("" : "+v"(fr), "+v"(fq));
        const size_t row0 = (size_t)u.orow + wr * 64 + fr; const int col0 = u.pn * 256 + wc * 32 + 8 * fq;
        v4u w1[2][4][2];
#pragma unroll
        for (int ai = 0; ai < 2; ++ai)
#pragma unroll
            for (int m = 0; m < 4; ++m)
#pragma unroll
                for (int bj = 0; bj < 2; ++bj) w1[ai][m][bj] = *(const v4u*)(G1 + (row0 + ai * 128 + m * 16) * 1024 + col0 + bj * 128);
        __builtin_amdgcn_sched_barrier(0);
#pragma unroll
        for (int ai = 0; ai < 2; ++ai)
#pragma unroll
            for (int m = 0; m < 4; ++m) { const size_t row = row0 + ai * 128 + m * 16;
#pragma unroll
                for (int bj = 0; bj < 2; ++bj) { f32x4 b0, b1; unpack8(w1[ai][m][bj], b0, b1);
                    *(v4u*)(MG + row * 1024 + col0 + bj * 128) = pack8(acc[ai][bj][m][0] * b0, acc[ai][bj][m][1] * b1); } }
    }
};
struct EpiOut {
    static constexpr bool MID = false, PREMID = false;
    struct Pre {}; __device__ __forceinline__ Pre pre(const pg8::Unit&, int, int) const { return Pre{}; }
    const bf16* XB; bf16* XMB; unsigned char* XM8;
    __device__ __forceinline__ void mid(AccT&, const pg8::Unit&, int, int, int, int) const {}
    __device__ __forceinline__ void operator()(AccT& acc, const pg8::Unit& u, int wr, int wc, int fr, int fq, const Pre& pre_) const {
        asm volatile("" : "+v"(fr), "+v"(fq));
        const size_t row0 = (size_t)u.orow + wr * 64 + fr; const int col0 = u.pn * 256 + wc * 32 + 8 * fq;
        v4u xw[2][4][2];
#pragma unroll
        for (int ai = 0; ai < 2; ++ai)
#pragma unroll
            for (int m = 0; m < 4; ++m)
#pragma unroll
                for (int bj = 0; bj < 2; ++bj) xw[ai][m][bj] = __builtin_nontemporal_load((const v4u*)(XB + (row0 + ai * 128 + m * 16) * 1024 + col0 + bj * 128));
        __builtin_amdgcn_sched_barrier(0);
#pragma unroll
        for (int ai = 0; ai < 2; ++ai)
#pragma unroll
            for (int m = 0; m < 4; ++m) { const size_t off = (row0 + ai * 128 + m * 16) * 1024 + col0;
#pragma unroll
                for (int bj = 0; bj < 2; ++bj) { f32x4 x0, x1; unpack8(xw[ai][m][bj], x0, x1); const f32x4 o0 = x0 + acc[ai][bj][m][0], o1 = x1 + acc[ai][bj][m][1];
                    *(v4u*)(XMB + off + bj * 128) = pack8(o0, o1);
                    v2u w8; w8.x = pg8::pack4_fp8(o0[0], o0[1], o0[2], o0[3]); w8.y = pg8::pack4_fp8(o1[0], o1[1], o1[2], o1[3]); *(v2u*)(XM8 + off + bj * 128) = w8; } }
        __builtin_amdgcn_sched_barrier(0);
    }
};
struct EpiGateUp {
    static constexpr bool MID = false, PREMID = false;
    typedef int i32x4 __attribute__((ext_vector_type(4)));
    struct Pre { int dst[2][4]; float w[2][4], rs[2][4]; };
    __device__ __forceinline__ Pre pre(const pg8::Unit& u, int wr, int fr) const { Pre p;
#pragma unroll
        for (int ai = 0; ai < 2; ++ai)
#pragma unroll
            for (int m = 0; m < 4; ++m) { const int r = ai * 128 + wr * 64 + m * 16 + fr; const i32x4 en = (r < u.nvalid) ? *(const i32x4*)(LIST + (size_t)(u.lrow + r) * 4) : (i32x4){-1, -1, 0, 0};
                p.dst[ai][m] = en[1]; p.w[ai][m] = __int_as_float(en[2]); p.rs[ai][m] = __int_as_float(en[3]); }
        return p; }
    const int* LIST; unsigned char* HP8; const LAS int* m2;
    __device__ __forceinline__ void mid(AccT&, const pg8::Unit&, int, int, int, int) const {}
    __device__ __forceinline__ void operator()(AccT& acc, const pg8::Unit& u, int wr, int wc, int fr, int fq, const Pre& pre_) const {
        asm volatile("" : "+v"(fr), "+v"(fq));
#pragma unroll
        for (int ai = 0; ai < 2; ++ai)
#pragma unroll
            for (int m = 0; m < 4; ++m) { const int dst = pre_.dst[ai][m]; if (dst < 0) continue;
                const float rs = pre_.rs[ai][m] * (1.0f / 64.0f), w8 = pre_.w[ai][m] * 8.0f;
                const size_t drow = (size_t)m2[dst >> 17] * 256 + ((dst >> 1) & 0xffff);
                float h[8];
#pragma unroll
                for (int n = 0; n < 2; ++n)
#pragma unroll
                    for (int j = 0; j < 4; ++j) { const float g = acc[ai][0][m][n][j] * rs, up = acc[ai][1][m][n][j] * rs; h[4 * n + j] = __builtin_amdgcn_fmed3f(g * sigmoidf_fast(g) * up * w8, -448.f, 448.f); }
                v2u o8; o8.x = pg8::pack4_fp8(h[0], h[1], h[2], h[3]); o8.y = pg8::pack4_fp8(h[4], h[5], h[6], h[7]);
                *(v2u*)(HP8 + drow * 1024 + (dst & 1) * 512 + u.pn * 128 + wc * 32 + 8 * fq) = o8; }
    }
};
struct EpiDownAdd {
    static constexpr bool MID = false, PREMID = true;
    struct Pre { int tok[2][4]; };
    __device__ __forceinline__ Pre pre(const pg8::Unit& u, int wr, int fr) const { Pre p;
#pragma unroll
        for (int ai = 0; ai < 2; ++ai)
#pragma unroll
            for (int m = 0; m < 4; ++m) { const int r = ai * 128 + wr * 64 + m * 16 + fr; p.tok[ai][m] = (r < u.nvalid) ? CTOK[u.lrow + r] : -1; }
        return p; }
    const int* CTOK; const bf16* XMB; float* out;
    __device__ __forceinline__ void mid(AccT&, const pg8::Unit&, int, int, int, int) const {}
    __device__ __forceinline__ void operator()(AccT& acc, const pg8::Unit& u, int wr, int wc, int fr, int fq, const Pre& pre_) const {
        asm volatile("" : "+v"(fr), "+v"(fq));
        const int col0 = u.pn * 256 + wc * 32 + 8 * fq;
        v4u xw[2][4][2];
#pragma unroll
        for (int ai = 0; ai < 2; ++ai)
#pragma unroll
            for (int m = 0; m < 4; ++m) { const int tk = pre_.tok[ai][m]; const size_t off = (size_t)(tk < 0 ? 0 : tk) * 1024 + col0;
#pragma unroll
                for (int bj = 0; bj < 2; ++bj) xw[ai][m][bj] = *(const v4u*)(XMB + off + bj * 128); }
        __builtin_amdgcn_sched_barrier(0);
#pragma unroll
        for (int ai = 0; ai < 2; ++ai)
#pragma unroll
            for (int m = 0; m < 4; ++m) { const int tk = pre_.tok[ai][m]; if (tk < 0) continue; const size_t off = (size_t)tk * 1024 + col0;
#pragma unroll
                for (int bj = 0; bj < 2; ++bj) { f32x4 x0, x1; unpack8(xw[ai][m][bj], x0, x1);
                    __builtin_nontemporal_store(x0 + acc[ai][bj][m][0] * (1.0f / 256.0f), (f32x4*)(out + off + bj * 128)); __builtin_nontemporal_store(x1 + acc[ai][bj][m][1] * (1.0f / 256.0f), (f32x4*)(out + off + bj * 128 + 4)); } }
    }
};
struct MoeOrder {
    int G, c, total; const LAS int* meta;
    __device__ __forceinline__ bool next(int i, pg8::Unit& u) const {
        int cc = c; if (G == 256 && (i + 1) * G > total * 4) cc = ((c & 31) >> 2) * 32 + (c >> 5) * 4 + (c & 3);
        const int L = i * G + cc; if (L >= total * 4) return false;
        const int blk = L >> 2; const int lane = tid_opaque() & 63;
        const int e = __builtin_amdgcn_readfirstlane(__builtin_popcountll(__ballot(lane < NEXP - 1 && meta[1 + lane] <= blk)));
        const int pre = __builtin_amdgcn_readfirstlane(meta[e]), cnt = __builtin_amdgcn_readfirstlane(meta[64 + e]); const int rb = blk - pre;
        u.pn = L & 3; u.pm = rb; u.e = e; u.e2 = e; u.lrow = e * LCAP + rb * 256; u.nvalid = min(256, cnt - rb * 256); u.orow = blk * 256; u.arow = 0; return true;
    }
};
struct ClassOrder {
    int G, c, total; const LAS int* m2;
    __device__ __forceinline__ bool next(int i, pg8::Unit& u) const {
        int cc = c; if (G == 256 && (i + 1) * G > total * 4) cc = ((c & 31) >> 2) * 32 + (c >> 5) * 4 + (c & 3);
        const int L = i * G + cc; if (L >= total * 4) return false;
        const int blk = L >> 2; const int lane = tid_opaque() & 63;
        const int n0 = __builtin_popcountll(__ballot(m2[1 + lane] <= blk)), n1 = __builtin_popcountll(__ballot(lane + 65 <= NCLS - 1 && m2[65 + lane] <= blk));
        const int cls = __builtin_amdgcn_readfirstlane(n0 + n1);
        const int pre = __builtin_amdgcn_readfirstlane(m2[cls]), cnt = __builtin_amdgcn_readfirstlane(m2[128 + cls]); const int rb = blk - pre;
        const int g = cls / 28; int p = cls % 28, a = 0;
        while (p >= 7 - a) { p -= 7 - a; ++a; }
        u.e = g * 8 + a; u.e2 = g * 8 + a + 1 + p; u.pn = L & 3; u.pm = rb; u.lrow = cls * NTOK + rb * 256; u.nvalid = min(256, cnt - rb * 256); u.orow = blk * 256; u.arow = u.orow; return true;
    }
};
__device__ __forceinline__ void moe_meta(LAS int* meta, LAS int* m2, const unsigned* ctl) {
    const int tid = tid_opaque();
    if (tid < NEXP) meta[64 + tid] = (int)__hip_atomic_load(ctl + tid, __ATOMIC_RELAXED, __HIP_MEMORY_SCOPE_AGENT);
    if (tid >= 64 && tid < 64 + NCLS) m2[128 + tid - 64] = (int)__hip_atomic_load(ctl + tid, __ATOMIC_RELAXED, __HIP_MEMORY_SCOPE_AGENT);
    __syncthreads();
    if (tid == 0) { int p = 0;
        for (int e = 0; e < NEXP; ++e) { meta[e] = p; p += (meta[64 + e] + 255) >> 8; }
        meta[NEXP] = p; }
    if (tid == 64) { int p = 0;
        for (int c = 0; c < NCLS; ++c) { m2[c] = p; p += (m2[128 + c] + 255) >> 8; }
        m2[NCLS] = p; }
    __syncthreads();
}

__device__ __forceinline__ void transpose_item(const float* W, int N, int k0, int n0, bf16* WT, int dpitch, int drow0, int dcol0, const float* kscale, LAS float* scr, int lane) {
    const int kr = lane >> 3, nc = (lane & 7) * 4;
    f32x4 v[8];
#pragma unroll
    for (int i = 0; i < 8; ++i) v[i] = *(const f32x4*)(W + (size_t)(k0 + i * 8 + kr) * N + n0 + nc);
    if (kscale) {
#pragma unroll
        for (int i = 0; i < 8; ++i) v[i] = v[i] * kscale[k0 + i * 8 + kr]; }
#pragma unroll
    for (int i = 0; i < 8; ++i) { LAS float* d = scr + (i * 8 + kr) * 33 + nc; d[0] = v[i][0]; d[1] = v[i][1]; d[2] = v[i][2]; d[3] = v[i][3]; }
    asm volatile("s_waitcnt lgkmcnt(0)" ::: "memory");
    const int c = lane & 7;
#pragma unroll
    for (int j = 0; j < 4; ++j) { const int n = (lane >> 3) + 8 * j; const LAS float* s = scr + (8 * c) * 33 + n;
        v4u o; o.x = cvt_pk_bf16(s[0 * 33], s[1 * 33]); o.y = cvt_pk_bf16(s[2 * 33], s[3 * 33]); o.z = cvt_pk_bf16(s[4 * 33], s[5 * 33]); o.w = cvt_pk_bf16(s[6 * 33], s[7 * 33]);
        *(v4u*)(WT + (size_t)(drow0 + n) * dpitch + dcol0 + k0 + 8 * c) = o; }
    asm volatile("s_waitcnt lgkmcnt(0)" ::: "memory");
}
__device__ __forceinline__ void t8_load(f32x4 (&v)[8], const float* W, int N, int k0, int n0, int lane) {
    const int kr = lane >> 3, nc = (lane & 7) * 4;
#pragma unroll
    for (int i = 0; i < 8; ++i) v[i] = __builtin_nontemporal_load((const f32x4*)(W + (size_t)(k0 + i * 8 + kr) * N + n0 + nc));
}
__device__ __forceinline__ void t8_finish(f32x4 (&v)[8], int k0, unsigned char* WT, int dpitch, int drow0, const float* kscale, float mul, LAS float* scr, int lane) {
    const int kr = lane >> 3, nc = (lane & 7) * 4;
#pragma unroll
    for (int i = 0; i < 8; ++i) v[i] = v[i] * (kscale ? kscale[k0 + i * 8 + kr] * mul : mul);
#pragma unroll
    for (int i = 0; i < 8; ++i) { LAS float* d = scr + (i * 8 + kr) * 33 + nc; d[0] = v[i][0]; d[1] = v[i][1]; d[2] = v[i][2]; d[3] = v[i][3]; }
    asm volatile("s_waitcnt lgkmcnt(0)" ::: "memory");
    const int c = lane & 7;
#pragma unroll
    for (int j = 0; j < 4; ++j) { const int n = (lane >> 3) + 8 * j; const LAS float* s = scr + (8 * c) * 33 + n;
        v2u o; o.x = pg8::pack4_fp8(s[0 * 33], s[1 * 33], s[2 * 33], s[3 * 33]); o.y = pg8::pack4_fp8(s[4 * 33], s[5 * 33], s[6 * 33], s[7 * 33]);
        *(v2u*)(WT + (size_t)(drow0 + n) * dpitch + k0 + 8 * c) = o; }
    asm volatile("s_waitcnt lgkmcnt(0)" ::: "memory");
}
__device__ __forceinline__ void transpose_item_fp8(const float* W, int N, int k0, int n0, unsigned char* WT, int dpitch, int drow0, const float* kscale, float mul, LAS float* scr, int lane) {
    f32x4 v[8]; t8_load(v, W, N, k0, n0, lane); t8_finish(v, k0, WT, dpitch, drow0, kscale, mul, scr, lane);
}
__device__ __forceinline__ int inproj_phys(int c) {
    if (c < 512) return (c >> 7) * 256 + (c & 127);
    if (c < 1024) { c -= 512; return (c >> 7) * 256 + 128 + (c & 127); }
    if (c < 2048) { const int sec = (c - 1024) >> 8, cl = (c - 1024) & 255, s = cl >> 6, d = cl & 63; return 1024 + sec * 256 + ((d >> 5) << 7) + (s << 5) + (d & 31); }
    if (c < 2560) return c;
    { int j = c - 2560; const int hi = j >= 1024; j &= 1023; return 2560 + (j >> 7) * 256 + hi * 128 + (j & 127); }
}
struct Ptrs {
    const float *x, *attn_norm_g, *w_in, *conv_dw_w, *conv_dw_b, *conv_ln_g, *conv_ln_b, *w_conv_out, *q_norm_g, *k_norm_g, *lq1, *lk1, *lq2, *lk2, *subln_g,
        *w_attn_out, *w_out, *ffn_norm_g, *w_rg, *b_rg, *w_re, *b_re, *w_gate, *w_up, *w_down;
    float* out; unsigned char* ws;
};

__device__ __forceinline__ void p0_prologue(const Ptrs& P, LAS unsigned char* lds, int vcu, int G) {
    const int tid = tid_opaque(), lane = tid & 63, wave = __builtin_amdgcn_readfirstlane(tid >> 6);
    LAS float* scr = (LAS float*)(lds + wave * 16384);
    const int gw = vcu * NWAVES + wave, NGW = G * NWAVES;
    bf16* WIN = (bf16*)(P.ws + WS_WIN); bf16* WCA = (bf16*)(P.ws + WS_WCA); bf16* WOUT = (bf16*)(P.ws + WS_WOUT);
    constexpr int I_IN = (DMODEL / 64) * (IN_COLS / 32), I_C = (CONV_CH / 64) * (DMODEL / 32), I_O = (DMODEL / 64) * (DMODEL / 32);
    for (int it = gw; it < I_IN + 2 * I_C + I_O; it += NGW) {
        int r = it;
        if (r < I_IN) { const int kb = r / (IN_COLS / 32), nb = r % (IN_COLS / 32); transpose_item(P.w_in, IN_COLS, kb * 64, nb * 32, WIN, 1024, inproj_phys(nb * 32), 0, P.attn_norm_g, scr, lane); continue; } r -= I_IN;
        if (r < I_C) { const int kb = r / 32, nb = r % 32; transpose_item(P.w_conv_out, DMODEL, kb * 64, nb * 32, WCA, 1024, nb * 32, 0, nullptr, scr, lane); continue; } r -= I_C;
        if (r < I_C) { const int kb = r / 32, nb = r % 32; transpose_item(P.w_attn_out, DMODEL, kb * 64, nb * 32, WCA, 1024, nb * 32, 512, nullptr, scr, lane); continue; } r -= I_C;
        { const int kb = r / 32, nb = r % 32; transpose_item(P.w_out, DMODEL, kb * 64, nb * 32, WOUT, 1024, nb * 32, 0, nullptr, scr, lane); }
    }
    bf16* WRhi = (bf16*)(P.ws + WS_WR); bf16* WRlo = WRhi + 64 * 1024;
    for (int idx = vcu * NTHREADS + tid; idx < 64 * 1024; idx += G * NTHREADS) {
        const int n = idx >> 10, k = idx & 1023; float v = 0.f;
        if (n < 4) v = P.w_rg[k * 4 + n]; else if (n < 36) v = P.w_re[k * 32 + (n - 4)];
        v *= P.ffn_norm_g[k];
        const unsigned hb = cvt_pk_bf16(v, 0.f) & 0xffffu; const float hf = __uint_as_float(hb << 16);
        const int pos = (((k >> 4) * 4 + (n >> 5)) * 64 + ((k >> 3) & 1) * 32 + (n & 31)) * 8 + (k & 7);
        WRhi[pos] = (bf16)hb; WRhi[pos + 2 * 64 * 8] = (bf16)(cvt_pk_bf16(v - hf, 0.f) & 0xffffu);
    }
    bf16* HB = (bf16*)(P.ws + WS_XB); float* RR = (float*)(P.ws + WS_R);
    constexpr int RPT = 4;
    for (int m = gw; m < NTOK; m += RPT * NGW) {
        f32x4 v[RPT][4];
#pragma unroll
        for (int q = 0; q < RPT; ++q) { const int mq = m + q * NGW; const f32x4* xr = (const f32x4*)(P.x + (size_t)(mq < NTOK ? mq : m) * DMODEL) + lane;
#pragma unroll
            for (int j = 0; j < 4; ++j) v[q][j] = __builtin_nontemporal_load(xr + 64 * j); }
#pragma unroll
        for (int q = 0; q < RPT; ++q) { const int mq = m + q * NGW; float ss = 0.f;
#pragma unroll
            for (int j = 0; j < 4; ++j) ss += (v[q][j][0] * v[q][j][0] + v[q][j][1] * v[q][j][1]) + (v[q][j][2] * v[q][j][2] + v[q][j][3] * v[q][j][3]);
            const float r = 1.0f / sqrtf(wave_sum(ss) * (1.0f / DMODEL) + EPS);
            if (mq < NTOK) { v2u* o8 = (v2u*)(HB + (size_t)mq * DMODEL) + lane; if (lane == 0) RR[mq] = r;
#pragma unroll
                for (int j = 0; j < 4; ++j) { const f32x4 y = v[q][j]; v2u w; w.x = cvt_pk_bf16(y[0], y[1]); w.y = cvt_pk_bf16(y[2], y[3]); o8[64 * j] = w; } } }
    }
}

__device__ __forceinline__ void conv_phase(const Ptrs& P, LAS unsigned char* lds, int first, int stride) {
    const int tid = tid_opaque(), lane = tid & 63, wave = __builtin_amdgcn_readfirstlane(tid >> 6);
    const bf16* YG = (const bf16*)(P.ws + WS_YG); bf16* CA = (bf16*)(P.ws + WS_CA);
    LAS bf16* yt = (LAS bf16*)lds; LAS float* co = (LAS float*)(lds + 62 * 1024);
    constexpr int NT = NTOK / 32;
    if (first >= NT) return;
    float w[CONV_W];
#pragma unroll
    for (int j = 0; j < CONV_W; ++j) w[j] = P.conv_dw_w[j * CONV_CH + tid];
    const float bias = P.conv_dw_b[tid];
    const f32x4 g0 = ((const f32x4*)P.conv_ln_g)[lane], g1 = ((const f32x4*)P.conv_ln_g)[64 + lane], b0 = ((const f32x4*)P.conv_ln_b)[lane], b1 = ((const f32x4*)P.conv_ln_b)[64 + lane];
    v4u pre[8];
#define CONV_FETCH(tile) do { const int b_ = (tile) / (SEQ / 32), t0_ = ((tile) % (SEQ / 32)) * 32; _Pragma("unroll") for (int p = 0; p < 8; ++p) { const int q = tid + NTHREADS * p; const int row = q >> 6, ch = q & 63, t = t0_ - 30 + row; \
        pre[p] = (v4u){0u, 0u, 0u, 0u}; if (q < 62 * 64 && t >= 0) pre[p] = *(const v4u*)(YG + ((size_t)(b_ * SEQ + t)) * 512 + ch * 8); } } while (0)
    CONV_FETCH(first);
    for (int tile = first; tile < NT; tile += stride) {
        const int b = tile / (SEQ / 32), t0 = (tile % (SEQ / 32)) * 32;
#pragma unroll
        for (int p = 0; p < 8; ++p) { const int q = tid + NTHREADS * p; if (q < 62 * 64) *(LAS v4u*)(yt + (q >> 6) * 512 + (q & 63) * 8) = pre[p]; }
        __syncthreads();
        if (tile + stride < NT) CONV_FETCH(tile + stride);
        float yv[62];
#pragma unroll
        for (int i = 0; i < 62; ++i) yv[i] = __uint_as_float((unsigned)yt[i * 512 + tid] << 16);
#pragma unroll
        for (int t = 0; t < 32; ++t) { float a = bias;
#pragma unroll
            for (int j = 0; j < CONV_W; ++j) a += w[j] * yv[t + j];
            co[t * 512 + tid] = a; }
        __syncthreads();
#pragma unroll
        for (int rr = 0; rr < 4; ++rr) { const int row = wave * 4 + rr;
            const f32x4 v0 = *(const LAS f32x4*)(co + row * 512 + lane * 4), v1 = *(const LAS f32x4*)(co + row * 512 + 256 + lane * 4);
            const float mean = wave_sum((v0[0] + v0[1]) + (v0[2] + v0[3]) + (v1[0] + v1[1]) + (v1[2] + v1[3])) * (1.0f / CONV_CH);
            const f32x4 d0 = v0 - mean, d1 = v1 - mean;
            const float var = wave_sum((d0[0] * d0[0] + d0[1] * d0[1]) + (d0[2] * d0[2] + d0[3] * d0[3]) + (d1[0] * d1[0] + d1[1] * d1[1]) + (d1[2] * d1[2] + d1[3] * d1[3])) * (1.0f / CONV_CH);
            const float rstd = 1.0f / sqrtf(var + EPS);
            f32x4 y0 = d0 * rstd * g0 + b0, y1 = d1 * rstd * g1 + b1;
#pragma unroll
            for (int j = 0; j < 4; ++j) { y0[j] = y0[j] * sigmoidf_fast(y0[j]); y1[j] = y1[j] * sigmoidf_fast(y1[j]); }
            bf16* orow = CA + ((size_t)(b * SEQ + t0 + row)) * 1024;
            v2u o0, o1; o0.x = cvt_pk_bf16(y0[0], y0[1]); o0.y = cvt_pk_bf16(y0[2], y0[3]); o1.x = cvt_pk_bf16(y1[0], y1[1]); o1.y = cvt_pk_bf16(y1[2], y1[3]);
            *(v2u*)(orow + lane * 4) = o0; *(v2u*)(orow + 256 + lane * 4) = o1; }
        __syncthreads();
    }
#undef CONV_FETCH
}

__device__ __forceinline__ void attn_pair(const Ptrs& P, LAS unsigned char* lds, char* lds_generic, int p) {
    const int tid = tid_opaque(), lane = tid & 63, wave = __builtin_amdgcn_readfirstlane(tid >> 6);
    const int bh = p >> 3, s = p & 7, b = bh >> 2, h = bh & 3;
    const __hip_bfloat16* QB = (const __hip_bfloat16*)(P.ws + WS_QB); const __hip_bfloat16* KB = (const __hip_bfloat16*)(P.ws + WS_KB); const __hip_bfloat16* VB = (const __hip_bfloat16*)(P.ws + WS_VB);
    __hip_bfloat16* OT = (__hip_bfloat16*)(P.ws + WS_A); bf16* CA = (bf16*)(P.ws + WS_CA);
    float mstat;
    { int l0 = lane; asm volatile("" : "+v"(l0));
      const float a = wave_max(fabsf(P.q_norm_g[l0])), b = wave_max(fabsf(P.k_norm_g[l0]));
      mstat = __int_as_float(__builtin_amdgcn_readfirstlane(__float_as_int(0.125f * 1.4426950408889634f * 64.0f * 1.02f * a * b))); }
    float lam;
    { int l1 = lane; asm volatile("" : "+v"(l1));
      lam = __int_as_float(__builtin_amdgcn_readfirstlane(__float_as_int(__expf(wave_sum(P.lq1[l1] * P.lk1[l1])) - __expf(wave_sum(P.lq2[l1] * P.lk2[l1])) + 0.2f))); }
    int s0 = 0; bool pre = false;
#pragma unroll 1
    for (int u4 = 0; u4 < 4; ++u4) { const int i = u4 >> 1, c = u4 & 1;
        const int qb = (i == 0) ? s : 15 - s;
        const __hip_bfloat16* q_ = QB + (size_t)b * SEQ * 512 + (h * 2 + c) * 64; const __hip_bfloat16* k_ = KB + (size_t)b * SEQ * 512 + (h * 2 + c) * 64; const __hip_bfloat16* v_ = VB + (size_t)b * SEQ * 512 + h * 128;
        const __hip_bfloat16* kn_ = (u4 < 3) ? KB + (size_t)b * SEQ * 512 + (h * 2 + (c ^ 1)) * 64 : nullptr;
        __hip_bfloat16* o_ = OT + (size_t)b * SEQ * 1024 + (h * 2) * 128;
        const __hip_bfloat16* o1_ = c ? o_ : nullptr; unsigned short* ca_ = CA + (size_t)b * SEQ * 1024 + 512 + h * 128;
        int sn;
        if (mstat <= 40.0f) sn = attn_body::attn_unit<8, true>(mstat, qb * 256, q_, k_, v_, o_, lds_generic, o1_, lam, P.subln_g, ca_, kn_, v_, s0, pre);
        else sn = attn_body::attn_unit<8, false>(0.f, qb * 256, q_, k_, v_, o_, lds_generic, o1_, lam, P.subln_g, ca_, kn_, v_, s0, pre);
        s0 = sn; pre = (kn_ != nullptr); }
}

__device__ __forceinline__ void router_tile(const Ptrs& P, LAS unsigned char* lds, int tile) {
    const int tid = tid_opaque(), lane = tid & 63, wave = __builtin_amdgcn_readfirstlane(tid >> 6), r32 = lane & 31, hi = lane >> 5;
    const bf16* WRhi = (const bf16*)(P.ws + WS_WR); const bf16* WRlo = WRhi + 64 * 1024;
    int* LIST = (int*)(P.ws + WS_LIST); int* CTOK = (int*)(P.ws + WS_CTOK); unsigned* cnt = (unsigned*)(P.ws + WS_CTL); unsigned* ccnt = cnt + 64;
    LAS float* lg = (LAS float*)(lds + wave * 16384);
    LAS int* hist = (LAS int*)(lds + HIST_OFF); LAS int* hbase = hist + 32; LAS int* hist2 = hist + 64; LAS int* hbase2 = hist2 + NCLS;
    if (tid < 32) hist[tid] = 0;
    if (tid >= 64 && tid < 64 + NCLS) hist2[tid - 64] = 0;
    __syncthreads();
    const int tbase = tile * 256 + wave * 32;
    LAS unsigned char* ring = lds + wave * 16384;
    const bf16* xg = (const bf16*)(P.ws + WS_CA) + (size_t)(tbase + (lane >> 3)) * DMODEL + (((lane & 7) ^ ((lane >> 3) & 7)) * 8);
    const bf16* wf0 = WRhi + lane * 8;
    f32x16 acc0 = {}, acc1 = {}; float ssq = 0.f;
#define RT_XDMA(c) do { _Pragma("unroll") for (int i_ = 0; i_ < 4; ++i_) \
        __builtin_amdgcn_global_load_lds((const unsigned*)(xg + (size_t)i_ * 8 * DMODEL + (c) * 64), (LAS unsigned*)(ring + ((c) & 3) * 4096 + i_ * 1024), 16, 0, 0); } while (0)
#define RT_WLOAD(dst, c) do { _Pragma("unroll") for (int q_ = 0; q_ < 4; ++q_) _Pragma("unroll") for (int f_ = 0; f_ < 4; ++f_) dst[q_][f_] = *(const bf16x8*)(wf0 + ((((c) * 4 + q_) * 4 + f_) * 64) * 8); } while (0)
    bf16x8 wA[4][4], wB[4][4];
    RT_XDMA(0); RT_XDMA(1); RT_XDMA(2); RT_WLOAD(wA, 0);
    const LAS unsigned char* xrd = ring + r32 * 128;
#define RT_CHUNK(c, wc, wn) do { \
        if ((c) + 1 < 16) RT_WLOAD(wn, (c) + 1); \
        if ((c) + 3 < 16) RT_XDMA((c) + 3); \
        if ((c) + 3 < 16) asm volatile("s_waitcnt vmcnt(24)" ::: "memory"); else if ((c) + 1 < 16) asm volatile("s_waitcnt vmcnt(16)" ::: "memory"); else asm volatile("s_waitcnt vmcnt(0)" ::: "memory"); \
        _Pragma("unroll") for (int q_ = 0; q_ < 4; ++q_) { \
            const v4u xa = *(const LAS v4u*)(xrd + ((c) & 3) * 4096 + (((2 * q_ + hi) ^ (r32 & 7)) * 16)); \
            f32x4 x0, x1; unpack8(xa, x0, x1); \
            ssq += (x0[0] * x0[0] + x0[1] * x0[1]) + (x0[2] * x0[2] + x0[3] * x0[3]) + (x1[0] * x1[0] + x1[1] * x1[1]) + (x1[2] * x1[2] + x1[3] * x1[3]); \
            const bf16x8 a_hi = __builtin_bit_cast(bf16x8, xa); \
            acc0 = __builtin_amdgcn_mfma_f32_32x32x16_bf16(a_hi, wc[q_][0], acc0, 0, 0, 0); acc1 = __builtin_amdgcn_mfma_f32_32x32x16_bf16(a_hi, wc[q_][1], acc1, 0, 0, 0); \
            acc0 = __builtin_amdgcn_mfma_f32_32x32x16_bf16(a_hi, wc[q_][2], acc0, 0, 0, 0); acc1 = __builtin_amdgcn_mfma_f32_32x32x16_bf16(a_hi, wc[q_][3], acc1, 0, 0, 0); } \
        asm volatile("s_waitcnt lgkmcnt(0)" ::: "memory"); } while (0)
#pragma unroll
    for (int c = 0; c < 16; c += 2) { RT_CHUNK(c, wA, wB); RT_CHUNK(c + 1, wB, wA); }
#undef RT_XDMA
#undef RT_WLOAD
#undef RT_CHUNK
    ssq += __shfl_xor(ssq, 32);
    const float rs = 1.0f / sqrtf(ssq * (1.0f / DMODEL) + EPS);
#pragma unroll
    for (int r = 0; r < 16; ++r) { const int m = (r & 3) + 8 * (r >> 2) + 4 * hi; lg[m * 66 + r32] = acc0[r]; lg[m * 66 + 32 + r32] = acc1[r]; }
    asm volatile("s_waitcnt lgkmcnt(0)" ::: "memory");
    int ea = 0, eb = 0, cls = 0, lpa = 0, lpb = 0, lpc = 0; float wa = 0.f, wb = 0.f;
    if (lane < 32) {
        const LAS float* L = lg + lane * 66;
        float gl[4];
#pragma unroll
        for (int j = 0; j < 4; ++j) gl[j] = L[j] * rs + P.b_rg[j];
        int gs = 0; float gm = gl[0];
#pragma unroll
        for (int j = 1; j < 4; ++j) if (gl[j] > gm) { gm = gl[j]; gs = j; }
        float gsum = 0.f;
#pragma unroll
        for (int j = 0; j < 4; ++j) gsum += __expf(gl[j] - gm);
        const float gw = 1.0f / gsum;
        float l0 = -INFINITY, l1 = -INFINITY; int i0 = 0, i1 = 0;
#pragma unroll
        for (int j = 0; j < 8; ++j) { const float v = L[4 + gs * 8 + j] * rs + P.b_re[gs * 8 + j];
            if (v > l0) { l1 = l0; i1 = i0; l0 = v; i0 = j; } else if (v > l1) { l1 = v; i1 = j; } }
        const float q = __expf(l1 - l0), inv = 1.0f / (1.0f + q);
        const float w0 = inv * gw, w1 = q * inv * gw;
        const int a = min(i0, i1), b = max(i0, i1);
        wa = (i0 < i1) ? w0 : w1; wb = (i0 < i1) ? w1 : w0;
        ea = gs * 8 + a; eb = gs * 8 + b; cls = gs * 28 + (a * (15 - a)) / 2 + (b - a - 1);
        lpa = __hip_atomic_fetch_add(&hist[ea], 1, __ATOMIC_RELAXED, __HIP_MEMORY_SCOPE_WORKGROUP); lpb = __hip_atomic_fetch_add(&hist[eb], 1, __ATOMIC_RELAXED, __HIP_MEMORY_SCOPE_WORKGROUP);
        lpc = __hip_atomic_fetch_add(&hist2[cls], 1, __ATOMIC_RELAXED, __HIP_MEMORY_SCOPE_WORKGROUP);
    }
    __syncthreads();
    if (tid < 32) hbase[tid] = (int)atomicAdd(cnt + tid, (unsigned)hist[tid]);
    if (tid >= 64 && tid < 64 + NCLS) { const int c = tid - 64; const int n = hist2[c]; hbase2[c] = n ? (int)atomicAdd(ccnt + c, (unsigned)n) : 0; }
    __syncthreads();
    if (lane < 32) { const int t = tbase + lane; const int pa = hbase[ea] + lpa, pb = hbase[eb] + lpb, pc = hbase2[cls] + lpc;
        typedef int i32x4 __attribute__((ext_vector_type(4)));
        const int dst = (cls << 17) | (pc << 1);
        *(i32x4*)(LIST + (size_t)(ea * LCAP + pa) * 4) = (i32x4){t, dst, __float_as_int(wa), __float_as_int(rs)};
        *(i32x4*)(LIST + (size_t)(eb * LCAP + pb) * 4) = (i32x4){t, dst | 1, __float_as_int(wb), __float_as_int(rs)};
        CTOK[(size_t)cls * NTOK + pc] = t; }
    __syncthreads();
}

template <bool DOWN> __device__ __forceinline__ void p5_convert(const Ptrs& P, LAS unsigned char* lds, int vcu, int G, int rank = 0, int count = 1) {
    const int tid = tid_opaque(), lane = tid & 63, wave = __builtin_amdgcn_readfirstlane(tid >> 6);
    LAS float* scr = (LAS float*)(lds + wave * 16384);
    const int gw = vcu * NWAVES + wave, NGW = G * NWAVES;
    unsigned char* WGU = P.ws + WS_WGU; unsigned char* WD = P.ws + WS_WD;
    constexpr int I_G = (DMODEL / 64) * (DEXP / 32);
    constexpr int I_D = (DEXP / 64) * (DMODEL / 32);
    constexpr int PER_E = DOWN ? I_D : 2 * I_G;
    constexpr int NITEMS = NEXP * PER_E, NRW = (NTOK / 256) * NWAVES;
    constexpr int SA = P5_SPLIT_A, SB = 16 - SA;
    const bool split = !DOWN && (G == 256) && (NITEMS == NRW * SA + (256 * NWAVES - NRW) * SB);
    const bool rwg = (int)blockIdx.x < NTOK / 256; const int wv = ((int)blockIdx.x - (rwg ? 0 : NTOK / 256)) * NWAVES + wave;
    const int it0 = DOWN ? rank * NWAVES + wave : split ? (rwg ? wv : NRW * SA + wv) : gw, itn = split ? (rwg ? NRW * SA : NITEMS) : NITEMS, its = DOWN ? count * NWAVES : split ? NRW : NGW;
    struct Item { const float* W; int N, k0, n0; unsigned char* WT; int dpitch, drow0; const float* ks; float mul; };
    auto decode = [&](int it) { Item q; const int e = it / PER_E; int r = it % PER_E;
        if (!DOWN) { const int up = r / I_G; r %= I_G; const int kb = r / (DEXP / 32), nb = r % (DEXP / 32), n0 = nb * 32;
            q.W = (up ? P.w_up : P.w_gate) + (size_t)e * DMODEL * DEXP; q.N = DEXP; q.k0 = kb * 64; q.n0 = n0; q.WT = WGU + (size_t)e * 1024 * 1024; q.dpitch = 1024; q.drow0 = (n0 >> 7) * 256 + up * 128 + (n0 & 127); q.ks = P.ffn_norm_g; q.mul = 64.f;
        } else { const int kb = r / (DMODEL / 32), nb = r % (DMODEL / 32);
            q.W = P.w_down + (size_t)e * DEXP * DMODEL; q.N = DMODEL; q.k0 = kb * 64; q.n0 = nb * 32; q.WT = WD + (size_t)e * 1024 * 512; q.dpitch = 512; q.drow0 = nb * 32; q.ks = nullptr; q.mul = 32.f; }
        return q; };
    for (int it = it0; it < itn; it += 4 * its) {
        const bool h1 = it + its < itn, h2 = it + 2 * its < itn, h3 = it + 3 * its < itn;
        const Item a = decode(it), b = decode(h1 ? it + its : it), c = decode(h2 ? it + 2 * its : it), d = decode(h3 ? it + 3 * its : it);
        f32x4 va[8], vb[8], vc[8], vd[8];
        t8_load(va, a.W, a.N, a.k0, a.n0, lane); t8_load(vb, b.W, b.N, b.k0, b.n0, lane); t8_load(vc, c.W, c.N, c.k0, c.n0, lane); t8_load(vd, d.W, d.N, d.k0, d.n0, lane);
        t8_finish(va, a.k0, a.WT, a.dpitch, a.drow0, a.ks, a.mul, scr, lane);
        if (h1) t8_finish(vb, b.k0, b.WT, b.dpitch, b.drow0, b.ks, b.mul, scr, lane);
        if (h2) t8_finish(vc, c.k0, c.WT, c.dpitch, c.drow0, c.ks, c.mul, scr, lane);
        if (h3) t8_finish(vd, d.k0, d.WT, d.dpitch, d.drow0, d.ks, d.mul, scr, lane);
    }
}

struct Args { Ptrs p; int ph_lo, ph_hi, use_cg, pad; };
__global__ void __launch_bounds__(NTHREADS, 2) mega_fwd(Args args) {
    extern __shared__ __attribute__((aligned(16))) unsigned char lds_raw[];
    LAS unsigned char* lds = (LAS unsigned char*)lds_raw;
    const Ptrs& P = args.p;
    const int tid = tid_opaque();
    const int G = gridDim.x, bx = blockIdx.x; const int vcu = (G % 8 == 0) ? (bx % 8) * (G / 8) + bx / 8 : bx;
    const int lo = args.ph_lo, hi = args.ph_hi;
    LAS int* meta = (LAS int*)(lds + META_OFF);
    if (tid < 2) ((volatile LAS unsigned*)(lds + BARST_OFF))[tid] = 0u;
    __syncthreads();
    XcdBarrier bar = xcd_barrier_post((unsigned*)(P.ws + WS_CTL) + 1024, (volatile LAS unsigned*)(lds + BARST_OFF));
#ifndef PHASE_MASK
#define PHASE_MASK 0xff
#endif
#ifndef DUP_PHASE
#define DUP_PHASE -1
#endif
#define REPS(k) for (int rep_ = 0; rep_ < ((DUP_PHASE == (k)) ? 2 : 1); ++rep_)
#define REPBAR() do { if (rep_) xcd_barrier(bar); } while (0)
#define IN(k) (((PHASE_MASK >> (k)) & 1) && lo <= (k) && (k) < hi)
#define SEAM(k) do { if (IN(k) && IN((k) + 1)) xcd_barrier(bar); } while (0)
    bf16* WS16 = (bf16*)P.ws;
    if (IN(0)) REPS(0) { REPBAR(); p0_prologue(P, lds, vcu, G); }
    SEAM(0);
    if (IN(1)) REPS(1) { REPBAR();
        pg8::Gemm g{(const bf16*)(P.ws + WS_XB), (const bf16*)(P.ws + WS_WIN), DMODEL, 0, nullptr};
        pg8::StaticOrder S; S.init(NTOK, IN_COLS, G, bx);
        LAS float* gl = (LAS float*)(lds + RING_BYTES + 8192);
        if (tid < 128) gl[tid] = (tid < 64) ? P.q_norm_g[tid] : P.k_norm_g[tid - 64];
        __syncthreads();
        EpiInProj E{(bf16*)(P.ws + WS_YG), (bf16*)(P.ws + WS_QB), (bf16*)(P.ws + WS_KB), (bf16*)(P.ws + WS_VB), (bf16*)(P.ws + WS_GT), gl, (const float*)(P.ws + WS_R)};
#if defined(DUMP_SEL) && DUMP_SEL == 5
        EpiRaw ER{(bf16*)(P.ws + WS_QB)};
        pg8::gemm_phase<EpiRaw, pg8::StaticOrder, false, true>(lds, g, S, ER);
#else
        pg8::gemm_phase<EpiInProj, pg8::StaticOrder, false, true>(lds, g, S, E);
#endif
    }
    SEAM(1);
    if (IN(2)) {
        REPS(2) { REPBAR();
        for (int p = vcu; p < 256; p += G) attn_pair(P, lds, (char*)lds_raw, p);
        __syncthreads(); }
        REPS(20) { REPBAR();
        conv_phase(P, lds, bx, G); }
    }
    SEAM(2);
    if (IN(3)) REPS(3) { REPBAR();
        pg8::Gemm g{(const bf16*)(P.ws + WS_CA), (const bf16*)(P.ws + WS_WCA), DMODEL, 0, nullptr};
        pg8::StaticOrder S; S.init(NTOK, DMODEL, G, bx);
        EpiMerged E{(const bf16*)(P.ws + WS_GT), (const bf16*)(P.ws + WS_GT) + (size_t)NTOK * 1024, (bf16*)(P.ws + WS_MG)};
#ifdef SKEW3
        if ((bx >> 3) & 1) { const unsigned long long t0 = __builtin_amdgcn_s_memrealtime(); while ((long long)(__builtin_amdgcn_s_memrealtime() - t0) < SKEW3) __builtin_amdgcn_s_sleep(8); }
#endif
        pg8::gemm_phase<EpiMerged, pg8::StaticOrder, false, true>(lds, g, S, E);
    }
    SEAM(3);
    if (IN(4)) REPS(4) { REPBAR();
        pg8::Gemm g{(const bf16*)(P.ws + WS_MG), (const bf16*)(P.ws + WS_WOUT), DMODEL, 0, nullptr};
        pg8::StaticOrder S; S.init(NTOK, DMODEL, G, bx);
        EpiOut E{(const bf16*)(P.ws + WS_XB), (bf16*)(P.ws + WS_CA), P.ws + WS_XM};
        pg8::gemm_phase<EpiOut, pg8::StaticOrder, false, true>(lds, g, S, E);
    }
    SEAM(4);
    if (IN(5)) {
        for (int t = bx; t < NTOK / 256; t += G) router_tile(P, lds, t);
        REPS(5) { REPBAR(); p5_convert<false>(P, lds, vcu, G); }
    }
    SEAM(5);
    LAS int* meta2 = (LAS int*)(lds + META2_OFF);
    if (IN(6)) REPS(6) { REPBAR();
        moe_meta(meta, meta2, (const unsigned*)(P.ws + WS_CTL));
        pg8::Gemm g{(const bf16*)(P.ws + WS_XM), (const bf16*)(P.ws + WS_WGU), DMODEL / 2, (size_t)1024 * 1024, (const int*)(P.ws + WS_LIST), 4};
        MoeOrder S{G, vcu, __builtin_amdgcn_readfirstlane(meta[NEXP]), meta};
        EpiGateUp E{(const int*)(P.ws + WS_LIST), P.ws + WS_A, meta2};
        pg8::gemm_phase<EpiGateUp, MoeOrder, true, true, true>(lds, g, S, E);
        { const int total4 = S.total * 4; int rank = vcu, count = G;
          bool conv = true;
          if (G == 256) { const int rounds = total4 / G, R = total4 - rounds * G; const int cc = ((vcu & 31) >> 2) * 32 + (vcu >> 5) * 4 + (vcu & 3);
              if (R > 0 && R < G) { conv = cc >= R; rank = cc - R; count = G - R; } else { rank = cc; } }
          if (conv) { asm volatile("s_waitcnt vmcnt(0)" ::: "memory"); __syncthreads();
              p5_convert<true>(P, lds, vcu, G, rank, count); } }
    }
    SEAM(6);
    if (IN(7)) REPS(7) { REPBAR();
        moe_meta(meta, meta2, (const unsigned*)(P.ws + WS_CTL));
        pg8::Gemm g{(const bf16*)(P.ws + WS_A), (const bf16*)(P.ws + WS_WD), DMODEL / 2, (size_t)1024 * 512, nullptr, 0, DEXP / 2};
        ClassOrder S{G, vcu, __builtin_amdgcn_readfirstlane(meta2[NCLS]), meta2};
        EpiDownAdd E{(const int*)(P.ws + WS_CTOK), (const bf16*)(P.ws + WS_CA), P.out};
        pg8::gemm_phase<EpiDownAdd, ClassOrder, false, true, true, true>(lds, g, S, E);
    }
#if defined(DUMP_SEL)
    xcd_barrier(bar);
    { const bf16* YG = (const bf16*)(P.ws + WS_YG); const bf16* QB = (const bf16*)(P.ws + WS_QB); const bf16* KB = (const bf16*)(P.ws + WS_KB); const bf16* VB = (const bf16*)(P.ws + WS_VB);
      const bf16* GT = (const bf16*)(P.ws + WS_GT); const bf16* CA = (const bf16*)(P.ws + WS_CA); const bf16* MG = (const bf16*)(P.ws + WS_MG);
      for (size_t i = (size_t)bx * NTHREADS + tid; i < (size_t)NTOK * 1024; i += (size_t)G * NTHREADS) { const size_t t = i >> 10; const int c = (int)(i & 1023); float v = 0.f;
#if DUMP_SEL == 1
          v = bf_lo(YG[t * 512 + (c & 511)]) + bf_lo(QB[t * 512 + (c & 511)]) + 2.f * bf_lo(KB[t * 512 + (c & 511)]) + 3.f * bf_lo(VB[t * 512 + (c & 511)]) + bf_lo(GT[t * 2048 + c]) + bf_lo(GT[t * 2048 + 1024 + c]);
#elif DUMP_SEL == 2
          v = bf_lo(CA[t * 1024 + c]);
#elif DUMP_SEL == 4
          { const bf16* HB = (const bf16*)(P.ws + WS_A); const bf16* WIN = (const bf16*)(P.ws + WS_WIN); v = bf_lo(HB[i]) + 30.f * bf_lo(WIN[i % ((size_t)IN_COLS * 1024)]); }
#elif DUMP_SEL == 5
          { const bf16* R = (const bf16*)(P.ws + WS_QB); v = bf_lo(R[t * 4608 + c]) + bf_lo(R[t * 4608 + 1024 + c]) + bf_lo(R[t * 4608 + 2048 + c]) + bf_lo(R[t * 4608 + 3072 + c]) + bf_lo(R[t * 4608 + 4096 + (c & 511)]); }
#elif DUMP_SEL == 3
          v = bf_lo(MG[t * 1024 + c]);
#endif
          P.out[i] = v; } }
#endif
    (void)WS16;
#undef IN
#undef SEAM
}

extern "C" void kernel_launch(void* const* d_in, const int* in_sizes, int n_in, void* d_out, int out_size, void* d_ws, size_t ws_size, hipStream_t stream) {
    static int grid = 0;
    if (grid == 0) {
        if (n_in != 25 || in_sizes[0] != NTOK * DMODEL || out_size != NTOK * DMODEL || ws_size < WS_END) {
            fprintf(stderr, "kernel_launch: unexpected shapes (n_in %d, in0 %d, out %d, ws %zu); nothing launched\n", n_in, n_in > 0 ? in_sizes[0] : -1, out_size, ws_size); grid = -1; return; }
        int dev = 0, cus = 0, per_cu = 0;
        if (hipGetDevice(&dev) != hipSuccess || hipDeviceGetAttribute(&cus, hipDeviceAttributeMultiprocessorCount, dev) != hipSuccess) { grid = -1; return; }
        if (hipFuncSetAttribute((const void*)mega_fwd, hipFuncAttributeMaxDynamicSharedMemorySize, LDS_BYTES) != hipSuccess) { fprintf(stderr, "kernel_launch: hipFuncSetAttribute failed\n"); grid = -1; return; }
        if (hipOccupancyMaxActiveBlocksPerMultiprocessor(&per_cu, (const void*)mega_fwd, NTHREADS, LDS_BYTES) != hipSuccess || per_cu < 1) { fprintf(stderr, "kernel_launch: the occupancy query reports %d workgroups per CU for this kernel and LDS size; nothing launched\n", per_cu); grid = -1; return; }
        (void)hipGetLastError();
        grid = cus;
    }
    if (grid < 0) return;
    (void)hipMemsetAsync((char*)d_ws + WS_CTL, 0, CTL_ZERO_BYTES, stream);
    Args a{};
    const float** pp = (const float**)&a.p;
    for (int i = 0; i < 25; ++i) pp[i] = (const float*)d_in[i];
    a.p.out = (float*)d_out; a.p.ws = (unsigned char*)d_ws;
#if MK_PER_PHASE
    for (int ph = 0; ph < N_PHASES; ++ph) { a.ph_lo = ph; a.ph_hi = ph + 1; void* params[] = {&a};
        hipError_t e = hipLaunchCooperativeKernel((const void*)mega_fwd, dim3(grid), dim3(NTHREADS), params, LDS_BYTES, stream);
        if (e != hipSuccess) { fprintf(stderr, "launch %d failed: %s\n", ph, hipGetErrorString(e)); break; } }
#else
    a.ph_lo = 0; a.ph_hi = N_PHASES; void* params[] = {&a};
    hipError_t e = hipLaunchCooperativeKernel((const void*)mega_fwd, dim3(grid), dim3(NTHREADS), params, LDS_BYTES, stream);
    if (e != hipSuccess) fprintf(stderr, "cooperative launch failed: %s (grid %d)\n", hipGetErrorString(e), grid);
#endif
}
```

```cpp
#ifndef P5_SPLIT_A
#define P5_SPLIT_A 4
#endif
#include <hip/hip_runtime.h>
#include <hip/hip_bf16.h>
#include <hip/hip_cooperative_groups.h>
#include <cstdio>
#include <cstdint>
#include <cmath>
namespace cg = cooperative_groups;
typedef unsigned v4u_wt __attribute__((ext_vector_type(4)));
__device__ __forceinline__ void store16_wt(void* p, v4u_wt v) { asm volatile("global_store_dwordx4 %0, %1, off sc1\n\ts_nop 1" :: "v"(p), "v"(v) : "memory"); }
__device__ __forceinline__ int tid_opaque() { int t = threadIdx.x; asm volatile("" : "+v"(t)); return t; }

constexpr int BATCH = 8, SEQ = 4096, DMODEL = 1024, NTOK = BATCH * SEQ;
constexpr int CONV_CH = 512, CONV_W = 31, NHEADS = 4, IN_COLS = 4608;
constexpr int NEXP = 32, DEXP = 512, LCAP = NTOK;
constexpr int NCLS = 4 * 28;
constexpr int CROWS = NTOK + NCLS * 256;
constexpr int MOE_ROWS = 2 * NTOK + NEXP * 256;
constexpr float EPS = 1e-6f;

namespace pg8 {
#define PG8_LAS __attribute__((address_space(3)))
typedef unsigned short bf16_t;
typedef short bf16x8 __attribute__((ext_vector_type(8)));
typedef float f32x4 __attribute__((ext_vector_type(4)));
typedef unsigned u32x4 __attribute__((ext_vector_type(4)));
constexpr int BM = 256, BK = 64, HALF = 128, HTB = HALF * BK * 2  , STAGE_BYTES = 8 * HTB, NXCD = 8, WGM = 8;

__host__ __device__ __forceinline__ int lds_byte(int r, int c) { const int st = (r >> 4) * 2 + (c >> 5), rr = r & 15, cc = c & 31, ob = rr * 64 + cc * 2; return st * 1024 + (ob ^ (((ob >> 9) & 1) << 5)); }
__host__ __device__ __forceinline__ void stage_rc(int b, int& R, int& C) { const int st = b / 1024, sb = b % 1024, swz = sb ^ (((sb >> 9) & 1) << 5); R = (st >> 1) * 16 + swz / 64; C = (st & 1) * 32 + (swz % 64) / 2; }
__host__ __device__ __forceinline__ int perm32(int rho) { const int n = rho >> 4, i = rho & 15; return 8 * (i >> 2) + 4 * n + (i & 3); }

struct Unit { int pm, pn, arow, e, e2, lrow, nvalid, orow; };
struct Gemm { const bf16_t* A; const bf16_t* Bt; int K; size_t bstride; const int* list; int lstride; int KBrow; };

struct StaticOrder {
    int nM, nN, nwg, G, c;
    __device__ void init(int M, int N, int G_, int c_) { nM = M / BM; nN = N / BM; nwg = nM * nN; G = G_; c = c_; }
    __device__ bool next(int i, Unit& u) const {
        const long L = (long)i * G + c; if (L >= nwg) return false;
        int wgid = (int)L; { const int q = nwg / NXCD, r = nwg % NXCD, xcd = wgid % NXCD, off = wgid / NXCD; wgid = (xcd < r ? xcd * (q + 1) : r * (q + 1) + (xcd - r) * q) + off; }
        const int nig = WGM * nN, gid = wgid / nig, fm = gid * WGM, gsz = (nM - fm) < WGM ? (nM - fm) : WGM;
        u.pm = fm + ((wgid % nig) % gsz); u.pn = (wgid % nig) / gsz; u.arow = u.pm * BM; u.orow = u.arow; u.e = 0; u.e2 = 0; u.lrow = 0; u.nvalid = BM; return true;
    }
};

typedef float f32x2_t __attribute__((ext_vector_type(2))); typedef __bf16 bf16x2_t __attribute__((ext_vector_type(2)));
__device__ __forceinline__ unsigned cvt_pk_bf16(float lo, float hi) { const f32x2_t v = {lo, hi}; const bf16x2_t b = __builtin_convertvector(v, bf16x2_t); return __builtin_bit_cast(unsigned, b); }
typedef int v8i_t __attribute__((ext_vector_type(8))); typedef int v4i_t __attribute__((ext_vector_type(4)));
__device__ __forceinline__ v8i_t cat8(const bf16x8 a, const bf16x8 b) { const v4i_t x = __builtin_bit_cast(v4i_t, a), y = __builtin_bit_cast(v4i_t, b); return (v8i_t){x[0], x[1], x[2], x[3], y[0], y[1], y[2], y[3]}; }
__device__ __forceinline__ unsigned pack4_fp8(float a, float b, float c, float d) { int w = 0; w = __builtin_amdgcn_cvt_pk_fp8_f32(a, b, w, false); w = __builtin_amdgcn_cvt_pk_fp8_f32(c, d, w, true); return (unsigned)w; }
__device__ __forceinline__ float bf_lo(unsigned w) { return __uint_as_float(w << 16); }
__device__ __forceinline__ float bf_hi(unsigned w) { return __uint_as_float(w & 0xffff0000u); }
__device__ __forceinline__ float sigmoidf_fast(float x) { return __builtin_amdgcn_rcpf(1.0f + __builtin_amdgcn_exp2f(-1.4426950408889634f * x)); }
__device__ __forceinline__ u32x4 pack8(const f32x4 a, const f32x4 b) { u32x4 w; w.x = cvt_pk_bf16(a[0], a[1]); w.y = cvt_pk_bf16(a[2], a[3]); w.z = cvt_pk_bf16(b[0], b[1]); w.w = cvt_pk_bf16(b[2], b[3]); return w; }
__device__ __forceinline__ void unpack8(const u32x4 w, f32x4& a, f32x4& b) { a = (f32x4){bf_lo(w.x), bf_hi(w.x), bf_lo(w.y), bf_hi(w.y)}; b = (f32x4){bf_lo(w.z), bf_hi(w.z), bf_lo(w.w), bf_hi(w.w)}; }

template <class Epi, class Sched, bool GATHER, bool ALIGN_EPI, bool FP8 = false, bool BSPLIT = false>
__device__ __forceinline__ void gemm_phase(PG8_LAS unsigned char* lds, const Gemm g, const Sched& S, const Epi& E) {
    const int tid = tid_opaque(), wid = __builtin_amdgcn_readfirstlane(tid >> 6), lane = tid & 63, wr = wid >> 2, wc = wid & 3, fr = lane & 15, fq = lane >> 4;
    const int K = g.K, nt = K / BK, KBp = g.KBrow ? g.KBrow : K;
    unsigned voffB[2]; int Ra[2], Ca[2];
#pragma unroll
    for (int i = 0; i < 2; ++i) { int R, C; stage_rc(tid * 16 + i * 8192, R, C); const int Rb = (R & ~31) + perm32(R & 31); Ra[i] = R; Ca[i] = C; voffB[i] = (unsigned)(Rb * KBp + C) * 2u; }
    const unsigned kstep = (unsigned)(BK * 2);
    const unsigned hstep = (unsigned)HALF * KBp * 2;
    const unsigned tstep = 2 * hstep;
    const char* const gA = (const char*)g.A; const char* const gB = (const char*)g.Bt;
    const unsigned ldsw = (unsigned)wid * 1024u;
    const int aoff = lds_byte(wr * 64 + fr, fq * 8), boff = lds_byte(wc * 32 + fr, fq * 8);
#define PG8_SA(b, h) (((b) * 2 + (h)) * HTB)
#define PG8_SB(b, h) ((4 + (b) * 2 + (h)) * HTB)
#define PG8_STAGE(bufoff, gbase, uoff, voff) do { _Pragma("unroll") for (int _i = 0; _i < 2; ++_i) \
        __builtin_amdgcn_global_load_lds((const unsigned*)((const char*)(gbase) + (unsigned)((uoff) + (voff)[_i])), (PG8_LAS unsigned*)(lds + (bufoff) + ldsw + _i * 8192), 16, 0, 0); } while (0)
#define PG8_LDA(dst, b, h) do { _Pragma("unroll") for (int m = 0; m < 4; ++m) _Pragma("unroll") for (int k = 0; k < 2; ++k) dst[m][k] = *(const PG8_LAS bf16x8*)(lds + PG8_SA(b, h) + aoff + m * 2048 + k * 1024); } while (0)
#define PG8_LDB(dst, b, h) do { _Pragma("unroll") for (int n = 0; n < 2; ++n) _Pragma("unroll") for (int k = 0; k < 2; ++k) dst[n][k] = *(const PG8_LAS bf16x8*)(lds + PG8_SB(b, h) + boff + n * 2048 + k * 1024); } while (0)
#define PG8_MMA(ai, bj, At, Bt) do { __builtin_amdgcn_s_setprio(1); \
        if constexpr (FP8) { _Pragma("unroll") for (int m = 0; m < 4; ++m) _Pragma("unroll") for (int n = 0; n < 2; ++n) \
            asm volatile("v_mfma_scale_f32_16x16x128_f8f6f4 %0, %1, %2, %0, %3, %3 op_sel_hi:[0,0,0]" : "+v"(acc[ai][bj][m][n]) : "v"(cat8(Bt[n][0], Bt[n][1])), "v"(cat8(At[m][0], At[m][1])), "v"(one_e8m0)); } \
        else { _Pragma("unroll") for (int m = 0; m < 4; ++m) _Pragma("unroll") for (int n = 0; n < 2; ++n) _Pragma("unroll") for (int k = 0; k < 2; ++k) \
            acc[ai][bj][m][n] = __builtin_amdgcn_mfma_f32_16x16x32_bf16(Bt[n][k], At[m][k], acc[ai][bj][m][n], 0, 0, 0); } \
        __builtin_amdgcn_s_setprio(0); } while (0)
#define PG8_WAIT_V(n) asm volatile("s_waitcnt vmcnt(" #n ")" ::: "memory")
#define PG8_WAIT_L(n) asm volatile("s_waitcnt lgkmcnt(" #n ")" ::: "memory")
#define PG8_BAR __builtin_amdgcn_s_barrier()
#define PG8_SCHED __builtin_amdgcn_sched_barrier(0)
#define PG8_LOAD_VA(dst, u) do { _Pragma("unroll") for (int _h = 0; _h < 2; ++_h) _Pragma("unroll") for (int _i = 0; _i < 2; ++_i) { const int _row = _h * HALF + Ra[_i]; \
        if constexpr (GATHER) { const int _tok = (_row < (u).nvalid) ? g.list[((u).lrow + _row) * g.lstride] : 0; dst[_h][_i] = (unsigned)(_tok * K + Ca[_i]) * 2u; } \
        else dst[_h][_i] = (unsigned)(_row * K + Ca[_i]) * 2u; } } while (0)
    Unit cur, nxt; int ui = 0;
    if (!S.next(0, cur)) return;
    typename Epi::Pre pre{};
    unsigned vAc[2][2], vAn[2][2];
    PG8_LOAD_VA(vAc, cur);
    f32x4 acc[2][2][4][2];
#pragma unroll
    for (int a = 0; a < 2; ++a)
#pragma unroll
        for (int b = 0; b < 2; ++b)
#pragma unroll
            for (int m = 0; m < 4; ++m)
#pragma unroll
                for (int n = 0; n < 2; ++n) acc[a][b][m][n] = (f32x4){0.f, 0.f, 0.f, 0.f};
    bf16x8 At[4][2], B0[2][2], B1[2][2];
    const int one_e8m0 = 0x7f7f7f7f; (void)one_e8m0;
    unsigned cA = (unsigned)cur.arow * K * 2, cB = (unsigned)cur.e * (unsigned)g.bstride + (unsigned)cur.pn * tstep;
    unsigned cB2 = (unsigned)cur.e2 * (unsigned)g.bstride + (unsigned)cur.pn * tstep; const unsigned hk = (unsigned)(nt / 2) * kstep; (void)cB2; (void)hk;
    PG8_STAGE(PG8_SB(0, 0), gB, cB, voffB); PG8_STAGE(PG8_SB(0, 1), gB, cB + hstep, voffB); PG8_STAGE(PG8_SA(0, 0), gA, cA, vAc[0]); PG8_STAGE(PG8_SA(0, 1), gA, cA, vAc[1]);
    if (wr == 1) PG8_BAR;
    PG8_WAIT_V(2); PG8_BAR;
    PG8_STAGE(PG8_SB(1, 0), gB, cB + kstep, voffB); PG8_STAGE(PG8_SA(1, 0), gA, cA + kstep, vAc[0]); PG8_STAGE(PG8_SB(1, 1), gB, cB + hstep + kstep, voffB);
    PG8_WAIT_V(6); PG8_BAR;
    for (;;) {
        const bool has_next = S.next(ui + 1, nxt);
        const unsigned nA = has_next ? (unsigned)nxt.arow * K * 2 : cA;
        const unsigned nB = has_next ? (unsigned)nxt.e * (unsigned)g.bstride + (unsigned)nxt.pn * tstep : cB;
        const unsigned nB2 = has_next ? (unsigned)nxt.e2 * (unsigned)g.bstride + (unsigned)nxt.pn * tstep : cB2; (void)nB2;
        if (has_next) { PG8_LOAD_VA(vAn, nxt); }
        else {
#pragma unroll
            for (int h = 0; h < 2; ++h)
#pragma unroll
                for (int i = 0; i < 2; ++i) vAn[h][i] = vAc[h][i]; }
#pragma unroll 1
        for (int t = 0; t < nt; t += 2) {
            const bool last = (t == nt - 2);
            if constexpr (Epi::MID) { if (t == nt / 2) E.mid(acc, cur, wr, wc, fr, fq); }
            if constexpr (Epi::PREMID) { if (t == nt / 2) pre = E.pre(cur, wr, fr); }
            const unsigned a1 = cA + (unsigned)(t + 1) * kstep;
            const unsigned a2 = last ? nA : cA + (unsigned)(t + 2) * kstep;
            unsigned b2 = last ? nB : cB + (unsigned)(t + 2) * kstep;
            if constexpr (BSPLIT) { if (!last && t + 2 >= nt / 2) b2 = cB2 + (unsigned)(t + 2) * kstep - hk; }
            const unsigned a3 = a2 + kstep, b3 = b2 + kstep;
            unsigned v2[2][2];
#pragma unroll
            for (int h = 0; h < 2; ++h)
#pragma unroll
                for (int i = 0; i < 2; ++i) v2[h][i] = vAc[h][i];
            if (last) { asm volatile("" ::: "memory");
#pragma unroll
                for (int h = 0; h < 2; ++h)
#pragma unroll
                    for (int i = 0; i < 2; ++i) v2[h][i] = vAn[h][i]; }
            PG8_LDB(B0, 0, 0); PG8_LDB(B1, 0, 1); PG8_SCHED; PG8_LDA(At, 0, 0); PG8_STAGE(PG8_SA(1, 1), gA, a1, vAc[1]);
            if constexpr (Epi::NPRE8) { if (t == nt / 2) PG8_WAIT_V(16); else PG8_WAIT_V(8); } else PG8_WAIT_V(8);
            PG8_WAIT_L(0); PG8_BAR; PG8_MMA(0, 0, At, B0); PG8_MMA(0, 1, At, B1); PG8_BAR; PG8_SCHED;
            PG8_LDA(At, 0, 1); PG8_STAGE(PG8_SB(0, 0), gB, b2, voffB); PG8_STAGE(PG8_SB(0, 1), gB, b2 + hstep, voffB); PG8_STAGE(PG8_SA(0, 0), gA, a2, v2[0]);
            if constexpr (Epi::NPRE8) { if (t == nt / 2) PG8_WAIT_V(16); else PG8_WAIT_V(8); } else PG8_WAIT_V(8);
            PG8_WAIT_L(0); PG8_BAR; PG8_MMA(1, 0, At, B0); PG8_MMA(1, 1, At, B1); PG8_BAR; PG8_SCHED;
            PG8_LDB(B0, 1, 0); PG8_LDB(B1, 1, 1); PG8_SCHED; PG8_LDA(At, 1, 0); PG8_STAGE(PG8_SA(0, 1), gA, a2, v2[1]);
            PG8_WAIT_V(8); PG8_WAIT_L(0); PG8_BAR; PG8_MMA(0, 0, At, B0); PG8_MMA(0, 1, At, B1); PG8_BAR; PG8_SCHED;
            PG8_LDA(At, 1, 1); PG8_STAGE(PG8_SB(1, 0), gB, b3, voffB); PG8_STAGE(PG8_SB(1, 1), gB, b3 + hstep, voffB); PG8_STAGE(PG8_SA(1, 0), gA, a3, v2[0]);
            PG8_WAIT_V(8); PG8_WAIT_L(0); PG8_BAR; PG8_MMA(1, 0, At, B0); PG8_MMA(1, 1, At, B1); PG8_BAR; PG8_SCHED;
        }
        if constexpr (ALIGN_EPI) { if (wr == 0) PG8_BAR; }
        if constexpr (FP8) asm volatile("s_nop 15\n\ts_nop 15\n\ts_nop 15\n\ts_nop 15" ::: "memory");
        if constexpr (Epi::PREMID) E(acc, cur, wr, wc, fr, fq, pre); else E(acc, cur, wr, wc, fr, fq, E.pre(cur, wr, fr));
        if (!has_next) break;
#pragma unroll
        for (int a = 0; a < 2; ++a)
#pragma unroll
            for (int b = 0; b < 2; ++b)
#pragma unroll
                for (int m = 0; m < 4; ++m)
#pragma unroll
                    for (int n = 0; n < 2; ++n) acc[a][b][m][n] = (f32x4){0.f, 0.f, 0.f, 0.f};
        cur = nxt; cA = nA; cB = nB; cB2 = nB2; ++ui;
#pragma unroll
        for (int h = 0; h < 2; ++h)
#pragma unroll
            for (int i = 0; i < 2; ++i) vAc[h][i] = vAn[h][i];
        if constexpr (ALIGN_EPI) { if (wr == 1) PG8_BAR; }
    }
    PG8_WAIT_V(0);
    if constexpr (!ALIGN_EPI) { if (wr == 0) PG8_BAR; }
    PG8_BAR;
#undef PG8_SA
#undef PG8_SB
#undef PG8_STAGE
#undef PG8_LDA
#undef PG8_LDB
#undef PG8_MMA
#undef PG8_WAIT_V
#undef PG8_WAIT_L
#undef PG8_BAR
#undef PG8_SCHED
#undef PG8_LOAD_VA
}
}

namespace attn_body {
using bf16=__hip_bfloat16;
using bf16x8=__attribute__((ext_vector_type(8)))short;
using s16x4=__attribute__((ext_vector_type(4)))short;
using f32x16=__attribute__((ext_vector_type(16)))float;
using u32x4=__attribute__((ext_vector_type(4)))unsigned;
constexpr int D=64, QP=512, KP=512, VP=512, OP=1024;
constexpr int NW=8,QBLK=32,QB=QBLK*NW,KVBLK=64;
constexpr int ATTN_UNIT_ROWS=QB;
__device__ __forceinline__ int crow(int r,int hi){return (r&3)+8*(r>>2)+4*hi;}
#define SBAR() __builtin_amdgcn_sched_barrier(0)
__device__ __forceinline__ void cmask(f32x16&p0,f32x16&p1,int jb,int qrel,int hi){
  const float NEG=-INFINITY; int kb=64*jb+4*hi;
  #pragma unroll
  for(int r=0;r<16;++r){int kv=kb+(r&3)+8*(r>>2); if(kv>qrel)p0[r]=NEG; if(kv+32>qrel)p1[r]=NEG;}
}

constexpr int NSLOT=3, SLOTB=8192, VSLOTB=16384;
constexpr int LDS_K=0, LDS_V=NSLOT*SLOTB, LDS_WS=LDS_V+NSLOT*VSLOTB, LDS_OST=LDS_WS+NW*64*4, LDS_BYTES=LDS_OST+NW*4096;
constexpr float C2=0.125f*1.4426950408889634f;
__device__ __forceinline__ void glds16(const void*gsrc,unsigned lds_dst){unsigned keep;
  asm volatile("s_mov_b32 %0, m0\n\ts_mov_b32 m0, %2\n\ts_nop 0\n\tglobal_load_lds_dwordx4 %1, off\n\ts_mov_b32 m0, %0":"=&s"(keep):"v"(gsrc),"s"(lds_dst):"memory");}
__device__ __forceinline__ float max3f(float a,float b,float c){float r;asm("v_max3_f32 %0, %1, %2, %3":"=v"(r):"v"(a),"v"(b),"v"(c));return r;}
__device__ __forceinline__ float max2f(float a,float b){float r;asm("v_max_f32_e32 %0, %1, %2":"=v"(r):"v"(a),"v"(b));return r;}
__device__ __forceinline__ float fadd_s(float a,float b){float r;asm("v_add_f32_e32 %0, %1, %2":"=v"(r):"v"(a),"v"(b));return r;}
__device__ __forceinline__ float fsub_s(float a,float b){float r;asm("v_sub_f32_e32 %0, %1, %2":"=v"(r):"v"(a),"v"(b));return r;}
typedef float f32x2_t __attribute__((ext_vector_type(2))); typedef __bf16 bf16x2_t __attribute__((ext_vector_type(2)));
__device__ __forceinline__ unsigned cvtpk_s(float lo,float hi){f32x2_t v={lo,hi};bf16x2_t b=__builtin_convertvector(v,bf16x2_t);return __builtin_bit_cast(unsigned,b);}
#define WAIT_BAR(N) asm volatile("s_waitcnt vmcnt(" #N ") lgkmcnt(0)\n\ts_barrier":::"memory")

__device__ __forceinline__ void qkt(f32x16&p0,f32x16&p1,const char*Kslot,const bf16x8*qr,const f32x16&negm,int r32,int hi){
  const char*kb=Kslot+hi*1024+r32*16;
  #pragma unroll
  for(int d0=0;d0<4;++d0){
    const bf16x8 b0=*reinterpret_cast<const bf16x8*>(kb+d0*2048);
    const bf16x8 b1=*reinterpret_cast<const bf16x8*>(kb+d0*2048+512);
    if(d0==0){p0=__builtin_amdgcn_mfma_f32_32x32x16_bf16(b0,qr[0],negm,0,0,0);p1=__builtin_amdgcn_mfma_f32_32x32x16_bf16(b1,qr[0],negm,0,0,0);}
    else{p0=__builtin_amdgcn_mfma_f32_32x32x16_bf16(b0,qr[d0],p0,0,0,0);p1=__builtin_amdgcn_mfma_f32_32x32x16_bf16(b1,qr[d0],p1,0,0,0);}}
}
typedef __attribute__((address_space(3))) const char* lds_cptr;
typedef short v4i16_t __attribute__((ext_vector_type(4)));
__device__ __forceinline__ void kload8(bf16x8*kf,lds_cptr kp){
  kf[0]=*(const __attribute__((address_space(3))) bf16x8*)(kp);      kf[1]=*(const __attribute__((address_space(3))) bf16x8*)(kp+512);
  kf[2]=*(const __attribute__((address_space(3))) bf16x8*)(kp+2048); kf[3]=*(const __attribute__((address_space(3))) bf16x8*)(kp+2560);
  kf[4]=*(const __attribute__((address_space(3))) bf16x8*)(kp+4096); kf[5]=*(const __attribute__((address_space(3))) bf16x8*)(kp+4608);
  kf[6]=*(const __attribute__((address_space(3))) bf16x8*)(kp+6144); kf[7]=*(const __attribute__((address_space(3))) bf16x8*)(kp+6656);
}
__device__ __forceinline__ void kload2(bf16x8*kf,lds_cptr kp,int j){ kf[2*j]=*(const __attribute__((address_space(3))) bf16x8*)(kp+j*2048); kf[2*j+1]=*(const __attribute__((address_space(3))) bf16x8*)(kp+j*2048+512); }
__device__ __forceinline__ s16x4 vtr(lds_cptr p){ return __builtin_bit_cast(s16x4,__builtin_amdgcn_ds_read_tr16_b64_v4i16((__attribute__((address_space(3))) v4i16_t*)p)); }
__device__ __forceinline__ float rowmax(const f32x16&p0,const f32x16&p1){
  float a=max3f(p0[0],p0[1],p1[0]),b=max3f(p0[2],p0[3],p1[1]);a=max3f(a,p1[2],p1[3]);
  #pragma unroll
  for(int r=4;r<16;r+=4){a=max3f(a,p0[r],p0[r+1]);b=max3f(b,p0[r+2],p0[r+3]);a=max3f(a,p1[r],p1[r+1]);b=max3f(b,p1[r+2],p1[r+3]);}
  const float m=max2f(a,b);
  auto rr=__builtin_amdgcn_permlane32_swap(__float_as_uint(m),__float_as_uint(m),false,false);
  return max2f(__uint_as_float(rr[0]),__uint_as_float(rr[1]));
}
__device__ __forceinline__ void pv(f32x16*o,int vb,bf16x8 pa0,bf16x8 pa1,bf16x8 pa2,bf16x8 pa3){
  #pragma unroll
  for(int d0=0;d0<4;++d0){s16x4 lo[4],hi[4];
    #pragma unroll
    for(int ks=0;ks<4;++ks){
      asm volatile("ds_read_b64_tr_b16 %0,%1 offset:%c2":"=&v"(lo[ks]):"v"(vb),"i"(d0*4096+ks*1024):"memory");
      asm volatile("ds_read_b64_tr_b16 %0,%1 offset:%c2":"=&v"(hi[ks]):"v"(vb),"i"(d0*4096+ks*1024+512):"memory");}
    asm volatile("s_waitcnt lgkmcnt(0)":::"memory");SBAR();
    #define PK(k) (bf16x8){lo[k][0],lo[k][1],lo[k][2],lo[k][3],hi[k][0],hi[k][1],hi[k][2],hi[k][3]}
    o[d0]=__builtin_amdgcn_mfma_f32_32x32x16_bf16(pa0,PK(0),o[d0],0,0,0);
    o[d0]=__builtin_amdgcn_mfma_f32_32x32x16_bf16(pa1,PK(1),o[d0],0,0,0);
    o[d0]=__builtin_amdgcn_mfma_f32_32x32x16_bf16(pa2,PK(2),o[d0],0,0,0);
    o[d0]=__builtin_amdgcn_mfma_f32_32x32x16_bf16(pa3,PK(3),o[d0],0,0,0);
    #undef PK
  }
}

#ifndef ATTN_STORE16
#define ATTN_STORE16(p,v) (*(u32x4*)(p)=(v))
#endif
template<int THRL,bool STAT> __device__ __forceinline__ int attn_unit(float mstat,int q0,const bf16*Q,const bf16*__restrict__ K,const bf16*__restrict__ V,bf16*O,char*shm,const bf16*O1,float lam,const float*subg,unsigned short*CAo,const bf16*Knext,const bf16*Vnext,int s0,bool pre){
  #define NXT_(x) (((x)==(NSLOT-1)*SLOTB)?0:(x)+SLOTB)
  const int s1=NXT_(s0),s2=NXT_(s1);
  int tid_=threadIdx.x; asm volatile("":"+v"(tid_));
  const int tid=tid_,lane=tid&63,r32=lane&31,hi=lane>>5; const int wid=__builtin_amdgcn_readfirstlane(tid>>6);
  const bf16*Qw=Q+(long)(q0+wid*QBLK)*QP;
  const bf16*Kh=K,*Vh=V;
  const unsigned lds0=(unsigned)(uintptr_t)shm;
  float*wsf=(float*)(shm+LDS_WS)+wid*64;
  const bf16*ksrc=Kh+(long)lane*KP+wid*8;
  const bf16*vsrc=Vh+(long)(16*(wid&3)+(lane>>2))*VP+(wid>>2)*32+(lane&3)*8;
  const unsigned kdst=lds0+LDS_K+wid*1024, vdst=lds0+LDS_V+wid*1024;
  #define DMA_K(t,slot) glds16(ksrc+(long)(t)*KVBLK*KP,(unsigned)__builtin_amdgcn_readfirstlane(kdst+(slot)))
  #define DMA_V(t,slot) do{ glds16(vsrc+(long)(t)*KVBLK*VP,(unsigned)__builtin_amdgcn_readfirstlane(vdst+2*(slot))); glds16(vsrc+(long)(t)*KVBLK*VP+64,(unsigned)__builtin_amdgcn_readfirstlane(vdst+2*(slot)+8192)); }while(0)
  const int vb0=(int)(lds0+LDS_V)+((lane>>4)&1)*32+(lane&3)*8+(4*hi+((lane&15)>>2))*64;
  const char*Kbase=shm+LDS_K; bf16x8 kf[8];
  const lds_cptr shm3=(lds_cptr)shm; const lds_cptr kp0=shm3+LDS_K+hi*1024+r32*16; const lds_cptr vp0=shm3+LDS_V+((lane>>4)&1)*32+(lane&3)*8+(4*hi+((lane&15)>>2))*64;
  const int NT=(q0+QB)/KVBLK;
  if(!pre){DMA_K(0,s0);DMA_V(0,s0);DMA_K(1,s1);}
  bf16x8 qr[4];
  #pragma unroll
  for(int d0=0;d0<4;++d0)qr[d0]=*reinterpret_cast<const bf16x8*>(&Qw[(long)r32*QP+d0*16+hi*8]);
  float mhat=0.f,l_reg=0.f;f32x16 o[4];{float zz=0.f;asm volatile("":"+v"(zz));
  #pragma unroll
  for(int r=0;r<16;++r){o[0][r]=zz;o[1][r]=zz;o[2][r]=zz;o[3][r]=zz;}}
  f32x16 negm;{float zn=0.f;asm volatile("":"+v"(zn));
  #pragma unroll
  for(int r=0;r<16;++r)negm[r]=zn;}
  asm volatile("":"+v"(negm));
  const int qrel=wid*QBLK+r32;
  #define CMASK(P0,P1,t) do{int jb_=(t)-(NT-4); if(jb_>=0)cmask(P0,P1,jb_,qrel,hi);}while(0)
  bool resc=false;
  #define START(P0,P1) do{ float rm; if constexpr (STAT) rm=mstat; else rm=rowmax(P0,P1); resc=false; \
    { const float dl=rm; mhat=fadd_s(mhat,dl); \
      _Pragma("unroll") for(int r=0;r<16;++r){P0[r]=fsub_s(P0[r],dl);P1[r]=fsub_s(P1[r],dl);} \
      _Pragma("unroll") for(int r=0;r<16;++r)negm[r]=-mhat; asm volatile("":"+v"(negm)); } \
    _Pragma("unroll") for(int r=0;r<16;++r)P0[r]=__builtin_amdgcn_exp2f(P0[r]); }while(0)
  #define RESC() do{ if(resc){ asm volatile("s_waitcnt lgkmcnt(0)":::"memory"); \
      _Pragma("unroll") for(int d_=0;d_<4;++d_) _Pragma("unroll") for(int r=0;r<16;++r)o[d_][r]*=wsf[crow(r,hi)]; } }while(0)
  f32x16 pA0,pA1,pB0,pB1;
  int sl_prev=s0,sl_cur=s0,sl_next=s1;
  #define ROT() do{sl_prev=sl_cur;sl_cur=sl_next;sl_next=(sl_next==(NSLOT-1)*SLOTB)?0:sl_next+SLOTB;}while(0)
  if(!pre){DMA_K(2,s2);}
  WAIT_BAR(4);
  qkt(pA0,pA1,Kbase+s0,qr,negm,r32,hi);asm volatile("s_nop 15\n\ts_nop 7":"+v"(pA0),"+v"(pA1));CMASK(pA0,pA1,0);
  START(pA0,pA1);
  _Pragma("unroll") for(int r=0;r<16;++r)pA1[r]=__builtin_amdgcn_exp2f(pA1[r]);
  WAIT_BAR(0);
  DMA_K(3,s0);DMA_V(1,s1);
  ROT();
  kload8(kf,kp0+sl_cur);
  WAIT_BAR(3);
  s16x4 vlo[8],vhi[8]; u32x4 pw0,pw1,pw2,pw3;
  #define PKW(P,B) cvtpk_s(P[B],P[B+1])
  #define PAF(k) __builtin_bit_cast(bf16x8,pw##k)
  #define VFR(i) (bf16x8){vlo[i][0],vlo[i][1],vlo[i][2],vlo[i][3],vhi[i][0],vhi[i][1],vhi[i][2],vhi[i][3]}
  #define PIN(x) asm volatile("":"+v"(x))
  #define MX3(a,b,c) __builtin_fmaxf(__builtin_fmaxf((a),(b)),(c))
  #define GAPA(MF,A0,A1,A2,A3,W0,W1,PW) do{ MF; sacc+=A0; sacc+=A1; sacc+=A2; sacc+=A3; PIN(sacc); W0; W1; PIN(PW); SBAR(); }while(0)
  #define EX(v) __builtin_amdgcn_exp2f(v)
  #define GAPB2(MF,X,B) do{ MF; X[B]=EX(X[B]); X[B+1]=EX(X[B+1]); PIN(X); SBAR(); }while(0)
  #define VRD2(i) do{ vlo[i]=vtr(vp_+((((i)>>2)+2)*4096+((i)&3)*1024)); vhi[i]=vtr(vp_+((((i)>>2)+2)*4096+((i)&3)*1024+512)); }while(0)
  #define VRD(i) do{ vlo[i]=vtr(vp_+(((i)>>2)*4096+((i)&3)*1024)); vhi[i]=vtr(vp_+(((i)>>2)*4096+((i)&3)*1024+512)); }while(0)
  #define KRD(G,j) do{ if(G){ kload2(kf,kp0+sl_next,j); SBAR(); } }while(0)
  #define STEP(C0,C1,P0,P1,t,GK,GV,GL) do{ SBAR(); \
    const lds_cptr vp_=vp0+2*sl_prev; \
    VRD(0); SBAR(); float sacc=(P0[0]+P0[1]); \
    GAPA(C0=__builtin_amdgcn_mfma_f32_32x32x16_bf16(kf[0],qr[0],negm,0,0,0), P0[2],P0[3],P0[4],P0[5],     pw0[0]=PKW(P0,0), pw0[1]=PKW(P0,2), pw0); \
    VRD(4); SBAR(); GAPA(C1=__builtin_amdgcn_mfma_f32_32x32x16_bf16(kf[1],qr[0],negm,0,0,0), P0[6],P0[7],P0[8],P0[9],     pw0[2]=PKW(P0,4), pw0[3]=PKW(P0,6), pw0); \
    VRD(1); SBAR(); GAPA(C0=__builtin_amdgcn_mfma_f32_32x32x16_bf16(kf[2],qr[1],C0,0,0,0),   P0[10],P0[11],P0[12],P0[13], pw1[0]=PKW(P0,8), pw1[1]=PKW(P0,10), pw1); \
    VRD(5); SBAR(); GAPA(C1=__builtin_amdgcn_mfma_f32_32x32x16_bf16(kf[3],qr[1],C1,0,0,0),   P0[14],P0[15],P1[0],P1[1],   pw1[2]=PKW(P0,12),pw1[3]=PKW(P0,14), pw1); \
    VRD(2); SBAR(); GAPA(C0=__builtin_amdgcn_mfma_f32_32x32x16_bf16(kf[4],qr[2],C0,0,0,0),   P1[2],P1[3],P1[4],P1[5],     pw2[0]=PKW(P1,0), pw2[1]=PKW(P1,2), pw2); \
    VRD(6); SBAR(); GAPA(C1=__builtin_amdgcn_mfma_f32_32x32x16_bf16(kf[5],qr[2],C1,0,0,0),   P1[6],P1[7],P1[8],P1[9],     pw2[2]=PKW(P1,4), pw2[3]=PKW(P1,6), pw2); \
    VRD(3); SBAR(); GAPA(C0=__builtin_amdgcn_mfma_f32_32x32x16_bf16(kf[6],qr[3],C0,0,0,0),   P1[10],P1[11],P1[12],P1[13], pw3[0]=PKW(P1,8), pw3[1]=PKW(P1,10), pw3); \
    VRD(7); SBAR(); GAPA(C1=__builtin_amdgcn_mfma_f32_32x32x16_bf16(kf[7],qr[3],C1,0,0,0),   P1[14],P1[15],0.f,0.f,       pw3[2]=PKW(P1,12),pw3[3]=PKW(P1,14), pw3); \
    l_reg+=sacc; \
    if(GK){DMA_K((t)+3,sl_cur);} if(GV){DMA_V((t)+1,sl_next);} \
    CMASK(C0,C1,t); \
    if constexpr (!STAT) { float a=MX3(C0[0],C0[1],C1[0]),b=MX3(C0[2],C0[3],C1[1]); a=MX3(a,C1[2],C1[3]); \
      _Pragma("unroll") for(int r=4;r<16;r+=4){a=MX3(a,C0[r],C0[r+1]);b=MX3(b,C0[r+2],C0[r+3]);a=MX3(a,C1[r],C1[r+1]);b=MX3(b,C1[r+2],C1[r+3]);} \
      float rm=__builtin_fmaxf(a,b); { auto rr=__builtin_amdgcn_permlane32_swap(__float_as_uint(rm),__float_as_uint(rm),false,false); rm=__builtin_fmaxf(__uint_as_float(rr[0]),__uint_as_float(rr[1])); } \
      resc=false; \
      if(__builtin_expect(__any(rm>(float)THRL),0)){ const float dl=__builtin_fmaxf(rm,0.f); mhat+=dl; \
        _Pragma("unroll") for(int r=0;r<16;++r){C0[r]-=dl;C1[r]-=dl;} \
        _Pragma("unroll") for(int r=0;r<16;++r)negm[r]=-mhat; asm volatile("":"+v"(negm)); \
        const float f=__builtin_amdgcn_exp2f(-dl); l_reg*=f; if(hi==0)wsf[r32]=f; resc=true; } } \
    SBAR(); \
    GAPB2(o[0]=__builtin_amdgcn_mfma_f32_32x32x16_bf16(PAF(0),VFR(0),o[0],0,0,0), C0,0);  VRD2(0); SBAR(); \
    GAPB2(o[1]=__builtin_amdgcn_mfma_f32_32x32x16_bf16(PAF(0),VFR(4),o[1],0,0,0), C0,2);  VRD2(4); SBAR(); \
    GAPB2(o[0]=__builtin_amdgcn_mfma_f32_32x32x16_bf16(PAF(1),VFR(1),o[0],0,0,0), C0,4);  VRD2(1); SBAR(); \
    GAPB2(o[1]=__builtin_amdgcn_mfma_f32_32x32x16_bf16(PAF(1),VFR(5),o[1],0,0,0), C0,6);  VRD2(5); SBAR(); \
    GAPB2(o[0]=__builtin_amdgcn_mfma_f32_32x32x16_bf16(PAF(2),VFR(2),o[0],0,0,0), C0,8);  VRD2(2); SBAR(); \
    GAPB2(o[1]=__builtin_amdgcn_mfma_f32_32x32x16_bf16(PAF(2),VFR(6),o[1],0,0,0), C0,10); VRD2(6); SBAR(); \
    GAPB2(o[0]=__builtin_amdgcn_mfma_f32_32x32x16_bf16(PAF(3),VFR(3),o[0],0,0,0), C0,12); VRD2(3); SBAR(); \
    GAPB2(o[1]=__builtin_amdgcn_mfma_f32_32x32x16_bf16(PAF(3),VFR(7),o[1],0,0,0), C0,14); VRD2(7); SBAR(); \
    GAPB2(o[2]=__builtin_amdgcn_mfma_f32_32x32x16_bf16(PAF(0),VFR(0),o[2],0,0,0), C1,0); \
    GAPB2(o[3]=__builtin_amdgcn_mfma_f32_32x32x16_bf16(PAF(0),VFR(4),o[3],0,0,0), C1,2); \
    KRD(GL,0); GAPB2(o[2]=__builtin_amdgcn_mfma_f32_32x32x16_bf16(PAF(1),VFR(1),o[2],0,0,0), C1,4); \
    KRD(GL,1); GAPB2(o[3]=__builtin_amdgcn_mfma_f32_32x32x16_bf16(PAF(1),VFR(5),o[3],0,0,0), C1,6); \
    KRD(GL,2); GAPB2(o[2]=__builtin_amdgcn_mfma_f32_32x32x16_bf16(PAF(2),VFR(2),o[2],0,0,0), C1,8); \
    KRD(GL,3); GAPB2(o[3]=__builtin_amdgcn_mfma_f32_32x32x16_bf16(PAF(2),VFR(6),o[3],0,0,0), C1,10); \
    GAPB2(o[2]=__builtin_amdgcn_mfma_f32_32x32x16_bf16(PAF(3),VFR(3),o[2],0,0,0), C1,12); \
    GAPB2(o[3]=__builtin_amdgcn_mfma_f32_32x32x16_bf16(PAF(3),VFR(7),o[3],0,0,0), C1,14); \
    }while(0)
  int t=1;
  #undef CMASK
  #define CMASK(P0,P1,t) do{}while(0)
  for(;t+5<NT;t+=2){
    STEP(pB0,pB1,pA0,pA1,t,true,true,true);     WAIT_BAR(3); RESC(); ROT();
    STEP(pA0,pA1,pB0,pB1,t+1,true,true,true);   WAIT_BAR(3); RESC(); ROT();
  }
  #undef CMASK
  #define CMASK(P0,P1,t) do{int jb_=(t)-(NT-4); if(jb_>=0)cmask(P0,P1,jb_,qrel,hi);}while(0)
  #define ENDW(tt) do{ if((tt)+3<NT){WAIT_BAR(3);} else if((tt)+2<NT){WAIT_BAR(2);} else {WAIT_BAR(0);} }while(0)
  for(;t+1<NT;t+=2){
    STEP(pB0,pB1,pA0,pA1,t,(t+3<NT),(t+1<NT),(t+1<NT));       ENDW(t);   RESC(); ROT();
    STEP(pA0,pA1,pB0,pB1,t+1,(t+4<NT),(t+2<NT),(t+2<NT));     ENDW(t+1); RESC(); ROT();
  }
  int snext=0;
  if(Knext!=nullptr){
    const int p0=sl_next,p1=NXT_(p0),p2=NXT_(p1); snext=p0;
    const bf16*kn=Knext+(long)lane*KP+wid*8; const bf16*vn=Vnext+(long)(16*(wid&3)+(lane>>2))*VP+(wid>>2)*32+(lane&3)*8;
    glds16(kn,(unsigned)__builtin_amdgcn_readfirstlane(kdst+p0));
    glds16(vn,(unsigned)__builtin_amdgcn_readfirstlane(vdst+2*p0)); glds16(vn+64,(unsigned)__builtin_amdgcn_readfirstlane(vdst+2*p0+8192));
    glds16(kn+(long)KVBLK*KP,(unsigned)__builtin_amdgcn_readfirstlane(kdst+p1)); glds16(kn+(long)2*KVBLK*KP,(unsigned)__builtin_amdgcn_readfirstlane(kdst+p2)); }
  STEP(pB0,pB1,pA0,pA1,NT-1,false,false,false); RESC();
  { float sacc=pB0[0]+pB0[1]; _Pragma("unroll") for(int r=2;r<16;++r)sacc+=pB0[r]; _Pragma("unroll") for(int r=0;r<16;++r)sacc+=pB1[r]; l_reg+=sacc;
    pw0=(u32x4){PKW(pB0,0),PKW(pB0,2),PKW(pB0,4),PKW(pB0,6)};pw1=(u32x4){PKW(pB0,8),PKW(pB0,10),PKW(pB0,12),PKW(pB0,14)};pw2=(u32x4){PKW(pB1,0),PKW(pB1,2),PKW(pB1,4),PKW(pB1,6)};pw3=(u32x4){PKW(pB1,8),PKW(pB1,10),PKW(pB1,12),PKW(pB1,14)};
    SBAR(); pv(o,vb0+2*sl_cur,PAF(0),PAF(1),PAF(2),PAF(3)); }
  #undef PKW
  #undef PAF
  #undef VFR
  #undef PIN
  #undef MX3
  #undef GAPA
  #undef GAPB2
  #undef VRD2
  #undef EX
  #undef VRD
  #undef KRD
  #undef STEP
  #undef ENDW
  {auto rr=__builtin_amdgcn_permlane32_swap(__float_as_uint(l_reg),__float_as_uint(l_reg),false,false);l_reg=__uint_as_float(rr[0])+__uint_as_float(rr[1]);}
  if(hi==0)wsf[32+r32]=l_reg;asm volatile("s_waitcnt lgkmcnt(0)":::"memory");
  float rli[16];
  #pragma unroll
  for(int r=0;r<16;++r)rli[r]=__builtin_amdgcn_rcpf(wsf[32+crow(r,hi)]);
  bf16*Ow=O+(long)(q0+wid*QBLK)*OP;
  bf16*stg=(bf16*)(shm+LDS_OST)+wid*2048;
  if(O1==nullptr){
    #pragma unroll
    for(int hf=0;hf<2;++hf){
      #pragma unroll
      for(int r=0;r<16;++r){const int orow=crow(r,hi);
        #pragma unroll
        for(int d0=0;d0<2;++d0)stg[orow*64+d0*32+r32]=__float2bfloat16(o[2*hf+d0][r]*rli[r]);}
      asm volatile("s_waitcnt lgkmcnt(0)":::"memory");
      #pragma unroll
      for(int i=0;i<4;++i){const int row=i*8+(lane>>3),ch=lane&7; const u32x4 v=*(const u32x4*)(stg+row*64+ch*8); ATTN_STORE16(Ow+(long)row*OP+hf*64+ch*8,v);}
      asm volatile("s_waitcnt lgkmcnt(0)":::"memory"); }
  } else {
    const bf16*O1w=O1+(long)(q0+wid*QBLK)*OP; unsigned long long p1[2][4][2];
    #pragma unroll
    for(int hf=0;hf<2;++hf)
      #pragma unroll
      for(int i=0;i<4;++i){const int row=i*8+(lane>>3),ch=lane&7; unsigned long long*a=(unsigned long long*)(O1w+(long)row*OP+hf*64+ch*8);
        p1[hf][i][0]=__hip_atomic_load(a,__ATOMIC_RELAXED,__HIP_MEMORY_SCOPE_AGENT); p1[hf][i][1]=__hip_atomic_load(a+1,__ATOMIC_RELAXED,__HIP_MEMORY_SCOPE_AGENT);}
    float dd[2][4][8]; float ssp[4]={0.f,0.f,0.f,0.f};
    #pragma unroll
    for(int hf=0;hf<2;++hf){
      #pragma unroll
      for(int r=0;r<16;++r){const int orow=crow(r,hi);
        #pragma unroll
        for(int d0=0;d0<2;++d0)stg[orow*64+d0*32+r32]=__float2bfloat16(o[2*hf+d0][r]*rli[r]);}
      asm volatile("s_waitcnt lgkmcnt(0)":::"memory");
      #pragma unroll
      for(int i=0;i<4;++i){const int row=i*8+(lane>>3),ch=lane&7; const u32x4 v=*(const u32x4*)(stg+row*64+ch*8);
        const unsigned w1[4]={(unsigned)p1[hf][i][0],(unsigned)(p1[hf][i][0]>>32),(unsigned)p1[hf][i][1],(unsigned)(p1[hf][i][1]>>32)};
        #pragma unroll
        for(int j=0;j<4;++j){ const float a0=__uint_as_float(w1[j]<<16)-lam*__uint_as_float(v[j]<<16), a1=__uint_as_float(w1[j]&0xffff0000u)-lam*__uint_as_float(v[j]&0xffff0000u);
          dd[hf][i][2*j]=a0; dd[hf][i][2*j+1]=a1; ssp[i]+=a0*a0+a1*a1; } }
      asm volatile("s_waitcnt lgkmcnt(0)":::"memory"); }
    #pragma unroll
    for(int i=0;i<4;++i){ float ss=ssp[i];
      ss+=__int_as_float(__builtin_amdgcn_update_dpp(0,__float_as_int(ss),0xB1,0xf,0xf,true)); ss+=__int_as_float(__builtin_amdgcn_update_dpp(0,__float_as_int(ss),0x4E,0xf,0xf,true)); ss+=__int_as_float(__builtin_amdgcn_update_dpp(0,__float_as_int(ss),0x141,0xf,0xf,true));
      const float rn=1.0f/sqrtf(ss*(1.0f/128.0f)+1e-6f)*0.8f;
      const int row=i*8+(lane>>3),ch=lane&7;
      #pragma unroll
      for(int hf=0;hf<2;++hf){ const float*gp=subg+hf*64+ch*8; u32x4 w;
        w[0]=cvtpk_s(dd[hf][i][0]*rn*gp[0],dd[hf][i][1]*rn*gp[1]); w[1]=cvtpk_s(dd[hf][i][2]*rn*gp[2],dd[hf][i][3]*rn*gp[3]);
        w[2]=cvtpk_s(dd[hf][i][4]*rn*gp[4],dd[hf][i][5]*rn*gp[5]); w[3]=cvtpk_s(dd[hf][i][6]*rn*gp[6],dd[hf][i][7]*rn*gp[7]);
        *(u32x4*)(CAo+(long)(q0+wid*QBLK+row)*1024+hf*64+ch*8)=w; } }
  }
  asm volatile("s_waitcnt lgkmcnt(0)\n\ts_barrier":::"memory");
  #undef DMA_K
  #undef DMA_V
  #undef CMASK
  #undef START
  #undef RESC
  #undef ROT
  #undef NXT_
  return snext;
}
constexpr int ATTN_LDS_BYTES=LDS_BYTES;
#undef SBAR
#undef WAIT_BAR
}

constexpr int NWAVES = 8, NTHREADS = NWAVES * 64;
#ifndef MK_PER_PHASE
#define MK_PER_PHASE 0
#endif
#ifndef RUN_PHASES
#define RUN_PHASES 8
#endif
constexpr int N_PHASES = RUN_PHASES;

constexpr size_t MiB = 1u << 20;
constexpr size_t WS_CTL = 0, CTL_ZERO_BYTES = 65536;
constexpr size_t WS_RS = 1 * MiB;
constexpr size_t WS_TINFO = 2 * MiB;
constexpr size_t WS_WR = 3 * MiB;
constexpr size_t WS_LTOK = 4 * MiB, WS_LW = 8 * MiB;
constexpr size_t WS_WIN = 16 * MiB, WS_WCA = 25 * MiB, WS_WOUT = 27 * MiB;
constexpr size_t WS_A = 32 * MiB;
constexpr size_t WS_QB = 112 * MiB, WS_KB = 144 * MiB, WS_VB = 176 * MiB, WS_YG = 208 * MiB;
constexpr size_t WS_MG = 32 * MiB  , WS_XM = 176 * MiB;
constexpr size_t WS_GT = 240 * MiB;
constexpr size_t WS_WGU = 240 * MiB, WS_WD = 304 * MiB;
constexpr size_t WS_CA = 368 * MiB;
constexpr size_t WS_YB = 112 * MiB;
constexpr size_t WS_LIST = 320 * MiB;
constexpr size_t WS_CTOK = 336 * MiB;
constexpr size_t WS_XB = 432 * MiB;
constexpr size_t WS_R = 1 * MiB;
constexpr size_t WS_END = 496 * MiB;
static_assert(WS_A + (size_t)CROWS * 1024 <= WS_QB && WS_WD + (size_t)NEXP * 1024 * 512 <= WS_CA, "d_ws map");
static_assert(WS_WIN + (size_t)IN_COLS * 1024 * 2 <= WS_WCA, "d_ws map");
static_assert(WS_WD + (size_t)NEXP * 1024 * 512 <= WS_LIST && WS_LIST + (size_t)NEXP * 32768 * 16 <= WS_CTOK && WS_CTOK + (size_t)112 * 32768 * 4 <= 368 * MiB, "d_ws map: the router's lists sit in the dead second gate plane");

constexpr int RING_BYTES = 131072;
constexpr int META_OFF = RING_BYTES;
constexpr int HIST_OFF = RING_BYTES + 1024;
constexpr int CTL_P3DONE = 720, CTL_L34 = 640;
constexpr int CTL_L23 = 896;
constexpr int CTL_MATCH = 704, CTL_L12 = 768;
constexpr int BARST_OFF = RING_BYTES + 3072;
constexpr int META2_OFF = RING_BYTES + 4096;
constexpr int LDS_BYTES = 147456;

#define GAS __attribute__((address_space(1)))
#define LAS __attribute__((address_space(3)))
typedef unsigned short bf16;
typedef unsigned v4u __attribute__((ext_vector_type(4)));
typedef unsigned v2u __attribute__((ext_vector_type(2)));
typedef float f32x4 __attribute__((ext_vector_type(4)));
typedef float f32x16 __attribute__((ext_vector_type(16)));
typedef short bf16x8 __attribute__((ext_vector_type(8)));
using pg8::cvt_pk_bf16; using pg8::bf_lo; using pg8::bf_hi; using pg8::sigmoidf_fast; using pg8::pack8; using pg8::unpack8;

__device__ __forceinline__ float wave_sum(float v) {
    v += __int_as_float(__builtin_amdgcn_update_dpp(0, __float_as_int(v), 0xB1, 0xf, 0xf, true));
    v += __int_as_float(__builtin_amdgcn_update_dpp(0, __float_as_int(v), 0x4E, 0xf, 0xf, true));
    v += __int_as_float(__builtin_amdgcn_update_dpp(0, __float_as_int(v), 0x141, 0xf, 0xf, true));
    v += __int_as_float(__builtin_amdgcn_update_dpp(0, __float_as_int(v), 0x140, 0xf, 0xf, true));
    const int iv = __float_as_int(v);
    return (__int_as_float(__builtin_amdgcn_readlane(iv, 0)) + __int_as_float(__builtin_amdgcn_readlane(iv, 16))) + (__int_as_float(__builtin_amdgcn_readlane(iv, 32)) + __int_as_float(__builtin_amdgcn_readlane(iv, 48)));
}
__device__ __forceinline__ float wave_max(float v) {
    v = fmaxf(v, __int_as_float(__builtin_amdgcn_update_dpp(0, __float_as_int(v), 0xB1, 0xf, 0xf, true)));
    v = fmaxf(v, __int_as_float(__builtin_amdgcn_update_dpp(0, __float_as_int(v), 0x4E, 0xf, 0xf, true)));
    v = fmaxf(v, __int_as_float(__builtin_amdgcn_update_dpp(0, __float_as_int(v), 0x141, 0xf, 0xf, true)));
    v = fmaxf(v, __int_as_float(__builtin_amdgcn_update_dpp(0, __float_as_int(v), 0x140, 0xf, 0xf, true)));
    const int iv = __float_as_int(v);
    return fmaxf(fmaxf(__int_as_float(__builtin_amdgcn_readlane(iv, 0)), __int_as_float(__builtin_amdgcn_readlane(iv, 16))), fmaxf(__int_as_float(__builtin_amdgcn_readlane(iv, 32)), __int_as_float(__builtin_amdgcn_readlane(iv, 48))));
}
__device__ __forceinline__ float bf16_round(float x) { return bf_lo(cvt_pk_bf16(x, 0.f) & 0xffffu); }

#define XB_TMO      128
#define XB_XCNT(j)  (256  + 64 * (j))
#define XB_XSUB(j)  (1280 + 64 * (j))
#define XB_XGEN(j)  (2304 + 64 * (j))
#define XB_TOP      3328
#define XB_TOPGEN   3392
#define XCD_BAR_WORDS 3456
#define XB_SPIN_CAP (1u << 18)

__device__ __forceinline__ unsigned xb_ld(unsigned* p)              { return __hip_atomic_load(p, __ATOMIC_RELAXED, __HIP_MEMORY_SCOPE_AGENT); }
__device__ __forceinline__ unsigned xb_add(unsigned* p, unsigned v) { return __hip_atomic_fetch_add(p, v, __ATOMIC_RELAXED, __HIP_MEMORY_SCOPE_AGENT); }
__device__ __forceinline__ unsigned xb_xcc_id() { return (unsigned)__builtin_amdgcn_s_getreg((3 << 11) | 20) & 0xFu; }
#define XB_SPIN(cond, bar) do { unsigned _sp = 0; while (cond) { __builtin_amdgcn_s_sleep(1); \
    if ((++_sp & 255u) == 0u) { if (xb_ld(&(bar)[XB_TMO])) break; if (_sp > XB_SPIN_CAP) { atomicAdd(&(bar)[XB_TMO], 1u); break; } } } } while (0)

struct XcdBarrier {
    unsigned* bar; unsigned x;
    volatile LAS unsigned* st;
};

__device__ __forceinline__ XcdBarrier xcd_barrier_post(unsigned* bar, volatile LAS unsigned* st) {
    XcdBarrier b; b.bar = bar; b.x = xb_xcc_id(); b.st = st;
    if (threadIdx.x == 0) (void)xb_add(&bar[XB_XCNT(b.x)], 1u);
    return b;
}
__device__ __forceinline__ void xcd_barrier_complete(unsigned* bar, unsigned x, unsigned& nloc, unsigned& nx) {
    const unsigned G = gridDim.x * gridDim.y * gridDim.z;
    unsigned sum, cnt, mine, sp = 0u;
    for (;;) {
        sum = 0u; cnt = 0u; mine = 0u;
#pragma unroll
        for (unsigned j = 0; j < 16; ++j) { const unsigned c = xb_ld(&bar[XB_XCNT(j)]); sum += c; cnt += (c > 0u) ? 1u : 0u; mine = (j == x) ? c : mine; }
        if (sum == G) break;
        __builtin_amdgcn_s_sleep(1);
        if ((++sp & 255u) == 0u) { if (xb_ld(&bar[XB_TMO])) break; if (sp > XB_SPIN_CAP) { atomicAdd(&bar[XB_TMO], 1u); break; } }
    }
    nloc = mine > 0u ? mine : 1u; nx = cnt > 0u ? cnt : 1u;
}

__device__ __forceinline__ void xcd_barrier(const XcdBarrier& b) {
    asm volatile("s_waitcnt vmcnt(0)" ::: "memory");
    __syncthreads();
    if (threadIdx.x == 0) {
        unsigned* bar = b.bar;
        __builtin_amdgcn_s_waitcnt(0);
        unsigned nloc = b.st[0], nx = b.st[1];
        if (nloc == 0u) { xcd_barrier_complete(bar, b.x, nloc, nx); b.st[0] = nloc; b.st[1] = nx; }
        const unsigned old = xb_add(&bar[XB_XSUB(b.x)], 1u);
        const unsigned gen = old / nloc;
        if (old + 1u == (gen + 1u) * nloc) {
            __builtin_amdgcn_fence(__ATOMIC_RELEASE, "agent");
            asm volatile("s_waitcnt vmcnt(0)" ::: "memory");
            (void)xb_add(&bar[XB_TOP], 1u);
        }
        asm volatile("buffer_inv sc1" ::: "memory");
        XB_SPIN(xb_ld(&bar[XB_TOP]) < (gen + 1u) * nx, bar);
        asm volatile("s_waitcnt vmcnt(0)" ::: "memory");
    }
    __syncthreads();
}


typedef f32x4 AccT[2][2][4][2];
struct EpiInProj {
    static constexpr bool NPRE8 = false, MID = false, PREMID = true;
    struct Pre { float r[2][4]; };
    __device__ __forceinline__ Pre pre(const pg8::Unit& u, int wr, int fr) const { Pre p;
#pragma unroll
        for (int ai = 0; ai < 2; ++ai)
#pragma unroll
            for (int m = 0; m < 4; ++m) p.r[ai][m] = R[u.orow + ai * 128 + wr * 64 + m * 16 + fr];
        return p; }
    bf16 *YG, *QB, *KB, *VB, *GT; const LAS float* gl; const float* R;
    __device__ __forceinline__ void mid(AccT&, const pg8::Unit&, int, int, int, int) const {}
    __device__ __forceinline__ void operator()(AccT& acc, const pg8::Unit& u, int wr, int wc, int fr, int fq, const Pre& pre_) const {
        asm volatile("" : "+v"(fr), "+v"(fq));
        const int pn = u.pn; const size_t row0 = (size_t)u.orow + wr * 64 + fr;
        if (pn < 4) {
#pragma unroll
            for (int ai = 0; ai < 2; ++ai)
#pragma unroll
                for (int m = 0; m < 4; ++m) { const size_t row = row0 + ai * 128 + m * 16; f32x4 y[2]; const float rr = pre_.r[ai][m];
#pragma unroll
                    for (int n = 0; n < 2; ++n) { const f32x4 a = acc[ai][0][m][n] * rr, g = acc[ai][1][m][n] * rr;
                        y[n] = (f32x4){a[0] * sigmoidf_fast(g[0]), a[1] * sigmoidf_fast(g[1]), a[2] * sigmoidf_fast(g[2]), a[3] * sigmoidf_fast(g[3])}; }
                    *(v4u*)(YG + row * 512 + pn * 128 + wc * 32 + 8 * fq) = pack8(y[0], y[1]); }
        } else if (pn < 8) {
            const bool isq = pn < 6; bf16* base = isq ? QB : KB; const LAS float* gp = gl + (isq ? 0 : 64); const float sc = isq ? 0.125f * 1.4426950408889634f : 1.0f;
            f32x4 gv[2][2];
#pragma unroll
            for (int bj = 0; bj < 2; ++bj)
#pragma unroll
                for (int n = 0; n < 2; ++n) gv[bj][n] = *(const LAS f32x4*)(gp + 32 * bj + 8 * fq + 4 * n) * sc;
#pragma unroll
            for (int ai = 0; ai < 2; ++ai)
#pragma unroll
                for (int m = 0; m < 4; ++m) { const size_t row = row0 + ai * 128 + m * 16; float ss = 0.f; const float rr = pre_.r[ai][m];
#pragma unroll
                    for (int bj = 0; bj < 2; ++bj)
#pragma unroll
                        for (int n = 0; n < 2; ++n) { const f32x4 a = acc[ai][bj][m][n]; ss += (a[0] * a[0] + a[1] * a[1]) + (a[2] * a[2] + a[3] * a[3]); }
                    ss += __shfl_xor(ss, 16); ss += __shfl_xor(ss, 32);
                    const float rinv = rr / sqrtf(ss * rr * rr * (1.0f / 64.0f) + EPS);
#pragma unroll
                    for (int bj = 0; bj < 2; ++bj)
                        *(v4u*)(base + row * 512 + (pn & 1) * 256 + wc * 64 + bj * 32 + 8 * fq) = pack8(acc[ai][bj][m][0] * rinv * gv[bj][0], acc[ai][bj][m][1] * rinv * gv[bj][1]); }
        } else if (pn < 10) {
#pragma unroll
            for (int ai = 0; ai < 2; ++ai)
#pragma unroll
                for (int m = 0; m < 4; ++m) { const size_t row = row0 + ai * 128 + m * 16; const float rr = pre_.r[ai][m];
#pragma unroll
                    for (int bj = 0; bj < 2; ++bj) *(v4u*)(VB + row * 512 + (pn - 8) * 256 + bj * 128 + wc * 32 + 8 * fq) = pack8(acc[ai][bj][m][0] * rr, acc[ai][bj][m][1] * rr); }
        } else {
#pragma unroll
            for (int ai = 0; ai < 2; ++ai)
#pragma unroll
                for (int m = 0; m < 4; ++m) { const size_t row = row0 + ai * 128 + m * 16; f32x4 rr[2], gg[2]; const float rz = -1.4426950408889634f * pre_.r[ai][m];
#pragma unroll
                    for (int n = 0; n < 2; ++n)
#pragma unroll
                        for (int j = 0; j < 4; ++j) { const float e0 = __builtin_amdgcn_exp2f(rz * acc[ai][0][m][n][j]), e1 = fminf(__builtin_amdgcn_exp2f(rz * acc[ai][1][m][n][j]), 1e30f);
                            gg[n][j] = __builtin_amdgcn_rcpf(1.0f + e1); rr[n][j] = (1.0f + e1) * __builtin_amdgcn_rcpf(1.0f + e0); }
                    const size_t o = ((((((size_t)u.pm * 8 + (pn - 10)) * 8 + (wr * 4 + wc)) * 2 + ai) * 4 + m) * 64 + (fq * 16 + fr)) * 8; (void)row;
                    __builtin_nontemporal_store(pack8(rr[0], rr[1]), (v4u*)(GT + o)); __builtin_nontemporal_store(pack8(gg[0], gg[1]), (v4u*)(GT + (size_t)NTOK * 1024 + o)); }
        }
    }
};
struct EpiMerged {
    static constexpr bool NPRE8 = true, MID = true, PREMID = true;
    struct Pre { v4u x[4][2]; };
    __device__ __forceinline__ Pre pre(const pg8::Unit& u, int wr, int fr) const { Pre p; const int t = tid_opaque(), fq = (t & 63) >> 4, wc = (t >> 6) & 3;
#pragma unroll
        for (int m = 0; m < 4; ++m)
#pragma unroll
            for (int bj = 0; bj < 2; ++bj) p.x[m][bj] = *(const v4u*)(G1 + ((((((size_t)u.pm * 8 + (2 * u.pn + bj)) * 8 + (wr * 4 + wc)) * 2 + 0) * 4 + m) * 64 + (fq * 16 + fr)) * 8);
        return p; }
    const bf16* GR; const bf16* G1; bf16* MG;
    __device__ __forceinline__ void mid(AccT& acc, const pg8::Unit& u, int wr, int wc, int fr, int fq) const {
        asm volatile("" : "+v"(fr), "+v"(fq));
        const size_t row0 = (size_t)u.orow + wr * 64 + fr; const int col0 = u.pn * 256 + wc * 32 + 8 * fq;
        v4u w0[2][4][2];
#pragma unroll
        for (int ai = 0; ai < 2; ++ai)
#pragma unroll
            for (int m = 0; m < 4; ++m)
#pragma unroll
                for (int bj = 0; bj < 2; ++bj) w0[ai][m][bj] = *(const v4u*)(GR + ((((((size_t)u.pm * 8 + (2 * u.pn + bj)) * 8 + (wr * 4 + wc)) * 2 + ai) * 4 + m) * 64 + (fq * 16 + fr)) * 8);
        __builtin_amdgcn_sched_barrier(0);
#pragma unroll
        for (int ai = 0; ai < 2; ++ai)
#pragma unroll
            for (int m = 0; m < 4; ++m)
#pragma unroll
                for (int bj = 0; bj < 2; ++bj) { f32x4 a0, a1; unpack8(w0[ai][m][bj], a0, a1); acc[ai][bj][m][0] = acc[ai][bj][m][0] * a0; acc[ai][bj][m][1] = acc[ai][bj][m][1] * a1; }
        __builtin_amdgcn_sched_barrier(0);
    }
    __device__ __forceinline__ void operator()(AccT& acc, const pg8::Unit& u, int wr, int wc, int fr, int fq, const Pre& pre_) const {
        asm volatile("" : "+v"(fr), "+v"(fq));
        const size_t row0 = (size_t)u.orow + wr * 64 + fr; const int col0 = u.pn * 256 + wc * 32 + 8 * fq;
        v4u w1[2][4][2];
#pragma unroll
        for (int m = 0; m < 4; ++m)
#pragma unroll
            for (int bj = 0; bj < 2; ++bj) { w1[0][m][bj] = pre_.x[m][bj]; w1[1][m][bj] = *(const v4u*)(G1 + ((((((size_t)u.pm * 8 + (2 * u.pn + bj)) * 8 + (wr * 4 + wc)) * 2 + 1) * 4 + m) * 64 + (fq * 16 + fr)) * 8); }
        __builtin_amdgcn_sched_barrier(0);
#pragma unroll
        for (int ai = 0; ai < 2; ++ai)
#pragma unroll
            for (int m = 0; m < 4; ++m) { const size_t row = row0 + ai * 128 + m * 16;
#pragma unroll
                for (int bj = 0; bj < 2; ++bj) { f32x4 b0, b1; unpack8(w1[ai][m][bj], b0, b1);
                    *(v4u*)(MG + row * 1024 + col0 + bj * 128) = pack8(acc[ai][bj][m][0] * b0, acc[ai][bj][m][1] * b1); } }
    }
};
struct EpiOut {
    static constexpr bool NPRE8 = true, MID = false, PREMID = true;
    struct Pre { v4u x[4][2]; };
    __device__ __forceinline__ Pre pre(const pg8::Unit& u, int wr, int fr) const { Pre p; const int t = tid_opaque(), fq = (t & 63) >> 4, wc = (t >> 6) & 3;
        const size_t row0 = (size_t)u.orow + wr * 64 + fr; const int col0 = u.pn * 256 + wc * 32 + 8 * fq;
#pragma unroll
        for (int m = 0; m < 4; ++m)
#pragma unroll
            for (int bj = 0; bj < 2; ++bj) p.x[m][bj] = __builtin_nontemporal_load((const v4u*)(XB + (row0 + m * 16) * 1024 + col0 + bj * 128));
        return p; }
    const bf16* XB; bf16* XMB; unsigned char* XM8; unsigned* rb; int pm_first;
    __device__ __forceinline__ void mid(AccT&, const pg8::Unit&, int, int, int, int) const {}
    __device__ __forceinline__ void operator()(AccT& acc, const pg8::Unit& u, int wr, int wc, int fr, int fq, const Pre& pre_) const {
        asm volatile("" : "+v"(fr), "+v"(fq));
        if (rb != nullptr && u.pm != pm_first && fr == 0 && fq == 0) __hip_atomic_fetch_add(rb + pm_first, 1u, __ATOMIC_RELAXED, __HIP_MEMORY_SCOPE_AGENT);
        const size_t row0 = (size_t)u.orow + wr * 64 + fr; const int col0 = u.pn * 256 + wc * 32 + 8 * fq;
        v4u xw[2][4][2];
#pragma unroll
        for (int m = 0; m < 4; ++m)
#pragma unroll
            for (int bj = 0; bj < 2; ++bj) { xw[0][m][bj] = pre_.x[m][bj]; xw[1][m][bj] = __builtin_nontemporal_load((const v4u*)(XB + (row0 + 128 + m * 16) * 1024 + col0 + bj * 128)); }
        __builtin_amdgcn_sched_barrier(0);
#pragma unroll
        for (int ai = 0; ai < 2; ++ai)
#pragma unroll
            for (int m = 0; m < 4; ++m) { const size_t off = (row0 + ai * 128 + m * 16) * 1024 + col0;
#pragma unroll
                for (int bj = 0; bj < 2; ++bj) { f32x4 x0, x1; unpack8(xw[ai][m][bj], x0, x1); const f32x4 o0 = x0 + acc[ai][bj][m][0], o1 = x1 + acc[ai][bj][m][1];
                    store16_wt(XMB + off + bj * 128, pack8(o0, o1));
                    v2u w8; w8.x = pg8::pack4_fp8(o0[0], o0[1], o0[2], o0[3]); w8.y = pg8::pack4_fp8(o1[0], o1[1], o1[2], o1[3]); *(v2u*)(XM8 + off + bj * 128) = w8; } }
        __builtin_amdgcn_sched_barrier(0);
    }
};
struct EpiGateUp {
    static constexpr bool NPRE8 = false, MID = false, PREMID = true;
    typedef int i32x4 __attribute__((ext_vector_type(4)));
    struct Pre { i32x4 e; };
    __device__ __forceinline__ Pre pre(const pg8::Unit& u, int, int) const { Pre p; const int t = tid_opaque();
        p.e = (t < 256 && t < u.nvalid) ? *(const i32x4*)(LIST + (size_t)(u.lrow + t) * 4) : (i32x4){-1, -1, 0, 0};
        return p; }
    const int* LIST; unsigned char* HP8; const LAS int* m2; LAS unsigned char* tab;
    __device__ __forceinline__ void mid(AccT&, const pg8::Unit&, int, int, int, int) const {}
    __device__ __forceinline__ void operator()(AccT& acc, const pg8::Unit& u, int wr, int wc, int fr, int fq, const Pre& pre_) const {
        asm volatile("" : "+v"(fr), "+v"(fq));
        { const int t = tid_opaque(); if (t < 256) *(LAS i32x4*)(tab + t * 16) = pre_.e; }
        asm volatile("s_waitcnt lgkmcnt(0)\n\ts_barrier" ::: "memory");
#pragma unroll
        for (int ai = 0; ai < 2; ++ai)
#pragma unroll
            for (int m = 0; m < 4; ++m) { const i32x4 en = *(const LAS i32x4*)(tab + (ai * 128 + wr * 64 + m * 16 + fr) * 16); const int dst = en[1]; if (dst < 0) continue;
                const float rs = __int_as_float(en[3]) * (1.0f / 64.0f), c1 = -1.4426950408889634f * rs, c2 = rs * rs * __int_as_float(en[2]) * 8.0f;
                const size_t drow = (size_t)m2[dst >> 17] * 256 + ((dst >> 1) & 0xffff);
                float h[8];
#pragma unroll
                for (int n = 0; n < 2; ++n)
#pragma unroll
                    for (int j = 0; j < 4; ++j) { const float ag = acc[ai][0][m][n][j]; h[4 * n + j] = __builtin_amdgcn_fmed3f((ag * acc[ai][1][m][n][j]) * c2 * __builtin_amdgcn_rcpf(1.0f + __builtin_amdgcn_exp2f(ag * c1)), -448.f, 448.f); }
                v2u o8; o8.x = pg8::pack4_fp8(h[0], h[1], h[2], h[3]); o8.y = pg8::pack4_fp8(h[4], h[5], h[6], h[7]);
                *(v2u*)(HP8 + drow * 1024 + (dst & 1) * 512 + u.pn * 128 + wc * 32 + 8 * fq) = o8; }
    }
};
struct EpiDownAdd {
    static constexpr bool NPRE8 = false, MID = false, PREMID = true;
    struct Pre { int tok[2][4]; };
    __device__ __forceinline__ Pre pre(const pg8::Unit& u, int wr, int fr) const { Pre p;
#pragma unroll
        for (int ai = 0; ai < 2; ++ai)
#pragma unroll
            for (int m = 0; m < 4; ++m) { const int r = ai * 128 + wr * 64 + m * 16 + fr; p.tok[ai][m] = (r < u.nvalid) ? CTOK[u.lrow + r] : -1; }
        return p; }
    const int* CTOK; const bf16* XMB; float* out;
    __device__ __forceinline__ void mid(AccT&, const pg8::Unit&, int, int, int, int) const {}
    __device__ __forceinline__ void operator()(AccT& acc, const pg8::Unit& u, int wr, int wc, int fr, int fq, const Pre& pre_) const {
        asm volatile("" : "+v"(fr), "+v"(fq));
        const int col0 = u.pn * 256 + wc * 32 + 8 * fq;
        v4u xw[2][4][2];
#pragma unroll
        for (int ai = 0; ai < 2; ++ai)
#pragma unroll
            for (int m = 0; m < 4; ++m) { const int tk = pre_.tok[ai][m]; const size_t off = (size_t)(tk < 0 ? 0 : tk) * 1024 + col0;
#pragma unroll
                for (int bj = 0; bj < 2; ++bj) xw[ai][m][bj] = *(const v4u*)(XMB + off + bj * 128); }
        __builtin_amdgcn_sched_barrier(0);
#pragma unroll
        for (int ai = 0; ai < 2; ++ai)
#pragma unroll
            for (int m = 0; m < 4; ++m) { const int tk = pre_.tok[ai][m]; if (tk < 0) continue; const size_t off = (size_t)tk * 1024 + col0;
#pragma unroll
                for (int bj = 0; bj < 2; ++bj) { f32x4 x0, x1; unpack8(xw[ai][m][bj], x0, x1);
                    __builtin_nontemporal_store(x0 + acc[ai][bj][m][0] * (1.0f / 256.0f), (f32x4*)(out + off + bj * 128)); __builtin_nontemporal_store(x1 + acc[ai][bj][m][1] * (1.0f / 256.0f), (f32x4*)(out + off + bj * 128 + 4)); } }
    }
};
struct MoeOrder {
    int G, c, total; const LAS int* meta;
    __device__ __forceinline__ bool next(int i, pg8::Unit& u) const {
        int cc = c; if (G == 256 && (i + 1) * G > total * 4) cc = ((c & 31) >> 2) * 32 + (c >> 5) * 4 + (c & 3);
        const int L = i * G + cc; if (L >= total * 4) return false;
        const int blk = L >> 2; const int lane = tid_opaque() & 63;
        const int e = __builtin_amdgcn_readfirstlane(__builtin_popcountll(__ballot(lane < NEXP - 1 && meta[1 + lane] <= blk)));
        const int pre = __builtin_amdgcn_readfirstlane(meta[e]), cnt = __builtin_amdgcn_readfirstlane(meta[64 + e]); const int rb = blk - pre;
        u.pn = L & 3; u.pm = rb; u.e = e; u.e2 = e; u.lrow = e * LCAP + rb * 256; u.nvalid = min(256, cnt - rb * 256); u.orow = blk * 256; u.arow = 0; return true;
    }
};
struct ClassOrder {
    int G, c, total; const LAS int* m2;
    __device__ __forceinline__ bool next(int i, pg8::Unit& u) const {
        int cc = c; if (G == 256 && (i + 1) * G > total * 4) cc = ((c & 31) >> 2) * 32 + (c >> 5) * 4 + (c & 3);
        const int L = i * G + cc; if (L >= total * 4) return false;
        const int blk = L >> 2; const int lane = tid_opaque() & 63;
        const int n0 = __builtin_popcountll(__ballot(m2[1 + lane] <= blk)), n1 = __builtin_popcountll(__ballot(lane + 65 <= NCLS - 1 && m2[65 + lane] <= blk));
        const int cls = __builtin_amdgcn_readfirstlane(n0 + n1);
        const int pre = __builtin_amdgcn_readfirstlane(m2[cls]), cnt = __builtin_amdgcn_readfirstlane(m2[128 + cls]); const int rb = blk - pre;
        const int g = cls / 28; int p = cls % 28, a = 0;
        while (p >= 7 - a) { p -= 7 - a; ++a; }
        u.e = g * 8 + a; u.e2 = g * 8 + a + 1 + p; u.pn = L & 3; u.pm = rb; u.lrow = cls * NTOK + rb * 256; u.nvalid = min(256, cnt - rb * 256); u.orow = blk * 256; u.arow = u.orow; return true;
    }
};
__device__ __forceinline__ void moe_meta(LAS int* meta, LAS int* m2, const unsigned* ctl) {
    const int tid = tid_opaque();
    if (tid < NEXP) meta[64 + tid] = (int)__hip_atomic_load(ctl + tid, __ATOMIC_RELAXED, __HIP_MEMORY_SCOPE_AGENT);
    if (tid >= 64 && tid < 64 + NCLS) m2[128 + tid - 64] = (int)__hip_atomic_load(ctl + tid, __ATOMIC_RELAXED, __HIP_MEMORY_SCOPE_AGENT);
    __syncthreads();
    if (tid < 128) { const int lane = tid & 63; const bool cw = tid >= 64;
        const int i0 = cw ? 2 * lane : lane, i1 = 2 * lane + 1;
        const int b0 = cw ? (i0 < NCLS ? (m2[128 + i0] + 255) >> 8 : 0) : (i0 < NEXP ? (meta[64 + i0] + 255) >> 8 : 0);
        const int b1 = (cw && i1 < NCLS) ? (m2[128 + i1] + 255) >> 8 : 0;
        const int s2 = b0 + b1; int inc = s2;
#pragma unroll
        for (int d = 1; d < 64; d <<= 1) { const int t = __shfl_up(inc, d); if (lane >= d) inc += t; }
        const int ex = inc - s2;
        if (cw) { if (i0 < NCLS) m2[i0] = ex; if (i1 < NCLS) m2[i1] = ex + b0; if (lane == 63) m2[NCLS] = inc; }
        else { if (i0 < NEXP) meta[i0] = ex; if (lane == 63) meta[NEXP] = inc; } }
    __syncthreads();
}

__device__ __forceinline__ void transpose_item(const float* W, int N, int k0, int n0, bf16* WT, int dpitch, int drow0, int dcol0, const float* kscale, LAS float* scr, int lane) {
    const int kr = lane >> 3, nc = (lane & 7) * 4;
    f32x4 v[8];
#pragma unroll
    for (int i = 0; i < 8; ++i) v[i] = __builtin_nontemporal_load((const f32x4*)(W + (size_t)(k0 + i * 8 + kr) * N + n0 + nc));
    if (kscale) {
#pragma unroll
        for (int i = 0; i < 8; ++i) v[i] = v[i] * kscale[k0 + i * 8 + kr]; }
#pragma unroll
    for (int i = 0; i < 8; ++i) { LAS float* d = scr + (i * 8 + kr) * 33 + nc; d[0] = v[i][0]; d[1] = v[i][1]; d[2] = v[i][2]; d[3] = v[i][3]; }
    asm volatile("s_waitcnt lgkmcnt(0)" ::: "memory");
    const int c = lane & 7;
#pragma unroll
    for (int j = 0; j < 4; ++j) { const int n = (lane >> 3) + 8 * j; const LAS float* s = scr + (8 * c) * 33 + n;
        v4u o; o.x = cvt_pk_bf16(s[0 * 33], s[1 * 33]); o.y = cvt_pk_bf16(s[2 * 33], s[3 * 33]); o.z = cvt_pk_bf16(s[4 * 33], s[5 * 33]); o.w = cvt_pk_bf16(s[6 * 33], s[7 * 33]);
        *(v4u*)(WT + (size_t)(drow0 + n) * dpitch + dcol0 + k0 + 8 * c) = o; }
    asm volatile("s_waitcnt lgkmcnt(0)" ::: "memory");
}
__device__ __forceinline__ void t8_load(f32x4 (&v)[8], const float* W, int N, int k0, int n0, int lane) {
    const int kg = lane >> 3, nc = (lane & 7) * 4;
#pragma unroll
    for (int i = 0; i < 8; ++i) v[i] = __builtin_nontemporal_load((const f32x4*)(W + (size_t)(k0 + kg * 8 + i) * N + n0 + nc));
}
__device__ __forceinline__ void t8_finish(f32x4 (&v)[8], int k0, unsigned char* WT, int dpitch, int drow0, const float* kscale, float mul, LAS float* scr, int lane) {
    (void)scr; const int kg = lane >> 3, nc = (lane & 7) * 4;
    f32x4 s0 = {mul, mul, mul, mul}, s1 = s0;
    if (kscale) { s0 = *(const f32x4*)(kscale + k0 + kg * 8) * mul; s1 = *(const f32x4*)(kscale + k0 + kg * 8 + 4) * mul; }
#pragma unroll
    for (int t = 0; t < 4; ++t) { v2u o;
        o.x = pg8::pack4_fp8(v[0][t] * s0[0], v[1][t] * s0[1], v[2][t] * s0[2], v[3][t] * s0[3]); o.y = pg8::pack4_fp8(v[4][t] * s1[0], v[5][t] * s1[1], v[6][t] * s1[2], v[7][t] * s1[3]);
        *(v2u*)(WT + (size_t)(drow0 + nc + t) * dpitch + k0 + 8 * kg) = o; }
}
__device__ __forceinline__ void transpose_item_fp8(const float* W, int N, int k0, int n0, unsigned char* WT, int dpitch, int drow0, const float* kscale, float mul, LAS float* scr, int lane) {
    f32x4 v[8]; t8_load(v, W, N, k0, n0, lane); t8_finish(v, k0, WT, dpitch, drow0, kscale, mul, scr, lane);
}
__device__ __forceinline__ int inproj_phys(int c) {
    if (c < 512) return (c >> 7) * 256 + (c & 127);
    if (c < 1024) { c -= 512; return (c >> 7) * 256 + 128 + (c & 127); }
    if (c < 2048) { const int sec = (c - 1024) >> 8, cl = (c - 1024) & 255, s = cl >> 6, d = cl & 63; return 1024 + sec * 256 + ((d >> 5) << 7) + (s << 5) + (d & 31); }
    if (c < 2560) return c;
    { int j = c - 2560; const int hi = j >= 1024; j &= 1023; return 2560 + (j >> 7) * 256 + hi * 128 + (j & 127); }
}
struct Ptrs {
    const float *x, *attn_norm_g, *w_in, *conv_dw_w, *conv_dw_b, *conv_ln_g, *conv_ln_b, *w_conv_out, *q_norm_g, *k_norm_g, *lq1, *lk1, *lq2, *lk2, *subln_g,
        *w_attn_out, *w_out, *ffn_norm_g, *w_rg, *b_rg, *w_re, *b_re, *w_gate, *w_up, *w_down;
    float* out; unsigned char* ws;
};

__device__ __forceinline__ void p0_prologue(const Ptrs& P, LAS unsigned char* lds, int vcu, int G) {
    const int tid = tid_opaque(), lane = tid & 63, wave = __builtin_amdgcn_readfirstlane(tid >> 6);
    LAS float* scr = (LAS float*)(lds + wave * 16384);
    const int gw = vcu * NWAVES + wave, NGW = G * NWAVES;
    bf16* WIN = (bf16*)(P.ws + WS_WIN); bf16* WCA = (bf16*)(P.ws + WS_WCA); bf16* WOUT = (bf16*)(P.ws + WS_WOUT);
    constexpr int I_IN = (DMODEL / 64) * (IN_COLS / 32), I_C = (CONV_CH / 64) * (DMODEL / 32), I_O = (DMODEL / 64) * (DMODEL / 32);
    for (int it = gw; it < I_IN + 2 * I_C + I_O; it += NGW) {
        int r = it;
        if (r < I_IN) { const int kb = r / (IN_COLS / 32), nb = r % (IN_COLS / 32); transpose_item(P.w_in, IN_COLS, kb * 64, nb * 32, WIN, 1024, inproj_phys(nb * 32), 0, P.attn_norm_g, scr, lane); continue; } r -= I_IN;
        if (r < I_C) { const int kb = r / 32, nb = r % 32; transpose_item(P.w_conv_out, DMODEL, kb * 64, nb * 32, WCA, 1024, nb * 32, 0, nullptr, scr, lane); continue; } r -= I_C;
        if (r < I_C) { const int kb = r / 32, nb = r % 32; transpose_item(P.w_attn_out, DMODEL, kb * 64, nb * 32, WCA, 1024, nb * 32, 512, nullptr, scr, lane); continue; } r -= I_C;
        { const int kb = r / 32, nb = r % 32; transpose_item(P.w_out, DMODEL, kb * 64, nb * 32, WOUT, 1024, nb * 32, 0, nullptr, scr, lane); }
    }
    bf16* WRhi = (bf16*)(P.ws + WS_WR); bf16* WRlo = WRhi + 64 * 1024;
    for (int idx = vcu * NTHREADS + tid; idx < 64 * 1024; idx += G * NTHREADS) {
        const int n = idx >> 10, k = idx & 1023; float v = 0.f;
        if (n < 4) v = P.w_rg[k * 4 + n]; else if (n < 36) v = P.w_re[k * 32 + (n - 4)];
        v *= P.ffn_norm_g[k];
        const unsigned hb = cvt_pk_bf16(v, 0.f) & 0xffffu; const float hf = __uint_as_float(hb << 16);
        const int pos = (((k >> 4) * 4 + (n >> 5)) * 64 + ((k >> 3) & 1) * 32 + (n & 31)) * 8 + (k & 7);
        WRhi[pos] = (bf16)hb; WRhi[pos + 2 * 64 * 8] = (bf16)(cvt_pk_bf16(v - hf, 0.f) & 0xffffu);
    }
    bf16* HB = (bf16*)(P.ws + WS_XB); float* RR = (float*)(P.ws + WS_R);
    constexpr int RPT = 4;
    for (int m = gw; m < NTOK; m += RPT * NGW) {
        f32x4 v[RPT][4];
#pragma unroll
        for (int q = 0; q < RPT; ++q) { const int mq = m + q * NGW; const f32x4* xr = (const f32x4*)(P.x + (size_t)(mq < NTOK ? mq : m) * DMODEL) + lane;
#pragma unroll
            for (int j = 0; j < 4; ++j) v[q][j] = __builtin_nontemporal_load(xr + 64 * j); }
#pragma unroll
        for (int q = 0; q < RPT; ++q) { const int mq = m + q * NGW; float ss = 0.f;
#pragma unroll
            for (int j = 0; j < 4; ++j) ss += (v[q][j][0] * v[q][j][0] + v[q][j][1] * v[q][j][1]) + (v[q][j][2] * v[q][j][2] + v[q][j][3] * v[q][j][3]);
            const float r = 1.0f / sqrtf(wave_sum(ss) * (1.0f / DMODEL) + EPS);
            if (mq < NTOK) { v2u* o8 = (v2u*)(HB + (size_t)mq * DMODEL) + lane; if (lane == 0) RR[mq] = r;
#pragma unroll
                for (int j = 0; j < 4; ++j) { const f32x4 y = v[q][j]; v2u w; w.x = cvt_pk_bf16(y[0], y[1]); w.y = cvt_pk_bf16(y[2], y[3]); o8[64 * j] = w; } } }
    }
}

__device__ __forceinline__ void conv_phase(const Ptrs& P, LAS unsigned char* lds, int first, int stride, int end) {
    const int tid = tid_opaque(), lane = tid & 63, wave = __builtin_amdgcn_readfirstlane(tid >> 6);
    const bf16* YG = (const bf16*)(P.ws + WS_YG); bf16* CA = (bf16*)(P.ws + WS_CA);
    LAS bf16* yt = (LAS bf16*)lds; LAS float* co = (LAS float*)(lds + 62 * 1024);
    constexpr int NT = NTOK / 32;
    if (end > NT) end = NT;
    if (first >= end) return;
    float w[CONV_W];
#pragma unroll
    for (int j = 0; j < CONV_W; ++j) w[j] = P.conv_dw_w[j * CONV_CH + tid];
    const float bias = P.conv_dw_b[tid];
    const f32x4 g0 = ((const f32x4*)P.conv_ln_g)[lane], g1 = ((const f32x4*)P.conv_ln_g)[64 + lane], b0 = ((const f32x4*)P.conv_ln_b)[lane], b1 = ((const f32x4*)P.conv_ln_b)[64 + lane];
    v4u pre[8];
#define CONV_FETCH(tile) do { const int b_ = (tile) / (SEQ / 32), t0_ = ((tile) % (SEQ / 32)) * 32; _Pragma("unroll") for (int p = 0; p < 8; ++p) { const int q = tid + NTHREADS * p; const int row = q >> 6, ch = q & 63, t = t0_ - 30 + row; \
        pre[p] = (v4u){0u, 0u, 0u, 0u}; if (q < 62 * 64 && t >= 0) pre[p] = *(const v4u*)(YG + ((size_t)(b_ * SEQ + t)) * 512 + ch * 8); } } while (0)
    CONV_FETCH(first);
    for (int tile = first; tile < end; tile += stride) {
        const int b = tile / (SEQ / 32), t0 = (tile % (SEQ / 32)) * 32;
#pragma unroll
        for (int p = 0; p < 8; ++p) { const int q = tid + NTHREADS * p; if (q < 62 * 64) *(LAS v4u*)(yt + (q >> 6) * 512 + (q & 63) * 8) = pre[p]; }
        __syncthreads();
        if (tile + stride < end) CONV_FETCH(tile + stride);
        float yv[62];
#pragma unroll
        for (int i = 0; i < 62; ++i) yv[i] = __uint_as_float((unsigned)yt[i * 512 + tid] << 16);
#pragma unroll
        for (int t = 0; t < 32; ++t) { float a = bias;
#pragma unroll
            for (int j = 0; j < CONV_W; ++j) a += w[j] * yv[t + j];
            co[t * 512 + tid] = a; }
        __syncthreads();
#pragma unroll
        for (int rr = 0; rr < 4; ++rr) { const int row = wave * 4 + rr;
            const f32x4 v0 = *(const LAS f32x4*)(co + row * 512 + lane * 4), v1 = *(const LAS f32x4*)(co + row * 512 + 256 + lane * 4);
            const float mean = wave_sum((v0[0] + v0[1]) + (v0[2] + v0[3]) + (v1[0] + v1[1]) + (v1[2] + v1[3])) * (1.0f / CONV_CH);
            const f32x4 d0 = v0 - mean, d1 = v1 - mean;
            const float var = wave_sum((d0[0] * d0[0] + d0[1] * d0[1]) + (d0[2] * d0[2] + d0[3] * d0[3]) + (d1[0] * d1[0] + d1[1] * d1[1]) + (d1[2] * d1[2] + d1[3] * d1[3])) * (1.0f / CONV_CH);
            const float rstd = 1.0f / sqrtf(var + EPS);
            f32x4 y0 = d0 * rstd * g0 + b0, y1 = d1 * rstd * g1 + b1;
#pragma unroll
            for (int j = 0; j < 4; ++j) { y0[j] = y0[j] * sigmoidf_fast(y0[j]); y1[j] = y1[j] * sigmoidf_fast(y1[j]); }
            bf16* orow = CA + ((size_t)(b * SEQ + t0 + row)) * 1024;
            v2u o0, o1; o0.x = cvt_pk_bf16(y0[0], y0[1]); o0.y = cvt_pk_bf16(y0[2], y0[3]); o1.x = cvt_pk_bf16(y1[0], y1[1]); o1.y = cvt_pk_bf16(y1[2], y1[3]);
            *(v2u*)(orow + lane * 4) = o0; *(v2u*)(orow + 256 + lane * 4) = o1; }
        __syncthreads();
    }
#undef CONV_FETCH
}

__device__ __forceinline__ void attn_pair(const Ptrs& P, LAS unsigned char* lds, char* lds_generic, int p) {
    const int tid = tid_opaque(), lane = tid & 63, wave = __builtin_amdgcn_readfirstlane(tid >> 6);
    const int bh = p >> 3, s = p & 7, b = bh >> 2, h = bh & 3;
    const __hip_bfloat16* QB = (const __hip_bfloat16*)(P.ws + WS_QB); const __hip_bfloat16* KB = (const __hip_bfloat16*)(P.ws + WS_KB); const __hip_bfloat16* VB = (const __hip_bfloat16*)(P.ws + WS_VB);
    __hip_bfloat16* OT = (__hip_bfloat16*)(P.ws + WS_A); bf16* CA = (bf16*)(P.ws + WS_CA);
    float mstat;
    { int l0 = lane; asm volatile("" : "+v"(l0));
      const float a = wave_max(fabsf(P.q_norm_g[l0])), b = wave_max(fabsf(P.k_norm_g[l0]));
      mstat = __int_as_float(__builtin_amdgcn_readfirstlane(__float_as_int(0.125f * 1.4426950408889634f * 64.0f * 1.02f * a * b))); }
    float lam;
    { int l1 = lane; asm volatile("" : "+v"(l1));
      lam = __int_as_float(__builtin_amdgcn_readfirstlane(__float_as_int(__expf(wave_sum(P.lq1[l1] * P.lk1[l1])) - __expf(wave_sum(P.lq2[l1] * P.lk2[l1])) + 0.2f))); }
    int s0 = 0; bool pre = false;
#pragma unroll 1
    for (int u4 = 0; u4 < 4; ++u4) { const int i = u4 >> 1, c = u4 & 1;
        const int qb = (i == 0) ? s : 15 - s;
        const __hip_bfloat16* q_ = QB + (size_t)b * SEQ * 512 + (h * 2 + c) * 64; const __hip_bfloat16* k_ = KB + (size_t)b * SEQ * 512 + (h * 2 + c) * 64; const __hip_bfloat16* v_ = VB + (size_t)b * SEQ * 512 + h * 128;
        const __hip_bfloat16* kn_ = (u4 < 3) ? KB + (size_t)b * SEQ * 512 + (h * 2 + (c ^ 1)) * 64 : nullptr;
        __hip_bfloat16* o_ = OT + (size_t)b * SEQ * 1024 + (h * 2) * 128;
        const __hip_bfloat16* o1_ = c ? o_ : nullptr; unsigned short* ca_ = CA + (size_t)b * SEQ * 1024 + 512 + h * 128;
        int sn;
        if (mstat <= 40.0f) sn = attn_body::attn_unit<8, true>(mstat, qb * 256, q_, k_, v_, o_, lds_generic, o1_, lam, P.subln_g, ca_, kn_, v_, s0, pre);
        else sn = attn_body::attn_unit<8, false>(0.f, qb * 256, q_, k_, v_, o_, lds_generic, o1_, lam, P.subln_g, ca_, kn_, v_, s0, pre);
        s0 = sn; pre = (kn_ != nullptr); }
}

__device__ __forceinline__ void router_tile(const Ptrs& P, LAS unsigned char* lds, int tile) {
    const int tid = tid_opaque(), lane = tid & 63, wave = __builtin_amdgcn_readfirstlane(tid >> 6), r32 = lane & 31, hi = lane >> 5;
    const bf16* WRhi = (const bf16*)(P.ws + WS_WR); const bf16* WRlo = WRhi + 64 * 1024;
    int* LIST = (int*)(P.ws + WS_LIST); int* CTOK = (int*)(P.ws + WS_CTOK); unsigned* cnt = (unsigned*)(P.ws + WS_CTL); unsigned* ccnt = cnt + 64;
    LAS float* lg = (LAS float*)(lds + wave * 16384);
    LAS int* hist = (LAS int*)(lds + HIST_OFF); LAS int* hbase = hist + 32; LAS int* hist2 = hist + 64; LAS int* hbase2 = hist2 + NCLS;
    if (tid < 32) hist[tid] = 0;
    if (tid >= 64 && tid < 64 + NCLS) hist2[tid - 64] = 0;
    __syncthreads();
    const int tbase = tile * 256 + wave * 32;
    LAS unsigned char* ring = lds + wave * 16384;
    const bf16* xg = (const bf16*)(P.ws + WS_CA) + (size_t)(tbase + (lane >> 3)) * DMODEL + (((lane & 7) ^ ((lane >> 3) & 7)) * 8);
    const bf16* wf0 = WRhi + lane * 8;
    f32x16 acc0 = {}, acc1 = {}; float ssq = 0.f;
#define RT_XDMA(c) do { _Pragma("unroll") for (int i_ = 0; i_ < 4; ++i_) \
        __builtin_amdgcn_global_load_lds((const unsigned*)(xg + (size_t)i_ * 8 * DMODEL + (c) * 64), (LAS unsigned*)(ring + ((c) & 3) * 4096 + i_ * 1024), 16, 0, 16); } while (0)
#define RT_WLOAD(dst, c) do { _Pragma("unroll") for (int q_ = 0; q_ < 4; ++q_) _Pragma("unroll") for (int f_ = 0; f_ < 4; ++f_) dst[q_][f_] = *(const bf16x8*)(wf0 + ((((c) * 4 + q_) * 4 + f_) * 64) * 8); } while (0)
    bf16x8 wA[4][4], wB[4][4];
    RT_XDMA(0); RT_XDMA(1); RT_XDMA(2); RT_WLOAD(wA, 0);
    const LAS unsigned char* xrd = ring + r32 * 128;
#define RT_CHUNK(c, wc, wn) do { \
        if ((c) + 1 < 16) RT_WLOAD(wn, (c) + 1); \
        if ((c) + 3 < 16) RT_XDMA((c) + 3); \
        if ((c) + 3 < 16) asm volatile("s_waitcnt vmcnt(24)" ::: "memory"); else if ((c) + 1 < 16) asm volatile("s_waitcnt vmcnt(16)" ::: "memory"); else asm volatile("s_waitcnt vmcnt(0)" ::: "memory"); \
        _Pragma("unroll") for (int q_ = 0; q_ < 4; ++q_) { \
            const v4u xa = *(const LAS v4u*)(xrd + ((c) & 3) * 4096 + (((2 * q_ + hi) ^ (r32 & 7)) * 16)); \
            f32x4 x0, x1; unpack8(xa, x0, x1); \
            ssq += (x0[0] * x0[0] + x0[1] * x0[1]) + (x0[2] * x0[2] + x0[3] * x0[3]) + (x1[0] * x1[0] + x1[1] * x1[1]) + (x1[2] * x1[2] + x1[3] * x1[3]); \
            const bf16x8 a_hi = __builtin_bit_cast(bf16x8, xa); \
            acc0 = __builtin_amdgcn_mfma_f32_32x32x16_bf16(a_hi, wc[q_][0], acc0, 0, 0, 0); acc1 = __builtin_amdgcn_mfma_f32_32x32x16_bf16(a_hi, wc[q_][1], acc1, 0, 0, 0); \
            acc0 = __builtin_amdgcn_mfma_f32_32x32x16_bf16(a_hi, wc[q_][2], acc0, 0, 0, 0); acc1 = __builtin_amdgcn_mfma_f32_32x32x16_bf16(a_hi, wc[q_][3], acc1, 0, 0, 0); } \
        asm volatile("s_waitcnt lgkmcnt(0)" ::: "memory"); } while (0)
#pragma unroll
    for (int c = 0; c < 16; c += 2) { RT_CHUNK(c, wA, wB); RT_CHUNK(c + 1, wB, wA); }
#undef RT_XDMA
#undef RT_WLOAD
#undef RT_CHUNK
    ssq += __shfl_xor(ssq, 32);
    const float rs = 1.0f / sqrtf(ssq * (1.0f / DMODEL) + EPS);
#pragma unroll
    for (int r = 0; r < 16; ++r) { const int m = (r & 3) + 8 * (r >> 2) + 4 * hi; lg[m * 66 + r32] = acc0[r]; lg[m * 66 + 32 + r32] = acc1[r]; }
    asm volatile("s_waitcnt lgkmcnt(0)" ::: "memory");
    int ea = 0, eb = 0, cls = 0, lpa = 0, lpb = 0, lpc = 0; float wa = 0.f, wb = 0.f;
    if (lane < 32) {
        const LAS float* L = lg + lane * 66;
        float gl[4];
#pragma unroll
        for (int j = 0; j < 4; ++j) gl[j] = L[j] * rs + P.b_rg[j];
        int gs = 0; float gm = gl[0];
#pragma unroll
        for (int j = 1; j < 4; ++j) if (gl[j] > gm) { gm = gl[j]; gs = j; }
        float gsum = 0.f;
#pragma unroll
        for (int j = 0; j < 4; ++j) gsum += __expf(gl[j] - gm);
        const float gw = 1.0f / gsum;
        float l0 = -INFINITY, l1 = -INFINITY; int i0 = 0, i1 = 0;
#pragma unroll
        for (int j = 0; j < 8; ++j) { const float v = L[4 + gs * 8 + j] * rs + P.b_re[gs * 8 + j];
            if (v > l0) { l1 = l0; i1 = i0; l0 = v; i0 = j; } else if (v > l1) { l1 = v; i1 = j; } }
        const float q = __expf(l1 - l0), inv = 1.0f / (1.0f + q);
        const float w0 = inv * gw, w1 = q * inv * gw;
        const int a = min(i0, i1), b = max(i0, i1);
        wa = (i0 < i1) ? w0 : w1; wb = (i0 < i1) ? w1 : w0;
        ea = gs * 8 + a; eb = gs * 8 + b; cls = gs * 28 + (a * (15 - a)) / 2 + (b - a - 1);
        lpa = __hip_atomic_fetch_add(&hist[ea], 1, __ATOMIC_RELAXED, __HIP_MEMORY_SCOPE_WORKGROUP); lpb = __hip_atomic_fetch_add(&hist[eb], 1, __ATOMIC_RELAXED, __HIP_MEMORY_SCOPE_WORKGROUP);
        lpc = __hip_atomic_fetch_add(&hist2[cls], 1, __ATOMIC_RELAXED, __HIP_MEMORY_SCOPE_WORKGROUP);
    }
    __syncthreads();
    if (tid < 32) hbase[tid] = (int)atomicAdd(cnt + tid, (unsigned)hist[tid]);
    if (tid >= 64 && tid < 64 + NCLS) { const int c = tid - 64; const int n = hist2[c]; hbase2[c] = n ? (int)atomicAdd(ccnt + c, (unsigned)n) : 0; }
    __syncthreads();
    if (lane < 32) { const int t = tbase + lane; const int pa = hbase[ea] + lpa, pb = hbase[eb] + lpb, pc = hbase2[cls] + lpc;
        typedef int i32x4 __attribute__((ext_vector_type(4)));
        const int dst = (cls << 17) | (pc << 1);
        *(i32x4*)(LIST + (size_t)(ea * LCAP + pa) * 4) = (i32x4){t, dst, __float_as_int(wa), __float_as_int(rs)};
        *(i32x4*)(LIST + (size_t)(eb * LCAP + pb) * 4) = (i32x4){t, dst | 1, __float_as_int(wb), __float_as_int(rs)};
        CTOK[(size_t)cls * NTOK + pc] = t; }
    __syncthreads();
}

template <bool DOWN> __device__ __forceinline__ void p5_convert(const Ptrs& P, LAS unsigned char* lds, int vcu, int G, int rank = 0, int count = 1) {
    const int tid = tid_opaque(), lane = tid & 63, wave = __builtin_amdgcn_readfirstlane(tid >> 6);
    LAS float* scr = (LAS float*)(lds + wave * 16384);
    const int gw = vcu * NWAVES + wave, NGW = G * NWAVES;
    unsigned char* WGU = P.ws + WS_WGU; unsigned char* WD = P.ws + WS_WD;
    constexpr int I_G = (DMODEL / 64) * (DEXP / 32);
    constexpr int I_D = (DEXP / 64) * (DMODEL / 32);
    constexpr int PER_E = DOWN ? I_D : 2 * I_G;
    constexpr int NITEMS = NEXP * PER_E, NRW = (NTOK / 256) * NWAVES;
    constexpr int SA = P5_SPLIT_A, SB = 16 - SA;
    const bool split = !DOWN && (G == 256) && (NITEMS == NRW * SA + (256 * NWAVES - NRW) * SB);
    const bool rwg = (int)blockIdx.x < NTOK / 256; const int wv = ((int)blockIdx.x - (rwg ? 0 : NTOK / 256)) * NWAVES + wave;
    const int it0 = DOWN ? rank * NWAVES + wave : split ? (rwg ? wv : NRW * SA + wv) : gw, itn = split ? (rwg ? NRW * SA : NITEMS) : NITEMS, its = DOWN ? count * NWAVES : split ? NRW : NGW;
    struct Item { const float* W; int N, k0, n0; unsigned char* WT; int dpitch, drow0; const float* ks; float mul; };
    auto decode = [&](int it) { Item q; const int e = it / PER_E; int r = it % PER_E;
        if (!DOWN) { const int up = r / I_G; r %= I_G; const int kb = r / (DEXP / 32), nb = r % (DEXP / 32), n0 = nb * 32;
            q.W = (up ? P.w_up : P.w_gate) + (size_t)e * DMODEL * DEXP; q.N = DEXP; q.k0 = kb * 64; q.n0 = n0; q.WT = WGU + (size_t)e * 1024 * 1024; q.dpitch = 1024; q.drow0 = (n0 >> 7) * 256 + up * 128 + (n0 & 127); q.ks = P.ffn_norm_g; q.mul = 64.f;
        } else { const int kb = r / (DMODEL / 32), nb = r % (DMODEL / 32);
            q.W = P.w_down + (size_t)e * DEXP * DMODEL; q.N = DMODEL; q.k0 = kb * 64; q.n0 = nb * 32; q.WT = WD + (size_t)e * 1024 * 512; q.dpitch = 512; q.drow0 = nb * 32; q.ks = nullptr; q.mul = 32.f; }
        return q; };
    for (int it = it0; it < itn; it += 4 * its) {
        const bool h1 = it + its < itn, h2 = it + 2 * its < itn, h3 = it + 3 * its < itn;
        const Item a = decode(it), b = decode(h1 ? it + its : it), c = decode(h2 ? it + 2 * its : it), d = decode(h3 ? it + 3 * its : it);
        f32x4 va[8], vb[8], vc[8], vd[8];
        t8_load(va, a.W, a.N, a.k0, a.n0, lane); t8_load(vb, b.W, b.N, b.k0, b.n0, lane); t8_load(vc, c.W, c.N, c.k0, c.n0, lane); t8_load(vd, d.W, d.N, d.k0, d.n0, lane);
        t8_finish(va, a.k0, a.WT, a.dpitch, a.drow0, a.ks, a.mul, scr, lane);
        if (h1) t8_finish(vb, b.k0, b.WT, b.dpitch, b.drow0, b.ks, b.mul, scr, lane);
        if (h2) t8_finish(vc, c.k0, c.WT, c.dpitch, c.drow0, c.ks, c.mul, scr, lane);
        if (h3) t8_finish(vd, d.k0, d.WT, d.dpitch, d.drow0, d.ks, d.mul, scr, lane);
    }
}

struct Args { Ptrs p; int ph_lo, ph_hi, use_cg, pad; };
__global__ void __launch_bounds__(NTHREADS, 2) mega_fwd(Args args) {
    extern __shared__ __attribute__((aligned(16))) unsigned char lds_raw[];
    LAS unsigned char* lds = (LAS unsigned char*)lds_raw;
    const Ptrs& P = args.p;
    const int tid = tid_opaque();
    const int G = gridDim.x, bx = blockIdx.x; const int vcu = (G % 8 == 0) ? (bx % 8) * (G / 8) + bx / 8 : bx;
    const int lo = args.ph_lo, hi = args.ph_hi;
    LAS int* meta = (LAS int*)(lds + META_OFF);
    if (tid < 3) ((volatile LAS unsigned*)(lds + BARST_OFF))[tid] = 0u;
    __syncthreads();
    XcdBarrier bar = xcd_barrier_post((unsigned*)(P.ws + WS_CTL) + 1024, (volatile LAS unsigned*)(lds + BARST_OFF));
    if (tid == 0 && G == 256 && bar.x == (unsigned)(bx & 7)) (void)xb_add((unsigned*)(P.ws + WS_CTL) + CTL_MATCH, 1u);
#ifndef PHASE_MASK
#define PHASE_MASK 0xff
#endif
#ifndef DUP_PHASE
#define DUP_PHASE -1
#endif
#define REPS(k) for (int rep_ = 0; rep_ < ((DUP_PHASE == (k)) ? 2 : 1); ++rep_)
#define REPBAR() do { if (rep_) xcd_barrier(bar); } while (0)
#define IN(k) (((PHASE_MASK >> (k)) & 1) && lo <= (k) && (k) < hi)
#define SEAM(k) do { if (IN(k) && IN((k) + 1)) xcd_barrier(bar); } while (0)
    const bool fine45 = (G == 256) && IN(4) && IN(5) && (DUP_PHASE < 0);
    bf16* WS16 = (bf16*)P.ws;
    if (IN(0)) REPS(0) { REPBAR(); p0_prologue(P, lds, vcu, G); }
    SEAM(0);
    if (IN(1)) REPS(1) { REPBAR();
        pg8::Gemm g{(const bf16*)(P.ws + WS_XB), (const bf16*)(P.ws + WS_WIN), DMODEL, 0, nullptr};
        pg8::StaticOrder S; S.init(NTOK, IN_COLS, G, bx);
        LAS float* gl = (LAS float*)(lds + RING_BYTES + 8192);
        if (tid < 128) gl[tid] = (tid < 64) ? P.q_norm_g[tid] : P.k_norm_g[tid - 64];
        if (tid == 0 && IN(0)) ((volatile LAS unsigned*)(lds + BARST_OFF))[2] = xb_ld((unsigned*)(P.ws + WS_CTL) + CTL_MATCH);
        __syncthreads();
        EpiInProj E{(bf16*)(P.ws + WS_YG), (bf16*)(P.ws + WS_QB), (bf16*)(P.ws + WS_KB), (bf16*)(P.ws + WS_VB), (bf16*)(P.ws + WS_GT), gl, (const float*)(P.ws + WS_R)};
#if defined(DUMP_SEL) && DUMP_SEL == 5
        EpiRaw ER{(bf16*)(P.ws + WS_QB)};
        pg8::gemm_phase<EpiRaw, pg8::StaticOrder, false, true>(lds, g, S, ER);
#else
        pg8::gemm_phase<EpiInProj, pg8::StaticOrder, false, true>(lds, g, S, E);
#endif
    }
    const bool fast12 = (G == 256) && IN(0) && IN(1) && IN(2) && (DUP_PHASE < 0) && __builtin_amdgcn_readfirstlane((int)((volatile LAS unsigned*)(lds + BARST_OFF))[2]) == G;
    if (fast12) { asm volatile("s_waitcnt vmcnt(0)" ::: "memory"); __syncthreads();
        if (tid_opaque() == 0) { unsigned* l12 = (unsigned*)(P.ws + WS_CTL) + CTL_L12 + 16 * bar.x; (void)xb_add(l12, 1u);
            asm volatile("buffer_inv sc1" ::: "memory");
            XB_SPIN(xb_ld(l12) < 32u, bar.bar);
            asm volatile("s_waitcnt vmcnt(0)" ::: "memory"); }
        __syncthreads(); }
    else { SEAM(1); }
    if (IN(2)) {
        REPS(2) { REPBAR();
        for (int p = vcu; p < 256; p += G) attn_pair(P, lds, (char*)lds_raw, p);
        __syncthreads(); }
        REPS(20) { REPBAR();
        if (G == 256) conv_phase(P, lds, (bx & 7) * 128 + (bx >> 3), 32, (bx & 7) * 128 + 128);
        else conv_phase(P, lds, bx, G, NTOK / 32); }
    }
    if (fast12 && IN(3)) { asm volatile("s_waitcnt vmcnt(0)" ::: "memory"); __syncthreads();
        if (tid_opaque() == 0) { unsigned* l23 = (unsigned*)(P.ws + WS_CTL) + CTL_L23 + 16 * bar.x; (void)xb_add(l23, 1u);
            asm volatile("buffer_inv sc1" ::: "memory");
            XB_SPIN(xb_ld(l23) < 32u, bar.bar);
            asm volatile("s_waitcnt vmcnt(0)" ::: "memory"); }
        __syncthreads(); }
    else { SEAM(2); }
    if (IN(3)) REPS(3) { REPBAR();
        pg8::Gemm g{(const bf16*)(P.ws + WS_CA), (const bf16*)(P.ws + WS_WCA), DMODEL, 0, nullptr};
        pg8::StaticOrder S; S.init(NTOK, DMODEL, G, bx);
        EpiMerged E{(const bf16*)(P.ws + WS_GT), (const bf16*)(P.ws + WS_GT) + (size_t)NTOK * 1024, (bf16*)(P.ws + WS_MG)};
#ifdef SKEW3
        if ((bx >> 3) & 1) { const unsigned long long t0 = __builtin_amdgcn_s_memrealtime(); while ((long long)(__builtin_amdgcn_s_memrealtime() - t0) < SKEW3) __builtin_amdgcn_s_sleep(8); }
#endif
        pg8::gemm_phase<EpiMerged, pg8::StaticOrder, false, true>(lds, g, S, E);
    }
    const bool fast34 = fast12 && IN(3) && IN(4);
    if (fast34) { asm volatile("s_waitcnt vmcnt(0)" ::: "memory"); __syncthreads();
        if (tid_opaque() == 0) { unsigned* ctl = (unsigned*)(P.ws + WS_CTL); unsigned* l34 = ctl + CTL_L34 + 8 * bar.x; (void)xb_add(ctl + CTL_P3DONE, 1u); (void)xb_add(l34, 1u);
            asm volatile("buffer_inv sc1" ::: "memory");
            XB_SPIN(xb_ld(l34) < 32u, bar.bar);
            asm volatile("s_waitcnt vmcnt(0)" ::: "memory"); }
        __syncthreads(); }
    else { SEAM(3); }
    if (IN(4)) REPS(4) { REPBAR();
        pg8::Gemm g{(const bf16*)(P.ws + WS_MG), (const bf16*)(P.ws + WS_WOUT), DMODEL, 0, nullptr};
        pg8::StaticOrder S; S.init(NTOK, DMODEL, G, bx);
        unsigned* rbc = fine45 ? (unsigned*)(P.ws + WS_CTL) + 512 : nullptr;
        pg8::Unit u0{}, u1{}; const bool has0 = S.next(0, u0), has1 = S.next(1, u1);
        EpiOut E{(const bf16*)(P.ws + WS_XB), (bf16*)(P.ws + WS_CA), P.ws + WS_XM, rbc, has0 ? u0.pm : -1};
        pg8::gemm_phase<EpiOut, pg8::StaticOrder, false, true>(lds, g, S, E);
        if (fine45 && has0) { asm volatile("s_waitcnt vmcnt(0)" ::: "memory");
            if ((tid_opaque() & 63) == 0) __hip_atomic_fetch_add(rbc + (has1 ? u1.pm : u0.pm), 1u, __ATOMIC_RELAXED, __HIP_MEMORY_SCOPE_AGENT); }
    }
    if (!fine45) { SEAM(4); }
    if (IN(5)) {
        if (fast34) { if (tid_opaque() == 0) { XB_SPIN(xb_ld((unsigned*)(P.ws + WS_CTL) + CTL_P3DONE) < (unsigned)G, bar.bar); } __syncthreads(); }
        if (fine45 && bx < NTOK / 256) { if (tid_opaque() == 0) { const unsigned* rbc = (const unsigned*)(P.ws + WS_CTL) + 512;
                for (int spin = 0; spin < (1 << 22); ++spin) { if (__hip_atomic_load(rbc + bx, __ATOMIC_RELAXED, __HIP_MEMORY_SCOPE_AGENT) >= 32u) break; __builtin_amdgcn_s_sleep(2); } }
            __syncthreads(); }
        for (int t = bx; t < NTOK / 256; t += G) router_tile(P, lds, t);
        REPS(5) { REPBAR(); p5_convert<false>(P, lds, vcu, G); }
    }
    SEAM(5);
    LAS int* meta2 = (LAS int*)(lds + META2_OFF);
    if (IN(6)) REPS(6) { REPBAR();
        moe_meta(meta, meta2, (const unsigned*)(P.ws + WS_CTL));
        pg8::Gemm g{(const bf16*)(P.ws + WS_XM), (const bf16*)(P.ws + WS_WGU), DMODEL / 2, (size_t)1024 * 1024, (const int*)(P.ws + WS_LIST), 4};
        MoeOrder S{G, vcu, __builtin_amdgcn_readfirstlane(meta[NEXP]), meta};
        EpiGateUp E{(const int*)(P.ws + WS_LIST), P.ws + WS_A, meta2, lds + RING_BYTES + 8192};
        pg8::gemm_phase<EpiGateUp, MoeOrder, true, true, true>(lds, g, S, E);
        { const int total4 = S.total * 4; int rank = vcu, count = G;
          bool conv = true;
          if (G == 256) { const int rounds = total4 / G, R = total4 - rounds * G; const int cc = ((vcu & 31) >> 2) * 32 + (vcu >> 5) * 4 + (vcu & 3);
              if (R > 0 && R < G) { conv = cc >= R; rank = cc - R; count = G - R; } else { rank = cc; } }
          if (conv) { asm volatile("s_waitcnt vmcnt(0)" ::: "memory"); __syncthreads();
              p5_convert<true>(P, lds, vcu, G, rank, count); } }
    }
    SEAM(6);
    if (IN(7)) REPS(7) { REPBAR();
        if (!IN(6)) moe_meta(meta, meta2, (const unsigned*)(P.ws + WS_CTL));
        pg8::Gemm g{(const bf16*)(P.ws + WS_A), (const bf16*)(P.ws + WS_WD), DMODEL / 2, (size_t)1024 * 512, nullptr, 0, DEXP / 2};
        ClassOrder S{G, vcu, __builtin_amdgcn_readfirstlane(meta2[NCLS]), meta2};
        EpiDownAdd E{(const int*)(P.ws + WS_CTOK), (const bf16*)(P.ws + WS_CA), P.out};
        pg8::gemm_phase<EpiDownAdd, ClassOrder, false, true, true, true>(lds, g, S, E);
    }
#if defined(DUMP_SEL)
    xcd_barrier(bar);
    { const bf16* YG = (const bf16*)(P.ws + WS_YG); const bf16* QB = (const bf16*)(P.ws + WS_QB); const bf16* KB = (const bf16*)(P.ws + WS_KB); const bf16* VB = (const bf16*)(P.ws + WS_VB);
      const bf16* GT = (const bf16*)(P.ws + WS_GT); const bf16* CA = (const bf16*)(P.ws + WS_CA); const bf16* MG = (const bf16*)(P.ws + WS_MG);
      for (size_t i = (size_t)bx * NTHREADS + tid; i < (size_t)NTOK * 1024; i += (size_t)G * NTHREADS) { const size_t t = i >> 10; const int c = (int)(i & 1023); float v = 0.f;
#if DUMP_SEL == 1
          v = bf_lo(YG[t * 512 + (c & 511)]) + bf_lo(QB[t * 512 + (c & 511)]) + 2.f * bf_lo(KB[t * 512 + (c & 511)]) + 3.f * bf_lo(VB[t * 512 + (c & 511)]) + bf_lo(GT[t * 2048 + c]) + bf_lo(GT[t * 2048 + 1024 + c]);
#elif DUMP_SEL == 2
          v = bf_lo(CA[t * 1024 + c]);
#elif DUMP_SEL == 4
          { const bf16* HB = (const bf16*)(P.ws + WS_A); const bf16* WIN = (const bf16*)(P.ws + WS_WIN); v = bf_lo(HB[i]) + 30.f * bf_lo(WIN[i % ((size_t)IN_COLS * 1024)]); }
#elif DUMP_SEL == 5
          { const bf16* R = (const bf16*)(P.ws + WS_QB); v = bf_lo(R[t * 4608 + c]) + bf_lo(R[t * 4608 + 1024 + c]) + bf_lo(R[t * 4608 + 2048 + c]) + bf_lo(R[t * 4608 + 3072 + c]) + bf_lo(R[t * 4608 + 4096 + (c & 511)]); }
#elif DUMP_SEL == 3
          v = bf_lo(MG[t * 1024 + c]);
#endif
          P.out[i] = v; } }
#endif
    (void)WS16;
#undef IN
#undef SEAM
}

extern "C" void kernel_launch(void* const* d_in, const int* in_sizes, int n_in, void* d_out, int out_size, void* d_ws, size_t ws_size, hipStream_t stream) {
    static int grid = 0;
    if (grid == 0) {
        if (n_in != 25 || in_sizes[0] != NTOK * DMODEL || out_size != NTOK * DMODEL || ws_size < WS_END) {
            fprintf(stderr, "kernel_launch: unexpected shapes (n_in %d, in0 %d, out %d, ws %zu); nothing launched\n", n_in, n_in > 0 ? in_sizes[0] : -1, out_size, ws_size); grid = -1; return; }
        int dev = 0, cus = 0, per_cu = 0;
        if (hipGetDevice(&dev) != hipSuccess || hipDeviceGetAttribute(&cus, hipDeviceAttributeMultiprocessorCount, dev) != hipSuccess) { grid = -1; return; }
        if (hipFuncSetAttribute((const void*)mega_fwd, hipFuncAttributeMaxDynamicSharedMemorySize, LDS_BYTES) != hipSuccess) { fprintf(stderr, "kernel_launch: hipFuncSetAttribute failed\n"); grid = -1; return; }
        if (hipOccupancyMaxActiveBlocksPerMultiprocessor(&per_cu, (const void*)mega_fwd, NTHREADS, LDS_BYTES) != hipSuccess || per_cu < 1) { fprintf(stderr, "kernel_launch: the occupancy query reports %d workgroups per CU for this kernel and LDS size; nothing launched\n", per_cu); grid = -1; return; }
        (void)hipGetLastError();
        grid = cus;
    }
    if (grid < 0) return;
    (void)hipMemsetAsync((char*)d_ws + WS_CTL, 0, CTL_ZERO_BYTES, stream);
    Args a{};
    const float** pp = (const float**)&a.p;
    for (int i = 0; i < 25; ++i) pp[i] = (const float*)d_in[i];
    a.p.out = (float*)d_out; a.p.ws = (unsigned char*)d_ws;
#if MK_PER_PHASE
    for (int ph = 0; ph < N_PHASES; ++ph) { a.ph_lo = ph; a.ph_hi = ph + 1; void* params[] = {&a};
        hipError_t e = hipLaunchCooperativeKernel((const void*)mega_fwd, dim3(grid), dim3(NTHREADS), params, LDS_BYTES, stream);
        if (e != hipSuccess) { fprintf(stderr, "launch %d failed: %s\n", ph, hipGetErrorString(e)); break; } }
#else
    a.ph_lo = 0; a.ph_hi = N_PHASES; void* params[] = {&a};
    hipError_t e = hipLaunchCooperativeKernel((const void*)mega_fwd, dim3(grid), dim3(NTHREADS), params, LDS_BYTES, stream);
    if (e != hipSuccess) fprintf(stderr, "cooperative launch failed: %s (grid %d)\n", hipGetErrorString(e), grid);
#endif
}
```
